# Optimizing an MI355X kernel written in HIP

```python
import math
import jax, jax.numpy as jnp
from jax import lax
import numpy as np

D_MODEL = 1024
BATCH = 2
SEQ = 8192
DEPTH = 1

GRID_W = 64
CTX_LEN = 256
NORM_EPS = 1e-6
ROPE_BASE = 10000.0
MASK_VALUE = -1e30

DA_HEADS = 4
DA_HEAD_DIM = 64
Q_BLOCK = 128
WA_HEADS = 8
WA_KV_HEADS = 2
WA_GROUP = WA_HEADS // WA_KV_HEADS
WA_HEAD_DIM = 64
WINDOW = 128
BAND_BLOCK = WINDOW

QA_COLS = DA_HEADS * 2 * DA_HEAD_DIM
KA_COLS = DA_HEADS * 2 * DA_HEAD_DIM
VA_COLS = DA_HEADS * 2 * DA_HEAD_DIM
QB_COLS = WA_HEADS * WA_HEAD_DIM
KB_COLS = WA_KV_HEADS * WA_HEAD_DIM
VB_COLS = WA_KV_HEADS * WA_HEAD_DIM
IN_COLS = QA_COLS + KA_COLS + VA_COLS + QB_COLS + KB_COLS + VB_COLS
SPLIT_POINTS = [QA_COLS, QA_COLS + KA_COLS, QA_COLS + KA_COLS + VA_COLS,
                QA_COLS + KA_COLS + VA_COLS + QB_COLS,
                QA_COLS + KA_COLS + VA_COLS + QB_COLS + KB_COLS]
DA_OUT = DA_HEADS * 2 * DA_HEAD_DIM
WA_OUT = WA_HEADS * WA_HEAD_DIM
MIX_WIDTH = DA_OUT + WA_OUT

N_EXPERTS = 32
TOP_K = 4
D_EXPERT = 1024
SWIGLU_LIMIT = 7.0
SWIGLU_ALPHA = 1.702
EXPERT_BLOCK = 128

kernel_name = "hymba_diff_swa_moe_dit_block"


def rmsnorm(x, g):
    xf = x.astype(jnp.float32)
    y = xf * lax.rsqrt(jnp.mean(xf * xf, axis=-1, keepdims=True) + NORM_EPS)
    return (y * g.astype(jnp.float32)).astype(x.dtype)


def adaln(cvec, w_mod, b_mod):
    mod = jax.nn.silu(cvec) @ w_mod + b_mod
    return jnp.split(mod, 6, axis=-1)


def modulate(h, shift, scale):
    return h * (1.0 + scale) + shift


def rope_tables(n_tok, head_dim):
    rows_count = n_tok // GRID_W
    rows = jnp.repeat(jnp.arange(rows_count), GRID_W).astype(jnp.float32)
    cols = jnp.tile(jnp.arange(GRID_W), rows_count).astype(jnp.float32)
    nf = head_dim // 4
    inv = ROPE_BASE ** (-jnp.arange(nf, dtype=jnp.float32) / nf)
    ang_r = rows[:, None] * inv
    ang_c = cols[:, None] * inv
    return (jnp.cos(ang_r), jnp.sin(ang_r), jnp.cos(ang_c), jnp.sin(ang_c))


def _rotate(xh, cos, sin):
    nf = xh.shape[-1] // 2
    x1, x2 = xh[..., :nf], xh[..., nf:]
    return jnp.concatenate([x1 * cos - x2 * sin, x2 * cos + x1 * sin], axis=-1)


def axial_rope(x, tabs):
    d = x.shape[-1]
    da = d // 2
    shape = (1, x.shape[1]) + (1,) * (x.ndim - 3) + (da // 2,)
    cr, sr, cc, sc = [t.reshape(shape).astype(x.dtype) for t in tabs]
    return jnp.concatenate([_rotate(x[..., :da], cr, sr), _rotate(x[..., da:], cc, sc)], axis=-1)


def split_proj(p):
    B, N, _ = p.shape
    qa, ka, va, qb, kb, vb = jnp.split(p, SPLIT_POINTS, axis=-1)
    qa = qa.reshape(B, N, DA_HEADS, 2, DA_HEAD_DIM)
    ka = ka.reshape(B, N, DA_HEADS, 2, DA_HEAD_DIM)
    va = va.reshape(B, N, DA_HEADS, 2 * DA_HEAD_DIM)
    qb = qb.reshape(B, N, WA_KV_HEADS, WA_GROUP, WA_HEAD_DIM)
    kb = kb.reshape(B, N, WA_KV_HEADS, WA_HEAD_DIM)
    vb = vb.reshape(B, N, WA_KV_HEADS, WA_HEAD_DIM)
    return qa, ka, va, qb, kb, vb


def diff_attend(q, k, v, lam):
    s = jnp.einsum('bqhcd,bkhcd->bhcqk', q, k).astype(jnp.float32)
    p = jax.nn.softmax(s, axis=-1)
    a = p[:, :, 0] - lam * p[:, :, 1]
    return jnp.einsum('bhqk,bkhe->bqhe', a.astype(v.dtype), v)


def diff_attend_latent(q, k_all, v_all, lam):
    B, S, H, _, d = q.shape
    nqb = S // Q_BLOCK
    qb = jnp.moveaxis(q.reshape(B, nqb, Q_BLOCK, H, 2, d), 1, 0)
    out = lax.map(lambda qq: diff_attend(qq, k_all, v_all, lam), qb)
    return jnp.moveaxis(out, 0, 1).reshape(B, S, H, 2 * d)


def diff_post(o, subln_g, lam_init):
    B, N = o.shape[:2]
    return (rmsnorm(o, subln_g) * (1.0 - lam_init)).reshape(B, N, DA_OUT)


def window_gqa_latent(q, k, v, k_ctx, v_ctx, sink):
    B, S, KV, G, d = q.shape
    W = BAND_BLOCK
    nb = S // W
    pad = ((0, 0), (W, W), (0, 0), (0, 0))
    kp = jnp.pad(k, pad).reshape(B, nb + 2, W, KV, d)
    vp = jnp.pad(v, pad).reshape(B, nb + 2, W, KV, d)
    kband = jnp.concatenate([kp[:, :-2], kp[:, 1:-1], kp[:, 2:]], axis=2)
    vband = jnp.concatenate([vp[:, :-2], vp[:, 1:-1], vp[:, 2:]], axis=2)
    qbk = q.reshape(B, nb, W, KV, G, d)
    s_loc = jnp.einsum('bnqkgd,bnjkd->bnkgqj', qbk, kband).astype(jnp.float32)
    s_ctx = jnp.einsum('bnqkgd,bjkd->bnkgqj', qbk, k_ctx).astype(jnp.float32)
    n_i = jnp.arange(nb)[:, None, None]
    q_i = jnp.arange(W)[None, :, None]
    k_j = jnp.arange(3 * W)[None, None, :]
    kpos = (n_i - 1) * W + k_j
    rel = k_j - W - q_i
    valid = (jnp.abs(rel) <= WINDOW) & (kpos >= 0) & (kpos < S)
    s_loc = jnp.where(valid[None, :, None, None], s_loc, MASK_VALUE)
    sink_col = jnp.broadcast_to(sink.astype(jnp.float32).reshape(1, 1, KV, G, 1, 1),
                                s_loc.shape[:-1] + (1,))
    p = jax.nn.softmax(jnp.concatenate([s_loc, s_ctx, sink_col], axis=-1), axis=-1)
    p_loc = p[..., :3 * W].astype(v.dtype)
    p_ctx = p[..., 3 * W:-1].astype(v.dtype)
    o = (jnp.einsum('bnkgqj,bnjkd->bnqkgd', p_loc, vband)
         + jnp.einsum('bnkgqj,bjkd->bnqkgd', p_ctx, v_ctx))
    return o.reshape(B, S, WA_OUT)


def sink_attend_ctx(q, k, v, sink):
    B, C, KV, G, d = q.shape
    s = jnp.einsum('bqkgd,bjkd->bkgqj', q, k).astype(jnp.float32)
    sink_col = jnp.broadcast_to(sink.astype(jnp.float32).reshape(1, KV, G, 1, 1), s.shape[:-1] + (1,))
    p = jax.nn.softmax(jnp.concatenate([s, sink_col], axis=-1), axis=-1)[..., :-1]
    o = jnp.einsum('bkgqj,bjkd->bqkgd', p.astype(v.dtype), v)
    return o.reshape(B, C, WA_OUT)


def moe(x2d, w_r, b_r, w_gu, b_gu, w_dn, b_dn):
    T, D = x2d.shape
    logits = (x2d @ w_r + b_r).astype(jnp.float32)
    top_v, top_i = lax.top_k(logits, TOP_K)
    gates = jax.nn.softmax(top_v, axis=-1)
    flat_e = top_i.reshape(-1).astype(jnp.int32)
    n_assign = T * TOP_K
    order = jnp.argsort(flat_e)
    sorted_e = flat_e[order]
    counts = jnp.zeros((N_EXPERTS,), jnp.int32).at[flat_e].add(1)
    padded = ((counts + EXPERT_BLOCK - 1) // EXPERT_BLOCK) * EXPERT_BLOCK
    start = jnp.cumsum(counts) - counts
    pend = jnp.cumsum(padded)
    pstart = pend - padded
    rank = jnp.arange(n_assign, dtype=jnp.int32) - start[sorted_e]
    dest_sorted = (pstart[sorted_e] + rank).astype(jnp.int32)
    n_rows = n_assign + N_EXPERTS * EXPERT_BLOCK
    n_blocks = n_rows // EXPERT_BLOCK
    row_tok = jnp.full((n_rows,), T, jnp.int32).at[dest_sorted].set((order // TOP_K).astype(jnp.int32))
    block_start = jnp.arange(n_blocks, dtype=jnp.int32) * EXPERT_BLOCK
    block_exp = jnp.clip(jnp.searchsorted(pend, block_start, side='right'), 0, N_EXPERTS - 1)
    x_pad = jnp.concatenate([x2d, jnp.zeros((1, D), x2d.dtype)], axis=0)

    def expert_block(args):
        tok, e = args
        xb = x_pad[tok]
        h = xb @ w_gu[e] + b_gu[e]
        g = jnp.minimum(h[:, ::2], SWIGLU_LIMIT)
        lin = jnp.clip(h[:, 1::2], -SWIGLU_LIMIT, SWIGLU_LIMIT)
        a = g * jax.nn.sigmoid(SWIGLU_ALPHA * g) * (lin + 1.0)
        return a @ w_dn[e] + b_dn[e]

    rows = lax.map(expert_block, (row_tok.reshape(n_blocks, EXPERT_BLOCK), block_exp))
    rows = rows.reshape(n_rows, D)
    dest = jnp.zeros((n_assign,), jnp.int32).at[order].set(dest_sorted)
    y = rows[dest].reshape(T, TOP_K, D)
    return jnp.einsum('tk,tkd->td', gates.astype(y.dtype), y)


def setup_inputs(seed: int = 0) -> dict:
    key = jax.random.key(seed)
    ks = jax.random.split(key, 24)
    D, L, E, F = D_MODEL, DEPTH, N_EXPERTS, D_EXPERT
    nrm = lambda k, s: jax.random.normal(k, s, jnp.float32)
    return {
        "x": nrm(ks[0], (BATCH, SEQ, D)),
        "c": nrm(ks[1], (BATCH, D)),
        "ctx": nrm(ks[2], (BATCH, CTX_LEN, D)),
        "c_ctx": nrm(ks[3], (D,)),
        "w_mod": nrm(ks[4], (L, D, 6 * D)) * (0.5 * D ** -0.5),
        "b_mod": nrm(ks[5], (L, 6 * D)) * 0.02,
        "norm1_g": 1.0 + 0.05 * nrm(ks[6], (L, D)),
        "w_in": nrm(ks[7], (L, D, IN_COLS)) * D ** -0.5,
        "lam_q1": 0.1 * nrm(ks[8], (L, DA_HEAD_DIM)),
        "lam_k1": 0.1 * nrm(ks[9], (L, DA_HEAD_DIM)),
        "lam_q2": 0.1 * nrm(ks[10], (L, DA_HEAD_DIM)),
        "lam_k2": 0.1 * nrm(ks[11], (L, DA_HEAD_DIM)),
        "subln_g": 1.0 + 0.05 * nrm(ks[12], (L, 2 * DA_HEAD_DIM)),
        "sink": 0.5 * nrm(ks[13], (L, WA_HEADS)),
        "w_out": nrm(ks[14], (L, MIX_WIDTH, D)) * MIX_WIDTH ** -0.5,
        "norm2_g": 1.0 + 0.05 * nrm(ks[15], (L, D)),
        "w_router": nrm(ks[16], (L, D, E)) * D ** -0.5,
        "b_router": 0.01 * nrm(ks[17], (L, E)),
        "w_gate_up": nrm(ks[18], (L, E, D, 2 * F)) * D ** -0.5,
        "b_gate_up": 0.01 * nrm(ks[19], (L, E, 2 * F)),
        "w_down": nrm(ks[20], (L, E, F, D)) * F ** -0.5,
        "b_down": 0.01 * nrm(ks[21], (L, E, D)),
        "final_g": 1.0 + 0.05 * nrm(ks[22], (D,)),
    }


def reference(x, c, ctx, c_ctx, w_mod, b_mod, norm1_g, w_in, lam_q1, lam_k1, lam_q2, lam_k2,
              subln_g, sink, w_out, norm2_g, w_router, b_router, w_gate_up, b_gate_up,
              w_down, b_down, final_g):
    B, S, D = x.shape
    C = ctx.shape[1]
    ROWS = S // GRID_W
    tabs = rope_tables(ROWS * GRID_W, DA_HEAD_DIM)
    scale_a = DA_HEAD_DIM ** -0.5
    scale_b = WA_HEAD_DIM ** -0.5
    cs = ctx
    for l in range(DEPTH):
        lam_init = 0.8 - 0.6 * math.exp(-0.3 * l)
        sh1, sc1, g1, sh2, sc2, g2 = [m[:, None, :] for m in adaln(c, w_mod[l], b_mod[l])]
        csh1, csc1, cg1, csh2, csc2, cg2 = [m[None, None, :] for m in adaln(c_ctx, w_mod[l], b_mod[l])]

        hx = modulate(rmsnorm(x, norm1_g[l]), sh1, sc1)
        hc = modulate(rmsnorm(cs, norm1_g[l]), csh1, csc1)
        qa, ka, va, qb, kb, vb = split_proj(hx @ w_in[l])
        qac, kac, vac, qbc, kbc, vbc = split_proj(hc @ w_in[l])
        qa = axial_rope(qa * scale_a, tabs)
        ka = axial_rope(ka, tabs)
        qb = axial_rope(qb * scale_b, tabs)
        kb = axial_rope(kb, tabs)
        lam = (jnp.exp(jnp.sum(lam_q1[l].astype(jnp.float32) * lam_k1[l].astype(jnp.float32)))
               - jnp.exp(jnp.sum(lam_q2[l].astype(jnp.float32) * lam_k2[l].astype(jnp.float32)))
               + lam_init)
        ya = diff_attend_latent(qa, jnp.concatenate([ka, kac], axis=1),
                                jnp.concatenate([va, vac], axis=1), lam)
        ya = diff_post(ya, subln_g[l], lam_init)
        yb = window_gqa_latent(qb, kb, vb, kbc, vbc, sink[l])
        x = x + g1 * (jnp.concatenate([ya, yb], axis=-1) @ w_out[l])
        if l < DEPTH - 1:
            yac = diff_post(diff_attend(qac * scale_a, kac, vac, lam), subln_g[l], lam_init)
            ybc = sink_attend_ctx(qbc * scale_b, kbc, vbc, sink[l])
            cs = cs + cg1 * (jnp.concatenate([yac, ybc], axis=-1) @ w_out[l])

        hx2 = modulate(rmsnorm(x, norm2_g[l]), sh2, sc2)
        x = x + g2 * moe(hx2.reshape(B * S, D), w_router[l], b_router[l], w_gate_up[l],
                         b_gate_up[l], w_down[l], b_down[l]).reshape(B, S, D)
        if l < DEPTH - 1:
            hc2 = modulate(rmsnorm(cs, norm2_g[l]), csh2, csc2)
            cs = cs + cg2 * moe(hc2.reshape(B * C, D), w_router[l], b_router[l], w_gate_up[l],
                                b_gate_up[l], w_down[l], b_down[l]).reshape(B, C, D)
    return rmsnorm(x, final_g)
```

```cpp
#include <hip/hip_runtime.h>
#include <cstdio>
#include <cstdint>
namespace pg8 {
#define PG8_LAS __attribute__((address_space(3)))
typedef unsigned short bf16_t;
typedef short bf16x8 __attribute__((ext_vector_type(8)));
typedef float f32x4 __attribute__((ext_vector_type(4)));
typedef unsigned u32x4 __attribute__((ext_vector_type(4)));
constexpr int BM = 256, BK = 64, HALF = 128, HTB = HALF * BK * 2  , STAGE_BYTES = 8 * HTB, NXCD = 8, WGM = 8;

__host__ __device__ __forceinline__ int lds_byte(int r, int c) { const int st = (r >> 4) * 2 + (c >> 5), rr = r & 15, cc = c & 31, ob = rr * 64 + cc * 2; return st * 1024 + (ob ^ (((ob >> 9) & 1) << 5)); }
__host__ __device__ __forceinline__ void stage_rc(int b, int& R, int& C) { const int st = b / 1024, sb = b % 1024, swz = sb ^ (((sb >> 9) & 1) << 5); R = (st >> 1) * 16 + swz / 64; C = (st & 1) * 32 + (swz % 64) / 2; }
__host__ __device__ __forceinline__ int perm32(int rho) { const int n = rho >> 4, i = rho & 15; return 8 * (i >> 2) + 4 * n + (i & 3); }

struct Unit { int pm, pn; };
struct Gemm { const bf16_t* A; const bf16_t* Bt; int M, N, K; };

struct StaticOrder {
    int nM, nN, nwg, G, c;
    __host__ __device__ void init(int M, int N, int G_, int c_) { nM = M / BM; nN = N / BM; nwg = nM * nN; G = G_; c = c_; }
    __host__ __device__ bool next(int i, Unit& u) const {
        const long L = (long)i * G + c; if (L >= nwg) return false;
        int wgid = (int)L; { const int q = nwg / NXCD, r = nwg % NXCD, xcd = wgid % NXCD, off = wgid / NXCD; wgid = (xcd < r ? xcd * (q + 1) : r * (q + 1) + (xcd - r) * q) + off; }
        const int nig = WGM * nN, gid = wgid / nig, fm = gid * WGM, gsz = (nM - fm) < WGM ? (nM - fm) : WGM;
        u.pm = fm + ((wgid % nig) % gsz); u.pn = (wgid % nig) / gsz; return true;
    }
    __device__ __forceinline__ void a_ready(const Unit&) const {}
    __device__ __forceinline__ void done(const Unit&) const {}
};

__device__ __forceinline__ unsigned cvt_pk_bf16(float lo, float hi) { unsigned r; asm volatile("v_cvt_pk_bf16_f32 %0, %1, %2" : "=v"(r) : "v"(lo), "v"(hi)); return r; }
typedef float f32x2 __attribute__((ext_vector_type(2)));
template <class Epi, class Sched, bool ALIGN_EPI = false, bool SP2 = false>
__device__ __forceinline__ void gemm_phase(PG8_LAS unsigned char* lds, const Gemm g, const Sched& S, const Epi& E) {
    const int tid = threadIdx.x, wid = __builtin_amdgcn_readfirstlane(tid >> 6), lane = tid & 63, wr = wid >> 2, wc = wid & 3, fr = lane & 15, fq = lane >> 4;
    const int K = g.K, nt = K / BK;
    unsigned voffA[2], voffB[2];
#pragma unroll
    for (int i = 0; i < 2; ++i) { int R, C; stage_rc(tid * 16 + i * 8192, R, C); const int Rb = Epi::PERM ? ((R & ~31) + perm32(R & 31)) : R;
        voffA[i] = (unsigned)(R * K + C) * 2u; voffB[i] = (unsigned)(Rb * K + C) * 2u; }
    const size_t kstep = (size_t)(BK * 2);
    const size_t hstep = (size_t)HALF * K * 2;
    const size_t tstep = 2 * hstep;
    const unsigned ldsw = (unsigned)wid * 1024u;
    const int aoff = lds_byte(wr * 64 + fr, fq * 8), boff = lds_byte(wc * 32 + fr, fq * 8);
#define PG8_SA(b, h) (((b) * 2 + (h)) * HTB)
#define PG8_SB(b, h) ((4 + (b) * 2 + (h)) * HTB)
#define PG8_STAGE(bufoff, gbase, voff) do { _Pragma("unroll") for (int _i = 0; _i < 2; ++_i) \
        __builtin_amdgcn_global_load_lds((const unsigned*)((const char*)(gbase) + (voff)[_i]), (PG8_LAS unsigned*)(lds + (bufoff) + ldsw + _i * 8192), 16, 0, 0); } while (0)
#define PG8_LDA(dst, b, h) do { _Pragma("unroll") for (int m = 0; m < 4; ++m) _Pragma("unroll") for (int k = 0; k < 2; ++k) dst[m][k] = *(const PG8_LAS bf16x8*)(lds + PG8_SA(b, h) + aoff + m * 2048 + k * 1024); } while (0)
#define PG8_LDB(dst, b, h) do { _Pragma("unroll") for (int n = 0; n < 2; ++n) _Pragma("unroll") for (int k = 0; k < 2; ++k) dst[n][k] = *(const PG8_LAS bf16x8*)(lds + PG8_SB(b, h) + boff + n * 2048 + k * 1024); } while (0)
#define PG8_MMA(ai, bj, At, Bt) do { __builtin_amdgcn_s_setprio(1); _Pragma("unroll") for (int m = 0; m < 4; ++m) _Pragma("unroll") for (int n = 0; n < 2; ++n) _Pragma("unroll") for (int k = 0; k < 2; ++k) \
        acc[ai][bj][m][n] = __builtin_amdgcn_mfma_f32_16x16x32_bf16(Bt[n][k], At[m][k], acc[ai][bj][m][n], 0, 0, 0); __builtin_amdgcn_s_setprio(0); } while (0)
#define PG8_WAIT_V(n) asm volatile("s_waitcnt vmcnt(" #n ")" ::: "memory")
#define PG8_WAIT_L(n) asm volatile("s_waitcnt lgkmcnt(" #n ")" ::: "memory")
#define PG8_BAR __builtin_amdgcn_s_barrier()
#define PG8_SCHED __builtin_amdgcn_sched_barrier(0)
    Unit cur, nxt; int ui = 0;
    if (!S.next(0, cur)) return;
    f32x4 acc[2][2][4][2];
#pragma unroll
    for (int a = 0; a < 2; ++a)
#pragma unroll
        for (int b = 0; b < 2; ++b)
#pragma unroll
            for (int m = 0; m < 4; ++m)
#pragma unroll
                for (int n = 0; n < 2; ++n) acc[a][b][m][n] = (f32x4){0.f, 0.f, 0.f, 0.f};
    bf16x8 At[4][2], B0[2][2], B1[2][2];
    const char* cA = (const char*)g.A + (size_t)cur.pm * tstep; const char* cB = (const char*)g.Bt + (size_t)cur.pn * tstep;
    S.a_ready(cur);
    if constexpr (SP2) {
        PG8_STAGE(PG8_SB(0, 0), cB, voffB); PG8_STAGE(PG8_SB(0, 1), cB + hstep, voffB); PG8_STAGE(PG8_SA(0, 0), cA, voffA); PG8_STAGE(PG8_SA(0, 1), cA + hstep, voffA);
        if (wr == 1) PG8_BAR;
        PG8_WAIT_V(2); PG8_BAR;
        PG8_STAGE(PG8_SB(1, 0), cB + kstep, voffB); PG8_STAGE(PG8_SA(1, 0), cA + kstep, voffA); PG8_STAGE(PG8_SB(1, 1), cB + hstep + kstep, voffB);
        PG8_WAIT_V(6); PG8_BAR;
    } else {
        PG8_STAGE(PG8_SB(0, 0), cB, voffB); PG8_STAGE(PG8_SA(0, 0), cA, voffA); PG8_STAGE(PG8_SB(0, 1), cB + hstep, voffB); PG8_STAGE(PG8_SA(0, 1), cA + hstep, voffA);
        if (wr == 1) PG8_BAR;
        PG8_WAIT_V(4); PG8_BAR;
        PG8_STAGE(PG8_SB(1, 0), cB + kstep, voffB); PG8_STAGE(PG8_SA(1, 0), cA + kstep, voffA); PG8_STAGE(PG8_SB(1, 1), cB + hstep + kstep, voffB);
        PG8_WAIT_V(6); PG8_BAR;
    }
    for (;;) {
        const bool has_next = S.next(ui + 1, nxt);
        const char* nA = has_next ? (const char*)g.A + (size_t)nxt.pm * tstep : cA; const char* nB = has_next ? (const char*)g.Bt + (size_t)nxt.pn * tstep : cB;
        for (int t = 0; t < nt; t += 2) {
            const bool last = (t == nt - 2);
            const char* a1 = cA + (size_t)(t + 1) * kstep;
            const char* a2 = last ? nA : cA + (size_t)(t + 2) * kstep; const char* b2 = last ? nB : cB + (size_t)(t + 2) * kstep;
            const char* a3 = a2 + kstep; const char* b3 = b2 + kstep;
            if (last && has_next) S.a_ready(nxt);
            if constexpr (SP2) {
            PG8_LDB(B0, 0, 0); PG8_LDB(B1, 0, 1); PG8_SCHED; PG8_LDA(At, 0, 0); PG8_STAGE(PG8_SA(1, 1), a1 + hstep, voffA);
            PG8_WAIT_V(8); PG8_WAIT_L(0); PG8_BAR; PG8_MMA(0, 0, At, B0); PG8_MMA(0, 1, At, B1); PG8_BAR; PG8_SCHED;
            PG8_LDA(At, 0, 1); PG8_STAGE(PG8_SB(0, 0), b2, voffB); PG8_STAGE(PG8_SB(0, 1), b2 + hstep, voffB); PG8_STAGE(PG8_SA(0, 0), a2, voffA);
            PG8_WAIT_V(8); PG8_WAIT_L(0); PG8_BAR; PG8_MMA(1, 0, At, B0); PG8_MMA(1, 1, At, B1); PG8_BAR; PG8_SCHED;
            PG8_LDB(B0, 1, 0); PG8_LDB(B1, 1, 1); PG8_SCHED; PG8_LDA(At, 1, 0); PG8_STAGE(PG8_SA(0, 1), a2 + hstep, voffA);
            PG8_WAIT_V(8); PG8_WAIT_L(0); PG8_BAR; PG8_MMA(0, 0, At, B0); PG8_MMA(0, 1, At, B1); PG8_BAR; PG8_SCHED;
            PG8_LDA(At, 1, 1); PG8_STAGE(PG8_SB(1, 0), b3, voffB); PG8_STAGE(PG8_SB(1, 1), b3 + hstep, voffB); PG8_STAGE(PG8_SA(1, 0), a3, voffA);
            PG8_WAIT_V(8); PG8_WAIT_L(0); PG8_BAR; PG8_MMA(1, 0, At, B0); PG8_MMA(1, 1, At, B1); PG8_BAR; PG8_SCHED;
            } else {
            PG8_LDB(B0, 0, 0); PG8_SCHED; PG8_LDA(At, 0, 0); PG8_STAGE(PG8_SA(1, 1), a1 + hstep, voffA);
            PG8_WAIT_L(8); PG8_BAR; PG8_WAIT_L(0); PG8_MMA(0, 0, At, B0); PG8_BAR; PG8_SCHED;
            PG8_LDB(B1, 0, 1); PG8_STAGE(PG8_SB(0, 0), b2, voffB);
            PG8_BAR; PG8_WAIT_L(0); PG8_MMA(0, 1, At, B1); PG8_BAR;
            PG8_LDA(At, 0, 1); PG8_STAGE(PG8_SA(0, 0), a2, voffA);
            PG8_BAR; PG8_WAIT_L(0); PG8_MMA(1, 0, At, B0); PG8_BAR; PG8_SCHED;
            PG8_STAGE(PG8_SB(0, 1), b2 + hstep, voffB);
            PG8_WAIT_V(6); PG8_BAR; PG8_MMA(1, 1, At, B1); PG8_BAR;
            PG8_LDB(B0, 1, 0); PG8_SCHED; PG8_LDA(At, 1, 0); PG8_STAGE(PG8_SA(0, 1), a2 + hstep, voffA);
            PG8_WAIT_L(8); PG8_BAR; PG8_WAIT_L(0); PG8_MMA(0, 0, At, B0); PG8_BAR; PG8_SCHED;
            PG8_LDB(B1, 1, 1); PG8_STAGE(PG8_SB(1, 0), b3, voffB);
            PG8_BAR; PG8_WAIT_L(0); PG8_MMA(0, 1, At, B1); PG8_BAR;
            PG8_LDA(At, 1, 1); PG8_STAGE(PG8_SA(1, 0), a3, voffA);
            PG8_BAR; PG8_WAIT_L(0); PG8_MMA(1, 0, At, B0); PG8_BAR; PG8_SCHED;
            PG8_STAGE(PG8_SB(1, 1), b3 + hstep, voffB);
            PG8_WAIT_V(6); PG8_BAR; PG8_MMA(1, 1, At, B1); PG8_BAR;
            }
        }
        if constexpr (ALIGN_EPI) { if (wr == 0) PG8_BAR; }
        if constexpr (!Epi::AFTER_DRAIN) { E(acc, cur, wr, wc, fr, fq); S.done(cur); }
        if (!has_next) break;
#pragma unroll
        for (int a = 0; a < 2; ++a)
#pragma unroll
            for (int b = 0; b < 2; ++b)
#pragma unroll
                for (int m = 0; m < 4; ++m)
#pragma unroll
                    for (int n = 0; n < 2; ++n) acc[a][b][m][n] = (f32x4){0.f, 0.f, 0.f, 0.f};
        cur = nxt; cA = nA; cB = nB; ++ui;
        if constexpr (ALIGN_EPI) { if (wr == 1) PG8_BAR; }
    }
    PG8_WAIT_V(0);
    if constexpr (!ALIGN_EPI) { if (wr == 0) PG8_BAR; }
    PG8_BAR;
    if constexpr (Epi::AFTER_DRAIN) { E.fused(acc, cur, wr, wc, fr, fq, lds, wid, lane); S.done(cur); }
#undef PG8_SA
#undef PG8_SB
#undef PG8_STAGE
#undef PG8_LDA
#undef PG8_LDB
#undef PG8_MMA
#undef PG8_WAIT_V
#undef PG8_WAIT_L
#undef PG8_BAR
#undef PG8_SCHED
}
}
#define GAS __attribute__((address_space(1)))
#define LAS __attribute__((address_space(3)))
typedef unsigned short bf16;
typedef unsigned v4u __attribute__((ext_vector_type(4)));
typedef float f32x4 __attribute__((ext_vector_type(4)));
typedef short bf16x8 __attribute__((ext_vector_type(8)));
typedef GAS unsigned gu32;
typedef GAS unsigned long long gu64;
#define RLX_AGENT __ATOMIC_RELAXED, __HIP_MEMORY_SCOPE_AGENT
#define LDS_WAIT() asm volatile("s_waitcnt lgkmcnt(0)" ::: "memory")
#define VM_WAIT() asm volatile("s_waitcnt vmcnt(0)" ::: "memory")
__device__ __forceinline__ unsigned long long rt() { return __builtin_amdgcn_s_memrealtime(); }
__device__ __forceinline__ unsigned f2bf(float f) { unsigned u = __builtin_bit_cast(unsigned, f); return (u + 0x7fffu + ((u >> 16) & 1u)) >> 16; }
__device__ __forceinline__ unsigned pk2(float lo, float hi) { return f2bf(lo) | (f2bf(hi) << 16); }
#define XB_TMO      128
#define XB_XCNT(j)  (256  + 64 * (j))
#define XB_XSUB(j)  (1280 + 64 * (j))
#define XB_XGEN(j)  (2304 + 64 * (j))
#define XB_TOP      3328
#define XB_TOPGEN   3392
#define XCD_BAR_WORDS 3456
#define XB_SPIN_CAP (1u << 18)

__device__ __forceinline__ unsigned xb_ld(unsigned* p)              { return __hip_atomic_load(p, __ATOMIC_RELAXED, __HIP_MEMORY_SCOPE_AGENT); }
__device__ __forceinline__ unsigned xb_add(unsigned* p, unsigned v) { return __hip_atomic_fetch_add(p, v, __ATOMIC_RELAXED, __HIP_MEMORY_SCOPE_AGENT); }
__device__ __forceinline__ unsigned xb_xcc_id() { return (unsigned)__builtin_amdgcn_s_getreg((3 << 11) | 20) & 0xFu; }
#define XB_SPIN(cond, bar) do { unsigned _sp = 0; while (cond) { __builtin_amdgcn_s_sleep(1); \
    if ((++_sp & 255u) == 0u) { if (xb_ld(&(bar)[XB_TMO])) break; if (_sp > XB_SPIN_CAP) { atomicAdd(&(bar)[XB_TMO], 1u); break; } } } } while (0)

struct XcdBarrier {
    unsigned* bar; unsigned x;
    volatile LAS unsigned* st;
};

__device__ __forceinline__ XcdBarrier xcd_barrier_post(unsigned* bar, volatile LAS unsigned* st) {
    XcdBarrier b; b.bar = bar; b.x = xb_xcc_id(); b.st = st;
    if (threadIdx.x == 0) (void)xb_add(&bar[XB_XCNT(b.x)], 1u);
    return b;
}
__device__ __forceinline__ void xcd_barrier_complete(unsigned* bar, unsigned x, unsigned& nloc, unsigned& nx) {
    const unsigned G = gridDim.x * gridDim.y * gridDim.z;
    unsigned sum, cnt, mine, sp = 0u;
    for (;;) {
        sum = 0u; cnt = 0u; mine = 0u;
#pragma unroll
        for (unsigned j = 0; j < 16; ++j) { const unsigned c = xb_ld(&bar[XB_XCNT(j)]); sum += c; cnt += (c > 0u) ? 1u : 0u; mine = (j == x) ? c : mine; }
        if (sum == G) break;
        __builtin_amdgcn_s_sleep(1);
        if ((++sp & 255u) == 0u) { if (xb_ld(&bar[XB_TMO])) break; if (sp > XB_SPIN_CAP) { atomicAdd(&bar[XB_TMO], 1u); break; } }
    }
    nloc = mine > 0u ? mine : 1u; nx = cnt > 0u ? cnt : 1u;
}

__device__ __forceinline__ void xcd_barrier(const XcdBarrier& b) {
    asm volatile("s_waitcnt vmcnt(0)" ::: "memory");
    __syncthreads();
    if (threadIdx.x == 0) {
        unsigned* bar = b.bar;
        __builtin_amdgcn_s_waitcnt(0);
        unsigned nloc = b.st[0], nx = b.st[1];
        if (nloc == 0u) { xcd_barrier_complete(bar, b.x, nloc, nx); b.st[0] = nloc; b.st[1] = nx; }
        const unsigned old = xb_add(&bar[XB_XSUB(b.x)], 1u);
        const unsigned gen = old / nloc;
        if (old + 1u == (gen + 1u) * nloc) {
            __builtin_amdgcn_fence(__ATOMIC_RELEASE, "agent");
            asm volatile("s_waitcnt vmcnt(0)" ::: "memory");
            const unsigned og = xb_add(&bar[XB_TOP], 1u);
            const unsigned tg = og / nx;
            if (og + 1u == (tg + 1u) * nx) xb_add(&bar[XB_TOPGEN], 1u);
            else XB_SPIN(xb_ld(&bar[XB_TOPGEN]) == tg, bar);
            __builtin_amdgcn_fence(__ATOMIC_ACQUIRE, "agent");
            xb_add(&bar[XB_XGEN(b.x)], 1u);
            asm volatile("s_waitcnt vmcnt(0)" ::: "memory");
        } else {
            XB_SPIN(xb_ld(&bar[XB_XGEN(b.x)]) == gen, bar);
            __builtin_amdgcn_fence(__ATOMIC_ACQUIRE, "agent");
            asm volatile("s_waitcnt vmcnt(0)" ::: "memory");
        }
    }
    __syncthreads();
}

constexpr int BATCH = 2, SEQ = 8192, DM = 1024, CTXL = 256;
constexpr int NTOK = BATCH * SEQ, NCTXR = BATCH * CTXL, NROW = NTOK + NCTXR, KVLEN = SEQ + CTXL;
constexpr int INC = 2304, NEXP = 32, TOPK = 4, GUW = 2048;
constexpr int NPAD_MAX = NTOK * TOPK + NEXP * 256;
constexpr float NORM_EPS = 1e-6f, LOG2E = 1.4426950408889634f, QSCALE = 0.125f * 1.4426950408889634f;
constexpr int NWAVES = 8;

constexpr size_t MiB = 1u << 20;
constexpr size_t WS_CTL = 0, CTL_ZERO_BYTES = 1 * MiB;
constexpr size_t WS_MODP = 1 * MiB;
constexpr size_t WS_MODV = 2 * MiB;
constexpr size_t WS_ROPE = 2 * MiB + 128 * 1024;
constexpr size_t WS_ROUTE = 3 * MiB;
constexpr size_t WS_WIN = 4 * MiB, WS_WOUT = 9 * MiB, WS_WGU = 12 * MiB, WS_WDN = 140 * MiB;
constexpr size_t WS_XN = 204 * MiB;
constexpr size_t WS_QA = 240 * MiB, WS_KA = 256 * MiB, WS_VA = 274 * MiB, WS_QB = 292 * MiB, WS_KB = 308 * MiB, WS_VB = 314 * MiB;
constexpr size_t WS_Y = 320 * MiB, WS_X1 = 352 * MiB, WS_XG = 416 * MiB, WS_H = 560 * MiB, WS_Y2 = 704 * MiB, WS_END = 848 * MiB;
constexpr int CW_TMO = 0, CW_CODE = 1, CW_BAR = 4096, CW_CNT = 8192;
constexpr int MODP_KC = 8;

constexpr int RING_OFF = 0, RING_BYTES = 131072;
constexpr int LDSCTL_OFF = RING_BYTES, MISC_OFF = LDSCTL_OFF + 320, XTRA_OFF = LDSCTL_OFF + 1024;
constexpr int LDS_BYTES = 147456;

__device__ const double ROPE_CS[32] = {
    0.54030230586813977, 0.8414709848078965, 0.84600911028170789, 0.53316843991402285, 0.95041528025518285, 0.31098359290718575, 0.98423023447009461, 0.17689218624615005,
    0.99500416527802582, 0.099833416646828155, 0.99841927779266448, 0.056204499214692491, 0.99950004166527784, 0.031617506402433708, 0.99984189028361437, 0.01778185687966613,
    0.99995000041666526, 0.0099998333341666645, 0.9999841886533658, 0.0056233836139601857, 0.99999500000416663, 0.0031622723897082477, 0.99999841886158658, 0.0017782784728035289,
    0.99999950000004167, 0.00099999983333334168, 0.99999984188612112, 0.00056234129555235944, 0.99999995000000041, 0.00031622776074637522, 0.99999998418861169, 0.00017782794006665674};

__device__ __forceinline__ unsigned cvtpk(float lo, float hi) { unsigned r; asm volatile("v_cvt_pk_bf16_f32 %0, %1, %2" : "=v"(r) : "v"(lo), "v"(hi)); return r; }
__device__ __forceinline__ float bflo(unsigned w) { return __uint_as_float(w << 16); }
__device__ __forceinline__ float bfhi(unsigned w) { return __uint_as_float(w & 0xffff0000u); }
__device__ __forceinline__ bf16 f2bf1(float f) { return (bf16)(cvtpk(f, 0.f) & 0xffffu); }
__device__ __forceinline__ void unpack8(const v4u v, float* f) { f[0] = bflo(v.x); f[1] = bfhi(v.x); f[2] = bflo(v.y); f[3] = bfhi(v.y); f[4] = bflo(v.z); f[5] = bfhi(v.z); f[6] = bflo(v.w); f[7] = bfhi(v.w); }
__device__ __forceinline__ float wave_sum(float v) {
#pragma unroll
    for (int o = 1; o < 64; o <<= 1) v += __shfl_xor(v, o);
    return v;
}

struct Frame {
    LAS unsigned char* lds;
    volatile LAS unsigned* MISC;
    gu32* ctl;
    int tid, lane, wave, vcu, G;
    const float *x, *c, *ctx, *c_ctx, *w_mod, *b_mod, *norm1_g, *w_in, *lq1, *lk1, *lq2, *lk2, *subln_g, *sink, *w_out, *norm2_g, *w_router, *b_router, *w_gu, *b_gu, *w_dn, *b_dn, *final_g;
    float* out;
    float *modp, *modv, *rope, *X1, *rgate;
    int *re, *rslot, *rpos;
    bf16 *Win_t, *Wout_t, *Wgu_t, *Wdn_t, *XN, *QA, *KA, *VA, *QB, *KB, *VB, *Y, *XG, *H, *Y2;
};

struct EpiQKV {
    bf16 *QA, *KA, *VA, *QB, *KB, *VB; const float* rope;
    struct Ctx { bf16* p; bool skip, rp, isq; const float* cs; };
    __device__ __forceinline__ Ctx prep(int row, int cg) const {
        Ctx c; const bool lat = row < NTOK; const int b = lat ? (row >> 13) : ((row - NTOK) >> 8);
        const int kvrow = lat ? (b * KVLEN + (row & (SEQ - 1))) : (b * KVLEN + SEQ + ((row - NTOK) & (CTXL - 1)));
        c.skip = false; c.rp = lat; c.isq = false;
        if (cg < 512)       { c.p = QA + (size_t)row * 512 + cg; c.isq = true; c.skip = !lat; }
        else if (cg < 1024) { c.p = KA + (size_t)kvrow * 512 + (cg - 512); }
        else if (cg < 1536) { c.p = VA + (size_t)kvrow * 512 + (cg - 1024); c.rp = false; }
        else if (cg < 2048) { c.p = QB + (size_t)row * 512 + (cg - 1536); c.isq = true; c.skip = !lat; }
        else if (cg < 2176) { c.p = KB + (size_t)kvrow * 128 + (cg - 2048); }
        else                { c.p = VB + (size_t)kvrow * 128 + (cg - 2176); c.rp = false; }
        const int t = row & (SEQ - 1); const int pos = ((cg >> 5) & 1) ? (t & 63) : (t >> 6);
        c.cs = rope + pos * 32;
        return c;
    }
    __device__ __forceinline__ void math(const Ctx& c, int i, float lo, float hi, float& olo, float& ohi) const {
        if (c.rp) { const float cs = c.cs[2 * i], sn = c.cs[2 * i + 1]; olo = lo * cs - hi * sn; ohi = hi * cs + lo * sn; } else { olo = lo; ohi = hi; }
        if (c.isq) { olo *= QSCALE; ohi *= QSCALE; }
    }
    __device__ __forceinline__ void one(int row, int cg, int i, float lo, float hi, int) const {
        const Ctx c = prep(row, cg); if (c.skip) return; float a, b; math(c, i, lo, hi, a, b); c.p[i] = f2bf1(a); c.p[16 + i] = f2bf1(b);
    }
    __device__ __forceinline__ void four(int row, int cg, int i0, const f32x4 lo, const f32x4 hi, int) const {
        const Ctx c = prep(row, cg); if (c.skip) return; float a[4], b[4];
#pragma unroll
        for (int i = 0; i < 4; ++i) math(c, i0 + i, lo[i], hi[i], a[i], b[i]);
        typedef unsigned u32x2 __attribute__((ext_vector_type(2)));
        *(u32x2*)(c.p + i0) = (u32x2){cvtpk(a[0], a[1]), cvtpk(a[2], a[3])}; *(u32x2*)(c.p + 16 + i0) = (u32x2){cvtpk(b[0], b[1]), cvtpk(b[2], b[3])};
    }
};
struct EpiOut {
    const float* x; const float* modv; float* X1;
    __device__ __forceinline__ void one(int row, int cg, int i, float lo, float hi, int) const {
        const float* g1 = modv + (row >> 13) * 6144 + 2048; const size_t o = (size_t)row * DM + cg + i;
        X1[o] = x[o] + g1[cg + i] * lo; X1[o + 16] = x[o + 16] + g1[cg + 16 + i] * hi;
    }
    __device__ __forceinline__ void four(int row, int cg, int i0, const f32x4 lo, const f32x4 hi, int) const {
        const float* g1 = modv + (row >> 13) * 6144 + 2048 + cg + i0; const size_t o = (size_t)row * DM + cg + i0;
        *(f32x4*)(X1 + o) = *(const f32x4*)(x + o) + *(const f32x4*)(g1) * lo; *(f32x4*)(X1 + o + 16) = *(const f32x4*)(x + o + 16) + *(const f32x4*)(g1 + 16) * hi;
    }
};
__device__ __forceinline__ float swiglu(float g, float lin) {
    g = fminf(g, 7.0f); lin = fminf(fmaxf(lin, -7.0f), 7.0f);
    return g * __builtin_amdgcn_rcpf(1.0f + __builtin_amdgcn_exp2f(-1.702f * LOG2E * g)) * (lin + 1.0f);
}
struct EpiGU {
    bf16* H; const float* b_gu;
    __device__ __forceinline__ void one(int row, int cg, int i, float lo, float hi, int e) const {
        const int f = (cg >> 1) + i; const float* bb = b_gu + e * GUW + 2 * f; H[(size_t)row * DM + f] = f2bf1(swiglu(lo + bb[0], hi + bb[1]));
    }
    __device__ __forceinline__ void four(int row, int cg, int i0, const f32x4 lo, const f32x4 hi, int e) const {
        const int f = (cg >> 1) + i0; const float* bb = b_gu + e * GUW + 2 * f; const f32x4 b0 = *(const f32x4*)bb, b1 = *(const f32x4*)(bb + 4);
        const float a0 = swiglu(lo[0] + b0[0], hi[0] + b0[1]), a1 = swiglu(lo[1] + b0[2], hi[1] + b0[3]), a2 = swiglu(lo[2] + b1[0], hi[2] + b1[1]), a3 = swiglu(lo[3] + b1[2], hi[3] + b1[3]);
        typedef unsigned u32x2 __attribute__((ext_vector_type(2)));
        *(u32x2*)(H + (size_t)row * DM + f) = (u32x2){cvtpk(a0, a1), cvtpk(a2, a3)};
    }
};
struct EpiDN {
    bf16* Y2; const float* b_dn;
    __device__ __forceinline__ void one(int row, int cg, int i, float lo, float hi, int e) const {
        const float* bb = b_dn + e * DM + cg + i; bf16* p = Y2 + (size_t)row * DM + cg + i; p[0] = f2bf1(lo + bb[0]); p[16] = f2bf1(hi + bb[16]);
    }
    __device__ __forceinline__ void four(int row, int cg, int i0, const f32x4 lo, const f32x4 hi, int e) const {
        const float* bb = b_dn + e * DM + cg + i0; const f32x4 b0 = *(const f32x4*)bb, b1 = *(const f32x4*)(bb + 16); bf16* p = Y2 + (size_t)row * DM + cg + i0;
        typedef unsigned u32x2 __attribute__((ext_vector_type(2)));
        *(u32x2*)p = (u32x2){cvtpk(lo[0] + b0[0], lo[1] + b0[1]), cvtpk(lo[2] + b0[2], lo[3] + b0[3])}; *(u32x2*)(p + 16) = (u32x2){cvtpk(hi[0] + b1[0], hi[1] + b1[1]), cvtpk(hi[2] + b1[2], hi[3] + b1[3])};
    }
};
template <class E, int NN> struct EpiAdapt {
    static constexpr bool PERM = false, AFTER_DRAIN = false;
    E e;
    __device__ __forceinline__ void operator()(const pg8::f32x4 (&acc)[2][2][4][2], const pg8::Unit& u, int wr, int wc, int fr, int fq) const {
        int ex = 0, pn = u.pn; if (NN) { ex = pn / NN; pn = pn - ex * NN; }
#pragma unroll
        for (int ai = 0; ai < 2; ++ai)
#pragma unroll
            for (int m = 0; m < 4; ++m) { const int row = u.pm * 256 + ai * 128 + wr * 64 + m * 16 + fr;
#pragma unroll
                for (int bj = 0; bj < 2; ++bj) e.four(row, pn * 256 + bj * 128 + wc * 32, 4 * fq, acc[ai][bj][m][0], acc[ai][bj][m][1], ex); }
    }
};
struct GroupedOrder {
    int nN, NP, G, c; const LAS int* pexp;
    __device__ __forceinline__ bool next(int i, pg8::Unit& u) const {
        int p, j;
        if (G == 256) { const int x = c & 7, r = c >> 3, ppx = 32 / nN; p = i * (8 * ppx) + x * ppx + r / nN; j = r % nN; }
        else { const long L = (long)i * G + c; p = (int)(L / nN); j = (int)(L % nN); }
        if (p >= NP) return false;
        u.pm = p; u.pn = pexp[p] * nN + j; return true;
    }
    __device__ __forceinline__ void a_ready(const pg8::Unit&) const {}
    __device__ __forceinline__ void done(const pg8::Unit&) const {}
};

struct DenseSel { const bf16* Bt; __device__ __forceinline__ const bf16* operator()(int, int& e) const { e = 0; return Bt; } };
struct GroupSel { const bf16* Bt; const LAS int* pexp; int N, K; __device__ __forceinline__ const bf16* operator()(int mt, int& e) const { e = pexp[mt >> 1]; return Bt + (size_t)e * N * K; } };
template <class Epi, class BSel>
__device__ __forceinline__ void naive_gemm(Frame& F, const bf16* A, int Mtiles, int N, int K, const BSel& bs, const Epi& E) {
    LAS float* As = (LAS float*)(F.lds + RING_OFF); LAS float* Bs = As + 128 * 33;
    const int nNt = N / 64, tx = F.tid & 15, ty = F.tid >> 4;
    for (int t = blockIdx.x; t < Mtiles * nNt; t += F.G) {
        const int mt = t / nNt, nt = t % nNt; int e; const bf16* Bt = bs(mt, e);
        float acc[4][4];
#pragma unroll
        for (int r = 0; r < 4; ++r)
#pragma unroll
            for (int j = 0; j < 4; ++j) acc[r][j] = 0.f;
        for (int k0 = 0; k0 < K; k0 += 32) {
            { const int r = F.tid >> 2, kc = (F.tid & 3) * 8; float f[8]; unpack8(*(const v4u*)(A + (size_t)(mt * 128 + r) * K + k0 + kc), f);
#pragma unroll
              for (int i = 0; i < 8; ++i) As[r * 33 + kc + i] = f[i]; }
            if (F.tid < 256) { const int r = F.tid >> 2, kc = (F.tid & 3) * 8; float f[8]; unpack8(*(const v4u*)(Bt + (size_t)(nt * 64 + r) * K + k0 + kc), f);
#pragma unroll
              for (int i = 0; i < 8; ++i) Bs[r * 33 + kc + i] = f[i]; }
            __syncthreads();
#pragma unroll 8
            for (int kk = 0; kk < 32; ++kk) { float a[4], b[4];
#pragma unroll
                for (int r = 0; r < 4; ++r) a[r] = As[(ty * 4 + r) * 33 + kk];
#pragma unroll
                for (int j = 0; j < 4; ++j) b[j] = Bs[(tx + 16 * j) * 33 + kk];
#pragma unroll
                for (int r = 0; r < 4; ++r)
#pragma unroll
                    for (int j = 0; j < 4; ++j) acc[r][j] += a[r] * b[j]; }
            __syncthreads();
        }
#pragma unroll
        for (int r = 0; r < 4; ++r) { const int row = mt * 128 + ty * 4 + r; E.one(row, nt * 64, tx, acc[r][0], acc[r][1], e); E.one(row, nt * 64 + 32, tx, acc[r][2], acc[r][3], e); }
    }
}

template <bool GUPERM>
__device__ __forceinline__ void p0_transpose_item(const float* W, int K, int N, bf16* WT, LAS float* scr, int item, int lane) {
    const int nblk = N / 32, kb = item / nblk, nb = item % nblk, k0 = 64 * kb, n0 = 32 * nb;
#pragma unroll 8
    for (int i = 0; i < 32; ++i) { const int kk = 2 * i + (lane >> 5); scr[kk * 33 + (lane & 31)] = W[(size_t)(k0 + kk) * N + n0 + (lane & 31)]; }
    LDS_WAIT(); asm volatile("" ::: "memory");
    const int c = lane & 7;
#pragma unroll
    for (int j = 0; j < 4; ++j) { const int n = (lane >> 3) + 8 * j; const LAS float* s = scr + (8 * c) * 33 + n;
        v4u o; o.x = cvtpk(s[0 * 33], s[1 * 33]); o.y = cvtpk(s[2 * 33], s[3 * 33]); o.z = cvtpk(s[4 * 33], s[5 * 33]); o.w = cvtpk(s[6 * 33], s[7 * 33]);
        const int nd = GUPERM ? ((n & 1) * 16 + (n >> 1)) : n;
        *(GAS v4u*)(WT + (size_t)(n0 + nd) * K + k0 + 8 * c) = o; }
    LDS_WAIT(); asm volatile("" ::: "memory");
}
__device__ __forceinline__ void p0_prologue(Frame& F) {
    LAS float* sil = (LAS float*)(F.lds + XTRA_OFF);
    for (int i = F.tid; i < 3072; i += 512) { const int v = i >> 10, k = i & 1023; const float cv = (v < 2) ? F.c[v * 1024 + k] : F.c_ctx[k]; sil[i] = cv / (1.f + __expf(-cv)); }
    __syncthreads();
    const int gw = F.vcu * NWAVES + F.wave, NGW = F.G * NWAVES;
    for (int it = gw; it < 24 * MODP_KC; it += NGW) {
        const int nb = it % 24, kc = it / 24, n = nb * 256 + F.lane * 4;
        f32x4 a0 = {0.f, 0.f, 0.f, 0.f}, a1 = a0, a2 = a0;
        const float* wp = F.w_mod + (size_t)(kc * 128) * 6144 + n;
#pragma unroll 8
        for (int kk = 0; kk < 128; ++kk) { const f32x4 w = *(const f32x4*)(wp + (size_t)kk * 6144); const int k = kc * 128 + kk; a0 += w * sil[k]; a1 += w * sil[1024 + k]; a2 += w * sil[2048 + k]; }
        float* pp = F.modp + (size_t)kc * 3 * 6144 + n;
        *(f32x4*)(pp) = a0; *(f32x4*)(pp + 6144) = a1; *(f32x4*)(pp + 12288) = a2;
    }
    if (blockIdx.x == 0) for (int i = F.tid; i < 2048; i += 512) { const int pos = i >> 4, j = i & 15; double cr = 1.0, sr = 0.0, cb = ROPE_CS[2 * j], sb = ROPE_CS[2 * j + 1];
        for (int bit = 0; bit < 7; ++bit) { if ((pos >> bit) & 1) { const double t = cr * cb - sr * sb; sr = cr * sb + sr * cb; cr = t; } const double t2 = cb * cb - sb * sb; sb = 2.0 * cb * sb; cb = t2; }
        F.rope[2 * i] = (float)cr; F.rope[2 * i + 1] = (float)sr; }
    LAS float* scr = (LAS float*)(F.lds + RING_OFF + F.wave * 16384);
    constexpr int I_IN = (DM / 64) * (INC / 32), I_OUT = (DM / 64) * (DM / 32), I_GU1 = (DM / 64) * (GUW / 32), I_DN1 = (DM / 64) * (DM / 32);
    constexpr int NITEMS = I_IN + I_OUT + NEXP * I_GU1 + NEXP * I_DN1;
    for (int it = gw; it < NITEMS; it += NGW) {
        int r = it;
        if (r < I_IN) { p0_transpose_item<false>(F.w_in, DM, INC, F.Win_t, scr, r, F.lane); continue; } r -= I_IN;
        if (r < I_OUT) { p0_transpose_item<false>(F.w_out, DM, DM, F.Wout_t, scr, r, F.lane); continue; } r -= I_OUT;
        if (r < NEXP * I_GU1) { const int e = r / I_GU1; p0_transpose_item<true>(F.w_gu + (size_t)e * DM * GUW, DM, GUW, F.Wgu_t + (size_t)e * GUW * DM, scr, r % I_GU1, F.lane); continue; } r -= NEXP * I_GU1;
        { const int e = r / I_DN1; p0_transpose_item<false>(F.w_dn + (size_t)e * DM * DM, DM, DM, F.Wdn_t + (size_t)e * DM * DM, scr, r % I_DN1, F.lane); }
    }
}

__device__ __forceinline__ void p1_norm(Frame& F) {
    LAS float* ml = (LAS float*)(F.lds + RING_OFF);
    for (int i = F.tid; i < 6144; i += 512) { const int v = i / 2048, j = i % 2048; float s = F.b_mod[j];
        for (int kc = 0; kc < MODP_KC; ++kc) s += F.modp[(size_t)(kc * 3 + v) * 6144 + j]; ml[i] = s; }
    for (int gi = blockIdx.x * 512 + F.tid; gi < 3 * 6144; gi += F.G * 512) { const int v = gi / 6144, j = gi % 6144; float s = F.b_mod[j];
        for (int kc = 0; kc < MODP_KC; ++kc) s += F.modp[(size_t)(kc * 3 + v) * 6144 + j]; F.modv[gi] = s; }
    __syncthreads();
    const int gw = F.vcu * NWAVES + F.wave, NGW = F.G * NWAVES;
    for (int m = gw; m < NROW; m += NGW) {
        const int v = m < SEQ ? 0 : (m < NTOK ? 1 : 2);
        const float* src = m < NTOK ? F.x + (size_t)m * DM : F.ctx + (size_t)(m - NTOK) * DM;
        f32x4 xv[4]; float s = 0.f;
#pragma unroll
        for (int j = 0; j < 4; ++j) { xv[j] = *(const f32x4*)(src + 4 * F.lane + 256 * j); s += (xv[j].x * xv[j].x + xv[j].y * xv[j].y) + (xv[j].z * xv[j].z + xv[j].w * xv[j].w); }
        const float rstd = 1.0f / sqrtf(wave_sum(s) * (1.f / DM) + NORM_EPS);
        typedef unsigned u32x2 __attribute__((ext_vector_type(2)));
#pragma unroll
        for (int j = 0; j < 4; ++j) { const int col = 4 * F.lane + 256 * j; const f32x4 g = *(const f32x4*)(F.norm1_g + col);
            const f32x4 sh = *(const LAS f32x4*)(ml + v * 2048 + col), sc = *(const LAS f32x4*)(ml + v * 2048 + 1024 + col);
            const f32x4 y = (xv[j] * rstd * g) * (sc + 1.0f) + sh;
            *(u32x2*)(F.XN + (size_t)m * DM + col) = (u32x2){cvtpk(y.x, y.y), cvtpk(y.z, y.w)}; }
    }
}

__device__ __forceinline__ float lam_value(Frame& F) {
    const float a = wave_sum(F.lq1[F.lane] * F.lk1[F.lane]), b = wave_sum(F.lq2[F.lane] * F.lk2[F.lane]);
    return __expf(a) - __expf(b) + 0.2f;
}
__device__ __forceinline__ void naive_diff_attn(Frame& F) {
    const float lam = lam_value(F);
    LAS float* X = (LAS float*)(F.lds + RING_OFF);
    LAS float* SS = X + 128 * 128;
    const int q = F.tid & 127, comp = (F.tid >> 7) & 1, vh = F.tid >> 8;
    for (int it = blockIdx.x; it < BATCH * 4 * (SEQ / 128); it += F.G) {
        const int b = it >> 8, h = (it >> 6) & 3, qb = it & 63; const int row = b * SEQ + qb * 128 + q;
        float qv[64], o[64];
#pragma unroll
        for (int c8 = 0; c8 < 8; ++c8) unpack8(*(const v4u*)(F.QA + (size_t)row * 512 + h * 128 + comp * 64 + c8 * 8), qv + 8 * c8);
#pragma unroll
        for (int e = 0; e < 64; ++e) o[e] = 0.f;
        float m = -1e30f, l = 0.f;
        const bf16* kp = F.KA + (size_t)(b * KVLEN) * 512 + h * 128 + comp * 64; const bf16* vp = F.VA + (size_t)(b * KVLEN) * 512 + h * 128 + vh * 64;
        for (int key = 0; key < KVLEN; ++key) {
            float s = 0.f;
#pragma unroll
            for (int c8 = 0; c8 < 8; ++c8) { float kf[8]; unpack8(*(const v4u*)(kp + (size_t)key * 512 + c8 * 8), kf);
#pragma unroll
                for (int i = 0; i < 8; ++i) s += qv[8 * c8 + i] * kf[i]; }
            if (s > m) { const float a = exp2f(m - s); l *= a;
#pragma unroll
                for (int e = 0; e < 64; ++e) o[e] *= a;
                m = s; }
            const float p = exp2f(s - m); l += p;
#pragma unroll
            for (int c8 = 0; c8 < 8; ++c8) { float vf[8]; unpack8(*(const v4u*)(vp + (size_t)key * 512 + c8 * 8), vf);
#pragma unroll
                for (int i = 0; i < 8; ++i) o[8 * c8 + i] += p * vf[i]; }
        }
        const float inv = 1.0f / l;
        __syncthreads();
        if (comp == 1) {
#pragma unroll
            for (int e = 0; e < 64; ++e) X[(vh * 64 + e) * 128 + q] = lam * o[e] * inv; }
        __syncthreads();
        if (comp == 0) { float ss = 0.f;
#pragma unroll
            for (int e = 0; e < 64; ++e) { o[e] = o[e] * inv - X[(vh * 64 + e) * 128 + q]; ss += o[e] * o[e]; }
            SS[vh * 128 + q] = ss; }
        __syncthreads();
        if (comp == 0) { const float r = 0.8f / sqrtf((SS[q] + SS[128 + q]) * (1.f / 128.f) + NORM_EPS);
            bf16* yp = F.Y + (size_t)row * DM + h * 128 + vh * 64; const float* sg = F.subln_g + vh * 64;
#pragma unroll
            for (int c8 = 0; c8 < 8; ++c8) { v4u w; w.x = cvtpk(o[8 * c8] * r * sg[8 * c8], o[8 * c8 + 1] * r * sg[8 * c8 + 1]); w.y = cvtpk(o[8 * c8 + 2] * r * sg[8 * c8 + 2], o[8 * c8 + 3] * r * sg[8 * c8 + 3]);
                w.z = cvtpk(o[8 * c8 + 4] * r * sg[8 * c8 + 4], o[8 * c8 + 5] * r * sg[8 * c8 + 5]); w.w = cvtpk(o[8 * c8 + 6] * r * sg[8 * c8 + 6], o[8 * c8 + 7] * r * sg[8 * c8 + 7]);
                *(v4u*)(yp + 8 * c8) = w; } }
    }
}
__device__ __forceinline__ void naive_win_attn(Frame& F) {
    for (int it = blockIdx.x; it < BATCH * 8 * (SEQ / 512); it += F.G) {
        const int b = it >> 7, h = (it >> 4) & 7, t = (it & 15) * 512 + F.tid, kv = h >> 2; const int row = b * SEQ + t;
        float qv[64], o[64];
#pragma unroll
        for (int c8 = 0; c8 < 8; ++c8) unpack8(*(const v4u*)(F.QB + (size_t)row * 512 + h * 64 + c8 * 8), qv + 8 * c8);
#pragma unroll
        for (int e = 0; e < 64; ++e) o[e] = 0.f;
        float m = F.sink[h] * LOG2E, l = 1.0f;
        const bf16* kp = F.KB + (size_t)(b * KVLEN) * 128 + kv * 64; const bf16* vp = F.VB + (size_t)(b * KVLEN) * 128 + kv * 64;
        for (int jj = 0; jj < 257 + CTXL; ++jj) {
            const int key = jj < 257 ? t - 128 + jj : SEQ + (jj - 257);
            if (jj < 257 && (key < 0 || key >= SEQ)) continue;
            float s = 0.f;
#pragma unroll
            for (int c8 = 0; c8 < 8; ++c8) { float kf[8]; unpack8(*(const v4u*)(kp + (size_t)key * 128 + c8 * 8), kf);
#pragma unroll
                for (int i = 0; i < 8; ++i) s += qv[8 * c8 + i] * kf[i]; }
            if (s > m) { const float a = exp2f(m - s); l *= a;
#pragma unroll
                for (int e = 0; e < 64; ++e) o[e] *= a;
                m = s; }
            const float p = exp2f(s - m); l += p;
#pragma unroll
            for (int c8 = 0; c8 < 8; ++c8) { float vf[8]; unpack8(*(const v4u*)(vp + (size_t)key * 128 + c8 * 8), vf);
#pragma unroll
                for (int i = 0; i < 8; ++i) o[8 * c8 + i] += p * vf[i]; }
        }
        const float inv = 1.0f / l; bf16* yp = F.Y + (size_t)row * DM + 512 + h * 64;
#pragma unroll
        for (int c8 = 0; c8 < 8; ++c8) { v4u w; w.x = cvtpk(o[8 * c8] * inv, o[8 * c8 + 1] * inv); w.y = cvtpk(o[8 * c8 + 2] * inv, o[8 * c8 + 3] * inv); w.z = cvtpk(o[8 * c8 + 4] * inv, o[8 * c8 + 5] * inv); w.w = cvtpk(o[8 * c8 + 6] * inv, o[8 * c8 + 7] * inv);
            *(v4u*)(yp + 8 * c8) = w; }
    }
}

__device__ __forceinline__ unsigned long long wave_max64(unsigned long long k) {
#pragma unroll
    for (int o = 1; o < 64; o <<= 1) { const unsigned lo = __shfl_xor((unsigned)k, o), hi = __shfl_xor((unsigned)(k >> 32), o); const unsigned long long t = ((unsigned long long)hi << 32) | lo; k = t > k ? t : k; }
    return k;
}
__device__ __forceinline__ void p5a_route(Frame& F) {
    LAS float* WRT = (LAS float*)(F.lds + RING_OFF);
    LAS int* lcnt = (LAS int*)(F.lds + XTRA_OFF); LAS int* lbase = lcnt + 32; LAS int* le = lcnt + 64; LAS int* lrk = le + 256;
    for (int idx = F.tid; idx < 32768; idx += 512) { const int k = idx >> 5, e = idx & 31; WRT[e * 1024 + k] = F.w_router[idx]; }
    gu32* gcnt = F.ctl + CW_CNT;
    typedef unsigned u32x2 __attribute__((ext_vector_type(2)));
    for (int chunk = blockIdx.x; chunk < NTOK / 64; chunk += F.G) {
        if (F.tid < 32) lcnt[F.tid] = 0;
        __syncthreads();
        const int b = (chunk * 64) >> 13; const float* mv = F.modv + b * 6144;
#pragma unroll 1
        for (int grp = 0; grp < 2; ++grp) {
            const int row0 = chunk * 64 + F.wave * 8 + grp * 4;
            f32x4 xv[4][4]; float ss[4];
#pragma unroll
            for (int r = 0; r < 4; ++r) { float s = 0.f;
#pragma unroll
                for (int j = 0; j < 4; ++j) { xv[r][j] = *(const f32x4*)(F.X1 + (size_t)(row0 + r) * DM + 4 * F.lane + 256 * j); s += (xv[r][j].x * xv[r][j].x + xv[r][j].y * xv[r][j].y) + (xv[r][j].z * xv[r][j].z + xv[r][j].w * xv[r][j].w); }
                ss[r] = 1.0f / sqrtf(wave_sum(s) * (1.f / DM) + NORM_EPS); }
#pragma unroll
            for (int j = 0; j < 4; ++j) { const int col = 4 * F.lane + 256 * j; const f32x4 g = *(const f32x4*)(F.norm2_g + col), sh = *(const f32x4*)(mv + 3072 + col), sc = *(const f32x4*)(mv + 4096 + col);
                const f32x4 ga = g * (sc + 1.0f);
#pragma unroll
                for (int r = 0; r < 4; ++r) { xv[r][j] = (xv[r][j] * ss[r]) * ga + sh;
                    *(u32x2*)(F.XN + (size_t)(row0 + r) * DM + col) = (u32x2){cvtpk(xv[r][j].x, xv[r][j].y), cvtpk(xv[r][j].z, xv[r][j].w)}; } }
            float logit[4] = {0.f, 0.f, 0.f, 0.f};
            const bool up = (F.lane & 32) != 0, up2 = (F.lane & 16) != 0; const int myg = (F.lane >> 1) & 7;
#pragma unroll 1
            for (int g = 0; g < 8; ++g) {
                float a[4][4];
#pragma unroll
                for (int r = 0; r < 4; ++r)
#pragma unroll
                    for (int ee = 0; ee < 4; ++ee) a[r][ee] = 0.f;
                const LAS float* wb = WRT + g * 4096 + 4 * F.lane;
#pragma unroll
                for (int ee = 0; ee < 4; ++ee)
#pragma unroll
                    for (int j = 0; j < 4; ++j) { const f32x4 w = *(const LAS f32x4*)(wb + ee * 1024 + 256 * j);
#pragma unroll
                        for (int r = 0; r < 4; ++r) a[r][ee] += (xv[r][j].x * w.x + xv[r][j].y * w.y) + (xv[r][j].z * w.z + xv[r][j].w * w.w); }
#pragma unroll
                for (int r = 0; r < 4; ++r) {
                    const float v0 = (up ? a[r][2] : a[r][0]) + __shfl_xor(up ? a[r][0] : a[r][2], 32);
                    const float v1 = (up ? a[r][3] : a[r][1]) + __shfl_xor(up ? a[r][1] : a[r][3], 32);
                    float v = (up2 ? v1 : v0) + __shfl_xor(up2 ? v0 : v1, 16);
                    v += __shfl_xor(v, 1); v += __shfl_xor(v, 2); v += __shfl_xor(v, 4); v += __shfl_xor(v, 8);
                    if (myg == g) logit[r] = v;
                }
            }
            const int e = 4 * myg + (up ? 2 : 0) + (up2 ? 1 : 0);
            const float br = F.b_router[e];
#pragma unroll
            for (int r = 0; r < 4; ++r) {
                unsigned u = __float_as_uint(logit[r] + br); u = (u & 0x80000000u) ? ~u : (u | 0x80000000u);
                unsigned long long key = ((unsigned long long)u << 32) | (unsigned)(31 - e);
                int ek[4]; float vk[4];
#pragma unroll
                for (int k = 0; k < 4; ++k) { const unsigned long long mx = wave_max64(key); ek[k] = 31 - (int)(mx & 31u); unsigned uu = (unsigned)(mx >> 32); uu = (uu & 0x80000000u) ? (uu & 0x7fffffffu) : ~uu; vk[k] = __uint_as_float(uu);
                    if (e == ek[k]) key = 0ull; }
                const float p1 = __expf(vk[1] - vk[0]), p2 = __expf(vk[2] - vk[0]), p3 = __expf(vk[3] - vk[0]); const float inv = 1.0f / (1.0f + p1 + p2 + p3);
                if (F.lane < 4) { const int k = F.lane; const int ee = k == 0 ? ek[0] : (k == 1 ? ek[1] : (k == 2 ? ek[2] : ek[3])); const float gg = (k == 0 ? 1.0f : (k == 1 ? p1 : (k == 2 ? p2 : p3))) * inv;
                    const int rl = F.wave * 8 + grp * 4 + r; const int rank = __hip_atomic_fetch_add(lcnt + ee, 1, __ATOMIC_RELAXED, __HIP_MEMORY_SCOPE_WORKGROUP);
                    le[rl * 4 + k] = ee; lrk[rl * 4 + k] = rank; F.rgate[(size_t)(row0 + r) * 4 + k] = gg; }
            }
        }
        __syncthreads();
        if (F.tid < 32) lbase[F.tid] = (int)__hip_atomic_fetch_add(gcnt + F.tid, (unsigned)lcnt[F.tid], __ATOMIC_RELAXED, __HIP_MEMORY_SCOPE_AGENT);
        __syncthreads();
        if (F.tid < 256) { const int row = chunk * 64 + (F.tid >> 2), k = F.tid & 3; const int ee = le[F.tid]; F.re[(size_t)row * 4 + k] = ee; F.rslot[(size_t)row * 4 + k] = lbase[ee] + lrk[F.tid]; }
        __syncthreads();
    }
}
__device__ __forceinline__ int expert_tables(Frame& F, LAS int* pst, LAS int* pexp) {
    LAS int* npan = pst + 40;
    if (F.tid == 0) { int P = 0; for (int e = 0; e < NEXP; ++e) { const int cnt = (int)__hip_atomic_load(F.ctl + CW_CNT + e, __ATOMIC_RELAXED, __HIP_MEMORY_SCOPE_AGENT); pst[e] = P * 256; const int np = (cnt + 255) >> 8; for (int i = 0; i < np; ++i) pexp[P + i] = e; P += np; } pst[32] = P * 256; npan[0] = P; }
    __syncthreads();
    return npan[0];
}
__device__ __forceinline__ void p5b_scatter(Frame& F) {
    LAS int* pst = (LAS int*)(F.lds + XTRA_OFF); LAS int* pexp = pst + 64;
    (void)expert_tables(F, pst, pexp);
    const int gw = F.vcu * NWAVES + F.wave, NGW = F.G * NWAVES;
    for (int row = gw; row < NTOK; row += NGW) {
        const v4u a = *(const v4u*)(F.XN + (size_t)row * DM + 8 * F.lane), b = *(const v4u*)(F.XN + (size_t)row * DM + 512 + 8 * F.lane);
#pragma unroll
        for (int k = 0; k < 4; ++k) { const int e = F.re[(size_t)row * 4 + k]; const int pos = pst[e] + F.rslot[(size_t)row * 4 + k];
            if (F.lane == 0) F.rpos[(size_t)row * 4 + k] = pos;
            *(v4u*)(F.XG + (size_t)pos * DM + 8 * F.lane) = a; *(v4u*)(F.XG + (size_t)pos * DM + 512 + 8 * F.lane) = b; }
    }
}
__device__ __forceinline__ void p8_final(Frame& F) {
    const int gw = F.vcu * NWAVES + F.wave, NGW = F.G * NWAVES;
    typedef unsigned u32x2 __attribute__((ext_vector_type(2)));
    for (int row = gw; row < NTOK; row += NGW) {
        const float* g2 = F.modv + (row >> 13) * 6144 + 5120;
        int pos[4]; float gt[4];
#pragma unroll
        for (int k = 0; k < 4; ++k) { pos[k] = F.rpos[(size_t)row * 4 + k]; gt[k] = F.rgate[(size_t)row * 4 + k]; }
        f32x4 xv[4]; float s = 0.f;
#pragma unroll
        for (int j = 0; j < 4; ++j) { const int col = 4 * F.lane + 256 * j; f32x4 a = {0.f, 0.f, 0.f, 0.f};
#pragma unroll
            for (int k = 0; k < 4; ++k) { const u32x2 y = *(const u32x2*)(F.Y2 + (size_t)pos[k] * DM + col); a += (f32x4){bflo(y.x), bfhi(y.x), bflo(y.y), bfhi(y.y)} * gt[k]; }
            xv[j] = *(const f32x4*)(F.X1 + (size_t)row * DM + col) + *(const f32x4*)(g2 + col) * a;
            s += (xv[j].x * xv[j].x + xv[j].y * xv[j].y) + (xv[j].z * xv[j].z + xv[j].w * xv[j].w); }
        const float rstd = 1.0f / sqrtf(wave_sum(s) * (1.f / DM) + NORM_EPS);
#pragma unroll
        for (int j = 0; j < 4; ++j) { const int col = 4 * F.lane + 256 * j; *(f32x4*)(F.out + (size_t)row * DM + col) = xv[j] * rstd * *(const f32x4*)(F.final_g + col); }
    }
}

#ifndef FAST_GEMM
#define FAST_GEMM 1
#endif
#ifndef FAST_ATTN
#define FAST_ATTN 0
#endif
constexpr int N_PHASES = 10;
struct Args { const float* in[23]; float* out; unsigned char* ws; int ph_lo, ph_hi, use_bar, pad; };
__global__ void __launch_bounds__(NWAVES * 64, 2) mk_fwd(Args args) {
    extern __shared__ __attribute__((aligned(16))) unsigned char lds[];
    Frame F;
    F.lds = (LAS unsigned char*)lds; F.MISC = (volatile LAS unsigned*)(F.lds + MISC_OFF);
    F.tid = threadIdx.x; F.lane = F.tid & 63; F.wave = __builtin_amdgcn_readfirstlane(F.tid >> 6);
    F.G = gridDim.x; { const int bx = blockIdx.x; F.vcu = (F.G % 8 == 0) ? (bx % 8) * (F.G / 8) + bx / 8 : bx; }
    unsigned char* ws = args.ws;
    F.ctl = (gu32*)(ws + WS_CTL);
    F.x = args.in[0]; F.c = args.in[1]; F.ctx = args.in[2]; F.c_ctx = args.in[3]; F.w_mod = args.in[4]; F.b_mod = args.in[5]; F.norm1_g = args.in[6]; F.w_in = args.in[7];
    F.lq1 = args.in[8]; F.lk1 = args.in[9]; F.lq2 = args.in[10]; F.lk2 = args.in[11]; F.subln_g = args.in[12]; F.sink = args.in[13]; F.w_out = args.in[14]; F.norm2_g = args.in[15];
    F.w_router = args.in[16]; F.b_router = args.in[17]; F.w_gu = args.in[18]; F.b_gu = args.in[19]; F.w_dn = args.in[20]; F.b_dn = args.in[21]; F.final_g = args.in[22];
    F.out = args.out;
    F.modp = (float*)(ws + WS_MODP); F.modv = (float*)(ws + WS_MODV); F.rope = (float*)(ws + WS_ROPE); F.X1 = (float*)(ws + WS_X1);
    F.re = (int*)(ws + WS_ROUTE); F.rslot = F.re + NTOK * 4; F.rgate = (float*)(F.rslot + NTOK * 4); F.rpos = (int*)(F.rgate + NTOK * 4);
    F.Win_t = (bf16*)(ws + WS_WIN); F.Wout_t = (bf16*)(ws + WS_WOUT); F.Wgu_t = (bf16*)(ws + WS_WGU); F.Wdn_t = (bf16*)(ws + WS_WDN);
    F.XN = (bf16*)(ws + WS_XN); F.QA = (bf16*)(ws + WS_QA); F.KA = (bf16*)(ws + WS_KA); F.VA = (bf16*)(ws + WS_VA); F.QB = (bf16*)(ws + WS_QB); F.KB = (bf16*)(ws + WS_KB); F.VB = (bf16*)(ws + WS_VB);
    F.Y = (bf16*)(ws + WS_Y); F.XG = (bf16*)(ws + WS_XG); F.H = (bf16*)(ws + WS_H); F.Y2 = (bf16*)(ws + WS_Y2);
    for (int u = F.tid; u < (LDS_BYTES - LDSCTL_OFF) / 4; u += NWAVES * 64) ((LAS unsigned*)(F.lds + LDSCTL_OFF))[u] = 0u;
    __syncthreads();
    XcdBarrier bar; bar.bar = (unsigned*)(F.ctl + CW_BAR); bar.x = 0; bar.st = nullptr;
    if (args.use_bar) bar = xcd_barrier_post((unsigned*)(F.ctl + CW_BAR), F.MISC + 8);
    const int lo = args.ph_lo, hi = args.ph_hi;
#ifndef PH_MASK
#define PH_MASK 0x3ff
#endif
#define IN(k) (((PH_MASK >> (k)) & 1) && lo <= (k) && (k) < hi)
#define SEAM(k) do { if (IN(k) && IN((k) + 1)) { if (args.use_bar) xcd_barrier(bar); } else { __syncthreads(); } } while (0)

    if (IN(0)) { p0_prologue(F); } SEAM(0);
    if (IN(1)) { p1_norm(F); } SEAM(1);
    if (IN(2)) {
        EpiQKV E{F.QA, F.KA, F.VA, F.QB, F.KB, F.VB, F.rope};
#if FAST_GEMM
        pg8::Gemm g{F.XN, F.Win_t, NROW, INC, DM}; pg8::StaticOrder S; S.init(NROW, INC, F.G, (int)blockIdx.x);
        EpiAdapt<EpiQKV, 0> EA{E};
        pg8::gemm_phase<EpiAdapt<EpiQKV, 0>, pg8::StaticOrder, true, true>(F.lds + RING_OFF, g, S, EA);
#else
        naive_gemm(F, F.XN, NROW / 128, INC, DM, DenseSel{F.Win_t}, E);
#endif
    } SEAM(2);
    if (IN(3)) { naive_diff_attn(F); __syncthreads(); naive_win_attn(F); } SEAM(3);
    if (IN(4)) {
        EpiOut E{F.x, F.modv, F.X1};
#if FAST_GEMM
        pg8::Gemm g{F.Y, F.Wout_t, NTOK, DM, DM}; pg8::StaticOrder S; S.init(NTOK, DM, F.G, (int)blockIdx.x);
        EpiAdapt<EpiOut, 0> EA{E};
        pg8::gemm_phase<EpiAdapt<EpiOut, 0>, pg8::StaticOrder, true, true>(F.lds + RING_OFF, g, S, EA);
#else
        naive_gemm(F, F.Y, NTOK / 128, DM, DM, DenseSel{F.Wout_t}, E);
#endif
    } SEAM(4);
    if (IN(5)) { p5a_route(F); } SEAM(5);
    if (IN(6)) { p5b_scatter(F); } SEAM(6);
    if (IN(7)) {
        LAS int* pst = (LAS int*)(F.lds + XTRA_OFF); LAS int* pexp = pst + 64;
        const int NP = expert_tables(F, pst, pexp);
        EpiGU E{F.H, F.b_gu};
#if FAST_GEMM
        pg8::Gemm g{F.XG, F.Wgu_t, NP * 256, GUW, DM}; GroupedOrder S{GUW / 256, NP, F.G, (int)blockIdx.x, pexp};
        EpiAdapt<EpiGU, GUW / 256> EA{E};
        pg8::gemm_phase<EpiAdapt<EpiGU, GUW / 256>, GroupedOrder, true, true>(F.lds + RING_OFF, g, S, EA);
#else
        naive_gemm(F, F.XG, NP * 2, GUW, DM, GroupSel{F.Wgu_t, pexp, GUW, DM}, E);
#endif
    } SEAM(7);
    if (IN(8)) {
        LAS int* pst = (LAS int*)(F.lds + XTRA_OFF); LAS int* pexp = pst + 64;
        const int NP = expert_tables(F, pst, pexp);
        EpiDN E{F.Y2, F.b_dn};
#if FAST_GEMM
        pg8::Gemm g{F.H, F.Wdn_t, NP * 256, DM, DM}; GroupedOrder S{DM / 256, NP, F.G, (int)blockIdx.x, pexp};
        EpiAdapt<EpiDN, DM / 256> EA{E};
        pg8::gemm_phase<EpiAdapt<EpiDN, DM / 256>, GroupedOrder, true, true>(F.lds + RING_OFF, g, S, EA);
#else
        naive_gemm(F, F.H, NP * 2, DM, DM, GroupSel{F.Wdn_t, pexp, DM, DM}, E);
#endif
    } SEAM(8);
    if (IN(9)) { p8_final(F); }
#undef IN
#undef SEAM
}

#ifndef N_LAUNCH_MODE
#define N_LAUNCH_MODE 1
#endif
extern "C" void kernel_launch(void* const* d_in, const int* in_sizes, int n_in, void* d_out, int out_size, void* d_ws, size_t ws_size, hipStream_t stream) {
    static int grid = 0;
    if (grid == 0) {
        if (n_in != 23 || in_sizes[0] != NTOK * DM || out_size != NTOK * DM || ws_size < WS_END) { fprintf(stderr, "kernel_launch: unexpected shapes (n_in %d, in0 %d, out %d, ws %zu); nothing launched\n", n_in, n_in > 0 ? in_sizes[0] : -1, out_size, ws_size); grid = -1; return; }
        int dev = 0, cus = 0, per_cu = 0;
        if (hipGetDevice(&dev) != hipSuccess || hipDeviceGetAttribute(&cus, hipDeviceAttributeMultiprocessorCount, dev) != hipSuccess) { grid = -1; return; }
        if (hipFuncSetAttribute((const void*)mk_fwd, hipFuncAttributeMaxDynamicSharedMemorySize, LDS_BYTES) != hipSuccess) { fprintf(stderr, "kernel_launch: hipFuncSetAttribute failed\n"); grid = -1; return; }
        if (hipOccupancyMaxActiveBlocksPerMultiprocessor(&per_cu, (const void*)mk_fwd, NWAVES * 64, LDS_BYTES) != hipSuccess || per_cu < 1) fprintf(stderr, "kernel_launch: note: occupancy query reports %d\n", per_cu);
        (void)hipGetLastError();
        grid = cus;
    }
    if (grid < 0) return;
    if (hipMemsetAsync((char*)d_ws + WS_CTL, 0, CTL_ZERO_BYTES, stream) != hipSuccess) { fprintf(stderr, "kernel_launch: memset failed\n"); return; }
    Args a{};
    for (int i = 0; i < 23; ++i) a.in[i] = (const float*)d_in[i];
    a.out = (float*)d_out; a.ws = (unsigned char*)d_ws; a.pad = 0;
#if N_LAUNCH_MODE == 0
    a.ph_lo = 0; a.ph_hi = N_PHASES; a.use_bar = 1;
    hipLaunchKernelGGL(mk_fwd, dim3(grid), dim3(NWAVES * 64), LDS_BYTES, stream, a);
#else
    for (int p = 0; p < N_PHASES; ++p) { a.ph_lo = p; a.ph_hi = p + 1; a.use_bar = 0; hipLaunchKernelGGL(mk_fwd, dim3(grid), dim3(NWAVES * 64), LDS_BYTES, stream, a); }
#endif
}
```

```cpp
#include <hip/hip_runtime.h>
#include <cstdio>
#include <cstdint>
namespace pg8 {
#define PG8_LAS __attribute__((address_space(3)))
typedef unsigned short bf16_t;
typedef short bf16x8 __attribute__((ext_vector_type(8)));
typedef float f32x4 __attribute__((ext_vector_type(4)));
typedef unsigned u32x4 __attribute__((ext_vector_type(4)));
constexpr int BM = 256, BK = 64, HALF = 128, HTB = HALF * BK * 2  , STAGE_BYTES = 8 * HTB, NXCD = 8, WGM = 8;

__host__ __device__ __forceinline__ int lds_byte(int r, int c) { const int st = (r >> 4) * 2 + (c >> 5), rr = r & 15, cc = c & 31, ob = rr * 64 + cc * 2; return st * 1024 + (ob ^ (((ob >> 9) & 1) << 5)); }
__host__ __device__ __forceinline__ void stage_rc(int b, int& R, int& C) { const int st = b / 1024, sb = b % 1024, swz = sb ^ (((sb >> 9) & 1) << 5); R = (st >> 1) * 16 + swz / 64; C = (st & 1) * 32 + (swz % 64) / 2; }
__host__ __device__ __forceinline__ int perm32(int rho) { const int n = rho >> 4, i = rho & 15; return 8 * (i >> 2) + 4 * n + (i & 3); }

struct Unit { int pm, pn; };
struct Gemm { const bf16_t* A; const bf16_t* Bt; int M, N, K; };

struct StaticOrder {
    int nM, nN, nwg, G, c;
    __host__ __device__ void init(int M, int N, int G_, int c_) { nM = M / BM; nN = N / BM; nwg = nM * nN; G = G_; c = c_; }
    __host__ __device__ bool next(int i, Unit& u) const {
        const long L = (long)i * G + c; if (L >= nwg) return false;
        int wgid = (int)L; { const int q = nwg / NXCD, r = nwg % NXCD, xcd = wgid % NXCD, off = wgid / NXCD; wgid = (xcd < r ? xcd * (q + 1) : r * (q + 1) + (xcd - r) * q) + off; }
        const int nig = WGM * nN, gid = wgid / nig, fm = gid * WGM, gsz = (nM - fm) < WGM ? (nM - fm) : WGM;
        u.pm = fm + ((wgid % nig) % gsz); u.pn = (wgid % nig) / gsz; return true;
    }
    __device__ __forceinline__ void a_ready(const Unit&) const {}
    __device__ __forceinline__ void done(const Unit&) const {}
};

__device__ __forceinline__ unsigned cvt_pk_bf16(float lo, float hi) { unsigned r; asm volatile("v_cvt_pk_bf16_f32 %0, %1, %2" : "=v"(r) : "v"(lo), "v"(hi)); return r; }
typedef float f32x2 __attribute__((ext_vector_type(2)));
typedef int i32x4 __attribute__((ext_vector_type(4))); typedef int i32x8 __attribute__((ext_vector_type(8)));
__device__ __forceinline__ i32x8 cat8(bf16x8 a, bf16x8 b) { const i32x4 x = __builtin_bit_cast(i32x4, a), y = __builtin_bit_cast(i32x4, b); return __builtin_shufflevector(x, y, 0, 1, 2, 3, 4, 5, 6, 7); }
template <class Epi, class Sched, bool ALIGN_EPI = false, bool SP2 = false, bool GATHER = false, bool FP8 = false>
__device__ __forceinline__ void gemm_phase(PG8_LAS unsigned char* lds, const Gemm g, const Sched& S, const Epi& E) {
    const int tid = threadIdx.x, wid = __builtin_amdgcn_readfirstlane(tid >> 6), lane = tid & 63, wr = wid >> 2, wc = wid & 3, fr = lane & 15, fq = lane >> 4;
    const int K = g.K, nt = K / BK;
    unsigned voffA[2], voffB[2]; int RA[2]; unsigned CA2[2];
#pragma unroll
    for (int i = 0; i < 2; ++i) { int R, C; stage_rc(tid * 16 + i * 8192, R, C); const int Rb = Epi::PERM ? ((R & ~31) + perm32(R & 31)) : R;
        voffA[i] = (unsigned)(R * K + C) * 2u; voffB[i] = (unsigned)(Rb * K + C) * 2u; RA[i] = R; CA2[i] = (unsigned)C * 2u; }
    static_assert(!GATHER || SP2, "GATHER is wired into the SP2 loop only");
    unsigned gA[2][2], gN[2][2];
    const size_t kstep = (size_t)(BK * 2);
    const size_t hstep = (size_t)HALF * K * 2;
    const size_t tstep = 2 * hstep;
    const unsigned ldsw = (unsigned)wid * 1024u;
    const int aoff = lds_byte(wr * 64 + fr, fq * 8), boff = lds_byte(wc * 32 + fr, fq * 8);
#define PG8_SA(b, h) (((b) * 2 + (h)) * HTB)
#define PG8_SB(b, h) ((4 + (b) * 2 + (h)) * HTB)
#define PG8_STAGE(bufoff, gbase, voff) do { _Pragma("unroll") for (int _i = 0; _i < 2; ++_i) \
        __builtin_amdgcn_global_load_lds((const unsigned*)((const char*)(gbase) + (voff)[_i]), (PG8_LAS unsigned*)(lds + (bufoff) + ldsw + _i * 8192), 16, 0, 0); } while (0)
#define PG8_STAGEG(bufoff, kbytes, v0, v1) do { \
        __builtin_amdgcn_global_load_lds((const unsigned*)((const char*)g.A + (kbytes) + (v0)), (PG8_LAS unsigned*)(lds + (bufoff) + ldsw), 16, 0, 0); \
        __builtin_amdgcn_global_load_lds((const unsigned*)((const char*)g.A + (kbytes) + (v1)), (PG8_LAS unsigned*)(lds + (bufoff) + ldsw + 8192), 16, 0, 0); } while (0)
#define PG8_GOFF(dst, ui_) do { _Pragma("unroll") for (int h_ = 0; h_ < 2; ++h_) _Pragma("unroll") for (int i_ = 0; i_ < 2; ++i_) dst[h_][i_] = (unsigned)S.tok((ui_), h_ * HALF + RA[i_]) * (unsigned)(K * 2) + CA2[i_]; } while (0)
#define PG8_LDA(dst, b, h) do { _Pragma("unroll") for (int m = 0; m < 4; ++m) _Pragma("unroll") for (int k = 0; k < 2; ++k) dst[m][k] = *(const PG8_LAS bf16x8*)(lds + PG8_SA(b, h) + aoff + m * 2048 + k * 1024); } while (0)
#define PG8_LDB(dst, b, h) do { _Pragma("unroll") for (int n = 0; n < 2; ++n) _Pragma("unroll") for (int k = 0; k < 2; ++k) dst[n][k] = *(const PG8_LAS bf16x8*)(lds + PG8_SB(b, h) + boff + n * 2048 + k * 1024); } while (0)
#define PG8_MMA(ai, bj, At, Bt) do { __builtin_amdgcn_s_setprio(1); _Pragma("unroll") for (int m = 0; m < 4; ++m) _Pragma("unroll") for (int n = 0; n < 2; ++n) { \
        if constexpr (FP8) { const i32x8 a8_ = cat8(Bt[n][0], Bt[n][1]), b8_ = cat8(At[m][0], At[m][1]); \
            asm volatile("v_mfma_scale_f32_16x16x128_f8f6f4 %0, %1, %2, %0, %3, %4 op_sel_hi:[0,0,0]" : "+v"(acc[ai][bj][m][n]) : "v"(a8_), "v"(b8_), "v"(sc_w8), "v"(sc_a8)); } \
        else { _Pragma("unroll") for (int k = 0; k < 2; ++k) acc[ai][bj][m][n] = __builtin_amdgcn_mfma_f32_16x16x32_bf16(Bt[n][k], At[m][k], acc[ai][bj][m][n], 0, 0, 0); } } \
        __builtin_amdgcn_s_setprio(0); } while (0)
#define PG8_WAIT_V(n) asm volatile("s_waitcnt vmcnt(" #n ")" ::: "memory")
#define PG8_WAIT_L(n) asm volatile("s_waitcnt lgkmcnt(" #n ")" ::: "memory")
#define PG8_BAR __builtin_amdgcn_s_barrier()
#define PG8_SCHED __builtin_amdgcn_sched_barrier(0)
    int sc_w8 = 0x7A7A7A7A, sc_a8 = 0x7F7F7F7F;
    asm volatile("" : "+v"(sc_w8), "+v"(sc_a8));
    Unit cur, nxt; int ui = 0;
    if (!S.next(0, cur)) return;
    f32x4 acc[2][2][4][2];
#pragma unroll
    for (int a = 0; a < 2; ++a)
#pragma unroll
        for (int b = 0; b < 2; ++b)
#pragma unroll
            for (int m = 0; m < 4; ++m)
#pragma unroll
                for (int n = 0; n < 2; ++n) acc[a][b][m][n] = (f32x4){0.f, 0.f, 0.f, 0.f};
    bf16x8 At[4][2], B0[2][2], B1[2][2];
    const char* cA = (const char*)g.A + (size_t)cur.pm * tstep; const char* cB = (const char*)g.Bt + (size_t)cur.pn * tstep;
    S.a_ready(cur);
    if constexpr (SP2) {
        if constexpr (GATHER) { PG8_GOFF(gA, 0); }
        PG8_STAGE(PG8_SB(0, 0), cB, voffB); PG8_STAGE(PG8_SB(0, 1), cB + hstep, voffB);
        if constexpr (GATHER) { PG8_STAGEG(PG8_SA(0, 0), 0, gA[0][0], gA[0][1]); PG8_STAGEG(PG8_SA(0, 1), 0, gA[1][0], gA[1][1]); } else { PG8_STAGE(PG8_SA(0, 0), cA, voffA); PG8_STAGE(PG8_SA(0, 1), cA + hstep, voffA); }
        if (wr == 1) PG8_BAR;
        PG8_WAIT_V(2); PG8_BAR;
        PG8_STAGE(PG8_SB(1, 0), cB + kstep, voffB); if constexpr (GATHER) { PG8_STAGEG(PG8_SA(1, 0), kstep, gA[0][0], gA[0][1]); } else { PG8_STAGE(PG8_SA(1, 0), cA + kstep, voffA); } PG8_STAGE(PG8_SB(1, 1), cB + hstep + kstep, voffB);
        PG8_WAIT_V(6); PG8_BAR;
    } else {
        PG8_STAGE(PG8_SB(0, 0), cB, voffB); PG8_STAGE(PG8_SA(0, 0), cA, voffA); PG8_STAGE(PG8_SB(0, 1), cB + hstep, voffB); PG8_STAGE(PG8_SA(0, 1), cA + hstep, voffA);
        if (wr == 1) PG8_BAR;
        PG8_WAIT_V(4); PG8_BAR;
        PG8_STAGE(PG8_SB(1, 0), cB + kstep, voffB); PG8_STAGE(PG8_SA(1, 0), cA + kstep, voffA); PG8_STAGE(PG8_SB(1, 1), cB + hstep + kstep, voffB);
        PG8_WAIT_V(6); PG8_BAR;
    }
    for (;;) {
        const bool has_next = S.next(ui + 1, nxt);
        const char* nA = has_next ? (const char*)g.A + (size_t)nxt.pm * tstep : cA; const char* nB = has_next ? (const char*)g.Bt + (size_t)nxt.pn * tstep : cB;
        if constexpr (GATHER) { if (has_next) { PG8_GOFF(gN, ui + 1); } else { _Pragma("unroll") for (int h_ = 0; h_ < 2; ++h_) _Pragma("unroll") for (int i_ = 0; i_ < 2; ++i_) gN[h_][i_] = gA[h_][i_]; } }
#pragma unroll 1
        for (int t = 0; t < nt; t += 2) {
            const bool last = (t == nt - 2);
            const char* a1 = cA + (size_t)(t + 1) * kstep;
            const char* a2 = last ? nA : cA + (size_t)(t + 2) * kstep; const char* b2 = last ? nB : cB + (size_t)(t + 2) * kstep;
            const char* a3 = a2 + kstep; const char* b3 = b2 + kstep;
            if (last && has_next) S.a_ready(nxt);
            if constexpr (SP2) {
            const size_t k1_ = (size_t)(t + 1) * kstep, k2_ = last ? (size_t)0 : (size_t)(t + 2) * kstep;
            const unsigned s00_ = last ? gN[0][0] : gA[0][0], s01_ = last ? gN[0][1] : gA[0][1], s10_ = last ? gN[1][0] : gA[1][0], s11_ = last ? gN[1][1] : gA[1][1];
            PG8_LDB(B0, 0, 0); PG8_LDB(B1, 0, 1); PG8_SCHED; PG8_LDA(At, 0, 0); if constexpr (GATHER) { PG8_STAGEG(PG8_SA(1, 1), k1_, gA[1][0], gA[1][1]); } else { PG8_STAGE(PG8_SA(1, 1), a1 + hstep, voffA); }
            PG8_WAIT_V(8); PG8_WAIT_L(0); PG8_BAR; PG8_MMA(0, 0, At, B0); PG8_MMA(0, 1, At, B1); PG8_BAR; PG8_SCHED;
            PG8_LDA(At, 0, 1); PG8_STAGE(PG8_SB(0, 0), b2, voffB); PG8_STAGE(PG8_SB(0, 1), b2 + hstep, voffB); if constexpr (GATHER) { PG8_STAGEG(PG8_SA(0, 0), k2_, s00_, s01_); } else { PG8_STAGE(PG8_SA(0, 0), a2, voffA); }
            PG8_WAIT_V(8); PG8_WAIT_L(0); PG8_BAR; PG8_MMA(1, 0, At, B0); PG8_MMA(1, 1, At, B1); PG8_BAR; PG8_SCHED;
            PG8_LDB(B0, 1, 0); PG8_LDB(B1, 1, 1); PG8_SCHED; PG8_LDA(At, 1, 0); if constexpr (GATHER) { PG8_STAGEG(PG8_SA(0, 1), k2_, s10_, s11_); } else { PG8_STAGE(PG8_SA(0, 1), a2 + hstep, voffA); }
            PG8_WAIT_V(8); PG8_WAIT_L(0); PG8_BAR; PG8_MMA(0, 0, At, B0); PG8_MMA(0, 1, At, B1); PG8_BAR; PG8_SCHED;
            PG8_LDA(At, 1, 1); PG8_STAGE(PG8_SB(1, 0), b3, voffB); PG8_STAGE(PG8_SB(1, 1), b3 + hstep, voffB); if constexpr (GATHER) { PG8_STAGEG(PG8_SA(1, 0), k2_ + kstep, s00_, s01_); } else { PG8_STAGE(PG8_SA(1, 0), a3, voffA); }
            PG8_WAIT_V(8); PG8_WAIT_L(0); PG8_BAR; PG8_MMA(1, 0, At, B0); PG8_MMA(1, 1, At, B1); PG8_BAR; PG8_SCHED;
            } else {
            PG8_LDB(B0, 0, 0); PG8_SCHED; PG8_LDA(At, 0, 0); PG8_STAGE(PG8_SA(1, 1), a1 + hstep, voffA);
            PG8_WAIT_L(8); PG8_BAR; PG8_WAIT_L(0); PG8_MMA(0, 0, At, B0); PG8_BAR; PG8_SCHED;
            PG8_LDB(B1, 0, 1); PG8_STAGE(PG8_SB(0, 0), b2, voffB);
            PG8_BAR; PG8_WAIT_L(0); PG8_MMA(0, 1, At, B1); PG8_BAR;
            PG8_LDA(At, 0, 1); PG8_STAGE(PG8_SA(0, 0), a2, voffA);
            PG8_BAR; PG8_WAIT_L(0); PG8_MMA(1, 0, At, B0); PG8_BAR; PG8_SCHED;
            PG8_STAGE(PG8_SB(0, 1), b2 + hstep, voffB);
            PG8_WAIT_V(6); PG8_BAR; PG8_MMA(1, 1, At, B1); PG8_BAR;
            PG8_LDB(B0, 1, 0); PG8_SCHED; PG8_LDA(At, 1, 0); PG8_STAGE(PG8_SA(0, 1), a2 + hstep, voffA);
            PG8_WAIT_L(8); PG8_BAR; PG8_WAIT_L(0); PG8_MMA(0, 0, At, B0); PG8_BAR; PG8_SCHED;
            PG8_LDB(B1, 1, 1); PG8_STAGE(PG8_SB(1, 0), b3, voffB);
            PG8_BAR; PG8_WAIT_L(0); PG8_MMA(0, 1, At, B1); PG8_BAR;
            PG8_LDA(At, 1, 1); PG8_STAGE(PG8_SA(1, 0), a3, voffA);
            PG8_BAR; PG8_WAIT_L(0); PG8_MMA(1, 0, At, B0); PG8_BAR; PG8_SCHED;
            PG8_STAGE(PG8_SB(1, 1), b3 + hstep, voffB);
            PG8_WAIT_V(6); PG8_BAR; PG8_MMA(1, 1, At, B1); PG8_BAR;
            }
        }
        if constexpr (FP8) { asm volatile("s_nop 15\n\ts_nop 15" ::: "memory"); }
        if constexpr (ALIGN_EPI) { if (wr == 0) PG8_BAR; }
        if constexpr (!Epi::AFTER_DRAIN) { E(acc, cur, wr, wc, fr, fq); S.done(cur); }
        if (!has_next) break;
#pragma unroll
        for (int a = 0; a < 2; ++a)
#pragma unroll
            for (int b = 0; b < 2; ++b)
#pragma unroll
                for (int m = 0; m < 4; ++m)
#pragma unroll
                    for (int n = 0; n < 2; ++n) acc[a][b][m][n] = (f32x4){0.f, 0.f, 0.f, 0.f};
        cur = nxt; cA = nA; cB = nB; ++ui;
        if constexpr (GATHER) { _Pragma("unroll") for (int h_ = 0; h_ < 2; ++h_) _Pragma("unroll") for (int i_ = 0; i_ < 2; ++i_) gA[h_][i_] = gN[h_][i_]; }
        if constexpr (ALIGN_EPI) { if (wr == 1) PG8_BAR; }
    }
    PG8_WAIT_V(0);
    if constexpr (!ALIGN_EPI) { if (wr == 0) PG8_BAR; }
    PG8_BAR;
    if constexpr (Epi::AFTER_DRAIN) { E.fused(acc, cur, wr, wc, fr, fq, lds, wid, lane); S.done(cur); }
#undef PG8_SA
#undef PG8_SB
#undef PG8_STAGE
#undef PG8_STAGEG
#undef PG8_GOFF
#undef PG8_LDA
#undef PG8_LDB
#undef PG8_MMA
#undef PG8_WAIT_V
#undef PG8_WAIT_L
#undef PG8_BAR
#undef PG8_SCHED
}
}
#define GAS __attribute__((address_space(1)))
#define LAS __attribute__((address_space(3)))
typedef unsigned short bf16;
typedef unsigned v4u __attribute__((ext_vector_type(4)));
typedef float f32x4 __attribute__((ext_vector_type(4)));
typedef short bf16x8 __attribute__((ext_vector_type(8)));
typedef GAS unsigned gu32;
typedef GAS unsigned long long gu64;
#define RLX_AGENT __ATOMIC_RELAXED, __HIP_MEMORY_SCOPE_AGENT
#define LDS_WAIT() asm volatile("s_waitcnt lgkmcnt(0)" ::: "memory")
#define VM_WAIT() asm volatile("s_waitcnt vmcnt(0)" ::: "memory")
__device__ __forceinline__ unsigned long long rt() { return __builtin_amdgcn_s_memrealtime(); }
__device__ __forceinline__ unsigned f2bf(float f) { unsigned u = __builtin_bit_cast(unsigned, f); return (u + 0x7fffu + ((u >> 16) & 1u)) >> 16; }
__device__ __forceinline__ unsigned pk2(float lo, float hi) { return f2bf(lo) | (f2bf(hi) << 16); }
#define XB_TMO      128
#define XB_XCNT(j)  (256  + 64 * (j))
#define XB_XSUB(j)  (1280 + 64 * (j))
#define XB_XGEN(j)  (2304 + 64 * (j))
#define XB_TOP      3328
#define XB_TOPGEN   3392
#define XCD_BAR_WORDS 3456
#define XB_SPIN_CAP (1u << 22)

__device__ __forceinline__ unsigned xb_ld(unsigned* p)              { return __hip_atomic_load(p, __ATOMIC_RELAXED, __HIP_MEMORY_SCOPE_AGENT); }
__device__ __forceinline__ unsigned xb_add(unsigned* p, unsigned v) { return __hip_atomic_fetch_add(p, v, __ATOMIC_RELAXED, __HIP_MEMORY_SCOPE_AGENT); }
__device__ __forceinline__ unsigned xb_xcc_id() { return (unsigned)__builtin_amdgcn_s_getreg((3 << 11) | 20) & 0xFu; }
#define XB_SPIN(cond, bar) do { unsigned _sp = 0; while (cond) { __builtin_amdgcn_s_sleep(1); \
    if ((++_sp & 255u) == 0u) { if (xb_ld(&(bar)[XB_TMO])) break; if (_sp > XB_SPIN_CAP) { atomicAdd(&(bar)[XB_TMO], 1u); break; } } } } while (0)

struct XcdBarrier {
    unsigned* bar; unsigned x;
    volatile LAS unsigned* st;
};

__device__ __forceinline__ XcdBarrier xcd_barrier_post(unsigned* bar, volatile LAS unsigned* st) {
    XcdBarrier b; b.bar = bar; b.x = xb_xcc_id(); b.st = st;
    if (threadIdx.x == 0) (void)xb_add(&bar[XB_XCNT(b.x)], 1u);
    return b;
}
__device__ __forceinline__ void xcd_barrier_complete(unsigned* bar, unsigned x, unsigned& nloc, unsigned& nx) {
    const unsigned G = gridDim.x * gridDim.y * gridDim.z;
    unsigned sum, cnt, mine, sp = 0u;
    for (;;) {
        sum = 0u; cnt = 0u; mine = 0u;
#pragma unroll
        for (unsigned j = 0; j < 16; ++j) { const unsigned c = xb_ld(&bar[XB_XCNT(j)]); sum += c; cnt += (c > 0u) ? 1u : 0u; mine = (j == x) ? c : mine; }
        if (sum == G) break;
        __builtin_amdgcn_s_sleep(1);
        if ((++sp & 255u) == 0u) { if (xb_ld(&bar[XB_TMO])) break; if (sp > XB_SPIN_CAP) { atomicAdd(&bar[XB_TMO], 1u); break; } }
    }
    nloc = mine > 0u ? mine : 1u; nx = cnt > 0u ? cnt : 1u;
}

__device__ __forceinline__ void xcd_barrier(const XcdBarrier& b) {
    asm volatile("s_waitcnt vmcnt(0)" ::: "memory");
    __syncthreads();
    if (threadIdx.x == 0) {
        unsigned* bar = b.bar;
        __builtin_amdgcn_s_waitcnt(0);
        unsigned nloc = b.st[0], nx = b.st[1];
        if (nloc == 0u) { xcd_barrier_complete(bar, b.x, nloc, nx); b.st[0] = nloc; b.st[1] = nx; }
        const unsigned old = xb_add(&bar[XB_XSUB(b.x)], 1u);
        const unsigned gen = old / nloc;
        if (old + 1u == (gen + 1u) * nloc) {
            __builtin_amdgcn_fence(__ATOMIC_RELEASE, "agent");
            asm volatile("s_waitcnt vmcnt(0)" ::: "memory");
            const unsigned og = xb_add(&bar[XB_TOP], 1u);
            const unsigned tg = og / nx;
            if (og + 1u == (tg + 1u) * nx) xb_add(&bar[XB_TOPGEN], 1u);
            else XB_SPIN(xb_ld(&bar[XB_TOPGEN]) == tg, bar);
            __builtin_amdgcn_fence(__ATOMIC_ACQUIRE, "agent");
            xb_add(&bar[XB_XGEN(b.x)], 1u);
            asm volatile("s_waitcnt vmcnt(0)" ::: "memory");
        } else {
            XB_SPIN(xb_ld(&bar[XB_XGEN(b.x)]) == gen, bar);
            __builtin_amdgcn_fence(__ATOMIC_ACQUIRE, "agent");
            asm volatile("s_waitcnt vmcnt(0)" ::: "memory");
        }
    }
    __syncthreads();
}

constexpr int BATCH = 2, SEQ = 8192, DM = 1024, CTXL = 256;
constexpr int NTOK = BATCH * SEQ, NCTXR = BATCH * CTXL, NROW = NTOK + NCTXR, KVLEN = SEQ + CTXL;
constexpr int INC = 2304, NEXP = 32, TOPK = 4, GUW = 2048;
constexpr int NPAD_MAX = NTOK * TOPK + NEXP * 256;
constexpr float NORM_EPS = 1e-6f, LOG2E = 1.4426950408889634f, QSCALE = 0.125f * 1.4426950408889634f;
constexpr int NWAVES = 8;


namespace at2 {
typedef short bf16x8 __attribute__((ext_vector_type(8)));
typedef short s16x4 __attribute__((ext_vector_type(4)));
typedef float f32x16 __attribute__((ext_vector_type(16)));
typedef unsigned u32x4 __attribute__((ext_vector_type(4)));
constexpr int SHM_V = 16384, SHM_K = 16384, AT_WS_OFF = 73728, AT_WS3_OFF = 98304, XROW = 132, XROWW = 68;
constexpr int SDEPTH = 1;
constexpr float THRL = 8.0f;
#define AT_LAS __attribute__((address_space(3)))
#define KSWZ(row, colB) ((row) * 256 + ((colB) ^ (((row) & 7) << 4)))
#define SBAR() __builtin_amdgcn_sched_barrier(0)
__device__ __forceinline__ int crow(int r, int hi) { return (r & 3) + 8 * (r >> 2) + 4 * hi; }
typedef float f32x2_t __attribute__((ext_vector_type(2))); typedef __bf16 bf16x2_t __attribute__((ext_vector_type(2)));
__device__ __forceinline__ unsigned cvtpk2(float lo, float hi) { f32x2_t v = {lo, hi}; bf16x2_t b = __builtin_convertvector(v, bf16x2_t); return __builtin_bit_cast(unsigned, b); }
__device__ __forceinline__ void partialSM(f32x16& p0, f32x16& p1, float& m_reg, float& alpha) {
  float pmax = p0[0];
#pragma unroll
  for (int r = 1; r < 16; ++r) pmax = fmaxf(pmax, p0[r]);
#pragma unroll
  for (int r = 0; r < 16; ++r) pmax = fmaxf(pmax, p1[r]);
  { auto rr = __builtin_amdgcn_permlane32_swap(__float_as_uint(pmax), __float_as_uint(pmax), false, false); pmax = fmaxf(__uint_as_float(rr[0]), __uint_as_float(rr[1])); }
  float mn;
  if (__builtin_expect(__all(pmax - m_reg <= THRL), 1)) { mn = m_reg; alpha = 1.f; }
  else { mn = fmaxf(m_reg, pmax); alpha = __builtin_amdgcn_exp2f(m_reg - mn); m_reg = mn; }
#pragma unroll
  for (int r = 0; r < 16; ++r) p0[r] = p0[r] - mn;
#pragma unroll
  for (int r = 0; r < 16; ++r) p1[r] = p1[r] - mn;
#pragma unroll
  for (int r = 0; r < 16; ++r) p0[r] = __builtin_amdgcn_exp2f(p0[r]);
}
__device__ __forceinline__ void finishSM(f32x16& p0, f32x16& p1, float alpha, float& l_reg, bf16x8& pa0, bf16x8& pa1, bf16x8& pa2, bf16x8& pa3) {
#pragma unroll
  for (int r = 0; r < 16; ++r) p1[r] = __builtin_amdgcn_exp2f(p1[r]);
  float ps = 0;
#pragma unroll
  for (int r = 0; r < 16; ++r) ps += p0[r];
#pragma unroll
  for (int r = 0; r < 16; ++r) ps += p1[r];
  { auto rr = __builtin_amdgcn_permlane32_swap(__float_as_uint(ps), __float_as_uint(ps), false, false); ps = __uint_as_float(rr[0]) + __uint_as_float(rr[1]); }
  l_reg = l_reg * alpha + ps;
#define PK4(P, BASE, OUT) do { unsigned a0 = cvtpk2(P[BASE + 0], P[BASE + 1]), a1 = cvtpk2(P[BASE + 2], P[BASE + 3]);   \
    unsigned b0 = cvtpk2(P[BASE + 4], P[BASE + 5]), b1 = cvtpk2(P[BASE + 6], P[BASE + 7]);                              \
    auto r0 = __builtin_amdgcn_permlane32_swap(a0, b0, false, false); auto r1 = __builtin_amdgcn_permlane32_swap(a1, b1, false, false); \
    u32x4 w = {r0[0], r1[0], r0[1], r1[1]}; OUT = __builtin_bit_cast(bf16x8, w); } while (0)
  PK4(p0, 0, pa0); PK4(p0, 8, pa1); PK4(p1, 0, pa2); PK4(p1, 8, pa3);
#undef PK4
}
__device__ __forceinline__ void qkt(f32x16& p0, f32x16& p1, const AT_LAS char* Ks, const bf16x8* qr, int r32, int hi) {
  p0 = f32x16{}; p1 = f32x16{};
#pragma unroll
  for (int d0 = 0; d0 < 4; ++d0) { const int cb = (d0 * 16 + hi * 8) * 2;
    const bf16x8 b0 = *(const AT_LAS bf16x8*)(Ks + KSWZ(r32, cb));
    const bf16x8 b1 = *(const AT_LAS bf16x8*)(Ks + KSWZ(32 + r32, cb));
    p0 = __builtin_amdgcn_mfma_f32_32x32x16_bf16(b0, qr[d0], p0, 0, 0, 0);
    p1 = __builtin_amdgcn_mfma_f32_32x32x16_bf16(b1, qr[d0], p1, 0, 0, 0); }
}
__device__ __forceinline__ int v_st(int k, int c) { const int kk = (k & ~0xC) | ((k & 4) << 1) | ((k & 8) >> 1); return ((kk >> 3) * 4 + (c >> 5)) * 512 + ((kk & 7) * 32 + (c & 31)) * 2; }
__device__ __forceinline__ int v_rd_base(int lane) { return ((lane & 3) << 3) | (((lane >> 2) & 3) << 6) | (((lane >> 4) & 1) << 5) | (((lane >> 5) & 1) << 8); }
constexpr int v_rd_off(int d0, int ks, int half) { return d0 * 512 + ks * 4096 + half * 2048; }
template <int OFF> __device__ __forceinline__ s16x4 tr_read(int vb) { s16x4 r; asm volatile("ds_read_b64_tr_b16 %0, %1 offset:%2" : "=&v"(r) : "v"(vb), "i"(OFF) : "memory"); return r; }
template <int D0> __device__ __forceinline__ void pv_one(f32x16& od, int vb, bf16x8 pa0, bf16x8 pa1, bf16x8 pa2, bf16x8 pa3) {
  const s16x4 l0 = tr_read<v_rd_off(D0, 0, 0)>(vb), h0 = tr_read<v_rd_off(D0, 0, 1)>(vb), l1 = tr_read<v_rd_off(D0, 1, 0)>(vb), h1 = tr_read<v_rd_off(D0, 1, 1)>(vb);
  const s16x4 l2 = tr_read<v_rd_off(D0, 2, 0)>(vb), h2 = tr_read<v_rd_off(D0, 2, 1)>(vb), l3 = tr_read<v_rd_off(D0, 3, 0)>(vb), h3 = tr_read<v_rd_off(D0, 3, 1)>(vb);
  asm volatile("s_waitcnt lgkmcnt(0)" ::: "memory"); SBAR();
#define PK(L, H) (bf16x8){L[0], L[1], L[2], L[3], H[0], H[1], H[2], H[3]}
  od = __builtin_amdgcn_mfma_f32_32x32x16_bf16(pa0, PK(l0, h0), od, 0, 0, 0);
  od = __builtin_amdgcn_mfma_f32_32x32x16_bf16(pa1, PK(l1, h1), od, 0, 0, 0);
  od = __builtin_amdgcn_mfma_f32_32x32x16_bf16(pa2, PK(l2, h2), od, 0, 0, 0);
  od = __builtin_amdgcn_mfma_f32_32x32x16_bf16(pa3, PK(l3, h3), od, 0, 0, 0);
#undef PK
}
typedef short v4i16_t __attribute__((ext_vector_type(4)));
__device__ __forceinline__ s16x4 vtr(int vb, int off) { return __builtin_bit_cast(s16x4, __builtin_amdgcn_ds_read_tr16_b64_v4i16((AT_LAS v4i16_t*)(unsigned)(vb + off))); }
template <int D0> __device__ __forceinline__ void pv_one_b(f32x16& od, int vb, bf16x8 pa0, bf16x8 pa1, bf16x8 pa2, bf16x8 pa3) {
  const s16x4 l0 = vtr(vb, v_rd_off(D0, 0, 0)), h0 = vtr(vb, v_rd_off(D0, 0, 1)), l1 = vtr(vb, v_rd_off(D0, 1, 0)), h1 = vtr(vb, v_rd_off(D0, 1, 1));
  const s16x4 l2 = vtr(vb, v_rd_off(D0, 2, 0)), h2 = vtr(vb, v_rd_off(D0, 2, 1)), l3 = vtr(vb, v_rd_off(D0, 3, 0)), h3 = vtr(vb, v_rd_off(D0, 3, 1));
#define PK(L, H) (bf16x8){L[0], L[1], L[2], L[3], H[0], H[1], H[2], H[3]}
  od = __builtin_amdgcn_mfma_f32_32x32x16_bf16(pa0, PK(l0, h0), od, 0, 0, 0);
  od = __builtin_amdgcn_mfma_f32_32x32x16_bf16(pa1, PK(l1, h1), od, 0, 0, 0);
  od = __builtin_amdgcn_mfma_f32_32x32x16_bf16(pa2, PK(l2, h2), od, 0, 0, 0);
  od = __builtin_amdgcn_mfma_f32_32x32x16_bf16(pa3, PK(l3, h3), od, 0, 0, 0);
#undef PK
}
template <int NDB> __device__ __forceinline__ void pv_all_b(f32x16* o, int vb, bf16x8 pa0, bf16x8 pa1, bf16x8 pa2, bf16x8 pa3) {
  pv_one_b<0>(o[0], vb, pa0, pa1, pa2, pa3); pv_one_b<1>(o[1], vb, pa0, pa1, pa2, pa3);
  if constexpr (NDB == 4) { pv_one_b<2>(o[2], vb, pa0, pa1, pa2, pa3); pv_one_b<3>(o[3], vb, pa0, pa1, pa2, pa3); }
}
template <int NDB> __device__ __forceinline__ void pv_all(f32x16* o, int vb, bf16x8 pa0, bf16x8 pa1, bf16x8 pa2, bf16x8 pa3) {
  pv_one<0>(o[0], vb, pa0, pa1, pa2, pa3); pv_one<1>(o[1], vb, pa0, pa1, pa2, pa3);
  if constexpr (NDB == 4) { pv_one<2>(o[2], vb, pa0, pa1, pa2, pa3); pv_one<3>(o[3], vb, pa0, pa1, pa2, pa3); }
}
__device__ __forceinline__ void wmask(f32x16& p0, f32x16& p1, int k0, int q, int hi) {
#pragma unroll
  for (int r = 0; r < 16; ++r) { const int d = k0 + crow(r, hi) - q; if (d > 128 || d < -128) p0[r] = -1e30f; if (d + 32 > 128 || d + 32 < -128) p1[r] = -1e30f; }
}

struct UnitArgs {
  const bf16* Q; int ldq;
  const bf16* K; const bf16* V; int ldk;
  int kcolB;
  int vcolB;
  int q0;
  int ks;
};
template <bool DIFF> __device__ __forceinline__ int tile_k0(const UnitArgs& a, int j) { if constexpr (DIFF) return 64 * j; else return j < 4 ? SEQ + 64 * j : a.ks + 64 * (j - 4); }

#define RD128(dst, addr, OFF) asm volatile("ds_read_b128 %0, %1 offset:%2" : "=v"(dst) : "v"(addr), "i"(OFF) : "memory")
#define RDTR(dst, addr, OFF) asm volatile("ds_read_b64_tr_b16 %0, %1 offset:%2" : "=v"(dst) : "v"(addr), "i"(OFF) : "memory")
#define WAITL8_4(n, a, b, c, d) asm volatile("s_waitcnt lgkmcnt(" #n ")" : "+v"(a), "+v"(b), "+v"(c), "+v"(d) :: "memory")
#define WAITL8_8(n, a, b, c, d, e, f, g, h) asm volatile("s_waitcnt lgkmcnt(" #n ")" : "+v"(a), "+v"(b), "+v"(c), "+v"(d), "+v"(e), "+v"(f), "+v"(g), "+v"(h) :: "memory")
__device__ __forceinline__ float max3f(float a, float b, float c) { return __builtin_fmaxf(__builtin_fmaxf(a, b), c); }
__device__ __forceinline__ void softmax_seg2(f32x16& p0, f32x16& p1, float& m_reg, float& alpha, bf16x8& pa0, bf16x8& pa1, bf16x8& pa2, bf16x8& pa3) {
  float x = max3f(p0[0], p0[1], p0[2]), y = max3f(p1[0], p1[1], p1[2]);
  x = max3f(x, p0[3], p0[4]); y = max3f(y, p1[3], p1[4]); x = max3f(x, p0[5], p0[6]); y = max3f(y, p1[5], p1[6]); x = max3f(x, p0[7], p0[8]); y = max3f(y, p1[7], p1[8]);
  x = max3f(x, p0[9], p0[10]); y = max3f(y, p1[9], p1[10]); x = max3f(x, p0[11], p0[12]); y = max3f(y, p1[11], p1[12]); x = max3f(x, p0[13], p0[14]); y = max3f(y, p1[13], p1[14]);
  float pmax = max3f(x, y, p0[15]); pmax = fmaxf(pmax, p1[15]);
  { auto rr = __builtin_amdgcn_permlane32_swap(__float_as_uint(pmax), __float_as_uint(pmax), false, false); pmax = fmaxf(__uint_as_float(rr[0]), __uint_as_float(rr[1])); }
  float mn;
  if (__builtin_expect(__all(pmax - m_reg <= THRL), 1)) { mn = m_reg; alpha = 1.f; }
  else { mn = fmaxf(m_reg, pmax); alpha = __builtin_amdgcn_exp2f(m_reg - mn); m_reg = mn; }
#pragma unroll
  for (int r = 0; r < 16; ++r) { p0[r] = __builtin_amdgcn_exp2f(p0[r] - mn); p1[r] = __builtin_amdgcn_exp2f(p1[r] - mn); }
  { u32x4 w = {cvtpk2(p0[0], p0[1]), cvtpk2(p0[2], p0[3]), cvtpk2(p0[4], p0[5]), cvtpk2(p0[6], p0[7])}; pa0 = __builtin_bit_cast(bf16x8, w); }
  { u32x4 w = {cvtpk2(p0[8], p0[9]), cvtpk2(p0[10], p0[11]), cvtpk2(p0[12], p0[13]), cvtpk2(p0[14], p0[15])}; pa1 = __builtin_bit_cast(bf16x8, w); }
  { u32x4 w = {cvtpk2(p1[0], p1[1]), cvtpk2(p1[2], p1[3]), cvtpk2(p1[4], p1[5]), cvtpk2(p1[6], p1[7])}; pa2 = __builtin_bit_cast(bf16x8, w); }
  { u32x4 w = {cvtpk2(p1[8], p1[9]), cvtpk2(p1[10], p1[11]), cvtpk2(p1[12], p1[13]), cvtpk2(p1[14], p1[15])}; pa3 = __builtin_bit_cast(bf16x8, w); }
}
template <bool DIFF>
__device__ __forceinline__ void attn_tiles_pp3(const UnitArgs& a, AT_LAS char* lds, int tid, int wid, int lane, f32x16* o, f32x16& ol, float& m_out) {
  constexpr int NDB = DIFF ? 4 : 2; constexpr int NT = DIFF ? KVLEN / 64 : 10;
  const int r32 = lane & 31, hi = lane >> 5;
  AT_LAS char* V_lds = lds; AT_LAS char* K_lds = lds + 3 * SHM_V;
  AT_LAS float* al_l = (AT_LAS float*)(lds + AT_WS3_OFF) + wid * 64 + 32;
  float m_reg = -1e30f, alpha = 1.f; bf16x8 qr[4];
  const short one_ = (short)0x3F80; const bf16x8 ones = {one_, one_, one_, one_, one_, one_, one_, one_};
  const bf16* Qw = a.Q + (long)r32 * a.ldq + hi * 8;
#pragma unroll
  for (int d0 = 0; d0 < 4; ++d0) qr[d0] = *(const bf16x8*)(Qw + d0 * 16);
  int koff[2], voff[2];
#pragma unroll
  for (int i = 0; i < 2; ++i) { const int pc = 2 * wid + i;
    { const int row = 4 * pc + (lane >> 4), p = lane & 15; koff[i] = row * a.ldk + ((p ^ (row & 7)) << 3); }
    { const int s = 2 * pc + (lane >> 5), kk = (s >> 2) * 8 + ((lane & 31) >> 2); const int key = kk; voff[i] = key * a.ldk + (s & 3) * 32 + 8 * (lane & 3); } }
  const int vb0 = (int)(unsigned)(uintptr_t)V_lds + v_rd_base(lane) + a.vcolB;
  const int kb0 = (int)(unsigned)(uintptr_t)K_lds + a.kcolB + r32 * 256;
  int kad[4];
#pragma unroll
  for (int d0 = 0; d0 < 4; ++d0) kad[d0] = kb0 + (((d0 * 2 + hi) ^ (r32 & 7)) << 4);
#define DMA_K(t, slot) do { const bf16* kb_ = a.K + (long)tile_k0<DIFF>(a, (t)) * a.ldk; _Pragma("unroll") for (int i_ = 0; i_ < 2; ++i_) \
    __builtin_amdgcn_global_load_lds((const unsigned*)(kb_ + koff[i_]), (AT_LAS unsigned*)(K_lds + (slot) * SHM_K + (2 * wid + i_) * 1024), 16, 0, 0); } while (0)
#define DMA_V(t, slot) do { const bf16* vb_ = a.V + (long)tile_k0<DIFF>(a, (t)) * a.ldk; _Pragma("unroll") for (int i_ = 0; i_ < 2; ++i_) \
    __builtin_amdgcn_global_load_lds((const unsigned*)(vb_ + voff[i_]), (AT_LAS unsigned*)(V_lds + (slot) * SHM_V + (2 * wid + i_) * 1024), 16, 0, 0); } while (0)
#define BAR_MID() do { SBAR(); asm volatile("s_barrier" ::: "memory"); SBAR(); } while (0)
#define BAR_END(n) do { SBAR(); asm volatile("s_waitcnt vmcnt(" #n ")\n\ts_barrier" ::: "memory"); SBAR(); } while (0)
#define RESC2() do { if (__any(alpha < 1.f)) { if (hi == 0) al_l[r32] = alpha; asm volatile("s_waitcnt lgkmcnt(0)" ::: "memory"); \
    _Pragma("unroll") for (int r = 0; r < 16; ++r) { const float f_ = al_l[crow(r, hi)]; ol[r] *= f_; _Pragma("unroll") for (int d = 0; d < NDB; ++d) o[d][r] *= f_; } } } while (0)
#define WMASK2(t) do { if constexpr (!DIFF) { if ((t) >= 4) wmask(p0, p1, tile_k0<DIFF>(a, (t)), a.q0 + r32, hi); } } while (0)
#define VSEG(t) do { WMASK2(t); softmax_seg2(p0, p1, m_reg, alpha, pa0, pa1, pa2, pa3); RESC2(); } while (0)
#define PKV(L, H) (bf16x8){L[0], L[1], L[2], L[3], H[0], H[1], H[2], H[3]}
#define VRD8(X, D0, va) do { RDTR(X##0, va, v_rd_off(D0, 0, 0)); RDTR(X##1, va, v_rd_off(D0, 0, 1)); RDTR(X##2, va, v_rd_off(D0, 1, 0)); RDTR(X##3, va, v_rd_off(D0, 1, 1)); \
    RDTR(X##4, va, v_rd_off(D0, 2, 0)); RDTR(X##5, va, v_rd_off(D0, 2, 1)); RDTR(X##6, va, v_rd_off(D0, 3, 0)); RDTR(X##7, va, v_rd_off(D0, 3, 1)); } while (0)
#define PV4(od, X) do { od = __builtin_amdgcn_mfma_f32_32x32x16_bf16(pa0, PKV(X##0, X##1), od, 0, 0, 0); od = __builtin_amdgcn_mfma_f32_32x32x16_bf16(pa1, PKV(X##2, X##3), od, 0, 0, 0); \
    od = __builtin_amdgcn_mfma_f32_32x32x16_bf16(pa2, PKV(X##4, X##5), od, 0, 0, 0); od = __builtin_amdgcn_mfma_f32_32x32x16_bf16(pa3, PKV(X##6, X##7), od, 0, 0, 0); } while (0)
#define MSEG(DOQK, DOPV, ksl, vsl) do { \
    bf16x8 k0_, k1_, k2_, k3_; s16x4 A0, A1, A2, A3, A4, A5, A6, A7, B0, B1, B2, B3, B4, B5, B6, B7; \
    const int ko_ = (ksl) * SHM_K; const int va_ = vb0 + (vsl) * SHM_V; \
    if (DOQK) { RD128(k0_, kad[0] + ko_, 0); RD128(k1_, kad[0] + ko_, 8192); RD128(k2_, kad[1] + ko_, 0); RD128(k3_, kad[1] + ko_, 8192); \
      bf16x8 k4_, k5_, k6_, k7_; RD128(k4_, kad[2] + ko_, 0); RD128(k5_, kad[2] + ko_, 8192); RD128(k6_, kad[3] + ko_, 0); RD128(k7_, kad[3] + ko_, 8192); \
      WAITL8_4(4, k0_, k1_, k2_, k3_); SBAR(); \
      p0 = __builtin_amdgcn_mfma_f32_32x32x16_bf16(k0_, qr[0], (f32x16){}, 0, 0, 0); p1 = __builtin_amdgcn_mfma_f32_32x32x16_bf16(k1_, qr[0], (f32x16){}, 0, 0, 0); \
      p0 = __builtin_amdgcn_mfma_f32_32x32x16_bf16(k2_, qr[1], p0, 0, 0, 0); p1 = __builtin_amdgcn_mfma_f32_32x32x16_bf16(k3_, qr[1], p1, 0, 0, 0); SBAR(); \
      if (DOPV) { VRD8(A, 0, va_); WAITL8_4(8, k4_, k5_, k6_, k7_); } else { WAITL8_4(0, k4_, k5_, k6_, k7_); } SBAR(); \
      p0 = __builtin_amdgcn_mfma_f32_32x32x16_bf16(k4_, qr[2], p0, 0, 0, 0); p1 = __builtin_amdgcn_mfma_f32_32x32x16_bf16(k5_, qr[2], p1, 0, 0, 0); \
      p0 = __builtin_amdgcn_mfma_f32_32x32x16_bf16(k6_, qr[3], p0, 0, 0, 0); p1 = __builtin_amdgcn_mfma_f32_32x32x16_bf16(k7_, qr[3], p1, 0, 0, 0); SBAR(); } \
    else if (DOPV) { VRD8(A, 0, va_); } \
    if (DOPV) { VRD8(B, 1, va_); WAITL8_8(8, A0, A1, A2, A3, A4, A5, A6, A7); SBAR(); PV4(o[0], A); SBAR(); \
      if constexpr (NDB == 4) { VRD8(A, 2, va_); WAITL8_8(8, B0, B1, B2, B3, B4, B5, B6, B7); SBAR(); PV4(o[1], B); SBAR(); \
        VRD8(B, 3, va_); WAITL8_8(8, A0, A1, A2, A3, A4, A5, A6, A7); SBAR(); PV4(o[2], A); SBAR(); \
        WAITL8_8(0, B0, B1, B2, B3, B4, B5, B6, B7); SBAR(); PV4(o[3], B); SBAR(); } \
      else { WAITL8_8(0, B0, B1, B2, B3, B4, B5, B6, B7); SBAR(); PV4(o[1], B); SBAR(); } \
      ol = __builtin_amdgcn_mfma_f32_32x32x16_bf16(pa0, ones, ol, 0, 0, 0); ol = __builtin_amdgcn_mfma_f32_32x32x16_bf16(pa1, ones, ol, 0, 0, 0); \
      ol = __builtin_amdgcn_mfma_f32_32x32x16_bf16(pa2, ones, ol, 0, 0, 0); ol = __builtin_amdgcn_mfma_f32_32x32x16_bf16(pa3, ones, ol, 0, 0, 0); SBAR(); } \
  } while (0)
#define ROT3(s) ((s) == 2 ? 0 : (s) + 1)
  f32x16 p0, p1; bf16x8 pa0, pa1, pa2, pa3;
  DMA_K(0, 0); DMA_K(1, 1); DMA_V(0, 0); BAR_END(0);
  int sk = 0;
  if (wid < 4) {
    DMA_K(2, 2); DMA_V(1, 1); MSEG(true, false, 0, 0); BAR_MID(); VSEG(0); BAR_END(4);
    sk = 1;
    for (int t = 1; t <= NT - 3; ++t) { const int s1 = ROT3(sk), s2 = ROT3(s1);
      DMA_K(t + 2, s2); DMA_V(t + 1, s1); MSEG(true, true, sk, s2); BAR_MID(); VSEG(t); BAR_END(4); sk = s1; }
    { const int s1 = ROT3(sk), s2 = ROT3(s1); DMA_V(NT - 1, s1); MSEG(true, true, sk, s2); BAR_MID(); VSEG(NT - 2); BAR_END(2); sk = s1; }
    { const int s1 = ROT3(sk), s2 = ROT3(s1); MSEG(true, true, sk, s2); BAR_MID(); VSEG(NT - 1); BAR_END(0); sk = s1; }
    { const int s2 = ROT3(ROT3(sk)); MSEG(false, true, 0, s2); BAR_MID(); BAR_END(0); }
  } else {
    DMA_K(2, 2); DMA_V(1, 1); BAR_MID(); MSEG(true, false, 0, 0); BAR_END(4);
    sk = 1;
    for (int t = 1; t <= NT - 3; ++t) { const int s1 = ROT3(sk), s2 = ROT3(s1);
      DMA_K(t + 2, s2); DMA_V(t + 1, s1); VSEG(t - 1); BAR_MID(); MSEG(true, true, sk, s2); BAR_END(4); sk = s1; }
    { const int s1 = ROT3(sk), s2 = ROT3(s1); DMA_V(NT - 1, s1); VSEG(NT - 3); BAR_MID(); MSEG(true, true, sk, s2); BAR_END(2); sk = s1; }
    { const int s1 = ROT3(sk), s2 = ROT3(s1); VSEG(NT - 2); BAR_MID(); MSEG(true, true, sk, s2); BAR_END(0); sk = s1; }
    { const int s2 = ROT3(ROT3(sk)); VSEG(NT - 1); BAR_MID(); MSEG(false, true, 0, s2); BAR_END(0); }
  }
  m_out = m_reg;
#undef DMA_K
#undef DMA_V
#undef BAR_MID
#undef BAR_END
#undef RESC2
#undef WMASK2
#undef VSEG
#undef PKV
#undef VRD8
#undef PV4
#undef MSEG
#undef ROT3
}

typedef int i32x8v __attribute__((ext_vector_type(8)));
constexpr int F8_SLOT = 8192, F8_K_OFF = 0, F8_V_OFF = 3 * F8_SLOT;
#define MF8_ACC(acc, a8, b8) asm volatile("v_mfma_scale_f32_32x32x64_f8f6f4 %0, %1, %2, %0, %3, %3 op_sel_hi:[0,0,0]" : "+v"(acc) : "v"(a8), "v"(b8), "v"(sc1))
#define MF8_NEW(acc, a8, b8) asm volatile("v_mfma_scale_f32_32x32x64_f8f6f4 %0, %1, %2, 0, %3, %3 op_sel_hi:[0,0,0]" : "=&v"(acc) : "v"(a8), "v"(b8), "v"(sc1))
__device__ __forceinline__ unsigned pk4f8(float a, float b, float c, float d) { int w = 0; w = __builtin_amdgcn_cvt_pk_fp8_f32(a, b, w, false); w = __builtin_amdgcn_cvt_pk_fp8_f32(c, d, w, true); return (unsigned)w; }
struct UnitArgs8 { const unsigned char* Q; const unsigned char* K; const unsigned char* VT; int comp, ldk, vdoff, q0, ks; };
template <bool DIFF> __device__ __forceinline__ int tile8_k0(const UnitArgs8& a, int j) { if constexpr (DIFF) return 64 * j; else return j < 4 ? SEQ + 64 * j : a.ks + 64 * (j - 4); }
template <bool DIFF>
__device__ __forceinline__ void attn_tiles_f8(const UnitArgs8& a, AT_LAS char* lds, int tid, int wid, int lane, f32x16* o, f32x16& ol, float& m_out) {
  constexpr int NDB = DIFF ? 4 : 2, NT = DIFF ? KVLEN / 64 : 10;
  const int r32 = lane & 31, hi = lane >> 5;
  AT_LAS char* K_lds = lds + F8_K_OFF; AT_LAS char* V_lds = lds + F8_V_OFF;
  AT_LAS float* al_l = (AT_LAS float*)(lds + AT_WS3_OFF) + wid * 64 + 32;
  float m_reg = -1e30f, alpha = 1.f;
  int sc1 = 0x7F7F7F7F; asm volatile("" : "+v"(sc1));
  i32x8v ones8; { int o4 = 0x38383838; asm volatile("" : "+v"(o4)); ones8 = (i32x8v){o4, o4, o4, o4, o4, o4, o4, o4}; }
  i32x8v q8; { const u32x4 qa_ = *(const u32x4*)(a.Q + (long)r32 * 512 + hi * 32), qb_ = *(const u32x4*)(a.Q + (long)r32 * 512 + hi * 32 + 16);
    q8 = (i32x8v){(int)qa_.x, (int)qa_.y, (int)qa_.z, (int)qa_.w, (int)qb_.x, (int)qb_.y, (int)qb_.z, (int)qb_.w}; }
  const int kkey = 8 * wid + (lane >> 3), koff = kkey * a.ldk + (((lane & 7) ^ ((kkey >> 1) & 7)) << 4);
  const int vd = 16 * wid + (lane >> 2); const long voff = (long)vd * KVLEN + (((lane & 3) ^ ((vd >> 2) & 3)) << 4);
  const int ksw = (r32 >> 1) & 7, vsw = (r32 >> 2) & 3;
  const int kb = (int)(unsigned)(uintptr_t)K_lds + r32 * 128, ka0 = kb + (((a.comp * 4 + 2 * hi) ^ ksw) << 4), ka1 = kb + (((a.comp * 4 + 2 * hi + 1) ^ ksw) << 4);
  const int vbb = (int)(unsigned)(uintptr_t)V_lds + a.vdoff + r32 * 64, va0 = vbb + (((2 * hi) ^ vsw) << 4), va1 = vbb + (((2 * hi + 1) ^ vsw) << 4);
#define DMA_K(t, slot) __builtin_amdgcn_global_load_lds((const unsigned*)(a.K + (long)tile8_k0<DIFF>(a, (t)) * a.ldk + koff), (AT_LAS unsigned*)(K_lds + (slot) * F8_SLOT + wid * 1024), 16, 0, 0)
#define DMA_V(t, slot) __builtin_amdgcn_global_load_lds((const unsigned*)(a.VT + (long)tile8_k0<DIFF>(a, (t)) + voff), (AT_LAS unsigned*)(V_lds + (slot) * F8_SLOT + wid * 1024), 16, 0, 0)
#define BAR_MID() do { SBAR(); asm volatile("s_barrier" ::: "memory"); SBAR(); } while (0)
#define BAR_END(n) do { SBAR(); asm volatile("s_waitcnt vmcnt(" #n ")\n\ts_barrier" ::: "memory"); SBAR(); } while (0)
#define RESC2() do { if (__any(alpha < 1.f)) { if (hi == 0) al_l[r32] = alpha; asm volatile("s_waitcnt lgkmcnt(0)" ::: "memory"); \
    _Pragma("unroll") for (int r = 0; r < 16; ++r) { const float f_ = al_l[crow(r, hi)]; ol[r] *= f_; _Pragma("unroll") for (int d = 0; d < NDB; ++d) o[d][r] *= f_; } } } while (0)
#define VSEG(t) do { if constexpr (!DIFF) { if ((t) >= 4) wmask(p0, p1, tile8_k0<DIFF>(a, (t)), a.q0 + r32, hi); } bf16x8 t0_, t1_, t2_, t3_; softmax_seg2(p0, p1, m_reg, alpha, t0_, t1_, t2_, t3_); (void)t0_; (void)t1_; (void)t2_; (void)t3_; \
    pa8 = (i32x8v){(int)pk4f8(p0[0], p0[1], p0[2], p0[3]), (int)pk4f8(p0[4], p0[5], p0[6], p0[7]), (int)pk4f8(p0[8], p0[9], p0[10], p0[11]), (int)pk4f8(p0[12], p0[13], p0[14], p0[15]), \
                   (int)pk4f8(p1[0], p1[1], p1[2], p1[3]), (int)pk4f8(p1[4], p1[5], p1[6], p1[7]), (int)pk4f8(p1[8], p1[9], p1[10], p1[11]), (int)pk4f8(p1[12], p1[13], p1[14], p1[15])}; RESC2(); } while (0)
#define RD16(dst, addr, OFF) asm volatile("ds_read_b128 %0, %1 offset:%2" : "=v"(dst) : "v"(addr), "i"(OFF) : "memory")
#define CAT8(x, y) (i32x8v){(int)x[0], (int)x[1], (int)x[2], (int)x[3], (int)y[0], (int)y[1], (int)y[2], (int)y[3]}
#define MSEG(DOQK, DOPV, ksl, vsl) do { \
    u32x4 ka_, kb_, kc_, kd_, v0a, v0b, v1a, v1b, v2a, v2b, v3a, v3b; const int ko_ = (ksl) * F8_SLOT, vo_ = (vsl) * F8_SLOT; \
    if (DOQK) { RD16(ka_, ka0 + ko_, 0); RD16(kb_, ka1 + ko_, 0); RD16(kc_, ka0 + ko_, 4096); RD16(kd_, ka1 + ko_, 4096); } \
    if (DOPV) { RD16(v0a, va0 + vo_, 0); RD16(v0b, va1 + vo_, 0); RD16(v1a, va0 + vo_, 2048); RD16(v1b, va1 + vo_, 2048); \
                if constexpr (NDB == 4) { RD16(v2a, va0 + vo_, 4096); RD16(v2b, va1 + vo_, 4096); RD16(v3a, va0 + vo_, 6144); RD16(v3b, va1 + vo_, 6144); } } \
    if (DOQK) { if (DOPV) { if constexpr (NDB == 4) asm volatile("s_waitcnt lgkmcnt(8)" : "+v"(ka_), "+v"(kb_), "+v"(kc_), "+v"(kd_) :: "memory"); else asm volatile("s_waitcnt lgkmcnt(4)" : "+v"(ka_), "+v"(kb_), "+v"(kc_), "+v"(kd_) :: "memory"); } else { asm volatile("s_waitcnt lgkmcnt(0)" : "+v"(ka_), "+v"(kb_), "+v"(kc_), "+v"(kd_) :: "memory"); } SBAR(); \
      { const i32x8v k0_ = CAT8(ka_, kb_), k1_ = CAT8(kc_, kd_); MF8_NEW(p0, k0_, q8); MF8_NEW(p1, k1_, q8); } SBAR(); } \
    if (DOPV) { if constexpr (NDB == 4) { asm volatile("s_waitcnt lgkmcnt(0)" : "+v"(v0a), "+v"(v0b), "+v"(v1a), "+v"(v1b), "+v"(v2a), "+v"(v2b), "+v"(v3a), "+v"(v3b) :: "memory"); SBAR(); \
        const i32x8v w0_ = CAT8(v0a, v0b), w1_ = CAT8(v1a, v1b), w2_ = CAT8(v2a, v2b), w3_ = CAT8(v3a, v3b); \
        MF8_ACC(o[0], pa8, w0_); MF8_ACC(o[1], pa8, w1_); MF8_ACC(o[2], pa8, w2_); MF8_ACC(o[3], pa8, w3_); MF8_ACC(ol, pa8, ones8); } \
      else { asm volatile("s_waitcnt lgkmcnt(0)" : "+v"(v0a), "+v"(v0b), "+v"(v1a), "+v"(v1b) :: "memory"); SBAR(); \
        const i32x8v w0_ = CAT8(v0a, v0b), w1_ = CAT8(v1a, v1b); MF8_ACC(o[0], pa8, w0_); MF8_ACC(o[1], pa8, w1_); MF8_ACC(ol, pa8, ones8); } SBAR(); } \
    asm volatile("s_nop 15\n\ts_nop 15" ::: "memory");     \
  } while (0)
#define ROT3(s) ((s) == 2 ? 0 : (s) + 1)
  f32x16 p0, p1; i32x8v pa8;
  DMA_K(0, 0); DMA_K(1, 1); DMA_V(0, 0); BAR_END(0);
  int sk = 0;
  if (wid < 4) {
    DMA_K(2, 2); DMA_V(1, 1); MSEG(true, false, 0, 0); BAR_MID(); VSEG(0); BAR_END(2);
    sk = 1;
    for (int t = 1; t <= NT - 3; ++t) { const int s1 = ROT3(sk), s2 = ROT3(s1);
      DMA_K(t + 2, s2); DMA_V(t + 1, s1); MSEG(true, true, sk, s2); BAR_MID(); VSEG(t); BAR_END(2); sk = s1; }
    { const int s1 = ROT3(sk), s2 = ROT3(s1); DMA_V(NT - 1, s1); MSEG(true, true, sk, s2); BAR_MID(); VSEG(NT - 2); BAR_END(1); sk = s1; }
    { const int s1 = ROT3(sk), s2 = ROT3(s1); MSEG(true, true, sk, s2); BAR_MID(); VSEG(NT - 1); BAR_END(0); sk = s1; }
    { const int s2 = ROT3(ROT3(sk)); MSEG(false, true, 0, s2); BAR_MID(); BAR_END(0); }
  } else {
    DMA_K(2, 2); DMA_V(1, 1); BAR_MID(); MSEG(true, false, 0, 0); BAR_END(2);
    sk = 1;
    for (int t = 1; t <= NT - 3; ++t) { const int s1 = ROT3(sk), s2 = ROT3(s1);
      DMA_K(t + 2, s2); DMA_V(t + 1, s1); VSEG(t - 1); BAR_MID(); MSEG(true, true, sk, s2); BAR_END(2); sk = s1; }
    { const int s1 = ROT3(sk), s2 = ROT3(s1); DMA_V(NT - 1, s1); VSEG(NT - 3); BAR_MID(); MSEG(true, true, sk, s2); BAR_END(1); sk = s1; }
    { const int s1 = ROT3(sk), s2 = ROT3(s1); VSEG(NT - 2); BAR_MID(); MSEG(true, true, sk, s2); BAR_END(0); sk = s1; }
    { const int s2 = ROT3(ROT3(sk)); VSEG(NT - 1); BAR_MID(); MSEG(false, true, 0, s2); BAR_END(0); }
  }
  m_out = m_reg;
#undef DMA_K
#undef DMA_V
#undef BAR_MID
#undef BAR_END
#undef RESC2
#undef VSEG
#undef RD16
#undef CAT8
#undef MSEG
#undef ROT3
}
#undef KSWZ
#undef SBAR
}

constexpr size_t MiB = 1u << 20;
constexpr size_t WS_CTL = 0, CTL_ZERO_BYTES = 1 * MiB;
constexpr size_t WS_MODP = 1 * MiB;
constexpr size_t WS_MODV = 2 * MiB;
constexpr size_t WS_ROPE = 2 * MiB + 128 * 1024;
constexpr size_t WS_ROUTE = 3 * MiB;
constexpr size_t WS_WIN = 4 * MiB, WS_WOUT = 9 * MiB, WS_WGU = 12 * MiB, WS_WDN = 140 * MiB;
constexpr size_t WS_ELIST = 238 * MiB;
constexpr size_t WS_XN = 204 * MiB;
constexpr size_t WS_QA = 240 * MiB, WS_KA = 256 * MiB, WS_VA = 274 * MiB, WS_QB = 292 * MiB, WS_KB = 308 * MiB, WS_VB = 314 * MiB;
constexpr size_t WS_Y = 320 * MiB, WS_X1 = 352 * MiB, WS_XG = 416 * MiB, WS_H = 560 * MiB, WS_Y2 = 704 * MiB, WS_END = 848 * MiB;
constexpr int CW_TMO = 0, CW_CODE = 1, CW_BAR = 4096, CW_CNT = 8192;
constexpr int MODP_KC = 8;

constexpr int RING_OFF = 0, RING_BYTES = 131072;
constexpr int LDSCTL_OFF = RING_BYTES, MISC_OFF = LDSCTL_OFF + 320, XTRA_OFF = LDSCTL_OFF + 1024;
constexpr int LDS_BYTES = 147456;

__device__ const double ROPE_CS[32] = {
    0.54030230586813977, 0.8414709848078965, 0.84600911028170789, 0.53316843991402285, 0.95041528025518285, 0.31098359290718575, 0.98423023447009461, 0.17689218624615005,
    0.99500416527802582, 0.099833416646828155, 0.99841927779266448, 0.056204499214692491, 0.99950004166527784, 0.031617506402433708, 0.99984189028361437, 0.01778185687966613,
    0.99995000041666526, 0.0099998333341666645, 0.9999841886533658, 0.0056233836139601857, 0.99999500000416663, 0.0031622723897082477, 0.99999841886158658, 0.0017782784728035289,
    0.99999950000004167, 0.00099999983333334168, 0.99999984188612112, 0.00056234129555235944, 0.99999995000000041, 0.00031622776074637522, 0.99999998418861169, 0.00017782794006665674};

__device__ __forceinline__ unsigned cvtpk(float lo, float hi) { return at2::cvtpk2(lo, hi); }
__device__ __forceinline__ unsigned pk4_fp8(float a, float b, float c, float d) { int w = 0; w = __builtin_amdgcn_cvt_pk_fp8_f32(a, b, w, false); w = __builtin_amdgcn_cvt_pk_fp8_f32(c, d, w, true); return (unsigned)w; }
__device__ __forceinline__ float bflo(unsigned w) { return __uint_as_float(w << 16); }
__device__ __forceinline__ float bfhi(unsigned w) { return __uint_as_float(w & 0xffff0000u); }
__device__ __forceinline__ bf16 f2bf1(float f) { return (bf16)(cvtpk(f, 0.f) & 0xffffu); }
__device__ __forceinline__ void unpack8(const v4u v, float* f) { f[0] = bflo(v.x); f[1] = bfhi(v.x); f[2] = bflo(v.y); f[3] = bfhi(v.y); f[4] = bflo(v.z); f[5] = bfhi(v.z); f[6] = bflo(v.w); f[7] = bfhi(v.w); }
__device__ __forceinline__ float wave_sum(float v) {
#pragma unroll
    for (int o = 1; o < 64; o <<= 1) v += __shfl_xor(v, o);
    return v;
}

struct Frame {
    LAS unsigned char* lds;
    volatile LAS unsigned* MISC;
    gu32* ctl;
    int tid, lane, wave, vcu, G, probe;
    const float *x, *c, *ctx, *c_ctx, *w_mod, *b_mod, *norm1_g, *w_in, *lq1, *lk1, *lq2, *lk2, *subln_g, *sink, *w_out, *norm2_g, *w_router, *b_router, *w_gu, *b_gu, *w_dn, *b_dn, *final_g;
    float* out;
    float *modp, *modv, *rope, *X1, *rgate;
    int *re, *rslot, *rpos, *elist;
    bf16 *Win_t, *Wout_t, *Wgu_t, *Wdn_t, *XN, *QA, *KA, *VA, *QB, *KB, *VB, *Y, *XG, *H, *Y2;
};

#ifdef PROBE_BUILD
#define RP(F, k) (1 + (((F).probe >> (k)) & 1))
#else
#define RP(F, k) 1
#endif
struct EpiQKV {
    bf16 *QA, *KA, *VA, *QB, *KB, *VB; const float* rope;
    struct Ctx { bf16* p; bool skip, rp, isq; const float* cs; };
    __device__ __forceinline__ Ctx prep(int row, int cg) const {
        Ctx c; const bool lat = row < NTOK; const int b = lat ? (row >> 13) : ((row - NTOK) >> 8);
        const int kvrow = lat ? (b * KVLEN + (row & (SEQ - 1))) : (b * KVLEN + SEQ + ((row - NTOK) & (CTXL - 1)));
        c.skip = false; c.rp = lat; c.isq = false;
        if (cg < 512)       { c.p = QA + (size_t)row * 512 + cg; c.isq = true; c.skip = !lat; }
        else if (cg < 1024) { c.p = KA + (size_t)kvrow * 512 + (cg - 512); }
        else if (cg < 1536) { c.p = VA + (size_t)kvrow * 512 + (cg - 1024); c.rp = false; }
        else if (cg < 2048) { c.p = QB + (size_t)row * 512 + (cg - 1536); c.isq = true; c.skip = !lat; }
        else if (cg < 2176) { c.p = KB + (size_t)kvrow * 128 + (cg - 2048); }
        else                { c.p = VB + (size_t)kvrow * 128 + (cg - 2176); c.rp = false; }
        const int t = row & (SEQ - 1); const int pos = ((cg >> 5) & 1) ? (t & 63) : (t >> 6);
        c.cs = rope + pos * 32;
        return c;
    }
    __device__ __forceinline__ void math(const Ctx& c, int i, float lo, float hi, float& olo, float& ohi) const {
        if (c.rp) { const float cs = c.cs[2 * i], sn = c.cs[2 * i + 1]; olo = lo * cs - hi * sn; ohi = hi * cs + lo * sn; } else { olo = lo; ohi = hi; }
        if (c.isq) { olo *= QSCALE; ohi *= QSCALE; }
    }
    __device__ __forceinline__ void one(int row, int cg, int i, float lo, float hi, int) const {
        const Ctx c = prep(row, cg); if (c.skip) return; float a, b; math(c, i, lo, hi, a, b); c.p[i] = f2bf1(a); c.p[16 + i] = f2bf1(b);
    }
    __device__ __forceinline__ void four(int row, int cg, int i0, const f32x4 lo, const f32x4 hi, int) const {
        const Ctx c = prep(row, cg); if (c.skip) return; float a[4], b[4];
#pragma unroll
        for (int i = 0; i < 4; ++i) math(c, i0 + i, lo[i], hi[i], a[i], b[i]);
        typedef unsigned u32x2 __attribute__((ext_vector_type(2)));
        *(u32x2*)(c.p + i0) = (u32x2){cvtpk(a[0], a[1]), cvtpk(a[2], a[3])}; *(u32x2*)(c.p + 16 + i0) = (u32x2){cvtpk(b[0], b[1]), cvtpk(b[2], b[3])};
    }
};
struct EpiOut {
    const float* x; const float* modv; float* X1;
    __device__ __forceinline__ void one(int row, int cg, int i, float lo, float hi, int) const {
        const float* g1 = modv + (row >> 13) * 6144 + 2048; const size_t o = (size_t)row * DM + cg + i;
        X1[o] = x[o] + g1[cg + i] * lo; X1[o + 16] = x[o + 16] + g1[cg + 16 + i] * hi;
    }
    __device__ __forceinline__ void four(int row, int cg, int i0, const f32x4 lo, const f32x4 hi, int) const {
        const float* g1 = modv + (row >> 13) * 6144 + 2048 + cg + i0; const size_t o = (size_t)row * DM + cg + i0;
        typedef unsigned u32x2 __attribute__((ext_vector_type(2)));
        const f32x4 a = *(const f32x4*)(x + o) + *(const f32x4*)(g1) * lo, b = *(const f32x4*)(x + o + 16) + *(const f32x4*)(g1 + 16) * hi;
        *(u32x2*)((bf16*)X1 + o) = (u32x2){cvtpk(a[0], a[1]), cvtpk(a[2], a[3])}; *(u32x2*)((bf16*)X1 + o + 16) = (u32x2){cvtpk(b[0], b[1]), cvtpk(b[2], b[3])};
    }
};
__device__ __forceinline__ float swiglu(float g, float lin) {
    g = fminf(g, 7.0f); lin = fminf(fmaxf(lin, -7.0f), 7.0f);
    return g * __builtin_amdgcn_rcpf(1.0f + __builtin_amdgcn_exp2f(-1.702f * LOG2E * g)) * (lin + 1.0f);
}
struct EpiGU {
    unsigned char* H; const float* b_gu;
    __device__ __forceinline__ void one(int row, int cg, int i, float lo, float hi, int e) const { (void)row; (void)cg; (void)i; (void)lo; (void)hi; (void)e; }
    __device__ __forceinline__ void four(int row, int cg, int i0, const f32x4 lo, const f32x4 hi, int e) const {
        const int f = (cg >> 1) + i0; const float* bb = b_gu + e * GUW + 2 * f; const f32x4 b0 = *(const f32x4*)bb, b1 = *(const f32x4*)(bb + 4);
        const float a0 = swiglu(lo[0] + b0[0], hi[0] + b0[1]), a1 = swiglu(lo[1] + b0[2], hi[1] + b0[3]), a2 = swiglu(lo[2] + b1[0], hi[2] + b1[1]), a3 = swiglu(lo[3] + b1[2], hi[3] + b1[3]);
        *(unsigned*)(H + (size_t)row * DM + f) = pk4_fp8(a0, a1, a2, a3);
    }
};
struct EpiDN {
    bf16* Y2; const float* b_dn;
    __device__ __forceinline__ void eight(int row, int c0, const f32x4 v0, const f32x4 v1, int e) const {
        const float* bb = b_dn + e * DM + c0; const f32x4 b0 = *(const f32x4*)bb, b1 = *(const f32x4*)(bb + 4);
        typedef unsigned u32x2 __attribute__((ext_vector_type(2)));
        *(u32x2*)((unsigned char*)Y2 + (size_t)row * DM + c0) = (u32x2){pk4_fp8(v0[0] + b0[0], v0[1] + b0[1], v0[2] + b0[2], v0[3] + b0[3]), pk4_fp8(v1[0] + b1[0], v1[1] + b1[1], v1[2] + b1[2], v1[3] + b1[3])};
    }
    __device__ __forceinline__ void one(int row, int cg, int i, float lo, float hi, int e) const {
        const float* bb = b_dn + e * DM + cg + i; bf16* p = Y2 + (size_t)row * DM + cg + i; p[0] = f2bf1(lo + bb[0]); p[16] = f2bf1(hi + bb[16]);
    }
    __device__ __forceinline__ void four(int row, int cg, int i0, const f32x4 lo, const f32x4 hi, int e) const {
        const float* bb = b_dn + e * DM + cg + i0; const f32x4 b0 = *(const f32x4*)bb, b1 = *(const f32x4*)(bb + 16); bf16* p = Y2 + (size_t)row * DM + cg + i0;
        typedef unsigned u32x2 __attribute__((ext_vector_type(2)));
        *(u32x2*)p = (u32x2){cvtpk(lo[0] + b0[0], lo[1] + b0[1]), cvtpk(lo[2] + b0[2], lo[3] + b0[3])}; *(u32x2*)(p + 16) = (u32x2){cvtpk(hi[0] + b1[0], hi[1] + b1[1]), cvtpk(hi[2] + b1[2], hi[3] + b1[3])};
    }
};
template <class E, int NN> struct EpiAdapt {
    static constexpr bool PERM = false, AFTER_DRAIN = false;
    E e;
    __device__ __forceinline__ void operator()(const pg8::f32x4 (&acc)[2][2][4][2], const pg8::Unit& u, int wr, int wc, int fr, int fq) const {
        int ex = 0, pn = u.pn; if (NN) { ex = pn / NN; pn = pn - ex * NN; }
#pragma unroll
        for (int ai = 0; ai < 2; ++ai)
#pragma unroll
            for (int m = 0; m < 4; ++m) { const int row = u.pm * 256 + ai * 128 + wr * 64 + m * 16 + fr;
#pragma unroll
                for (int bj = 0; bj < 2; ++bj) e.four(row, pn * 256 + bj * 128 + wc * 32, 4 * fq, acc[ai][bj][m][0], acc[ai][bj][m][1], ex); }
    }
};
struct RepOrder : pg8::StaticOrder { int rep;
    __device__ __forceinline__ bool next(int i, pg8::Unit& u) const { if (rep > 1) { const int R = (nwg + G - 1) / G; if (i >= R * rep) return false; i %= R; } return pg8::StaticOrder::next(i, u); } };
struct EpiQKVFast {
    static constexpr bool PERM = false, AFTER_DRAIN = false;
    bf16 *QA, *KA, *VA, *QB, *KB, *VB; const float* rope;
    __device__ __forceinline__ void operator()(const pg8::f32x4 (&acc)[2][2][4][2], const pg8::Unit& u, int wr, int wc, int fr, int fq) const {
        typedef unsigned u32x2 __attribute__((ext_vector_type(2)));
        bf16* base[2]; int ld[2]; bool isq[2], rp[2], kvr[2], f8[2];
#pragma unroll
        for (int bj = 0; bj < 2; ++bj) { const int cg = u.pn * 256 + bj * 128 + wc * 32; isq[bj] = false; rp[bj] = true; kvr[bj] = true; f8[bj] = true;
            if (cg < 512)       { base[bj] = (bf16*)((unsigned char*)QA + cg); ld[bj] = 512; isq[bj] = true; kvr[bj] = false; }
            else if (cg < 1024) { base[bj] = (bf16*)((unsigned char*)KA + (cg - 512)); ld[bj] = 512; }
            else if (cg < 1536) { base[bj] = (bf16*)((unsigned char*)VA + (cg - 1024)); ld[bj] = 512; rp[bj] = false; }
            else if (cg < 2048) { base[bj] = (bf16*)((unsigned char*)QB + (cg - 1536)); ld[bj] = 512; isq[bj] = true; kvr[bj] = false; }
            else if (cg < 2176) { base[bj] = (bf16*)((unsigned char*)KB + (cg - 2048)); ld[bj] = 128; }
            else                { base[bj] = (bf16*)((unsigned char*)VB + (cg - 2176)); ld[bj] = 128; rp[bj] = false; } }
        const bool colhalf = (wc & 1) != 0;
#pragma unroll
        for (int ai = 0; ai < 2; ++ai)
#pragma unroll
            for (int m = 0; m < 4; ++m) {
                const int row = u.pm * 256 + ai * 128 + wr * 64 + m * 16 + fr; const bool lat = row < NTOK;
                const int b = lat ? (row >> 13) : ((row - NTOK) >> 8);
                const int kvrow = lat ? (b * KVLEN + (row & (SEQ - 1))) : (b * KVLEN + SEQ + ((row - NTOK) & (CTXL - 1)));
                const int t = row & (SEQ - 1), pos = colhalf ? (t & 63) : (t >> 6);
                const f32x4 c0 = *(const f32x4*)(rope + pos * 32 + 8 * fq), c1 = *(const f32x4*)(rope + pos * 32 + 8 * fq + 4);
#pragma unroll
                for (int bj = 0; bj < 2; ++bj) {
                    if (isq[bj] && !lat) continue;
                    f32x4 lo = acc[ai][bj][m][0], hi = acc[ai][bj][m][1];
                    if (rp[bj] && lat) { const f32x4 cs = {c0[0], c0[2], c1[0], c1[2]}, sn = {c0[1], c0[3], c1[1], c1[3]}; const f32x4 nl = lo * cs - hi * sn, nh = hi * cs + lo * sn; lo = nl; hi = nh; }
                    if (isq[bj]) { lo = lo * QSCALE; hi = hi * QSCALE; }
                    const size_t rr = (size_t)(kvr[bj] ? kvrow : row) * ld[bj];
                    if (f8[bj]) { unsigned char* p = (unsigned char*)base[bj] + rr + 4 * fq; *(unsigned*)p = pk4_fp8(lo[0], lo[1], lo[2], lo[3]); *(unsigned*)(p + 16) = pk4_fp8(hi[0], hi[1], hi[2], hi[3]); }
                    else { bf16* p = base[bj] + rr + 4 * fq; *(u32x2*)p = (u32x2){cvtpk(lo[0], lo[1]), cvtpk(lo[2], lo[3])}; *(u32x2*)(p + 16) = (u32x2){cvtpk(hi[0], hi[1]), cvtpk(hi[2], hi[3])}; }
                }
            }
    }
};
template <class E, int NN> struct EpiAdaptP {
    static constexpr bool PERM = true, AFTER_DRAIN = false;
    E e;
    __device__ __forceinline__ void operator()(const pg8::f32x4 (&acc)[2][2][4][2], const pg8::Unit& u, int wr, int wc, int fr, int fq) const {
        int ex = 0, pn = u.pn; if (NN) { ex = pn / NN; pn = pn - ex * NN; }
#pragma unroll
        for (int ai = 0; ai < 2; ++ai)
#pragma unroll
            for (int m = 0; m < 4; ++m) { const int row = u.pm * 256 + ai * 128 + wr * 64 + m * 16 + fr;
#pragma unroll
                for (int bj = 0; bj < 2; ++bj) e.eight(row, pn * 256 + bj * 128 + wc * 32 + 8 * fq, acc[ai][bj][m][0], acc[ai][bj][m][1], ex); }
    }
};
struct GroupedOrder {
    int nN, NP, G, c; const LAS int* pexp; int rep; const LAS int* tokT;
    __device__ __forceinline__ int rounds() const { const int upr = G / nN; return (NP + upr - 1) / upr; }
    __device__ __forceinline__ int tok(int ui, int r) const { if (rep > 1) ui %= rounds(); return tokT[ui * 256 + r]; }
    __device__ __forceinline__ bool next(int i, pg8::Unit& u) const {
        int p, j;
        if (rep > 1) { const int R = rounds(); if (i >= R * rep) return false; i %= R; }
        if (G == 256) { const int x = c & 7, r = c >> 3, ppx = 32 / nN; p = i * (8 * ppx) + x * ppx + r / nN; j = r % nN; }
        else { const long L = (long)i * G + c; p = (int)(L / nN); j = (int)(L % nN); }
        if (p >= NP) return false;
        u.pm = p; u.pn = pexp[p] * nN + j; return true;
    }
    __device__ __forceinline__ void a_ready(const pg8::Unit&) const {}
    __device__ __forceinline__ void done(const pg8::Unit&) const {}
};

struct DenseSel { const bf16* Bt; __device__ __forceinline__ const bf16* operator()(int, int& e) const { e = 0; return Bt; } };
struct GroupSel { const bf16* Bt; const LAS int* pexp; int N, K; __device__ __forceinline__ const bf16* operator()(int mt, int& e) const { e = pexp[mt >> 1]; return Bt + (size_t)e * N * K; } };
template <class Epi, class BSel>
__device__ __forceinline__ void naive_gemm(Frame& F, const bf16* A, int Mtiles, int N, int K, const BSel& bs, const Epi& E) {
    LAS float* As = (LAS float*)(F.lds + RING_OFF); LAS float* Bs = As + 128 * 33;
    const int nNt = N / 64, tx = F.tid & 15, ty = F.tid >> 4;
    for (int t = blockIdx.x; t < Mtiles * nNt; t += F.G) {
        const int mt = t / nNt, nt = t % nNt; int e; const bf16* Bt = bs(mt, e);
        float acc[4][4];
#pragma unroll
        for (int r = 0; r < 4; ++r)
#pragma unroll
            for (int j = 0; j < 4; ++j) acc[r][j] = 0.f;
        for (int k0 = 0; k0 < K; k0 += 32) {
            { const int r = F.tid >> 2, kc = (F.tid & 3) * 8; float f[8]; unpack8(*(const v4u*)(A + (size_t)(mt * 128 + r) * K + k0 + kc), f);
#pragma unroll
              for (int i = 0; i < 8; ++i) As[r * 33 + kc + i] = f[i]; }
            if (F.tid < 256) { const int r = F.tid >> 2, kc = (F.tid & 3) * 8; float f[8]; unpack8(*(const v4u*)(Bt + (size_t)(nt * 64 + r) * K + k0 + kc), f);
#pragma unroll
              for (int i = 0; i < 8; ++i) Bs[r * 33 + kc + i] = f[i]; }
            __syncthreads();
#pragma unroll 8
            for (int kk = 0; kk < 32; ++kk) { float a[4], b[4];
#pragma unroll
                for (int r = 0; r < 4; ++r) a[r] = As[(ty * 4 + r) * 33 + kk];
#pragma unroll
                for (int j = 0; j < 4; ++j) b[j] = Bs[(tx + 16 * j) * 33 + kk];
#pragma unroll
                for (int r = 0; r < 4; ++r)
#pragma unroll
                    for (int j = 0; j < 4; ++j) acc[r][j] += a[r] * b[j]; }
            __syncthreads();
        }
#pragma unroll
        for (int r = 0; r < 4; ++r) { const int row = mt * 128 + ty * 4 + r; E.one(row, nt * 64, tx, acc[r][0], acc[r][1], e); E.one(row, nt * 64 + 32, tx, acc[r][2], acc[r][3], e); }
    }
}

template <bool GUPERM>
__device__ __forceinline__ void p0_transpose_item(const float* W, int K, int N, bf16* WT, LAS float* scr, int item, int lane) {
    const int nblk = N / 32, kb = item / nblk, nb = item % nblk, k0 = 64 * kb, n0 = 32 * nb;
    { f32x4 v[8]; const float* wp = W + (size_t)(k0 + (lane >> 3)) * N + n0 + 4 * (lane & 7);
#pragma unroll
      for (int i = 0; i < 8; ++i) v[i] = __builtin_nontemporal_load((const f32x4*)(wp + (size_t)(8 * i) * N));
#pragma unroll
      for (int i = 0; i < 8; ++i) { LAS float* d = scr + (8 * i + (lane >> 3)) * 33 + 4 * (lane & 7); d[0] = v[i].x; d[1] = v[i].y; d[2] = v[i].z; d[3] = v[i].w; } }
    LDS_WAIT(); asm volatile("" ::: "memory");
    const int c = lane & 7;
#pragma unroll
    for (int j = 0; j < 4; ++j) { const int n = (lane >> 3) + 8 * j; const LAS float* s = scr + (8 * c) * 33 + n;
        v4u o; o.x = cvtpk(s[0 * 33], s[1 * 33]); o.y = cvtpk(s[2 * 33], s[3 * 33]); o.z = cvtpk(s[4 * 33], s[5 * 33]); o.w = cvtpk(s[6 * 33], s[7 * 33]);
        const int nd = GUPERM ? ((n & 1) * 16 + (n >> 1)) : n;
        *(GAS v4u*)(WT + (size_t)(n0 + nd) * K + k0 + 8 * c) = o; }
    LDS_WAIT(); asm volatile("" ::: "memory");
}
template <bool GUPERM>
__device__ __forceinline__ void p0_transpose_item_fp8(const float* W, int K, int N, unsigned char* WT, LAS float* scr, int item, int lane) {
    const int nblk = N / 32, kb = item / nblk, nb = item % nblk, k0 = 64 * kb, n0 = 32 * nb;
    { f32x4 v[8]; const float* wp = W + (size_t)(k0 + (lane >> 3)) * N + n0 + 4 * (lane & 7);
#pragma unroll
      for (int i = 0; i < 8; ++i) v[i] = __builtin_nontemporal_load((const f32x4*)(wp + (size_t)(8 * i) * N));
#pragma unroll
      for (int i = 0; i < 8; ++i) { LAS float* d = scr + (8 * i + (lane >> 3)) * 33 + 4 * (lane & 7); d[0] = v[i].x; d[1] = v[i].y; d[2] = v[i].z; d[3] = v[i].w; } }
    LDS_WAIT(); asm volatile("" ::: "memory");
    const int c = lane & 7;
    typedef unsigned u32x2 __attribute__((ext_vector_type(2)));
#pragma unroll
    for (int j = 0; j < 4; ++j) { const int n = (lane >> 3) + 8 * j; const LAS float* s = scr + (8 * c) * 33 + n;
        u32x2 o; o.x = pk4_fp8(s[0 * 33] * 32.f, s[1 * 33] * 32.f, s[2 * 33] * 32.f, s[3 * 33] * 32.f); o.y = pk4_fp8(s[4 * 33] * 32.f, s[5 * 33] * 32.f, s[6 * 33] * 32.f, s[7 * 33] * 32.f);
        const int nd = GUPERM ? ((n & 1) * 16 + (n >> 1)) : n;
        *(GAS u32x2*)(WT + (size_t)(n0 + nd) * K + k0 + 8 * c) = o; }
    LDS_WAIT(); asm volatile("" ::: "memory");
}
__device__ __forceinline__ void p0_item(Frame& F, LAS float* sil, LAS float* scr, int it) {
    constexpr int I_IN = (DM / 64) * (INC / 32), I_OUT = (DM / 64) * (DM / 32), I_GU1 = (DM / 64) * (GUW / 32), I_DN1 = (DM / 64) * (DM / 32);

        int r = it;
        if (r < 24 * MODP_KC) {
            const int nb = r % 24, kc = r / 24, n = nb * 256 + F.lane * 4;
            f32x4 a0 = {0.f, 0.f, 0.f, 0.f}, a1 = a0, a2 = a0;
            const float* wp = F.w_mod + (size_t)(kc * 128) * 6144 + n;
#pragma unroll 8
            for (int kk = 0; kk < 128; ++kk) { const f32x4 w = *(const f32x4*)(wp + (size_t)kk * 6144); const int k = kc * 128 + kk; a0 += w * sil[k]; a1 += w * sil[1024 + k]; a2 += w * sil[2048 + k]; }
            float* pp = F.modp + (size_t)kc * 3 * 6144 + n;
            *(f32x4*)(pp) = a0; *(f32x4*)(pp + 6144) = a1; *(f32x4*)(pp + 12288) = a2;
            return; } r -= 24 * MODP_KC;
        if (r < I_IN) { p0_transpose_item<false>(F.w_in, DM, INC, F.Win_t, scr, r, F.lane); return; } r -= I_IN;
        if (r < I_OUT) { p0_transpose_item<false>(F.w_out, DM, DM, F.Wout_t, scr, r, F.lane); return; } r -= I_OUT;
        if (r < NEXP * I_GU1) { const int e = r / I_GU1; p0_transpose_item_fp8<true>(F.w_gu + (size_t)e * DM * GUW, DM, GUW, (unsigned char*)F.Wgu_t + (size_t)e * GUW * DM, scr, r % I_GU1, F.lane); return; } r -= NEXP * I_GU1;
        { const int e = r / I_DN1; p0_transpose_item_fp8<false>(F.w_dn + (size_t)e * DM * DM, DM, DM, (unsigned char*)F.Wdn_t + (size_t)e * DM * DM, scr, r % I_DN1, F.lane); }
}
constexpr int P0_NITEMS = 24 * MODP_KC + (DM / 64) * (INC / 32) + (DM / 64) * (DM / 32) + NEXP * (DM / 64) * (GUW / 32) + NEXP * (DM / 64) * (DM / 32);
constexpr int P0_SPLIT = P0_NITEMS - 13920;
__device__ __forceinline__ void p0_tail(Frame& F) {
    LAS float* scr = (LAS float*)(F.lds + RING_OFF + F.wave * 16384);
    const int w = ((int)blockIdx.x - 82) * NWAVES + F.wave, NW = (F.G - 82) * NWAVES;
    for (int it = P0_SPLIT + w; it < P0_NITEMS; it += NW) p0_item(F, nullptr, scr, it);
}
__device__ __forceinline__ void p0_prologue(Frame& F) {
    LAS float* sil = (LAS float*)(F.lds + XTRA_OFF);
    for (int i = F.tid; i < 3072; i += 512) { const int v = i >> 10, k = i & 1023; const float cv = (v < 2) ? F.c[v * 1024 + k] : F.c_ctx[k]; sil[i] = cv / (1.f + __expf(-cv)); }
    __syncthreads();
    const int gw = F.vcu * NWAVES + F.wave, NGW = F.G * NWAVES;
    if (blockIdx.x == 0) for (int i = F.tid; i < 2048; i += 512) { const int pos = i >> 4, j = i & 15; double cr = 1.0, sr = 0.0, cb = ROPE_CS[2 * j], sb = ROPE_CS[2 * j + 1];
        for (int bit = 0; bit < 7; ++bit) { if ((pos >> bit) & 1) { const double t = cr * cb - sr * sb; sr = cr * sb + sr * cb; cr = t; } const double t2 = cb * cb - sb * sb; sb = 2.0 * cb * sb; cb = t2; }
        F.rope[2 * i] = (float)cr; F.rope[2 * i + 1] = (float)sr; }
    LAS float* scr = (LAS float*)(F.lds + RING_OFF + F.wave * 16384);
    constexpr int I_IN = (DM / 64) * (INC / 32), I_OUT = (DM / 64) * (DM / 32), I_GU1 = (DM / 64) * (GUW / 32), I_DN1 = (DM / 64) * (DM / 32);
    constexpr int NITEMS = 24 * MODP_KC + I_IN + I_OUT + NEXP * I_GU1 + NEXP * I_DN1;
    const int nsplit = (F.G == 256) ? P0_SPLIT : NITEMS;
    for (int it0 = gw; it0 < nsplit * RP(F, 0); it0 += NGW) { const int it = it0 % nsplit; p0_item(F, sil, scr, it); }
}
__device__ __forceinline__ void p1_norm(Frame& F) {
    LAS float* ml = (LAS float*)(F.lds + RING_OFF);
    for (int i = F.tid; i < 6144; i += 512) { const int v = i / 2048, j = i % 2048; float s = F.b_mod[j];
        for (int kc = 0; kc < MODP_KC; ++kc) s += F.modp[(size_t)(kc * 3 + v) * 6144 + j]; ml[i] = s; }
    for (int gi = blockIdx.x * 512 + F.tid; gi < 3 * 6144; gi += F.G * 512) { const int v = gi / 6144, j = gi % 6144; float s = F.b_mod[j];
        for (int kc = 0; kc < MODP_KC; ++kc) s += F.modp[(size_t)(kc * 3 + v) * 6144 + j]; F.modv[gi] = s; }
    __syncthreads();
    const int gw = F.vcu * NWAVES + F.wave, NGW = F.G * NWAVES;
    typedef unsigned u32x2 __attribute__((ext_vector_type(2)));
    for (int pp = gw; pp < (NROW / 2) * RP(F, 1); pp += NGW) { const int m0 = (pp % (NROW / 2)) * 2;
        f32x4 xv[2][4]; float s[2] = {0.f, 0.f}; int v[2];
#pragma unroll
        for (int q = 0; q < 2; ++q) { const int m = m0 + q; v[q] = m < SEQ ? 0 : (m < NTOK ? 1 : 2);
            const float* src = m < NTOK ? F.x + (size_t)m * DM : F.ctx + (size_t)(m - NTOK) * DM;
#pragma unroll
            for (int j = 0; j < 4; ++j) xv[q][j] = __builtin_nontemporal_load((const f32x4*)(src + 4 * F.lane + 256 * j)); }
#pragma unroll
        for (int q = 0; q < 2; ++q)
#pragma unroll
            for (int j = 0; j < 4; ++j) s[q] += (xv[q][j].x * xv[q][j].x + xv[q][j].y * xv[q][j].y) + (xv[q][j].z * xv[q][j].z + xv[q][j].w * xv[q][j].w);
#pragma unroll
        for (int q = 0; q < 2; ++q) { const int m = m0 + q; const float rstd = 1.0f / sqrtf(wave_sum(s[q]) * (1.f / DM) + NORM_EPS);
#pragma unroll
            for (int j = 0; j < 4; ++j) { const int col = 4 * F.lane + 256 * j; const f32x4 g = *(const f32x4*)(F.norm1_g + col);
                const f32x4 sh = *(const LAS f32x4*)(ml + v[q] * 2048 + col), sc = *(const LAS f32x4*)(ml + v[q] * 2048 + 1024 + col);
                const f32x4 y = (xv[q][j] * rstd * g) * (sc + 1.0f) + sh;
                *(u32x2*)(F.XN + (size_t)m * DM + col) = (u32x2){cvtpk(y.x, y.y), cvtpk(y.z, y.w)}; } }
    }
}

__device__ __forceinline__ float lam_value(Frame& F) {
    const float a = wave_sum(F.lq1[F.lane] * F.lk1[F.lane]), b = wave_sum(F.lq2[F.lane] * F.lk2[F.lane]);
    return __expf(a) - __expf(b) + 0.2f;
}
__device__ __forceinline__ void naive_diff_attn(Frame& F) {
    const float lam = lam_value(F);
    LAS float* X = (LAS float*)(F.lds + RING_OFF);
    LAS float* SS = X + 128 * 128;
    const int q = F.tid & 127, comp = (F.tid >> 7) & 1, vh = F.tid >> 8;
    for (int it = blockIdx.x; it < BATCH * 4 * (SEQ / 128); it += F.G) {
        const int b = it >> 8, h = (it >> 6) & 3, qb = it & 63; const int row = b * SEQ + qb * 128 + q;
        float qv[64], o[64];
#pragma unroll
        for (int c8 = 0; c8 < 8; ++c8) unpack8(*(const v4u*)(F.QA + (size_t)row * 512 + h * 128 + comp * 64 + c8 * 8), qv + 8 * c8);
#pragma unroll
        for (int e = 0; e < 64; ++e) o[e] = 0.f;
        float m = -1e30f, l = 0.f;
        const bf16* kp = F.KA + (size_t)(b * KVLEN) * 512 + h * 128 + comp * 64; const bf16* vp = F.VA + (size_t)(b * KVLEN) * 512 + h * 128 + vh * 64;
        for (int key = 0; key < KVLEN; ++key) {
            float s = 0.f;
#pragma unroll
            for (int c8 = 0; c8 < 8; ++c8) { float kf[8]; unpack8(*(const v4u*)(kp + (size_t)key * 512 + c8 * 8), kf);
#pragma unroll
                for (int i = 0; i < 8; ++i) s += qv[8 * c8 + i] * kf[i]; }
            if (s > m) { const float a = exp2f(m - s); l *= a;
#pragma unroll
                for (int e = 0; e < 64; ++e) o[e] *= a;
                m = s; }
            const float p = exp2f(s - m); l += p;
#pragma unroll
            for (int c8 = 0; c8 < 8; ++c8) { float vf[8]; unpack8(*(const v4u*)(vp + (size_t)key * 512 + c8 * 8), vf);
#pragma unroll
                for (int i = 0; i < 8; ++i) o[8 * c8 + i] += p * vf[i]; }
        }
        const float inv = 1.0f / l;
        __syncthreads();
        if (comp == 1) {
#pragma unroll
            for (int e = 0; e < 64; ++e) X[(vh * 64 + e) * 128 + q] = lam * o[e] * inv; }
        __syncthreads();
        if (comp == 0) { float ss = 0.f;
#pragma unroll
            for (int e = 0; e < 64; ++e) { o[e] = o[e] * inv - X[(vh * 64 + e) * 128 + q]; ss += o[e] * o[e]; }
            SS[vh * 128 + q] = ss; }
        __syncthreads();
        if (comp == 0) { const float r = 0.8f / sqrtf((SS[q] + SS[128 + q]) * (1.f / 128.f) + NORM_EPS);
            bf16* yp = F.Y + (size_t)row * DM + h * 128 + vh * 64; const float* sg = F.subln_g + vh * 64;
#pragma unroll
            for (int c8 = 0; c8 < 8; ++c8) { v4u w; w.x = cvtpk(o[8 * c8] * r * sg[8 * c8], o[8 * c8 + 1] * r * sg[8 * c8 + 1]); w.y = cvtpk(o[8 * c8 + 2] * r * sg[8 * c8 + 2], o[8 * c8 + 3] * r * sg[8 * c8 + 3]);
                w.z = cvtpk(o[8 * c8 + 4] * r * sg[8 * c8 + 4], o[8 * c8 + 5] * r * sg[8 * c8 + 5]); w.w = cvtpk(o[8 * c8 + 6] * r * sg[8 * c8 + 6], o[8 * c8 + 7] * r * sg[8 * c8 + 7]);
                *(v4u*)(yp + 8 * c8) = w; } }
    }
}
__device__ __forceinline__ void naive_win_attn(Frame& F) {
    for (int it = blockIdx.x; it < BATCH * 8 * (SEQ / 512); it += F.G) {
        const int b = it >> 7, h = (it >> 4) & 7, t = (it & 15) * 512 + F.tid, kv = h >> 2; const int row = b * SEQ + t;
        float qv[64], o[64];
#pragma unroll
        for (int c8 = 0; c8 < 8; ++c8) unpack8(*(const v4u*)(F.QB + (size_t)row * 512 + h * 64 + c8 * 8), qv + 8 * c8);
#pragma unroll
        for (int e = 0; e < 64; ++e) o[e] = 0.f;
        float m = F.sink[h] * LOG2E, l = 1.0f;
        const bf16* kp = F.KB + (size_t)(b * KVLEN) * 128 + kv * 64; const bf16* vp = F.VB + (size_t)(b * KVLEN) * 128 + kv * 64;
        for (int jj = 0; jj < 257 + CTXL; ++jj) {
            const int key = jj < 257 ? t - 128 + jj : SEQ + (jj - 257);
            if (jj < 257 && (key < 0 || key >= SEQ)) continue;
            float s = 0.f;
#pragma unroll
            for (int c8 = 0; c8 < 8; ++c8) { float kf[8]; unpack8(*(const v4u*)(kp + (size_t)key * 128 + c8 * 8), kf);
#pragma unroll
                for (int i = 0; i < 8; ++i) s += qv[8 * c8 + i] * kf[i]; }
            if (s > m) { const float a = exp2f(m - s); l *= a;
#pragma unroll
                for (int e = 0; e < 64; ++e) o[e] *= a;
                m = s; }
            const float p = exp2f(s - m); l += p;
#pragma unroll
            for (int c8 = 0; c8 < 8; ++c8) { float vf[8]; unpack8(*(const v4u*)(vp + (size_t)key * 128 + c8 * 8), vf);
#pragma unroll
                for (int i = 0; i < 8; ++i) o[8 * c8 + i] += p * vf[i]; }
        }
        const float inv = 1.0f / l; bf16* yp = F.Y + (size_t)row * DM + 512 + h * 64;
#pragma unroll
        for (int c8 = 0; c8 < 8; ++c8) { v4u w; w.x = cvtpk(o[8 * c8] * inv, o[8 * c8 + 1] * inv); w.y = cvtpk(o[8 * c8 + 2] * inv, o[8 * c8 + 3] * inv); w.z = cvtpk(o[8 * c8 + 4] * inv, o[8 * c8 + 5] * inv); w.w = cvtpk(o[8 * c8 + 6] * inv, o[8 * c8 + 7] * inv);
            *(v4u*)(yp + 8 * c8) = w; }
    }
}

#ifndef ATT_PP
#define ATT_PP 3
#endif
constexpr size_t WIN_VT_OFF = 16u << 20;
__device__ __forceinline__ void vt_item(const unsigned char* src, int rstride, unsigned char* drow0, int tile, int dg, int half) {
        unsigned outw[4][8];
#pragma unroll
        for (int i8 = 0; i8 < 8; ++i8) { const int kg = 8 * half + i8;
            const unsigned w0 = *(const unsigned*)(src + (size_t)(4 * kg + 0) * rstride), w1 = *(const unsigned*)(src + (size_t)(4 * kg + 1) * rstride), w2 = *(const unsigned*)(src + (size_t)(4 * kg + 2) * rstride), w3 = *(const unsigned*)(src + (size_t)(4 * kg + 3) * rstride);
            const unsigned a01 = __builtin_amdgcn_perm(w1, w0, 0x05010400u), c01 = __builtin_amdgcn_perm(w1, w0, 0x07030602u);
            const unsigned a23 = __builtin_amdgcn_perm(w3, w2, 0x05010400u), c23 = __builtin_amdgcn_perm(w3, w2, 0x07030602u);
            const int slot = ((i8 >> 1) & 3) + 4 * (i8 & 1);
            outw[0][slot] = __builtin_amdgcn_perm(a23, a01, 0x05040100u); outw[1][slot] = __builtin_amdgcn_perm(a23, a01, 0x07060302u);
            outw[2][slot] = __builtin_amdgcn_perm(c23, c01, 0x05040100u); outw[3][slot] = __builtin_amdgcn_perm(c23, c01, 0x07060302u); }
#pragma unroll
        for (int i = 0; i < 4; ++i) { unsigned char* dst = drow0 + (size_t)i * KVLEN + tile * 64 + 16 * half;
            *(v4u*)dst = (v4u){outw[i][0], outw[i][1], outw[i][2], outw[i][3]}; *(v4u*)(dst + 32) = (v4u){outw[i][4], outw[i][5], outw[i][6], outw[i][7]}; }
}
__device__ __forceinline__ void p3_vt_pass(Frame& F) {
    const unsigned char* V8 = (const unsigned char*)F.VA; unsigned char* VT8 = (unsigned char*)F.XG;
    const unsigned char* VB8 = (const unsigned char*)F.VB; unsigned char* VBT8 = (unsigned char*)F.XG + WIN_VT_OFF;
    const int gw = F.vcu * NWAVES + F.wave, NGW = F.G * NWAVES, dg = F.lane & 31, half = F.lane >> 5;
    constexpr int NTL = KVLEN / 64;
    for (int it = gw; it < 10 * NTL; it += NGW) {
        if (it < 8 * NTL) { const int bh = it / NTL, tile = it % NTL, b = bh >> 2, h = bh & 3;
            vt_item(V8 + ((size_t)(b * KVLEN + tile * 64)) * 512 + h * 128 + 4 * dg, 512, VT8 + ((size_t)(bh * 128 + 4 * dg)) * KVLEN, tile, dg, half); }
        else { const int b = (it - 8 * NTL) / NTL, tile = it % NTL;
            vt_item(VB8 + ((size_t)(b * KVLEN + tile * 64)) * 128 + 4 * dg, 128, VBT8 + ((size_t)(b * 128 + 4 * dg)) * KVLEN, tile, dg, half); }
    }
}
__device__ __forceinline__ void diff_unit(Frame& F, int b, int h, int qb, float lam) {
    using namespace at2;
    const int wid = F.wave, lane = F.lane, r32 = lane & 31, hi = lane >> 5, qblk = wid >> 1, comp = wid & 1;
    const int row0 = b * SEQ + qb * 128 + qblk * 32;
    UnitArgs8 a; a.Q = (const unsigned char*)F.QA + (size_t)row0 * 512 + h * 128 + comp * 64;
    a.K = (const unsigned char*)F.KA + (size_t)(b * KVLEN) * 512 + h * 128; a.VT = (const unsigned char*)F.XG + (size_t)((b * 4 + h) * 128) * KVLEN; a.comp = comp; a.ldk = 512; a.vdoff = 0; a.q0 = 0; a.ks = 0;
    f32x16 o[4]; o[0] = f32x16{}; o[1] = f32x16{}; o[2] = f32x16{}; o[3] = f32x16{};
    float m; f32x16 ol = f32x16{};
    AT_LAS char* lds = (AT_LAS char*)F.lds;
    attn_tiles_f8<true>(a, lds, F.tid, wid, lane, o, ol, m);
    float rli[16];
#pragma unroll
    for (int r = 0; r < 16; ++r) rli[r] = __builtin_amdgcn_rcpf(ol[r]);
    __syncthreads();
    AT_LAS float* XD = (AT_LAS float*)lds + qblk * 32 * XROW;
    if (comp == 1) {
#pragma unroll
        for (int r = 0; r < 16; ++r)
#pragma unroll
            for (int d0 = 0; d0 < 4; ++d0) XD[crow(r, hi) * XROW + d0 * 32 + r32] = lam * (o[d0][r] * rli[r]); }
    __syncthreads();
    if (comp == 0) {
#pragma unroll
        for (int r = 0; r < 16; ++r)
#pragma unroll
            for (int d0 = 0; d0 < 4; ++d0) { const int idx = crow(r, hi) * XROW + d0 * 32 + r32; XD[idx] = o[d0][r] * rli[r] - XD[idx]; }
        asm volatile("s_waitcnt lgkmcnt(0)" ::: "memory");
        const int row = lane >> 1, half = lane & 1;
        f32x4 v[16]; float ss = 0.f;
#pragma unroll
        for (int i = 0; i < 16; ++i) { v[i] = *(const AT_LAS f32x4*)(XD + row * XROW + half * 64 + 4 * i); ss += (v[i].x * v[i].x + v[i].y * v[i].y) + (v[i].z * v[i].z + v[i].w * v[i].w); }
        ss += __shfl_xor(ss, 1);
        const float rs = 0.8f / sqrtf(ss * (1.f / 128.f) + NORM_EPS);
        bf16* yp = F.Y + (size_t)(row0 + row) * DM + h * 128 + half * 64; const float* sg = F.subln_g + half * 64;
#pragma unroll
        for (int c8 = 0; c8 < 8; ++c8) { const f32x4 g0 = *(const f32x4*)(sg + 8 * c8), g1 = *(const f32x4*)(sg + 8 * c8 + 4); const f32x4 x0 = v[2 * c8] * rs * g0, x1 = v[2 * c8 + 1] * rs * g1;
            v4u w; w.x = cvtpk(x0.x, x0.y); w.y = cvtpk(x0.z, x0.w); w.z = cvtpk(x1.x, x1.y); w.w = cvtpk(x1.z, x1.w); *(v4u*)(yp + 8 * c8) = w; }
    }
    __syncthreads();
}
__device__ __forceinline__ void win_unit(Frame& F, int b, int j32) {
    using namespace at2;
    const int wid = F.wave, lane = F.lane, r32 = lane & 31, hi = lane >> 5, h = wid, kv = h >> 2;
    const int t0 = 32 * j32, row0 = b * SEQ + t0;
    UnitArgs8 a; a.Q = (const unsigned char*)F.QB + (size_t)row0 * 512 + h * 64;
    a.K = (const unsigned char*)F.KB + (size_t)(b * KVLEN) * 128; a.VT = (const unsigned char*)F.XG + WIN_VT_OFF + (size_t)(b * 128) * KVLEN; a.comp = kv; a.ldk = 128; a.vdoff = kv * 4096; a.q0 = t0;
    { const int st = t0 - 128; int ks = st < 0 ? 0 : (st & ~63); if (ks > SEQ - 384) ks = SEQ - 384; a.ks = ks; }
    f32x16 o[2]; o[0] = f32x16{}; o[1] = f32x16{};
    float m; f32x16 ol = f32x16{};
    AT_LAS char* lds = (AT_LAS char*)F.lds;
    attn_tiles_f8<false>(a, lds, F.tid, wid, lane, o, ol, m);
    AT_LAS float* li_l = (AT_LAS float*)(lds + AT_WS3_OFF) + wid * 64;
    if (hi == 0) li_l[r32] = __builtin_amdgcn_exp2f(F.sink[h] * LOG2E - m);
    asm volatile("s_waitcnt lgkmcnt(0)" ::: "memory");
    float rli[16];
#pragma unroll
    for (int r = 0; r < 16; ++r) rli[r] = __builtin_amdgcn_rcpf(ol[r] + li_l[crow(r, hi)]);
    __syncthreads();
    AT_LAS float* XD = (AT_LAS float*)lds + wid * 32 * XROWW;
#pragma unroll
    for (int r = 0; r < 16; ++r)
#pragma unroll
        for (int d0 = 0; d0 < 2; ++d0) XD[crow(r, hi) * XROWW + d0 * 32 + r32] = o[d0][r] * rli[r];
    asm volatile("s_waitcnt lgkmcnt(0)" ::: "memory");
    const int row = lane >> 1, half = lane & 1;
    bf16* yp = F.Y + (size_t)(row0 + row) * DM + 512 + h * 64 + half * 32;
#pragma unroll
    for (int c8 = 0; c8 < 4; ++c8) { const f32x4 x0 = *(const AT_LAS f32x4*)(XD + row * XROWW + half * 32 + 8 * c8), x1 = *(const AT_LAS f32x4*)(XD + row * XROWW + half * 32 + 8 * c8 + 4);
        v4u w; w.x = cvtpk(x0.x, x0.y); w.y = cvtpk(x0.z, x0.w); w.z = cvtpk(x1.x, x1.y); w.w = cvtpk(x1.z, x1.w); *(v4u*)(yp + 8 * c8) = w; }
    __syncthreads();
}
__device__ __forceinline__ void p3_attention(Frame& F) {
    const float lam = lam_value(F);
#ifndef NO_DIFF
#pragma unroll 1
    for (int U = F.vcu * 2; U < BATCH * 4 * (SEQ / 128) * RP(F, 3); U += 2 * F.G)
#pragma unroll 1
        for (int i = 0; i < 2; ++i) { const int u = (U + i) % 512; diff_unit(F, u >> 8, (u >> 6) & 3, u & 63, lam); }
#endif
#ifndef NO_WIN
#pragma unroll 1
    for (int W = F.vcu * 2; W < BATCH * (SEQ / 32) * RP(F, 3); W += 2 * F.G)
#pragma unroll 1
        for (int i = 0; i < 2; ++i) { const int w = (W + i) % 512; win_unit(F, w >> 8, w & 255); }
#endif
}

__device__ __forceinline__ unsigned long long wave_max64(unsigned long long k) {
#pragma unroll
    for (int o = 1; o < 64; o <<= 1) { const unsigned lo = __shfl_xor((unsigned)k, o), hi = __shfl_xor((unsigned)(k >> 32), o); const unsigned long long t = ((unsigned long long)hi << 32) | lo; k = t > k ? t : k; }
    return k;
}
__device__ __forceinline__ void p5a_route(Frame& F) {
    const int npass = RP(F, 5);
    LAS float* WRT = (LAS float*)(F.lds + RING_OFF);
    LAS int* lcnt = (LAS int*)(F.lds + XTRA_OFF); LAS int* lbase = lcnt + 32; LAS int* le = lcnt + 64; LAS int* lrk = le + 256;
    for (int idx = F.tid; idx < 32768; idx += 512) { const int k = idx >> 5, e = idx & 31; WRT[e * 1024 + k] = F.w_router[idx]; }
    gu32* gcnt = F.ctl + CW_CNT;
    typedef unsigned u32x2 __attribute__((ext_vector_type(2)));
    for (int cc = blockIdx.x; cc < (NTOK / 64) * npass; cc += F.G) { const int chunk = cc % (NTOK / 64); const bool dry = cc < (NTOK / 64) * (npass - 1);
        if (F.tid < 32) lcnt[F.tid] = 0;
        __syncthreads();
        const int b = (chunk * 64) >> 13; const float* mv = F.modv + b * 6144;
#pragma unroll 1
        for (int grp = 0; grp < 2; ++grp) {
            const int row0 = chunk * 64 + F.wave * 8 + grp * 4;
            f32x4 xv[4][4]; float ss[4];
#pragma unroll
            for (int r = 0; r < 4; ++r) { float s = 0.f;
#pragma unroll
                for (int j = 0; j < 4; ++j) { { const u32x2 t_ = *(const u32x2*)((const bf16*)F.X1 + (size_t)(row0 + r) * DM + 4 * F.lane + 256 * j); xv[r][j] = (f32x4){bflo(t_.x), bfhi(t_.x), bflo(t_.y), bfhi(t_.y)}; } s += (xv[r][j].x * xv[r][j].x + xv[r][j].y * xv[r][j].y) + (xv[r][j].z * xv[r][j].z + xv[r][j].w * xv[r][j].w); }
                ss[r] = 1.0f / sqrtf(wave_sum(s) * (1.f / DM) + NORM_EPS); }
#pragma unroll
            for (int j = 0; j < 4; ++j) { const int col = 4 * F.lane + 256 * j; const f32x4 g = *(const f32x4*)(F.norm2_g + col), sh = *(const f32x4*)(mv + 3072 + col), sc = *(const f32x4*)(mv + 4096 + col);
                const f32x4 ga = g * (sc + 1.0f);
#pragma unroll
                for (int r = 0; r < 4; ++r) { xv[r][j] = (xv[r][j] * ss[r]) * ga + sh;
                    *(unsigned*)((unsigned char*)F.XN + (size_t)(row0 + r) * DM + col) = pk4_fp8(xv[r][j].x, xv[r][j].y, xv[r][j].z, xv[r][j].w); } }
            float logit[4] = {0.f, 0.f, 0.f, 0.f};
            const bool up = (F.lane & 32) != 0, up2 = (F.lane & 16) != 0; const int myg = (F.lane >> 1) & 7;
#pragma unroll 1
            for (int g = 0; g < 8; ++g) {
                float a[4][4];
#pragma unroll
                for (int r = 0; r < 4; ++r)
#pragma unroll
                    for (int ee = 0; ee < 4; ++ee) a[r][ee] = 0.f;
                const LAS float* wb = WRT + g * 4096 + 4 * F.lane;
#pragma unroll
                for (int ee = 0; ee < 4; ++ee)
#pragma unroll
                    for (int j = 0; j < 4; ++j) { const f32x4 w = *(const LAS f32x4*)(wb + ee * 1024 + 256 * j);
#pragma unroll
                        for (int r = 0; r < 4; ++r) a[r][ee] += (xv[r][j].x * w.x + xv[r][j].y * w.y) + (xv[r][j].z * w.z + xv[r][j].w * w.w); }
#pragma unroll
                for (int r = 0; r < 4; ++r) {
                    const float v0 = (up ? a[r][2] : a[r][0]) + __shfl_xor(up ? a[r][0] : a[r][2], 32);
                    const float v1 = (up ? a[r][3] : a[r][1]) + __shfl_xor(up ? a[r][1] : a[r][3], 32);
                    float v = (up2 ? v1 : v0) + __shfl_xor(up2 ? v0 : v1, 16);
                    v += __shfl_xor(v, 1); v += __shfl_xor(v, 2); v += __shfl_xor(v, 4); v += __shfl_xor(v, 8);
                    if (myg == g) logit[r] = v;
                }
            }
            const int e = 4 * myg + (up ? 2 : 0) + (up2 ? 1 : 0);
            const float br = F.b_router[e];
#pragma unroll
            for (int r = 0; r < 4; ++r) {
                unsigned u = __float_as_uint(logit[r] + br); u = (u & 0x80000000u) ? ~u : (u | 0x80000000u);
                unsigned long long key = ((unsigned long long)u << 32) | (unsigned)(31 - e);
                int ek[4]; float vk[4];
#pragma unroll
                for (int k = 0; k < 4; ++k) { const unsigned long long mx = wave_max64(key); ek[k] = 31 - (int)(mx & 31u); unsigned uu = (unsigned)(mx >> 32); uu = (uu & 0x80000000u) ? (uu & 0x7fffffffu) : ~uu; vk[k] = __uint_as_float(uu);
                    if (e == ek[k]) key = 0ull; }
                const float p1 = __expf(vk[1] - vk[0]), p2 = __expf(vk[2] - vk[0]), p3 = __expf(vk[3] - vk[0]); const float inv = 1.0f / (1.0f + p1 + p2 + p3);
                if (F.lane < 4 && !dry) { const int k = F.lane; const int ee = k == 0 ? ek[0] : (k == 1 ? ek[1] : (k == 2 ? ek[2] : ek[3])); const float gg = (k == 0 ? 1.0f : (k == 1 ? p1 : (k == 2 ? p2 : p3))) * inv;
                    const int rl = F.wave * 8 + grp * 4 + r; const int rank = __hip_atomic_fetch_add(lcnt + ee, 1, __ATOMIC_RELAXED, __HIP_MEMORY_SCOPE_WORKGROUP);
                    le[rl * 4 + k] = ee; lrk[rl * 4 + k] = rank; F.rgate[(size_t)(row0 + r) * 4 + k] = gg; }
            }
        }
        __syncthreads();
        if (F.tid < 32 && !dry) lbase[F.tid] = (int)__hip_atomic_fetch_add(gcnt + F.tid, (unsigned)lcnt[F.tid], __ATOMIC_RELAXED, __HIP_MEMORY_SCOPE_AGENT);
        __syncthreads();
        if (F.tid < 256 && !dry) { const int row = chunk * 64 + (F.tid >> 2), k = F.tid & 3; const int ee = le[F.tid]; const int slot = lbase[ee] + lrk[F.tid]; F.re[(size_t)row * 4 + k] = ee; F.rslot[(size_t)row * 4 + k] = slot; F.elist[ee * NTOK + slot] = row; }
        __syncthreads();
    }
}
__device__ __forceinline__ int expert_tables(Frame& F, LAS int* pst, LAS int* pexp) {
    LAS int* npan = pst + 40; LAS int* cntT = pexp + 320;
    if (F.tid == 0) { int P = 0; for (int e = 0; e < NEXP; ++e) { const int cnt = (int)__hip_atomic_load(F.ctl + CW_CNT + e, __ATOMIC_RELAXED, __HIP_MEMORY_SCOPE_AGENT); cntT[e] = cnt; pst[e] = P * 256; const int np = (cnt + 255) >> 8; for (int i = 0; i < np; ++i) pexp[P + i] = e; P += np; } pst[32] = P * 256; npan[0] = P; }
    __syncthreads();
    return npan[0];
}
__device__ __forceinline__ void p5b_scatter(Frame& F) {
    LAS int* pst = (LAS int*)(F.lds + XTRA_OFF); LAS int* pexp = pst + 64;
    (void)expert_tables(F, pst, pexp);
    const int gw = F.vcu * NWAVES + F.wave, NGW = F.G * NWAVES;
    for (int rr = gw; rr < NTOK * RP(F, 6); rr += NGW) { const int row = rr % NTOK;
        const v4u a = *(const v4u*)(F.XN + (size_t)row * DM + 8 * F.lane), b = *(const v4u*)(F.XN + (size_t)row * DM + 512 + 8 * F.lane);
#pragma unroll
        for (int k = 0; k < 4; ++k) { const int e = F.re[(size_t)row * 4 + k]; const int pos = pst[e] + F.rslot[(size_t)row * 4 + k];
            if (F.lane == 0) F.rpos[(size_t)row * 4 + k] = pos;
            *(v4u*)(F.XG + (size_t)pos * DM + 8 * F.lane) = a; *(v4u*)(F.XG + (size_t)pos * DM + 512 + 8 * F.lane) = b; }
    }
}
__device__ __forceinline__ void p8_final(Frame& F) {
    LAS int* pst = (LAS int*)(F.lds + XTRA_OFF); LAS int* pexp = pst + 64;
    (void)expert_tables(F, pst, pexp);
    const int gw = F.vcu * NWAVES + F.wave, NGW = F.G * NWAVES;
    typedef unsigned u32x2 __attribute__((ext_vector_type(2)));
    for (int pp = gw; pp < (NTOK / 2) * RP(F, 9); pp += NGW) { const int row0 = (pp % (NTOK / 2)) * 2;
        const float* g2 = F.modv + (row0 >> 13) * 6144 + 5120;
        int pos[2][4]; float gt[2][4];
#pragma unroll
        for (int q = 0; q < 2; ++q)
#pragma unroll
            for (int k = 0; k < 4; ++k) { const size_t ix = (size_t)(row0 + q) * 4 + k; pos[q][k] = pst[F.re[ix]] + F.rslot[ix]; gt[q][k] = F.rgate[ix]; }
        f32x4 xv[2][4]; unsigned yv[2][4][4];
#pragma unroll
        for (int q = 0; q < 2; ++q)
#pragma unroll
            for (int j = 0; j < 4; ++j) { const int col = 4 * F.lane + 256 * j; { const u32x2 t_ = *(const u32x2*)((const bf16*)F.X1 + (size_t)(row0 + q) * DM + col); xv[q][j] = (f32x4){bflo(t_.x), bfhi(t_.x), bflo(t_.y), bfhi(t_.y)}; }
#pragma unroll
                for (int k = 0; k < 4; ++k) yv[q][j][k] = *(const unsigned*)((const unsigned char*)F.Y2 + (size_t)pos[q][k] * DM + col); }
#pragma unroll
        for (int q = 0; q < 2; ++q) { float s = 0.f;
#pragma unroll
            for (int j = 0; j < 4; ++j) { const int col = 4 * F.lane + 256 * j; f32x4 a = {0.f, 0.f, 0.f, 0.f};
#pragma unroll
                for (int k = 0; k < 4; ++k) { const unsigned y = yv[q][j][k]; const auto lo2 = __builtin_amdgcn_cvt_pk_f32_fp8((int)y, false), hi2 = __builtin_amdgcn_cvt_pk_f32_fp8((int)y, true); a += (f32x4){lo2[0], lo2[1], hi2[0], hi2[1]} * gt[q][k]; }
                xv[q][j] = xv[q][j] + *(const f32x4*)(g2 + col) * a;
                s += (xv[q][j].x * xv[q][j].x + xv[q][j].y * xv[q][j].y) + (xv[q][j].z * xv[q][j].z + xv[q][j].w * xv[q][j].w); }
            const float rstd = 1.0f / sqrtf(wave_sum(s) * (1.f / DM) + NORM_EPS);
#pragma unroll
            for (int j = 0; j < 4; ++j) { const int col = 4 * F.lane + 256 * j; __builtin_nontemporal_store(xv[q][j] * rstd * *(const f32x4*)(F.final_g + col), (f32x4*)(F.out + (size_t)(row0 + q) * DM + col)); } }
    }
}

#ifndef FAST_GEMM
#define FAST_GEMM 1
#endif
#ifndef FAST_ATTN
#define FAST_ATTN 1
#endif
constexpr int N_PHASES = 10;
struct Args { const float* in[23]; float* out; unsigned char* ws; int ph_lo, ph_hi, use_bar, pad; };
__global__ void __launch_bounds__(NWAVES * 64, 2) mk_fwd(Args args) {
    extern __shared__ __attribute__((aligned(16))) unsigned char lds[];
    Frame F;
    F.lds = (LAS unsigned char*)lds; F.MISC = (volatile LAS unsigned*)(F.lds + MISC_OFF);
    F.tid = threadIdx.x; F.lane = F.tid & 63; F.wave = __builtin_amdgcn_readfirstlane(F.tid >> 6);
    F.probe = args.pad; F.G = gridDim.x; { const int bx = blockIdx.x; F.vcu = (F.G % 8 == 0) ? (bx % 8) * (F.G / 8) + bx / 8 : bx; }
    unsigned char* ws = args.ws;
    F.ctl = (gu32*)(ws + WS_CTL);
    F.x = args.in[0]; F.c = args.in[1]; F.ctx = args.in[2]; F.c_ctx = args.in[3]; F.w_mod = args.in[4]; F.b_mod = args.in[5]; F.norm1_g = args.in[6]; F.w_in = args.in[7];
    F.lq1 = args.in[8]; F.lk1 = args.in[9]; F.lq2 = args.in[10]; F.lk2 = args.in[11]; F.subln_g = args.in[12]; F.sink = args.in[13]; F.w_out = args.in[14]; F.norm2_g = args.in[15];
    F.w_router = args.in[16]; F.b_router = args.in[17]; F.w_gu = args.in[18]; F.b_gu = args.in[19]; F.w_dn = args.in[20]; F.b_dn = args.in[21]; F.final_g = args.in[22];
    F.out = args.out;
    F.modp = (float*)(ws + WS_MODP); F.modv = (float*)(ws + WS_MODV); F.rope = (float*)(ws + WS_ROPE); F.X1 = (float*)(ws + WS_X1);
    F.elist = (int*)(ws + WS_ELIST); F.re = (int*)(ws + WS_ROUTE); F.rslot = F.re + NTOK * 4; F.rgate = (float*)(F.rslot + NTOK * 4); F.rpos = (int*)(F.rgate + NTOK * 4);
    F.Win_t = (bf16*)(ws + WS_WIN); F.Wout_t = (bf16*)(ws + WS_WOUT); F.Wgu_t = (bf16*)(ws + WS_WGU); F.Wdn_t = (bf16*)(ws + WS_WDN);
    F.XN = (bf16*)(ws + WS_XN); F.QA = (bf16*)(ws + WS_QA); F.KA = (bf16*)(ws + WS_KA); F.VA = (bf16*)(ws + WS_VA); F.QB = (bf16*)(ws + WS_QB); F.KB = (bf16*)(ws + WS_KB); F.VB = (bf16*)(ws + WS_VB);
    F.Y = (bf16*)(ws + WS_Y); F.XG = (bf16*)(ws + WS_XG); F.H = (bf16*)(ws + WS_H); F.Y2 = (bf16*)(ws + WS_Y2);
    for (int u = F.tid; u < (LDS_BYTES - LDSCTL_OFF) / 4; u += NWAVES * 64) ((LAS unsigned*)(F.lds + LDSCTL_OFF))[u] = 0u;
    __syncthreads();
    XcdBarrier bar; bar.bar = (unsigned*)(F.ctl + CW_BAR); bar.x = 0; bar.st = nullptr;
    if (args.use_bar) bar = xcd_barrier_post((unsigned*)(F.ctl + CW_BAR), F.MISC + 8);
    const int lo = args.ph_lo, hi = args.ph_hi;
#ifndef PH_MASK
#define PH_MASK 0x3ff
#endif
#define IN(k) (((PH_MASK >> (k)) & 1) && lo <= (k) && (k) < hi)
#ifndef REP_MASK
#define REP_MASK 0
#endif
#define SEAM(k) do { if (IN(k) && IN((k) + 1)) { if (args.use_bar) { xcd_barrier(bar); if (args.pad & 0x10000) { xcd_barrier(bar); xcd_barrier(bar); } } } else { __syncthreads(); } } while (0)

    if (IN(0)) { p0_prologue(F); } SEAM(0);
    if (IN(1)) { p1_norm(F); } SEAM(1);
    if (IN(2)) {
        EpiQKV E{F.QA, F.KA, F.VA, F.QB, F.KB, F.VB, F.rope};
#if FAST_GEMM
        pg8::Gemm g{F.XN, F.Win_t, NROW, INC, DM}; RepOrder S; S.init(NROW, INC, F.G, (int)blockIdx.x); S.rep = RP(F, 2);
        EpiQKVFast EA{F.QA, F.KA, F.VA, F.QB, F.KB, F.VB, F.rope};
        pg8::gemm_phase<EpiQKVFast, RepOrder, true, true>(F.lds + RING_OFF, g, S, EA);
        if (F.G == 256 && blockIdx.x >= 82) p0_tail(F);
#else
        naive_gemm(F, F.XN, NROW / 128, INC, DM, DenseSel{F.Win_t}, E);
#endif
    } SEAM(2);
#if FAST_ATTN == 1
    if (IN(3)) { p3_vt_pass(F); if (args.use_bar) xcd_barrier(bar); else __syncthreads(); p3_attention(F); } SEAM(3);
#else
    if (IN(3)) { naive_diff_attn(F); __syncthreads(); naive_win_attn(F); } SEAM(3);
#endif
    if (IN(4)) {
        EpiOut E{F.x, F.modv, F.X1};
#if FAST_GEMM
        pg8::Gemm g{F.Y, F.Wout_t, NTOK, DM, DM}; RepOrder S; S.init(NTOK, DM, F.G, (int)blockIdx.x); S.rep = RP(F, 4);
        EpiAdapt<EpiOut, 0> EA{E};
        pg8::gemm_phase<EpiAdapt<EpiOut, 0>, RepOrder, true, true>(F.lds + RING_OFF, g, S, EA);
#else
        naive_gemm(F, F.Y, NTOK / 128, DM, DM, DenseSel{F.Wout_t}, E);
#endif
    } SEAM(4);
    if (IN(5)) { p5a_route(F); } SEAM(5);
    if (IN(7)) {
        LAS int* pst = (LAS int*)(F.lds + XTRA_OFF); LAS int* pexp = pst + 64; LAS int* cntT = pexp + 320; LAS int* tokT = (LAS int*)(F.lds + XTRA_OFF + 2048);
        const int NP = expert_tables(F, pst, pexp);
        EpiGU E{(unsigned char*)F.H, F.b_gu};
        GroupedOrder S{GUW / 256, NP, F.G, (int)blockIdx.x, pexp, RP(F, 7), tokT};
        { const int R = S.rounds();
          for (int i0 = 0; i0 < R; i0 += 2) { const int i = i0 + (F.tid >> 8), r = F.tid & 255; pg8::Unit u; GroupedOrder S1 = S; S1.rep = 1;
              if (i < R && S1.next(i, u)) { const int e = pexp[u.pm], sl = u.pm * 256 - pst[e] + r; tokT[i * 256 + r] = sl < cntT[e] ? F.elist[e * NTOK + sl] : 0; } }
          __syncthreads(); }
#if FAST_GEMM
        pg8::Gemm g{F.XN, F.Wgu_t, NP * 256, GUW, DM / 2};
        EpiAdapt<EpiGU, GUW / 256> EA{E};
        pg8::gemm_phase<EpiAdapt<EpiGU, GUW / 256>, GroupedOrder, true, true, true, true>(F.lds + RING_OFF, g, S, EA);
#else
#error "the naive GEMM path has no gather"
#endif
    } SEAM(7);
    if (IN(8)) {
        LAS int* pst = (LAS int*)(F.lds + XTRA_OFF); LAS int* pexp = pst + 64;
        const int NP = expert_tables(F, pst, pexp);
        EpiDN E{F.Y2, F.b_dn};
#if FAST_GEMM
        pg8::Gemm g{F.H, F.Wdn_t, NP * 256, DM, DM / 2}; GroupedOrder S{DM / 256, NP, F.G, (int)blockIdx.x, pexp, RP(F, 8), nullptr};
        EpiAdaptP<EpiDN, DM / 256> EA{E};
        pg8::gemm_phase<EpiAdaptP<EpiDN, DM / 256>, GroupedOrder, true, true, false, true>(F.lds + RING_OFF, g, S, EA);
#else
        naive_gemm(F, F.H, NP * 2, DM, DM, GroupSel{F.Wdn_t, pexp, DM, DM}, E);
#endif
    } SEAM(8);
    if (IN(9)) { p8_final(F); }
#undef IN
#undef SEAM
}

#ifndef N_LAUNCH_MODE
#define N_LAUNCH_MODE 0
#endif
extern "C" void kernel_launch(void* const* d_in, const int* in_sizes, int n_in, void* d_out, int out_size, void* d_ws, size_t ws_size, hipStream_t stream) {
    static int grid = 0;
    if (grid == 0) {
        if (n_in != 23 || in_sizes[0] != NTOK * DM || out_size != NTOK * DM || ws_size < WS_END) { fprintf(stderr, "kernel_launch: unexpected shapes (n_in %d, in0 %d, out %d, ws %zu); nothing launched\n", n_in, n_in > 0 ? in_sizes[0] : -1, out_size, ws_size); grid = -1; return; }
        int dev = 0, cus = 0, per_cu = 0;
        if (hipGetDevice(&dev) != hipSuccess || hipDeviceGetAttribute(&cus, hipDeviceAttributeMultiprocessorCount, dev) != hipSuccess) { grid = -1; return; }
        if (hipFuncSetAttribute((const void*)mk_fwd, hipFuncAttributeMaxDynamicSharedMemorySize, LDS_BYTES) != hipSuccess) { fprintf(stderr, "kernel_launch: hipFuncSetAttribute failed\n"); grid = -1; return; }
        if (hipOccupancyMaxActiveBlocksPerMultiprocessor(&per_cu, (const void*)mk_fwd, NWAVES * 64, LDS_BYTES) != hipSuccess || per_cu < 1) fprintf(stderr, "kernel_launch: note: occupancy query reports %d\n", per_cu);
        (void)hipGetLastError();
        grid = cus;
    }
    if (grid < 0) return;
    if (hipMemsetAsync((char*)d_ws + WS_CTL, 0, CTL_ZERO_BYTES, stream) != hipSuccess) { fprintf(stderr, "kernel_launch: memset failed\n"); return; }
    Args a{};
    for (int i = 0; i < 23; ++i) a.in[i] = (const float*)d_in[i];
    a.out = (float*)d_out; a.ws = (unsigned char*)d_ws; a.pad = REP_MASK;
#if N_LAUNCH_MODE == 0
    a.ph_lo = 0; a.ph_hi = N_PHASES; a.use_bar = 1;
    hipLaunchKernelGGL(mk_fwd, dim3(grid), dim3(NWAVES * 64), LDS_BYTES, stream, a);
#else
    for (int p = 0; p < N_PHASES; ++p) { a.ph_lo = p; a.ph_hi = p + 1; a.use_bar = 0; hipLaunchKernelGGL(mk_fwd, dim3(grid), dim3(NWAVES * 64), LDS_BYTES, stream, a); }
#endif
}
```

```cpp
#include <hip/hip_runtime.h>
#include <cstdio>
#include <cstdint>
namespace pg8 {
#define PG8_LAS __attribute__((address_space(3)))
typedef unsigned short bf16_t;
typedef short bf16x8 __attribute__((ext_vector_type(8)));
typedef float f32x4 __attribute__((ext_vector_type(4)));
typedef unsigned u32x4 __attribute__((ext_vector_type(4)));
constexpr int BM = 256, BK = 64, HALF = 128, HTB = HALF * BK * 2  , STAGE_BYTES = 8 * HTB, NXCD = 8, WGM = 8;

__host__ __device__ __forceinline__ int lds_byte(int r, int c) { const int st = (r >> 4) * 2 + (c >> 5), rr = r & 15, cc = c & 31, ob = rr * 64 + cc * 2; return st * 1024 + (ob ^ (((ob >> 9) & 1) << 5)); }
__host__ __device__ __forceinline__ void stage_rc(int b, int& R, int& C) { const int st = b / 1024, sb = b % 1024, swz = sb ^ (((sb >> 9) & 1) << 5); R = (st >> 1) * 16 + swz / 64; C = (st & 1) * 32 + (swz % 64) / 2; }
__host__ __device__ __forceinline__ int perm32(int rho) { const int n = rho >> 4, i = rho & 15; return 8 * (i >> 2) + 4 * n + (i & 3); }

struct Unit { int pm, pn; };
struct Gemm { const bf16_t* A; const bf16_t* Bt; int M, N, K; };

struct StaticOrder {
    int nM, nN, nwg, G, c;
    __host__ __device__ void init(int M, int N, int G_, int c_) { nM = M / BM; nN = N / BM; nwg = nM * nN; G = G_; c = c_; }
    __host__ __device__ bool next(int i, Unit& u) const {
        const long L = (long)i * G + c; if (L >= nwg) return false;
        int wgid = (int)L; { const int q = nwg / NXCD, r = nwg % NXCD, xcd = wgid % NXCD, off = wgid / NXCD; wgid = (xcd < r ? xcd * (q + 1) : r * (q + 1) + (xcd - r) * q) + off; }
        const int nig = WGM * nN, gid = wgid / nig, fm = gid * WGM, gsz = (nM - fm) < WGM ? (nM - fm) : WGM;
        u.pm = fm + ((wgid % nig) % gsz); u.pn = (wgid % nig) / gsz; return true;
    }
    __device__ __forceinline__ void a_ready(const Unit&) const {}
    __device__ __forceinline__ void done(const Unit&) const {}
};

__device__ __forceinline__ unsigned cvt_pk_bf16(float lo, float hi) { unsigned r; asm volatile("v_cvt_pk_bf16_f32 %0, %1, %2" : "=v"(r) : "v"(lo), "v"(hi)); return r; }
typedef float f32x2 __attribute__((ext_vector_type(2)));
typedef int i32x4 __attribute__((ext_vector_type(4))); typedef int i32x8 __attribute__((ext_vector_type(8)));
__device__ __forceinline__ i32x8 cat8(bf16x8 a, bf16x8 b) { const i32x4 x = __builtin_bit_cast(i32x4, a), y = __builtin_bit_cast(i32x4, b); return __builtin_shufflevector(x, y, 0, 1, 2, 3, 4, 5, 6, 7); }
template <class Epi, class Sched, bool ALIGN_EPI = false, bool SP2 = false, bool GATHER = false, bool FP8 = false>
__device__ __forceinline__ void gemm_phase(PG8_LAS unsigned char* lds, const Gemm g, const Sched& S, const Epi& E) {
    const int tid = threadIdx.x, wid = __builtin_amdgcn_readfirstlane(tid >> 6), lane = tid & 63, wr = wid >> 2, wc = wid & 3, fr = lane & 15, fq = lane >> 4;
    const int K = g.K, nt = K / BK;
    unsigned voffA[2], voffB[2]; int RA[2]; unsigned CA2[2];
#pragma unroll
    for (int i = 0; i < 2; ++i) { int R, C; stage_rc(tid * 16 + i * 8192, R, C); const int Rb = Epi::PERM ? ((R & ~31) + perm32(R & 31)) : R;
        voffA[i] = (unsigned)(R * K + C) * 2u; voffB[i] = (unsigned)(Rb * K + C) * 2u; RA[i] = R; CA2[i] = (unsigned)C * 2u; }
    static_assert(!GATHER || SP2, "GATHER is wired into the SP2 loop only");
    unsigned gA[2][2], gN[2][2];
    const size_t kstep = (size_t)(BK * 2);
    const size_t hstep = (size_t)HALF * K * 2;
    const size_t tstep = 2 * hstep;
    const unsigned ldsw = (unsigned)wid * 1024u;
    const int aoff = lds_byte(wr * 64 + fr, fq * 8), boff = lds_byte(wc * 32 + fr, fq * 8);
#define PG8_SA(b, h) (((b) * 2 + (h)) * HTB)
#define PG8_SB(b, h) ((4 + (b) * 2 + (h)) * HTB)
#define PG8_STAGE(bufoff, gbase, voff) do { _Pragma("unroll") for (int _i = 0; _i < 2; ++_i) \
        __builtin_amdgcn_global_load_lds((const unsigned*)((const char*)(gbase) + (voff)[_i]), (PG8_LAS unsigned*)(lds + (bufoff) + ldsw + _i * 8192), 16, 0, 0); } while (0)
#define PG8_STAGEG(bufoff, kbytes, v0, v1) do { \
        __builtin_amdgcn_global_load_lds((const unsigned*)((const char*)g.A + (kbytes) + (v0)), (PG8_LAS unsigned*)(lds + (bufoff) + ldsw), 16, 0, 0); \
        __builtin_amdgcn_global_load_lds((const unsigned*)((const char*)g.A + (kbytes) + (v1)), (PG8_LAS unsigned*)(lds + (bufoff) + ldsw + 8192), 16, 0, 0); } while (0)
#define PG8_GOFF(dst, ui_) do { _Pragma("unroll") for (int h_ = 0; h_ < 2; ++h_) _Pragma("unroll") for (int i_ = 0; i_ < 2; ++i_) dst[h_][i_] = (unsigned)S.tok((ui_), h_ * HALF + RA[i_]) * (unsigned)(K * 2) + CA2[i_]; } while (0)
#define PG8_LDA(dst, b, h) do { _Pragma("unroll") for (int m = 0; m < 4; ++m) _Pragma("unroll") for (int k = 0; k < 2; ++k) dst[m][k] = *(const PG8_LAS bf16x8*)(lds + PG8_SA(b, h) + aoff + m * 2048 + k * 1024); } while (0)
#define PG8_LDB(dst, b, h) do { _Pragma("unroll") for (int n = 0; n < 2; ++n) _Pragma("unroll") for (int k = 0; k < 2; ++k) dst[n][k] = *(const PG8_LAS bf16x8*)(lds + PG8_SB(b, h) + boff + n * 2048 + k * 1024); } while (0)
#define PG8_MMA(ai, bj, At, Bt) do { __builtin_amdgcn_s_setprio(1); _Pragma("unroll") for (int m = 0; m < 4; ++m) _Pragma("unroll") for (int n = 0; n < 2; ++n) { \
        if constexpr (FP8) { const i32x8 a8_ = cat8(Bt[n][0], Bt[n][1]), b8_ = cat8(At[m][0], At[m][1]); \
            asm volatile("v_mfma_scale_f32_16x16x128_f8f6f4 %0, %1, %2, %0, %3, %4 op_sel_hi:[0,0,0]" : "+v"(acc[ai][bj][m][n]) : "v"(a8_), "v"(b8_), "v"(sc_w8), "v"(sc_a8)); } \
        else { _Pragma("unroll") for (int k = 0; k < 2; ++k) acc[ai][bj][m][n] = __builtin_amdgcn_mfma_f32_16x16x32_bf16(Bt[n][k], At[m][k], acc[ai][bj][m][n], 0, 0, 0); } } \
        __builtin_amdgcn_s_setprio(0); } while (0)
#define PG8_WAIT_V(n) asm volatile("s_waitcnt vmcnt(" #n ")" ::: "memory")
#define PG8_WAIT_L(n) asm volatile("s_waitcnt lgkmcnt(" #n ")" ::: "memory")
#define PG8_BAR __builtin_amdgcn_s_barrier()
#define PG8_SCHED __builtin_amdgcn_sched_barrier(0)
    int sc_w8 = 0x7A7A7A7A, sc_a8 = 0x7F7F7F7F;
    asm volatile("" : "+v"(sc_w8), "+v"(sc_a8));
    Unit cur, nxt; int ui = 0;
    if (!S.next(0, cur)) return;
    f32x4 acc[2][2][4][2];
#pragma unroll
    for (int a = 0; a < 2; ++a)
#pragma unroll
        for (int b = 0; b < 2; ++b)
#pragma unroll
            for (int m = 0; m < 4; ++m)
#pragma unroll
                for (int n = 0; n < 2; ++n) acc[a][b][m][n] = (f32x4){0.f, 0.f, 0.f, 0.f};
    bf16x8 At[4][2], B0[2][2], B1[2][2];
    const char* cA = (const char*)g.A + (size_t)cur.pm * tstep; const char* cB = (const char*)g.Bt + (size_t)cur.pn * tstep;
    S.a_ready(cur);
    if constexpr (SP2) {
        if constexpr (GATHER) { PG8_GOFF(gA, 0); }
        PG8_STAGE(PG8_SB(0, 0), cB, voffB); PG8_STAGE(PG8_SB(0, 1), cB + hstep, voffB);
        if constexpr (GATHER) { PG8_STAGEG(PG8_SA(0, 0), 0, gA[0][0], gA[0][1]); PG8_STAGEG(PG8_SA(0, 1), 0, gA[1][0], gA[1][1]); } else { PG8_STAGE(PG8_SA(0, 0), cA, voffA); PG8_STAGE(PG8_SA(0, 1), cA + hstep, voffA); }
        if (wr == 1) PG8_BAR;
        PG8_WAIT_V(2); PG8_BAR;
        PG8_STAGE(PG8_SB(1, 0), cB + kstep, voffB); if constexpr (GATHER) { PG8_STAGEG(PG8_SA(1, 0), kstep, gA[0][0], gA[0][1]); } else { PG8_STAGE(PG8_SA(1, 0), cA + kstep, voffA); } PG8_STAGE(PG8_SB(1, 1), cB + hstep + kstep, voffB);
        PG8_WAIT_V(6); PG8_BAR;
    } else {
        PG8_STAGE(PG8_SB(0, 0), cB, voffB); PG8_STAGE(PG8_SA(0, 0), cA, voffA); PG8_STAGE(PG8_SB(0, 1), cB + hstep, voffB); PG8_STAGE(PG8_SA(0, 1), cA + hstep, voffA);
        if (wr == 1) PG8_BAR;
        PG8_WAIT_V(4); PG8_BAR;
        PG8_STAGE(PG8_SB(1, 0), cB + kstep, voffB); PG8_STAGE(PG8_SA(1, 0), cA + kstep, voffA); PG8_STAGE(PG8_SB(1, 1), cB + hstep + kstep, voffB);
        PG8_WAIT_V(6); PG8_BAR;
    }
    for (;;) {
        const bool has_next = S.next(ui + 1, nxt);
        const char* nA = has_next ? (const char*)g.A + (size_t)nxt.pm * tstep : cA; const char* nB = has_next ? (const char*)g.Bt + (size_t)nxt.pn * tstep : cB;
        if constexpr (GATHER) { if (has_next) { PG8_GOFF(gN, ui + 1); } else { _Pragma("unroll") for (int h_ = 0; h_ < 2; ++h_) _Pragma("unroll") for (int i_ = 0; i_ < 2; ++i_) gN[h_][i_] = gA[h_][i_]; } }
#pragma unroll 1
        for (int t = 0; t < nt; t += 2) {
            const bool last = (t == nt - 2);
            const char* a1 = cA + (size_t)(t + 1) * kstep;
            const char* a2 = last ? nA : cA + (size_t)(t + 2) * kstep; const char* b2 = last ? nB : cB + (size_t)(t + 2) * kstep;
            const char* a3 = a2 + kstep; const char* b3 = b2 + kstep;
            if (last && has_next) S.a_ready(nxt);
            if constexpr (SP2) {
            const size_t k1_ = (size_t)(t + 1) * kstep, k2_ = last ? (size_t)0 : (size_t)(t + 2) * kstep;
            const unsigned s00_ = last ? gN[0][0] : gA[0][0], s01_ = last ? gN[0][1] : gA[0][1], s10_ = last ? gN[1][0] : gA[1][0], s11_ = last ? gN[1][1] : gA[1][1];
            PG8_LDB(B0, 0, 0); PG8_LDB(B1, 0, 1); PG8_SCHED; PG8_LDA(At, 0, 0); if constexpr (GATHER) { PG8_STAGEG(PG8_SA(1, 1), k1_, gA[1][0], gA[1][1]); } else { PG8_STAGE(PG8_SA(1, 1), a1 + hstep, voffA); }
            PG8_WAIT_V(8); PG8_WAIT_L(0); PG8_BAR; PG8_MMA(0, 0, At, B0); PG8_MMA(0, 1, At, B1); PG8_BAR; PG8_SCHED;
            PG8_LDA(At, 0, 1); PG8_STAGE(PG8_SB(0, 0), b2, voffB); PG8_STAGE(PG8_SB(0, 1), b2 + hstep, voffB); if constexpr (GATHER) { PG8_STAGEG(PG8_SA(0, 0), k2_, s00_, s01_); } else { PG8_STAGE(PG8_SA(0, 0), a2, voffA); }
            PG8_WAIT_V(8); PG8_WAIT_L(0); PG8_BAR; PG8_MMA(1, 0, At, B0); PG8_MMA(1, 1, At, B1); PG8_BAR; PG8_SCHED;
            PG8_LDB(B0, 1, 0); PG8_LDB(B1, 1, 1); PG8_SCHED; PG8_LDA(At, 1, 0); if constexpr (GATHER) { PG8_STAGEG(PG8_SA(0, 1), k2_, s10_, s11_); } else { PG8_STAGE(PG8_SA(0, 1), a2 + hstep, voffA); }
            PG8_WAIT_V(8); PG8_WAIT_L(0); PG8_BAR; PG8_MMA(0, 0, At, B0); PG8_MMA(0, 1, At, B1); PG8_BAR; PG8_SCHED;
            PG8_LDA(At, 1, 1); PG8_STAGE(PG8_SB(1, 0), b3, voffB); PG8_STAGE(PG8_SB(1, 1), b3 + hstep, voffB); if constexpr (GATHER) { PG8_STAGEG(PG8_SA(1, 0), k2_ + kstep, s00_, s01_); } else { PG8_STAGE(PG8_SA(1, 0), a3, voffA); }
            PG8_WAIT_V(8); PG8_WAIT_L(0); PG8_BAR; PG8_MMA(1, 0, At, B0); PG8_MMA(1, 1, At, B1); PG8_BAR; PG8_SCHED;
            } else {
            PG8_LDB(B0, 0, 0); PG8_SCHED; PG8_LDA(At, 0, 0); PG8_STAGE(PG8_SA(1, 1), a1 + hstep, voffA);
            PG8_WAIT_L(8); PG8_BAR; PG8_WAIT_L(0); PG8_MMA(0, 0, At, B0); PG8_BAR; PG8_SCHED;
            PG8_LDB(B1, 0, 1); PG8_STAGE(PG8_SB(0, 0), b2, voffB);
            PG8_BAR; PG8_WAIT_L(0); PG8_MMA(0, 1, At, B1); PG8_BAR;
            PG8_LDA(At, 0, 1); PG8_STAGE(PG8_SA(0, 0), a2, voffA);
            PG8_BAR; PG8_WAIT_L(0); PG8_MMA(1, 0, At, B0); PG8_BAR; PG8_SCHED;
            PG8_STAGE(PG8_SB(0, 1), b2 + hstep, voffB);
            PG8_WAIT_V(6); PG8_BAR; PG8_MMA(1, 1, At, B1); PG8_BAR;
            PG8_LDB(B0, 1, 0); PG8_SCHED; PG8_LDA(At, 1, 0); PG8_STAGE(PG8_SA(0, 1), a2 + hstep, voffA);
            PG8_WAIT_L(8); PG8_BAR; PG8_WAIT_L(0); PG8_MMA(0, 0, At, B0); PG8_BAR; PG8_SCHED;
            PG8_LDB(B1, 1, 1); PG8_STAGE(PG8_SB(1, 0), b3, voffB);
            PG8_BAR; PG8_WAIT_L(0); PG8_MMA(0, 1, At, B1); PG8_BAR;
            PG8_LDA(At, 1, 1); PG8_STAGE(PG8_SA(1, 0), a3, voffA);
            PG8_BAR; PG8_WAIT_L(0); PG8_MMA(1, 0, At, B0); PG8_BAR; PG8_SCHED;
            PG8_STAGE(PG8_SB(1, 1), b3 + hstep, voffB);
            PG8_WAIT_V(6); PG8_BAR; PG8_MMA(1, 1, At, B1); PG8_BAR;
            }
        }
        if constexpr (FP8) { asm volatile("s_nop 15\n\ts_nop 15" ::: "memory"); }
        if constexpr (ALIGN_EPI) { if (wr == 0) PG8_BAR; }
        if constexpr (!Epi::AFTER_DRAIN) { E(acc, cur, wr, wc, fr, fq); S.done(cur); }
        if (!has_next) break;
#pragma unroll
        for (int a = 0; a < 2; ++a)
#pragma unroll
            for (int b = 0; b < 2; ++b)
#pragma unroll
                for (int m = 0; m < 4; ++m)
#pragma unroll
                    for (int n = 0; n < 2; ++n) acc[a][b][m][n] = (f32x4){0.f, 0.f, 0.f, 0.f};
        cur = nxt; cA = nA; cB = nB; ++ui;
        if constexpr (GATHER) { _Pragma("unroll") for (int h_ = 0; h_ < 2; ++h_) _Pragma("unroll") for (int i_ = 0; i_ < 2; ++i_) gA[h_][i_] = gN[h_][i_]; }
        if constexpr (ALIGN_EPI) { if (wr == 1) PG8_BAR; }
    }
    PG8_WAIT_V(0);
    if constexpr (!ALIGN_EPI) { if (wr == 0) PG8_BAR; }
    PG8_BAR;
    if constexpr (Epi::AFTER_DRAIN) { E.fused(acc, cur, wr, wc, fr, fq, lds, wid, lane); S.done(cur); }
#undef PG8_SA
#undef PG8_SB
#undef PG8_STAGE
#undef PG8_STAGEG
#undef PG8_GOFF
#undef PG8_LDA
#undef PG8_LDB
#undef PG8_MMA
#undef PG8_WAIT_V
#undef PG8_WAIT_L
#undef PG8_BAR
#undef PG8_SCHED
}
}
#define GAS __attribute__((address_space(1)))
#define LAS __attribute__((address_space(3)))
typedef unsigned short bf16;
typedef unsigned v4u __attribute__((ext_vector_type(4)));
typedef float f32x4 __attribute__((ext_vector_type(4)));
typedef short bf16x8 __attribute__((ext_vector_type(8)));
typedef GAS unsigned gu32;
typedef GAS unsigned long long gu64;
#define RLX_AGENT __ATOMIC_RELAXED, __HIP_MEMORY_SCOPE_AGENT
#define LDS_WAIT() asm volatile("s_waitcnt lgkmcnt(0)" ::: "memory")
#define VM_WAIT() asm volatile("s_waitcnt vmcnt(0)" ::: "memory")
__device__ __forceinline__ unsigned long long rt() { return __builtin_amdgcn_s_memrealtime(); }
__device__ __forceinline__ unsigned f2bf(float f) { unsigned u = __builtin_bit_cast(unsigned, f); return (u + 0x7fffu + ((u >> 16) & 1u)) >> 16; }
__device__ __forceinline__ unsigned pk2(float lo, float hi) { return f2bf(lo) | (f2bf(hi) << 16); }
#define XB_TMO      128
#define XB_XCNT(j)  (256  + 64 * (j))
#define XB_XSUB(j)  (1280 + 64 * (j))
#define XB_XGEN(j)  (2304 + 64 * (j))
#define XB_TOP      3328
#define XB_TOPGEN   3392
#define XCD_BAR_WORDS 3456
#define XB_SPIN_CAP (1u << 22)

__device__ __forceinline__ unsigned xb_ld(unsigned* p)              { return __hip_atomic_load(p, __ATOMIC_RELAXED, __HIP_MEMORY_SCOPE_AGENT); }
__device__ __forceinline__ unsigned xb_add(unsigned* p, unsigned v) { return __hip_atomic_fetch_add(p, v, __ATOMIC_RELAXED, __HIP_MEMORY_SCOPE_AGENT); }
__device__ __forceinline__ unsigned xb_xcc_id() { return (unsigned)__builtin_amdgcn_s_getreg((3 << 11) | 20) & 0xFu; }
#define XB_SPIN(cond, bar) do { unsigned _sp = 0; while (cond) { __builtin_amdgcn_s_sleep(1); \
    if ((++_sp & 255u) == 0u) { if (xb_ld(&(bar)[XB_TMO])) break; if (_sp > XB_SPIN_CAP) { atomicAdd(&(bar)[XB_TMO], 1u); break; } } } } while (0)

struct XcdBarrier {
    unsigned* bar; unsigned x;
    volatile LAS unsigned* st;
};

__device__ __forceinline__ XcdBarrier xcd_barrier_post(unsigned* bar, volatile LAS unsigned* st) {
    XcdBarrier b; b.bar = bar; b.x = xb_xcc_id(); b.st = st;
    if (threadIdx.x == 0) (void)xb_add(&bar[XB_XCNT(b.x)], 1u);
    return b;
}
__device__ __forceinline__ void xcd_barrier_complete(unsigned* bar, unsigned x, unsigned& nloc, unsigned& nx) {
    const unsigned G = gridDim.x * gridDim.y * gridDim.z;
    unsigned sum, cnt, mine, sp = 0u;
    for (;;) {
        sum = 0u; cnt = 0u; mine = 0u;
#pragma unroll
        for (unsigned j = 0; j < 16; ++j) { const unsigned c = xb_ld(&bar[XB_XCNT(j)]); sum += c; cnt += (c > 0u) ? 1u : 0u; mine = (j == x) ? c : mine; }
        if (sum == G) break;
        __builtin_amdgcn_s_sleep(1);
        if ((++sp & 255u) == 0u) { if (xb_ld(&bar[XB_TMO])) break; if (sp > XB_SPIN_CAP) { atomicAdd(&bar[XB_TMO], 1u); break; } }
    }
    nloc = mine > 0u ? mine : 1u; nx = cnt > 0u ? cnt : 1u;
}

__device__ __forceinline__ void xcd_barrier(const XcdBarrier& b) {
    asm volatile("s_waitcnt vmcnt(0)" ::: "memory");
    __syncthreads();
    if (threadIdx.x == 0) {
        unsigned* bar = b.bar;
        __builtin_amdgcn_s_waitcnt(0);
        unsigned nloc = b.st[0], nx = b.st[1];
        if (nloc == 0u) { xcd_barrier_complete(bar, b.x, nloc, nx); b.st[0] = nloc; b.st[1] = nx; }
        const unsigned old = xb_add(&bar[XB_XSUB(b.x)], 1u);
        const unsigned gen = old / nloc;
        if (old + 1u == (gen + 1u) * nloc) {
            __builtin_amdgcn_fence(__ATOMIC_RELEASE, "agent");
            asm volatile("s_waitcnt vmcnt(0)" ::: "memory");
            const unsigned og = xb_add(&bar[XB_TOP], 1u);
            const unsigned tg = og / nx;
            if (og + 1u == (tg + 1u) * nx) xb_add(&bar[XB_TOPGEN], 1u);
            else XB_SPIN(xb_ld(&bar[XB_TOPGEN]) == tg, bar);
            __builtin_amdgcn_fence(__ATOMIC_ACQUIRE, "agent");
            xb_add(&bar[XB_XGEN(b.x)], 1u);
            asm volatile("s_waitcnt vmcnt(0)" ::: "memory");
        } else {
            XB_SPIN(xb_ld(&bar[XB_XGEN(b.x)]) == gen, bar);
            __builtin_amdgcn_fence(__ATOMIC_ACQUIRE, "agent");
            asm volatile("s_waitcnt vmcnt(0)" ::: "memory");
        }
    }
    __syncthreads();
}

constexpr int BATCH = 2, SEQ = 8192, DM = 1024, CTXL = 256;
constexpr int NTOK = BATCH * SEQ, NCTXR = BATCH * CTXL, NROW = NTOK + NCTXR, KVLEN = SEQ + CTXL;
constexpr int INC = 2304, NEXP = 32, TOPK = 4, GUW = 2048;
constexpr int NPAD_MAX = NTOK * TOPK + NEXP * 256;
constexpr float NORM_EPS = 1e-6f, LOG2E = 1.4426950408889634f, QSCALE = 0.125f * 1.4426950408889634f;
constexpr int NWAVES = 8;


namespace at2 {
typedef short bf16x8 __attribute__((ext_vector_type(8)));
typedef short s16x4 __attribute__((ext_vector_type(4)));
typedef float f32x16 __attribute__((ext_vector_type(16)));
typedef unsigned u32x4 __attribute__((ext_vector_type(4)));
constexpr int SHM_V = 16384, SHM_K = 16384, AT_WS_OFF = 73728, AT_WS3_OFF = 98304, XROW = 132, XROWW = 68;
constexpr int SDEPTH = 1;
constexpr float THRL = 8.0f;
#define AT_LAS __attribute__((address_space(3)))
#define KSWZ(row, colB) ((row) * 256 + ((colB) ^ (((row) & 7) << 4)))
#define SBAR() __builtin_amdgcn_sched_barrier(0)
__device__ __forceinline__ int crow(int r, int hi) { return (r & 3) + 8 * (r >> 2) + 4 * hi; }
typedef float f32x2_t __attribute__((ext_vector_type(2))); typedef __bf16 bf16x2_t __attribute__((ext_vector_type(2)));
__device__ __forceinline__ unsigned cvtpk2(float lo, float hi) { f32x2_t v = {lo, hi}; bf16x2_t b = __builtin_convertvector(v, bf16x2_t); return __builtin_bit_cast(unsigned, b); }
__device__ __forceinline__ void partialSM(f32x16& p0, f32x16& p1, float& m_reg, float& alpha) {
  float pmax = p0[0];
#pragma unroll
  for (int r = 1; r < 16; ++r) pmax = fmaxf(pmax, p0[r]);
#pragma unroll
  for (int r = 0; r < 16; ++r) pmax = fmaxf(pmax, p1[r]);
  { auto rr = __builtin_amdgcn_permlane32_swap(__float_as_uint(pmax), __float_as_uint(pmax), false, false); pmax = fmaxf(__uint_as_float(rr[0]), __uint_as_float(rr[1])); }
  float mn;
  if (__builtin_expect(__all(pmax - m_reg <= THRL), 1)) { mn = m_reg; alpha = 1.f; }
  else { mn = fmaxf(m_reg, pmax); alpha = __builtin_amdgcn_exp2f(m_reg - mn); m_reg = mn; }
#pragma unroll
  for (int r = 0; r < 16; ++r) p0[r] = p0[r] - mn;
#pragma unroll
  for (int r = 0; r < 16; ++r) p1[r] = p1[r] - mn;
#pragma unroll
  for (int r = 0; r < 16; ++r) p0[r] = __builtin_amdgcn_exp2f(p0[r]);
}
__device__ __forceinline__ void finishSM(f32x16& p0, f32x16& p1, float alpha, float& l_reg, bf16x8& pa0, bf16x8& pa1, bf16x8& pa2, bf16x8& pa3) {
#pragma unroll
  for (int r = 0; r < 16; ++r) p1[r] = __builtin_amdgcn_exp2f(p1[r]);
  float ps = 0;
#pragma unroll
  for (int r = 0; r < 16; ++r) ps += p0[r];
#pragma unroll
  for (int r = 0; r < 16; ++r) ps += p1[r];
  { auto rr = __builtin_amdgcn_permlane32_swap(__float_as_uint(ps), __float_as_uint(ps), false, false); ps = __uint_as_float(rr[0]) + __uint_as_float(rr[1]); }
  l_reg = l_reg * alpha + ps;
#define PK4(P, BASE, OUT) do { unsigned a0 = cvtpk2(P[BASE + 0], P[BASE + 1]), a1 = cvtpk2(P[BASE + 2], P[BASE + 3]);   \
    unsigned b0 = cvtpk2(P[BASE + 4], P[BASE + 5]), b1 = cvtpk2(P[BASE + 6], P[BASE + 7]);                              \
    auto r0 = __builtin_amdgcn_permlane32_swap(a0, b0, false, false); auto r1 = __builtin_amdgcn_permlane32_swap(a1, b1, false, false); \
    u32x4 w = {r0[0], r1[0], r0[1], r1[1]}; OUT = __builtin_bit_cast(bf16x8, w); } while (0)
  PK4(p0, 0, pa0); PK4(p0, 8, pa1); PK4(p1, 0, pa2); PK4(p1, 8, pa3);
#undef PK4
}
__device__ __forceinline__ void qkt(f32x16& p0, f32x16& p1, const AT_LAS char* Ks, const bf16x8* qr, int r32, int hi) {
  p0 = f32x16{}; p1 = f32x16{};
#pragma unroll
  for (int d0 = 0; d0 < 4; ++d0) { const int cb = (d0 * 16 + hi * 8) * 2;
    const bf16x8 b0 = *(const AT_LAS bf16x8*)(Ks + KSWZ(r32, cb));
    const bf16x8 b1 = *(const AT_LAS bf16x8*)(Ks + KSWZ(32 + r32, cb));
    p0 = __builtin_amdgcn_mfma_f32_32x32x16_bf16(b0, qr[d0], p0, 0, 0, 0);
    p1 = __builtin_amdgcn_mfma_f32_32x32x16_bf16(b1, qr[d0], p1, 0, 0, 0); }
}
__device__ __forceinline__ int v_st(int k, int c) { const int kk = (k & ~0xC) | ((k & 4) << 1) | ((k & 8) >> 1); return ((kk >> 3) * 4 + (c >> 5)) * 512 + ((kk & 7) * 32 + (c & 31)) * 2; }
__device__ __forceinline__ int v_rd_base(int lane) { return ((lane & 3) << 3) | (((lane >> 2) & 3) << 6) | (((lane >> 4) & 1) << 5) | (((lane >> 5) & 1) << 8); }
constexpr int v_rd_off(int d0, int ks, int half) { return d0 * 512 + ks * 4096 + half * 2048; }
template <int OFF> __device__ __forceinline__ s16x4 tr_read(int vb) { s16x4 r; asm volatile("ds_read_b64_tr_b16 %0, %1 offset:%2" : "=&v"(r) : "v"(vb), "i"(OFF) : "memory"); return r; }
template <int D0> __device__ __forceinline__ void pv_one(f32x16& od, int vb, bf16x8 pa0, bf16x8 pa1, bf16x8 pa2, bf16x8 pa3) {
  const s16x4 l0 = tr_read<v_rd_off(D0, 0, 0)>(vb), h0 = tr_read<v_rd_off(D0, 0, 1)>(vb), l1 = tr_read<v_rd_off(D0, 1, 0)>(vb), h1 = tr_read<v_rd_off(D0, 1, 1)>(vb);
  const s16x4 l2 = tr_read<v_rd_off(D0, 2, 0)>(vb), h2 = tr_read<v_rd_off(D0, 2, 1)>(vb), l3 = tr_read<v_rd_off(D0, 3, 0)>(vb), h3 = tr_read<v_rd_off(D0, 3, 1)>(vb);
  asm volatile("s_waitcnt lgkmcnt(0)" ::: "memory"); SBAR();
#define PK(L, H) (bf16x8){L[0], L[1], L[2], L[3], H[0], H[1], H[2], H[3]}
  od = __builtin_amdgcn_mfma_f32_32x32x16_bf16(pa0, PK(l0, h0), od, 0, 0, 0);
  od = __builtin_amdgcn_mfma_f32_32x32x16_bf16(pa1, PK(l1, h1), od, 0, 0, 0);
  od = __builtin_amdgcn_mfma_f32_32x32x16_bf16(pa2, PK(l2, h2), od, 0, 0, 0);
  od = __builtin_amdgcn_mfma_f32_32x32x16_bf16(pa3, PK(l3, h3), od, 0, 0, 0);
#undef PK
}
typedef short v4i16_t __attribute__((ext_vector_type(4)));
__device__ __forceinline__ s16x4 vtr(int vb, int off) { return __builtin_bit_cast(s16x4, __builtin_amdgcn_ds_read_tr16_b64_v4i16((AT_LAS v4i16_t*)(unsigned)(vb + off))); }
template <int D0> __device__ __forceinline__ void pv_one_b(f32x16& od, int vb, bf16x8 pa0, bf16x8 pa1, bf16x8 pa2, bf16x8 pa3) {
  const s16x4 l0 = vtr(vb, v_rd_off(D0, 0, 0)), h0 = vtr(vb, v_rd_off(D0, 0, 1)), l1 = vtr(vb, v_rd_off(D0, 1, 0)), h1 = vtr(vb, v_rd_off(D0, 1, 1));
  const s16x4 l2 = vtr(vb, v_rd_off(D0, 2, 0)), h2 = vtr(vb, v_rd_off(D0, 2, 1)), l3 = vtr(vb, v_rd_off(D0, 3, 0)), h3 = vtr(vb, v_rd_off(D0, 3, 1));
#define PK(L, H) (bf16x8){L[0], L[1], L[2], L[3], H[0], H[1], H[2], H[3]}
  od = __builtin_amdgcn_mfma_f32_32x32x16_bf16(pa0, PK(l0, h0), od, 0, 0, 0);
  od = __builtin_amdgcn_mfma_f32_32x32x16_bf16(pa1, PK(l1, h1), od, 0, 0, 0);
  od = __builtin_amdgcn_mfma_f32_32x32x16_bf16(pa2, PK(l2, h2), od, 0, 0, 0);
  od = __builtin_amdgcn_mfma_f32_32x32x16_bf16(pa3, PK(l3, h3), od, 0, 0, 0);
#undef PK
}
template <int NDB> __device__ __forceinline__ void pv_all_b(f32x16* o, int vb, bf16x8 pa0, bf16x8 pa1, bf16x8 pa2, bf16x8 pa3) {
  pv_one_b<0>(o[0], vb, pa0, pa1, pa2, pa3); pv_one_b<1>(o[1], vb, pa0, pa1, pa2, pa3);
  if constexpr (NDB == 4) { pv_one_b<2>(o[2], vb, pa0, pa1, pa2, pa3); pv_one_b<3>(o[3], vb, pa0, pa1, pa2, pa3); }
}
template <int NDB> __device__ __forceinline__ void pv_all(f32x16* o, int vb, bf16x8 pa0, bf16x8 pa1, bf16x8 pa2, bf16x8 pa3) {
  pv_one<0>(o[0], vb, pa0, pa1, pa2, pa3); pv_one<1>(o[1], vb, pa0, pa1, pa2, pa3);
  if constexpr (NDB == 4) { pv_one<2>(o[2], vb, pa0, pa1, pa2, pa3); pv_one<3>(o[3], vb, pa0, pa1, pa2, pa3); }
}
__device__ __forceinline__ void wmask(f32x16& p0, f32x16& p1, int k0, int q, int hi) {
#pragma unroll
  for (int r = 0; r < 16; ++r) { const int d = k0 + crow(r, hi) - q; if (d > 128 || d < -128) p0[r] = -1e30f; if (d + 32 > 128 || d + 32 < -128) p1[r] = -1e30f; }
}

struct UnitArgs {
  const bf16* Q; int ldq;
  const bf16* K; const bf16* V; int ldk;
  int kcolB;
  int vcolB;
  int q0;
  int ks;
};
template <bool DIFF> __device__ __forceinline__ int tile_k0(const UnitArgs& a, int j) { if constexpr (DIFF) return 64 * j; else return j < 4 ? SEQ + 64 * j : a.ks + 64 * (j - 4); }

#define RD128(dst, addr, OFF) asm volatile("ds_read_b128 %0, %1 offset:%2" : "=v"(dst) : "v"(addr), "i"(OFF) : "memory")
#define RDTR(dst, addr, OFF) asm volatile("ds_read_b64_tr_b16 %0, %1 offset:%2" : "=v"(dst) : "v"(addr), "i"(OFF) : "memory")
#define WAITL8_4(n, a, b, c, d) asm volatile("s_waitcnt lgkmcnt(" #n ")" : "+v"(a), "+v"(b), "+v"(c), "+v"(d) :: "memory")
#define WAITL8_8(n, a, b, c, d, e, f, g, h) asm volatile("s_waitcnt lgkmcnt(" #n ")" : "+v"(a), "+v"(b), "+v"(c), "+v"(d), "+v"(e), "+v"(f), "+v"(g), "+v"(h) :: "memory")
__device__ __forceinline__ float max3f(float a, float b, float c) { return __builtin_fmaxf(__builtin_fmaxf(a, b), c); }
__device__ __forceinline__ void softmax_seg2(f32x16& p0, f32x16& p1, float& m_reg, float& alpha, bf16x8& pa0, bf16x8& pa1, bf16x8& pa2, bf16x8& pa3) {
  float x = max3f(p0[0], p0[1], p0[2]), y = max3f(p1[0], p1[1], p1[2]);
  x = max3f(x, p0[3], p0[4]); y = max3f(y, p1[3], p1[4]); x = max3f(x, p0[5], p0[6]); y = max3f(y, p1[5], p1[6]); x = max3f(x, p0[7], p0[8]); y = max3f(y, p1[7], p1[8]);
  x = max3f(x, p0[9], p0[10]); y = max3f(y, p1[9], p1[10]); x = max3f(x, p0[11], p0[12]); y = max3f(y, p1[11], p1[12]); x = max3f(x, p0[13], p0[14]); y = max3f(y, p1[13], p1[14]);
  float pmax = max3f(x, y, p0[15]); pmax = fmaxf(pmax, p1[15]);
  { auto rr = __builtin_amdgcn_permlane32_swap(__float_as_uint(pmax), __float_as_uint(pmax), false, false); pmax = fmaxf(__uint_as_float(rr[0]), __uint_as_float(rr[1])); }
  float mn;
  if (__builtin_expect(__all(pmax - m_reg <= THRL), 1)) { mn = m_reg; alpha = 1.f; }
  else { mn = fmaxf(m_reg, pmax); alpha = __builtin_amdgcn_exp2f(m_reg - mn); m_reg = mn; }
#pragma unroll
  for (int r = 0; r < 16; ++r) { p0[r] = __builtin_amdgcn_exp2f(p0[r] - mn); p1[r] = __builtin_amdgcn_exp2f(p1[r] - mn); }
  { u32x4 w = {cvtpk2(p0[0], p0[1]), cvtpk2(p0[2], p0[3]), cvtpk2(p0[4], p0[5]), cvtpk2(p0[6], p0[7])}; pa0 = __builtin_bit_cast(bf16x8, w); }
  { u32x4 w = {cvtpk2(p0[8], p0[9]), cvtpk2(p0[10], p0[11]), cvtpk2(p0[12], p0[13]), cvtpk2(p0[14], p0[15])}; pa1 = __builtin_bit_cast(bf16x8, w); }
  { u32x4 w = {cvtpk2(p1[0], p1[1]), cvtpk2(p1[2], p1[3]), cvtpk2(p1[4], p1[5]), cvtpk2(p1[6], p1[7])}; pa2 = __builtin_bit_cast(bf16x8, w); }
  { u32x4 w = {cvtpk2(p1[8], p1[9]), cvtpk2(p1[10], p1[11]), cvtpk2(p1[12], p1[13]), cvtpk2(p1[14], p1[15])}; pa3 = __builtin_bit_cast(bf16x8, w); }
}
template <bool DIFF>
__device__ __forceinline__ void attn_tiles_pp3(const UnitArgs& a, AT_LAS char* lds, int tid, int wid, int lane, f32x16* o, f32x16& ol, float& m_out) {
  constexpr int NDB = DIFF ? 4 : 2; constexpr int NT = DIFF ? KVLEN / 64 : 10;
  const int r32 = lane & 31, hi = lane >> 5;
  AT_LAS char* V_lds = lds; AT_LAS char* K_lds = lds + 3 * SHM_V;
  AT_LAS float* al_l = (AT_LAS float*)(lds + AT_WS3_OFF) + wid * 64 + 32;
  float m_reg = -1e30f, alpha = 1.f; bf16x8 qr[4];
  const short one_ = (short)0x3F80; const bf16x8 ones = {one_, one_, one_, one_, one_, one_, one_, one_};
  const bf16* Qw = a.Q + (long)r32 * a.ldq + hi * 8;
#pragma unroll
  for (int d0 = 0; d0 < 4; ++d0) qr[d0] = *(const bf16x8*)(Qw + d0 * 16);
  int koff[2], voff[2];
#pragma unroll
  for (int i = 0; i < 2; ++i) { const int pc = 2 * wid + i;
    { const int row = 4 * pc + (lane >> 4), p = lane & 15; koff[i] = row * a.ldk + ((p ^ (row & 7)) << 3); }
    { const int s = 2 * pc + (lane >> 5), kk = (s >> 2) * 8 + ((lane & 31) >> 2); const int key = kk; voff[i] = key * a.ldk + (s & 3) * 32 + 8 * (lane & 3); } }
  const int vb0 = (int)(unsigned)(uintptr_t)V_lds + v_rd_base(lane) + a.vcolB;
  const int kb0 = (int)(unsigned)(uintptr_t)K_lds + a.kcolB + r32 * 256;
  int kad[4];
#pragma unroll
  for (int d0 = 0; d0 < 4; ++d0) kad[d0] = kb0 + (((d0 * 2 + hi) ^ (r32 & 7)) << 4);
#define DMA_K(t, slot) do { const bf16* kb_ = a.K + (long)tile_k0<DIFF>(a, (t)) * a.ldk; _Pragma("unroll") for (int i_ = 0; i_ < 2; ++i_) \
    __builtin_amdgcn_global_load_lds((const unsigned*)(kb_ + koff[i_]), (AT_LAS unsigned*)(K_lds + (slot) * SHM_K + (2 * wid + i_) * 1024), 16, 0, 0); } while (0)
#define DMA_V(t, slot) do { const bf16* vb_ = a.V + (long)tile_k0<DIFF>(a, (t)) * a.ldk; _Pragma("unroll") for (int i_ = 0; i_ < 2; ++i_) \
    __builtin_amdgcn_global_load_lds((const unsigned*)(vb_ + voff[i_]), (AT_LAS unsigned*)(V_lds + (slot) * SHM_V + (2 * wid + i_) * 1024), 16, 0, 0); } while (0)
#define BAR_MID() do { SBAR(); asm volatile("s_barrier" ::: "memory"); SBAR(); } while (0)
#define BAR_END(n) do { SBAR(); asm volatile("s_waitcnt vmcnt(" #n ")\n\ts_barrier" ::: "memory"); SBAR(); } while (0)
#define RESC2() do { if (__any(alpha < 1.f)) { if (hi == 0) al_l[r32] = alpha; asm volatile("s_waitcnt lgkmcnt(0)" ::: "memory"); \
    _Pragma("unroll") for (int r = 0; r < 16; ++r) { const float f_ = al_l[crow(r, hi)]; ol[r] *= f_; _Pragma("unroll") for (int d = 0; d < NDB; ++d) o[d][r] *= f_; } } } while (0)
#define WMASK2(t) do { if constexpr (!DIFF) { if ((t) >= 4) wmask(p0, p1, tile_k0<DIFF>(a, (t)), a.q0 + r32, hi); } } while (0)
#define VSEG(t) do { WMASK2(t); softmax_seg2(p0, p1, m_reg, alpha, pa0, pa1, pa2, pa3); RESC2(); } while (0)
#define PKV(L, H) (bf16x8){L[0], L[1], L[2], L[3], H[0], H[1], H[2], H[3]}
#define VRD8(X, D0, va) do { RDTR(X##0, va, v_rd_off(D0, 0, 0)); RDTR(X##1, va, v_rd_off(D0, 0, 1)); RDTR(X##2, va, v_rd_off(D0, 1, 0)); RDTR(X##3, va, v_rd_off(D0, 1, 1)); \
    RDTR(X##4, va, v_rd_off(D0, 2, 0)); RDTR(X##5, va, v_rd_off(D0, 2, 1)); RDTR(X##6, va, v_rd_off(D0, 3, 0)); RDTR(X##7, va, v_rd_off(D0, 3, 1)); } while (0)
#define PV4(od, X) do { od = __builtin_amdgcn_mfma_f32_32x32x16_bf16(pa0, PKV(X##0, X##1), od, 0, 0, 0); od = __builtin_amdgcn_mfma_f32_32x32x16_bf16(pa1, PKV(X##2, X##3), od, 0, 0, 0); \
    od = __builtin_amdgcn_mfma_f32_32x32x16_bf16(pa2, PKV(X##4, X##5), od, 0, 0, 0); od = __builtin_amdgcn_mfma_f32_32x32x16_bf16(pa3, PKV(X##6, X##7), od, 0, 0, 0); } while (0)
#define MSEG(DOQK, DOPV, ksl, vsl) do { \
    bf16x8 k0_, k1_, k2_, k3_; s16x4 A0, A1, A2, A3, A4, A5, A6, A7, B0, B1, B2, B3, B4, B5, B6, B7; \
    const int ko_ = (ksl) * SHM_K; const int va_ = vb0 + (vsl) * SHM_V; \
    if (DOQK) { RD128(k0_, kad[0] + ko_, 0); RD128(k1_, kad[0] + ko_, 8192); RD128(k2_, kad[1] + ko_, 0); RD128(k3_, kad[1] + ko_, 8192); \
      bf16x8 k4_, k5_, k6_, k7_; RD128(k4_, kad[2] + ko_, 0); RD128(k5_, kad[2] + ko_, 8192); RD128(k6_, kad[3] + ko_, 0); RD128(k7_, kad[3] + ko_, 8192); \
      WAITL8_4(4, k0_, k1_, k2_, k3_); SBAR(); \
      p0 = __builtin_amdgcn_mfma_f32_32x32x16_bf16(k0_, qr[0], (f32x16){}, 0, 0, 0); p1 = __builtin_amdgcn_mfma_f32_32x32x16_bf16(k1_, qr[0], (f32x16){}, 0, 0, 0); \
      p0 = __builtin_amdgcn_mfma_f32_32x32x16_bf16(k2_, qr[1], p0, 0, 0, 0); p1 = __builtin_amdgcn_mfma_f32_32x32x16_bf16(k3_, qr[1], p1, 0, 0, 0); SBAR(); \
      if (DOPV) { VRD8(A, 0, va_); WAITL8_4(8, k4_, k5_, k6_, k7_); } else { WAITL8_4(0, k4_, k5_, k6_, k7_); } SBAR(); \
      p0 = __builtin_amdgcn_mfma_f32_32x32x16_bf16(k4_, qr[2], p0, 0, 0, 0); p1 = __builtin_amdgcn_mfma_f32_32x32x16_bf16(k5_, qr[2], p1, 0, 0, 0); \
      p0 = __builtin_amdgcn_mfma_f32_32x32x16_bf16(k6_, qr[3], p0, 0, 0, 0); p1 = __builtin_amdgcn_mfma_f32_32x32x16_bf16(k7_, qr[3], p1, 0, 0, 0); SBAR(); } \
    else if (DOPV) { VRD8(A, 0, va_); } \
    if (DOPV) { VRD8(B, 1, va_); WAITL8_8(8, A0, A1, A2, A3, A4, A5, A6, A7); SBAR(); PV4(o[0], A); SBAR(); \
      if constexpr (NDB == 4) { VRD8(A, 2, va_); WAITL8_8(8, B0, B1, B2, B3, B4, B5, B6, B7); SBAR(); PV4(o[1], B); SBAR(); \
        VRD8(B, 3, va_); WAITL8_8(8, A0, A1, A2, A3, A4, A5, A6, A7); SBAR(); PV4(o[2], A); SBAR(); \
        WAITL8_8(0, B0, B1, B2, B3, B4, B5, B6, B7); SBAR(); PV4(o[3], B); SBAR(); } \
      else { WAITL8_8(0, B0, B1, B2, B3, B4, B5, B6, B7); SBAR(); PV4(o[1], B); SBAR(); } \
      ol = __builtin_amdgcn_mfma_f32_32x32x16_bf16(pa0, ones, ol, 0, 0, 0); ol = __builtin_amdgcn_mfma_f32_32x32x16_bf16(pa1, ones, ol, 0, 0, 0); \
      ol = __builtin_amdgcn_mfma_f32_32x32x16_bf16(pa2, ones, ol, 0, 0, 0); ol = __builtin_amdgcn_mfma_f32_32x32x16_bf16(pa3, ones, ol, 0, 0, 0); SBAR(); } \
  } while (0)
#define ROT3(s) ((s) == 2 ? 0 : (s) + 1)
  f32x16 p0, p1; bf16x8 pa0, pa1, pa2, pa3;
  DMA_K(0, 0); DMA_K(1, 1); DMA_V(0, 0); BAR_END(0);
  int sk = 0;
  if (wid < 4) {
    DMA_K(2, 2); DMA_V(1, 1); MSEG(true, false, 0, 0); BAR_MID(); VSEG(0); BAR_END(4);
    sk = 1;
    for (int t = 1; t <= NT - 3; ++t) { const int s1 = ROT3(sk), s2 = ROT3(s1);
      DMA_K(t + 2, s2); DMA_V(t + 1, s1); MSEG(true, true, sk, s2); BAR_MID(); VSEG(t); BAR_END(4); sk = s1; }
    { const int s1 = ROT3(sk), s2 = ROT3(s1); DMA_V(NT - 1, s1); MSEG(true, true, sk, s2); BAR_MID(); VSEG(NT - 2); BAR_END(2); sk = s1; }
    { const int s1 = ROT3(sk), s2 = ROT3(s1); MSEG(true, true, sk, s2); BAR_MID(); VSEG(NT - 1); BAR_END(0); sk = s1; }
    { const int s2 = ROT3(ROT3(sk)); MSEG(false, true, 0, s2); BAR_MID(); BAR_END(0); }
  } else {
    DMA_K(2, 2); DMA_V(1, 1); BAR_MID(); MSEG(true, false, 0, 0); BAR_END(4);
    sk = 1;
    for (int t = 1; t <= NT - 3; ++t) { const int s1 = ROT3(sk), s2 = ROT3(s1);
      DMA_K(t + 2, s2); DMA_V(t + 1, s1); VSEG(t - 1); BAR_MID(); MSEG(true, true, sk, s2); BAR_END(4); sk = s1; }
    { const int s1 = ROT3(sk), s2 = ROT3(s1); DMA_V(NT - 1, s1); VSEG(NT - 3); BAR_MID(); MSEG(true, true, sk, s2); BAR_END(2); sk = s1; }
    { const int s1 = ROT3(sk), s2 = ROT3(s1); VSEG(NT - 2); BAR_MID(); MSEG(true, true, sk, s2); BAR_END(0); sk = s1; }
    { const int s2 = ROT3(ROT3(sk)); VSEG(NT - 1); BAR_MID(); MSEG(false, true, 0, s2); BAR_END(0); }
  }
  m_out = m_reg;
#undef DMA_K
#undef DMA_V
#undef BAR_MID
#undef BAR_END
#undef RESC2
#undef WMASK2
#undef VSEG
#undef PKV
#undef VRD8
#undef PV4
#undef MSEG
#undef ROT3
}

typedef int i32x8v __attribute__((ext_vector_type(8)));
constexpr int F8_SLOT = 8192, F8_K_OFF = 0, F8_V_OFF = 3 * F8_SLOT;
#define MF8_ACC(acc, a8, b8) asm volatile("v_mfma_scale_f32_32x32x64_f8f6f4 %0, %1, %2, %0, %3, %3 op_sel_hi:[0,0,0]" : "+v"(acc) : "v"(a8), "v"(b8), "v"(sc1))
#define MF8_NEW(acc, a8, b8) asm volatile("v_mfma_scale_f32_32x32x64_f8f6f4 %0, %1, %2, 0, %3, %3 op_sel_hi:[0,0,0]" : "=&v"(acc) : "v"(a8), "v"(b8), "v"(sc1))
__device__ __forceinline__ unsigned pk4f8(float a, float b, float c, float d) { int w = 0; w = __builtin_amdgcn_cvt_pk_fp8_f32(a, b, w, false); w = __builtin_amdgcn_cvt_pk_fp8_f32(c, d, w, true); return (unsigned)w; }
struct UnitArgs8 { const unsigned char* Q; const unsigned char* K; const unsigned char* VT; int comp, ldk, vdoff, q0, ks; };
template <bool DIFF> __device__ __forceinline__ int tile8_k0(const UnitArgs8& a, int j) { if constexpr (DIFF) return 64 * j; else return j < 4 ? SEQ + 64 * j : a.ks + 64 * (j - 4); }
template <bool DIFF>
__device__ __forceinline__ void attn_tiles_f8(const UnitArgs8& a, AT_LAS char* lds, int tid, int wid, int lane, f32x16* o, f32x16& ol, float& m_out) {
  constexpr int NDB = DIFF ? 4 : 2, NT = DIFF ? KVLEN / 64 : 10;
  const int r32 = lane & 31, hi = lane >> 5;
  AT_LAS char* K_lds = lds + F8_K_OFF; AT_LAS char* V_lds = lds + F8_V_OFF;
  AT_LAS float* al_l = (AT_LAS float*)(lds + AT_WS3_OFF) + wid * 64 + 32;
  float m_reg = -1e30f, alpha = 1.f;
  int sc1 = 0x7F7F7F7F; asm volatile("" : "+v"(sc1));
  i32x8v ones8; { int o4 = 0x38383838; asm volatile("" : "+v"(o4)); ones8 = (i32x8v){o4, o4, o4, o4, o4, o4, o4, o4}; }
  i32x8v q8; { const u32x4 qa_ = *(const u32x4*)(a.Q + (long)r32 * 512 + hi * 32), qb_ = *(const u32x4*)(a.Q + (long)r32 * 512 + hi * 32 + 16);
    q8 = (i32x8v){(int)qa_.x, (int)qa_.y, (int)qa_.z, (int)qa_.w, (int)qb_.x, (int)qb_.y, (int)qb_.z, (int)qb_.w}; }
  const int kkey = 8 * wid + (lane >> 3), koff = kkey * a.ldk + (((lane & 7) ^ ((kkey >> 1) & 7)) << 4);
  const int vd = 16 * wid + (lane >> 2); const long voff = (long)vd * KVLEN + (((lane & 3) ^ ((vd >> 2) & 3)) << 4);
  const int ksw = (r32 >> 1) & 7, vsw = (r32 >> 2) & 3;
  const int kb = (int)(unsigned)(uintptr_t)K_lds + r32 * 128, ka0 = kb + (((a.comp * 4 + 2 * hi) ^ ksw) << 4), ka1 = kb + (((a.comp * 4 + 2 * hi + 1) ^ ksw) << 4);
  const int vbb = (int)(unsigned)(uintptr_t)V_lds + a.vdoff + r32 * 64, va0 = vbb + (((2 * hi) ^ vsw) << 4), va1 = vbb + (((2 * hi + 1) ^ vsw) << 4);
#define DMA_K(t, slot) __builtin_amdgcn_global_load_lds((const unsigned*)(a.K + (long)tile8_k0<DIFF>(a, (t)) * a.ldk + koff), (AT_LAS unsigned*)(K_lds + (slot) * F8_SLOT + wid * 1024), 16, 0, 0)
#define DMA_V(t, slot) __builtin_amdgcn_global_load_lds((const unsigned*)(a.VT + (long)tile8_k0<DIFF>(a, (t)) + voff), (AT_LAS unsigned*)(V_lds + (slot) * F8_SLOT + wid * 1024), 16, 0, 0)
#define BAR_MID() do { SBAR(); asm volatile("s_barrier" ::: "memory"); SBAR(); } while (0)
#define BAR_END(n) do { SBAR(); asm volatile("s_waitcnt vmcnt(" #n ")\n\ts_barrier" ::: "memory"); SBAR(); } while (0)
#define RESC2() do { if (__any(alpha < 1.f)) { if (hi == 0) al_l[r32] = alpha; asm volatile("s_waitcnt lgkmcnt(0)" ::: "memory"); \
    _Pragma("unroll") for (int r = 0; r < 16; ++r) { const float f_ = al_l[crow(r, hi)]; ol[r] *= f_; _Pragma("unroll") for (int d = 0; d < NDB; ++d) o[d][r] *= f_; } } } while (0)
#define VSEG(t) do { if constexpr (!DIFF) { if ((t) >= 4) wmask(p0, p1, tile8_k0<DIFF>(a, (t)), a.q0 + r32, hi); } bf16x8 t0_, t1_, t2_, t3_; softmax_seg2(p0, p1, m_reg, alpha, t0_, t1_, t2_, t3_); (void)t0_; (void)t1_; (void)t2_; (void)t3_; \
    pa8 = (i32x8v){(int)pk4f8(p0[0], p0[1], p0[2], p0[3]), (int)pk4f8(p0[4], p0[5], p0[6], p0[7]), (int)pk4f8(p0[8], p0[9], p0[10], p0[11]), (int)pk4f8(p0[12], p0[13], p0[14], p0[15]), \
                   (int)pk4f8(p1[0], p1[1], p1[2], p1[3]), (int)pk4f8(p1[4], p1[5], p1[6], p1[7]), (int)pk4f8(p1[8], p1[9], p1[10], p1[11]), (int)pk4f8(p1[12], p1[13], p1[14], p1[15])}; RESC2(); } while (0)
#define RD16(dst, addr, OFF) asm volatile("ds_read_b128 %0, %1 offset:%2" : "=v"(dst) : "v"(addr), "i"(OFF) : "memory")
#define CAT8(x, y) (i32x8v){(int)x[0], (int)x[1], (int)x[2], (int)x[3], (int)y[0], (int)y[1], (int)y[2], (int)y[3]}
#define MSEG(DOQK, DOPV, ksl, vsl) do { \
    u32x4 ka_, kb_, kc_, kd_, v0a, v0b, v1a, v1b, v2a, v2b, v3a, v3b; const int ko_ = (ksl) * F8_SLOT, vo_ = (vsl) * F8_SLOT; \
    if (DOQK) { RD16(ka_, ka0 + ko_, 0); RD16(kb_, ka1 + ko_, 0); RD16(kc_, ka0 + ko_, 4096); RD16(kd_, ka1 + ko_, 4096); } \
    if (DOPV) { RD16(v0a, va0 + vo_, 0); RD16(v0b, va1 + vo_, 0); RD16(v1a, va0 + vo_, 2048); RD16(v1b, va1 + vo_, 2048); \
                if constexpr (NDB == 4) { RD16(v2a, va0 + vo_, 4096); RD16(v2b, va1 + vo_, 4096); RD16(v3a, va0 + vo_, 6144); RD16(v3b, va1 + vo_, 6144); } } \
    if (DOQK) { if (DOPV) { if constexpr (NDB == 4) asm volatile("s_waitcnt lgkmcnt(8)" : "+v"(ka_), "+v"(kb_), "+v"(kc_), "+v"(kd_) :: "memory"); else asm volatile("s_waitcnt lgkmcnt(4)" : "+v"(ka_), "+v"(kb_), "+v"(kc_), "+v"(kd_) :: "memory"); } else { asm volatile("s_waitcnt lgkmcnt(0)" : "+v"(ka_), "+v"(kb_), "+v"(kc_), "+v"(kd_) :: "memory"); } SBAR(); \
      { const i32x8v k0_ = CAT8(ka_, kb_), k1_ = CAT8(kc_, kd_); MF8_NEW(p0, k0_, q8); MF8_NEW(p1, k1_, q8); } SBAR(); } \
    if (DOPV) { if constexpr (NDB == 4) { asm volatile("s_waitcnt lgkmcnt(0)" : "+v"(v0a), "+v"(v0b), "+v"(v1a), "+v"(v1b), "+v"(v2a), "+v"(v2b), "+v"(v3a), "+v"(v3b) :: "memory"); SBAR(); \
        const i32x8v w0_ = CAT8(v0a, v0b), w1_ = CAT8(v1a, v1b), w2_ = CAT8(v2a, v2b), w3_ = CAT8(v3a, v3b); \
        MF8_ACC(o[0], pa8, w0_); MF8_ACC(o[1], pa8, w1_); MF8_ACC(o[2], pa8, w2_); MF8_ACC(o[3], pa8, w3_); MF8_ACC(ol, pa8, ones8); } \
      else { asm volatile("s_waitcnt lgkmcnt(0)" : "+v"(v0a), "+v"(v0b), "+v"(v1a), "+v"(v1b) :: "memory"); SBAR(); \
        const i32x8v w0_ = CAT8(v0a, v0b), w1_ = CAT8(v1a, v1b); MF8_ACC(o[0], pa8, w0_); MF8_ACC(o[1], pa8, w1_); MF8_ACC(ol, pa8, ones8); } SBAR(); } \
    asm volatile("s_nop 15\n\ts_nop 15" ::: "memory");     \
  } while (0)
#define ROT3(s) ((s) == 2 ? 0 : (s) + 1)
  f32x16 p0, p1; i32x8v pa8;
  DMA_K(0, 0); DMA_K(1, 1); DMA_V(0, 0); BAR_END(0);
  int sk = 0;
  if (wid < 4) {
    DMA_K(2, 2); DMA_V(1, 1); MSEG(true, false, 0, 0); BAR_MID(); VSEG(0); BAR_END(2);
    sk = 1;
    for (int t = 1; t <= NT - 3; ++t) { const int s1 = ROT3(sk), s2 = ROT3(s1);
      DMA_K(t + 2, s2); DMA_V(t + 1, s1); MSEG(true, true, sk, s2); BAR_MID(); VSEG(t); BAR_END(2); sk = s1; }
    { const int s1 = ROT3(sk), s2 = ROT3(s1); DMA_V(NT - 1, s1); MSEG(true, true, sk, s2); BAR_MID(); VSEG(NT - 2); BAR_END(1); sk = s1; }
    { const int s1 = ROT3(sk), s2 = ROT3(s1); MSEG(true, true, sk, s2); BAR_MID(); VSEG(NT - 1); BAR_END(0); sk = s1; }
    { const int s2 = ROT3(ROT3(sk)); MSEG(false, true, 0, s2); BAR_MID(); BAR_END(0); }
  } else {
    DMA_K(2, 2); DMA_V(1, 1); BAR_MID(); MSEG(true, false, 0, 0); BAR_END(2);
    sk = 1;
    for (int t = 1; t <= NT - 3; ++t) { const int s1 = ROT3(sk), s2 = ROT3(s1);
      DMA_K(t + 2, s2); DMA_V(t + 1, s1); VSEG(t - 1); BAR_MID(); MSEG(true, true, sk, s2); BAR_END(2); sk = s1; }
    { const int s1 = ROT3(sk), s2 = ROT3(s1); DMA_V(NT - 1, s1); VSEG(NT - 3); BAR_MID(); MSEG(true, true, sk, s2); BAR_END(1); sk = s1; }
    { const int s1 = ROT3(sk), s2 = ROT3(s1); VSEG(NT - 2); BAR_MID(); MSEG(true, true, sk, s2); BAR_END(0); sk = s1; }
    { const int s2 = ROT3(ROT3(sk)); VSEG(NT - 1); BAR_MID(); MSEG(false, true, 0, s2); BAR_END(0); }
  }
  m_out = m_reg;
#undef DMA_K
#undef DMA_V
#undef BAR_MID
#undef BAR_END
#undef RESC2
#undef VSEG
#undef RD16
#undef CAT8
#undef MSEG
#undef ROT3
}
#undef KSWZ
#undef SBAR
}

constexpr size_t MiB = 1u << 20;
constexpr size_t WS_CTL = 0, CTL_ZERO_BYTES = 1 * MiB;
constexpr size_t WS_MODP = 1 * MiB;
constexpr size_t WS_MODV = 2 * MiB;
constexpr size_t WS_ROPE = 2 * MiB + 128 * 1024;
constexpr size_t WS_ROUTE = 3 * MiB;
constexpr size_t WS_WIN = 4 * MiB, WS_WOUT = 9 * MiB, WS_WGU = 12 * MiB, WS_WDN = 140 * MiB;
constexpr size_t WS_ELIST = 238 * MiB;
constexpr size_t WS_XN = 204 * MiB;
constexpr size_t WS_QA = 240 * MiB, WS_KA = 256 * MiB, WS_VA = 274 * MiB, WS_QB = 292 * MiB, WS_KB = 308 * MiB, WS_VB = 314 * MiB;
constexpr size_t WS_Y = 320 * MiB, WS_X1 = 352 * MiB, WS_XG = 416 * MiB, WS_H = 560 * MiB, WS_Y2 = 704 * MiB, WS_END = 848 * MiB;
constexpr int CW_TMO = 0, CW_CODE = 1, CW_BAR = 4096, CW_CNT = 8192;
constexpr int MODP_KC = 8;

constexpr int RING_OFF = 0, RING_BYTES = 131072;
constexpr int LDSCTL_OFF = RING_BYTES, MISC_OFF = LDSCTL_OFF + 320, XTRA_OFF = LDSCTL_OFF + 1024;
constexpr int LDS_BYTES = 147456;

__device__ const double ROPE_CS[32] = {
    0.54030230586813977, 0.8414709848078965, 0.84600911028170789, 0.53316843991402285, 0.95041528025518285, 0.31098359290718575, 0.98423023447009461, 0.17689218624615005,
    0.99500416527802582, 0.099833416646828155, 0.99841927779266448, 0.056204499214692491, 0.99950004166527784, 0.031617506402433708, 0.99984189028361437, 0.01778185687966613,
    0.99995000041666526, 0.0099998333341666645, 0.9999841886533658, 0.0056233836139601857, 0.99999500000416663, 0.0031622723897082477, 0.99999841886158658, 0.0017782784728035289,
    0.99999950000004167, 0.00099999983333334168, 0.99999984188612112, 0.00056234129555235944, 0.99999995000000041, 0.00031622776074637522, 0.99999998418861169, 0.00017782794006665674};

__device__ __forceinline__ unsigned cvtpk(float lo, float hi) { return at2::cvtpk2(lo, hi); }
__device__ __forceinline__ unsigned pk4_fp8(float a, float b, float c, float d) { int w = 0; w = __builtin_amdgcn_cvt_pk_fp8_f32(a, b, w, false); w = __builtin_amdgcn_cvt_pk_fp8_f32(c, d, w, true); return (unsigned)w; }
__device__ __forceinline__ float bflo(unsigned w) { return __uint_as_float(w << 16); }
__device__ __forceinline__ float bfhi(unsigned w) { return __uint_as_float(w & 0xffff0000u); }
__device__ __forceinline__ bf16 f2bf1(float f) { return (bf16)(cvtpk(f, 0.f) & 0xffffu); }
__device__ __forceinline__ void unpack8(const v4u v, float* f) { f[0] = bflo(v.x); f[1] = bfhi(v.x); f[2] = bflo(v.y); f[3] = bfhi(v.y); f[4] = bflo(v.z); f[5] = bfhi(v.z); f[6] = bflo(v.w); f[7] = bfhi(v.w); }
__device__ __forceinline__ float wave_sum(float v) {
#pragma unroll
    for (int o = 1; o < 64; o <<= 1) v += __shfl_xor(v, o);
    return v;
}

struct Frame {
    LAS unsigned char* lds;
    volatile LAS unsigned* MISC;
    gu32* ctl;
    int tid, lane, wave, vcu, G, probe;
    const float *x, *c, *ctx, *c_ctx, *w_mod, *b_mod, *norm1_g, *w_in, *lq1, *lk1, *lq2, *lk2, *subln_g, *sink, *w_out, *norm2_g, *w_router, *b_router, *w_gu, *b_gu, *w_dn, *b_dn, *final_g;
    float* out;
    float *modp, *modv, *rope, *X1, *rgate;
    int *re, *rslot, *rpos, *elist;
    bf16 *Win_t, *Wout_t, *Wgu_t, *Wdn_t, *XN, *QA, *KA, *VA, *QB, *KB, *VB, *Y, *XG, *H, *Y2;
};

#ifdef PROBE_BUILD
#define RP(F, k) (1 + (((F).probe >> (k)) & 1))
#else
#define RP(F, k) 1
#endif
struct EpiQKV {
    bf16 *QA, *KA, *VA, *QB, *KB, *VB; const float* rope;
    struct Ctx { bf16* p; bool skip, rp, isq; const float* cs; };
    __device__ __forceinline__ Ctx prep(int row, int cg) const {
        Ctx c; const bool lat = row < NTOK; const int b = lat ? (row >> 13) : ((row - NTOK) >> 8);
        const int kvrow = lat ? (b * KVLEN + (row & (SEQ - 1))) : (b * KVLEN + SEQ + ((row - NTOK) & (CTXL - 1)));
        c.skip = false; c.rp = lat; c.isq = false;
        if (cg < 512)       { c.p = QA + (size_t)row * 512 + cg; c.isq = true; c.skip = !lat; }
        else if (cg < 1024) { c.p = KA + (size_t)kvrow * 512 + (cg - 512); }
        else if (cg < 1536) { c.p = VA + (size_t)kvrow * 512 + (cg - 1024); c.rp = false; }
        else if (cg < 2048) { c.p = QB + (size_t)row * 512 + (cg - 1536); c.isq = true; c.skip = !lat; }
        else if (cg < 2176) { c.p = KB + (size_t)kvrow * 128 + (cg - 2048); }
        else                { c.p = VB + (size_t)kvrow * 128 + (cg - 2176); c.rp = false; }
        const int t = row & (SEQ - 1); const int pos = ((cg >> 5) & 1) ? (t & 63) : (t >> 6);
        c.cs = rope + pos * 32;
        return c;
    }
    __device__ __forceinline__ void math(const Ctx& c, int i, float lo, float hi, float& olo, float& ohi) const {
        if (c.rp) { const float cs = c.cs[2 * i], sn = c.cs[2 * i + 1]; olo = lo * cs - hi * sn; ohi = hi * cs + lo * sn; } else { olo = lo; ohi = hi; }
        if (c.isq) { olo *= QSCALE; ohi *= QSCALE; }
    }
    __device__ __forceinline__ void one(int row, int cg, int i, float lo, float hi, int) const {
        const Ctx c = prep(row, cg); if (c.skip) return; float a, b; math(c, i, lo, hi, a, b); c.p[i] = f2bf1(a); c.p[16 + i] = f2bf1(b);
    }
    __device__ __forceinline__ void four(int row, int cg, int i0, const f32x4 lo, const f32x4 hi, int) const {
        const Ctx c = prep(row, cg); if (c.skip) return; float a[4], b[4];
#pragma unroll
        for (int i = 0; i < 4; ++i) math(c, i0 + i, lo[i], hi[i], a[i], b[i]);
        typedef unsigned u32x2 __attribute__((ext_vector_type(2)));
        *(u32x2*)(c.p + i0) = (u32x2){cvtpk(a[0], a[1]), cvtpk(a[2], a[3])}; *(u32x2*)(c.p + 16 + i0) = (u32x2){cvtpk(b[0], b[1]), cvtpk(b[2], b[3])};
    }
};
struct EpiOut {
    const float* x; const float* modv; float* X1;
    __device__ __forceinline__ void one(int row, int cg, int i, float lo, float hi, int) const {
        const float* g1 = modv + (row >> 13) * 6144 + 2048; const size_t o = (size_t)row * DM + cg + i;
        X1[o] = x[o] + g1[cg + i] * lo; X1[o + 16] = x[o + 16] + g1[cg + 16 + i] * hi;
    }
    __device__ __forceinline__ void four(int row, int cg, int i0, const f32x4 lo, const f32x4 hi, int) const {
        const float* g1 = modv + (row >> 13) * 6144 + 2048 + cg + i0; const size_t o = (size_t)row * DM + cg + i0;
        typedef unsigned u32x2 __attribute__((ext_vector_type(2)));
        const f32x4 a = *(const f32x4*)(x + o) + *(const f32x4*)(g1) * lo, b = *(const f32x4*)(x + o + 16) + *(const f32x4*)(g1 + 16) * hi;
        *(u32x2*)((bf16*)X1 + o) = (u32x2){cvtpk(a[0], a[1]), cvtpk(a[2], a[3])}; *(u32x2*)((bf16*)X1 + o + 16) = (u32x2){cvtpk(b[0], b[1]), cvtpk(b[2], b[3])};
    }
};
__device__ __forceinline__ float swiglu(float g, float lin) {
    g = fminf(g, 7.0f); lin = fminf(fmaxf(lin, -7.0f), 7.0f);
    return g * __builtin_amdgcn_rcpf(1.0f + __builtin_amdgcn_exp2f(-1.702f * LOG2E * g)) * (lin + 1.0f);
}
struct EpiGU {
    unsigned char* H; const float* b_gu;
    __device__ __forceinline__ void one(int row, int cg, int i, float lo, float hi, int e) const { (void)row; (void)cg; (void)i; (void)lo; (void)hi; (void)e; }
    __device__ __forceinline__ void four(int row, int cg, int i0, const f32x4 lo, const f32x4 hi, int e) const {
        const int f = (cg >> 1) + i0; const float* bb = b_gu + e * GUW + 2 * f; const f32x4 b0 = *(const f32x4*)bb, b1 = *(const f32x4*)(bb + 4);
        const float a0 = swiglu(lo[0] + b0[0], hi[0] + b0[1]), a1 = swiglu(lo[1] + b0[2], hi[1] + b0[3]), a2 = swiglu(lo[2] + b1[0], hi[2] + b1[1]), a3 = swiglu(lo[3] + b1[2], hi[3] + b1[3]);
        *(unsigned*)(H + (size_t)row * DM + f) = pk4_fp8(a0, a1, a2, a3);
    }
};
struct EpiDN {
    bf16* Y2; const float* b_dn;
    __device__ __forceinline__ void eight(int row, int c0, const f32x4 v0, const f32x4 v1, int e) const {
        const float* bb = b_dn + e * DM + c0; const f32x4 b0 = *(const f32x4*)bb, b1 = *(const f32x4*)(bb + 4);
        typedef unsigned u32x2 __attribute__((ext_vector_type(2)));
        *(u32x2*)((unsigned char*)Y2 + (size_t)row * DM + c0) = (u32x2){pk4_fp8(v0[0] + b0[0], v0[1] + b0[1], v0[2] + b0[2], v0[3] + b0[3]), pk4_fp8(v1[0] + b1[0], v1[1] + b1[1], v1[2] + b1[2], v1[3] + b1[3])};
    }
    __device__ __forceinline__ void one(int row, int cg, int i, float lo, float hi, int e) const {
        const float* bb = b_dn + e * DM + cg + i; bf16* p = Y2 + (size_t)row * DM + cg + i; p[0] = f2bf1(lo + bb[0]); p[16] = f2bf1(hi + bb[16]);
    }
    __device__ __forceinline__ void four(int row, int cg, int i0, const f32x4 lo, const f32x4 hi, int e) const {
        const float* bb = b_dn + e * DM + cg + i0; const f32x4 b0 = *(const f32x4*)bb, b1 = *(const f32x4*)(bb + 16); bf16* p = Y2 + (size_t)row * DM + cg + i0;
        typedef unsigned u32x2 __attribute__((ext_vector_type(2)));
        *(u32x2*)p = (u32x2){cvtpk(lo[0] + b0[0], lo[1] + b0[1]), cvtpk(lo[2] + b0[2], lo[3] + b0[3])}; *(u32x2*)(p + 16) = (u32x2){cvtpk(hi[0] + b1[0], hi[1] + b1[1]), cvtpk(hi[2] + b1[2], hi[3] + b1[3])};
    }
};
template <class E, int NN> struct EpiAdapt {
    static constexpr bool PERM = false, AFTER_DRAIN = false;
    E e;
    __device__ __forceinline__ void operator()(const pg8::f32x4 (&acc)[2][2][4][2], const pg8::Unit& u, int wr, int wc, int fr, int fq) const {
        int ex = 0, pn = u.pn; if (NN) { ex = pn / NN; pn = pn - ex * NN; }
#pragma unroll
        for (int ai = 0; ai < 2; ++ai)
#pragma unroll
            for (int m = 0; m < 4; ++m) { const int row = u.pm * 256 + ai * 128 + wr * 64 + m * 16 + fr;
#pragma unroll
                for (int bj = 0; bj < 2; ++bj) e.four(row, pn * 256 + bj * 128 + wc * 32, 4 * fq, acc[ai][bj][m][0], acc[ai][bj][m][1], ex); }
    }
};
struct RepOrder : pg8::StaticOrder { int rep;
    __device__ __forceinline__ bool next(int i, pg8::Unit& u) const { if (rep > 1) { const int R = (nwg + G - 1) / G; if (i >= R * rep) return false; i %= R; } return pg8::StaticOrder::next(i, u); } };
struct EpiQKVFast {
    static constexpr bool PERM = false, AFTER_DRAIN = false;
    bf16 *QA, *KA, *VA, *QB, *KB, *VB; const float* rope;
    __device__ __forceinline__ void operator()(const pg8::f32x4 (&acc)[2][2][4][2], const pg8::Unit& u, int wr, int wc, int fr, int fq) const {
        typedef unsigned u32x2 __attribute__((ext_vector_type(2)));
        bf16* base[2]; int ld[2]; bool isq[2], rp[2], kvr[2], f8[2];
#pragma unroll
        for (int bj = 0; bj < 2; ++bj) { const int cg = u.pn * 256 + bj * 128 + wc * 32; isq[bj] = false; rp[bj] = true; kvr[bj] = true; f8[bj] = true;
            if (cg < 512)       { base[bj] = (bf16*)((unsigned char*)QA + cg); ld[bj] = 512; isq[bj] = true; kvr[bj] = false; }
            else if (cg < 1024) { base[bj] = (bf16*)((unsigned char*)KA + (cg - 512)); ld[bj] = 512; }
            else if (cg < 1536) { base[bj] = (bf16*)((unsigned char*)VA + (cg - 1024)); ld[bj] = 512; rp[bj] = false; }
            else if (cg < 2048) { base[bj] = (bf16*)((unsigned char*)QB + (cg - 1536)); ld[bj] = 512; isq[bj] = true; kvr[bj] = false; }
            else if (cg < 2176) { base[bj] = (bf16*)((unsigned char*)KB + (cg - 2048)); ld[bj] = 128; }
            else                { base[bj] = (bf16*)((unsigned char*)VB + (cg - 2176)); ld[bj] = 128; rp[bj] = false; } }
        const bool colhalf = (wc & 1) != 0;
#pragma unroll
        for (int ai = 0; ai < 2; ++ai)
#pragma unroll
            for (int m = 0; m < 4; ++m) {
                const int row = u.pm * 256 + ai * 128 + wr * 64 + m * 16 + fr; const bool lat = row < NTOK;
                const int b = lat ? (row >> 13) : ((row - NTOK) >> 8);
                const int kvrow = lat ? (b * KVLEN + (row & (SEQ - 1))) : (b * KVLEN + SEQ + ((row - NTOK) & (CTXL - 1)));
                const int t = row & (SEQ - 1), pos = colhalf ? (t & 63) : (t >> 6);
                const f32x4 c0 = *(const f32x4*)(rope + pos * 32 + 8 * fq), c1 = *(const f32x4*)(rope + pos * 32 + 8 * fq + 4);
#pragma unroll
                for (int bj = 0; bj < 2; ++bj) {
                    if (isq[bj] && !lat) continue;
                    f32x4 lo = acc[ai][bj][m][0], hi = acc[ai][bj][m][1];
                    if (rp[bj] && lat) { const f32x4 cs = {c0[0], c0[2], c1[0], c1[2]}, sn = {c0[1], c0[3], c1[1], c1[3]}; const f32x4 nl = lo * cs - hi * sn, nh = hi * cs + lo * sn; lo = nl; hi = nh; }
                    if (isq[bj]) { lo = lo * QSCALE; hi = hi * QSCALE; }
                    const size_t rr = (size_t)(kvr[bj] ? kvrow : row) * ld[bj];
                    if (f8[bj]) { unsigned char* p = (unsigned char*)base[bj] + rr + 4 * fq; *(unsigned*)p = pk4_fp8(lo[0], lo[1], lo[2], lo[3]); *(unsigned*)(p + 16) = pk4_fp8(hi[0], hi[1], hi[2], hi[3]); }
                    else { bf16* p = base[bj] + rr + 4 * fq; *(u32x2*)p = (u32x2){cvtpk(lo[0], lo[1]), cvtpk(lo[2], lo[3])}; *(u32x2*)(p + 16) = (u32x2){cvtpk(hi[0], hi[1]), cvtpk(hi[2], hi[3])}; }
                }
            }
    }
};
template <class E, int NN> struct EpiAdaptP {
    static constexpr bool PERM = true, AFTER_DRAIN = false;
    E e;
    __device__ __forceinline__ void operator()(const pg8::f32x4 (&acc)[2][2][4][2], const pg8::Unit& u, int wr, int wc, int fr, int fq) const {
        int ex = 0, pn = u.pn; if (NN) { ex = pn / NN; pn = pn - ex * NN; }
#pragma unroll
        for (int ai = 0; ai < 2; ++ai)
#pragma unroll
            for (int m = 0; m < 4; ++m) { const int row = u.pm * 256 + ai * 128 + wr * 64 + m * 16 + fr;
#pragma unroll
                for (int bj = 0; bj < 2; ++bj) e.eight(row, pn * 256 + bj * 128 + wc * 32 + 8 * fq, acc[ai][bj][m][0], acc[ai][bj][m][1], ex); }
    }
};
struct GroupedOrder {
    int nN, NP, G, c; const LAS int* pexp; int rep; const LAS int* tokT;
    __device__ __forceinline__ int rounds() const { const int upr = G / nN; return (NP + upr - 1) / upr; }
    __device__ __forceinline__ int tok(int ui, int r) const { if (rep > 1) ui %= rounds(); return tokT[ui * 256 + r]; }
    __device__ __forceinline__ bool next(int i, pg8::Unit& u) const {
        int p, j;
        if (rep > 1) { const int R = rounds(); if (i >= R * rep) return false; i %= R; }
        if (G == 256) { const int x = c & 7, r = c >> 3, ppx = 32 / nN; p = i * (8 * ppx) + x * ppx + r / nN; j = r % nN; }
        else { const long L = (long)i * G + c; p = (int)(L / nN); j = (int)(L % nN); }
        if (p >= NP) return false;
        u.pm = p; u.pn = pexp[p] * nN + j; return true;
    }
    __device__ __forceinline__ void a_ready(const pg8::Unit&) const {}
    __device__ __forceinline__ void done(const pg8::Unit&) const {}
};

struct DenseSel { const bf16* Bt; __device__ __forceinline__ const bf16* operator()(int, int& e) const { e = 0; return Bt; } };
struct GroupSel { const bf16* Bt; const LAS int* pexp; int N, K; __device__ __forceinline__ const bf16* operator()(int mt, int& e) const { e = pexp[mt >> 1]; return Bt + (size_t)e * N * K; } };
template <class Epi, class BSel>
__device__ __forceinline__ void naive_gemm(Frame& F, const bf16* A, int Mtiles, int N, int K, const BSel& bs, const Epi& E) {
    LAS float* As = (LAS float*)(F.lds + RING_OFF); LAS float* Bs = As + 128 * 33;
    const int nNt = N / 64, tx = F.tid & 15, ty = F.tid >> 4;
    for (int t = blockIdx.x; t < Mtiles * nNt; t += F.G) {
        const int mt = t / nNt, nt = t % nNt; int e; const bf16* Bt = bs(mt, e);
        float acc[4][4];
#pragma unroll
        for (int r = 0; r < 4; ++r)
#pragma unroll
            for (int j = 0; j < 4; ++j) acc[r][j] = 0.f;
        for (int k0 = 0; k0 < K; k0 += 32) {
            { const int r = F.tid >> 2, kc = (F.tid & 3) * 8; float f[8]; unpack8(*(const v4u*)(A + (size_t)(mt * 128 + r) * K + k0 + kc), f);
#pragma unroll
              for (int i = 0; i < 8; ++i) As[r * 33 + kc + i] = f[i]; }
            if (F.tid < 256) { const int r = F.tid >> 2, kc = (F.tid & 3) * 8; float f[8]; unpack8(*(const v4u*)(Bt + (size_t)(nt * 64 + r) * K + k0 + kc), f);
#pragma unroll
              for (int i = 0; i < 8; ++i) Bs[r * 33 + kc + i] = f[i]; }
            __syncthreads();
#pragma unroll 8
            for (int kk = 0; kk < 32; ++kk) { float a[4], b[4];
#pragma unroll
                for (int r = 0; r < 4; ++r) a[r] = As[(ty * 4 + r) * 33 + kk];
#pragma unroll
                for (int j = 0; j < 4; ++j) b[j] = Bs[(tx + 16 * j) * 33 + kk];
#pragma unroll
                for (int r = 0; r < 4; ++r)
#pragma unroll
                    for (int j = 0; j < 4; ++j) acc[r][j] += a[r] * b[j]; }
            __syncthreads();
        }
#pragma unroll
        for (int r = 0; r < 4; ++r) { const int row = mt * 128 + ty * 4 + r; E.one(row, nt * 64, tx, acc[r][0], acc[r][1], e); E.one(row, nt * 64 + 32, tx, acc[r][2], acc[r][3], e); }
    }
}

template <bool GUPERM>
__device__ __forceinline__ void p0_transpose_item(const float* W, int K, int N, bf16* WT, LAS float* scr, int item, int lane) {
    const int nblk = N / 32, kb = item / nblk, nb = item % nblk, k0 = 64 * kb, n0 = 32 * nb;
    { f32x4 v[8]; const float* wp = W + (size_t)(k0 + (lane >> 3)) * N + n0 + 4 * (lane & 7);
#pragma unroll
      for (int i = 0; i < 8; ++i) v[i] = __builtin_nontemporal_load((const f32x4*)(wp + (size_t)(8 * i) * N));
#pragma unroll
      for (int i = 0; i < 8; ++i) { LAS float* d = scr + (8 * i + (lane >> 3)) * 33 + 4 * (lane & 7); d[0] = v[i].x; d[1] = v[i].y; d[2] = v[i].z; d[3] = v[i].w; } }
    LDS_WAIT(); asm volatile("" ::: "memory");
    const int c = lane & 7;
#pragma unroll
    for (int j = 0; j < 4; ++j) { const int n = (lane >> 3) + 8 * j; const LAS float* s = scr + (8 * c) * 33 + n;
        v4u o; o.x = cvtpk(s[0 * 33], s[1 * 33]); o.y = cvtpk(s[2 * 33], s[3 * 33]); o.z = cvtpk(s[4 * 33], s[5 * 33]); o.w = cvtpk(s[6 * 33], s[7 * 33]);
        const int nd = GUPERM ? ((n & 1) * 16 + (n >> 1)) : n;
        *(GAS v4u*)(WT + (size_t)(n0 + nd) * K + k0 + 8 * c) = o; }
    LDS_WAIT(); asm volatile("" ::: "memory");
}
template <bool GUPERM>
__device__ __forceinline__ void p0_transpose_item_fp8(const float* W, int K, int N, unsigned char* WT, LAS float* scr, int item, int lane) {
    const int nblk = N / 32, kb = item / nblk, nb = item % nblk, k0 = 64 * kb, n0 = 32 * nb;
    { f32x4 v[8]; const float* wp = W + (size_t)(k0 + (lane >> 3)) * N + n0 + 4 * (lane & 7);
#pragma unroll
      for (int i = 0; i < 8; ++i) v[i] = __builtin_nontemporal_load((const f32x4*)(wp + (size_t)(8 * i) * N));
#pragma unroll
      for (int i = 0; i < 8; ++i) { LAS float* d = scr + (8 * i + (lane >> 3)) * 33 + 4 * (lane & 7); d[0] = v[i].x; d[1] = v[i].y; d[2] = v[i].z; d[3] = v[i].w; } }
    LDS_WAIT(); asm volatile("" ::: "memory");
    const int c = lane & 7;
    typedef unsigned u32x2 __attribute__((ext_vector_type(2)));
#pragma unroll
    for (int j = 0; j < 4; ++j) { const int n = (lane >> 3) + 8 * j; const LAS float* s = scr + (8 * c) * 33 + n;
        u32x2 o; o.x = pk4_fp8(s[0 * 33] * 32.f, s[1 * 33] * 32.f, s[2 * 33] * 32.f, s[3 * 33] * 32.f); o.y = pk4_fp8(s[4 * 33] * 32.f, s[5 * 33] * 32.f, s[6 * 33] * 32.f, s[7 * 33] * 32.f);
        const int nd = GUPERM ? ((n & 1) * 16 + (n >> 1)) : n;
        *(GAS u32x2*)(WT + (size_t)(n0 + nd) * K + k0 + 8 * c) = o; }
    LDS_WAIT(); asm volatile("" ::: "memory");
}
struct F8Item { const float* wp; unsigned char* wt; int K; int guperm; };
__device__ __forceinline__ F8Item f8_decode(const Frame& F, int r, int lane) {
    constexpr int I_GU1 = (DM / 64) * (GUW / 32), I_DN1 = (DM / 64) * (DM / 32);
    F8Item I; const float* W; int N, item; unsigned char* WT;
    if (r < NEXP * I_GU1) { const int e = r / I_GU1; item = r % I_GU1; W = F.w_gu + (size_t)e * DM * GUW; N = GUW; WT = (unsigned char*)F.Wgu_t + (size_t)e * GUW * DM; I.guperm = 1; }
    else { r -= NEXP * I_GU1; const int e = r / I_DN1; item = r % I_DN1; W = F.w_dn + (size_t)e * DM * DM; N = DM; WT = (unsigned char*)F.Wdn_t + (size_t)e * DM * DM; I.guperm = 0; }
    const int nblk = N / 32, kb = item / nblk, nb = item % nblk, k0 = 64 * kb, n0 = 32 * nb;
    I.wp = W + (size_t)(k0 + (lane >> 3)) * N + n0 + 4 * (lane & 7); I.K = N;
    I.wt = WT + (size_t)n0 * DM + k0 + 8 * (lane & 7);
    return I;
}
__device__ __forceinline__ void f8_issue(const F8Item& I, f32x4 (&v)[8]) {
#pragma unroll
    for (int i = 0; i < 8; ++i) v[i] = __builtin_nontemporal_load((const f32x4*)(I.wp + (size_t)(8 * i) * I.K));
}
__device__ __forceinline__ void f8_finish(const F8Item& I, f32x4 (&v)[8], LAS float* scr, int lane) {
#pragma unroll
    for (int i = 0; i < 8; ++i) { LAS float* d = scr + (8 * i + (lane >> 3)) * 33 + 4 * (lane & 7); d[0] = v[i].x; d[1] = v[i].y; d[2] = v[i].z; d[3] = v[i].w; }
    LDS_WAIT(); asm volatile("" ::: "memory");
    const int c = lane & 7;
    typedef unsigned u32x2 __attribute__((ext_vector_type(2)));
#pragma unroll
    for (int j = 0; j < 4; ++j) { const int n = (lane >> 3) + 8 * j; const LAS float* s = scr + (8 * c) * 33 + n;
        u32x2 o; o.x = pk4_fp8(s[0 * 33] * 32.f, s[1 * 33] * 32.f, s[2 * 33] * 32.f, s[3 * 33] * 32.f); o.y = pk4_fp8(s[4 * 33] * 32.f, s[5 * 33] * 32.f, s[6 * 33] * 32.f, s[7 * 33] * 32.f);
        const int nd = I.guperm ? ((n & 1) * 16 + (n >> 1)) : n;
        *(GAS u32x2*)(I.wt + (size_t)nd * DM) = o; }
    LDS_WAIT(); asm volatile("" ::: "memory");
}
__device__ __forceinline__ void f8_stream(const Frame& F, LAS float* scr, int r, int rend, int stride) {
    f32x4 va[8], vb[8]; F8Item Ia, Ib;
    if (r >= rend) return;
    Ia = f8_decode(F, r, F.lane); f8_issue(Ia, va);
    while (true) {
        int nx = r + stride;
        if (nx < rend) { Ib = f8_decode(F, nx, F.lane); f8_issue(Ib, vb); }
        f8_finish(Ia, va, scr, F.lane);
        r = nx; if (r >= rend) break;
        nx = r + stride;
        if (nx < rend) { Ia = f8_decode(F, nx, F.lane); f8_issue(Ia, va); }
        f8_finish(Ib, vb, scr, F.lane);
        r = nx; if (r >= rend) break;
    }
}
__device__ __forceinline__ void p0_item(Frame& F, LAS float* sil, LAS float* scr, int it) {
    constexpr int I_IN = (DM / 64) * (INC / 32), I_OUT = (DM / 64) * (DM / 32), I_GU1 = (DM / 64) * (GUW / 32), I_DN1 = (DM / 64) * (DM / 32);

        int r = it;
        if (r < I_IN) { p0_transpose_item<false>(F.w_in, DM, INC, F.Win_t, scr, r, F.lane); return; } r -= I_IN;
        if (r < I_OUT) { p0_transpose_item<false>(F.w_out, DM, DM, F.Wout_t, scr, r, F.lane); return; } r -= I_OUT;
        if (r < NEXP * I_GU1) { const int e = r / I_GU1; p0_transpose_item_fp8<true>(F.w_gu + (size_t)e * DM * GUW, DM, GUW, (unsigned char*)F.Wgu_t + (size_t)e * GUW * DM, scr, r % I_GU1, F.lane); return; } r -= NEXP * I_GU1;
        { const int e = r / I_DN1; p0_transpose_item_fp8<false>(F.w_dn + (size_t)e * DM * DM, DM, DM, (unsigned char*)F.Wdn_t + (size_t)e * DM * DM, scr, r % I_DN1, F.lane); }
}
constexpr int P0_NITEMS = (DM / 64) * (INC / 32) + (DM / 64) * (DM / 32) + NEXP * (DM / 64) * (GUW / 32) + NEXP * (DM / 64) * (DM / 32);
constexpr int P0_SPLIT = P0_NITEMS - 13920;
__device__ __forceinline__ void p0_tail(Frame& F) {
    LAS float* scr = (LAS float*)(F.lds + RING_OFF + F.wave * 16384);
    const int w = ((int)blockIdx.x - 82) * NWAVES + F.wave, NW = (F.G - 82) * NWAVES;
    constexpr int NPRE = (DM / 64) * (INC / 32) + (DM / 64) * (DM / 32);
    f8_stream(F, scr, P0_SPLIT - NPRE + w, P0_NITEMS - NPRE, NW);
}
__device__ __forceinline__ void p0_prologue(Frame& F) {
    LAS float* sil = (LAS float*)(F.lds + XTRA_OFF);
    for (int i = F.tid; i < 3072; i += 512) { const int v = i >> 10, k = i & 1023; const float cv = (v < 2) ? F.c[v * 1024 + k] : F.c_ctx[k]; sil[i] = cv / (1.f + __expf(-cv)); }
    __syncthreads();
    const int gw = F.vcu * NWAVES + F.wave, NGW = F.G * NWAVES;
    if (blockIdx.x == 0) for (int i = F.tid; i < 2048; i += 512) { const int pos = i >> 4, j = i & 15; double cr = 1.0, sr = 0.0, cb = ROPE_CS[2 * j], sb = ROPE_CS[2 * j + 1];
        for (int bit = 0; bit < 7; ++bit) { if ((pos >> bit) & 1) { const double t = cr * cb - sr * sb; sr = cr * sb + sr * cb; cr = t; } const double t2 = cb * cb - sb * sb; sb = 2.0 * cb * sb; cb = t2; }
        F.rope[2 * i] = (float)cr; F.rope[2 * i + 1] = (float)sr; }
    for (int r = F.vcu; r < 24 * MODP_KC; r += F.G) {
        const int nb = r % 24, kc = r / 24, n = nb * 256 + F.lane * 4, kbase = kc * 128 + F.wave * 16;
        f32x4 a0 = {0.f, 0.f, 0.f, 0.f}, a1 = a0, a2 = a0;
        const float* wp = F.w_mod + (size_t)kbase * 6144 + n;
#pragma unroll
        for (int kk = 0; kk < 16; ++kk) { const f32x4 w = __builtin_nontemporal_load((const f32x4*)(wp + (size_t)kk * 6144)); const int k = kbase + kk; a0 += w * sil[k]; a1 += w * sil[1024 + k]; a2 += w * sil[2048 + k]; }
        LAS float* red = (LAS float*)(F.lds + RING_OFF);
        *(LAS f32x4*)(red + (F.wave * 3 + 0) * 256 + 4 * F.lane) = a0; *(LAS f32x4*)(red + (F.wave * 3 + 1) * 256 + 4 * F.lane) = a1; *(LAS f32x4*)(red + (F.wave * 3 + 2) * 256 + 4 * F.lane) = a2;
        __syncthreads();
        for (int i = F.tid; i < 768; i += 512) { float t = 0.f;
#pragma unroll
            for (int w = 0; w < NWAVES; ++w) t += red[w * 768 + i];
            F.modp[(size_t)(kc * 3 + i / 256) * 6144 + nb * 256 + (i % 256)] = t; }
        __syncthreads();
    }
    LAS float* scr = (LAS float*)(F.lds + RING_OFF + F.wave * 16384);
    constexpr int I_IN = (DM / 64) * (INC / 32), I_OUT = (DM / 64) * (DM / 32), I_GU1 = (DM / 64) * (GUW / 32), I_DN1 = (DM / 64) * (DM / 32);
    constexpr int NITEMS = I_IN + I_OUT + NEXP * I_GU1 + NEXP * I_DN1;
    const int nsplit = (F.G == 256) ? P0_SPLIT : NITEMS;
    constexpr int NPRE = I_IN + I_OUT;
    int it0 = gw;
    if (NPRE > NGW) { for (; it0 < NPRE; it0 += NGW) p0_item(F, sil, scr, it0); } else if (it0 < NPRE) { p0_item(F, sil, scr, it0); it0 += NGW; }
    f8_stream(F, scr, it0 - NPRE, nsplit - NPRE, NGW);
}
__device__ __forceinline__ void p1_norm(Frame& F) {
    LAS float* ml = (LAS float*)(F.lds + RING_OFF);
    for (int i0 = F.tid; i0 < 6144; i0 += 2048) { float pv[4][MODP_KC], bv[4];
#pragma unroll
        for (int q = 0; q < 4; ++q) { const int i = i0 + 512 * q, v = i / 2048, j = i % 2048; bv[q] = F.b_mod[j];
#pragma unroll
            for (int kc = 0; kc < MODP_KC; ++kc) pv[q][kc] = F.modp[(size_t)(kc * 3 + v) * 6144 + j]; }
#pragma unroll
        for (int q = 0; q < 4; ++q) { float t = bv[q];
#pragma unroll
            for (int kc = 0; kc < MODP_KC; ++kc) t += pv[q][kc];
            ml[i0 + 512 * q] = t; } }
    for (int gi = blockIdx.x * 512 + F.tid; gi < 3 * 6144; gi += F.G * 512) { const int v = gi / 6144, j = gi % 6144; float s = F.b_mod[j];
        for (int kc = 0; kc < MODP_KC; ++kc) s += F.modp[(size_t)(kc * 3 + v) * 6144 + j]; F.modv[gi] = s; }
    __syncthreads();
    const int gw = F.vcu * NWAVES + F.wave, NGW = F.G * NWAVES;
    typedef unsigned u32x2 __attribute__((ext_vector_type(2)));
    for (int pp = gw; pp < (NROW / 2) * RP(F, 1); pp += NGW) { const int m0 = (pp % (NROW / 2)) * 2;
        f32x4 xv[2][4]; float s[2] = {0.f, 0.f}; int v[2];
#pragma unroll
        for (int q = 0; q < 2; ++q) { const int m = m0 + q; v[q] = m < SEQ ? 0 : (m < NTOK ? 1 : 2);
            const float* src = m < NTOK ? F.x + (size_t)m * DM : F.ctx + (size_t)(m - NTOK) * DM;
#pragma unroll
            for (int j = 0; j < 4; ++j) xv[q][j] = __builtin_nontemporal_load((const f32x4*)(src + 4 * F.lane + 256 * j)); }
#pragma unroll
        for (int q = 0; q < 2; ++q)
#pragma unroll
            for (int j = 0; j < 4; ++j) s[q] += (xv[q][j].x * xv[q][j].x + xv[q][j].y * xv[q][j].y) + (xv[q][j].z * xv[q][j].z + xv[q][j].w * xv[q][j].w);
#pragma unroll
        for (int q = 0; q < 2; ++q) { const int m = m0 + q; const float rstd = 1.0f / sqrtf(wave_sum(s[q]) * (1.f / DM) + NORM_EPS);
#pragma unroll
            for (int j = 0; j < 4; ++j) { const int col = 4 * F.lane + 256 * j; const f32x4 g = *(const f32x4*)(F.norm1_g + col);
                const f32x4 sh = *(const LAS f32x4*)(ml + v[q] * 2048 + col), sc = *(const LAS f32x4*)(ml + v[q] * 2048 + 1024 + col);
                const f32x4 y = (xv[q][j] * rstd * g) * (sc + 1.0f) + sh;
                *(u32x2*)(F.XN + (size_t)m * DM + col) = (u32x2){cvtpk(y.x, y.y), cvtpk(y.z, y.w)}; } }
    }
}

__device__ __forceinline__ float lam_value(Frame& F) {
    const float a = wave_sum(F.lq1[F.lane] * F.lk1[F.lane]), b = wave_sum(F.lq2[F.lane] * F.lk2[F.lane]);
    return __expf(a) - __expf(b) + 0.2f;
}
__device__ __forceinline__ void naive_diff_attn(Frame& F) {
    const float lam = lam_value(F);
    LAS float* X = (LAS float*)(F.lds + RING_OFF);
    LAS float* SS = X + 128 * 128;
    const int q = F.tid & 127, comp = (F.tid >> 7) & 1, vh = F.tid >> 8;
    for (int it = blockIdx.x; it < BATCH * 4 * (SEQ / 128); it += F.G) {
        const int b = it >> 8, h = (it >> 6) & 3, qb = it & 63; const int row = b * SEQ + qb * 128 + q;
        float qv[64], o[64];
#pragma unroll
        for (int c8 = 0; c8 < 8; ++c8) unpack8(*(const v4u*)(F.QA + (size_t)row * 512 + h * 128 + comp * 64 + c8 * 8), qv + 8 * c8);
#pragma unroll
        for (int e = 0; e < 64; ++e) o[e] = 0.f;
        float m = -1e30f, l = 0.f;
        const bf16* kp = F.KA + (size_t)(b * KVLEN) * 512 + h * 128 + comp * 64; const bf16* vp = F.VA + (size_t)(b * KVLEN) * 512 + h * 128 + vh * 64;
        for (int key = 0; key < KVLEN; ++key) {
            float s = 0.f;
#pragma unroll
            for (int c8 = 0; c8 < 8; ++c8) { float kf[8]; unpack8(*(const v4u*)(kp + (size_t)key * 512 + c8 * 8), kf);
#pragma unroll
                for (int i = 0; i < 8; ++i) s += qv[8 * c8 + i] * kf[i]; }
            if (s > m) { const float a = exp2f(m - s); l *= a;
#pragma unroll
                for (int e = 0; e < 64; ++e) o[e] *= a;
                m = s; }
            const float p = exp2f(s - m); l += p;
#pragma unroll
            for (int c8 = 0; c8 < 8; ++c8) { float vf[8]; unpack8(*(const v4u*)(vp + (size_t)key * 512 + c8 * 8), vf);
#pragma unroll
                for (int i = 0; i < 8; ++i) o[8 * c8 + i] += p * vf[i]; }
        }
        const float inv = 1.0f / l;
        __syncthreads();
        if (comp == 1) {
#pragma unroll
            for (int e = 0; e < 64; ++e) X[(vh * 64 + e) * 128 + q] = lam * o[e] * inv; }
        __syncthreads();
        if (comp == 0) { float ss = 0.f;
#pragma unroll
            for (int e = 0; e < 64; ++e) { o[e] = o[e] * inv - X[(vh * 64 + e) * 128 + q]; ss += o[e] * o[e]; }
            SS[vh * 128 + q] = ss; }
        __syncthreads();
        if (comp == 0) { const float r = 0.8f / sqrtf((SS[q] + SS[128 + q]) * (1.f / 128.f) + NORM_EPS);
            bf16* yp = F.Y + (size_t)row * DM + h * 128 + vh * 64; const float* sg = F.subln_g + vh * 64;
#pragma unroll
            for (int c8 = 0; c8 < 8; ++c8) { v4u w; w.x = cvtpk(o[8 * c8] * r * sg[8 * c8], o[8 * c8 + 1] * r * sg[8 * c8 + 1]); w.y = cvtpk(o[8 * c8 + 2] * r * sg[8 * c8 + 2], o[8 * c8 + 3] * r * sg[8 * c8 + 3]);
                w.z = cvtpk(o[8 * c8 + 4] * r * sg[8 * c8 + 4], o[8 * c8 + 5] * r * sg[8 * c8 + 5]); w.w = cvtpk(o[8 * c8 + 6] * r * sg[8 * c8 + 6], o[8 * c8 + 7] * r * sg[8 * c8 + 7]);
                *(v4u*)(yp + 8 * c8) = w; } }
    }
}
__device__ __forceinline__ void naive_win_attn(Frame& F) {
    for (int it = blockIdx.x; it < BATCH * 8 * (SEQ / 512); it += F.G) {
        const int b = it >> 7, h = (it >> 4) & 7, t = (it & 15) * 512 + F.tid, kv = h >> 2; const int row = b * SEQ + t;
        float qv[64], o[64];
#pragma unroll
        for (int c8 = 0; c8 < 8; ++c8) unpack8(*(const v4u*)(F.QB + (size_t)row * 512 + h * 64 + c8 * 8), qv + 8 * c8);
#pragma unroll
        for (int e = 0; e < 64; ++e) o[e] = 0.f;
        float m = F.sink[h] * LOG2E, l = 1.0f;
        const bf16* kp = F.KB + (size_t)(b * KVLEN) * 128 + kv * 64; const bf16* vp = F.VB + (size_t)(b * KVLEN) * 128 + kv * 64;
        for (int jj = 0; jj < 257 + CTXL; ++jj) {
            const int key = jj < 257 ? t - 128 + jj : SEQ + (jj - 257);
            if (jj < 257 && (key < 0 || key >= SEQ)) continue;
            float s = 0.f;
#pragma unroll
            for (int c8 = 0; c8 < 8; ++c8) { float kf[8]; unpack8(*(const v4u*)(kp + (size_t)key * 128 + c8 * 8), kf);
#pragma unroll
                for (int i = 0; i < 8; ++i) s += qv[8 * c8 + i] * kf[i]; }
            if (s > m) { const float a = exp2f(m - s); l *= a;
#pragma unroll
                for (int e = 0; e < 64; ++e) o[e] *= a;
                m = s; }
            const float p = exp2f(s - m); l += p;
#pragma unroll
            for (int c8 = 0; c8 < 8; ++c8) { float vf[8]; unpack8(*(const v4u*)(vp + (size_t)key * 128 + c8 * 8), vf);
#pragma unroll
                for (int i = 0; i < 8; ++i) o[8 * c8 + i] += p * vf[i]; }
        }
        const float inv = 1.0f / l; bf16* yp = F.Y + (size_t)row * DM + 512 + h * 64;
#pragma unroll
        for (int c8 = 0; c8 < 8; ++c8) { v4u w; w.x = cvtpk(o[8 * c8] * inv, o[8 * c8 + 1] * inv); w.y = cvtpk(o[8 * c8 + 2] * inv, o[8 * c8 + 3] * inv); w.z = cvtpk(o[8 * c8 + 4] * inv, o[8 * c8 + 5] * inv); w.w = cvtpk(o[8 * c8 + 6] * inv, o[8 * c8 + 7] * inv);
            *(v4u*)(yp + 8 * c8) = w; }
    }
}

#ifndef ATT_PP
#define ATT_PP 3
#endif
constexpr size_t WIN_VT_OFF = 16u << 20;
__device__ __forceinline__ void vt_item(const unsigned char* src, int rstride, unsigned char* drow0, int tile, int dg, int half) {
        unsigned outw[4][8];
#pragma unroll
        for (int i8 = 0; i8 < 8; ++i8) { const int kg = 8 * half + i8;
            const unsigned w0 = *(const unsigned*)(src + (size_t)(4 * kg + 0) * rstride), w1 = *(const unsigned*)(src + (size_t)(4 * kg + 1) * rstride), w2 = *(const unsigned*)(src + (size_t)(4 * kg + 2) * rstride), w3 = *(const unsigned*)(src + (size_t)(4 * kg + 3) * rstride);
            const unsigned a01 = __builtin_amdgcn_perm(w1, w0, 0x05010400u), c01 = __builtin_amdgcn_perm(w1, w0, 0x07030602u);
            const unsigned a23 = __builtin_amdgcn_perm(w3, w2, 0x05010400u), c23 = __builtin_amdgcn_perm(w3, w2, 0x07030602u);
            const int slot = ((i8 >> 1) & 3) + 4 * (i8 & 1);
            outw[0][slot] = __builtin_amdgcn_perm(a23, a01, 0x05040100u); outw[1][slot] = __builtin_amdgcn_perm(a23, a01, 0x07060302u);
            outw[2][slot] = __builtin_amdgcn_perm(c23, c01, 0x05040100u); outw[3][slot] = __builtin_amdgcn_perm(c23, c01, 0x07060302u); }
#pragma unroll
        for (int i = 0; i < 4; ++i) { unsigned char* dst = drow0 + (size_t)i * KVLEN + tile * 64 + 16 * half;
            *(v4u*)dst = (v4u){outw[i][0], outw[i][1], outw[i][2], outw[i][3]}; *(v4u*)(dst + 32) = (v4u){outw[i][4], outw[i][5], outw[i][6], outw[i][7]}; }
}
__device__ __forceinline__ void p3_vt_pass(Frame& F) {
    const unsigned char* V8 = (const unsigned char*)F.VA; unsigned char* VT8 = (unsigned char*)F.XG;
    const unsigned char* VB8 = (const unsigned char*)F.VB; unsigned char* VBT8 = (unsigned char*)F.XG + WIN_VT_OFF;
    const int gw = F.vcu * NWAVES + F.wave, NGW = F.G * NWAVES, dg = F.lane & 31, half = F.lane >> 5;
    constexpr int NTL = KVLEN / 64;
    for (int it = gw; it < 10 * NTL; it += NGW) {
        if (it < 8 * NTL) { const int bh = it / NTL, tile = it % NTL, b = bh >> 2, h = bh & 3;
            vt_item(V8 + ((size_t)(b * KVLEN + tile * 64)) * 512 + h * 128 + 4 * dg, 512, VT8 + ((size_t)(bh * 128 + 4 * dg)) * KVLEN, tile, dg, half); }
        else { const int b = (it - 8 * NTL) / NTL, tile = it % NTL;
            vt_item(VB8 + ((size_t)(b * KVLEN + tile * 64)) * 128 + 4 * dg, 128, VBT8 + ((size_t)(b * 128 + 4 * dg)) * KVLEN, tile, dg, half); }
    }
}
__device__ __forceinline__ void diff_unit(Frame& F, int b, int h, int qb, float lam) {
    using namespace at2;
    const int wid = F.wave, lane = F.lane, r32 = lane & 31, hi = lane >> 5, qblk = wid >> 1, comp = wid & 1;
    const int row0 = b * SEQ + qb * 128 + qblk * 32;
    UnitArgs8 a; a.Q = (const unsigned char*)F.QA + (size_t)row0 * 512 + h * 128 + comp * 64;
    a.K = (const unsigned char*)F.KA + (size_t)(b * KVLEN) * 512 + h * 128; a.VT = (const unsigned char*)F.XG + (size_t)((b * 4 + h) * 128) * KVLEN; a.comp = comp; a.ldk = 512; a.vdoff = 0; a.q0 = 0; a.ks = 0;
    f32x16 o[4]; o[0] = f32x16{}; o[1] = f32x16{}; o[2] = f32x16{}; o[3] = f32x16{};
    float m; f32x16 ol = f32x16{};
    AT_LAS char* lds = (AT_LAS char*)F.lds;
    attn_tiles_f8<true>(a, lds, F.tid, wid, lane, o, ol, m);
    float rli[16];
#pragma unroll
    for (int r = 0; r < 16; ++r) rli[r] = __builtin_amdgcn_rcpf(ol[r]);
    __syncthreads();
    AT_LAS float* XD = (AT_LAS float*)lds + qblk * 32 * XROW;
    if (comp == 1) {
#pragma unroll
        for (int r = 0; r < 16; ++r)
#pragma unroll
            for (int d0 = 0; d0 < 4; ++d0) XD[crow(r, hi) * XROW + d0 * 32 + r32] = lam * (o[d0][r] * rli[r]); }
    __syncthreads();
    if (comp == 0) {
#pragma unroll
        for (int r = 0; r < 16; ++r)
#pragma unroll
            for (int d0 = 0; d0 < 4; ++d0) { const int idx = crow(r, hi) * XROW + d0 * 32 + r32; XD[idx] = o[d0][r] * rli[r] - XD[idx]; }
        asm volatile("s_waitcnt lgkmcnt(0)" ::: "memory");
        const int row = lane >> 1, half = lane & 1;
        f32x4 v[16]; float ss = 0.f;
#pragma unroll
        for (int i = 0; i < 16; ++i) { v[i] = *(const AT_LAS f32x4*)(XD + row * XROW + half * 64 + 4 * i); ss += (v[i].x * v[i].x + v[i].y * v[i].y) + (v[i].z * v[i].z + v[i].w * v[i].w); }
        ss += __shfl_xor(ss, 1);
        const float rs = 0.8f / sqrtf(ss * (1.f / 128.f) + NORM_EPS);
        bf16* yp = F.Y + (size_t)(row0 + row) * DM + h * 128 + half * 64; const float* sg = F.subln_g + half * 64;
#pragma unroll
        for (int c8 = 0; c8 < 8; ++c8) { const f32x4 g0 = *(const f32x4*)(sg + 8 * c8), g1 = *(const f32x4*)(sg + 8 * c8 + 4); const f32x4 x0 = v[2 * c8] * rs * g0, x1 = v[2 * c8 + 1] * rs * g1;
            v4u w; w.x = cvtpk(x0.x, x0.y); w.y = cvtpk(x0.z, x0.w); w.z = cvtpk(x1.x, x1.y); w.w = cvtpk(x1.z, x1.w); *(v4u*)(yp + 8 * c8) = w; }
    }
    __syncthreads();
}
__device__ __forceinline__ void win_unit(Frame& F, int b, int j32) {
    using namespace at2;
    const int wid = F.wave, lane = F.lane, r32 = lane & 31, hi = lane >> 5, h = wid, kv = h >> 2;
    const int t0 = 32 * j32, row0 = b * SEQ + t0;
    UnitArgs8 a; a.Q = (const unsigned char*)F.QB + (size_t)row0 * 512 + h * 64;
    a.K = (const unsigned char*)F.KB + (size_t)(b * KVLEN) * 128; a.VT = (const unsigned char*)F.XG + WIN_VT_OFF + (size_t)(b * 128) * KVLEN; a.comp = kv; a.ldk = 128; a.vdoff = kv * 4096; a.q0 = t0;
    { const int st = t0 - 128; int ks = st < 0 ? 0 : (st & ~63); if (ks > SEQ - 384) ks = SEQ - 384; a.ks = ks; }
    f32x16 o[2]; o[0] = f32x16{}; o[1] = f32x16{};
    float m; f32x16 ol = f32x16{};
    AT_LAS char* lds = (AT_LAS char*)F.lds;
    attn_tiles_f8<false>(a, lds, F.tid, wid, lane, o, ol, m);
    AT_LAS float* li_l = (AT_LAS float*)(lds + AT_WS3_OFF) + wid * 64;
    if (hi == 0) li_l[r32] = __builtin_amdgcn_exp2f(F.sink[h] * LOG2E - m);
    asm volatile("s_waitcnt lgkmcnt(0)" ::: "memory");
    float rli[16];
#pragma unroll
    for (int r = 0; r < 16; ++r) rli[r] = __builtin_amdgcn_rcpf(ol[r] + li_l[crow(r, hi)]);
    __syncthreads();
    AT_LAS float* XD = (AT_LAS float*)lds + wid * 32 * XROWW;
#pragma unroll
    for (int r = 0; r < 16; ++r)
#pragma unroll
        for (int d0 = 0; d0 < 2; ++d0) XD[crow(r, hi) * XROWW + d0 * 32 + r32] = o[d0][r] * rli[r];
    asm volatile("s_waitcnt lgkmcnt(0)" ::: "memory");
    const int row = lane >> 1, half = lane & 1;
    bf16* yp = F.Y + (size_t)(row0 + row) * DM + 512 + h * 64 + half * 32;
#pragma unroll
    for (int c8 = 0; c8 < 4; ++c8) { const f32x4 x0 = *(const AT_LAS f32x4*)(XD + row * XROWW + half * 32 + 8 * c8), x1 = *(const AT_LAS f32x4*)(XD + row * XROWW + half * 32 + 8 * c8 + 4);
        v4u w; w.x = cvtpk(x0.x, x0.y); w.y = cvtpk(x0.z, x0.w); w.z = cvtpk(x1.x, x1.y); w.w = cvtpk(x1.z, x1.w); *(v4u*)(yp + 8 * c8) = w; }
    __syncthreads();
}
__device__ __forceinline__ void p3_attention(Frame& F) {
    const float lam = lam_value(F);
#ifndef NO_DIFF
#pragma unroll 1
    for (int U = F.vcu * 2; U < BATCH * 4 * (SEQ / 128) * RP(F, 3); U += 2 * F.G)
#pragma unroll 1
        for (int i = 0; i < 2; ++i) { const int u = (U + i) % 512; diff_unit(F, u >> 8, (u >> 6) & 3, u & 63, lam); }
#endif
#ifndef NO_WIN
#pragma unroll 1
    for (int W = F.vcu * 2; W < BATCH * (SEQ / 32) * RP(F, 3); W += 2 * F.G)
#pragma unroll 1
        for (int i = 0; i < 2; ++i) { const int w = (W + i) % 512; win_unit(F, w >> 8, w & 255); }
#endif
}

__device__ __forceinline__ unsigned long long wave_max64(unsigned long long k) {
#pragma unroll
    for (int o = 1; o < 64; o <<= 1) { const unsigned lo = __shfl_xor((unsigned)k, o), hi = __shfl_xor((unsigned)(k >> 32), o); const unsigned long long t = ((unsigned long long)hi << 32) | lo; k = t > k ? t : k; }
    return k;
}
__device__ __forceinline__ void p5a_route(Frame& F) {
    const int npass = RP(F, 5);
    LAS float* WRT = (LAS float*)(F.lds + RING_OFF);
    LAS int* lcnt = (LAS int*)(F.lds + XTRA_OFF); LAS int* lbase = lcnt + 32; LAS int* le = lcnt + 64; LAS int* lrk = le + 256;
    for (int idx = F.tid; idx < 32768; idx += 512) { const int k = idx >> 5, e = idx & 31; WRT[e * 1024 + k] = F.w_router[idx]; }
    gu32* gcnt = F.ctl + CW_CNT;
    typedef unsigned u32x2 __attribute__((ext_vector_type(2)));
    for (int cc = blockIdx.x; cc < (NTOK / 64) * npass; cc += F.G) { const int chunk = cc % (NTOK / 64); const bool dry = cc < (NTOK / 64) * (npass - 1);
        if (F.tid < 32) lcnt[F.tid] = 0;
        __syncthreads();
        const int b = (chunk * 64) >> 13; const float* mv = F.modv + b * 6144;
#pragma unroll 1
        for (int grp = 0; grp < 2; ++grp) {
            const int row0 = chunk * 64 + F.wave * 8 + grp * 4;
            f32x4 xv[4][4]; float ss[4];
#pragma unroll
            for (int r = 0; r < 4; ++r) { float s = 0.f;
#pragma unroll
                for (int j = 0; j < 4; ++j) { { const u32x2 t_ = *(const u32x2*)((const bf16*)F.X1 + (size_t)(row0 + r) * DM + 4 * F.lane + 256 * j); xv[r][j] = (f32x4){bflo(t_.x), bfhi(t_.x), bflo(t_.y), bfhi(t_.y)}; } s += (xv[r][j].x * xv[r][j].x + xv[r][j].y * xv[r][j].y) + (xv[r][j].z * xv[r][j].z + xv[r][j].w * xv[r][j].w); }
                ss[r] = 1.0f / sqrtf(wave_sum(s) * (1.f / DM) + NORM_EPS); }
#pragma unroll
            for (int j = 0; j < 4; ++j) { const int col = 4 * F.lane + 256 * j; const f32x4 g = *(const f32x4*)(F.norm2_g + col), sh = *(const f32x4*)(mv + 3072 + col), sc = *(const f32x4*)(mv + 4096 + col);
                const f32x4 ga = g * (sc + 1.0f);
#pragma unroll
                for (int r = 0; r < 4; ++r) { xv[r][j] = (xv[r][j] * ss[r]) * ga + sh;
                    *(unsigned*)((unsigned char*)F.XN + (size_t)(row0 + r) * DM + col) = pk4_fp8(xv[r][j].x, xv[r][j].y, xv[r][j].z, xv[r][j].w); } }
            float logit[4] = {0.f, 0.f, 0.f, 0.f};
            const bool up = (F.lane & 32) != 0, up2 = (F.lane & 16) != 0; const int myg = (F.lane >> 1) & 7;
#pragma unroll 1
            for (int g = 0; g < 8; ++g) {
                float a[4][4];
#pragma unroll
                for (int r = 0; r < 4; ++r)
#pragma unroll
                    for (int ee = 0; ee < 4; ++ee) a[r][ee] = 0.f;
                const LAS float* wb = WRT + g * 4096 + 4 * F.lane;
#pragma unroll
                for (int ee = 0; ee < 4; ++ee)
#pragma unroll
                    for (int j = 0; j < 4; ++j) { const f32x4 w = *(const LAS f32x4*)(wb + ee * 1024 + 256 * j);
#pragma unroll
                        for (int r = 0; r < 4; ++r) a[r][ee] += (xv[r][j].x * w.x + xv[r][j].y * w.y) + (xv[r][j].z * w.z + xv[r][j].w * w.w); }
#pragma unroll
                for (int r = 0; r < 4; ++r) {
                    const float v0 = (up ? a[r][2] : a[r][0]) + __shfl_xor(up ? a[r][0] : a[r][2], 32);
                    const float v1 = (up ? a[r][3] : a[r][1]) + __shfl_xor(up ? a[r][1] : a[r][3], 32);
                    float v = (up2 ? v1 : v0) + __shfl_xor(up2 ? v0 : v1, 16);
                    v += __shfl_xor(v, 1); v += __shfl_xor(v, 2); v += __shfl_xor(v, 4); v += __shfl_xor(v, 8);
                    if (myg == g) logit[r] = v;
                }
            }
            const int e = 4 * myg + (up ? 2 : 0) + (up2 ? 1 : 0);
            const float br = F.b_router[e];
#pragma unroll
            for (int r = 0; r < 4; ++r) {
                unsigned u = __float_as_uint(logit[r] + br); u = (u & 0x80000000u) ? ~u : (u | 0x80000000u);
                unsigned long long key = ((unsigned long long)u << 32) | (unsigned)(31 - e);
                int ek[4]; float vk[4];
#pragma unroll
                for (int k = 0; k < 4; ++k) { const unsigned long long mx = wave_max64(key); ek[k] = 31 - (int)(mx & 31u); unsigned uu = (unsigned)(mx >> 32); uu = (uu & 0x80000000u) ? (uu & 0x7fffffffu) : ~uu; vk[k] = __uint_as_float(uu);
                    if (e == ek[k]) key = 0ull; }
                const float p1 = __expf(vk[1] - vk[0]), p2 = __expf(vk[2] - vk[0]), p3 = __expf(vk[3] - vk[0]); const float inv = 1.0f / (1.0f + p1 + p2 + p3);
                if (F.lane < 4 && !dry) { const int k = F.lane; const int ee = k == 0 ? ek[0] : (k == 1 ? ek[1] : (k == 2 ? ek[2] : ek[3])); const float gg = (k == 0 ? 1.0f : (k == 1 ? p1 : (k == 2 ? p2 : p3))) * inv;
                    const int rl = F.wave * 8 + grp * 4 + r; const int rank = __hip_atomic_fetch_add(lcnt + ee, 1, __ATOMIC_RELAXED, __HIP_MEMORY_SCOPE_WORKGROUP);
                    le[rl * 4 + k] = ee; lrk[rl * 4 + k] = rank; F.rgate[(size_t)(row0 + r) * 4 + k] = gg; }
            }
        }
        __syncthreads();
        if (F.tid < 32 && !dry) lbase[F.tid] = (int)__hip_atomic_fetch_add(gcnt + F.tid, (unsigned)lcnt[F.tid], __ATOMIC_RELAXED, __HIP_MEMORY_SCOPE_AGENT);
        __syncthreads();
        if (F.tid < 256 && !dry) { const int row = chunk * 64 + (F.tid >> 2), k = F.tid & 3; const int ee = le[F.tid]; const int slot = lbase[ee] + lrk[F.tid]; F.re[(size_t)row * 4 + k] = ee; F.rslot[(size_t)row * 4 + k] = slot; F.elist[ee * NTOK + slot] = row; }
        __syncthreads();
    }
}
__device__ __forceinline__ int expert_tables(Frame& F, LAS int* pst, LAS int* pexp) {
    LAS int* npan = pst + 40; LAS int* cntT = pexp + 320;
    if (F.tid == 0) { int P = 0; for (int e = 0; e < NEXP; ++e) { const int cnt = (int)__hip_atomic_load(F.ctl + CW_CNT + e, __ATOMIC_RELAXED, __HIP_MEMORY_SCOPE_AGENT); cntT[e] = cnt; pst[e] = P * 256; const int np = (cnt + 255) >> 8; for (int i = 0; i < np; ++i) pexp[P + i] = e; P += np; } pst[32] = P * 256; npan[0] = P; }
    __syncthreads();
    return npan[0];
}
__device__ __forceinline__ void p5b_scatter(Frame& F) {
    LAS int* pst = (LAS int*)(F.lds + XTRA_OFF); LAS int* pexp = pst + 64;
    (void)expert_tables(F, pst, pexp);
    const int gw = F.vcu * NWAVES + F.wave, NGW = F.G * NWAVES;
    for (int rr = gw; rr < NTOK * RP(F, 6); rr += NGW) { const int row = rr % NTOK;
        const v4u a = *(const v4u*)(F.XN + (size_t)row * DM + 8 * F.lane), b = *(const v4u*)(F.XN + (size_t)row * DM + 512 + 8 * F.lane);
#pragma unroll
        for (int k = 0; k < 4; ++k) { const int e = F.re[(size_t)row * 4 + k]; const int pos = pst[e] + F.rslot[(size_t)row * 4 + k];
            if (F.lane == 0) F.rpos[(size_t)row * 4 + k] = pos;
            *(v4u*)(F.XG + (size_t)pos * DM + 8 * F.lane) = a; *(v4u*)(F.XG + (size_t)pos * DM + 512 + 8 * F.lane) = b; }
    }
}
__device__ __forceinline__ void p8_final(Frame& F) {
    LAS int* pst = (LAS int*)(F.lds + XTRA_OFF); LAS int* pexp = pst + 64;
    (void)expert_tables(F, pst, pexp);
    const int gw = F.vcu * NWAVES + F.wave, NGW = F.G * NWAVES;
    typedef unsigned u32x2 __attribute__((ext_vector_type(2)));
    for (int pp = gw; pp < (NTOK / 2) * RP(F, 9); pp += NGW) { const int row0 = (pp % (NTOK / 2)) * 2;
        const float* g2 = F.modv + (row0 >> 13) * 6144 + 5120;
        int pos[2][4]; float gt[2][4];
#pragma unroll
        for (int q = 0; q < 2; ++q)
#pragma unroll
            for (int k = 0; k < 4; ++k) { const size_t ix = (size_t)(row0 + q) * 4 + k; pos[q][k] = pst[F.re[ix]] + F.rslot[ix]; gt[q][k] = F.rgate[ix]; }
        f32x4 xv[2][4]; unsigned yv[2][4][4];
#pragma unroll
        for (int q = 0; q < 2; ++q)
#pragma unroll
            for (int j = 0; j < 4; ++j) { const int col = 4 * F.lane + 256 * j; { const u32x2 t_ = *(const u32x2*)((const bf16*)F.X1 + (size_t)(row0 + q) * DM + col); xv[q][j] = (f32x4){bflo(t_.x), bfhi(t_.x), bflo(t_.y), bfhi(t_.y)}; }
#pragma unroll
                for (int k = 0; k < 4; ++k) yv[q][j][k] = *(const unsigned*)((const unsigned char*)F.Y2 + (size_t)pos[q][k] * DM + col); }
#pragma unroll
        for (int q = 0; q < 2; ++q) { float s = 0.f;
#pragma unroll
            for (int j = 0; j < 4; ++j) { const int col = 4 * F.lane + 256 * j; f32x4 a = {0.f, 0.f, 0.f, 0.f};
#pragma unroll
                for (int k = 0; k < 4; ++k) { const unsigned y = yv[q][j][k]; const auto lo2 = __builtin_amdgcn_cvt_pk_f32_fp8((int)y, false), hi2 = __builtin_amdgcn_cvt_pk_f32_fp8((int)y, true); a += (f32x4){lo2[0], lo2[1], hi2[0], hi2[1]} * gt[q][k]; }
                xv[q][j] = xv[q][j] + *(const f32x4*)(g2 + col) * a;
                s += (xv[q][j].x * xv[q][j].x + xv[q][j].y * xv[q][j].y) + (xv[q][j].z * xv[q][j].z + xv[q][j].w * xv[q][j].w); }
            const float rstd = 1.0f / sqrtf(wave_sum(s) * (1.f / DM) + NORM_EPS);
#pragma unroll
            for (int j = 0; j < 4; ++j) { const int col = 4 * F.lane + 256 * j; __builtin_nontemporal_store(xv[q][j] * rstd * *(const f32x4*)(F.final_g + col), (f32x4*)(F.out + (size_t)(row0 + q) * DM + col)); } }
    }
}

#ifndef FAST_GEMM
#define FAST_GEMM 1
#endif
#ifndef FAST_ATTN
#define FAST_ATTN 1
#endif
constexpr int N_PHASES = 10;
struct Args { const float* in[23]; float* out; unsigned char* ws; int ph_lo, ph_hi, use_bar, pad; };
__global__ void __launch_bounds__(NWAVES * 64, 2) mk_fwd(Args args) {
    extern __shared__ __attribute__((aligned(16))) unsigned char lds[];
    Frame F;
    F.lds = (LAS unsigned char*)lds; F.MISC = (volatile LAS unsigned*)(F.lds + MISC_OFF);
    F.tid = threadIdx.x; F.lane = F.tid & 63; F.wave = __builtin_amdgcn_readfirstlane(F.tid >> 6);
    F.probe = args.pad; F.G = gridDim.x; { const int bx = blockIdx.x; F.vcu = (F.G % 8 == 0) ? (bx % 8) * (F.G / 8) + bx / 8 : bx; }
    unsigned char* ws = args.ws;
    F.ctl = (gu32*)(ws + WS_CTL);
    F.x = args.in[0]; F.c = args.in[1]; F.ctx = args.in[2]; F.c_ctx = args.in[3]; F.w_mod = args.in[4]; F.b_mod = args.in[5]; F.norm1_g = args.in[6]; F.w_in = args.in[7];
    F.lq1 = args.in[8]; F.lk1 = args.in[9]; F.lq2 = args.in[10]; F.lk2 = args.in[11]; F.subln_g = args.in[12]; F.sink = args.in[13]; F.w_out = args.in[14]; F.norm2_g = args.in[15];
    F.w_router = args.in[16]; F.b_router = args.in[17]; F.w_gu = args.in[18]; F.b_gu = args.in[19]; F.w_dn = args.in[20]; F.b_dn = args.in[21]; F.final_g = args.in[22];
    F.out = args.out;
    F.modp = (float*)(ws + WS_MODP); F.modv = (float*)(ws + WS_MODV); F.rope = (float*)(ws + WS_ROPE); F.X1 = (float*)(ws + WS_X1);
    F.elist = (int*)(ws + WS_ELIST); F.re = (int*)(ws + WS_ROUTE); F.rslot = F.re + NTOK * 4; F.rgate = (float*)(F.rslot + NTOK * 4); F.rpos = (int*)(F.rgate + NTOK * 4);
    F.Win_t = (bf16*)(ws + WS_WIN); F.Wout_t = (bf16*)(ws + WS_WOUT); F.Wgu_t = (bf16*)(ws + WS_WGU); F.Wdn_t = (bf16*)(ws + WS_WDN);
    F.XN = (bf16*)(ws + WS_XN); F.QA = (bf16*)(ws + WS_QA); F.KA = (bf16*)(ws + WS_KA); F.VA = (bf16*)(ws + WS_VA); F.QB = (bf16*)(ws + WS_QB); F.KB = (bf16*)(ws + WS_KB); F.VB = (bf16*)(ws + WS_VB);
    F.Y = (bf16*)(ws + WS_Y); F.XG = (bf16*)(ws + WS_XG); F.H = (bf16*)(ws + WS_H); F.Y2 = (bf16*)(ws + WS_Y2);
    for (int u = F.tid; u < (LDS_BYTES - LDSCTL_OFF) / 4; u += NWAVES * 64) ((LAS unsigned*)(F.lds + LDSCTL_OFF))[u] = 0u;
    __syncthreads();
#ifdef SPIN_SEAM
#define STAMP(k) do { if ((k) == SPIN_SEAM && blockIdx.x == 0 && F.tid == 0) *(volatile LAS unsigned long long*)(F.lds + XTRA_OFF + 15008) = wall_clock64(); } while (0)
    if (blockIdx.x == 0 && F.tid == 0) { const unsigned long long t_ = wall_clock64(); *(volatile LAS unsigned long long*)(F.lds + XTRA_OFF + 15000) = t_; *(volatile LAS unsigned long long*)(F.lds + XTRA_OFF + 15008) = t_; }
#else
#define STAMP(k) do {} while (0)
#endif
    XcdBarrier bar; bar.bar = (unsigned*)(F.ctl + CW_BAR); bar.x = 0; bar.st = nullptr;
    if (args.use_bar) bar = xcd_barrier_post((unsigned*)(F.ctl + CW_BAR), F.MISC + 8);
    const int lo = args.ph_lo, hi = args.ph_hi;
#ifndef PH_MASK
#define PH_MASK 0x3ff
#endif
#define IN(k) (((PH_MASK >> (k)) & 1) && lo <= (k) && (k) < hi)
#ifndef REP_MASK
#define REP_MASK 0
#endif
#define SEAM(k) do { if (IN(k) && IN((k) + 1)) { if (args.use_bar) { xcd_barrier(bar); if (args.pad & 0x10000) { xcd_barrier(bar); xcd_barrier(bar); } } } else { __syncthreads(); } } while (0)

    if (IN(0)) { p0_prologue(F); } SEAM(0); STAMP(0);
    if (IN(1)) { p1_norm(F); } SEAM(1); STAMP(1);
    if (IN(2)) {
        EpiQKV E{F.QA, F.KA, F.VA, F.QB, F.KB, F.VB, F.rope};
#if FAST_GEMM
        pg8::Gemm g{F.XN, F.Win_t, NROW, INC, DM}; RepOrder S; S.init(NROW, INC, F.G, (int)blockIdx.x); S.rep = RP(F, 2);
        EpiQKVFast EA{F.QA, F.KA, F.VA, F.QB, F.KB, F.VB, F.rope};
        pg8::gemm_phase<EpiQKVFast, RepOrder, true, true>(F.lds + RING_OFF, g, S, EA);
        if (F.G == 256 && blockIdx.x >= 82) p0_tail(F);
#else
        naive_gemm(F, F.XN, NROW / 128, INC, DM, DenseSel{F.Win_t}, E);
#endif
    } SEAM(2); STAMP(2);
#if FAST_ATTN == 1
    if (IN(3)) { p3_vt_pass(F); if (args.use_bar) xcd_barrier(bar); else __syncthreads(); STAMP(10); p3_attention(F); } SEAM(3); STAMP(3);
#else
    if (IN(3)) { naive_diff_attn(F); __syncthreads(); naive_win_attn(F); } SEAM(3); STAMP(3);
#endif
    if (IN(4)) {
        EpiOut E{F.x, F.modv, F.X1};
#if FAST_GEMM
        pg8::Gemm g{F.Y, F.Wout_t, NTOK, DM, DM}; RepOrder S; S.init(NTOK, DM, F.G, (int)blockIdx.x); S.rep = RP(F, 4);
        EpiAdapt<EpiOut, 0> EA{E};
        pg8::gemm_phase<EpiAdapt<EpiOut, 0>, RepOrder, true, true>(F.lds + RING_OFF, g, S, EA);
#else
        naive_gemm(F, F.Y, NTOK / 128, DM, DM, DenseSel{F.Wout_t}, E);
#endif
    } SEAM(4); STAMP(4);
    if (IN(5)) { p5a_route(F); } SEAM(5); STAMP(5);
    if (IN(7)) {
        LAS int* pst = (LAS int*)(F.lds + XTRA_OFF); LAS int* pexp = pst + 64; LAS int* cntT = pexp + 320; LAS int* tokT = (LAS int*)(F.lds + XTRA_OFF + 2048);
        const int NP = expert_tables(F, pst, pexp);
        EpiGU E{(unsigned char*)F.H, F.b_gu};
        GroupedOrder S{GUW / 256, NP, F.G, (int)blockIdx.x, pexp, RP(F, 7), tokT};
        { const int R = S.rounds();
          for (int i0 = 0; i0 < R; i0 += 2) { const int i = i0 + (F.tid >> 8), r = F.tid & 255; pg8::Unit u; GroupedOrder S1 = S; S1.rep = 1;
              if (i < R && S1.next(i, u)) { const int e = pexp[u.pm], sl = u.pm * 256 - pst[e] + r; tokT[i * 256 + r] = sl < cntT[e] ? F.elist[e * NTOK + sl] : 0; } }
          __syncthreads(); }
#if FAST_GEMM
        pg8::Gemm g{F.XN, F.Wgu_t, NP * 256, GUW, DM / 2};
        EpiAdapt<EpiGU, GUW / 256> EA{E};
        pg8::gemm_phase<EpiAdapt<EpiGU, GUW / 256>, GroupedOrder, true, true, true, true>(F.lds + RING_OFF, g, S, EA);
#else
#error "the naive GEMM path has no gather"
#endif
    } SEAM(7); STAMP(7);
    if (IN(8)) {
        LAS int* pst = (LAS int*)(F.lds + XTRA_OFF); LAS int* pexp = pst + 64;
        const int NP = expert_tables(F, pst, pexp);
        EpiDN E{F.Y2, F.b_dn};
#if FAST_GEMM
        pg8::Gemm g{F.H, F.Wdn_t, NP * 256, DM, DM / 2}; GroupedOrder S{DM / 256, NP, F.G, (int)blockIdx.x, pexp, RP(F, 8), nullptr};
        EpiAdaptP<EpiDN, DM / 256> EA{E};
        pg8::gemm_phase<EpiAdaptP<EpiDN, DM / 256>, GroupedOrder, true, true, false, true>(F.lds + RING_OFF, g, S, EA);
#else
        naive_gemm(F, F.H, NP * 2, DM, DM, GroupSel{F.Wdn_t, pexp, DM, DM}, E);
#endif
    } SEAM(8); STAMP(8);
    if (IN(9)) { p8_final(F); }
#ifdef SPIN_SEAM
    if (blockIdx.x == 0 && F.tid == 0) { const unsigned long long t0_ = *(volatile LAS unsigned long long*)(F.lds + XTRA_OFF + 15000), tk_ = *(volatile LAS unsigned long long*)(F.lds + XTRA_OFF + 15008);
        const unsigned long long te_ = wall_clock64(); while (wall_clock64() - te_ < tk_ - t0_) __builtin_amdgcn_s_sleep(8); }
#endif
#undef STAMP
#undef IN
#undef SEAM
}

#ifndef N_LAUNCH_MODE
#define N_LAUNCH_MODE 0
#endif
extern "C" void kernel_launch(void* const* d_in, const int* in_sizes, int n_in, void* d_out, int out_size, void* d_ws, size_t ws_size, hipStream_t stream) {
    static int grid = 0;
    if (grid == 0) {
        if (n_in != 23 || in_sizes[0] != NTOK * DM || out_size != NTOK * DM || ws_size < WS_END) { fprintf(stderr, "kernel_launch: unexpected shapes (n_in %d, in0 %d, out %d, ws %zu); nothing launched\n", n_in, n_in > 0 ? in_sizes[0] : -1, out_size, ws_size); grid = -1; return; }
        int dev = 0, cus = 0, per_cu = 0;
        if (hipGetDevice(&dev) != hipSuccess || hipDeviceGetAttribute(&cus, hipDeviceAttributeMultiprocessorCount, dev) != hipSuccess) { grid = -1; return; }
        if (hipFuncSetAttribute((const void*)mk_fwd, hipFuncAttributeMaxDynamicSharedMemorySize, LDS_BYTES) != hipSuccess) { fprintf(stderr, "kernel_launch: hipFuncSetAttribute failed\n"); grid = -1; return; }
        if (hipOccupancyMaxActiveBlocksPerMultiprocessor(&per_cu, (const void*)mk_fwd, NWAVES * 64, LDS_BYTES) != hipSuccess || per_cu < 1) fprintf(stderr, "kernel_launch: note: occupancy query reports %d\n", per_cu);
        (void)hipGetLastError();
        grid = cus;
    }
    if (grid < 0) return;
    if (hipMemsetAsync((char*)d_ws + WS_CTL, 0, CTL_ZERO_BYTES, stream) != hipSuccess) { fprintf(stderr, "kernel_launch: memset failed\n"); return; }
    Args a{};
    for (int i = 0; i < 23; ++i) a.in[i] = (const float*)d_in[i];
    a.out = (float*)d_out; a.ws = (unsigned char*)d_ws; a.pad = REP_MASK;
#if N_LAUNCH_MODE == 0
    a.ph_lo = 0; a.ph_hi = N_PHASES; a.use_bar = 1;
    hipLaunchKernelGGL(mk_fwd, dim3(grid), dim3(NWAVES * 64), LDS_BYTES, stream, a);
#else
    for (int p = 0; p < N_PHASES; ++p) { a.ph_lo = p; a.ph_hi = p + 1; a.use_bar = 0; hipLaunchKernelGGL(mk_fwd, dim3(grid), dim3(NWAVES * 64), LDS_BYTES, stream, a); }
#endif
}
```

```cpp
#include <hip/hip_runtime.h>
#include <cstdio>
#include <cstdint>
namespace pg8 {
#define PG8_LAS __attribute__((address_space(3)))
typedef unsigned short bf16_t;
typedef short bf16x8 __attribute__((ext_vector_type(8)));
typedef float f32x4 __attribute__((ext_vector_type(4)));
typedef unsigned u32x4 __attribute__((ext_vector_type(4)));
constexpr int BM = 256, BK = 64, HALF = 128, HTB = HALF * BK * 2  , STAGE_BYTES = 8 * HTB, NXCD = 8, WGM = 8;

__host__ __device__ __forceinline__ int lds_byte(int r, int c) { const int st = (r >> 4) * 2 + (c >> 5), rr = r & 15, cc = c & 31, ob = rr * 64 + cc * 2; return st * 1024 + (ob ^ (((ob >> 9) & 1) << 5)); }
__host__ __device__ __forceinline__ void stage_rc(int b, int& R, int& C) { const int st = b / 1024, sb = b % 1024, swz = sb ^ (((sb >> 9) & 1) << 5); R = (st >> 1) * 16 + swz / 64; C = (st & 1) * 32 + (swz % 64) / 2; }
__host__ __device__ __forceinline__ int perm32(int rho) { const int n = rho >> 4, i = rho & 15; return 8 * (i >> 2) + 4 * n + (i & 3); }

struct Unit { int pm, pn; };
struct Gemm { const bf16_t* A; const bf16_t* Bt; int M, N, K; };

struct StaticOrder {
    int nM, nN, nwg, G, c;
    __host__ __device__ void init(int M, int N, int G_, int c_) { nM = M / BM; nN = N / BM; nwg = nM * nN; G = G_; c = c_; }
    __host__ __device__ bool next(int i, Unit& u) const {
        const long L = (long)i * G + c; if (L >= nwg) return false;
        int wgid = (int)L; { const int q = nwg / NXCD, r = nwg % NXCD, xcd = wgid % NXCD, off = wgid / NXCD; wgid = (xcd < r ? xcd * (q + 1) : r * (q + 1) + (xcd - r) * q) + off; }
        const int nig = WGM * nN, gid = wgid / nig, fm = gid * WGM, gsz = (nM - fm) < WGM ? (nM - fm) : WGM;
        u.pm = fm + ((wgid % nig) % gsz); u.pn = (wgid % nig) / gsz; return true;
    }
    __device__ __forceinline__ void a_ready(const Unit&) const {}
    __device__ __forceinline__ void done(const Unit&) const {}
};

__device__ __forceinline__ unsigned cvt_pk_bf16(float lo, float hi) { unsigned r; asm volatile("v_cvt_pk_bf16_f32 %0, %1, %2" : "=v"(r) : "v"(lo), "v"(hi)); return r; }
typedef float f32x2 __attribute__((ext_vector_type(2)));
typedef int i32x4 __attribute__((ext_vector_type(4))); typedef int i32x8 __attribute__((ext_vector_type(8)));
__device__ __forceinline__ i32x8 cat8(bf16x8 a, bf16x8 b) { const i32x4 x = __builtin_bit_cast(i32x4, a), y = __builtin_bit_cast(i32x4, b); return __builtin_shufflevector(x, y, 0, 1, 2, 3, 4, 5, 6, 7); }
template <class Epi, class Sched, bool ALIGN_EPI = false, bool SP2 = false, bool GATHER = false, bool FP8 = false>
__device__ __forceinline__ void gemm_phase(PG8_LAS unsigned char* lds, const Gemm g, const Sched& S, const Epi& E) {
    const int tid = threadIdx.x, wid = __builtin_amdgcn_readfirstlane(tid >> 6), lane = tid & 63, wr = wid >> 2, wc = wid & 3, fr = lane & 15, fq = lane >> 4;
    const int K = g.K, nt = K / BK;
    unsigned voffA[2], voffB[2]; int RA[2]; unsigned CA2[2];
#pragma unroll
    for (int i = 0; i < 2; ++i) { int R, C; stage_rc(tid * 16 + i * 8192, R, C); const int Rb = Epi::PERM ? ((R & ~31) + perm32(R & 31)) : R;
        voffA[i] = (unsigned)(R * K + C) * 2u; voffB[i] = (unsigned)(Rb * K + C) * 2u; RA[i] = R; CA2[i] = (unsigned)C * 2u; }
    static_assert(!GATHER || SP2, "GATHER is wired into the SP2 loop only");
    unsigned gA[2][2], gN[2][2];
    const size_t kstep = (size_t)(BK * 2);
    const size_t hstep = (size_t)HALF * K * 2;
    const size_t tstep = 2 * hstep;
    const unsigned ldsw = (unsigned)wid * 1024u;
    const int aoff = lds_byte(wr * 64 + fr, fq * 8), boff = lds_byte(wc * 32 + fr, fq * 8);
#define PG8_SA(b, h) (((b) * 2 + (h)) * HTB)
#define PG8_SB(b, h) ((4 + (b) * 2 + (h)) * HTB)
#define PG8_STAGE(bufoff, gbase, voff) do { _Pragma("unroll") for (int _i = 0; _i < 2; ++_i) \
        __builtin_amdgcn_global_load_lds((const unsigned*)((const char*)(gbase) + (voff)[_i]), (PG8_LAS unsigned*)(lds + (bufoff) + ldsw + _i * 8192), 16, 0, 0); } while (0)
#define PG8_STAGEG(bufoff, kbytes, v0, v1) do { \
        __builtin_amdgcn_global_load_lds((const unsigned*)((const char*)g.A + (kbytes) + (v0)), (PG8_LAS unsigned*)(lds + (bufoff) + ldsw), 16, 0, 0); \
        __builtin_amdgcn_global_load_lds((const unsigned*)((const char*)g.A + (kbytes) + (v1)), (PG8_LAS unsigned*)(lds + (bufoff) + ldsw + 8192), 16, 0, 0); } while (0)
#define PG8_GOFF(dst, ui_) do { _Pragma("unroll") for (int h_ = 0; h_ < 2; ++h_) _Pragma("unroll") for (int i_ = 0; i_ < 2; ++i_) dst[h_][i_] = (unsigned)S.tok((ui_), h_ * HALF + RA[i_]) * (unsigned)(K * 2) + CA2[i_]; } while (0)
#define PG8_LDA(dst, b, h) do { _Pragma("unroll") for (int m = 0; m < 4; ++m) _Pragma("unroll") for (int k = 0; k < 2; ++k) dst[m][k] = *(const PG8_LAS bf16x8*)(lds + PG8_SA(b, h) + aoff + m * 2048 + k * 1024); } while (0)
#define PG8_LDB(dst, b, h) do { _Pragma("unroll") for (int n = 0; n < 2; ++n) _Pragma("unroll") for (int k = 0; k < 2; ++k) dst[n][k] = *(const PG8_LAS bf16x8*)(lds + PG8_SB(b, h) + boff + n * 2048 + k * 1024); } while (0)
#define PG8_MMA(ai, bj, At, Bt) do { __builtin_amdgcn_s_setprio(1); _Pragma("unroll") for (int m = 0; m < 4; ++m) _Pragma("unroll") for (int n = 0; n < 2; ++n) { \
        if constexpr (FP8) { const i32x8 a8_ = cat8(Bt[n][0], Bt[n][1]), b8_ = cat8(At[m][0], At[m][1]); \
            asm volatile("v_mfma_scale_f32_16x16x128_f8f6f4 %0, %1, %2, %0, %3, %4 op_sel_hi:[0,0,0]" : "+v"(acc[ai][bj][m][n]) : "v"(a8_), "v"(b8_), "v"(sc_w8), "v"(sc_a8)); } \
        else { _Pragma("unroll") for (int k = 0; k < 2; ++k) acc[ai][bj][m][n] = __builtin_amdgcn_mfma_f32_16x16x32_bf16(Bt[n][k], At[m][k], acc[ai][bj][m][n], 0, 0, 0); } } \
        __builtin_amdgcn_s_setprio(0); } while (0)
#define PG8_WAIT_V(n) asm volatile("s_waitcnt vmcnt(" #n ")" ::: "memory")
#define PG8_WAIT_L(n) asm volatile("s_waitcnt lgkmcnt(" #n ")" ::: "memory")
#define PG8_BAR __builtin_amdgcn_s_barrier()
#define PG8_SCHED __builtin_amdgcn_sched_barrier(0)
    int sc_w8 = 0x7A7A7A7A, sc_a8 = 0x7F7F7F7F;
    asm volatile("" : "+v"(sc_w8), "+v"(sc_a8));
    Unit cur, nxt; int ui = 0;
    if (!S.next(0, cur)) return;
    f32x4 acc[2][2][4][2];
#pragma unroll
    for (int a = 0; a < 2; ++a)
#pragma unroll
        for (int b = 0; b < 2; ++b)
#pragma unroll
            for (int m = 0; m < 4; ++m)
#pragma unroll
                for (int n = 0; n < 2; ++n) acc[a][b][m][n] = (f32x4){0.f, 0.f, 0.f, 0.f};
    bf16x8 At[4][2], B0[2][2], B1[2][2];
    const char* cA = (const char*)g.A + (size_t)cur.pm * tstep; const char* cB = (const char*)g.Bt + (size_t)cur.pn * tstep;
    S.a_ready(cur);
    if constexpr (SP2) {
        if constexpr (GATHER) { PG8_GOFF(gA, 0); }
        PG8_STAGE(PG8_SB(0, 0), cB, voffB); PG8_STAGE(PG8_SB(0, 1), cB + hstep, voffB);
        if constexpr (GATHER) { PG8_STAGEG(PG8_SA(0, 0), 0, gA[0][0], gA[0][1]); PG8_STAGEG(PG8_SA(0, 1), 0, gA[1][0], gA[1][1]); } else { PG8_STAGE(PG8_SA(0, 0), cA, voffA); PG8_STAGE(PG8_SA(0, 1), cA + hstep, voffA); }
        if (wr == 1) PG8_BAR;
        PG8_WAIT_V(2); PG8_BAR;
        PG8_STAGE(PG8_SB(1, 0), cB + kstep, voffB); if constexpr (GATHER) { PG8_STAGEG(PG8_SA(1, 0), kstep, gA[0][0], gA[0][1]); } else { PG8_STAGE(PG8_SA(1, 0), cA + kstep, voffA); } PG8_STAGE(PG8_SB(1, 1), cB + hstep + kstep, voffB);
        PG8_WAIT_V(6); PG8_BAR;
    } else {
        PG8_STAGE(PG8_SB(0, 0), cB, voffB); PG8_STAGE(PG8_SA(0, 0), cA, voffA); PG8_STAGE(PG8_SB(0, 1), cB + hstep, voffB); PG8_STAGE(PG8_SA(0, 1), cA + hstep, voffA);
        if (wr == 1) PG8_BAR;
        PG8_WAIT_V(4); PG8_BAR;
        PG8_STAGE(PG8_SB(1, 0), cB + kstep, voffB); PG8_STAGE(PG8_SA(1, 0), cA + kstep, voffA); PG8_STAGE(PG8_SB(1, 1), cB + hstep + kstep, voffB);
        PG8_WAIT_V(6); PG8_BAR;
    }
    for (;;) {
        const bool has_next = S.next(ui + 1, nxt);
        const char* nA = has_next ? (const char*)g.A + (size_t)nxt.pm * tstep : cA; const char* nB = has_next ? (const char*)g.Bt + (size_t)nxt.pn * tstep : cB;
        if constexpr (GATHER) { if (has_next) { PG8_GOFF(gN, ui + 1); } else { _Pragma("unroll") for (int h_ = 0; h_ < 2; ++h_) _Pragma("unroll") for (int i_ = 0; i_ < 2; ++i_) gN[h_][i_] = gA[h_][i_]; } }
#pragma unroll 1
        for (int t = 0; t < nt; t += 2) {
            const bool last = (t == nt - 2);
            const char* a1 = cA + (size_t)(t + 1) * kstep;
            const char* a2 = last ? nA : cA + (size_t)(t + 2) * kstep; const char* b2 = last ? nB : cB + (size_t)(t + 2) * kstep;
            const char* a3 = a2 + kstep; const char* b3 = b2 + kstep;
            if (last && has_next) S.a_ready(nxt);
            if constexpr (SP2) {
            const size_t k1_ = (size_t)(t + 1) * kstep, k2_ = last ? (size_t)0 : (size_t)(t + 2) * kstep;
            const unsigned s00_ = last ? gN[0][0] : gA[0][0], s01_ = last ? gN[0][1] : gA[0][1], s10_ = last ? gN[1][0] : gA[1][0], s11_ = last ? gN[1][1] : gA[1][1];
            PG8_LDB(B0, 0, 0); PG8_LDB(B1, 0, 1); PG8_SCHED; PG8_LDA(At, 0, 0); if constexpr (GATHER) { PG8_STAGEG(PG8_SA(1, 1), k1_, gA[1][0], gA[1][1]); } else { PG8_STAGE(PG8_SA(1, 1), a1 + hstep, voffA); }
            PG8_WAIT_V(8); PG8_WAIT_L(0); PG8_BAR; PG8_MMA(0, 0, At, B0); PG8_MMA(0, 1, At, B1); PG8_BAR; PG8_SCHED;
            PG8_LDA(At, 0, 1); PG8_STAGE(PG8_SB(0, 0), b2, voffB); PG8_STAGE(PG8_SB(0, 1), b2 + hstep, voffB); if constexpr (GATHER) { PG8_STAGEG(PG8_SA(0, 0), k2_, s00_, s01_); } else { PG8_STAGE(PG8_SA(0, 0), a2, voffA); }
            PG8_WAIT_V(8); PG8_WAIT_L(0); PG8_BAR; PG8_MMA(1, 0, At, B0); PG8_MMA(1, 1, At, B1); PG8_BAR; PG8_SCHED;
            PG8_LDB(B0, 1, 0); PG8_LDB(B1, 1, 1); PG8_SCHED; PG8_LDA(At, 1, 0); if constexpr (GATHER) { PG8_STAGEG(PG8_SA(0, 1), k2_, s10_, s11_); } else { PG8_STAGE(PG8_SA(0, 1), a2 + hstep, voffA); }
            PG8_WAIT_V(8); PG8_WAIT_L(0); PG8_BAR; PG8_MMA(0, 0, At, B0); PG8_MMA(0, 1, At, B1); PG8_BAR; PG8_SCHED;
            PG8_LDA(At, 1, 1); PG8_STAGE(PG8_SB(1, 0), b3, voffB); PG8_STAGE(PG8_SB(1, 1), b3 + hstep, voffB); if constexpr (GATHER) { PG8_STAGEG(PG8_SA(1, 0), k2_ + kstep, s00_, s01_); } else { PG8_STAGE(PG8_SA(1, 0), a3, voffA); }
            PG8_WAIT_V(8); PG8_WAIT_L(0); PG8_BAR; PG8_MMA(1, 0, At, B0); PG8_MMA(1, 1, At, B1); PG8_BAR; PG8_SCHED;
            } else {
            PG8_LDB(B0, 0, 0); PG8_SCHED; PG8_LDA(At, 0, 0); PG8_STAGE(PG8_SA(1, 1), a1 + hstep, voffA);
            PG8_WAIT_L(8); PG8_BAR; PG8_WAIT_L(0); PG8_MMA(0, 0, At, B0); PG8_BAR; PG8_SCHED;
            PG8_LDB(B1, 0, 1); PG8_STAGE(PG8_SB(0, 0), b2, voffB);
            PG8_BAR; PG8_WAIT_L(0); PG8_MMA(0, 1, At, B1); PG8_BAR;
            PG8_LDA(At, 0, 1); PG8_STAGE(PG8_SA(0, 0), a2, voffA);
            PG8_BAR; PG8_WAIT_L(0); PG8_MMA(1, 0, At, B0); PG8_BAR; PG8_SCHED;
            PG8_STAGE(PG8_SB(0, 1), b2 + hstep, voffB);
            PG8_WAIT_V(6); PG8_BAR; PG8_MMA(1, 1, At, B1); PG8_BAR;
            PG8_LDB(B0, 1, 0); PG8_SCHED; PG8_LDA(At, 1, 0); PG8_STAGE(PG8_SA(0, 1), a2 + hstep, voffA);
            PG8_WAIT_L(8); PG8_BAR; PG8_WAIT_L(0); PG8_MMA(0, 0, At, B0); PG8_BAR; PG8_SCHED;
            PG8_LDB(B1, 1, 1); PG8_STAGE(PG8_SB(1, 0), b3, voffB);
            PG8_BAR; PG8_WAIT_L(0); PG8_MMA(0, 1, At, B1); PG8_BAR;
            PG8_LDA(At, 1, 1); PG8_STAGE(PG8_SA(1, 0), a3, voffA);
            PG8_BAR; PG8_WAIT_L(0); PG8_MMA(1, 0, At, B0); PG8_BAR; PG8_SCHED;
            PG8_STAGE(PG8_SB(1, 1), b3 + hstep, voffB);
            PG8_WAIT_V(6); PG8_BAR; PG8_MMA(1, 1, At, B1); PG8_BAR;
            }
        }
        if constexpr (FP8) { asm volatile("s_nop 15\n\ts_nop 15" ::: "memory"); }
        if constexpr (ALIGN_EPI) { if (wr == 0) PG8_BAR; }
        if constexpr (!Epi::AFTER_DRAIN) { E(acc, cur, wr, wc, fr, fq); S.done(cur); }
        if (!has_next) break;
#pragma unroll
        for (int a = 0; a < 2; ++a)
#pragma unroll
            for (int b = 0; b < 2; ++b)
#pragma unroll
                for (int m = 0; m < 4; ++m)
#pragma unroll
                    for (int n = 0; n < 2; ++n) acc[a][b][m][n] = (f32x4){0.f, 0.f, 0.f, 0.f};
        cur = nxt; cA = nA; cB = nB; ++ui;
        if constexpr (GATHER) { _Pragma("unroll") for (int h_ = 0; h_ < 2; ++h_) _Pragma("unroll") for (int i_ = 0; i_ < 2; ++i_) gA[h_][i_] = gN[h_][i_]; }
        if constexpr (ALIGN_EPI) { if (wr == 1) PG8_BAR; }
    }
    PG8_WAIT_V(0);
    if constexpr (!ALIGN_EPI) { if (wr == 0) PG8_BAR; }
    PG8_BAR;
    if constexpr (Epi::AFTER_DRAIN) { E.fused(acc, cur, wr, wc, fr, fq, lds, wid, lane); S.done(cur); }
#undef PG8_SA
#undef PG8_SB
#undef PG8_STAGE
#undef PG8_STAGEG
#undef PG8_GOFF
#undef PG8_LDA
#undef PG8_LDB
#undef PG8_MMA
#undef PG8_WAIT_V
#undef PG8_WAIT_L
#undef PG8_BAR
#undef PG8_SCHED
}
}
#define GAS __attribute__((address_space(1)))
#define LAS __attribute__((address_space(3)))
typedef unsigned short bf16;
typedef unsigned v4u __attribute__((ext_vector_type(4)));
typedef float f32x4 __attribute__((ext_vector_type(4)));
typedef short bf16x8 __attribute__((ext_vector_type(8)));
typedef GAS unsigned gu32;
typedef GAS unsigned long long gu64;
#define RLX_AGENT __ATOMIC_RELAXED, __HIP_MEMORY_SCOPE_AGENT
#define LDS_WAIT() asm volatile("s_waitcnt lgkmcnt(0)" ::: "memory")
#define VM_WAIT() asm volatile("s_waitcnt vmcnt(0)" ::: "memory")
__device__ __forceinline__ unsigned long long rt() { return __builtin_amdgcn_s_memrealtime(); }
__device__ __forceinline__ unsigned f2bf(float f) { unsigned u = __builtin_bit_cast(unsigned, f); return (u + 0x7fffu + ((u >> 16) & 1u)) >> 16; }
__device__ __forceinline__ unsigned pk2(float lo, float hi) { return f2bf(lo) | (f2bf(hi) << 16); }
#define XB_TMO      128
#define XB_XCNT(j)  (256  + 64 * (j))
#define XB_XSUB(j)  (1280 + 64 * (j))
#define XB_XGEN(j)  (2304 + 64 * (j))
#define XB_TOP      3328
#define XB_TOPGEN   3392
#define XCD_BAR_WORDS 3456
#define XB_SPIN_CAP (1u << 22)

__device__ __forceinline__ unsigned xb_ld(unsigned* p)              { return __hip_atomic_load(p, __ATOMIC_RELAXED, __HIP_MEMORY_SCOPE_AGENT); }
__device__ __forceinline__ unsigned xb_add(unsigned* p, unsigned v) { return __hip_atomic_fetch_add(p, v, __ATOMIC_RELAXED, __HIP_MEMORY_SCOPE_AGENT); }
__device__ __forceinline__ unsigned xb_xcc_id() { return (unsigned)__builtin_amdgcn_s_getreg((3 << 11) | 20) & 0xFu; }
#define XB_SPIN(cond, bar) do { unsigned _sp = 0; while (cond) { __builtin_amdgcn_s_sleep(1); \
    if ((++_sp & 255u) == 0u) { if (xb_ld(&(bar)[XB_TMO])) break; if (_sp > XB_SPIN_CAP) { atomicAdd(&(bar)[XB_TMO], 1u); break; } } } } while (0)

struct XcdBarrier {
    unsigned* bar; unsigned x;
    volatile LAS unsigned* st;
};

__device__ __forceinline__ XcdBarrier xcd_barrier_post(unsigned* bar, volatile LAS unsigned* st) {
    XcdBarrier b; b.bar = bar; b.x = xb_xcc_id(); b.st = st;
    if (threadIdx.x == 0) (void)xb_add(&bar[XB_XCNT(b.x)], 1u);
    return b;
}
__device__ __forceinline__ void xcd_barrier_complete(unsigned* bar, unsigned x, unsigned& nloc, unsigned& nx) {
    const unsigned G = gridDim.x * gridDim.y * gridDim.z;
    unsigned sum, cnt, mine, sp = 0u;
    for (;;) {
        sum = 0u; cnt = 0u; mine = 0u;
#pragma unroll
        for (unsigned j = 0; j < 16; ++j) { const unsigned c = xb_ld(&bar[XB_XCNT(j)]); sum += c; cnt += (c > 0u) ? 1u : 0u; mine = (j == x) ? c : mine; }
        if (sum == G) break;
        __builtin_amdgcn_s_sleep(1);
        if ((++sp & 255u) == 0u) { if (xb_ld(&bar[XB_TMO])) break; if (sp > XB_SPIN_CAP) { atomicAdd(&bar[XB_TMO], 1u); break; } }
    }
    nloc = mine > 0u ? mine : 1u; nx = cnt > 0u ? cnt : 1u;
}

__device__ __forceinline__ void xcd_barrier(const XcdBarrier& b) {
    asm volatile("s_waitcnt vmcnt(0)" ::: "memory");
    __syncthreads();
    if (threadIdx.x == 0) {
        unsigned* bar = b.bar;
        __builtin_amdgcn_s_waitcnt(0);
        unsigned nloc = b.st[0], nx = b.st[1];
        if (nloc == 0u) { xcd_barrier_complete(bar, b.x, nloc, nx); b.st[0] = nloc; b.st[1] = nx; }
        const unsigned old = xb_add(&bar[XB_XSUB(b.x)], 1u);
        const unsigned gen = old / nloc;
        if (old + 1u == (gen + 1u) * nloc) {
            __builtin_amdgcn_fence(__ATOMIC_RELEASE, "agent");
            asm volatile("s_waitcnt vmcnt(0)" ::: "memory");
            const unsigned og = xb_add(&bar[XB_TOP], 1u);
            const unsigned tg = og / nx;
            if (og + 1u == (tg + 1u) * nx) xb_add(&bar[XB_TOPGEN], 1u);
            else XB_SPIN(xb_ld(&bar[XB_TOPGEN]) == tg, bar);
            __builtin_amdgcn_fence(__ATOMIC_ACQUIRE, "agent");
            xb_add(&bar[XB_XGEN(b.x)], 1u);
            asm volatile("s_waitcnt vmcnt(0)" ::: "memory");
        } else {
            XB_SPIN(xb_ld(&bar[XB_XGEN(b.x)]) == gen, bar);
            __builtin_amdgcn_fence(__ATOMIC_ACQUIRE, "agent");
            asm volatile("s_waitcnt vmcnt(0)" ::: "memory");
        }
    }
    __syncthreads();
}

constexpr int BATCH = 2, SEQ = 8192, DM = 1024, CTXL = 256;
constexpr int NTOK = BATCH * SEQ, NCTXR = BATCH * CTXL, NROW = NTOK + NCTXR, KVLEN = SEQ + CTXL;
constexpr int INC = 2304, NEXP = 32, TOPK = 4, GUW = 2048;
constexpr int NPAD_MAX = NTOK * TOPK + NEXP * 256;
constexpr float NORM_EPS = 1e-6f, LOG2E = 1.4426950408889634f, QSCALE = 0.125f * 1.4426950408889634f;
constexpr int NWAVES = 8;


namespace at2 {
typedef short bf16x8 __attribute__((ext_vector_type(8)));
typedef short s16x4 __attribute__((ext_vector_type(4)));
typedef float f32x16 __attribute__((ext_vector_type(16)));
typedef unsigned u32x4 __attribute__((ext_vector_type(4)));
constexpr int SHM_V = 16384, SHM_K = 16384, AT_WS_OFF = 73728, AT_WS3_OFF = 98304, XROW = 132, XROWW = 68;
constexpr int SDEPTH = 1;
constexpr float THRL = 8.0f;
#define AT_LAS __attribute__((address_space(3)))
#define KSWZ(row, colB) ((row) * 256 + ((colB) ^ (((row) & 7) << 4)))
#define SBAR() __builtin_amdgcn_sched_barrier(0)
__device__ __forceinline__ int crow(int r, int hi) { return (r & 3) + 8 * (r >> 2) + 4 * hi; }
typedef float f32x2_t __attribute__((ext_vector_type(2))); typedef __bf16 bf16x2_t __attribute__((ext_vector_type(2)));
__device__ __forceinline__ unsigned cvtpk2(float lo, float hi) { f32x2_t v = {lo, hi}; bf16x2_t b = __builtin_convertvector(v, bf16x2_t); return __builtin_bit_cast(unsigned, b); }
__device__ __forceinline__ void partialSM(f32x16& p0, f32x16& p1, float& m_reg, float& alpha) {
  float pmax = p0[0];
#pragma unroll
  for (int r = 1; r < 16; ++r) pmax = fmaxf(pmax, p0[r]);
#pragma unroll
  for (int r = 0; r < 16; ++r) pmax = fmaxf(pmax, p1[r]);
  { auto rr = __builtin_amdgcn_permlane32_swap(__float_as_uint(pmax), __float_as_uint(pmax), false, false); pmax = fmaxf(__uint_as_float(rr[0]), __uint_as_float(rr[1])); }
  float mn;
  if (__builtin_expect(__all(pmax - m_reg <= THRL), 1)) { mn = m_reg; alpha = 1.f; }
  else { mn = fmaxf(m_reg, pmax); alpha = __builtin_amdgcn_exp2f(m_reg - mn); m_reg = mn; }
#pragma unroll
  for (int r = 0; r < 16; ++r) p0[r] = p0[r] - mn;
#pragma unroll
  for (int r = 0; r < 16; ++r) p1[r] = p1[r] - mn;
#pragma unroll
  for (int r = 0; r < 16; ++r) p0[r] = __builtin_amdgcn_exp2f(p0[r]);
}
__device__ __forceinline__ void finishSM(f32x16& p0, f32x16& p1, float alpha, float& l_reg, bf16x8& pa0, bf16x8& pa1, bf16x8& pa2, bf16x8& pa3) {
#pragma unroll
  for (int r = 0; r < 16; ++r) p1[r] = __builtin_amdgcn_exp2f(p1[r]);
  float ps = 0;
#pragma unroll
  for (int r = 0; r < 16; ++r) ps += p0[r];
#pragma unroll
  for (int r = 0; r < 16; ++r) ps += p1[r];
  { auto rr = __builtin_amdgcn_permlane32_swap(__float_as_uint(ps), __float_as_uint(ps), false, false); ps = __uint_as_float(rr[0]) + __uint_as_float(rr[1]); }
  l_reg = l_reg * alpha + ps;
#define PK4(P, BASE, OUT) do { unsigned a0 = cvtpk2(P[BASE + 0], P[BASE + 1]), a1 = cvtpk2(P[BASE + 2], P[BASE + 3]);   \
    unsigned b0 = cvtpk2(P[BASE + 4], P[BASE + 5]), b1 = cvtpk2(P[BASE + 6], P[BASE + 7]);                              \
    auto r0 = __builtin_amdgcn_permlane32_swap(a0, b0, false, false); auto r1 = __builtin_amdgcn_permlane32_swap(a1, b1, false, false); \
    u32x4 w = {r0[0], r1[0], r0[1], r1[1]}; OUT = __builtin_bit_cast(bf16x8, w); } while (0)
  PK4(p0, 0, pa0); PK4(p0, 8, pa1); PK4(p1, 0, pa2); PK4(p1, 8, pa3);
#undef PK4
}
__device__ __forceinline__ void qkt(f32x16& p0, f32x16& p1, const AT_LAS char* Ks, const bf16x8* qr, int r32, int hi) {
  p0 = f32x16{}; p1 = f32x16{};
#pragma unroll
  for (int d0 = 0; d0 < 4; ++d0) { const int cb = (d0 * 16 + hi * 8) * 2;
    const bf16x8 b0 = *(const AT_LAS bf16x8*)(Ks + KSWZ(r32, cb));
    const bf16x8 b1 = *(const AT_LAS bf16x8*)(Ks + KSWZ(32 + r32, cb));
    p0 = __builtin_amdgcn_mfma_f32_32x32x16_bf16(b0, qr[d0], p0, 0, 0, 0);
    p1 = __builtin_amdgcn_mfma_f32_32x32x16_bf16(b1, qr[d0], p1, 0, 0, 0); }
}
__device__ __forceinline__ int v_st(int k, int c) { const int kk = (k & ~0xC) | ((k & 4) << 1) | ((k & 8) >> 1); return ((kk >> 3) * 4 + (c >> 5)) * 512 + ((kk & 7) * 32 + (c & 31)) * 2; }
__device__ __forceinline__ int v_rd_base(int lane) { return ((lane & 3) << 3) | (((lane >> 2) & 3) << 6) | (((lane >> 4) & 1) << 5) | (((lane >> 5) & 1) << 8); }
constexpr int v_rd_off(int d0, int ks, int half) { return d0 * 512 + ks * 4096 + half * 2048; }
template <int OFF> __device__ __forceinline__ s16x4 tr_read(int vb) { s16x4 r; asm volatile("ds_read_b64_tr_b16 %0, %1 offset:%2" : "=&v"(r) : "v"(vb), "i"(OFF) : "memory"); return r; }
template <int D0> __device__ __forceinline__ void pv_one(f32x16& od, int vb, bf16x8 pa0, bf16x8 pa1, bf16x8 pa2, bf16x8 pa3) {
  const s16x4 l0 = tr_read<v_rd_off(D0, 0, 0)>(vb), h0 = tr_read<v_rd_off(D0, 0, 1)>(vb), l1 = tr_read<v_rd_off(D0, 1, 0)>(vb), h1 = tr_read<v_rd_off(D0, 1, 1)>(vb);
  const s16x4 l2 = tr_read<v_rd_off(D0, 2, 0)>(vb), h2 = tr_read<v_rd_off(D0, 2, 1)>(vb), l3 = tr_read<v_rd_off(D0, 3, 0)>(vb), h3 = tr_read<v_rd_off(D0, 3, 1)>(vb);
  asm volatile("s_waitcnt lgkmcnt(0)" ::: "memory"); SBAR();
#define PK(L, H) (bf16x8){L[0], L[1], L[2], L[3], H[0], H[1], H[2], H[3]}
  od = __builtin_amdgcn_mfma_f32_32x32x16_bf16(pa0, PK(l0, h0), od, 0, 0, 0);
  od = __builtin_amdgcn_mfma_f32_32x32x16_bf16(pa1, PK(l1, h1), od, 0, 0, 0);
  od = __builtin_amdgcn_mfma_f32_32x32x16_bf16(pa2, PK(l2, h2), od, 0, 0, 0);
  od = __builtin_amdgcn_mfma_f32_32x32x16_bf16(pa3, PK(l3, h3), od, 0, 0, 0);
#undef PK
}
typedef short v4i16_t __attribute__((ext_vector_type(4)));
__device__ __forceinline__ s16x4 vtr(int vb, int off) { return __builtin_bit_cast(s16x4, __builtin_amdgcn_ds_read_tr16_b64_v4i16((AT_LAS v4i16_t*)(unsigned)(vb + off))); }
template <int D0> __device__ __forceinline__ void pv_one_b(f32x16& od, int vb, bf16x8 pa0, bf16x8 pa1, bf16x8 pa2, bf16x8 pa3) {
  const s16x4 l0 = vtr(vb, v_rd_off(D0, 0, 0)), h0 = vtr(vb, v_rd_off(D0, 0, 1)), l1 = vtr(vb, v_rd_off(D0, 1, 0)), h1 = vtr(vb, v_rd_off(D0, 1, 1));
  const s16x4 l2 = vtr(vb, v_rd_off(D0, 2, 0)), h2 = vtr(vb, v_rd_off(D0, 2, 1)), l3 = vtr(vb, v_rd_off(D0, 3, 0)), h3 = vtr(vb, v_rd_off(D0, 3, 1));
#define PK(L, H) (bf16x8){L[0], L[1], L[2], L[3], H[0], H[1], H[2], H[3]}
  od = __builtin_amdgcn_mfma_f32_32x32x16_bf16(pa0, PK(l0, h0), od, 0, 0, 0);
  od = __builtin_amdgcn_mfma_f32_32x32x16_bf16(pa1, PK(l1, h1), od, 0, 0, 0);
  od = __builtin_amdgcn_mfma_f32_32x32x16_bf16(pa2, PK(l2, h2), od, 0, 0, 0);
  od = __builtin_amdgcn_mfma_f32_32x32x16_bf16(pa3, PK(l3, h3), od, 0, 0, 0);
#undef PK
}
template <int NDB> __device__ __forceinline__ void pv_all_b(f32x16* o, int vb, bf16x8 pa0, bf16x8 pa1, bf16x8 pa2, bf16x8 pa3) {
  pv_one_b<0>(o[0], vb, pa0, pa1, pa2, pa3); pv_one_b<1>(o[1], vb, pa0, pa1, pa2, pa3);
  if constexpr (NDB == 4) { pv_one_b<2>(o[2], vb, pa0, pa1, pa2, pa3); pv_one_b<3>(o[3], vb, pa0, pa1, pa2, pa3); }
}
template <int NDB> __device__ __forceinline__ void pv_all(f32x16* o, int vb, bf16x8 pa0, bf16x8 pa1, bf16x8 pa2, bf16x8 pa3) {
  pv_one<0>(o[0], vb, pa0, pa1, pa2, pa3); pv_one<1>(o[1], vb, pa0, pa1, pa2, pa3);
  if constexpr (NDB == 4) { pv_one<2>(o[2], vb, pa0, pa1, pa2, pa3); pv_one<3>(o[3], vb, pa0, pa1, pa2, pa3); }
}
__device__ __forceinline__ void wmask(f32x16& p0, f32x16& p1, int k0, int q, int hi) {
#pragma unroll
  for (int r = 0; r < 16; ++r) { const int d = k0 + crow(r, hi) - q; if (d > 128 || d < -128) p0[r] = -1e30f; if (d + 32 > 128 || d + 32 < -128) p1[r] = -1e30f; }
}

struct UnitArgs {
  const bf16* Q; int ldq;
  const bf16* K; const bf16* V; int ldk;
  int kcolB;
  int vcolB;
  int q0;
  int ks;
};
template <bool DIFF> __device__ __forceinline__ int tile_k0(const UnitArgs& a, int j) { if constexpr (DIFF) return 64 * j; else return j < 4 ? SEQ + 64 * j : a.ks + 64 * (j - 4); }

#define RD128(dst, addr, OFF) asm volatile("ds_read_b128 %0, %1 offset:%2" : "=v"(dst) : "v"(addr), "i"(OFF) : "memory")
#define RDTR(dst, addr, OFF) asm volatile("ds_read_b64_tr_b16 %0, %1 offset:%2" : "=v"(dst) : "v"(addr), "i"(OFF) : "memory")
#define WAITL8_4(n, a, b, c, d) asm volatile("s_waitcnt lgkmcnt(" #n ")" : "+v"(a), "+v"(b), "+v"(c), "+v"(d) :: "memory")
#define WAITL8_8(n, a, b, c, d, e, f, g, h) asm volatile("s_waitcnt lgkmcnt(" #n ")" : "+v"(a), "+v"(b), "+v"(c), "+v"(d), "+v"(e), "+v"(f), "+v"(g), "+v"(h) :: "memory")
__device__ __forceinline__ float max3f(float a, float b, float c) { return __builtin_fmaxf(__builtin_fmaxf(a, b), c); }
__device__ __forceinline__ void softmax_seg2(f32x16& p0, f32x16& p1, float& m_reg, float& alpha, bf16x8& pa0, bf16x8& pa1, bf16x8& pa2, bf16x8& pa3) {
  float x = max3f(p0[0], p0[1], p0[2]), y = max3f(p1[0], p1[1], p1[2]);
  x = max3f(x, p0[3], p0[4]); y = max3f(y, p1[3], p1[4]); x = max3f(x, p0[5], p0[6]); y = max3f(y, p1[5], p1[6]); x = max3f(x, p0[7], p0[8]); y = max3f(y, p1[7], p1[8]);
  x = max3f(x, p0[9], p0[10]); y = max3f(y, p1[9], p1[10]); x = max3f(x, p0[11], p0[12]); y = max3f(y, p1[11], p1[12]); x = max3f(x, p0[13], p0[14]); y = max3f(y, p1[13], p1[14]);
  float pmax = max3f(x, y, p0[15]); pmax = fmaxf(pmax, p1[15]);
  { auto rr = __builtin_amdgcn_permlane32_swap(__float_as_uint(pmax), __float_as_uint(pmax), false, false); pmax = fmaxf(__uint_as_float(rr[0]), __uint_as_float(rr[1])); }
  float mn;
  if (__builtin_expect(__all(pmax - m_reg <= THRL), 1)) { mn = m_reg; alpha = 1.f; }
  else { mn = fmaxf(m_reg, pmax); alpha = __builtin_amdgcn_exp2f(m_reg - mn); m_reg = mn; }
#pragma unroll
  for (int r = 0; r < 16; ++r) { p0[r] = __builtin_amdgcn_exp2f(p0[r] - mn); p1[r] = __builtin_amdgcn_exp2f(p1[r] - mn); }
  { u32x4 w = {cvtpk2(p0[0], p0[1]), cvtpk2(p0[2], p0[3]), cvtpk2(p0[4], p0[5]), cvtpk2(p0[6], p0[7])}; pa0 = __builtin_bit_cast(bf16x8, w); }
  { u32x4 w = {cvtpk2(p0[8], p0[9]), cvtpk2(p0[10], p0[11]), cvtpk2(p0[12], p0[13]), cvtpk2(p0[14], p0[15])}; pa1 = __builtin_bit_cast(bf16x8, w); }
  { u32x4 w = {cvtpk2(p1[0], p1[1]), cvtpk2(p1[2], p1[3]), cvtpk2(p1[4], p1[5]), cvtpk2(p1[6], p1[7])}; pa2 = __builtin_bit_cast(bf16x8, w); }
  { u32x4 w = {cvtpk2(p1[8], p1[9]), cvtpk2(p1[10], p1[11]), cvtpk2(p1[12], p1[13]), cvtpk2(p1[14], p1[15])}; pa3 = __builtin_bit_cast(bf16x8, w); }
}
template <bool DIFF>
__device__ __forceinline__ void attn_tiles_pp3(const UnitArgs& a, AT_LAS char* lds, int tid, int wid, int lane, f32x16* o, f32x16& ol, float& m_out) {
  constexpr int NDB = DIFF ? 4 : 2; constexpr int NT = DIFF ? KVLEN / 64 : 10;
  const int r32 = lane & 31, hi = lane >> 5;
  AT_LAS char* V_lds = lds; AT_LAS char* K_lds = lds + 3 * SHM_V;
  AT_LAS float* al_l = (AT_LAS float*)(lds + AT_WS3_OFF) + wid * 64 + 32;
  float m_reg = -1e30f, alpha = 1.f; bf16x8 qr[4];
  const short one_ = (short)0x3F80; const bf16x8 ones = {one_, one_, one_, one_, one_, one_, one_, one_};
  const bf16* Qw = a.Q + (long)r32 * a.ldq + hi * 8;
#pragma unroll
  for (int d0 = 0; d0 < 4; ++d0) qr[d0] = *(const bf16x8*)(Qw + d0 * 16);
  int koff[2], voff[2];
#pragma unroll
  for (int i = 0; i < 2; ++i) { const int pc = 2 * wid + i;
    { const int row = 4 * pc + (lane >> 4), p = lane & 15; koff[i] = row * a.ldk + ((p ^ (row & 7)) << 3); }
    { const int s = 2 * pc + (lane >> 5), kk = (s >> 2) * 8 + ((lane & 31) >> 2); const int key = kk; voff[i] = key * a.ldk + (s & 3) * 32 + 8 * (lane & 3); } }
  const int vb0 = (int)(unsigned)(uintptr_t)V_lds + v_rd_base(lane) + a.vcolB;
  const int kb0 = (int)(unsigned)(uintptr_t)K_lds + a.kcolB + r32 * 256;
  int kad[4];
#pragma unroll
  for (int d0 = 0; d0 < 4; ++d0) kad[d0] = kb0 + (((d0 * 2 + hi) ^ (r32 & 7)) << 4);
#define DMA_K(t, slot) do { const bf16* kb_ = a.K + (long)tile_k0<DIFF>(a, (t)) * a.ldk; _Pragma("unroll") for (int i_ = 0; i_ < 2; ++i_) \
    __builtin_amdgcn_global_load_lds((const unsigned*)(kb_ + koff[i_]), (AT_LAS unsigned*)(K_lds + (slot) * SHM_K + (2 * wid + i_) * 1024), 16, 0, 0); } while (0)
#define DMA_V(t, slot) do { const bf16* vb_ = a.V + (long)tile_k0<DIFF>(a, (t)) * a.ldk; _Pragma("unroll") for (int i_ = 0; i_ < 2; ++i_) \
    __builtin_amdgcn_global_load_lds((const unsigned*)(vb_ + voff[i_]), (AT_LAS unsigned*)(V_lds + (slot) * SHM_V + (2 * wid + i_) * 1024), 16, 0, 0); } while (0)
#define BAR_MID() do { SBAR(); asm volatile("s_barrier" ::: "memory"); SBAR(); } while (0)
#define BAR_END(n) do { SBAR(); asm volatile("s_waitcnt vmcnt(" #n ")\n\ts_barrier" ::: "memory"); SBAR(); } while (0)
#define RESC2() do { if (__any(alpha < 1.f)) { if (hi == 0) al_l[r32] = alpha; asm volatile("s_waitcnt lgkmcnt(0)" ::: "memory"); \
    _Pragma("unroll") for (int r = 0; r < 16; ++r) { const float f_ = al_l[crow(r, hi)]; ol[r] *= f_; _Pragma("unroll") for (int d = 0; d < NDB; ++d) o[d][r] *= f_; } } } while (0)
#define WMASK2(t) do { if constexpr (!DIFF) { if ((t) >= 4) wmask(p0, p1, tile_k0<DIFF>(a, (t)), a.q0 + r32, hi); } } while (0)
#define VSEG(t) do { WMASK2(t); softmax_seg2(p0, p1, m_reg, alpha, pa0, pa1, pa2, pa3); RESC2(); } while (0)
#define PKV(L, H) (bf16x8){L[0], L[1], L[2], L[3], H[0], H[1], H[2], H[3]}
#define VRD8(X, D0, va) do { RDTR(X##0, va, v_rd_off(D0, 0, 0)); RDTR(X##1, va, v_rd_off(D0, 0, 1)); RDTR(X##2, va, v_rd_off(D0, 1, 0)); RDTR(X##3, va, v_rd_off(D0, 1, 1)); \
    RDTR(X##4, va, v_rd_off(D0, 2, 0)); RDTR(X##5, va, v_rd_off(D0, 2, 1)); RDTR(X##6, va, v_rd_off(D0, 3, 0)); RDTR(X##7, va, v_rd_off(D0, 3, 1)); } while (0)
#define PV4(od, X) do { od = __builtin_amdgcn_mfma_f32_32x32x16_bf16(pa0, PKV(X##0, X##1), od, 0, 0, 0); od = __builtin_amdgcn_mfma_f32_32x32x16_bf16(pa1, PKV(X##2, X##3), od, 0, 0, 0); \
    od = __builtin_amdgcn_mfma_f32_32x32x16_bf16(pa2, PKV(X##4, X##5), od, 0, 0, 0); od = __builtin_amdgcn_mfma_f32_32x32x16_bf16(pa3, PKV(X##6, X##7), od, 0, 0, 0); } while (0)
#define MSEG(DOQK, DOPV, ksl, vsl) do { \
    bf16x8 k0_, k1_, k2_, k3_; s16x4 A0, A1, A2, A3, A4, A5, A6, A7, B0, B1, B2, B3, B4, B5, B6, B7; \
    const int ko_ = (ksl) * SHM_K; const int va_ = vb0 + (vsl) * SHM_V; \
    if (DOQK) { RD128(k0_, kad[0] + ko_, 0); RD128(k1_, kad[0] + ko_, 8192); RD128(k2_, kad[1] + ko_, 0); RD128(k3_, kad[1] + ko_, 8192); \
      bf16x8 k4_, k5_, k6_, k7_; RD128(k4_, kad[2] + ko_, 0); RD128(k5_, kad[2] + ko_, 8192); RD128(k6_, kad[3] + ko_, 0); RD128(k7_, kad[3] + ko_, 8192); \
      WAITL8_4(4, k0_, k1_, k2_, k3_); SBAR(); \
      p0 = __builtin_amdgcn_mfma_f32_32x32x16_bf16(k0_, qr[0], (f32x16){}, 0, 0, 0); p1 = __builtin_amdgcn_mfma_f32_32x32x16_bf16(k1_, qr[0], (f32x16){}, 0, 0, 0); \
      p0 = __builtin_amdgcn_mfma_f32_32x32x16_bf16(k2_, qr[1], p0, 0, 0, 0); p1 = __builtin_amdgcn_mfma_f32_32x32x16_bf16(k3_, qr[1], p1, 0, 0, 0); SBAR(); \
      if (DOPV) { VRD8(A, 0, va_); WAITL8_4(8, k4_, k5_, k6_, k7_); } else { WAITL8_4(0, k4_, k5_, k6_, k7_); } SBAR(); \
      p0 = __builtin_amdgcn_mfma_f32_32x32x16_bf16(k4_, qr[2], p0, 0, 0, 0); p1 = __builtin_amdgcn_mfma_f32_32x32x16_bf16(k5_, qr[2], p1, 0, 0, 0); \
      p0 = __builtin_amdgcn_mfma_f32_32x32x16_bf16(k6_, qr[3], p0, 0, 0, 0); p1 = __builtin_amdgcn_mfma_f32_32x32x16_bf16(k7_, qr[3], p1, 0, 0, 0); SBAR(); } \
    else if (DOPV) { VRD8(A, 0, va_); } \
    if (DOPV) { VRD8(B, 1, va_); WAITL8_8(8, A0, A1, A2, A3, A4, A5, A6, A7); SBAR(); PV4(o[0], A); SBAR(); \
      if constexpr (NDB == 4) { VRD8(A, 2, va_); WAITL8_8(8, B0, B1, B2, B3, B4, B5, B6, B7); SBAR(); PV4(o[1], B); SBAR(); \
        VRD8(B, 3, va_); WAITL8_8(8, A0, A1, A2, A3, A4, A5, A6, A7); SBAR(); PV4(o[2], A); SBAR(); \
        WAITL8_8(0, B0, B1, B2, B3, B4, B5, B6, B7); SBAR(); PV4(o[3], B); SBAR(); } \
      else { WAITL8_8(0, B0, B1, B2, B3, B4, B5, B6, B7); SBAR(); PV4(o[1], B); SBAR(); } \
      ol = __builtin_amdgcn_mfma_f32_32x32x16_bf16(pa0, ones, ol, 0, 0, 0); ol = __builtin_amdgcn_mfma_f32_32x32x16_bf16(pa1, ones, ol, 0, 0, 0); \
      ol = __builtin_amdgcn_mfma_f32_32x32x16_bf16(pa2, ones, ol, 0, 0, 0); ol = __builtin_amdgcn_mfma_f32_32x32x16_bf16(pa3, ones, ol, 0, 0, 0); SBAR(); } \
  } while (0)
#define ROT3(s) ((s) == 2 ? 0 : (s) + 1)
  f32x16 p0, p1; bf16x8 pa0, pa1, pa2, pa3;
  DMA_K(0, 0); DMA_K(1, 1); DMA_V(0, 0); BAR_END(0);
  int sk = 0;
  if (wid < 4) {
    DMA_K(2, 2); DMA_V(1, 1); MSEG(true, false, 0, 0); BAR_MID(); VSEG(0); BAR_END(4);
    sk = 1;
    for (int t = 1; t <= NT - 3; ++t) { const int s1 = ROT3(sk), s2 = ROT3(s1);
      DMA_K(t + 2, s2); DMA_V(t + 1, s1); MSEG(true, true, sk, s2); BAR_MID(); VSEG(t); BAR_END(4); sk = s1; }
    { const int s1 = ROT3(sk), s2 = ROT3(s1); DMA_V(NT - 1, s1); MSEG(true, true, sk, s2); BAR_MID(); VSEG(NT - 2); BAR_END(2); sk = s1; }
    { const int s1 = ROT3(sk), s2 = ROT3(s1); MSEG(true, true, sk, s2); BAR_MID(); VSEG(NT - 1); BAR_END(0); sk = s1; }
    { const int s2 = ROT3(ROT3(sk)); MSEG(false, true, 0, s2); BAR_MID(); BAR_END(0); }
  } else {
    DMA_K(2, 2); DMA_V(1, 1); BAR_MID(); MSEG(true, false, 0, 0); BAR_END(4);
    sk = 1;
    for (int t = 1; t <= NT - 3; ++t) { const int s1 = ROT3(sk), s2 = ROT3(s1);
      DMA_K(t + 2, s2); DMA_V(t + 1, s1); VSEG(t - 1); BAR_MID(); MSEG(true, true, sk, s2); BAR_END(4); sk = s1; }
    { const int s1 = ROT3(sk), s2 = ROT3(s1); DMA_V(NT - 1, s1); VSEG(NT - 3); BAR_MID(); MSEG(true, true, sk, s2); BAR_END(2); sk = s1; }
    { const int s1 = ROT3(sk), s2 = ROT3(s1); VSEG(NT - 2); BAR_MID(); MSEG(true, true, sk, s2); BAR_END(0); sk = s1; }
    { const int s2 = ROT3(ROT3(sk)); VSEG(NT - 1); BAR_MID(); MSEG(false, true, 0, s2); BAR_END(0); }
  }
  m_out = m_reg;
#undef DMA_K
#undef DMA_V
#undef BAR_MID
#undef BAR_END
#undef RESC2
#undef WMASK2
#undef VSEG
#undef PKV
#undef VRD8
#undef PV4
#undef MSEG
#undef ROT3
}

typedef int i32x8v __attribute__((ext_vector_type(8)));
constexpr int F8_SLOT = 8192, F8_K_OFF = 0, F8_V_OFF = 3 * F8_SLOT;
#define MF8_ACC(acc, a8, b8) asm volatile("v_mfma_scale_f32_32x32x64_f8f6f4 %0, %1, %2, %0, %3, %3 op_sel_hi:[0,0,0]" : "+v"(acc) : "v"(a8), "v"(b8), "v"(sc1))
#define MF8_NEW(acc, a8, b8) asm volatile("v_mfma_scale_f32_32x32x64_f8f6f4 %0, %1, %2, 0, %3, %3 op_sel_hi:[0,0,0]" : "=&v"(acc) : "v"(a8), "v"(b8), "v"(sc1))
__device__ __forceinline__ unsigned pk4f8(float a, float b, float c, float d) { int w = 0; w = __builtin_amdgcn_cvt_pk_fp8_f32(a, b, w, false); w = __builtin_amdgcn_cvt_pk_fp8_f32(c, d, w, true); return (unsigned)w; }
struct UnitArgs8 { const unsigned char* Q; const unsigned char* K; const unsigned char* VT; int comp, ldk, vdoff, q0, ks; };
template <bool DIFF> __device__ __forceinline__ int tile8_k0(const UnitArgs8& a, int j) { if constexpr (DIFF) return 64 * j; else return j < 4 ? SEQ + 64 * j : a.ks + 64 * (j - 4); }
template <bool DIFF>
__device__ __forceinline__ void attn_tiles_f8(const UnitArgs8& a, AT_LAS char* lds, int tid, int wid, int lane, f32x16* o, f32x16& ol, float& m_out) {
  constexpr int NDB = DIFF ? 4 : 2, NT = DIFF ? KVLEN / 64 : 10;
  const int r32 = lane & 31, hi = lane >> 5;
  AT_LAS char* K_lds = lds + F8_K_OFF; AT_LAS char* V_lds = lds + F8_V_OFF;
  AT_LAS float* al_l = (AT_LAS float*)(lds + AT_WS3_OFF) + wid * 64 + 32;
  float m_reg = -1e30f, alpha = 1.f;
  int sc1 = 0x7F7F7F7F; asm volatile("" : "+v"(sc1));
  i32x8v ones8; { int o4 = 0x38383838; asm volatile("" : "+v"(o4)); ones8 = (i32x8v){o4, o4, o4, o4, o4, o4, o4, o4}; }
  i32x8v q8; { const u32x4 qa_ = *(const u32x4*)(a.Q + (long)r32 * 512 + hi * 32), qb_ = *(const u32x4*)(a.Q + (long)r32 * 512 + hi * 32 + 16);
    q8 = (i32x8v){(int)qa_.x, (int)qa_.y, (int)qa_.z, (int)qa_.w, (int)qb_.x, (int)qb_.y, (int)qb_.z, (int)qb_.w}; }
  const int kkey = 8 * wid + (lane >> 3), koff = kkey * a.ldk + (((lane & 7) ^ ((kkey >> 1) & 7)) << 4);
  const int vd = 16 * wid + (lane >> 2); const long voff = (long)vd * KVLEN + (((lane & 3) ^ ((vd >> 2) & 3)) << 4);
  const int ksw = (r32 >> 1) & 7, vsw = (r32 >> 2) & 3;
  const int kb = (int)(unsigned)(uintptr_t)K_lds + r32 * 128, ka0 = kb + (((a.comp * 4 + 2 * hi) ^ ksw) << 4), ka1 = kb + (((a.comp * 4 + 2 * hi + 1) ^ ksw) << 4);
  const int vbb = (int)(unsigned)(uintptr_t)V_lds + a.vdoff + r32 * 64, va0 = vbb + (((2 * hi) ^ vsw) << 4), va1 = vbb + (((2 * hi + 1) ^ vsw) << 4);
#define DMA_K(t, slot) __builtin_amdgcn_global_load_lds((const unsigned*)(a.K + (long)tile8_k0<DIFF>(a, (t)) * a.ldk + koff), (AT_LAS unsigned*)(K_lds + (slot) * F8_SLOT + wid * 1024), 16, 0, 0)
#define DMA_V(t, slot) __builtin_amdgcn_global_load_lds((const unsigned*)(a.VT + (long)tile8_k0<DIFF>(a, (t)) + voff), (AT_LAS unsigned*)(V_lds + (slot) * F8_SLOT + wid * 1024), 16, 0, 0)
#define BAR_MID() do { SBAR(); asm volatile("s_barrier" ::: "memory"); SBAR(); } while (0)
#define BAR_END(n) do { SBAR(); asm volatile("s_waitcnt vmcnt(" #n ")\n\ts_barrier" ::: "memory"); SBAR(); } while (0)
#define RESC2() do { if (__any(alpha < 1.f)) { if (hi == 0) al_l[r32] = alpha; asm volatile("s_waitcnt lgkmcnt(0)" ::: "memory"); \
    _Pragma("unroll") for (int r = 0; r < 16; ++r) { const float f_ = al_l[crow(r, hi)]; ol[r] *= f_; _Pragma("unroll") for (int d = 0; d < NDB; ++d) o[d][r] *= f_; } } } while (0)
#define VSEG(t) do { if constexpr (!DIFF) { if ((t) >= 4) wmask(p0, p1, tile8_k0<DIFF>(a, (t)), a.q0 + r32, hi); } bf16x8 t0_, t1_, t2_, t3_; softmax_seg2(p0, p1, m_reg, alpha, t0_, t1_, t2_, t3_); (void)t0_; (void)t1_; (void)t2_; (void)t3_; \
    pa8 = (i32x8v){(int)pk4f8(p0[0], p0[1], p0[2], p0[3]), (int)pk4f8(p0[4], p0[5], p0[6], p0[7]), (int)pk4f8(p0[8], p0[9], p0[10], p0[11]), (int)pk4f8(p0[12], p0[13], p0[14], p0[15]), \
                   (int)pk4f8(p1[0], p1[1], p1[2], p1[3]), (int)pk4f8(p1[4], p1[5], p1[6], p1[7]), (int)pk4f8(p1[8], p1[9], p1[10], p1[11]), (int)pk4f8(p1[12], p1[13], p1[14], p1[15])}; RESC2(); } while (0)
#define RD16(dst, addr, OFF) asm volatile("ds_read_b128 %0, %1 offset:%2" : "=v"(dst) : "v"(addr), "i"(OFF) : "memory")
#define CAT8(x, y) (i32x8v){(int)x[0], (int)x[1], (int)x[2], (int)x[3], (int)y[0], (int)y[1], (int)y[2], (int)y[3]}
#define MSEG(DOQK, DOPV, ksl, vsl) do { \
    u32x4 ka_, kb_, kc_, kd_, v0a, v0b, v1a, v1b, v2a, v2b, v3a, v3b; const int ko_ = (ksl) * F8_SLOT, vo_ = (vsl) * F8_SLOT; \
    if (DOQK) { RD16(ka_, ka0 + ko_, 0); RD16(kb_, ka1 + ko_, 0); RD16(kc_, ka0 + ko_, 4096); RD16(kd_, ka1 + ko_, 4096); } \
    if (DOPV) { RD16(v0a, va0 + vo_, 0); RD16(v0b, va1 + vo_, 0); RD16(v1a, va0 + vo_, 2048); RD16(v1b, va1 + vo_, 2048); \
                if constexpr (NDB == 4) { RD16(v2a, va0 + vo_, 4096); RD16(v2b, va1 + vo_, 4096); RD16(v3a, va0 + vo_, 6144); RD16(v3b, va1 + vo_, 6144); } } \
    if (DOQK) { if (DOPV) { if constexpr (NDB == 4) asm volatile("s_waitcnt lgkmcnt(8)" : "+v"(ka_), "+v"(kb_), "+v"(kc_), "+v"(kd_) :: "memory"); else asm volatile("s_waitcnt lgkmcnt(4)" : "+v"(ka_), "+v"(kb_), "+v"(kc_), "+v"(kd_) :: "memory"); } else { asm volatile("s_waitcnt lgkmcnt(0)" : "+v"(ka_), "+v"(kb_), "+v"(kc_), "+v"(kd_) :: "memory"); } SBAR(); \
      { const i32x8v k0_ = CAT8(ka_, kb_), k1_ = CAT8(kc_, kd_); MF8_NEW(p0, k0_, q8); MF8_NEW(p1, k1_, q8); } SBAR(); } \
    if (DOPV) { if constexpr (NDB == 4) { asm volatile("s_waitcnt lgkmcnt(0)" : "+v"(v0a), "+v"(v0b), "+v"(v1a), "+v"(v1b), "+v"(v2a), "+v"(v2b), "+v"(v3a), "+v"(v3b) :: "memory"); SBAR(); \
        const i32x8v w0_ = CAT8(v0a, v0b), w1_ = CAT8(v1a, v1b), w2_ = CAT8(v2a, v2b), w3_ = CAT8(v3a, v3b); \
        MF8_ACC(o[0], pa8, w0_); MF8_ACC(o[1], pa8, w1_); MF8_ACC(o[2], pa8, w2_); MF8_ACC(o[3], pa8, w3_); MF8_ACC(ol, pa8, ones8); } \
      else { asm volatile("s_waitcnt lgkmcnt(0)" : "+v"(v0a), "+v"(v0b), "+v"(v1a), "+v"(v1b) :: "memory"); SBAR(); \
        const i32x8v w0_ = CAT8(v0a, v0b), w1_ = CAT8(v1a, v1b); MF8_ACC(o[0], pa8, w0_); MF8_ACC(o[1], pa8, w1_); MF8_ACC(ol, pa8, ones8); } SBAR(); } \
    asm volatile("s_nop 15\n\ts_nop 15" ::: "memory");     \
  } while (0)
#define ROT3(s) ((s) == 2 ? 0 : (s) + 1)
  f32x16 p0, p1; i32x8v pa8;
  DMA_K(0, 0); DMA_K(1, 1); DMA_V(0, 0); BAR_END(0);
  int sk = 0;
  if (wid < 4) {
    DMA_K(2, 2); DMA_V(1, 1); MSEG(true, false, 0, 0); BAR_MID(); VSEG(0); BAR_END(2);
    sk = 1;
    for (int t = 1; t <= NT - 3; ++t) { const int s1 = ROT3(sk), s2 = ROT3(s1);
      DMA_K(t + 2, s2); DMA_V(t + 1, s1); MSEG(true, true, sk, s2); BAR_MID(); VSEG(t); BAR_END(2); sk = s1; }
    { const int s1 = ROT3(sk), s2 = ROT3(s1); DMA_V(NT - 1, s1); MSEG(true, true, sk, s2); BAR_MID(); VSEG(NT - 2); BAR_END(1); sk = s1; }
    { const int s1 = ROT3(sk), s2 = ROT3(s1); MSEG(true, true, sk, s2); BAR_MID(); VSEG(NT - 1); BAR_END(0); sk = s1; }
    { const int s2 = ROT3(ROT3(sk)); MSEG(false, true, 0, s2); BAR_MID(); BAR_END(0); }
  } else {
    DMA_K(2, 2); DMA_V(1, 1); BAR_MID(); MSEG(true, false, 0, 0); BAR_END(2);
    sk = 1;
    for (int t = 1; t <= NT - 3; ++t) { const int s1 = ROT3(sk), s2 = ROT3(s1);
      DMA_K(t + 2, s2); DMA_V(t + 1, s1); VSEG(t - 1); BAR_MID(); MSEG(true, true, sk, s2); BAR_END(2); sk = s1; }
    { const int s1 = ROT3(sk), s2 = ROT3(s1); DMA_V(NT - 1, s1); VSEG(NT - 3); BAR_MID(); MSEG(true, true, sk, s2); BAR_END(1); sk = s1; }
    { const int s1 = ROT3(sk), s2 = ROT3(s1); VSEG(NT - 2); BAR_MID(); MSEG(true, true, sk, s2); BAR_END(0); sk = s1; }
    { const int s2 = ROT3(ROT3(sk)); VSEG(NT - 1); BAR_MID(); MSEG(false, true, 0, s2); BAR_END(0); }
  }
  m_out = m_reg;
#undef DMA_K
#undef DMA_V
#undef BAR_MID
#undef BAR_END
#undef RESC2
#undef VSEG
#undef RD16
#undef CAT8
#undef MSEG
#undef ROT3
}
#undef KSWZ
#undef SBAR
}

constexpr size_t MiB = 1u << 20;
constexpr size_t WS_CTL = 0, CTL_ZERO_BYTES = 1 * MiB;
constexpr size_t WS_MODP = 1 * MiB;
constexpr size_t WS_MODV = 2 * MiB;
constexpr size_t WS_ROPE = 2 * MiB + 128 * 1024;
constexpr size_t WS_ROUTE = 3 * MiB;
constexpr size_t WS_WIN = 4 * MiB, WS_WOUT = 9 * MiB, WS_WGU = 12 * MiB, WS_WDN = 140 * MiB;
constexpr size_t WS_ELIST = 238 * MiB;
constexpr size_t WS_XN = 204 * MiB;
constexpr size_t WS_QA = 240 * MiB, WS_KA = 256 * MiB, WS_VA = 274 * MiB, WS_QB = 292 * MiB, WS_KB = 308 * MiB, WS_VB = 314 * MiB;
constexpr size_t WS_Y = 320 * MiB, WS_X1 = 352 * MiB, WS_XG = 416 * MiB, WS_H = 560 * MiB, WS_Y2 = 704 * MiB, WS_END = 848 * MiB;
constexpr int CW_TMO = 0, CW_CODE = 1, CW_BAR = 4096, CW_CNT = 8192;
constexpr int MODP_KC = 8;

constexpr int RING_OFF = 0, RING_BYTES = 131072;
constexpr int LDSCTL_OFF = RING_BYTES, MISC_OFF = LDSCTL_OFF + 320, XTRA_OFF = LDSCTL_OFF + 1024;
constexpr int LDS_BYTES = 147456;

__device__ const double ROPE_CS[32] = {
    0.54030230586813977, 0.8414709848078965, 0.84600911028170789, 0.53316843991402285, 0.95041528025518285, 0.31098359290718575, 0.98423023447009461, 0.17689218624615005,
    0.99500416527802582, 0.099833416646828155, 0.99841927779266448, 0.056204499214692491, 0.99950004166527784, 0.031617506402433708, 0.99984189028361437, 0.01778185687966613,
    0.99995000041666526, 0.0099998333341666645, 0.9999841886533658, 0.0056233836139601857, 0.99999500000416663, 0.0031622723897082477, 0.99999841886158658, 0.0017782784728035289,
    0.99999950000004167, 0.00099999983333334168, 0.99999984188612112, 0.00056234129555235944, 0.99999995000000041, 0.00031622776074637522, 0.99999998418861169, 0.00017782794006665674};

__device__ __forceinline__ unsigned cvtpk(float lo, float hi) { return at2::cvtpk2(lo, hi); }
__device__ __forceinline__ unsigned pk4_fp8(float a, float b, float c, float d) { int w = 0; w = __builtin_amdgcn_cvt_pk_fp8_f32(a, b, w, false); w = __builtin_amdgcn_cvt_pk_fp8_f32(c, d, w, true); return (unsigned)w; }
__device__ __forceinline__ float bflo(unsigned w) { return __uint_as_float(w << 16); }
__device__ __forceinline__ float bfhi(unsigned w) { return __uint_as_float(w & 0xffff0000u); }
__device__ __forceinline__ bf16 f2bf1(float f) { return (bf16)(cvtpk(f, 0.f) & 0xffffu); }
__device__ __forceinline__ void unpack8(const v4u v, float* f) { f[0] = bflo(v.x); f[1] = bfhi(v.x); f[2] = bflo(v.y); f[3] = bfhi(v.y); f[4] = bflo(v.z); f[5] = bfhi(v.z); f[6] = bflo(v.w); f[7] = bfhi(v.w); }
__device__ __forceinline__ float wave_sum(float v) {
#pragma unroll
    for (int o = 1; o < 64; o <<= 1) v += __shfl_xor(v, o);
    return v;
}

struct Frame {
    LAS unsigned char* lds;
    volatile LAS unsigned* MISC;
    gu32* ctl;
    int tid, lane, wave, vcu, G, probe;
    const float *x, *c, *ctx, *c_ctx, *w_mod, *b_mod, *norm1_g, *w_in, *lq1, *lk1, *lq2, *lk2, *subln_g, *sink, *w_out, *norm2_g, *w_router, *b_router, *w_gu, *b_gu, *w_dn, *b_dn, *final_g;
    float* out;
    float *modp, *modv, *rope, *X1, *rgate;
    int *re, *rslot, *rpos, *elist;
    bf16 *Win_t, *Wout_t, *Wgu_t, *Wdn_t, *XN, *QA, *KA, *VA, *QB, *KB, *VB, *Y, *XG, *H, *Y2;
};

#ifdef PROBE_BUILD
#define RP(F, k) (1 + (((F).probe >> (k)) & 1))
#else
#define RP(F, k) 1
#endif
struct EpiQKV {
    bf16 *QA, *KA, *VA, *QB, *KB, *VB; const float* rope;
    struct Ctx { bf16* p; bool skip, rp, isq; const float* cs; };
    __device__ __forceinline__ Ctx prep(int row, int cg) const {
        Ctx c; const bool lat = row < NTOK; const int b = lat ? (row >> 13) : ((row - NTOK) >> 8);
        const int kvrow = lat ? (b * KVLEN + (row & (SEQ - 1))) : (b * KVLEN + SEQ + ((row - NTOK) & (CTXL - 1)));
        c.skip = false; c.rp = lat; c.isq = false;
        if (cg < 512)       { c.p = QA + (size_t)row * 512 + cg; c.isq = true; c.skip = !lat; }
        else if (cg < 1024) { c.p = KA + (size_t)kvrow * 512 + (cg - 512); }
        else if (cg < 1536) { c.p = VA + (size_t)kvrow * 512 + (cg - 1024); c.rp = false; }
        else if (cg < 2048) { c.p = QB + (size_t)row * 512 + (cg - 1536); c.isq = true; c.skip = !lat; }
        else if (cg < 2176) { c.p = KB + (size_t)kvrow * 128 + (cg - 2048); }
        else                { c.p = VB + (size_t)kvrow * 128 + (cg - 2176); c.rp = false; }
        const int t = row & (SEQ - 1); const int pos = ((cg >> 5) & 1) ? (t & 63) : (t >> 6);
        c.cs = rope + pos * 32;
        return c;
    }
    __device__ __forceinline__ void math(const Ctx& c, int i, float lo, float hi, float& olo, float& ohi) const {
        if (c.rp) { const float cs = c.cs[2 * i], sn = c.cs[2 * i + 1]; olo = lo * cs - hi * sn; ohi = hi * cs + lo * sn; } else { olo = lo; ohi = hi; }
        if (c.isq) { olo *= QSCALE; ohi *= QSCALE; }
    }
    __device__ __forceinline__ void one(int row, int cg, int i, float lo, float hi, int) const {
        const Ctx c = prep(row, cg); if (c.skip) return; float a, b; math(c, i, lo, hi, a, b); c.p[i] = f2bf1(a); c.p[16 + i] = f2bf1(b);
    }
    __device__ __forceinline__ void four(int row, int cg, int i0, const f32x4 lo, const f32x4 hi, int) const {
        const Ctx c = prep(row, cg); if (c.skip) return; float a[4], b[4];
#pragma unroll
        for (int i = 0; i < 4; ++i) math(c, i0 + i, lo[i], hi[i], a[i], b[i]);
        typedef unsigned u32x2 __attribute__((ext_vector_type(2)));
        *(u32x2*)(c.p + i0) = (u32x2){cvtpk(a[0], a[1]), cvtpk(a[2], a[3])}; *(u32x2*)(c.p + 16 + i0) = (u32x2){cvtpk(b[0], b[1]), cvtpk(b[2], b[3])};
    }
};
struct EpiOut {
    const float* x; const float* modv; float* X1;
    __device__ __forceinline__ void one(int row, int cg, int i, float lo, float hi, int) const {
        const float* g1 = modv + (row >> 13) * 6144 + 2048; const size_t o = (size_t)row * DM + cg + i;
        X1[o] = x[o] + g1[cg + i] * lo; X1[o + 16] = x[o + 16] + g1[cg + 16 + i] * hi;
    }
    __device__ __forceinline__ void four(int row, int cg, int i0, const f32x4 lo, const f32x4 hi, int) const {
        const float* g1 = modv + (row >> 13) * 6144 + 2048 + cg + i0; const size_t o = (size_t)row * DM + cg + i0;
        typedef unsigned u32x2 __attribute__((ext_vector_type(2)));
        const f32x4 a = *(const f32x4*)(x + o) + *(const f32x4*)(g1) * lo, b = *(const f32x4*)(x + o + 16) + *(const f32x4*)(g1 + 16) * hi;
        *(u32x2*)((bf16*)X1 + o) = (u32x2){cvtpk(a[0], a[1]), cvtpk(a[2], a[3])}; *(u32x2*)((bf16*)X1 + o + 16) = (u32x2){cvtpk(b[0], b[1]), cvtpk(b[2], b[3])};
    }
};
__device__ __forceinline__ float swiglu(float g, float lin) {
    g = fminf(g, 7.0f); lin = fminf(fmaxf(lin, -7.0f), 7.0f);
    return g * __builtin_amdgcn_rcpf(1.0f + __builtin_amdgcn_exp2f(-1.702f * LOG2E * g)) * (lin + 1.0f);
}
struct EpiGU {
    unsigned char* H; const float* b_gu;
    __device__ __forceinline__ void one(int row, int cg, int i, float lo, float hi, int e) const { (void)row; (void)cg; (void)i; (void)lo; (void)hi; (void)e; }
    __device__ __forceinline__ void four(int row, int cg, int i0, const f32x4 lo, const f32x4 hi, int e) const {
        const int f = (cg >> 1) + i0; const float* bb = b_gu + e * GUW + 2 * f; const f32x4 b0 = *(const f32x4*)bb, b1 = *(const f32x4*)(bb + 4);
        const float a0 = swiglu(lo[0] + b0[0], hi[0] + b0[1]), a1 = swiglu(lo[1] + b0[2], hi[1] + b0[3]), a2 = swiglu(lo[2] + b1[0], hi[2] + b1[1]), a3 = swiglu(lo[3] + b1[2], hi[3] + b1[3]);
        *(unsigned*)(H + (size_t)row * DM + f) = pk4_fp8(a0, a1, a2, a3);
    }
};
struct EpiDN {
    bf16* Y2; const float* b_dn;
    __device__ __forceinline__ void eight(int row, int c0, const f32x4 v0, const f32x4 v1, int e) const {
        const float* bb = b_dn + e * DM + c0; const f32x4 b0 = *(const f32x4*)bb, b1 = *(const f32x4*)(bb + 4);
        typedef unsigned u32x2 __attribute__((ext_vector_type(2)));
        *(u32x2*)((unsigned char*)Y2 + (size_t)row * DM + c0) = (u32x2){pk4_fp8(v0[0] + b0[0], v0[1] + b0[1], v0[2] + b0[2], v0[3] + b0[3]), pk4_fp8(v1[0] + b1[0], v1[1] + b1[1], v1[2] + b1[2], v1[3] + b1[3])};
    }
    __device__ __forceinline__ void one(int row, int cg, int i, float lo, float hi, int e) const {
        const float* bb = b_dn + e * DM + cg + i; bf16* p = Y2 + (size_t)row * DM + cg + i; p[0] = f2bf1(lo + bb[0]); p[16] = f2bf1(hi + bb[16]);
    }
    __device__ __forceinline__ void four(int row, int cg, int i0, const f32x4 lo, const f32x4 hi, int e) const {
        const float* bb = b_dn + e * DM + cg + i0; const f32x4 b0 = *(const f32x4*)bb, b1 = *(const f32x4*)(bb + 16); bf16* p = Y2 + (size_t)row * DM + cg + i0;
        typedef unsigned u32x2 __attribute__((ext_vector_type(2)));
        *(u32x2*)p = (u32x2){cvtpk(lo[0] + b0[0], lo[1] + b0[1]), cvtpk(lo[2] + b0[2], lo[3] + b0[3])}; *(u32x2*)(p + 16) = (u32x2){cvtpk(hi[0] + b1[0], hi[1] + b1[1]), cvtpk(hi[2] + b1[2], hi[3] + b1[3])};
    }
};
template <class E, int NN> struct EpiAdapt {
    static constexpr bool PERM = false, AFTER_DRAIN = false;
    E e;
    __device__ __forceinline__ void operator()(const pg8::f32x4 (&acc)[2][2][4][2], const pg8::Unit& u, int wr, int wc, int fr, int fq) const {
        int ex = 0, pn = u.pn; if (NN) { ex = pn / NN; pn = pn - ex * NN; }
#pragma unroll
        for (int ai = 0; ai < 2; ++ai)
#pragma unroll
            for (int m = 0; m < 4; ++m) { const int row = u.pm * 256 + ai * 128 + wr * 64 + m * 16 + fr;
#pragma unroll
                for (int bj = 0; bj < 2; ++bj) e.four(row, pn * 256 + bj * 128 + wc * 32, 4 * fq, acc[ai][bj][m][0], acc[ai][bj][m][1], ex); }
    }
};
struct RepOrder : pg8::StaticOrder { int rep;
    __device__ __forceinline__ bool next(int i, pg8::Unit& u) const { if (rep > 1) { const int R = (nwg + G - 1) / G; if (i >= R * rep) return false; i %= R; } return pg8::StaticOrder::next(i, u); } };
struct EpiQKVFast {
    static constexpr bool PERM = false, AFTER_DRAIN = false;
    bf16 *QA, *KA, *VA, *QB, *KB, *VB; const float* rope;
    __device__ __forceinline__ void operator()(const pg8::f32x4 (&acc)[2][2][4][2], const pg8::Unit& u, int wr, int wc, int fr, int fq) const {
        typedef unsigned u32x2 __attribute__((ext_vector_type(2)));
        bf16* base[2]; int ld[2]; bool isq[2], rp[2], kvr[2], f8[2];
#pragma unroll
        for (int bj = 0; bj < 2; ++bj) { const int cg = u.pn * 256 + bj * 128 + wc * 32; isq[bj] = false; rp[bj] = true; kvr[bj] = true; f8[bj] = true;
            if (cg < 512)       { base[bj] = (bf16*)((unsigned char*)QA + cg); ld[bj] = 512; isq[bj] = true; kvr[bj] = false; }
            else if (cg < 1024) { base[bj] = (bf16*)((unsigned char*)KA + (cg - 512)); ld[bj] = 512; }
            else if (cg < 1536) { base[bj] = (bf16*)((unsigned char*)VA + (cg - 1024)); ld[bj] = 512; rp[bj] = false; }
            else if (cg < 2048) { base[bj] = (bf16*)((unsigned char*)QB + (cg - 1536)); ld[bj] = 512; isq[bj] = true; kvr[bj] = false; }
            else if (cg < 2176) { base[bj] = (bf16*)((unsigned char*)KB + (cg - 2048)); ld[bj] = 128; }
            else                { base[bj] = (bf16*)((unsigned char*)VB + (cg - 2176)); ld[bj] = 128; rp[bj] = false; } }
        const bool colhalf = (wc & 1) != 0;
#pragma unroll
        for (int ai = 0; ai < 2; ++ai)
#pragma unroll
            for (int m = 0; m < 4; ++m) {
                const int row = u.pm * 256 + ai * 128 + wr * 64 + m * 16 + fr; const bool lat = row < NTOK;
                const int b = lat ? (row >> 13) : ((row - NTOK) >> 8);
                const int kvrow = lat ? (b * KVLEN + (row & (SEQ - 1))) : (b * KVLEN + SEQ + ((row - NTOK) & (CTXL - 1)));
                const int t = row & (SEQ - 1), pos = colhalf ? (t & 63) : (t >> 6);
                const f32x4 c0 = *(const f32x4*)(rope + pos * 32 + 8 * fq), c1 = *(const f32x4*)(rope + pos * 32 + 8 * fq + 4);
#pragma unroll
                for (int bj = 0; bj < 2; ++bj) {
                    if (isq[bj] && !lat) continue;
                    f32x4 lo = acc[ai][bj][m][0], hi = acc[ai][bj][m][1];
                    if (rp[bj] && lat) { const f32x4 cs = {c0[0], c0[2], c1[0], c1[2]}, sn = {c0[1], c0[3], c1[1], c1[3]}; const f32x4 nl = lo * cs - hi * sn, nh = hi * cs + lo * sn; lo = nl; hi = nh; }
                    if (isq[bj]) { lo = lo * QSCALE; hi = hi * QSCALE; }
                    const size_t rr = (size_t)(kvr[bj] ? kvrow : row) * ld[bj];
                    if (f8[bj]) { unsigned char* p = (unsigned char*)base[bj] + rr + 4 * fq; *(unsigned*)p = pk4_fp8(lo[0], lo[1], lo[2], lo[3]); *(unsigned*)(p + 16) = pk4_fp8(hi[0], hi[1], hi[2], hi[3]); }
                    else { bf16* p = base[bj] + rr + 4 * fq; *(u32x2*)p = (u32x2){cvtpk(lo[0], lo[1]), cvtpk(lo[2], lo[3])}; *(u32x2*)(p + 16) = (u32x2){cvtpk(hi[0], hi[1]), cvtpk(hi[2], hi[3])}; }
                }
            }
    }
};
template <class E, int NN> struct EpiAdaptP {
    static constexpr bool PERM = true, AFTER_DRAIN = false;
    E e;
    __device__ __forceinline__ void operator()(const pg8::f32x4 (&acc)[2][2][4][2], const pg8::Unit& u, int wr, int wc, int fr, int fq) const {
        int ex = 0, pn = u.pn; if (NN) { ex = pn / NN; pn = pn - ex * NN; }
#pragma unroll
        for (int ai = 0; ai < 2; ++ai)
#pragma unroll
            for (int m = 0; m < 4; ++m) { const int row = u.pm * 256 + ai * 128 + wr * 64 + m * 16 + fr;
#pragma unroll
                for (int bj = 0; bj < 2; ++bj) e.eight(row, pn * 256 + bj * 128 + wc * 32 + 8 * fq, acc[ai][bj][m][0], acc[ai][bj][m][1], ex); }
    }
};
struct GroupedOrder {
    int nN, NP, G, c; const LAS int* pexp; int rep; const LAS int* tokT;
    __device__ __forceinline__ int rounds() const { const int upr = G / nN; return (NP + upr - 1) / upr; }
    __device__ __forceinline__ int tok(int ui, int r) const { if (rep > 1) ui %= rounds(); return tokT[ui * 256 + r]; }
    __device__ __forceinline__ bool next(int i, pg8::Unit& u) const {
        int p, j;
        if (rep > 1) { const int R = rounds(); if (i >= R * rep) return false; i %= R; }
        if (G == 256) { const int x = c & 7, r = c >> 3, ppx = 32 / nN; p = i * (8 * ppx) + x * ppx + r / nN; j = r % nN; }
        else { const long L = (long)i * G + c; p = (int)(L / nN); j = (int)(L % nN); }
        if (p >= NP) return false;
        u.pm = p; u.pn = pexp[p] * nN + j; return true;
    }
    __device__ __forceinline__ void a_ready(const pg8::Unit&) const {}
    __device__ __forceinline__ void done(const pg8::Unit&) const {}
};

struct DenseSel { const bf16* Bt; __device__ __forceinline__ const bf16* operator()(int, int& e) const { e = 0; return Bt; } };
struct GroupSel { const bf16* Bt; const LAS int* pexp; int N, K; __device__ __forceinline__ const bf16* operator()(int mt, int& e) const { e = pexp[mt >> 1]; return Bt + (size_t)e * N * K; } };
template <class Epi, class BSel>
__device__ __forceinline__ void naive_gemm(Frame& F, const bf16* A, int Mtiles, int N, int K, const BSel& bs, const Epi& E) {
    LAS float* As = (LAS float*)(F.lds + RING_OFF); LAS float* Bs = As + 128 * 33;
    const int nNt = N / 64, tx = F.tid & 15, ty = F.tid >> 4;
    for (int t = blockIdx.x; t < Mtiles * nNt; t += F.G) {
        const int mt = t / nNt, nt = t % nNt; int e; const bf16* Bt = bs(mt, e);
        float acc[4][4];
#pragma unroll
        for (int r = 0; r < 4; ++r)
#pragma unroll
            for (int j = 0; j < 4; ++j) acc[r][j] = 0.f;
        for (int k0 = 0; k0 < K; k0 += 32) {
            { const int r = F.tid >> 2, kc = (F.tid & 3) * 8; float f[8]; unpack8(*(const v4u*)(A + (size_t)(mt * 128 + r) * K + k0 + kc), f);
#pragma unroll
              for (int i = 0; i < 8; ++i) As[r * 33 + kc + i] = f[i]; }
            if (F.tid < 256) { const int r = F.tid >> 2, kc = (F.tid & 3) * 8; float f[8]; unpack8(*(const v4u*)(Bt + (size_t)(nt * 64 + r) * K + k0 + kc), f);
#pragma unroll
              for (int i = 0; i < 8; ++i) Bs[r * 33 + kc + i] = f[i]; }
            __syncthreads();
#pragma unroll 8
            for (int kk = 0; kk < 32; ++kk) { float a[4], b[4];
#pragma unroll
                for (int r = 0; r < 4; ++r) a[r] = As[(ty * 4 + r) * 33 + kk];
#pragma unroll
                for (int j = 0; j < 4; ++j) b[j] = Bs[(tx + 16 * j) * 33 + kk];
#pragma unroll
                for (int r = 0; r < 4; ++r)
#pragma unroll
                    for (int j = 0; j < 4; ++j) acc[r][j] += a[r] * b[j]; }
            __syncthreads();
        }
#pragma unroll
        for (int r = 0; r < 4; ++r) { const int row = mt * 128 + ty * 4 + r; E.one(row, nt * 64, tx, acc[r][0], acc[r][1], e); E.one(row, nt * 64 + 32, tx, acc[r][2], acc[r][3], e); }
    }
}

template <bool GUPERM>
__device__ __forceinline__ void p0_transpose_item(const float* W, int K, int N, bf16* WT, LAS float* scr, int item, int lane) {
    const int nblk = N / 32, kb = item / nblk, nb = item % nblk, k0 = 64 * kb, n0 = 32 * nb;
    { f32x4 v[8]; const float* wp = W + (size_t)(k0 + (lane >> 3)) * N + n0 + 4 * (lane & 7);
#pragma unroll
      for (int i = 0; i < 8; ++i) v[i] = __builtin_nontemporal_load((const f32x4*)(wp + (size_t)(8 * i) * N));
#pragma unroll
      for (int i = 0; i < 8; ++i) { LAS float* d = scr + (8 * i + (lane >> 3)) * 33 + 4 * (lane & 7); d[0] = v[i].x; d[1] = v[i].y; d[2] = v[i].z; d[3] = v[i].w; } }
    LDS_WAIT(); asm volatile("" ::: "memory");
    const int c = lane & 7;
#pragma unroll
    for (int j = 0; j < 4; ++j) { const int n = (lane >> 3) + 8 * j; const LAS float* s = scr + (8 * c) * 33 + n;
        v4u o; o.x = cvtpk(s[0 * 33], s[1 * 33]); o.y = cvtpk(s[2 * 33], s[3 * 33]); o.z = cvtpk(s[4 * 33], s[5 * 33]); o.w = cvtpk(s[6 * 33], s[7 * 33]);
        const int nd = GUPERM ? ((n & 1) * 16 + (n >> 1)) : n;
        *(GAS v4u*)(WT + (size_t)(n0 + nd) * K + k0 + 8 * c) = o; }
    LDS_WAIT(); asm volatile("" ::: "memory");
}
template <bool GUPERM>
__device__ __forceinline__ void p0_transpose_item_fp8(const float* W, int K, int N, unsigned char* WT, LAS float* scr, int item, int lane) {
    const int nblk = N / 32, kb = item / nblk, nb = item % nblk, k0 = 64 * kb, n0 = 32 * nb;
    { f32x4 v[8]; const float* wp = W + (size_t)(k0 + (lane >> 3)) * N + n0 + 4 * (lane & 7);
#pragma unroll
      for (int i = 0; i < 8; ++i) v[i] = __builtin_nontemporal_load((const f32x4*)(wp + (size_t)(8 * i) * N));
#pragma unroll
      for (int i = 0; i < 8; ++i) { LAS float* d = scr + (8 * i + (lane >> 3)) * 33 + 4 * (lane & 7); d[0] = v[i].x; d[1] = v[i].y; d[2] = v[i].z; d[3] = v[i].w; } }
    LDS_WAIT(); asm volatile("" ::: "memory");
    const int c = lane & 7;
    typedef unsigned u32x2 __attribute__((ext_vector_type(2)));
#pragma unroll
    for (int j = 0; j < 4; ++j) { const int n = (lane >> 3) + 8 * j; const LAS float* s = scr + (8 * c) * 33 + n;
        u32x2 o; o.x = pk4_fp8(s[0 * 33] * 32.f, s[1 * 33] * 32.f, s[2 * 33] * 32.f, s[3 * 33] * 32.f); o.y = pk4_fp8(s[4 * 33] * 32.f, s[5 * 33] * 32.f, s[6 * 33] * 32.f, s[7 * 33] * 32.f);
        const int nd = GUPERM ? ((n & 1) * 16 + (n >> 1)) : n;
        *(GAS u32x2*)(WT + (size_t)(n0 + nd) * K + k0 + 8 * c) = o; }
    LDS_WAIT(); asm volatile("" ::: "memory");
}
struct F8Item { const float* wp; unsigned char* wt; int K; int guperm; };
__device__ __forceinline__ F8Item f8_decode(const Frame& F, int r, int lane) {
    constexpr int I_GU1 = (DM / 64) * (GUW / 32), I_DN1 = (DM / 64) * (DM / 32);
    F8Item I; const float* W; int N, item; unsigned char* WT;
    if (r < NEXP * I_GU1) { const int e = r / I_GU1; item = r % I_GU1; W = F.w_gu + (size_t)e * DM * GUW; N = GUW; WT = (unsigned char*)F.Wgu_t + (size_t)e * GUW * DM; I.guperm = 1; }
    else { r -= NEXP * I_GU1; const int e = r / I_DN1; item = r % I_DN1; W = F.w_dn + (size_t)e * DM * DM; N = DM; WT = (unsigned char*)F.Wdn_t + (size_t)e * DM * DM; I.guperm = 0; }
    const int nblk = N / 32, kb = item / nblk, nb = item % nblk, k0 = 64 * kb, n0 = 32 * nb;
    I.wp = W + (size_t)(k0 + (lane >> 3)) * N + n0 + 4 * (lane & 7); I.K = N;
    I.wt = WT + (size_t)n0 * DM + k0 + 8 * (lane & 7);
    return I;
}
__device__ __forceinline__ void f8_issue(const F8Item& I, f32x4 (&v)[8]) {
#pragma unroll
    for (int i = 0; i < 8; ++i) v[i] = __builtin_nontemporal_load((const f32x4*)(I.wp + (size_t)(8 * i) * I.K));
}
__device__ __forceinline__ void f8_finish(const F8Item& I, f32x4 (&v)[8], LAS float* scr, int lane) {
#pragma unroll
    for (int i = 0; i < 8; ++i) { LAS float* d = scr + (8 * i + (lane >> 3)) * 33 + 4 * (lane & 7); d[0] = v[i].x; d[1] = v[i].y; d[2] = v[i].z; d[3] = v[i].w; }
    LDS_WAIT(); asm volatile("" ::: "memory");
    const int c = lane & 7;
    typedef unsigned u32x2 __attribute__((ext_vector_type(2)));
#pragma unroll
    for (int j = 0; j < 4; ++j) { const int n = (lane >> 3) + 8 * j; const LAS float* s = scr + (8 * c) * 33 + n;
        u32x2 o; o.x = pk4_fp8(s[0 * 33] * 32.f, s[1 * 33] * 32.f, s[2 * 33] * 32.f, s[3 * 33] * 32.f); o.y = pk4_fp8(s[4 * 33] * 32.f, s[5 * 33] * 32.f, s[6 * 33] * 32.f, s[7 * 33] * 32.f);
        const int nd = I.guperm ? ((n & 1) * 16 + (n >> 1)) : n;
        *(GAS u32x2*)(I.wt + (size_t)nd * DM) = o; }
    LDS_WAIT(); asm volatile("" ::: "memory");
}
__device__ __forceinline__ void f8_stream(const Frame& F, LAS float* scr, int r, int rend, int stride) {
    f32x4 va[8], vb[8]; F8Item Ia, Ib;
    if (r >= rend) return;
    Ia = f8_decode(F, r, F.lane); f8_issue(Ia, va);
    while (true) {
        int nx = r + stride;
        if (nx < rend) { Ib = f8_decode(F, nx, F.lane); f8_issue(Ib, vb); }
        f8_finish(Ia, va, scr, F.lane);
        r = nx; if (r >= rend) break;
        nx = r + stride;
        if (nx < rend) { Ia = f8_decode(F, nx, F.lane); f8_issue(Ia, va); }
        f8_finish(Ib, vb, scr, F.lane);
        r = nx; if (r >= rend) break;
    }
}
__device__ __forceinline__ void p0_item(Frame& F, LAS float* sil, LAS float* scr, int it) {
    constexpr int I_IN = (DM / 64) * (INC / 32), I_OUT = (DM / 64) * (DM / 32), I_GU1 = (DM / 64) * (GUW / 32), I_DN1 = (DM / 64) * (DM / 32);

        int r = it;
        if (r < I_IN) { p0_transpose_item<false>(F.w_in, DM, INC, F.Win_t, scr, r, F.lane); return; } r -= I_IN;
        if (r < I_OUT) { p0_transpose_item<false>(F.w_out, DM, DM, F.Wout_t, scr, r, F.lane); return; } r -= I_OUT;
        if (r < NEXP * I_GU1) { const int e = r / I_GU1; p0_transpose_item_fp8<true>(F.w_gu + (size_t)e * DM * GUW, DM, GUW, (unsigned char*)F.Wgu_t + (size_t)e * GUW * DM, scr, r % I_GU1, F.lane); return; } r -= NEXP * I_GU1;
        { const int e = r / I_DN1; p0_transpose_item_fp8<false>(F.w_dn + (size_t)e * DM * DM, DM, DM, (unsigned char*)F.Wdn_t + (size_t)e * DM * DM, scr, r % I_DN1, F.lane); }
}
constexpr int P0_NITEMS = (DM / 64) * (INC / 32) + (DM / 64) * (DM / 32) + NEXP * (DM / 64) * (GUW / 32) + NEXP * (DM / 64) * (DM / 32);
constexpr int P0_SPLIT = P0_NITEMS - 13920;
__device__ __forceinline__ void p0_tail(Frame& F) {
    LAS float* scr = (LAS float*)(F.lds + RING_OFF + F.wave * 16384);
    const int w = ((int)blockIdx.x - 82) * NWAVES + F.wave, NW = (F.G - 82) * NWAVES;
    constexpr int NPRE = (DM / 64) * (INC / 32) + (DM / 64) * (DM / 32);
    f8_stream(F, scr, P0_SPLIT - NPRE + w, P0_NITEMS - NPRE, NW);
}
__device__ __forceinline__ void p0_prologue(Frame& F) {
    LAS float* sil = (LAS float*)(F.lds + XTRA_OFF);
    for (int i = F.tid; i < 3072; i += 512) { const int v = i >> 10, k = i & 1023; const float cv = (v < 2) ? F.c[v * 1024 + k] : F.c_ctx[k]; sil[i] = cv / (1.f + __expf(-cv)); }
    __syncthreads();
    const int gw = F.vcu * NWAVES + F.wave, NGW = F.G * NWAVES;
    if (blockIdx.x == 0) for (int i = F.tid; i < 2048; i += 512) { const int pos = i >> 4, j = i & 15; double cr = 1.0, sr = 0.0, cb = ROPE_CS[2 * j], sb = ROPE_CS[2 * j + 1];
        for (int bit = 0; bit < 7; ++bit) { if ((pos >> bit) & 1) { const double t = cr * cb - sr * sb; sr = cr * sb + sr * cb; cr = t; } const double t2 = cb * cb - sb * sb; sb = 2.0 * cb * sb; cb = t2; }
        F.rope[2 * i] = (float)cr; F.rope[2 * i + 1] = (float)sr; }
    for (int r = F.vcu; r < 24 * MODP_KC; r += F.G) {
        const int nb = r % 24, kc = r / 24, n = nb * 256 + F.lane * 4, kbase = kc * 128 + F.wave * 16;
        f32x4 a0 = {0.f, 0.f, 0.f, 0.f}, a1 = a0, a2 = a0;
        const float* wp = F.w_mod + (size_t)kbase * 6144 + n;
#pragma unroll
        for (int kk = 0; kk < 16; ++kk) { const f32x4 w = __builtin_nontemporal_load((const f32x4*)(wp + (size_t)kk * 6144)); const int k = kbase + kk; a0 += w * sil[k]; a1 += w * sil[1024 + k]; a2 += w * sil[2048 + k]; }
        LAS float* red = (LAS float*)(F.lds + RING_OFF);
        *(LAS f32x4*)(red + (F.wave * 3 + 0) * 256 + 4 * F.lane) = a0; *(LAS f32x4*)(red + (F.wave * 3 + 1) * 256 + 4 * F.lane) = a1; *(LAS f32x4*)(red + (F.wave * 3 + 2) * 256 + 4 * F.lane) = a2;
        __syncthreads();
        for (int i = F.tid; i < 768; i += 512) { float t = 0.f;
#pragma unroll
            for (int w = 0; w < NWAVES; ++w) t += red[w * 768 + i];
            F.modp[(size_t)(kc * 3 + i / 256) * 6144 + nb * 256 + (i % 256)] = t; }
        __syncthreads();
    }
    LAS float* scr = (LAS float*)(F.lds + RING_OFF + F.wave * 16384);
    constexpr int I_IN = (DM / 64) * (INC / 32), I_OUT = (DM / 64) * (DM / 32), I_GU1 = (DM / 64) * (GUW / 32), I_DN1 = (DM / 64) * (DM / 32);
    constexpr int NITEMS = I_IN + I_OUT + NEXP * I_GU1 + NEXP * I_DN1;
    const int nsplit = (F.G == 256) ? P0_SPLIT : NITEMS;
    constexpr int NPRE = I_IN + I_OUT;
    int it0 = gw;
    if (NPRE > NGW) { for (; it0 < NPRE; it0 += NGW) p0_item(F, sil, scr, it0); } else if (it0 < NPRE) { p0_item(F, sil, scr, it0); it0 += NGW; }
    f8_stream(F, scr, it0 - NPRE, nsplit - NPRE, NGW);
}
__device__ __forceinline__ void p1_norm(Frame& F) {
    LAS float* ml = (LAS float*)(F.lds + RING_OFF);
    for (int i0 = F.tid; i0 < 6144; i0 += 2048) { float pv[4][MODP_KC], bv[4];
#pragma unroll
        for (int q = 0; q < 4; ++q) { const int i = i0 + 512 * q, v = i / 2048, j = i % 2048; bv[q] = F.b_mod[j];
#pragma unroll
            for (int kc = 0; kc < MODP_KC; ++kc) pv[q][kc] = F.modp[(size_t)(kc * 3 + v) * 6144 + j]; }
#pragma unroll
        for (int q = 0; q < 4; ++q) { float t = bv[q];
#pragma unroll
            for (int kc = 0; kc < MODP_KC; ++kc) t += pv[q][kc];
            ml[i0 + 512 * q] = t; } }
    for (int gi = blockIdx.x * 512 + F.tid; gi < 3 * 6144; gi += F.G * 512) { const int v = gi / 6144, j = gi % 6144; float s = F.b_mod[j];
        for (int kc = 0; kc < MODP_KC; ++kc) s += F.modp[(size_t)(kc * 3 + v) * 6144 + j]; F.modv[gi] = s; }
    __syncthreads();
    const int gw = F.vcu * NWAVES + F.wave, NGW = F.G * NWAVES;
    typedef unsigned u32x2 __attribute__((ext_vector_type(2)));
    for (int pp = gw; pp < (NROW / 2) * RP(F, 1); pp += NGW) { const int m0 = (pp % (NROW / 2)) * 2;
        f32x4 xv[2][4]; float s[2] = {0.f, 0.f}; int v[2];
#pragma unroll
        for (int q = 0; q < 2; ++q) { const int m = m0 + q; v[q] = m < SEQ ? 0 : (m < NTOK ? 1 : 2);
            const float* src = m < NTOK ? F.x + (size_t)m * DM : F.ctx + (size_t)(m - NTOK) * DM;
#pragma unroll
            for (int j = 0; j < 4; ++j) xv[q][j] = __builtin_nontemporal_load((const f32x4*)(src + 4 * F.lane + 256 * j)); }
#pragma unroll
        for (int q = 0; q < 2; ++q)
#pragma unroll
            for (int j = 0; j < 4; ++j) s[q] += (xv[q][j].x * xv[q][j].x + xv[q][j].y * xv[q][j].y) + (xv[q][j].z * xv[q][j].z + xv[q][j].w * xv[q][j].w);
#pragma unroll
        for (int q = 0; q < 2; ++q) { const int m = m0 + q; const float rstd = 1.0f / sqrtf(wave_sum(s[q]) * (1.f / DM) + NORM_EPS);
#pragma unroll
            for (int j = 0; j < 4; ++j) { const int col = 4 * F.lane + 256 * j; const f32x4 g = *(const f32x4*)(F.norm1_g + col);
                const f32x4 sh = *(const LAS f32x4*)(ml + v[q] * 2048 + col), sc = *(const LAS f32x4*)(ml + v[q] * 2048 + 1024 + col);
                const f32x4 y = (xv[q][j] * rstd * g) * (sc + 1.0f) + sh;
                *(u32x2*)(F.XN + (size_t)m * DM + col) = (u32x2){cvtpk(y.x, y.y), cvtpk(y.z, y.w)}; } }
    }
}

__device__ __forceinline__ float lam_value(Frame& F) {
    const float a = wave_sum(F.lq1[F.lane] * F.lk1[F.lane]), b = wave_sum(F.lq2[F.lane] * F.lk2[F.lane]);
    return __expf(a) - __expf(b) + 0.2f;
}
__device__ __forceinline__ void naive_diff_attn(Frame& F) {
    const float lam = lam_value(F);
    LAS float* X = (LAS float*)(F.lds + RING_OFF);
    LAS float* SS = X + 128 * 128;
    const int q = F.tid & 127, comp = (F.tid >> 7) & 1, vh = F.tid >> 8;
    for (int it = blockIdx.x; it < BATCH * 4 * (SEQ / 128); it += F.G) {
        const int b = it >> 8, h = (it >> 6) & 3, qb = it & 63; const int row = b * SEQ + qb * 128 + q;
        float qv[64], o[64];
#pragma unroll
        for (int c8 = 0; c8 < 8; ++c8) unpack8(*(const v4u*)(F.QA + (size_t)row * 512 + h * 128 + comp * 64 + c8 * 8), qv + 8 * c8);
#pragma unroll
        for (int e = 0; e < 64; ++e) o[e] = 0.f;
        float m = -1e30f, l = 0.f;
        const bf16* kp = F.KA + (size_t)(b * KVLEN) * 512 + h * 128 + comp * 64; const bf16* vp = F.VA + (size_t)(b * KVLEN) * 512 + h * 128 + vh * 64;
        for (int key = 0; key < KVLEN; ++key) {
            float s = 0.f;
#pragma unroll
            for (int c8 = 0; c8 < 8; ++c8) { float kf[8]; unpack8(*(const v4u*)(kp + (size_t)key * 512 + c8 * 8), kf);
#pragma unroll
                for (int i = 0; i < 8; ++i) s += qv[8 * c8 + i] * kf[i]; }
            if (s > m) { const float a = exp2f(m - s); l *= a;
#pragma unroll
                for (int e = 0; e < 64; ++e) o[e] *= a;
                m = s; }
            const float p = exp2f(s - m); l += p;
#pragma unroll
            for (int c8 = 0; c8 < 8; ++c8) { float vf[8]; unpack8(*(const v4u*)(vp + (size_t)key * 512 + c8 * 8), vf);
#pragma unroll
                for (int i = 0; i < 8; ++i) o[8 * c8 + i] += p * vf[i]; }
        }
        const float inv = 1.0f / l;
        __syncthreads();
        if (comp == 1) {
#pragma unroll
            for (int e = 0; e < 64; ++e) X[(vh * 64 + e) * 128 + q] = lam * o[e] * inv; }
        __syncthreads();
        if (comp == 0) { float ss = 0.f;
#pragma unroll
            for (int e = 0; e < 64; ++e) { o[e] = o[e] * inv - X[(vh * 64 + e) * 128 + q]; ss += o[e] * o[e]; }
            SS[vh * 128 + q] = ss; }
        __syncthreads();
        if (comp == 0) { const float r = 0.8f / sqrtf((SS[q] + SS[128 + q]) * (1.f / 128.f) + NORM_EPS);
            bf16* yp = F.Y + (size_t)row * DM + h * 128 + vh * 64; const float* sg = F.subln_g + vh * 64;
#pragma unroll
            for (int c8 = 0; c8 < 8; ++c8) { v4u w; w.x = cvtpk(o[8 * c8] * r * sg[8 * c8], o[8 * c8 + 1] * r * sg[8 * c8 + 1]); w.y = cvtpk(o[8 * c8 + 2] * r * sg[8 * c8 + 2], o[8 * c8 + 3] * r * sg[8 * c8 + 3]);
                w.z = cvtpk(o[8 * c8 + 4] * r * sg[8 * c8 + 4], o[8 * c8 + 5] * r * sg[8 * c8 + 5]); w.w = cvtpk(o[8 * c8 + 6] * r * sg[8 * c8 + 6], o[8 * c8 + 7] * r * sg[8 * c8 + 7]);
                *(v4u*)(yp + 8 * c8) = w; } }
    }
}
__device__ __forceinline__ void naive_win_attn(Frame& F) {
    for (int it = blockIdx.x; it < BATCH * 8 * (SEQ / 512); it += F.G) {
        const int b = it >> 7, h = (it >> 4) & 7, t = (it & 15) * 512 + F.tid, kv = h >> 2; const int row = b * SEQ + t;
        float qv[64], o[64];
#pragma unroll
        for (int c8 = 0; c8 < 8; ++c8) unpack8(*(const v4u*)(F.QB + (size_t)row * 512 + h * 64 + c8 * 8), qv + 8 * c8);
#pragma unroll
        for (int e = 0; e < 64; ++e) o[e] = 0.f;
        float m = F.sink[h] * LOG2E, l = 1.0f;
        const bf16* kp = F.KB + (size_t)(b * KVLEN) * 128 + kv * 64; const bf16* vp = F.VB + (size_t)(b * KVLEN) * 128 + kv * 64;
        for (int jj = 0; jj < 257 + CTXL; ++jj) {
            const int key = jj < 257 ? t - 128 + jj : SEQ + (jj - 257);
            if (jj < 257 && (key < 0 || key >= SEQ)) continue;
            float s = 0.f;
#pragma unroll
            for (int c8 = 0; c8 < 8; ++c8) { float kf[8]; unpack8(*(const v4u*)(kp + (size_t)key * 128 + c8 * 8), kf);
#pragma unroll
                for (int i = 0; i < 8; ++i) s += qv[8 * c8 + i] * kf[i]; }
            if (s > m) { const float a = exp2f(m - s); l *= a;
#pragma unroll
                for (int e = 0; e < 64; ++e) o[e] *= a;
                m = s; }
            const float p = exp2f(s - m); l += p;
#pragma unroll
            for (int c8 = 0; c8 < 8; ++c8) { float vf[8]; unpack8(*(const v4u*)(vp + (size_t)key * 128 + c8 * 8), vf);
#pragma unroll
                for (int i = 0; i < 8; ++i) o[8 * c8 + i] += p * vf[i]; }
        }
        const float inv = 1.0f / l; bf16* yp = F.Y + (size_t)row * DM + 512 + h * 64;
#pragma unroll
        for (int c8 = 0; c8 < 8; ++c8) { v4u w; w.x = cvtpk(o[8 * c8] * inv, o[8 * c8 + 1] * inv); w.y = cvtpk(o[8 * c8 + 2] * inv, o[8 * c8 + 3] * inv); w.z = cvtpk(o[8 * c8 + 4] * inv, o[8 * c8 + 5] * inv); w.w = cvtpk(o[8 * c8 + 6] * inv, o[8 * c8 + 7] * inv);
            *(v4u*)(yp + 8 * c8) = w; }
    }
}

#ifndef ATT_PP
#define ATT_PP 3
#endif
constexpr size_t WIN_VT_OFF = 16u << 20;
__device__ __forceinline__ void vt_item(const unsigned char* src, int rstride, unsigned char* drow0, int tile, int dg, int half) {
        unsigned outw[4][8];
#pragma unroll
        for (int i8 = 0; i8 < 8; ++i8) { const int kg = 8 * half + i8;
            const unsigned w0 = *(const unsigned*)(src + (size_t)(4 * kg + 0) * rstride), w1 = *(const unsigned*)(src + (size_t)(4 * kg + 1) * rstride), w2 = *(const unsigned*)(src + (size_t)(4 * kg + 2) * rstride), w3 = *(const unsigned*)(src + (size_t)(4 * kg + 3) * rstride);
            const unsigned a01 = __builtin_amdgcn_perm(w1, w0, 0x05010400u), c01 = __builtin_amdgcn_perm(w1, w0, 0x07030602u);
            const unsigned a23 = __builtin_amdgcn_perm(w3, w2, 0x05010400u), c23 = __builtin_amdgcn_perm(w3, w2, 0x07030602u);
            const int slot = ((i8 >> 1) & 3) + 4 * (i8 & 1);
            outw[0][slot] = __builtin_amdgcn_perm(a23, a01, 0x05040100u); outw[1][slot] = __builtin_amdgcn_perm(a23, a01, 0x07060302u);
            outw[2][slot] = __builtin_amdgcn_perm(c23, c01, 0x05040100u); outw[3][slot] = __builtin_amdgcn_perm(c23, c01, 0x07060302u); }
#pragma unroll
        for (int i = 0; i < 4; ++i) { unsigned char* dst = drow0 + (size_t)i * KVLEN + tile * 64 + 16 * half;
            *(v4u*)dst = (v4u){outw[i][0], outw[i][1], outw[i][2], outw[i][3]}; *(v4u*)(dst + 32) = (v4u){outw[i][4], outw[i][5], outw[i][6], outw[i][7]}; }
}
__device__ __forceinline__ void p3_vt_pass(Frame& F) {
    const unsigned char* V8 = (const unsigned char*)F.VA; unsigned char* VT8 = (unsigned char*)F.XG;
    const unsigned char* VB8 = (const unsigned char*)F.VB; unsigned char* VBT8 = (unsigned char*)F.XG + WIN_VT_OFF;
    const int gw = F.vcu * NWAVES + F.wave, NGW = F.G * NWAVES, dg = F.lane & 31, half = F.lane >> 5;
    constexpr int NTL = KVLEN / 64;
    for (int it = gw; it < 10 * NTL; it += NGW) {
        if (it < 8 * NTL) { const int bh = it / NTL, tile = it % NTL, b = bh >> 2, h = bh & 3;
            vt_item(V8 + ((size_t)(b * KVLEN + tile * 64)) * 512 + h * 128 + 4 * dg, 512, VT8 + ((size_t)(bh * 128 + 4 * dg)) * KVLEN, tile, dg, half); }
        else { const int b = (it - 8 * NTL) / NTL, tile = it % NTL;
            vt_item(VB8 + ((size_t)(b * KVLEN + tile * 64)) * 128 + 4 * dg, 128, VBT8 + ((size_t)(b * 128 + 4 * dg)) * KVLEN, tile, dg, half); }
    }
}
__device__ __forceinline__ void diff_unit(Frame& F, int b, int h, int qb, float lam) {
    using namespace at2;
    const int wid = F.wave, lane = F.lane, r32 = lane & 31, hi = lane >> 5, qblk = wid >> 1, comp = wid & 1;
    const int row0 = b * SEQ + qb * 128 + qblk * 32;
    UnitArgs8 a; a.Q = (const unsigned char*)F.QA + (size_t)row0 * 512 + h * 128 + comp * 64;
    a.K = (const unsigned char*)F.KA + (size_t)(b * KVLEN) * 512 + h * 128; a.VT = (const unsigned char*)F.XG + (size_t)((b * 4 + h) * 128) * KVLEN; a.comp = comp; a.ldk = 512; a.vdoff = 0; a.q0 = 0; a.ks = 0;
    f32x16 o[4]; o[0] = f32x16{}; o[1] = f32x16{}; o[2] = f32x16{}; o[3] = f32x16{};
    float m; f32x16 ol = f32x16{};
    AT_LAS char* lds = (AT_LAS char*)F.lds;
    attn_tiles_f8<true>(a, lds, F.tid, wid, lane, o, ol, m);
    float rli[16];
#pragma unroll
    for (int r = 0; r < 16; ++r) rli[r] = __builtin_amdgcn_rcpf(ol[r]);
    __syncthreads();
    AT_LAS float* XD = (AT_LAS float*)lds + qblk * 32 * XROW;
    if (comp == 1) {
#pragma unroll
        for (int r = 0; r < 16; ++r)
#pragma unroll
            for (int d0 = 0; d0 < 4; ++d0) XD[crow(r, hi) * XROW + d0 * 32 + r32] = lam * (o[d0][r] * rli[r]); }
    __syncthreads();
    if (comp == 0) {
#pragma unroll
        for (int r = 0; r < 16; ++r)
#pragma unroll
            for (int d0 = 0; d0 < 4; ++d0) { const int idx = crow(r, hi) * XROW + d0 * 32 + r32; XD[idx] = o[d0][r] * rli[r] - XD[idx]; }
        asm volatile("s_waitcnt lgkmcnt(0)" ::: "memory");
        const int row = lane >> 1, half = lane & 1;
        f32x4 v[16]; float ss = 0.f;
#pragma unroll
        for (int i = 0; i < 16; ++i) { v[i] = *(const AT_LAS f32x4*)(XD + row * XROW + half * 64 + 4 * i); ss += (v[i].x * v[i].x + v[i].y * v[i].y) + (v[i].z * v[i].z + v[i].w * v[i].w); }
        ss += __shfl_xor(ss, 1);
        const float rs = 0.8f / sqrtf(ss * (1.f / 128.f) + NORM_EPS);
        bf16* yp = F.Y + (size_t)(row0 + row) * DM + h * 128 + half * 64; const float* sg = F.subln_g + half * 64;
#pragma unroll
        for (int c8 = 0; c8 < 8; ++c8) { const f32x4 g0 = *(const f32x4*)(sg + 8 * c8), g1 = *(const f32x4*)(sg + 8 * c8 + 4); const f32x4 x0 = v[2 * c8] * rs * g0, x1 = v[2 * c8 + 1] * rs * g1;
            v4u w; w.x = cvtpk(x0.x, x0.y); w.y = cvtpk(x0.z, x0.w); w.z = cvtpk(x1.x, x1.y); w.w = cvtpk(x1.z, x1.w); *(v4u*)(yp + 8 * c8) = w; }
    }
    __syncthreads();
}
__device__ __forceinline__ void win_unit(Frame& F, int b, int j32) {
    using namespace at2;
    const int wid = F.wave, lane = F.lane, r32 = lane & 31, hi = lane >> 5, h = wid, kv = h >> 2;
    const int t0 = 32 * j32, row0 = b * SEQ + t0;
    UnitArgs8 a; a.Q = (const unsigned char*)F.QB + (size_t)row0 * 512 + h * 64;
    a.K = (const unsigned char*)F.KB + (size_t)(b * KVLEN) * 128; a.VT = (const unsigned char*)F.XG + WIN_VT_OFF + (size_t)(b * 128) * KVLEN; a.comp = kv; a.ldk = 128; a.vdoff = kv * 4096; a.q0 = t0;
    { const int st = t0 - 128; int ks = st < 0 ? 0 : (st & ~63); if (ks > SEQ - 384) ks = SEQ - 384; a.ks = ks; }
    f32x16 o[2]; o[0] = f32x16{}; o[1] = f32x16{};
    float m; f32x16 ol = f32x16{};
    AT_LAS char* lds = (AT_LAS char*)F.lds;
    attn_tiles_f8<false>(a, lds, F.tid, wid, lane, o, ol, m);
    AT_LAS float* li_l = (AT_LAS float*)(lds + AT_WS3_OFF) + wid * 64;
    if (hi == 0) li_l[r32] = __builtin_amdgcn_exp2f(F.sink[h] * LOG2E - m);
    asm volatile("s_waitcnt lgkmcnt(0)" ::: "memory");
    float rli[16];
#pragma unroll
    for (int r = 0; r < 16; ++r) rli[r] = __builtin_amdgcn_rcpf(ol[r] + li_l[crow(r, hi)]);
    __syncthreads();
    AT_LAS float* XD = (AT_LAS float*)lds + wid * 32 * XROWW;
#pragma unroll
    for (int r = 0; r < 16; ++r)
#pragma unroll
        for (int d0 = 0; d0 < 2; ++d0) XD[crow(r, hi) * XROWW + d0 * 32 + r32] = o[d0][r] * rli[r];
    asm volatile("s_waitcnt lgkmcnt(0)" ::: "memory");
    const int row = lane >> 1, half = lane & 1;
    bf16* yp = F.Y + (size_t)(row0 + row) * DM + 512 + h * 64 + half * 32;
#pragma unroll
    for (int c8 = 0; c8 < 4; ++c8) { const f32x4 x0 = *(const AT_LAS f32x4*)(XD + row * XROWW + half * 32 + 8 * c8), x1 = *(const AT_LAS f32x4*)(XD + row * XROWW + half * 32 + 8 * c8 + 4);
        v4u w; w.x = cvtpk(x0.x, x0.y); w.y = cvtpk(x0.z, x0.w); w.z = cvtpk(x1.x, x1.y); w.w = cvtpk(x1.z, x1.w); *(v4u*)(yp + 8 * c8) = w; }
    __syncthreads();
}
__device__ __forceinline__ void p3_attention(Frame& F) {
    const float lam = lam_value(F);
#ifndef NO_DIFF
#pragma unroll 1
    for (int U = F.vcu * 2; U < BATCH * 4 * (SEQ / 128) * RP(F, 3); U += 2 * F.G)
#pragma unroll 1
        for (int i = 0; i < 2; ++i) { const int u = (U + i) % 512; diff_unit(F, u >> 8, (u >> 6) & 3, u & 63, lam); }
#endif
#ifndef NO_WIN
#pragma unroll 1
    for (int W = F.vcu * 2; W < BATCH * (SEQ / 32) * RP(F, 3); W += 2 * F.G)
#pragma unroll 1
        for (int i = 0; i < 2; ++i) { const int w = (W + i) % 512; win_unit(F, w >> 8, w & 255); }
#endif
}

__device__ __forceinline__ unsigned long long wave_max64(unsigned long long k) {
#pragma unroll
    for (int o = 1; o < 64; o <<= 1) { const unsigned lo = __shfl_xor((unsigned)k, o), hi = __shfl_xor((unsigned)(k >> 32), o); const unsigned long long t = ((unsigned long long)hi << 32) | lo; k = t > k ? t : k; }
    return k;
}
__device__ __forceinline__ void p5a_route(Frame& F) {
    const int npass = RP(F, 5);
    LAS float* WRT = (LAS float*)(F.lds + RING_OFF);
    LAS int* lcnt = (LAS int*)(F.lds + XTRA_OFF); LAS int* lbase = lcnt + 32; LAS int* le = lcnt + 64; LAS int* lrk = le + 256;
    for (int idx = F.tid; idx < 32768; idx += 512) { const int k = idx >> 5, e = idx & 31; WRT[e * 1024 + (k ^ ((e & 15) << 2))] = F.w_router[idx]; }
    gu32* gcnt = F.ctl + CW_CNT;
    typedef unsigned u32x2 __attribute__((ext_vector_type(2)));
    for (int cc = blockIdx.x; cc < (NTOK / 64) * npass; cc += F.G) { const int chunk = cc % (NTOK / 64); const bool dry = cc < (NTOK / 64) * (npass - 1);
        if (F.tid < 32) lcnt[F.tid] = 0;
        __syncthreads();
        const int b = (chunk * 64) >> 13; const float* mv = F.modv + b * 6144;
#pragma unroll 1
        for (int grp = 0; grp < 2; ++grp) {
            const int row0 = chunk * 64 + F.wave * 8 + grp * 4;
            f32x4 xv[4][4]; float ss[4];
#pragma unroll
            for (int r = 0; r < 4; ++r) { float s = 0.f;
#pragma unroll
                for (int j = 0; j < 4; ++j) { { const u32x2 t_ = *(const u32x2*)((const bf16*)F.X1 + (size_t)(row0 + r) * DM + 4 * F.lane + 256 * j); xv[r][j] = (f32x4){bflo(t_.x), bfhi(t_.x), bflo(t_.y), bfhi(t_.y)}; } s += (xv[r][j].x * xv[r][j].x + xv[r][j].y * xv[r][j].y) + (xv[r][j].z * xv[r][j].z + xv[r][j].w * xv[r][j].w); }
                ss[r] = 1.0f / sqrtf(wave_sum(s) * (1.f / DM) + NORM_EPS); }
#pragma unroll
            for (int j = 0; j < 4; ++j) { const int col = 4 * F.lane + 256 * j; const f32x4 g = *(const f32x4*)(F.norm2_g + col), sh = *(const f32x4*)(mv + 3072 + col), sc = *(const f32x4*)(mv + 4096 + col);
                const f32x4 ga = g * (sc + 1.0f);
#pragma unroll
                for (int r = 0; r < 4; ++r) { xv[r][j] = (xv[r][j] * ss[r]) * ga + sh;
                    *(unsigned*)((unsigned char*)F.XN + (size_t)(row0 + r) * DM + col) = pk4_fp8(xv[r][j].x, xv[r][j].y, xv[r][j].z, xv[r][j].w); } }
            float logit[4] = {0.f, 0.f, 0.f, 0.f};
            const bool up = (F.lane & 32) != 0, up2 = (F.lane & 16) != 0; const int myg = (F.lane >> 1) & 7;
#pragma unroll 1
            for (int g = 0; g < 8; ++g) {
                float a[4][4];
#pragma unroll
                for (int r = 0; r < 4; ++r)
#pragma unroll
                    for (int ee = 0; ee < 4; ++ee) a[r][ee] = 0.f;
                const LAS float* wg_ = WRT + g * 4096;
#pragma unroll
                for (int ee = 0; ee < 4; ++ee) { const LAS float* wb = wg_ + ee * 1024 + ((4 * F.lane) ^ (((g * 4 + ee) & 15) << 2));
#pragma unroll
                    for (int j = 0; j < 4; ++j) { const f32x4 w = *(const LAS f32x4*)(wb + 256 * j);
#pragma unroll
                        for (int r = 0; r < 4; ++r) a[r][ee] += (xv[r][j].x * w.x + xv[r][j].y * w.y) + (xv[r][j].z * w.z + xv[r][j].w * w.w); } }
#pragma unroll
                for (int r = 0; r < 4; ++r) {
                    const float v0 = (up ? a[r][2] : a[r][0]) + __shfl_xor(up ? a[r][0] : a[r][2], 32);
                    const float v1 = (up ? a[r][3] : a[r][1]) + __shfl_xor(up ? a[r][1] : a[r][3], 32);
                    float v = (up2 ? v1 : v0) + __shfl_xor(up2 ? v0 : v1, 16);
                    v += __shfl_xor(v, 1); v += __shfl_xor(v, 2); v += __shfl_xor(v, 4); v += __shfl_xor(v, 8);
                    if (myg == g) logit[r] = v;
                }
            }
            const int e = 4 * myg + (up ? 2 : 0) + (up2 ? 1 : 0);
            const float br = F.b_router[e];
#pragma unroll
            for (int r = 0; r < 4; ++r) {
                unsigned u = __float_as_uint(logit[r] + br); u = (u & 0x80000000u) ? ~u : (u | 0x80000000u);
                unsigned long long key = ((unsigned long long)u << 32) | (unsigned)(31 - e);
                int ek[4]; float vk[4];
#pragma unroll
                for (int k = 0; k < 4; ++k) { const unsigned long long mx = wave_max64(key); ek[k] = 31 - (int)(mx & 31u); unsigned uu = (unsigned)(mx >> 32); uu = (uu & 0x80000000u) ? (uu & 0x7fffffffu) : ~uu; vk[k] = __uint_as_float(uu);
                    if (e == ek[k]) key = 0ull; }
                const float p1 = __expf(vk[1] - vk[0]), p2 = __expf(vk[2] - vk[0]), p3 = __expf(vk[3] - vk[0]); const float inv = 1.0f / (1.0f + p1 + p2 + p3);
                if (F.lane < 4 && !dry) { const int k = F.lane; const int ee = k == 0 ? ek[0] : (k == 1 ? ek[1] : (k == 2 ? ek[2] : ek[3])); const float gg = (k == 0 ? 1.0f : (k == 1 ? p1 : (k == 2 ? p2 : p3))) * inv;
                    const int rl = F.wave * 8 + grp * 4 + r; const int rank = __hip_atomic_fetch_add(lcnt + ee, 1, __ATOMIC_RELAXED, __HIP_MEMORY_SCOPE_WORKGROUP);
                    le[rl * 4 + k] = ee; lrk[rl * 4 + k] = rank; F.rgate[(size_t)(row0 + r) * 4 + k] = gg; }
            }
        }
        __syncthreads();
        if (F.tid < 32 && !dry) lbase[F.tid] = (int)__hip_atomic_fetch_add(gcnt + F.tid, (unsigned)lcnt[F.tid], __ATOMIC_RELAXED, __HIP_MEMORY_SCOPE_AGENT);
        __syncthreads();
        if (F.tid < 256 && !dry) { const int row = chunk * 64 + (F.tid >> 2), k = F.tid & 3; const int ee = le[F.tid]; const int slot = lbase[ee] + lrk[F.tid]; F.re[(size_t)row * 4 + k] = ee; F.rslot[(size_t)row * 4 + k] = slot; F.elist[ee * NTOK + slot] = row; }
        __syncthreads();
    }
}
__device__ __forceinline__ int expert_tables(Frame& F, LAS int* pst, LAS int* pexp) {
    LAS int* npan = pst + 40; LAS int* cntT = pexp + 320;
    if (F.tid < 64) {
        const int e = F.lane & 31; const int cnt = (int)__hip_atomic_load(F.ctl + CW_CNT + e, __ATOMIC_RELAXED, __HIP_MEMORY_SCOPE_AGENT);
        const int np = (cnt + 255) >> 8; int incl = np;
#pragma unroll
        for (int o = 1; o < 32; o <<= 1) { const int t = __shfl_up(incl, o, 32); if (e >= o) incl += t; }
        if (F.lane < 32) { const int st = incl - np; cntT[e] = cnt; pst[e] = st * 256; for (int i = 0; i < np; ++i) pexp[st + i] = e; if (e == 31) { pst[32] = incl * 256; npan[0] = incl; } } }
    __syncthreads();
    return npan[0];
}
__device__ __forceinline__ void p5b_scatter(Frame& F) {
    LAS int* pst = (LAS int*)(F.lds + XTRA_OFF); LAS int* pexp = pst + 64;
    (void)expert_tables(F, pst, pexp);
    const int gw = F.vcu * NWAVES + F.wave, NGW = F.G * NWAVES;
    for (int rr = gw; rr < NTOK * RP(F, 6); rr += NGW) { const int row = rr % NTOK;
        const v4u a = *(const v4u*)(F.XN + (size_t)row * DM + 8 * F.lane), b = *(const v4u*)(F.XN + (size_t)row * DM + 512 + 8 * F.lane);
#pragma unroll
        for (int k = 0; k < 4; ++k) { const int e = F.re[(size_t)row * 4 + k]; const int pos = pst[e] + F.rslot[(size_t)row * 4 + k];
            if (F.lane == 0) F.rpos[(size_t)row * 4 + k] = pos;
            *(v4u*)(F.XG + (size_t)pos * DM + 8 * F.lane) = a; *(v4u*)(F.XG + (size_t)pos * DM + 512 + 8 * F.lane) = b; }
    }
}
__device__ __forceinline__ void p8_final(Frame& F) {
    LAS int* pst = (LAS int*)(F.lds + XTRA_OFF); LAS int* pexp = pst + 64;
    (void)expert_tables(F, pst, pexp);
    const int gw = F.vcu * NWAVES + F.wave, NGW = F.G * NWAVES;
    typedef unsigned u32x2 __attribute__((ext_vector_type(2)));
    for (int pp = gw; pp < (NTOK / 2) * RP(F, 9); pp += NGW) { const int row0 = (pp % (NTOK / 2)) * 2;
        const float* g2 = F.modv + (row0 >> 13) * 6144 + 5120;
        int pos[2][4]; float gt[2][4];
#pragma unroll
        for (int q = 0; q < 2; ++q)
#pragma unroll
            for (int k = 0; k < 4; ++k) { const size_t ix = (size_t)(row0 + q) * 4 + k; pos[q][k] = pst[F.re[ix]] + F.rslot[ix]; gt[q][k] = F.rgate[ix]; }
        f32x4 xv[2][4]; unsigned yv[2][4][4];
#pragma unroll
        for (int q = 0; q < 2; ++q)
#pragma unroll
            for (int j = 0; j < 4; ++j) { const int col = 4 * F.lane + 256 * j; { const u32x2 t_ = *(const u32x2*)((const bf16*)F.X1 + (size_t)(row0 + q) * DM + col); xv[q][j] = (f32x4){bflo(t_.x), bfhi(t_.x), bflo(t_.y), bfhi(t_.y)}; }
#pragma unroll
                for (int k = 0; k < 4; ++k) yv[q][j][k] = *(const unsigned*)((const unsigned char*)F.Y2 + (size_t)pos[q][k] * DM + col); }
#pragma unroll
        for (int q = 0; q < 2; ++q) { float s = 0.f;
#pragma unroll
            for (int j = 0; j < 4; ++j) { const int col = 4 * F.lane + 256 * j; f32x4 a = {0.f, 0.f, 0.f, 0.f};
#pragma unroll
                for (int k = 0; k < 4; ++k) { const unsigned y = yv[q][j][k]; const auto lo2 = __builtin_amdgcn_cvt_pk_f32_fp8((int)y, false), hi2 = __builtin_amdgcn_cvt_pk_f32_fp8((int)y, true); a += (f32x4){lo2[0], lo2[1], hi2[0], hi2[1]} * gt[q][k]; }
                xv[q][j] = xv[q][j] + *(const f32x4*)(g2 + col) * a;
                s += (xv[q][j].x * xv[q][j].x + xv[q][j].y * xv[q][j].y) + (xv[q][j].z * xv[q][j].z + xv[q][j].w * xv[q][j].w); }
            const float rstd = 1.0f / sqrtf(wave_sum(s) * (1.f / DM) + NORM_EPS);
#pragma unroll
            for (int j = 0; j < 4; ++j) { const int col = 4 * F.lane + 256 * j; __builtin_nontemporal_store(xv[q][j] * rstd * *(const f32x4*)(F.final_g + col), (f32x4*)(F.out + (size_t)(row0 + q) * DM + col)); } }
    }
}

#ifndef FAST_GEMM
#define FAST_GEMM 1
#endif
#ifndef FAST_ATTN
#define FAST_ATTN 1
#endif
constexpr int N_PHASES = 10;
struct Args { const float* in[23]; float* out; unsigned char* ws; int ph_lo, ph_hi, use_bar, pad; };
__global__ void __launch_bounds__(NWAVES * 64, 2) mk_fwd(Args args) {
    extern __shared__ __attribute__((aligned(16))) unsigned char lds[];
    Frame F;
    F.lds = (LAS unsigned char*)lds; F.MISC = (volatile LAS unsigned*)(F.lds + MISC_OFF);
    F.tid = threadIdx.x; F.lane = F.tid & 63; F.wave = __builtin_amdgcn_readfirstlane(F.tid >> 6);
    F.probe = args.pad; F.G = gridDim.x; { const int bx = blockIdx.x; F.vcu = (F.G % 8 == 0) ? (bx % 8) * (F.G / 8) + bx / 8 : bx; }
    unsigned char* ws = args.ws;
    F.ctl = (gu32*)(ws + WS_CTL);
    F.x = args.in[0]; F.c = args.in[1]; F.ctx = args.in[2]; F.c_ctx = args.in[3]; F.w_mod = args.in[4]; F.b_mod = args.in[5]; F.norm1_g = args.in[6]; F.w_in = args.in[7];
    F.lq1 = args.in[8]; F.lk1 = args.in[9]; F.lq2 = args.in[10]; F.lk2 = args.in[11]; F.subln_g = args.in[12]; F.sink = args.in[13]; F.w_out = args.in[14]; F.norm2_g = args.in[15];
    F.w_router = args.in[16]; F.b_router = args.in[17]; F.w_gu = args.in[18]; F.b_gu = args.in[19]; F.w_dn = args.in[20]; F.b_dn = args.in[21]; F.final_g = args.in[22];
    F.out = args.out;
    F.modp = (float*)(ws + WS_MODP); F.modv = (float*)(ws + WS_MODV); F.rope = (float*)(ws + WS_ROPE); F.X1 = (float*)(ws + WS_X1);
    F.elist = (int*)(ws + WS_ELIST); F.re = (int*)(ws + WS_ROUTE); F.rslot = F.re + NTOK * 4; F.rgate = (float*)(F.rslot + NTOK * 4); F.rpos = (int*)(F.rgate + NTOK * 4);
    F.Win_t = (bf16*)(ws + WS_WIN); F.Wout_t = (bf16*)(ws + WS_WOUT); F.Wgu_t = (bf16*)(ws + WS_WGU); F.Wdn_t = (bf16*)(ws + WS_WDN);
    F.XN = (bf16*)(ws + WS_XN); F.QA = (bf16*)(ws + WS_QA); F.KA = (bf16*)(ws + WS_KA); F.VA = (bf16*)(ws + WS_VA); F.QB = (bf16*)(ws + WS_QB); F.KB = (bf16*)(ws + WS_KB); F.VB = (bf16*)(ws + WS_VB);
    F.Y = (bf16*)(ws + WS_Y); F.XG = (bf16*)(ws + WS_XG); F.H = (bf16*)(ws + WS_H); F.Y2 = (bf16*)(ws + WS_Y2);
    for (int u = F.tid; u < (LDS_BYTES - LDSCTL_OFF) / 4; u += NWAVES * 64) ((LAS unsigned*)(F.lds + LDSCTL_OFF))[u] = 0u;
    __syncthreads();
#ifdef SPIN_SEAM
#define STAMP(k) do { if ((k) == SPIN_SEAM && blockIdx.x == 0 && F.tid == 0) *(volatile LAS unsigned long long*)(F.lds + XTRA_OFF + 15008) = wall_clock64(); } while (0)
    if (blockIdx.x == 0 && F.tid == 0) { const unsigned long long t_ = wall_clock64(); *(volatile LAS unsigned long long*)(F.lds + XTRA_OFF + 15000) = t_; *(volatile LAS unsigned long long*)(F.lds + XTRA_OFF + 15008) = t_; }
#else
#define STAMP(k) do {} while (0)
#endif
    XcdBarrier bar; bar.bar = (unsigned*)(F.ctl + CW_BAR); bar.x = 0; bar.st = nullptr;
    if (args.use_bar) bar = xcd_barrier_post((unsigned*)(F.ctl + CW_BAR), F.MISC + 8);
    const int lo = args.ph_lo, hi = args.ph_hi;
#ifndef PH_MASK
#define PH_MASK 0x3ff
#endif
#define IN(k) (((PH_MASK >> (k)) & 1) && lo <= (k) && (k) < hi)
#ifndef REP_MASK
#define REP_MASK 0
#endif
#define SEAM(k) do { if (IN(k) && IN((k) + 1)) { if (args.use_bar) { xcd_barrier(bar); if (args.pad & 0x10000) { xcd_barrier(bar); xcd_barrier(bar); } } } else { __syncthreads(); } } while (0)

    if (IN(0)) { p0_prologue(F); } SEAM(0); STAMP(0);
    if (IN(1)) { p1_norm(F); } SEAM(1); STAMP(1);
    if (IN(2)) {
        EpiQKV E{F.QA, F.KA, F.VA, F.QB, F.KB, F.VB, F.rope};
#if FAST_GEMM
        pg8::Gemm g{F.XN, F.Win_t, NROW, INC, DM}; RepOrder S; S.init(NROW, INC, F.G, (int)blockIdx.x); S.rep = RP(F, 2);
        EpiQKVFast EA{F.QA, F.KA, F.VA, F.QB, F.KB, F.VB, F.rope};
        pg8::gemm_phase<EpiQKVFast, RepOrder, true, true>(F.lds + RING_OFF, g, S, EA);
        if (F.G == 256 && blockIdx.x >= 82) p0_tail(F);
#else
        naive_gemm(F, F.XN, NROW / 128, INC, DM, DenseSel{F.Win_t}, E);
#endif
    } SEAM(2); STAMP(2);
#if FAST_ATTN == 1
    if (IN(3)) { p3_vt_pass(F); if (args.use_bar) xcd_barrier(bar); else __syncthreads(); STAMP(10); p3_attention(F); } SEAM(3); STAMP(3);
#else
    if (IN(3)) { naive_diff_attn(F); __syncthreads(); naive_win_attn(F); } SEAM(3); STAMP(3);
#endif
    if (IN(4)) {
        EpiOut E{F.x, F.modv, F.X1};
#if FAST_GEMM
        pg8::Gemm g{F.Y, F.Wout_t, NTOK, DM, DM}; RepOrder S; S.init(NTOK, DM, F.G, (int)blockIdx.x); S.rep = RP(F, 4);
        EpiAdapt<EpiOut, 0> EA{E};
        pg8::gemm_phase<EpiAdapt<EpiOut, 0>, RepOrder, true, true>(F.lds + RING_OFF, g, S, EA);
#else
        naive_gemm(F, F.Y, NTOK / 128, DM, DM, DenseSel{F.Wout_t}, E);
#endif
    } SEAM(4); STAMP(4);
    if (IN(5)) { p5a_route(F); } SEAM(5); STAMP(5);
    if (IN(7)) {
        LAS int* pst = (LAS int*)(F.lds + XTRA_OFF); LAS int* pexp = pst + 64; LAS int* cntT = pexp + 320; LAS int* tokT = (LAS int*)(F.lds + XTRA_OFF + 2048);
        const int NP = expert_tables(F, pst, pexp);
        EpiGU E{(unsigned char*)F.H, F.b_gu};
        GroupedOrder S{GUW / 256, NP, F.G, (int)blockIdx.x, pexp, RP(F, 7), tokT};
        { const int R = S.rounds();
          for (int i0 = 0; i0 < R; i0 += 2) { const int i = i0 + (F.tid >> 8), r = F.tid & 255; pg8::Unit u; GroupedOrder S1 = S; S1.rep = 1;
              if (i < R && S1.next(i, u)) { const int e = pexp[u.pm], sl = u.pm * 256 - pst[e] + r; tokT[i * 256 + r] = sl < cntT[e] ? F.elist[e * NTOK + sl] : 0; } }
          __syncthreads(); }
#if FAST_GEMM
        pg8::Gemm g{F.XN, F.Wgu_t, NP * 256, GUW, DM / 2};
        EpiAdapt<EpiGU, GUW / 256> EA{E};
        pg8::gemm_phase<EpiAdapt<EpiGU, GUW / 256>, GroupedOrder, true, true, true, true>(F.lds + RING_OFF, g, S, EA);
#else
#error "the naive GEMM path has no gather"
#endif
    } SEAM(7); STAMP(7);
    if (IN(8)) {
        LAS int* pst = (LAS int*)(F.lds + XTRA_OFF); LAS int* pexp = pst + 64;
        const int NP = expert_tables(F, pst, pexp);
        EpiDN E{F.Y2, F.b_dn};
#if FAST_GEMM
        pg8::Gemm g{F.H, F.Wdn_t, NP * 256, DM, DM / 2}; GroupedOrder S{DM / 256, NP, F.G, (int)blockIdx.x, pexp, RP(F, 8), nullptr};
        EpiAdaptP<EpiDN, DM / 256> EA{E};
        pg8::gemm_phase<EpiAdaptP<EpiDN, DM / 256>, GroupedOrder, true, true, false, true>(F.lds + RING_OFF, g, S, EA);
#else
        naive_gemm(F, F.H, NP * 2, DM, DM, GroupSel{F.Wdn_t, pexp, DM, DM}, E);
#endif
    } SEAM(8); STAMP(8);
    if (IN(9)) { p8_final(F); }
#ifdef SPIN_SEAM
    if (blockIdx.x == 0 && F.tid == 0) { const unsigned long long t0_ = *(volatile LAS unsigned long long*)(F.lds + XTRA_OFF + 15000), tk_ = *(volatile LAS unsigned long long*)(F.lds + XTRA_OFF + 15008);
        const unsigned long long te_ = wall_clock64(); while (wall_clock64() - te_ < tk_ - t0_) __builtin_amdgcn_s_sleep(8); }
#endif
#undef STAMP
#undef IN
#undef SEAM
}

#ifndef N_LAUNCH_MODE
#define N_LAUNCH_MODE 0
#endif
extern "C" void kernel_launch(void* const* d_in, const int* in_sizes, int n_in, void* d_out, int out_size, void* d_ws, size_t ws_size, hipStream_t stream) {
    static int grid = 0;
    if (grid == 0) {
        if (n_in != 23 || in_sizes[0] != NTOK * DM || out_size != NTOK * DM || ws_size < WS_END) { fprintf(stderr, "kernel_launch: unexpected shapes (n_in %d, in0 %d, out %d, ws %zu); nothing launched\n", n_in, n_in > 0 ? in_sizes[0] : -1, out_size, ws_size); grid = -1; return; }
        int dev = 0, cus = 0, per_cu = 0;
        if (hipGetDevice(&dev) != hipSuccess || hipDeviceGetAttribute(&cus, hipDeviceAttributeMultiprocessorCount, dev) != hipSuccess) { grid = -1; return; }
        if (hipFuncSetAttribute((const void*)mk_fwd, hipFuncAttributeMaxDynamicSharedMemorySize, LDS_BYTES) != hipSuccess) { fprintf(stderr, "kernel_launch: hipFuncSetAttribute failed\n"); grid = -1; return; }
        if (hipOccupancyMaxActiveBlocksPerMultiprocessor(&per_cu, (const void*)mk_fwd, NWAVES * 64, LDS_BYTES) != hipSuccess || per_cu < 1) fprintf(stderr, "kernel_launch: note: occupancy query reports %d\n", per_cu);
        (void)hipGetLastError();
        grid = cus;
    }
    if (grid < 0) return;
    if (hipMemsetAsync((char*)d_ws + WS_CTL, 0, CTL_ZERO_BYTES, stream) != hipSuccess) { fprintf(stderr, "kernel_launch: memset failed\n"); return; }
    Args a{};
    for (int i = 0; i < 23; ++i) a.in[i] = (const float*)d_in[i];
    a.out = (float*)d_out; a.ws = (unsigned char*)d_ws; a.pad = REP_MASK;
#if N_LAUNCH_MODE == 0
    a.ph_lo = 0; a.ph_hi = N_PHASES; a.use_bar = 1;
    hipLaunchKernelGGL(mk_fwd, dim3(grid), dim3(NWAVES * 64), LDS_BYTES, stream, a);
#else
    for (int p = 0; p < N_PHASES; ++p) { a.ph_lo = p; a.ph_hi = p + 1; a.use_bar = 0; hipLaunchKernelGGL(mk_fwd, dim3(grid), dim3(NWAVES * 64), LDS_BYTES, stream, a); }
#endif
}
```

```cpp
#include <hip/hip_runtime.h>
#include <cstdio>
#include <cstdint>
namespace pg8 {
#define PG8_LAS __attribute__((address_space(3)))
typedef unsigned short bf16_t;
typedef short bf16x8 __attribute__((ext_vector_type(8)));
typedef float f32x4 __attribute__((ext_vector_type(4)));
typedef unsigned u32x4 __attribute__((ext_vector_type(4)));
constexpr int BM = 256, BK = 64, HALF = 128, HTB = HALF * BK * 2  , STAGE_BYTES = 8 * HTB, NXCD = 8, WGM = 8;

__host__ __device__ __forceinline__ int lds_byte(int r, int c) { const int st = (r >> 4) * 2 + (c >> 5), rr = r & 15, cc = c & 31, ob = rr * 64 + cc * 2; return st * 1024 + (ob ^ (((ob >> 9) & 1) << 5)); }
__host__ __device__ __forceinline__ void stage_rc(int b, int& R, int& C) { const int st = b / 1024, sb = b % 1024, swz = sb ^ (((sb >> 9) & 1) << 5); R = (st >> 1) * 16 + swz / 64; C = (st & 1) * 32 + (swz % 64) / 2; }
__host__ __device__ __forceinline__ int perm32(int rho) { const int n = rho >> 4, i = rho & 15; return 8 * (i >> 2) + 4 * n + (i & 3); }

struct Unit { int pm, pn; };
struct Gemm { const bf16_t* A; const bf16_t* Bt; int M, N, K; };

struct StaticOrder {
    int nM, nN, nwg, G, c;
    __host__ __device__ void init(int M, int N, int G_, int c_) { nM = M / BM; nN = N / BM; nwg = nM * nN; G = G_; c = c_; }
    __host__ __device__ bool next(int i, Unit& u) const {
        const long L = (long)i * G + c; if (L >= nwg) return false;
        int wgid = (int)L; { const int q = nwg / NXCD, r = nwg % NXCD, xcd = wgid % NXCD, off = wgid / NXCD; wgid = (xcd < r ? xcd * (q + 1) : r * (q + 1) + (xcd - r) * q) + off; }
        const int nig = WGM * nN, gid = wgid / nig, fm = gid * WGM, gsz = (nM - fm) < WGM ? (nM - fm) : WGM;
        u.pm = fm + ((wgid % nig) % gsz); u.pn = (wgid % nig) / gsz; return true;
    }
    __device__ __forceinline__ void a_ready(const Unit&) const {}
    __device__ __forceinline__ void done(const Unit&) const {}
};

__device__ __forceinline__ unsigned cvt_pk_bf16(float lo, float hi) { unsigned r; asm volatile("v_cvt_pk_bf16_f32 %0, %1, %2" : "=v"(r) : "v"(lo), "v"(hi)); return r; }
typedef float f32x2 __attribute__((ext_vector_type(2)));
typedef int i32x4 __attribute__((ext_vector_type(4))); typedef int i32x8 __attribute__((ext_vector_type(8)));
__device__ __forceinline__ i32x8 cat8(bf16x8 a, bf16x8 b) { const i32x4 x = __builtin_bit_cast(i32x4, a), y = __builtin_bit_cast(i32x4, b); return __builtin_shufflevector(x, y, 0, 1, 2, 3, 4, 5, 6, 7); }
template <class Epi, class Sched, bool ALIGN_EPI = false, bool SP2 = false, bool GATHER = false, bool FP8 = false>
__device__ __forceinline__ void gemm_phase(PG8_LAS unsigned char* lds, const Gemm g, const Sched& S, const Epi& E) {
    const int tid = threadIdx.x, wid = __builtin_amdgcn_readfirstlane(tid >> 6), lane = tid & 63, wr = wid >> 2, wc = wid & 3, fr = lane & 15, fq = lane >> 4;
    const int K = g.K, nt = K / BK;
    unsigned voffA[2], voffB[2]; int RA[2]; unsigned CA2[2];
#pragma unroll
    for (int i = 0; i < 2; ++i) { int R, C; stage_rc(tid * 16 + i * 8192, R, C); const int Rb = Epi::PERM ? ((R & ~31) + perm32(R & 31)) : R;
        voffA[i] = (unsigned)(R * K + C) * 2u; voffB[i] = (unsigned)(Rb * K + C) * 2u; RA[i] = R; CA2[i] = (unsigned)C * 2u; }
    static_assert(!GATHER || SP2, "GATHER is wired into the SP2 loop only");
    unsigned gA[2][2], gN[2][2];
    const size_t kstep = (size_t)(BK * 2);
    const size_t hstep = (size_t)HALF * K * 2;
    const size_t tstep = 2 * hstep;
    const unsigned ldsw = (unsigned)wid * 1024u;
    const int aoff = lds_byte(wr * 64 + fr, fq * 8), boff = lds_byte(wc * 32 + fr, fq * 8);
#define PG8_SA(b, h) (((b) * 2 + (h)) * HTB)
#define PG8_SB(b, h) ((4 + (b) * 2 + (h)) * HTB)
#define PG8_STAGE(bufoff, gbase, voff) do { _Pragma("unroll") for (int _i = 0; _i < 2; ++_i) \
        __builtin_amdgcn_global_load_lds((const unsigned*)((const char*)(gbase) + (voff)[_i]), (PG8_LAS unsigned*)(lds + (bufoff) + ldsw + _i * 8192), 16, 0, 0); } while (0)
#define PG8_STAGEG(bufoff, kbytes, v0, v1) do { \
        __builtin_amdgcn_global_load_lds((const unsigned*)((const char*)g.A + (kbytes) + (v0)), (PG8_LAS unsigned*)(lds + (bufoff) + ldsw), 16, 0, 0); \
        __builtin_amdgcn_global_load_lds((const unsigned*)((const char*)g.A + (kbytes) + (v1)), (PG8_LAS unsigned*)(lds + (bufoff) + ldsw + 8192), 16, 0, 0); } while (0)
#define PG8_GOFF(dst, ui_) do { _Pragma("unroll") for (int h_ = 0; h_ < 2; ++h_) _Pragma("unroll") for (int i_ = 0; i_ < 2; ++i_) dst[h_][i_] = (unsigned)S.tok((ui_), h_ * HALF + RA[i_]) * (unsigned)(K * 2) + CA2[i_]; } while (0)
#define PG8_LDA(dst, b, h) do { _Pragma("unroll") for (int m = 0; m < 4; ++m) _Pragma("unroll") for (int k = 0; k < 2; ++k) dst[m][k] = *(const PG8_LAS bf16x8*)(lds + PG8_SA(b, h) + aoff + m * 2048 + k * 1024); } while (0)
#define PG8_LDB(dst, b, h) do { _Pragma("unroll") for (int n = 0; n < 2; ++n) _Pragma("unroll") for (int k = 0; k < 2; ++k) dst[n][k] = *(const PG8_LAS bf16x8*)(lds + PG8_SB(b, h) + boff + n * 2048 + k * 1024); } while (0)
#define PG8_MMA(ai, bj, At, Bt) do { __builtin_amdgcn_s_setprio(1); _Pragma("unroll") for (int m = 0; m < 4; ++m) _Pragma("unroll") for (int n = 0; n < 2; ++n) { \
        if constexpr (FP8) { const i32x8 a8_ = cat8(Bt[n][0], Bt[n][1]), b8_ = cat8(At[m][0], At[m][1]); \
            asm volatile("v_mfma_scale_f32_16x16x128_f8f6f4 %0, %1, %2, %0, %3, %4 op_sel_hi:[0,0,0]" : "+v"(acc[ai][bj][m][n]) : "v"(a8_), "v"(b8_), "v"(sc_w8), "v"(sc_a8)); } \
        else { _Pragma("unroll") for (int k = 0; k < 2; ++k) acc[ai][bj][m][n] = __builtin_amdgcn_mfma_f32_16x16x32_bf16(Bt[n][k], At[m][k], acc[ai][bj][m][n], 0, 0, 0); } } \
        __builtin_amdgcn_s_setprio(0); } while (0)
#define PG8_WAIT_V(n) asm volatile("s_waitcnt vmcnt(" #n ")" ::: "memory")
#define PG8_WAIT_L(n) asm volatile("s_waitcnt lgkmcnt(" #n ")" ::: "memory")
#define PG8_BAR __builtin_amdgcn_s_barrier()
#define PG8_SCHED __builtin_amdgcn_sched_barrier(0)
    int sc_w8 = 0x7A7A7A7A, sc_a8 = 0x7F7F7F7F;
    asm volatile("" : "+v"(sc_w8), "+v"(sc_a8));
    Unit cur, nxt; int ui = 0;
    if (!S.next(0, cur)) return;
    f32x4 acc[2][2][4][2];
#pragma unroll
    for (int a = 0; a < 2; ++a)
#pragma unroll
        for (int b = 0; b < 2; ++b)
#pragma unroll
            for (int m = 0; m < 4; ++m)
#pragma unroll
                for (int n = 0; n < 2; ++n) acc[a][b][m][n] = (f32x4){0.f, 0.f, 0.f, 0.f};
    bf16x8 At[4][2], B0[2][2], B1[2][2];
    const char* cA = (const char*)g.A + (size_t)cur.pm * tstep; const char* cB = (const char*)g.Bt + (size_t)cur.pn * tstep;
    S.a_ready(cur);
    if constexpr (SP2) {
        if constexpr (GATHER) { PG8_GOFF(gA, 0); }
        PG8_STAGE(PG8_SB(0, 0), cB, voffB); PG8_STAGE(PG8_SB(0, 1), cB + hstep, voffB);
        if constexpr (GATHER) { PG8_STAGEG(PG8_SA(0, 0), 0, gA[0][0], gA[0][1]); PG8_STAGEG(PG8_SA(0, 1), 0, gA[1][0], gA[1][1]); } else { PG8_STAGE(PG8_SA(0, 0), cA, voffA); PG8_STAGE(PG8_SA(0, 1), cA + hstep, voffA); }
        if (wr == 1) PG8_BAR;
        PG8_WAIT_V(2); PG8_BAR;
        PG8_STAGE(PG8_SB(1, 0), cB + kstep, voffB); if constexpr (GATHER) { PG8_STAGEG(PG8_SA(1, 0), kstep, gA[0][0], gA[0][1]); } else { PG8_STAGE(PG8_SA(1, 0), cA + kstep, voffA); } PG8_STAGE(PG8_SB(1, 1), cB + hstep + kstep, voffB);
        PG8_WAIT_V(6); PG8_BAR;
    } else {
        PG8_STAGE(PG8_SB(0, 0), cB, voffB); PG8_STAGE(PG8_SA(0, 0), cA, voffA); PG8_STAGE(PG8_SB(0, 1), cB + hstep, voffB); PG8_STAGE(PG8_SA(0, 1), cA + hstep, voffA);
        if (wr == 1) PG8_BAR;
        PG8_WAIT_V(4); PG8_BAR;
        PG8_STAGE(PG8_SB(1, 0), cB + kstep, voffB); PG8_STAGE(PG8_SA(1, 0), cA + kstep, voffA); PG8_STAGE(PG8_SB(1, 1), cB + hstep + kstep, voffB);
        PG8_WAIT_V(6); PG8_BAR;
    }
    for (;;) {
        const bool has_next = S.next(ui + 1, nxt);
        const char* nA = has_next ? (const char*)g.A + (size_t)nxt.pm * tstep : cA; const char* nB = has_next ? (const char*)g.Bt + (size_t)nxt.pn * tstep : cB;
        if constexpr (GATHER) { if (has_next) { PG8_GOFF(gN, ui + 1); } else { _Pragma("unroll") for (int h_ = 0; h_ < 2; ++h_) _Pragma("unroll") for (int i_ = 0; i_ < 2; ++i_) gN[h_][i_] = gA[h_][i_]; } }
#pragma unroll 1
        for (int t = 0; t < nt; t += 2) {
            const bool last = (t == nt - 2);
            const char* a1 = cA + (size_t)(t + 1) * kstep;
            const char* a2 = last ? nA : cA + (size_t)(t + 2) * kstep; const char* b2 = last ? nB : cB + (size_t)(t + 2) * kstep;
            const char* a3 = a2 + kstep; const char* b3 = b2 + kstep;
            if (last && has_next) S.a_ready(nxt);
            if constexpr (SP2) {
            const size_t k1_ = (size_t)(t + 1) * kstep, k2_ = last ? (size_t)0 : (size_t)(t + 2) * kstep;
            const unsigned s00_ = last ? gN[0][0] : gA[0][0], s01_ = last ? gN[0][1] : gA[0][1], s10_ = last ? gN[1][0] : gA[1][0], s11_ = last ? gN[1][1] : gA[1][1];
            PG8_LDB(B0, 0, 0); PG8_LDB(B1, 0, 1); PG8_SCHED; PG8_LDA(At, 0, 0); if constexpr (GATHER) { PG8_STAGEG(PG8_SA(1, 1), k1_, gA[1][0], gA[1][1]); } else { PG8_STAGE(PG8_SA(1, 1), a1 + hstep, voffA); }
            PG8_WAIT_V(8); PG8_WAIT_L(0); PG8_BAR; PG8_MMA(0, 0, At, B0); PG8_MMA(0, 1, At, B1); PG8_BAR; PG8_SCHED;
            PG8_LDA(At, 0, 1); PG8_STAGE(PG8_SB(0, 0), b2, voffB); PG8_STAGE(PG8_SB(0, 1), b2 + hstep, voffB); if constexpr (GATHER) { PG8_STAGEG(PG8_SA(0, 0), k2_, s00_, s01_); } else { PG8_STAGE(PG8_SA(0, 0), a2, voffA); }
            PG8_WAIT_V(8); PG8_WAIT_L(0); PG8_BAR; PG8_MMA(1, 0, At, B0); PG8_MMA(1, 1, At, B1); PG8_BAR; PG8_SCHED;
            PG8_LDB(B0, 1, 0); PG8_LDB(B1, 1, 1); PG8_SCHED; PG8_LDA(At, 1, 0); if constexpr (GATHER) { PG8_STAGEG(PG8_SA(0, 1), k2_, s10_, s11_); } else { PG8_STAGE(PG8_SA(0, 1), a2 + hstep, voffA); }
            PG8_WAIT_V(8); PG8_WAIT_L(0); PG8_BAR; PG8_MMA(0, 0, At, B0); PG8_MMA(0, 1, At, B1); PG8_BAR; PG8_SCHED;
            PG8_LDA(At, 1, 1); PG8_STAGE(PG8_SB(1, 0), b3, voffB); PG8_STAGE(PG8_SB(1, 1), b3 + hstep, voffB); if constexpr (GATHER) { PG8_STAGEG(PG8_SA(1, 0), k2_ + kstep, s00_, s01_); } else { PG8_STAGE(PG8_SA(1, 0), a3, voffA); }
            PG8_WAIT_V(8); PG8_WAIT_L(0); PG8_BAR; PG8_MMA(1, 0, At, B0); PG8_MMA(1, 1, At, B1); PG8_BAR; PG8_SCHED;
            } else {
            PG8_LDB(B0, 0, 0); PG8_SCHED; PG8_LDA(At, 0, 0); PG8_STAGE(PG8_SA(1, 1), a1 + hstep, voffA);
            PG8_WAIT_L(8); PG8_BAR; PG8_WAIT_L(0); PG8_MMA(0, 0, At, B0); PG8_BAR; PG8_SCHED;
            PG8_LDB(B1, 0, 1); PG8_STAGE(PG8_SB(0, 0), b2, voffB);
            PG8_BAR; PG8_WAIT_L(0); PG8_MMA(0, 1, At, B1); PG8_BAR;
            PG8_LDA(At, 0, 1); PG8_STAGE(PG8_SA(0, 0), a2, voffA);
            PG8_BAR; PG8_WAIT_L(0); PG8_MMA(1, 0, At, B0); PG8_BAR; PG8_SCHED;
            PG8_STAGE(PG8_SB(0, 1), b2 + hstep, voffB);
            PG8_WAIT_V(6); PG8_BAR; PG8_MMA(1, 1, At, B1); PG8_BAR;
            PG8_LDB(B0, 1, 0); PG8_SCHED; PG8_LDA(At, 1, 0); PG8_STAGE(PG8_SA(0, 1), a2 + hstep, voffA);
            PG8_WAIT_L(8); PG8_BAR; PG8_WAIT_L(0); PG8_MMA(0, 0, At, B0); PG8_BAR; PG8_SCHED;
            PG8_LDB(B1, 1, 1); PG8_STAGE(PG8_SB(1, 0), b3, voffB);
            PG8_BAR; PG8_WAIT_L(0); PG8_MMA(0, 1, At, B1); PG8_BAR;
            PG8_LDA(At, 1, 1); PG8_STAGE(PG8_SA(1, 0), a3, voffA);
            PG8_BAR; PG8_WAIT_L(0); PG8_MMA(1, 0, At, B0); PG8_BAR; PG8_SCHED;
            PG8_STAGE(PG8_SB(1, 1), b3 + hstep, voffB);
            PG8_WAIT_V(6); PG8_BAR; PG8_MMA(1, 1, At, B1); PG8_BAR;
            }
        }
        if constexpr (FP8) { asm volatile("s_nop 15\n\ts_nop 15" ::: "memory"); }
        if constexpr (ALIGN_EPI) { if (wr == 0) PG8_BAR; }
        if constexpr (!Epi::AFTER_DRAIN) { E(acc, cur, wr, wc, fr, fq); S.done(cur); }
        if (!has_next) break;
#pragma unroll
        for (int a = 0; a < 2; ++a)
#pragma unroll
            for (int b = 0; b < 2; ++b)
#pragma unroll
                for (int m = 0; m < 4; ++m)
#pragma unroll
                    for (int n = 0; n < 2; ++n) acc[a][b][m][n] = (f32x4){0.f, 0.f, 0.f, 0.f};
        cur = nxt; cA = nA; cB = nB; ++ui;
        if constexpr (GATHER) { _Pragma("unroll") for (int h_ = 0; h_ < 2; ++h_) _Pragma("unroll") for (int i_ = 0; i_ < 2; ++i_) gA[h_][i_] = gN[h_][i_]; }
        if constexpr (ALIGN_EPI) { if (wr == 1) PG8_BAR; }
    }
    PG8_WAIT_V(0);
    if constexpr (!ALIGN_EPI) { if (wr == 0) PG8_BAR; }
    PG8_BAR;
    if constexpr (Epi::AFTER_DRAIN) { E.fused(acc, cur, wr, wc, fr, fq, lds, wid, lane); S.done(cur); }
#undef PG8_SA
#undef PG8_SB
#undef PG8_STAGE
#undef PG8_STAGEG
#undef PG8_GOFF
#undef PG8_LDA
#undef PG8_LDB
#undef PG8_MMA
#undef PG8_WAIT_V
#undef PG8_WAIT_L
#undef PG8_BAR
#undef PG8_SCHED
}
}
#define GAS __attribute__((address_space(1)))
#define LAS __attribute__((address_space(3)))
typedef unsigned short bf16;
typedef unsigned v4u __attribute__((ext_vector_type(4)));
typedef float f32x4 __attribute__((ext_vector_type(4)));
typedef short bf16x8 __attribute__((ext_vector_type(8)));
typedef GAS unsigned gu32;
typedef GAS unsigned long long gu64;
#define RLX_AGENT __ATOMIC_RELAXED, __HIP_MEMORY_SCOPE_AGENT
#define LDS_WAIT() asm volatile("s_waitcnt lgkmcnt(0)" ::: "memory")
#define VM_WAIT() asm volatile("s_waitcnt vmcnt(0)" ::: "memory")
__device__ __forceinline__ unsigned long long rt() { return __builtin_amdgcn_s_memrealtime(); }
__device__ __forceinline__ unsigned f2bf(float f) { unsigned u = __builtin_bit_cast(unsigned, f); return (u + 0x7fffu + ((u >> 16) & 1u)) >> 16; }
__device__ __forceinline__ unsigned pk2(float lo, float hi) { return f2bf(lo) | (f2bf(hi) << 16); }
#define XB_TMO      128
#define XB_XCNT(j)  (256  + 64 * (j))
#define XB_XSUB(j)  (1280 + 64 * (j))
#define XB_XGEN(j)  (2304 + 64 * (j))
#define XB_TOP      3328
#define XB_TOPGEN   3392
#define XCD_BAR_WORDS 3456
#define XB_SPIN_CAP (1u << 22)

__device__ __forceinline__ unsigned xb_ld(unsigned* p)              { return __hip_atomic_load(p, __ATOMIC_RELAXED, __HIP_MEMORY_SCOPE_AGENT); }
__device__ __forceinline__ unsigned xb_add(unsigned* p, unsigned v) { return __hip_atomic_fetch_add(p, v, __ATOMIC_RELAXED, __HIP_MEMORY_SCOPE_AGENT); }
__device__ __forceinline__ unsigned xb_xcc_id() { return (unsigned)__builtin_amdgcn_s_getreg((3 << 11) | 20) & 0xFu; }
#define XB_SPIN(cond, bar) do { unsigned _sp = 0; while (cond) { __builtin_amdgcn_s_sleep(1); \
    if ((++_sp & 255u) == 0u) { if (xb_ld(&(bar)[XB_TMO])) break; if (_sp > XB_SPIN_CAP) { atomicAdd(&(bar)[XB_TMO], 1u); break; } } } } while (0)

struct XcdBarrier {
    unsigned* bar; unsigned x;
    volatile LAS unsigned* st;
};

__device__ __forceinline__ XcdBarrier xcd_barrier_post(unsigned* bar, volatile LAS unsigned* st) {
    XcdBarrier b; b.bar = bar; b.x = xb_xcc_id(); b.st = st;
    if (threadIdx.x == 0) (void)xb_add(&bar[XB_XCNT(b.x)], 1u);
    return b;
}
__device__ __forceinline__ void xcd_barrier_complete(unsigned* bar, unsigned x, unsigned& nloc, unsigned& nx) {
    const unsigned G = gridDim.x * gridDim.y * gridDim.z;
    unsigned sum, cnt, mine, sp = 0u;
    for (;;) {
        sum = 0u; cnt = 0u; mine = 0u;
#pragma unroll
        for (unsigned j = 0; j < 16; ++j) { const unsigned c = xb_ld(&bar[XB_XCNT(j)]); sum += c; cnt += (c > 0u) ? 1u : 0u; mine = (j == x) ? c : mine; }
        if (sum == G) break;
        __builtin_amdgcn_s_sleep(1);
        if ((++sp & 255u) == 0u) { if (xb_ld(&bar[XB_TMO])) break; if (sp > XB_SPIN_CAP) { atomicAdd(&bar[XB_TMO], 1u); break; } }
    }
    nloc = mine > 0u ? mine : 1u; nx = cnt > 0u ? cnt : 1u;
}

__device__ __forceinline__ void xcd_barrier(const XcdBarrier& b) {
    asm volatile("s_waitcnt vmcnt(0)" ::: "memory");
    __syncthreads();
    if (threadIdx.x == 0) {
        unsigned* bar = b.bar;
        __builtin_amdgcn_s_waitcnt(0);
        unsigned nloc = b.st[0], nx = b.st[1];
        if (nloc == 0u) { xcd_barrier_complete(bar, b.x, nloc, nx); b.st[0] = nloc; b.st[1] = nx; }
        const unsigned old = xb_add(&bar[XB_XSUB(b.x)], 1u);
        const unsigned gen = old / nloc;
        if (old + 1u == (gen + 1u) * nloc) {
            __builtin_amdgcn_fence(__ATOMIC_RELEASE, "agent");
            asm volatile("s_waitcnt vmcnt(0)" ::: "memory");
            const unsigned og = xb_add(&bar[XB_TOP], 1u);
            const unsigned tg = og / nx;
            if (og + 1u == (tg + 1u) * nx) xb_add(&bar[XB_TOPGEN], 1u);
            else XB_SPIN(xb_ld(&bar[XB_TOPGEN]) == tg, bar);
            __builtin_amdgcn_fence(__ATOMIC_ACQUIRE, "agent");
            xb_add(&bar[XB_XGEN(b.x)], 1u);
            asm volatile("s_waitcnt vmcnt(0)" ::: "memory");
        } else {
            XB_SPIN(xb_ld(&bar[XB_XGEN(b.x)]) == gen, bar);
            __builtin_amdgcn_fence(__ATOMIC_ACQUIRE, "agent");
            asm volatile("s_waitcnt vmcnt(0)" ::: "memory");
        }
    }
    __syncthreads();
}

constexpr int BATCH = 2, SEQ = 8192, DM = 1024, CTXL = 256;
constexpr int NTOK = BATCH * SEQ, NCTXR = BATCH * CTXL, NROW = NTOK + NCTXR, KVLEN = SEQ + CTXL;
constexpr int INC = 2304, NEXP = 32, TOPK = 4, GUW = 2048;
constexpr int NPAD_MAX = NTOK * TOPK + NEXP * 256;
constexpr float NORM_EPS = 1e-6f, LOG2E = 1.4426950408889634f, QSCALE = 0.125f * 1.4426950408889634f;
constexpr int NWAVES = 8;


namespace at2 {
typedef short bf16x8 __attribute__((ext_vector_type(8)));
typedef short s16x4 __attribute__((ext_vector_type(4)));
typedef float f32x16 __attribute__((ext_vector_type(16)));
typedef unsigned u32x4 __attribute__((ext_vector_type(4)));
constexpr int SHM_V = 16384, SHM_K = 16384, AT_WS_OFF = 73728, AT_WS3_OFF = 98304, XROW = 132, XROWW = 68;
constexpr int SDEPTH = 1;
constexpr float THRL = 8.0f;
#define AT_LAS __attribute__((address_space(3)))
#define KSWZ(row, colB) ((row) * 256 + ((colB) ^ (((row) & 7) << 4)))
#define SBAR() __builtin_amdgcn_sched_barrier(0)
__device__ __forceinline__ int crow(int r, int hi) { return (r & 3) + 8 * (r >> 2) + 4 * hi; }
typedef float f32x2_t __attribute__((ext_vector_type(2))); typedef __bf16 bf16x2_t __attribute__((ext_vector_type(2)));
__device__ __forceinline__ unsigned cvtpk2(float lo, float hi) { f32x2_t v = {lo, hi}; bf16x2_t b = __builtin_convertvector(v, bf16x2_t); return __builtin_bit_cast(unsigned, b); }
__device__ __forceinline__ void partialSM(f32x16& p0, f32x16& p1, float& m_reg, float& alpha) {
  float pmax = p0[0];
#pragma unroll
  for (int r = 1; r < 16; ++r) pmax = fmaxf(pmax, p0[r]);
#pragma unroll
  for (int r = 0; r < 16; ++r) pmax = fmaxf(pmax, p1[r]);
  { auto rr = __builtin_amdgcn_permlane32_swap(__float_as_uint(pmax), __float_as_uint(pmax), false, false); pmax = fmaxf(__uint_as_float(rr[0]), __uint_as_float(rr[1])); }
  float mn;
  if (__builtin_expect(__all(pmax - m_reg <= THRL), 1)) { mn = m_reg; alpha = 1.f; }
  else { mn = fmaxf(m_reg, pmax); alpha = __builtin_amdgcn_exp2f(m_reg - mn); m_reg = mn; }
#pragma unroll
  for (int r = 0; r < 16; ++r) p0[r] = p0[r] - mn;
#pragma unroll
  for (int r = 0; r < 16; ++r) p1[r] = p1[r] - mn;
#pragma unroll
  for (int r = 0; r < 16; ++r) p0[r] = __builtin_amdgcn_exp2f(p0[r]);
}
__device__ __forceinline__ void finishSM(f32x16& p0, f32x16& p1, float alpha, float& l_reg, bf16x8& pa0, bf16x8& pa1, bf16x8& pa2, bf16x8& pa3) {
#pragma unroll
  for (int r = 0; r < 16; ++r) p1[r] = __builtin_amdgcn_exp2f(p1[r]);
  float ps = 0;
#pragma unroll
  for (int r = 0; r < 16; ++r) ps += p0[r];
#pragma unroll
  for (int r = 0; r < 16; ++r) ps += p1[r];
  { auto rr = __builtin_amdgcn_permlane32_swap(__float_as_uint(ps), __float_as_uint(ps), false, false); ps = __uint_as_float(rr[0]) + __uint_as_float(rr[1]); }
  l_reg = l_reg * alpha + ps;
#define PK4(P, BASE, OUT) do { unsigned a0 = cvtpk2(P[BASE + 0], P[BASE + 1]), a1 = cvtpk2(P[BASE + 2], P[BASE + 3]);   \
    unsigned b0 = cvtpk2(P[BASE + 4], P[BASE + 5]), b1 = cvtpk2(P[BASE + 6], P[BASE + 7]);                              \
    auto r0 = __builtin_amdgcn_permlane32_swap(a0, b0, false, false); auto r1 = __builtin_amdgcn_permlane32_swap(a1, b1, false, false); \
    u32x4 w = {r0[0], r1[0], r0[1], r1[1]}; OUT = __builtin_bit_cast(bf16x8, w); } while (0)
  PK4(p0, 0, pa0); PK4(p0, 8, pa1); PK4(p1, 0, pa2); PK4(p1, 8, pa3);
#undef PK4
}
__device__ __forceinline__ void qkt(f32x16& p0, f32x16& p1, const AT_LAS char* Ks, const bf16x8* qr, int r32, int hi) {
  p0 = f32x16{}; p1 = f32x16{};
#pragma unroll
  for (int d0 = 0; d0 < 4; ++d0) { const int cb = (d0 * 16 + hi * 8) * 2;
    const bf16x8 b0 = *(const AT_LAS bf16x8*)(Ks + KSWZ(r32, cb));
    const bf16x8 b1 = *(const AT_LAS bf16x8*)(Ks + KSWZ(32 + r32, cb));
    p0 = __builtin_amdgcn_mfma_f32_32x32x16_bf16(b0, qr[d0], p0, 0, 0, 0);
    p1 = __builtin_amdgcn_mfma_f32_32x32x16_bf16(b1, qr[d0], p1, 0, 0, 0); }
}
__device__ __forceinline__ int v_st(int k, int c) { const int kk = (k & ~0xC) | ((k & 4) << 1) | ((k & 8) >> 1); return ((kk >> 3) * 4 + (c >> 5)) * 512 + ((kk & 7) * 32 + (c & 31)) * 2; }
__device__ __forceinline__ int v_rd_base(int lane) { return ((lane & 3) << 3) | (((lane >> 2) & 3) << 6) | (((lane >> 4) & 1) << 5) | (((lane >> 5) & 1) << 8); }
constexpr int v_rd_off(int d0, int ks, int half) { return d0 * 512 + ks * 4096 + half * 2048; }
template <int OFF> __device__ __forceinline__ s16x4 tr_read(int vb) { s16x4 r; asm volatile("ds_read_b64_tr_b16 %0, %1 offset:%2" : "=&v"(r) : "v"(vb), "i"(OFF) : "memory"); return r; }
template <int D0> __device__ __forceinline__ void pv_one(f32x16& od, int vb, bf16x8 pa0, bf16x8 pa1, bf16x8 pa2, bf16x8 pa3) {
  const s16x4 l0 = tr_read<v_rd_off(D0, 0, 0)>(vb), h0 = tr_read<v_rd_off(D0, 0, 1)>(vb), l1 = tr_read<v_rd_off(D0, 1, 0)>(vb), h1 = tr_read<v_rd_off(D0, 1, 1)>(vb);
  const s16x4 l2 = tr_read<v_rd_off(D0, 2, 0)>(vb), h2 = tr_read<v_rd_off(D0, 2, 1)>(vb), l3 = tr_read<v_rd_off(D0, 3, 0)>(vb), h3 = tr_read<v_rd_off(D0, 3, 1)>(vb);
  asm volatile("s_waitcnt lgkmcnt(0)" ::: "memory"); SBAR();
#define PK(L, H) (bf16x8){L[0], L[1], L[2], L[3], H[0], H[1], H[2], H[3]}
  od = __builtin_amdgcn_mfma_f32_32x32x16_bf16(pa0, PK(l0, h0), od, 0, 0, 0);
  od = __builtin_amdgcn_mfma_f32_32x32x16_bf16(pa1, PK(l1, h1), od, 0, 0, 0);
  od = __builtin_amdgcn_mfma_f32_32x32x16_bf16(pa2, PK(l2, h2), od, 0, 0, 0);
  od = __builtin_amdgcn_mfma_f32_32x32x16_bf16(pa3, PK(l3, h3), od, 0, 0, 0);
#undef PK
}
typedef short v4i16_t __attribute__((ext_vector_type(4)));
__device__ __forceinline__ s16x4 vtr(int vb, int off) { return __builtin_bit_cast(s16x4, __builtin_amdgcn_ds_read_tr16_b64_v4i16((AT_LAS v4i16_t*)(unsigned)(vb + off))); }
template <int D0> __device__ __forceinline__ void pv_one_b(f32x16& od, int vb, bf16x8 pa0, bf16x8 pa1, bf16x8 pa2, bf16x8 pa3) {
  const s16x4 l0 = vtr(vb, v_rd_off(D0, 0, 0)), h0 = vtr(vb, v_rd_off(D0, 0, 1)), l1 = vtr(vb, v_rd_off(D0, 1, 0)), h1 = vtr(vb, v_rd_off(D0, 1, 1));
  const s16x4 l2 = vtr(vb, v_rd_off(D0, 2, 0)), h2 = vtr(vb, v_rd_off(D0, 2, 1)), l3 = vtr(vb, v_rd_off(D0, 3, 0)), h3 = vtr(vb, v_rd_off(D0, 3, 1));
#define PK(L, H) (bf16x8){L[0], L[1], L[2], L[3], H[0], H[1], H[2], H[3]}
  od = __builtin_amdgcn_mfma_f32_32x32x16_bf16(pa0, PK(l0, h0), od, 0, 0, 0);
  od = __builtin_amdgcn_mfma_f32_32x32x16_bf16(pa1, PK(l1, h1), od, 0, 0, 0);
  od = __builtin_amdgcn_mfma_f32_32x32x16_bf16(pa2, PK(l2, h2), od, 0, 0, 0);
  od = __builtin_amdgcn_mfma_f32_32x32x16_bf16(pa3, PK(l3, h3), od, 0, 0, 0);
#undef PK
}
template <int NDB> __device__ __forceinline__ void pv_all_b(f32x16* o, int vb, bf16x8 pa0, bf16x8 pa1, bf16x8 pa2, bf16x8 pa3) {
  pv_one_b<0>(o[0], vb, pa0, pa1, pa2, pa3); pv_one_b<1>(o[1], vb, pa0, pa1, pa2, pa3);
  if constexpr (NDB == 4) { pv_one_b<2>(o[2], vb, pa0, pa1, pa2, pa3); pv_one_b<3>(o[3], vb, pa0, pa1, pa2, pa3); }
}
template <int NDB> __device__ __forceinline__ void pv_all(f32x16* o, int vb, bf16x8 pa0, bf16x8 pa1, bf16x8 pa2, bf16x8 pa3) {
  pv_one<0>(o[0], vb, pa0, pa1, pa2, pa3); pv_one<1>(o[1], vb, pa0, pa1, pa2, pa3);
  if constexpr (NDB == 4) { pv_one<2>(o[2], vb, pa0, pa1, pa2, pa3); pv_one<3>(o[3], vb, pa0, pa1, pa2, pa3); }
}
__device__ __forceinline__ void wmask(f32x16& p0, f32x16& p1, int k0, int q, int hi) {
#pragma unroll
  for (int r = 0; r < 16; ++r) { const int d = k0 + crow(r, hi) - q; if (d > 128 || d < -128) p0[r] = -1e30f; if (d + 32 > 128 || d + 32 < -128) p1[r] = -1e30f; }
}

struct UnitArgs {
  const bf16* Q; int ldq;
  const bf16* K; const bf16* V; int ldk;
  int kcolB;
  int vcolB;
  int q0;
  int ks;
};
template <bool DIFF> __device__ __forceinline__ int tile_k0(const UnitArgs& a, int j) { if constexpr (DIFF) return 64 * j; else return j < 4 ? SEQ + 64 * j : a.ks + 64 * (j - 4); }

#define RD128(dst, addr, OFF) asm volatile("ds_read_b128 %0, %1 offset:%2" : "=v"(dst) : "v"(addr), "i"(OFF) : "memory")
#define RDTR(dst, addr, OFF) asm volatile("ds_read_b64_tr_b16 %0, %1 offset:%2" : "=v"(dst) : "v"(addr), "i"(OFF) : "memory")
#define WAITL8_4(n, a, b, c, d) asm volatile("s_waitcnt lgkmcnt(" #n ")" : "+v"(a), "+v"(b), "+v"(c), "+v"(d) :: "memory")
#define WAITL8_8(n, a, b, c, d, e, f, g, h) asm volatile("s_waitcnt lgkmcnt(" #n ")" : "+v"(a), "+v"(b), "+v"(c), "+v"(d), "+v"(e), "+v"(f), "+v"(g), "+v"(h) :: "memory")
__device__ __forceinline__ float max3f(float a, float b, float c) { return __builtin_fmaxf(__builtin_fmaxf(a, b), c); }
__device__ __forceinline__ void softmax_seg2(f32x16& p0, f32x16& p1, float& m_reg, float& alpha, bf16x8& pa0, bf16x8& pa1, bf16x8& pa2, bf16x8& pa3) {
  float x = max3f(p0[0], p0[1], p0[2]), y = max3f(p1[0], p1[1], p1[2]);
  x = max3f(x, p0[3], p0[4]); y = max3f(y, p1[3], p1[4]); x = max3f(x, p0[5], p0[6]); y = max3f(y, p1[5], p1[6]); x = max3f(x, p0[7], p0[8]); y = max3f(y, p1[7], p1[8]);
  x = max3f(x, p0[9], p0[10]); y = max3f(y, p1[9], p1[10]); x = max3f(x, p0[11], p0[12]); y = max3f(y, p1[11], p1[12]); x = max3f(x, p0[13], p0[14]); y = max3f(y, p1[13], p1[14]);
  float pmax = max3f(x, y, p0[15]); pmax = fmaxf(pmax, p1[15]);
  { auto rr = __builtin_amdgcn_permlane32_swap(__float_as_uint(pmax), __float_as_uint(pmax), false, false); pmax = fmaxf(__uint_as_float(rr[0]), __uint_as_float(rr[1])); }
  float mn;
  if (__builtin_expect(__all(pmax - m_reg <= THRL), 1)) { mn = m_reg; alpha = 1.f; }
  else { mn = fmaxf(m_reg, pmax); alpha = __builtin_amdgcn_exp2f(m_reg - mn); m_reg = mn; }
#pragma unroll
  for (int r = 0; r < 16; ++r) { p0[r] = __builtin_amdgcn_exp2f(p0[r] - mn); p1[r] = __builtin_amdgcn_exp2f(p1[r] - mn); }
  { u32x4 w = {cvtpk2(p0[0], p0[1]), cvtpk2(p0[2], p0[3]), cvtpk2(p0[4], p0[5]), cvtpk2(p0[6], p0[7])}; pa0 = __builtin_bit_cast(bf16x8, w); }
  { u32x4 w = {cvtpk2(p0[8], p0[9]), cvtpk2(p0[10], p0[11]), cvtpk2(p0[12], p0[13]), cvtpk2(p0[14], p0[15])}; pa1 = __builtin_bit_cast(bf16x8, w); }
  { u32x4 w = {cvtpk2(p1[0], p1[1]), cvtpk2(p1[2], p1[3]), cvtpk2(p1[4], p1[5]), cvtpk2(p1[6], p1[7])}; pa2 = __builtin_bit_cast(bf16x8, w); }
  { u32x4 w = {cvtpk2(p1[8], p1[9]), cvtpk2(p1[10], p1[11]), cvtpk2(p1[12], p1[13]), cvtpk2(p1[14], p1[15])}; pa3 = __builtin_bit_cast(bf16x8, w); }
}
template <bool DIFF>
__device__ __forceinline__ void attn_tiles_pp3(const UnitArgs& a, AT_LAS char* lds, int tid, int wid, int lane, f32x16* o, f32x16& ol, float& m_out) {
  constexpr int NDB = DIFF ? 4 : 2; constexpr int NT = DIFF ? KVLEN / 64 : 10;
  const int r32 = lane & 31, hi = lane >> 5;
  AT_LAS char* V_lds = lds; AT_LAS char* K_lds = lds + 3 * SHM_V;
  AT_LAS float* al_l = (AT_LAS float*)(lds + AT_WS3_OFF) + wid * 64 + 32;
  float m_reg = -1e30f, alpha = 1.f; bf16x8 qr[4];
  const short one_ = (short)0x3F80; const bf16x8 ones = {one_, one_, one_, one_, one_, one_, one_, one_};
  const bf16* Qw = a.Q + (long)r32 * a.ldq + hi * 8;
#pragma unroll
  for (int d0 = 0; d0 < 4; ++d0) qr[d0] = *(const bf16x8*)(Qw + d0 * 16);
  int koff[2], voff[2];
#pragma unroll
  for (int i = 0; i < 2; ++i) { const int pc = 2 * wid + i;
    { const int row = 4 * pc + (lane >> 4), p = lane & 15; koff[i] = row * a.ldk + ((p ^ (row & 7)) << 3); }
    { const int s = 2 * pc + (lane >> 5), kk = (s >> 2) * 8 + ((lane & 31) >> 2); const int key = kk; voff[i] = key * a.ldk + (s & 3) * 32 + 8 * (lane & 3); } }
  const int vb0 = (int)(unsigned)(uintptr_t)V_lds + v_rd_base(lane) + a.vcolB;
  const int kb0 = (int)(unsigned)(uintptr_t)K_lds + a.kcolB + r32 * 256;
  int kad[4];
#pragma unroll
  for (int d0 = 0; d0 < 4; ++d0) kad[d0] = kb0 + (((d0 * 2 + hi) ^ (r32 & 7)) << 4);
#define DMA_K(t, slot) do { const bf16* kb_ = a.K + (long)tile_k0<DIFF>(a, (t)) * a.ldk; _Pragma("unroll") for (int i_ = 0; i_ < 2; ++i_) \
    __builtin_amdgcn_global_load_lds((const unsigned*)(kb_ + koff[i_]), (AT_LAS unsigned*)(K_lds + (slot) * SHM_K + (2 * wid + i_) * 1024), 16, 0, 0); } while (0)
#define DMA_V(t, slot) do { const bf16* vb_ = a.V + (long)tile_k0<DIFF>(a, (t)) * a.ldk; _Pragma("unroll") for (int i_ = 0; i_ < 2; ++i_) \
    __builtin_amdgcn_global_load_lds((const unsigned*)(vb_ + voff[i_]), (AT_LAS unsigned*)(V_lds + (slot) * SHM_V + (2 * wid + i_) * 1024), 16, 0, 0); } while (0)
#define BAR_MID() do { SBAR(); asm volatile("s_barrier" ::: "memory"); SBAR(); } while (0)
#define BAR_END(n) do { SBAR(); asm volatile("s_waitcnt vmcnt(" #n ")\n\ts_barrier" ::: "memory"); SBAR(); } while (0)
#define RESC2() do { if (__any(alpha < 1.f)) { if (hi == 0) al_l[r32] = alpha; asm volatile("s_waitcnt lgkmcnt(0)" ::: "memory"); \
    _Pragma("unroll") for (int r = 0; r < 16; ++r) { const float f_ = al_l[crow(r, hi)]; ol[r] *= f_; _Pragma("unroll") for (int d = 0; d < NDB; ++d) o[d][r] *= f_; } } } while (0)
#define WMASK2(t) do { if constexpr (!DIFF) { if ((t) >= 4) wmask(p0, p1, tile_k0<DIFF>(a, (t)), a.q0 + r32, hi); } } while (0)
#define VSEG(t) do { WMASK2(t); softmax_seg2(p0, p1, m_reg, alpha, pa0, pa1, pa2, pa3); RESC2(); } while (0)
#define PKV(L, H) (bf16x8){L[0], L[1], L[2], L[3], H[0], H[1], H[2], H[3]}
#define VRD8(X, D0, va) do { RDTR(X##0, va, v_rd_off(D0, 0, 0)); RDTR(X##1, va, v_rd_off(D0, 0, 1)); RDTR(X##2, va, v_rd_off(D0, 1, 0)); RDTR(X##3, va, v_rd_off(D0, 1, 1)); \
    RDTR(X##4, va, v_rd_off(D0, 2, 0)); RDTR(X##5, va, v_rd_off(D0, 2, 1)); RDTR(X##6, va, v_rd_off(D0, 3, 0)); RDTR(X##7, va, v_rd_off(D0, 3, 1)); } while (0)
#define PV4(od, X) do { od = __builtin_amdgcn_mfma_f32_32x32x16_bf16(pa0, PKV(X##0, X##1), od, 0, 0, 0); od = __builtin_amdgcn_mfma_f32_32x32x16_bf16(pa1, PKV(X##2, X##3), od, 0, 0, 0); \
    od = __builtin_amdgcn_mfma_f32_32x32x16_bf16(pa2, PKV(X##4, X##5), od, 0, 0, 0); od = __builtin_amdgcn_mfma_f32_32x32x16_bf16(pa3, PKV(X##6, X##7), od, 0, 0, 0); } while (0)
#define MSEG(DOQK, DOPV, ksl, vsl) do { \
    bf16x8 k0_, k1_, k2_, k3_; s16x4 A0, A1, A2, A3, A4, A5, A6, A7, B0, B1, B2, B3, B4, B5, B6, B7; \
    const int ko_ = (ksl) * SHM_K; const int va_ = vb0 + (vsl) * SHM_V; \
    if (DOQK) { RD128(k0_, kad[0] + ko_, 0); RD128(k1_, kad[0] + ko_, 8192); RD128(k2_, kad[1] + ko_, 0); RD128(k3_, kad[1] + ko_, 8192); \
      bf16x8 k4_, k5_, k6_, k7_; RD128(k4_, kad[2] + ko_, 0); RD128(k5_, kad[2] + ko_, 8192); RD128(k6_, kad[3] + ko_, 0); RD128(k7_, kad[3] + ko_, 8192); \
      WAITL8_4(4, k0_, k1_, k2_, k3_); SBAR(); \
      p0 = __builtin_amdgcn_mfma_f32_32x32x16_bf16(k0_, qr[0], (f32x16){}, 0, 0, 0); p1 = __builtin_amdgcn_mfma_f32_32x32x16_bf16(k1_, qr[0], (f32x16){}, 0, 0, 0); \
      p0 = __builtin_amdgcn_mfma_f32_32x32x16_bf16(k2_, qr[1], p0, 0, 0, 0); p1 = __builtin_amdgcn_mfma_f32_32x32x16_bf16(k3_, qr[1], p1, 0, 0, 0); SBAR(); \
      if (DOPV) { VRD8(A, 0, va_); WAITL8_4(8, k4_, k5_, k6_, k7_); } else { WAITL8_4(0, k4_, k5_, k6_, k7_); } SBAR(); \
      p0 = __builtin_amdgcn_mfma_f32_32x32x16_bf16(k4_, qr[2], p0, 0, 0, 0); p1 = __builtin_amdgcn_mfma_f32_32x32x16_bf16(k5_, qr[2], p1, 0, 0, 0); \
      p0 = __builtin_amdgcn_mfma_f32_32x32x16_bf16(k6_, qr[3], p0, 0, 0, 0); p1 = __builtin_amdgcn_mfma_f32_32x32x16_bf16(k7_, qr[3], p1, 0, 0, 0); SBAR(); } \
    else if (DOPV) { VRD8(A, 0, va_); } \
    if (DOPV) { VRD8(B, 1, va_); WAITL8_8(8, A0, A1, A2, A3, A4, A5, A6, A7); SBAR(); PV4(o[0], A); SBAR(); \
      if constexpr (NDB == 4) { VRD8(A, 2, va_); WAITL8_8(8, B0, B1, B2, B3, B4, B5, B6, B7); SBAR(); PV4(o[1], B); SBAR(); \
        VRD8(B, 3, va_); WAITL8_8(8, A0, A1, A2, A3, A4, A5, A6, A7); SBAR(); PV4(o[2], A); SBAR(); \
        WAITL8_8(0, B0, B1, B2, B3, B4, B5, B6, B7); SBAR(); PV4(o[3], B); SBAR(); } \
      else { WAITL8_8(0, B0, B1, B2, B3, B4, B5, B6, B7); SBAR(); PV4(o[1], B); SBAR(); } \
      ol = __builtin_amdgcn_mfma_f32_32x32x16_bf16(pa0, ones, ol, 0, 0, 0); ol = __builtin_amdgcn_mfma_f32_32x32x16_bf16(pa1, ones, ol, 0, 0, 0); \
      ol = __builtin_amdgcn_mfma_f32_32x32x16_bf16(pa2, ones, ol, 0, 0, 0); ol = __builtin_amdgcn_mfma_f32_32x32x16_bf16(pa3, ones, ol, 0, 0, 0); SBAR(); } \
  } while (0)
#define ROT3(s) ((s) == 2 ? 0 : (s) + 1)
  f32x16 p0, p1; bf16x8 pa0, pa1, pa2, pa3;
  DMA_K(0, 0); DMA_K(1, 1); DMA_V(0, 0); BAR_END(0);
  int sk = 0;
  if (wid < 4) {
    DMA_K(2, 2); DMA_V(1, 1); MSEG(true, false, 0, 0); BAR_MID(); VSEG(0); BAR_END(4);
    sk = 1;
    for (int t = 1; t <= NT - 3; ++t) { const int s1 = ROT3(sk), s2 = ROT3(s1);
      DMA_K(t + 2, s2); DMA_V(t + 1, s1); MSEG(true, true, sk, s2); BAR_MID(); VSEG(t); BAR_END(4); sk = s1; }
    { const int s1 = ROT3(sk), s2 = ROT3(s1); DMA_V(NT - 1, s1); MSEG(true, true, sk, s2); BAR_MID(); VSEG(NT - 2); BAR_END(2); sk = s1; }
    { const int s1 = ROT3(sk), s2 = ROT3(s1); MSEG(true, true, sk, s2); BAR_MID(); VSEG(NT - 1); BAR_END(0); sk = s1; }
    { const int s2 = ROT3(ROT3(sk)); MSEG(false, true, 0, s2); BAR_MID(); BAR_END(0); }
  } else {
    DMA_K(2, 2); DMA_V(1, 1); BAR_MID(); MSEG(true, false, 0, 0); BAR_END(4);
    sk = 1;
    for (int t = 1; t <= NT - 3; ++t) { const int s1 = ROT3(sk), s2 = ROT3(s1);
      DMA_K(t + 2, s2); DMA_V(t + 1, s1); VSEG(t - 1); BAR_MID(); MSEG(true, true, sk, s2); BAR_END(4); sk = s1; }
    { const int s1 = ROT3(sk), s2 = ROT3(s1); DMA_V(NT - 1, s1); VSEG(NT - 3); BAR_MID(); MSEG(true, true, sk, s2); BAR_END(2); sk = s1; }
    { const int s1 = ROT3(sk), s2 = ROT3(s1); VSEG(NT - 2); BAR_MID(); MSEG(true, true, sk, s2); BAR_END(0); sk = s1; }
    { const int s2 = ROT3(ROT3(sk)); VSEG(NT - 1); BAR_MID(); MSEG(false, true, 0, s2); BAR_END(0); }
  }
  m_out = m_reg;
#undef DMA_K
#undef DMA_V
#undef BAR_MID
#undef BAR_END
#undef RESC2
#undef WMASK2
#undef VSEG
#undef PKV
#undef VRD8
#undef PV4
#undef MSEG
#undef ROT3
}

typedef int i32x8v __attribute__((ext_vector_type(8)));
constexpr int F8_SLOT = 8192, F8_K_OFF = 0, F8_V_OFF = 3 * F8_SLOT;
#define MF8_ACC(acc, a8, b8) asm volatile("v_mfma_scale_f32_32x32x64_f8f6f4 %0, %1, %2, %0, %3, %3 op_sel_hi:[0,0,0]" : "+v"(acc) : "v"(a8), "v"(b8), "v"(sc1))
#define MF8_NEW(acc, a8, b8) asm volatile("v_mfma_scale_f32_32x32x64_f8f6f4 %0, %1, %2, 0, %3, %3 op_sel_hi:[0,0,0]" : "=&v"(acc) : "v"(a8), "v"(b8), "v"(sc1))
__device__ __forceinline__ unsigned pk4f8(float a, float b, float c, float d) { int w = 0; w = __builtin_amdgcn_cvt_pk_fp8_f32(a, b, w, false); w = __builtin_amdgcn_cvt_pk_fp8_f32(c, d, w, true); return (unsigned)w; }
struct UnitArgs8 { const unsigned char* Q; const unsigned char* K; const unsigned char* VT; int comp, ldk, vdoff, q0, ks; };
template <bool DIFF> __device__ __forceinline__ int tile8_k0(const UnitArgs8& a, int j) { if constexpr (DIFF) return 64 * j; else return j < 4 ? SEQ + 64 * j : a.ks + 64 * (j - 4); }
template <bool DIFF>
__device__ __forceinline__ void attn_tiles_f8(const UnitArgs8& a, AT_LAS char* lds, int tid, int wid, int lane, f32x16* o, f32x16& ol, float& m_out) {
  constexpr int NDB = DIFF ? 4 : 2, NT = DIFF ? KVLEN / 64 : 10;
  const int r32 = lane & 31, hi = lane >> 5;
  AT_LAS char* K_lds = lds + F8_K_OFF; AT_LAS char* V_lds = lds + F8_V_OFF;
  AT_LAS float* al_l = (AT_LAS float*)(lds + AT_WS3_OFF) + wid * 64 + 32;
  float m_reg = -1e30f, alpha = 1.f;
  int sc1 = 0x7F7F7F7F; asm volatile("" : "+v"(sc1));
  i32x8v ones8; { int o4 = 0x38383838; asm volatile("" : "+v"(o4)); ones8 = (i32x8v){o4, o4, o4, o4, o4, o4, o4, o4}; }
  i32x8v q8; { const u32x4 qa_ = *(const u32x4*)(a.Q + (long)r32 * 512 + hi * 32), qb_ = *(const u32x4*)(a.Q + (long)r32 * 512 + hi * 32 + 16);
    q8 = (i32x8v){(int)qa_.x, (int)qa_.y, (int)qa_.z, (int)qa_.w, (int)qb_.x, (int)qb_.y, (int)qb_.z, (int)qb_.w}; }
  const int kkey = 8 * wid + (lane >> 3), koff = kkey * a.ldk + (((lane & 7) ^ ((kkey >> 1) & 7)) << 4);
  const int vd = 16 * wid + (lane >> 2); const long voff = (long)vd * KVLEN + (((lane & 3) ^ ((vd >> 2) & 3)) << 4);
  const int ksw = (r32 >> 1) & 7, vsw = (r32 >> 2) & 3;
  const int kb = (int)(unsigned)(uintptr_t)K_lds + r32 * 128, ka0 = kb + (((a.comp * 4 + 2 * hi) ^ ksw) << 4), ka1 = kb + (((a.comp * 4 + 2 * hi + 1) ^ ksw) << 4);
  const int vbb = (int)(unsigned)(uintptr_t)V_lds + a.vdoff + r32 * 64, va0 = vbb + (((2 * hi) ^ vsw) << 4), va1 = vbb + (((2 * hi + 1) ^ vsw) << 4);
#define DMA_K(t, slot) __builtin_amdgcn_global_load_lds((const unsigned*)(a.K + (long)tile8_k0<DIFF>(a, (t)) * a.ldk + koff), (AT_LAS unsigned*)(K_lds + (slot) * F8_SLOT + wid * 1024), 16, 0, 0)
#define DMA_V(t, slot) __builtin_amdgcn_global_load_lds((const unsigned*)(a.VT + (long)tile8_k0<DIFF>(a, (t)) + voff), (AT_LAS unsigned*)(V_lds + (slot) * F8_SLOT + wid * 1024), 16, 0, 0)
#define BAR_MID() do { SBAR(); asm volatile("s_barrier" ::: "memory"); SBAR(); } while (0)
#define BAR_END(n) do { SBAR(); asm volatile("s_waitcnt vmcnt(" #n ")\n\ts_barrier" ::: "memory"); SBAR(); } while (0)
#define RESC2() do { if (__any(alpha < 1.f)) { if (hi == 0) al_l[r32] = alpha; asm volatile("s_waitcnt lgkmcnt(0)" ::: "memory"); \
    _Pragma("unroll") for (int r = 0; r < 16; ++r) { const float f_ = al_l[crow(r, hi)]; ol[r] *= f_; _Pragma("unroll") for (int d = 0; d < NDB; ++d) o[d][r] *= f_; } } } while (0)
#define VSEG(t) do { if constexpr (!DIFF) { if ((t) >= 4) wmask(p0, p1, tile8_k0<DIFF>(a, (t)), a.q0 + r32, hi); } bf16x8 t0_, t1_, t2_, t3_; softmax_seg2(p0, p1, m_reg, alpha, t0_, t1_, t2_, t3_); (void)t0_; (void)t1_; (void)t2_; (void)t3_; \
    pa8 = (i32x8v){(int)pk4f8(p0[0], p0[1], p0[2], p0[3]), (int)pk4f8(p0[4], p0[5], p0[6], p0[7]), (int)pk4f8(p0[8], p0[9], p0[10], p0[11]), (int)pk4f8(p0[12], p0[13], p0[14], p0[15]), \
                   (int)pk4f8(p1[0], p1[1], p1[2], p1[3]), (int)pk4f8(p1[4], p1[5], p1[6], p1[7]), (int)pk4f8(p1[8], p1[9], p1[10], p1[11]), (int)pk4f8(p1[12], p1[13], p1[14], p1[15])}; RESC2(); } while (0)
#define RD16(dst, addr, OFF) asm volatile("ds_read_b128 %0, %1 offset:%2" : "=v"(dst) : "v"(addr), "i"(OFF) : "memory")
#define CAT8(x, y) (i32x8v){(int)x[0], (int)x[1], (int)x[2], (int)x[3], (int)y[0], (int)y[1], (int)y[2], (int)y[3]}
#define MSEG(DOQK, DOPV, ksl, vsl) do { \
    u32x4 ka_, kb_, kc_, kd_, v0a, v0b, v1a, v1b, v2a, v2b, v3a, v3b; const int ko_ = (ksl) * F8_SLOT, vo_ = (vsl) * F8_SLOT; \
    if (DOQK) { RD16(ka_, ka0 + ko_, 0); RD16(kb_, ka1 + ko_, 0); RD16(kc_, ka0 + ko_, 4096); RD16(kd_, ka1 + ko_, 4096); } \
    if (DOPV) { RD16(v0a, va0 + vo_, 0); RD16(v0b, va1 + vo_, 0); RD16(v1a, va0 + vo_, 2048); RD16(v1b, va1 + vo_, 2048); \
                if constexpr (NDB == 4) { RD16(v2a, va0 + vo_, 4096); RD16(v2b, va1 + vo_, 4096); RD16(v3a, va0 + vo_, 6144); RD16(v3b, va1 + vo_, 6144); } } \
    if (DOQK) { if (DOPV) { if constexpr (NDB == 4) asm volatile("s_waitcnt lgkmcnt(8)" : "+v"(ka_), "+v"(kb_), "+v"(kc_), "+v"(kd_) :: "memory"); else asm volatile("s_waitcnt lgkmcnt(4)" : "+v"(ka_), "+v"(kb_), "+v"(kc_), "+v"(kd_) :: "memory"); } else { asm volatile("s_waitcnt lgkmcnt(0)" : "+v"(ka_), "+v"(kb_), "+v"(kc_), "+v"(kd_) :: "memory"); } SBAR(); \
      { const i32x8v k0_ = CAT8(ka_, kb_), k1_ = CAT8(kc_, kd_); MF8_NEW(p0, k0_, q8); MF8_NEW(p1, k1_, q8); } SBAR(); } \
    if (DOPV) { if constexpr (NDB == 4) { asm volatile("s_waitcnt lgkmcnt(0)" : "+v"(v0a), "+v"(v0b), "+v"(v1a), "+v"(v1b), "+v"(v2a), "+v"(v2b), "+v"(v3a), "+v"(v3b) :: "memory"); SBAR(); \
        const i32x8v w0_ = CAT8(v0a, v0b), w1_ = CAT8(v1a, v1b), w2_ = CAT8(v2a, v2b), w3_ = CAT8(v3a, v3b); \
        MF8_ACC(o[0], pa8, w0_); MF8_ACC(o[1], pa8, w1_); MF8_ACC(o[2], pa8, w2_); MF8_ACC(o[3], pa8, w3_); MF8_ACC(ol, pa8, ones8); } \
      else { asm volatile("s_waitcnt lgkmcnt(0)" : "+v"(v0a), "+v"(v0b), "+v"(v1a), "+v"(v1b) :: "memory"); SBAR(); \
        const i32x8v w0_ = CAT8(v0a, v0b), w1_ = CAT8(v1a, v1b); MF8_ACC(o[0], pa8, w0_); MF8_ACC(o[1], pa8, w1_); MF8_ACC(ol, pa8, ones8); } SBAR(); } \
    asm volatile("s_nop 15\n\ts_nop 15" ::: "memory");     \
  } while (0)
#define ROT3(s) ((s) == 2 ? 0 : (s) + 1)
  f32x16 p0, p1; i32x8v pa8;
  DMA_K(0, 0); DMA_K(1, 1); DMA_V(0, 0); BAR_END(0);
  int sk = 0;
  if (wid < 4) {
    DMA_K(2, 2); DMA_V(1, 1); MSEG(true, false, 0, 0); BAR_MID(); VSEG(0); BAR_END(2);
    sk = 1;
    for (int t = 1; t <= NT - 3; ++t) { const int s1 = ROT3(sk), s2 = ROT3(s1);
      DMA_K(t + 2, s2); DMA_V(t + 1, s1); MSEG(true, true, sk, s2); BAR_MID(); VSEG(t); BAR_END(2); sk = s1; }
    { const int s1 = ROT3(sk), s2 = ROT3(s1); DMA_V(NT - 1, s1); MSEG(true, true, sk, s2); BAR_MID(); VSEG(NT - 2); BAR_END(1); sk = s1; }
    { const int s1 = ROT3(sk), s2 = ROT3(s1); MSEG(true, true, sk, s2); BAR_MID(); VSEG(NT - 1); BAR_END(0); sk = s1; }
    { const int s2 = ROT3(ROT3(sk)); MSEG(false, true, 0, s2); BAR_MID(); BAR_END(0); }
  } else {
    DMA_K(2, 2); DMA_V(1, 1); BAR_MID(); MSEG(true, false, 0, 0); BAR_END(2);
    sk = 1;
    for (int t = 1; t <= NT - 3; ++t) { const int s1 = ROT3(sk), s2 = ROT3(s1);
      DMA_K(t + 2, s2); DMA_V(t + 1, s1); VSEG(t - 1); BAR_MID(); MSEG(true, true, sk, s2); BAR_END(2); sk = s1; }
    { const int s1 = ROT3(sk), s2 = ROT3(s1); DMA_V(NT - 1, s1); VSEG(NT - 3); BAR_MID(); MSEG(true, true, sk, s2); BAR_END(1); sk = s1; }
    { const int s1 = ROT3(sk), s2 = ROT3(s1); VSEG(NT - 2); BAR_MID(); MSEG(true, true, sk, s2); BAR_END(0); sk = s1; }
    { const int s2 = ROT3(ROT3(sk)); VSEG(NT - 1); BAR_MID(); MSEG(false, true, 0, s2); BAR_END(0); }
  }
  m_out = m_reg;
#undef DMA_K
#undef DMA_V
#undef BAR_MID
#undef BAR_END
#undef RESC2
#undef VSEG
#undef RD16
#undef CAT8
#undef MSEG
#undef ROT3
}
#undef KSWZ
#undef SBAR
}

constexpr size_t MiB = 1u << 20;
constexpr size_t WS_CTL = 0, CTL_ZERO_BYTES = 1 * MiB;
constexpr size_t WS_MODP = 1 * MiB;
constexpr size_t WS_MODV = 2 * MiB;
constexpr size_t WS_ROPE = 2 * MiB + 128 * 1024;
constexpr size_t WS_ROUTE = 3 * MiB;
constexpr size_t WS_WIN = 4 * MiB, WS_WOUT = 9 * MiB, WS_WGU = 12 * MiB, WS_WDN = 140 * MiB;
constexpr size_t WS_ELIST = 238 * MiB;
constexpr size_t WS_XN = 204 * MiB;
constexpr size_t WS_QA = 240 * MiB, WS_KA = 256 * MiB, WS_VA = 274 * MiB, WS_QB = 292 * MiB, WS_KB = 308 * MiB, WS_VB = 314 * MiB;
constexpr size_t WS_Y = 320 * MiB, WS_X1 = 352 * MiB, WS_XG = 416 * MiB, WS_H = 560 * MiB, WS_Y2 = 704 * MiB, WS_END = 848 * MiB;
constexpr int CW_TMO = 0, CW_CODE = 1, CW_BAR = 4096, CW_CNT = 8192;
constexpr int MODP_KC = 8;

constexpr int RING_OFF = 0, RING_BYTES = 131072;
constexpr int LDSCTL_OFF = RING_BYTES, MISC_OFF = LDSCTL_OFF + 320, XTRA_OFF = LDSCTL_OFF + 1024;
constexpr int LDS_BYTES = 147456;

__device__ const double ROPE_CS[32] = {
    0.54030230586813977, 0.8414709848078965, 0.84600911028170789, 0.53316843991402285, 0.95041528025518285, 0.31098359290718575, 0.98423023447009461, 0.17689218624615005,
    0.99500416527802582, 0.099833416646828155, 0.99841927779266448, 0.056204499214692491, 0.99950004166527784, 0.031617506402433708, 0.99984189028361437, 0.01778185687966613,
    0.99995000041666526, 0.0099998333341666645, 0.9999841886533658, 0.0056233836139601857, 0.99999500000416663, 0.0031622723897082477, 0.99999841886158658, 0.0017782784728035289,
    0.99999950000004167, 0.00099999983333334168, 0.99999984188612112, 0.00056234129555235944, 0.99999995000000041, 0.00031622776074637522, 0.99999998418861169, 0.00017782794006665674};

__device__ __forceinline__ unsigned cvtpk(float lo, float hi) { return at2::cvtpk2(lo, hi); }
__device__ __forceinline__ unsigned pk4_fp8(float a, float b, float c, float d) { int w = 0; w = __builtin_amdgcn_cvt_pk_fp8_f32(a, b, w, false); w = __builtin_amdgcn_cvt_pk_fp8_f32(c, d, w, true); return (unsigned)w; }
__device__ __forceinline__ float bflo(unsigned w) { return __uint_as_float(w << 16); }
__device__ __forceinline__ float bfhi(unsigned w) { return __uint_as_float(w & 0xffff0000u); }
__device__ __forceinline__ bf16 f2bf1(float f) { return (bf16)(cvtpk(f, 0.f) & 0xffffu); }
__device__ __forceinline__ void unpack8(const v4u v, float* f) { f[0] = bflo(v.x); f[1] = bfhi(v.x); f[2] = bflo(v.y); f[3] = bfhi(v.y); f[4] = bflo(v.z); f[5] = bfhi(v.z); f[6] = bflo(v.w); f[7] = bfhi(v.w); }
__device__ __forceinline__ float wave_sum(float v) {
#pragma unroll
    for (int o = 1; o < 64; o <<= 1) v += __shfl_xor(v, o);
    return v;
}

struct Frame {
    LAS unsigned char* lds;
    volatile LAS unsigned* MISC;
    gu32* ctl;
    int tid, lane, wave, vcu, G, probe;
    const float *x, *c, *ctx, *c_ctx, *w_mod, *b_mod, *norm1_g, *w_in, *lq1, *lk1, *lq2, *lk2, *subln_g, *sink, *w_out, *norm2_g, *w_router, *b_router, *w_gu, *b_gu, *w_dn, *b_dn, *final_g;
    float* out;
    float *modp, *modv, *rope, *X1, *rgate;
    int *re, *rslot, *rpos, *elist;
    bf16 *Win_t, *Wout_t, *Wgu_t, *Wdn_t, *XN, *QA, *KA, *VA, *QB, *KB, *VB, *Y, *XG, *H, *Y2;
};

#ifdef PROBE_BUILD
#define RP(F, k) (1 + (((F).probe >> (k)) & 1))
#else
#define RP(F, k) 1
#endif
struct EpiQKV {
    bf16 *QA, *KA, *VA, *QB, *KB, *VB; const float* rope;
    struct Ctx { bf16* p; bool skip, rp, isq; const float* cs; };
    __device__ __forceinline__ Ctx prep(int row, int cg) const {
        Ctx c; const bool lat = row < NTOK; const int b = lat ? (row >> 13) : ((row - NTOK) >> 8);
        const int kvrow = lat ? (b * KVLEN + (row & (SEQ - 1))) : (b * KVLEN + SEQ + ((row - NTOK) & (CTXL - 1)));
        c.skip = false; c.rp = lat; c.isq = false;
        if (cg < 512)       { c.p = QA + (size_t)row * 512 + cg; c.isq = true; c.skip = !lat; }
        else if (cg < 1024) { c.p = KA + (size_t)kvrow * 512 + (cg - 512); }
        else if (cg < 1536) { c.p = VA + (size_t)kvrow * 512 + (cg - 1024); c.rp = false; }
        else if (cg < 2048) { c.p = QB + (size_t)row * 512 + (cg - 1536); c.isq = true; c.skip = !lat; }
        else if (cg < 2176) { c.p = KB + (size_t)kvrow * 128 + (cg - 2048); }
        else                { c.p = VB + (size_t)kvrow * 128 + (cg - 2176); c.rp = false; }
        const int t = row & (SEQ - 1); const int pos = ((cg >> 5) & 1) ? (t & 63) : (t >> 6);
        c.cs = rope + pos * 32;
        return c;
    }
    __device__ __forceinline__ void math(const Ctx& c, int i, float lo, float hi, float& olo, float& ohi) const {
        if (c.rp) { const float cs = c.cs[2 * i], sn = c.cs[2 * i + 1]; olo = lo * cs - hi * sn; ohi = hi * cs + lo * sn; } else { olo = lo; ohi = hi; }
        if (c.isq) { olo *= QSCALE; ohi *= QSCALE; }
    }
    __device__ __forceinline__ void one(int row, int cg, int i, float lo, float hi, int) const {
        const Ctx c = prep(row, cg); if (c.skip) return; float a, b; math(c, i, lo, hi, a, b); c.p[i] = f2bf1(a); c.p[16 + i] = f2bf1(b);
    }
    __device__ __forceinline__ void four(int row, int cg, int i0, const f32x4 lo, const f32x4 hi, int) const {
        const Ctx c = prep(row, cg); if (c.skip) return; float a[4], b[4];
#pragma unroll
        for (int i = 0; i < 4; ++i) math(c, i0 + i, lo[i], hi[i], a[i], b[i]);
        typedef unsigned u32x2 __attribute__((ext_vector_type(2)));
        *(u32x2*)(c.p + i0) = (u32x2){cvtpk(a[0], a[1]), cvtpk(a[2], a[3])}; *(u32x2*)(c.p + 16 + i0) = (u32x2){cvtpk(b[0], b[1]), cvtpk(b[2], b[3])};
    }
};
struct EpiOut {
    const float* x; const float* modv; float* X1;
    __device__ __forceinline__ void one(int row, int cg, int i, float lo, float hi, int) const {
        const float* g1 = modv + (row >> 13) * 6144 + 2048; const size_t o = (size_t)row * DM + cg + i;
        X1[o] = x[o] + g1[cg + i] * lo; X1[o + 16] = x[o + 16] + g1[cg + 16 + i] * hi;
    }
    __device__ __forceinline__ void four(int row, int cg, int i0, const f32x4 lo, const f32x4 hi, int) const {
        const float* g1 = modv + (row >> 13) * 6144 + 2048 + cg + i0; const size_t o = (size_t)row * DM + cg + i0;
        typedef unsigned u32x2 __attribute__((ext_vector_type(2)));
        const f32x4 a = *(const f32x4*)(x + o) + *(const f32x4*)(g1) * lo, b = *(const f32x4*)(x + o + 16) + *(const f32x4*)(g1 + 16) * hi;
        *(u32x2*)((bf16*)X1 + o) = (u32x2){cvtpk(a[0], a[1]), cvtpk(a[2], a[3])}; *(u32x2*)((bf16*)X1 + o + 16) = (u32x2){cvtpk(b[0], b[1]), cvtpk(b[2], b[3])};
    }
};
__device__ __forceinline__ float swiglu(float g, float lin) {
    g = fminf(g, 7.0f); lin = fminf(fmaxf(lin, -7.0f), 7.0f);
    return g * __builtin_amdgcn_rcpf(1.0f + __builtin_amdgcn_exp2f(-1.702f * LOG2E * g)) * (lin + 1.0f);
}
struct EpiGU {
    unsigned char* H; const float* b_gu;
    __device__ __forceinline__ void one(int row, int cg, int i, float lo, float hi, int e) const { (void)row; (void)cg; (void)i; (void)lo; (void)hi; (void)e; }
    __device__ __forceinline__ void four(int row, int cg, int i0, const f32x4 lo, const f32x4 hi, int e) const {
        const int f = (cg >> 1) + i0; const float* bb = b_gu + e * GUW + 2 * f; const f32x4 b0 = *(const f32x4*)bb, b1 = *(const f32x4*)(bb + 4);
        const float a0 = swiglu(lo[0] + b0[0], hi[0] + b0[1]), a1 = swiglu(lo[1] + b0[2], hi[1] + b0[3]), a2 = swiglu(lo[2] + b1[0], hi[2] + b1[1]), a3 = swiglu(lo[3] + b1[2], hi[3] + b1[3]);
        *(unsigned*)(H + (size_t)row * DM + f) = pk4_fp8(a0, a1, a2, a3);
    }
};
struct EpiDN {
    bf16* Y2; const float* b_dn;
    __device__ __forceinline__ void eight(int row, int c0, const f32x4 v0, const f32x4 v1, int e) const {
        const float* bb = b_dn + e * DM + c0; const f32x4 b0 = *(const f32x4*)bb, b1 = *(const f32x4*)(bb + 4);
        typedef unsigned u32x2 __attribute__((ext_vector_type(2)));
        *(u32x2*)((unsigned char*)Y2 + (size_t)row * DM + c0) = (u32x2){pk4_fp8(v0[0] + b0[0], v0[1] + b0[1], v0[2] + b0[2], v0[3] + b0[3]), pk4_fp8(v1[0] + b1[0], v1[1] + b1[1], v1[2] + b1[2], v1[3] + b1[3])};
    }
    __device__ __forceinline__ void one(int row, int cg, int i, float lo, float hi, int e) const {
        const float* bb = b_dn + e * DM + cg + i; bf16* p = Y2 + (size_t)row * DM + cg + i; p[0] = f2bf1(lo + bb[0]); p[16] = f2bf1(hi + bb[16]);
    }
    __device__ __forceinline__ void four(int row, int cg, int i0, const f32x4 lo, const f32x4 hi, int e) const {
        const float* bb = b_dn + e * DM + cg + i0; const f32x4 b0 = *(const f32x4*)bb, b1 = *(const f32x4*)(bb + 16); bf16* p = Y2 + (size_t)row * DM + cg + i0;
        typedef unsigned u32x2 __attribute__((ext_vector_type(2)));
        *(u32x2*)p = (u32x2){cvtpk(lo[0] + b0[0], lo[1] + b0[1]), cvtpk(lo[2] + b0[2], lo[3] + b0[3])}; *(u32x2*)(p + 16) = (u32x2){cvtpk(hi[0] + b1[0], hi[1] + b1[1]), cvtpk(hi[2] + b1[2], hi[3] + b1[3])};
    }
};
template <class E, int NN> struct EpiAdapt {
    static constexpr bool PERM = false, AFTER_DRAIN = false;
    E e;
    __device__ __forceinline__ void operator()(const pg8::f32x4 (&acc)[2][2][4][2], const pg8::Unit& u, int wr, int wc, int fr, int fq) const {
        int ex = 0, pn = u.pn; if (NN) { ex = pn / NN; pn = pn - ex * NN; }
#pragma unroll
        for (int ai = 0; ai < 2; ++ai)
#pragma unroll
            for (int m = 0; m < 4; ++m) { const int row = u.pm * 256 + ai * 128 + wr * 64 + m * 16 + fr;
#pragma unroll
                for (int bj = 0; bj < 2; ++bj) e.four(row, pn * 256 + bj * 128 + wc * 32, 4 * fq, acc[ai][bj][m][0], acc[ai][bj][m][1], ex); }
    }
};
struct RepOrder : pg8::StaticOrder { int rep;
    __device__ __forceinline__ bool next(int i, pg8::Unit& u) const { if (rep > 1) { const int R = (nwg + G - 1) / G; if (i >= R * rep) return false; i %= R; } return pg8::StaticOrder::next(i, u); } };
struct EpiQKVFast {
    static constexpr bool PERM = false, AFTER_DRAIN = false;
    bf16 *QA, *KA, *VA, *QB, *KB, *VB; const float* rope;
    __device__ __forceinline__ void operator()(const pg8::f32x4 (&acc)[2][2][4][2], const pg8::Unit& u, int wr, int wc, int fr, int fq) const {
        typedef unsigned u32x2 __attribute__((ext_vector_type(2)));
        bf16* base[2]; int ld[2]; bool isq[2], rp[2], kvr[2], f8[2];
#pragma unroll
        for (int bj = 0; bj < 2; ++bj) { const int cg = u.pn * 256 + bj * 128 + wc * 32; isq[bj] = false; rp[bj] = true; kvr[bj] = true; f8[bj] = true;
            if (cg < 512)       { base[bj] = (bf16*)((unsigned char*)QA + cg); ld[bj] = 512; isq[bj] = true; kvr[bj] = false; }
            else if (cg < 1024) { base[bj] = (bf16*)((unsigned char*)KA + (cg - 512)); ld[bj] = 512; }
            else if (cg < 1536) { base[bj] = (bf16*)((unsigned char*)VA + (cg - 1024)); ld[bj] = 512; rp[bj] = false; }
            else if (cg < 2048) { base[bj] = (bf16*)((unsigned char*)QB + (cg - 1536)); ld[bj] = 512; isq[bj] = true; kvr[bj] = false; }
            else if (cg < 2176) { base[bj] = (bf16*)((unsigned char*)KB + (cg - 2048)); ld[bj] = 128; }
            else                { base[bj] = (bf16*)((unsigned char*)VB + (cg - 2176)); ld[bj] = 128; rp[bj] = false; } }
        const bool colhalf = (wc & 1) != 0;
#pragma unroll
        for (int ai = 0; ai < 2; ++ai)
#pragma unroll
            for (int m = 0; m < 4; ++m) {
                const int row = u.pm * 256 + ai * 128 + wr * 64 + m * 16 + fr; const bool lat = row < NTOK;
                const int b = lat ? (row >> 13) : ((row - NTOK) >> 8);
                const int kvrow = lat ? (b * KVLEN + (row & (SEQ - 1))) : (b * KVLEN + SEQ + ((row - NTOK) & (CTXL - 1)));
                const int t = row & (SEQ - 1), pos = colhalf ? (t & 63) : (t >> 6);
                const f32x4 c0 = *(const f32x4*)(rope + pos * 32 + 8 * fq), c1 = *(const f32x4*)(rope + pos * 32 + 8 * fq + 4);
#pragma unroll
                for (int bj = 0; bj < 2; ++bj) {
                    if (isq[bj] && !lat) continue;
                    f32x4 lo = acc[ai][bj][m][0], hi = acc[ai][bj][m][1];
                    if (rp[bj] && lat) { const f32x4 cs = {c0[0], c0[2], c1[0], c1[2]}, sn = {c0[1], c0[3], c1[1], c1[3]}; const f32x4 nl = lo * cs - hi * sn, nh = hi * cs + lo * sn; lo = nl; hi = nh; }
                    if (isq[bj]) { lo = lo * QSCALE; hi = hi * QSCALE; }
                    const size_t rr = (size_t)(kvr[bj] ? kvrow : row) * ld[bj];
                    if (f8[bj]) { unsigned char* p = (unsigned char*)base[bj] + rr + 4 * fq; *(unsigned*)p = pk4_fp8(lo[0], lo[1], lo[2], lo[3]); *(unsigned*)(p + 16) = pk4_fp8(hi[0], hi[1], hi[2], hi[3]); }
                    else { bf16* p = base[bj] + rr + 4 * fq; *(u32x2*)p = (u32x2){cvtpk(lo[0], lo[1]), cvtpk(lo[2], lo[3])}; *(u32x2*)(p + 16) = (u32x2){cvtpk(hi[0], hi[1]), cvtpk(hi[2], hi[3])}; }
                }
            }
    }
};
template <class E, int NN> struct EpiAdaptP {
    static constexpr bool PERM = true, AFTER_DRAIN = false;
    E e;
    __device__ __forceinline__ void operator()(const pg8::f32x4 (&acc)[2][2][4][2], const pg8::Unit& u, int wr, int wc, int fr, int fq) const {
        int ex = 0, pn = u.pn; if (NN) { ex = pn / NN; pn = pn - ex * NN; }
#pragma unroll
        for (int ai = 0; ai < 2; ++ai)
#pragma unroll
            for (int m = 0; m < 4; ++m) { const int row = u.pm * 256 + ai * 128 + wr * 64 + m * 16 + fr;
#pragma unroll
                for (int bj = 0; bj < 2; ++bj) e.eight(row, pn * 256 + bj * 128 + wc * 32 + 8 * fq, acc[ai][bj][m][0], acc[ai][bj][m][1], ex); }
    }
};
struct GroupedOrder {
    int nN, NP, G, c; const LAS int* pexp; int rep; const LAS int* tokT;
    __device__ __forceinline__ int rounds() const { const int upr = G / nN; return (NP + upr - 1) / upr; }
    __device__ __forceinline__ int tok(int ui, int r) const { if (rep > 1) ui %= rounds(); return tokT[ui * 256 + r]; }
    __device__ __forceinline__ bool next(int i, pg8::Unit& u) const {
        int p, j;
        if (rep > 1) { const int R = rounds(); if (i >= R * rep) return false; i %= R; }
        if (G == 256) { const int x = c & 7, r = c >> 3, ppx = 32 / nN; p = i * (8 * ppx) + x * ppx + r / nN; j = r % nN; }
        else { const long L = (long)i * G + c; p = (int)(L / nN); j = (int)(L % nN); }
        if (p >= NP) return false;
        u.pm = p; u.pn = pexp[p] * nN + j; return true;
    }
    __device__ __forceinline__ void a_ready(const pg8::Unit&) const {}
    __device__ __forceinline__ void done(const pg8::Unit&) const {}
};

struct DenseSel { const bf16* Bt; __device__ __forceinline__ const bf16* operator()(int, int& e) const { e = 0; return Bt; } };
struct GroupSel { const bf16* Bt; const LAS int* pexp; int N, K; __device__ __forceinline__ const bf16* operator()(int mt, int& e) const { e = pexp[mt >> 1]; return Bt + (size_t)e * N * K; } };
template <class Epi, class BSel>
__device__ __forceinline__ void naive_gemm(Frame& F, const bf16* A, int Mtiles, int N, int K, const BSel& bs, const Epi& E) {
    LAS float* As = (LAS float*)(F.lds + RING_OFF); LAS float* Bs = As + 128 * 33;
    const int nNt = N / 64, tx = F.tid & 15, ty = F.tid >> 4;
    for (int t = blockIdx.x; t < Mtiles * nNt; t += F.G) {
        const int mt = t / nNt, nt = t % nNt; int e; const bf16* Bt = bs(mt, e);
        float acc[4][4];
#pragma unroll
        for (int r = 0; r < 4; ++r)
#pragma unroll
            for (int j = 0; j < 4; ++j) acc[r][j] = 0.f;
        for (int k0 = 0; k0 < K; k0 += 32) {
            { const int r = F.tid >> 2, kc = (F.tid & 3) * 8; float f[8]; unpack8(*(const v4u*)(A + (size_t)(mt * 128 + r) * K + k0 + kc), f);
#pragma unroll
              for (int i = 0; i < 8; ++i) As[r * 33 + kc + i] = f[i]; }
            if (F.tid < 256) { const int r = F.tid >> 2, kc = (F.tid & 3) * 8; float f[8]; unpack8(*(const v4u*)(Bt + (size_t)(nt * 64 + r) * K + k0 + kc), f);
#pragma unroll
              for (int i = 0; i < 8; ++i) Bs[r * 33 + kc + i] = f[i]; }
            __syncthreads();
#pragma unroll 8
            for (int kk = 0; kk < 32; ++kk) { float a[4], b[4];
#pragma unroll
                for (int r = 0; r < 4; ++r) a[r] = As[(ty * 4 + r) * 33 + kk];
#pragma unroll
                for (int j = 0; j < 4; ++j) b[j] = Bs[(tx + 16 * j) * 33 + kk];
#pragma unroll
                for (int r = 0; r < 4; ++r)
#pragma unroll
                    for (int j = 0; j < 4; ++j) acc[r][j] += a[r] * b[j]; }
            __syncthreads();
        }
#pragma unroll
        for (int r = 0; r < 4; ++r) { const int row = mt * 128 + ty * 4 + r; E.one(row, nt * 64, tx, acc[r][0], acc[r][1], e); E.one(row, nt * 64 + 32, tx, acc[r][2], acc[r][3], e); }
    }
}

template <bool GUPERM>
__device__ __forceinline__ void p0_transpose_item(const float* W, int K, int N, bf16* WT, LAS float* scr, int item, int lane) {
    const int nblk = N / 32, kb = item / nblk, nb = item % nblk, k0 = 64 * kb, n0 = 32 * nb;
    { f32x4 v[8]; const float* wp = W + (size_t)(k0 + (lane >> 3)) * N + n0 + 4 * (lane & 7);
#pragma unroll
      for (int i = 0; i < 8; ++i) v[i] = __builtin_nontemporal_load((const f32x4*)(wp + (size_t)(8 * i) * N));
#pragma unroll
      for (int i = 0; i < 8; ++i) { LAS float* d = scr + (8 * i + (lane >> 3)) * 33 + 4 * (lane & 7); d[0] = v[i].x; d[1] = v[i].y; d[2] = v[i].z; d[3] = v[i].w; } }
    LDS_WAIT(); asm volatile("" ::: "memory");
    const int c = lane & 7;
#pragma unroll
    for (int j = 0; j < 4; ++j) { const int n = (lane >> 3) + 8 * j; const LAS float* s = scr + (8 * c) * 33 + n;
        v4u o; o.x = cvtpk(s[0 * 33], s[1 * 33]); o.y = cvtpk(s[2 * 33], s[3 * 33]); o.z = cvtpk(s[4 * 33], s[5 * 33]); o.w = cvtpk(s[6 * 33], s[7 * 33]);
        const int nd = GUPERM ? ((n & 1) * 16 + (n >> 1)) : n;
        *(GAS v4u*)(WT + (size_t)(n0 + nd) * K + k0 + 8 * c) = o; }
    LDS_WAIT(); asm volatile("" ::: "memory");
}
template <bool GUPERM>
__device__ __forceinline__ void p0_transpose_item_fp8(const float* W, int K, int N, unsigned char* WT, LAS float* scr, int item, int lane) {
    const int nblk = N / 32, kb = item / nblk, nb = item % nblk, k0 = 64 * kb, n0 = 32 * nb;
    { f32x4 v[8]; const float* wp = W + (size_t)(k0 + (lane >> 3)) * N + n0 + 4 * (lane & 7);
#pragma unroll
      for (int i = 0; i < 8; ++i) v[i] = __builtin_nontemporal_load((const f32x4*)(wp + (size_t)(8 * i) * N));
#pragma unroll
      for (int i = 0; i < 8; ++i) { LAS float* d = scr + (8 * i + (lane >> 3)) * 33 + 4 * (lane & 7); d[0] = v[i].x; d[1] = v[i].y; d[2] = v[i].z; d[3] = v[i].w; } }
    LDS_WAIT(); asm volatile("" ::: "memory");
    const int c = lane & 7;
    typedef unsigned u32x2 __attribute__((ext_vector_type(2)));
#pragma unroll
    for (int j = 0; j < 4; ++j) { const int n = (lane >> 3) + 8 * j; const LAS float* s = scr + (8 * c) * 33 + n;
        u32x2 o; o.x = pk4_fp8(s[0 * 33] * 32.f, s[1 * 33] * 32.f, s[2 * 33] * 32.f, s[3 * 33] * 32.f); o.y = pk4_fp8(s[4 * 33] * 32.f, s[5 * 33] * 32.f, s[6 * 33] * 32.f, s[7 * 33] * 32.f);
        const int nd = GUPERM ? ((n & 1) * 16 + (n >> 1)) : n;
        *(GAS u32x2*)(WT + (size_t)(n0 + nd) * K + k0 + 8 * c) = o; }
    LDS_WAIT(); asm volatile("" ::: "memory");
}
struct F8Item { const float* wp; unsigned char* wt; int K; int guperm; };
__device__ __forceinline__ F8Item f8_decode(const Frame& F, int r, int lane) {
    constexpr int I_GU1 = (DM / 64) * (GUW / 32), I_DN1 = (DM / 64) * (DM / 32);
    F8Item I; const float* W; int N, item; unsigned char* WT;
    if (r < NEXP * I_GU1) { const int e = r / I_GU1; item = r % I_GU1; W = F.w_gu + (size_t)e * DM * GUW; N = GUW; WT = (unsigned char*)F.Wgu_t + (size_t)e * GUW * DM; I.guperm = 1; }
    else { r -= NEXP * I_GU1; const int e = r / I_DN1; item = r % I_DN1; W = F.w_dn + (size_t)e * DM * DM; N = DM; WT = (unsigned char*)F.Wdn_t + (size_t)e * DM * DM; I.guperm = 0; }
    const int nblk = N / 32, kb = item / nblk, nb = item % nblk, k0 = 64 * kb, n0 = 32 * nb;
    I.wp = W + (size_t)(k0 + (lane >> 3)) * N + n0 + 4 * (lane & 7); I.K = N;
    I.wt = WT + (size_t)n0 * DM + k0 + 8 * (lane & 7);
    return I;
}
__device__ __forceinline__ void f8_issue(const F8Item& I, f32x4 (&v)[8]) {
#pragma unroll
    for (int i = 0; i < 8; ++i) v[i] = __builtin_nontemporal_load((const f32x4*)(I.wp + (size_t)(8 * i) * I.K));
}
__device__ __forceinline__ void f8_finish(const F8Item& I, f32x4 (&v)[8], LAS float* scr, int lane) {
#pragma unroll
    for (int i = 0; i < 8; ++i) { LAS float* d = scr + (8 * i + (lane >> 3)) * 33 + 4 * (lane & 7); d[0] = v[i].x; d[1] = v[i].y; d[2] = v[i].z; d[3] = v[i].w; }
    LDS_WAIT(); asm volatile("" ::: "memory");
    const int c = lane & 7;
    typedef unsigned u32x2 __attribute__((ext_vector_type(2)));
#pragma unroll
    for (int j = 0; j < 4; ++j) { const int n = (lane >> 3) + 8 * j; const LAS float* s = scr + (8 * c) * 33 + n;
        u32x2 o; o.x = pk4_fp8(s[0 * 33] * 32.f, s[1 * 33] * 32.f, s[2 * 33] * 32.f, s[3 * 33] * 32.f); o.y = pk4_fp8(s[4 * 33] * 32.f, s[5 * 33] * 32.f, s[6 * 33] * 32.f, s[7 * 33] * 32.f);
        const int nd = I.guperm ? ((n & 1) * 16 + (n >> 1)) : n;
        *(GAS u32x2*)(I.wt + (size_t)nd * DM) = o; }
    LDS_WAIT(); asm volatile("" ::: "memory");
}
__device__ __forceinline__ void f8_stream(const Frame& F, LAS float* scr, int r, int rend, int stride) {
    f32x4 va[8], vb[8]; F8Item Ia, Ib;
    if (r >= rend) return;
    Ia = f8_decode(F, r, F.lane); f8_issue(Ia, va);
    while (true) {
        int nx = r + stride;
        if (nx < rend) { Ib = f8_decode(F, nx, F.lane); f8_issue(Ib, vb); }
        f8_finish(Ia, va, scr, F.lane);
        r = nx; if (r >= rend) break;
        nx = r + stride;
        if (nx < rend) { Ia = f8_decode(F, nx, F.lane); f8_issue(Ia, va); }
        f8_finish(Ib, vb, scr, F.lane);
        r = nx; if (r >= rend) break;
    }
}
__device__ __forceinline__ void p0_item(Frame& F, LAS float* sil, LAS float* scr, int it) {
    constexpr int I_IN = (DM / 64) * (INC / 32), I_OUT = (DM / 64) * (DM / 32), I_GU1 = (DM / 64) * (GUW / 32), I_DN1 = (DM / 64) * (DM / 32);

        int r = it;
        if (r < I_IN) { p0_transpose_item<false>(F.w_in, DM, INC, F.Win_t, scr, r, F.lane); return; } r -= I_IN;
        if (r < I_OUT) { p0_transpose_item<false>(F.w_out, DM, DM, F.Wout_t, scr, r, F.lane); return; } r -= I_OUT;
        if (r < NEXP * I_GU1) { const int e = r / I_GU1; p0_transpose_item_fp8<true>(F.w_gu + (size_t)e * DM * GUW, DM, GUW, (unsigned char*)F.Wgu_t + (size_t)e * GUW * DM, scr, r % I_GU1, F.lane); return; } r -= NEXP * I_GU1;
        { const int e = r / I_DN1; p0_transpose_item_fp8<false>(F.w_dn + (size_t)e * DM * DM, DM, DM, (unsigned char*)F.Wdn_t + (size_t)e * DM * DM, scr, r % I_DN1, F.lane); }
}
constexpr int P0_NITEMS = (DM / 64) * (INC / 32) + (DM / 64) * (DM / 32) + NEXP * (DM / 64) * (GUW / 32) + NEXP * (DM / 64) * (DM / 32);
#ifndef P2_TAIL_ITEMS
#define P2_TAIL_ITEMS 46000
#endif
#ifndef P2_GEMM_WGS_N
#define P2_GEMM_WGS_N 152
#endif
constexpr int P2_GEMM_WGS = P2_GEMM_WGS_N;
constexpr int P0_SPLIT = P0_NITEMS - P2_TAIL_ITEMS;
__device__ __forceinline__ void p0_tail(Frame& F) {
    LAS float* scr = (LAS float*)(F.lds + RING_OFF + F.wave * 16384);
    const int w = ((int)blockIdx.x - P2_GEMM_WGS) * NWAVES + F.wave, NW = (F.G - P2_GEMM_WGS) * NWAVES;
    constexpr int NPRE = (DM / 64) * (INC / 32) + (DM / 64) * (DM / 32);
    f8_stream(F, scr, P0_SPLIT - NPRE + w, P0_NITEMS - NPRE, NW);
}
__device__ __forceinline__ void p0_prologue(Frame& F) {
    LAS float* sil = (LAS float*)(F.lds + XTRA_OFF);
    for (int i = F.tid; i < 3072; i += 512) { const int v = i >> 10, k = i & 1023; const float cv = (v < 2) ? F.c[v * 1024 + k] : F.c_ctx[k]; sil[i] = cv / (1.f + __expf(-cv)); }
    __syncthreads();
    const int gw = F.vcu * NWAVES + F.wave, NGW = F.G * NWAVES;
    if (blockIdx.x == 0) for (int i = F.tid; i < 2048; i += 512) { const int pos = i >> 4, j = i & 15; double cr = 1.0, sr = 0.0, cb = ROPE_CS[2 * j], sb = ROPE_CS[2 * j + 1];
        for (int bit = 0; bit < 7; ++bit) { if ((pos >> bit) & 1) { const double t = cr * cb - sr * sb; sr = cr * sb + sr * cb; cr = t; } const double t2 = cb * cb - sb * sb; sb = 2.0 * cb * sb; cb = t2; }
        F.rope[2 * i] = (float)cr; F.rope[2 * i + 1] = (float)sr; }
    for (int r = F.vcu; r < 24 * MODP_KC; r += F.G) {
        const int nb = r % 24, kc = r / 24, n = nb * 256 + F.lane * 4, kbase = kc * 128 + F.wave * 16;
        f32x4 a0 = {0.f, 0.f, 0.f, 0.f}, a1 = a0, a2 = a0;
        const float* wp = F.w_mod + (size_t)kbase * 6144 + n;
#pragma unroll
        for (int kk = 0; kk < 16; ++kk) { const f32x4 w = __builtin_nontemporal_load((const f32x4*)(wp + (size_t)kk * 6144)); const int k = kbase + kk; a0 += w * sil[k]; a1 += w * sil[1024 + k]; a2 += w * sil[2048 + k]; }
        LAS float* red = (LAS float*)(F.lds + RING_OFF);
        *(LAS f32x4*)(red + (F.wave * 3 + 0) * 256 + 4 * F.lane) = a0; *(LAS f32x4*)(red + (F.wave * 3 + 1) * 256 + 4 * F.lane) = a1; *(LAS f32x4*)(red + (F.wave * 3 + 2) * 256 + 4 * F.lane) = a2;
        __syncthreads();
        for (int i = F.tid; i < 768; i += 512) { float t = 0.f;
#pragma unroll
            for (int w = 0; w < NWAVES; ++w) t += red[w * 768 + i];
            F.modp[(size_t)(kc * 3 + i / 256) * 6144 + nb * 256 + (i % 256)] = t; }
        __syncthreads();
    }
    LAS float* scr = (LAS float*)(F.lds + RING_OFF + F.wave * 16384);
    constexpr int I_IN = (DM / 64) * (INC / 32), I_OUT = (DM / 64) * (DM / 32), I_GU1 = (DM / 64) * (GUW / 32), I_DN1 = (DM / 64) * (DM / 32);
    constexpr int NITEMS = I_IN + I_OUT + NEXP * I_GU1 + NEXP * I_DN1;
    const int nsplit = (F.G == 256) ? P0_SPLIT : NITEMS;
    constexpr int NPRE = I_IN + I_OUT;
    int it0 = gw;
    if (NPRE > NGW) { for (; it0 < NPRE; it0 += NGW) p0_item(F, sil, scr, it0); } else if (it0 < NPRE) { p0_item(F, sil, scr, it0); it0 += NGW; }
    f8_stream(F, scr, it0 - NPRE, nsplit - NPRE, NGW);
}
__device__ __forceinline__ void p1_norm(Frame& F) {
    LAS float* ml = (LAS float*)(F.lds + RING_OFF);
    for (int i0 = F.tid; i0 < 6144; i0 += 2048) { float pv[4][MODP_KC], bv[4];
#pragma unroll
        for (int q = 0; q < 4; ++q) { const int i = i0 + 512 * q, v = i / 2048, j = i % 2048; bv[q] = F.b_mod[j];
#pragma unroll
            for (int kc = 0; kc < MODP_KC; ++kc) pv[q][kc] = F.modp[(size_t)(kc * 3 + v) * 6144 + j]; }
#pragma unroll
        for (int q = 0; q < 4; ++q) { float t = bv[q];
#pragma unroll
            for (int kc = 0; kc < MODP_KC; ++kc) t += pv[q][kc];
            ml[i0 + 512 * q] = t; } }
    for (int gi = blockIdx.x * 512 + F.tid; gi < 3 * 6144; gi += F.G * 512) { const int v = gi / 6144, j = gi % 6144; float s = F.b_mod[j];
        for (int kc = 0; kc < MODP_KC; ++kc) s += F.modp[(size_t)(kc * 3 + v) * 6144 + j]; F.modv[gi] = s; }
    __syncthreads();
    const int gw = F.vcu * NWAVES + F.wave, NGW = F.G * NWAVES;
    typedef unsigned u32x2 __attribute__((ext_vector_type(2)));
    for (int pp = gw; pp < (NROW / 2) * RP(F, 1); pp += NGW) { const int m0 = (pp % (NROW / 2)) * 2;
        f32x4 xv[2][4]; float s[2] = {0.f, 0.f}; int v[2];
#pragma unroll
        for (int q = 0; q < 2; ++q) { const int m = m0 + q; v[q] = m < SEQ ? 0 : (m < NTOK ? 1 : 2);
            const float* src = m < NTOK ? F.x + (size_t)m * DM : F.ctx + (size_t)(m - NTOK) * DM;
#pragma unroll
            for (int j = 0; j < 4; ++j) xv[q][j] = __builtin_nontemporal_load((const f32x4*)(src + 4 * F.lane + 256 * j)); }
#pragma unroll
        for (int q = 0; q < 2; ++q)
#pragma unroll
            for (int j = 0; j < 4; ++j) s[q] += (xv[q][j].x * xv[q][j].x + xv[q][j].y * xv[q][j].y) + (xv[q][j].z * xv[q][j].z + xv[q][j].w * xv[q][j].w);
#pragma unroll
        for (int q = 0; q < 2; ++q) { const int m = m0 + q; const float rstd = 1.0f / sqrtf(wave_sum(s[q]) * (1.f / DM) + NORM_EPS);
#pragma unroll
            for (int j = 0; j < 4; ++j) { const int col = 4 * F.lane + 256 * j; const f32x4 g = *(const f32x4*)(F.norm1_g + col);
                const f32x4 sh = *(const LAS f32x4*)(ml + v[q] * 2048 + col), sc = *(const LAS f32x4*)(ml + v[q] * 2048 + 1024 + col);
                const f32x4 y = (xv[q][j] * rstd * g) * (sc + 1.0f) + sh;
                *(u32x2*)(F.XN + (size_t)m * DM + col) = (u32x2){cvtpk(y.x, y.y), cvtpk(y.z, y.w)}; } }
    }
}

__device__ __forceinline__ float lam_value(Frame& F) {
    const float a = wave_sum(F.lq1[F.lane] * F.lk1[F.lane]), b = wave_sum(F.lq2[F.lane] * F.lk2[F.lane]);
    return __expf(a) - __expf(b) + 0.2f;
}
__device__ __forceinline__ void naive_diff_attn(Frame& F) {
    const float lam = lam_value(F);
    LAS float* X = (LAS float*)(F.lds + RING_OFF);
    LAS float* SS = X + 128 * 128;
    const int q = F.tid & 127, comp = (F.tid >> 7) & 1, vh = F.tid >> 8;
    for (int it = blockIdx.x; it < BATCH * 4 * (SEQ / 128); it += F.G) {
        const int b = it >> 8, h = (it >> 6) & 3, qb = it & 63; const int row = b * SEQ + qb * 128 + q;
        float qv[64], o[64];
#pragma unroll
        for (int c8 = 0; c8 < 8; ++c8) unpack8(*(const v4u*)(F.QA + (size_t)row * 512 + h * 128 + comp * 64 + c8 * 8), qv + 8 * c8);
#pragma unroll
        for (int e = 0; e < 64; ++e) o[e] = 0.f;
        float m = -1e30f, l = 0.f;
        const bf16* kp = F.KA + (size_t)(b * KVLEN) * 512 + h * 128 + comp * 64; const bf16* vp = F.VA + (size_t)(b * KVLEN) * 512 + h * 128 + vh * 64;
        for (int key = 0; key < KVLEN; ++key) {
            float s = 0.f;
#pragma unroll
            for (int c8 = 0; c8 < 8; ++c8) { float kf[8]; unpack8(*(const v4u*)(kp + (size_t)key * 512 + c8 * 8), kf);
#pragma unroll
                for (int i = 0; i < 8; ++i) s += qv[8 * c8 + i] * kf[i]; }
            if (s > m) { const float a = exp2f(m - s); l *= a;
#pragma unroll
                for (int e = 0; e < 64; ++e) o[e] *= a;
                m = s; }
            const float p = exp2f(s - m); l += p;
#pragma unroll
            for (int c8 = 0; c8 < 8; ++c8) { float vf[8]; unpack8(*(const v4u*)(vp + (size_t)key * 512 + c8 * 8), vf);
#pragma unroll
                for (int i = 0; i < 8; ++i) o[8 * c8 + i] += p * vf[i]; }
        }
        const float inv = 1.0f / l;
        __syncthreads();
        if (comp == 1) {
#pragma unroll
            for (int e = 0; e < 64; ++e) X[(vh * 64 + e) * 128 + q] = lam * o[e] * inv; }
        __syncthreads();
        if (comp == 0) { float ss = 0.f;
#pragma unroll
            for (int e = 0; e < 64; ++e) { o[e] = o[e] * inv - X[(vh * 64 + e) * 128 + q]; ss += o[e] * o[e]; }
            SS[vh * 128 + q] = ss; }
        __syncthreads();
        if (comp == 0) { const float r = 0.8f / sqrtf((SS[q] + SS[128 + q]) * (1.f / 128.f) + NORM_EPS);
            bf16* yp = F.Y + (size_t)row * DM + h * 128 + vh * 64; const float* sg = F.subln_g + vh * 64;
#pragma unroll
            for (int c8 = 0; c8 < 8; ++c8) { v4u w; w.x = cvtpk(o[8 * c8] * r * sg[8 * c8], o[8 * c8 + 1] * r * sg[8 * c8 + 1]); w.y = cvtpk(o[8 * c8 + 2] * r * sg[8 * c8 + 2], o[8 * c8 + 3] * r * sg[8 * c8 + 3]);
                w.z = cvtpk(o[8 * c8 + 4] * r * sg[8 * c8 + 4], o[8 * c8 + 5] * r * sg[8 * c8 + 5]); w.w = cvtpk(o[8 * c8 + 6] * r * sg[8 * c8 + 6], o[8 * c8 + 7] * r * sg[8 * c8 + 7]);
                *(v4u*)(yp + 8 * c8) = w; } }
    }
}
__device__ __forceinline__ void naive_win_attn(Frame& F) {
    for (int it = blockIdx.x; it < BATCH * 8 * (SEQ / 512); it += F.G) {
        const int b = it >> 7, h = (it >> 4) & 7, t = (it & 15) * 512 + F.tid, kv = h >> 2; const int row = b * SEQ + t;
        float qv[64], o[64];
#pragma unroll
        for (int c8 = 0; c8 < 8; ++c8) unpack8(*(const v4u*)(F.QB + (size_t)row * 512 + h * 64 + c8 * 8), qv + 8 * c8);
#pragma unroll
        for (int e = 0; e < 64; ++e) o[e] = 0.f;
        float m = F.sink[h] * LOG2E, l = 1.0f;
        const bf16* kp = F.KB + (size_t)(b * KVLEN) * 128 + kv * 64; const bf16* vp = F.VB + (size_t)(b * KVLEN) * 128 + kv * 64;
        for (int jj = 0; jj < 257 + CTXL; ++jj) {
            const int key = jj < 257 ? t - 128 + jj : SEQ + (jj - 257);
            if (jj < 257 && (key < 0 || key >= SEQ)) continue;
            float s = 0.f;
#pragma unroll
            for (int c8 = 0; c8 < 8; ++c8) { float kf[8]; unpack8(*(const v4u*)(kp + (size_t)key * 128 + c8 * 8), kf);
#pragma unroll
                for (int i = 0; i < 8; ++i) s += qv[8 * c8 + i] * kf[i]; }
            if (s > m) { const float a = exp2f(m - s); l *= a;
#pragma unroll
                for (int e = 0; e < 64; ++e) o[e] *= a;
                m = s; }
            const float p = exp2f(s - m); l += p;
#pragma unroll
            for (int c8 = 0; c8 < 8; ++c8) { float vf[8]; unpack8(*(const v4u*)(vp + (size_t)key * 128 + c8 * 8), vf);
#pragma unroll
                for (int i = 0; i < 8; ++i) o[8 * c8 + i] += p * vf[i]; }
        }
        const float inv = 1.0f / l; bf16* yp = F.Y + (size_t)row * DM + 512 + h * 64;
#pragma unroll
        for (int c8 = 0; c8 < 8; ++c8) { v4u w; w.x = cvtpk(o[8 * c8] * inv, o[8 * c8 + 1] * inv); w.y = cvtpk(o[8 * c8 + 2] * inv, o[8 * c8 + 3] * inv); w.z = cvtpk(o[8 * c8 + 4] * inv, o[8 * c8 + 5] * inv); w.w = cvtpk(o[8 * c8 + 6] * inv, o[8 * c8 + 7] * inv);
            *(v4u*)(yp + 8 * c8) = w; }
    }
}

#ifndef ATT_PP
#define ATT_PP 3
#endif
constexpr size_t WIN_VT_OFF = 16u << 20;
__device__ __forceinline__ void vt_item(const unsigned char* src, int rstride, unsigned char* drow0, int tile, int dg, int half) {
        unsigned outw[4][8];
#pragma unroll
        for (int i8 = 0; i8 < 8; ++i8) { const int kg = 8 * half + i8;
            const unsigned w0 = *(const unsigned*)(src + (size_t)(4 * kg + 0) * rstride), w1 = *(const unsigned*)(src + (size_t)(4 * kg + 1) * rstride), w2 = *(const unsigned*)(src + (size_t)(4 * kg + 2) * rstride), w3 = *(const unsigned*)(src + (size_t)(4 * kg + 3) * rstride);
            const unsigned a01 = __builtin_amdgcn_perm(w1, w0, 0x05010400u), c01 = __builtin_amdgcn_perm(w1, w0, 0x07030602u);
            const unsigned a23 = __builtin_amdgcn_perm(w3, w2, 0x05010400u), c23 = __builtin_amdgcn_perm(w3, w2, 0x07030602u);
            const int slot = ((i8 >> 1) & 3) + 4 * (i8 & 1);
            outw[0][slot] = __builtin_amdgcn_perm(a23, a01, 0x05040100u); outw[1][slot] = __builtin_amdgcn_perm(a23, a01, 0x07060302u);
            outw[2][slot] = __builtin_amdgcn_perm(c23, c01, 0x05040100u); outw[3][slot] = __builtin_amdgcn_perm(c23, c01, 0x07060302u); }
#pragma unroll
        for (int i = 0; i < 4; ++i) { unsigned char* dst = drow0 + (size_t)i * KVLEN + tile * 64 + 16 * half;
            *(v4u*)dst = (v4u){outw[i][0], outw[i][1], outw[i][2], outw[i][3]}; *(v4u*)(dst + 32) = (v4u){outw[i][4], outw[i][5], outw[i][6], outw[i][7]}; }
}
__device__ __forceinline__ void p3_vt_pass(Frame& F) {
    const unsigned char* V8 = (const unsigned char*)F.VA; unsigned char* VT8 = (unsigned char*)F.XG;
    const unsigned char* VB8 = (const unsigned char*)F.VB; unsigned char* VBT8 = (unsigned char*)F.XG + WIN_VT_OFF;
    const int gw = F.vcu * NWAVES + F.wave, NGW = F.G * NWAVES, dg = F.lane & 31, half = F.lane >> 5;
    constexpr int NTL = KVLEN / 64;
    for (int it = gw; it < 10 * NTL; it += NGW) {
        if (it < 8 * NTL) { const int bh = it / NTL, tile = it % NTL, b = bh >> 2, h = bh & 3;
            vt_item(V8 + ((size_t)(b * KVLEN + tile * 64)) * 512 + h * 128 + 4 * dg, 512, VT8 + ((size_t)(bh * 128 + 4 * dg)) * KVLEN, tile, dg, half); }
        else { const int b = (it - 8 * NTL) / NTL, tile = it % NTL;
            vt_item(VB8 + ((size_t)(b * KVLEN + tile * 64)) * 128 + 4 * dg, 128, VBT8 + ((size_t)(b * 128 + 4 * dg)) * KVLEN, tile, dg, half); }
    }
}
__device__ __forceinline__ void diff_unit(Frame& F, int b, int h, int qb, float lam) {
    using namespace at2;
    const int wid = F.wave, lane = F.lane, r32 = lane & 31, hi = lane >> 5, qblk = wid >> 1, comp = wid & 1;
    const int row0 = b * SEQ + qb * 128 + qblk * 32;
    UnitArgs8 a; a.Q = (const unsigned char*)F.QA + (size_t)row0 * 512 + h * 128 + comp * 64;
    a.K = (const unsigned char*)F.KA + (size_t)(b * KVLEN) * 512 + h * 128; a.VT = (const unsigned char*)F.XG + (size_t)((b * 4 + h) * 128) * KVLEN; a.comp = comp; a.ldk = 512; a.vdoff = 0; a.q0 = 0; a.ks = 0;
    f32x16 o[4]; o[0] = f32x16{}; o[1] = f32x16{}; o[2] = f32x16{}; o[3] = f32x16{};
    float m; f32x16 ol = f32x16{};
    AT_LAS char* lds = (AT_LAS char*)F.lds;
    attn_tiles_f8<true>(a, lds, F.tid, wid, lane, o, ol, m);
    float rli[16];
#pragma unroll
    for (int r = 0; r < 16; ++r) rli[r] = __builtin_amdgcn_rcpf(ol[r]);
    __syncthreads();
    AT_LAS float* XD = (AT_LAS float*)lds + qblk * 32 * XROW;
    if (comp == 1) {
#pragma unroll
        for (int r = 0; r < 16; ++r)
#pragma unroll
            for (int d0 = 0; d0 < 4; ++d0) XD[crow(r, hi) * XROW + d0 * 32 + r32] = lam * (o[d0][r] * rli[r]); }
    __syncthreads();
    if (comp == 0) {
#pragma unroll
        for (int r = 0; r < 16; ++r)
#pragma unroll
            for (int d0 = 0; d0 < 4; ++d0) { const int idx = crow(r, hi) * XROW + d0 * 32 + r32; XD[idx] = o[d0][r] * rli[r] - XD[idx]; }
        asm volatile("s_waitcnt lgkmcnt(0)" ::: "memory");
        const int row = lane >> 1, half = lane & 1;
        f32x4 v[16]; float ss = 0.f;
#pragma unroll
        for (int i = 0; i < 16; ++i) { v[i] = *(const AT_LAS f32x4*)(XD + row * XROW + half * 64 + 4 * i); ss += (v[i].x * v[i].x + v[i].y * v[i].y) + (v[i].z * v[i].z + v[i].w * v[i].w); }
        ss += __shfl_xor(ss, 1);
        const float rs = 0.8f / sqrtf(ss * (1.f / 128.f) + NORM_EPS);
        bf16* yp = F.Y + (size_t)(row0 + row) * DM + h * 128 + half * 64; const float* sg = F.subln_g + half * 64;
#pragma unroll
        for (int c8 = 0; c8 < 8; ++c8) { const f32x4 g0 = *(const f32x4*)(sg + 8 * c8), g1 = *(const f32x4*)(sg + 8 * c8 + 4); const f32x4 x0 = v[2 * c8] * rs * g0, x1 = v[2 * c8 + 1] * rs * g1;
            v4u w; w.x = cvtpk(x0.x, x0.y); w.y = cvtpk(x0.z, x0.w); w.z = cvtpk(x1.x, x1.y); w.w = cvtpk(x1.z, x1.w); *(v4u*)(yp + 8 * c8) = w; }
    }
    __syncthreads();
}
__device__ __forceinline__ void win_unit(Frame& F, int b, int j32) {
    using namespace at2;
    const int wid = F.wave, lane = F.lane, r32 = lane & 31, hi = lane >> 5, h = wid, kv = h >> 2;
    const int t0 = 32 * j32, row0 = b * SEQ + t0;
    UnitArgs8 a; a.Q = (const unsigned char*)F.QB + (size_t)row0 * 512 + h * 64;
    a.K = (const unsigned char*)F.KB + (size_t)(b * KVLEN) * 128; a.VT = (const unsigned char*)F.XG + WIN_VT_OFF + (size_t)(b * 128) * KVLEN; a.comp = kv; a.ldk = 128; a.vdoff = kv * 4096; a.q0 = t0;
    { const int st = t0 - 128; int ks = st < 0 ? 0 : (st & ~63); if (ks > SEQ - 384) ks = SEQ - 384; a.ks = ks; }
    f32x16 o[2]; o[0] = f32x16{}; o[1] = f32x16{};
    float m; f32x16 ol = f32x16{};
    AT_LAS char* lds = (AT_LAS char*)F.lds;
    attn_tiles_f8<false>(a, lds, F.tid, wid, lane, o, ol, m);
    AT_LAS float* li_l = (AT_LAS float*)(lds + AT_WS3_OFF) + wid * 64;
    if (hi == 0) li_l[r32] = __builtin_amdgcn_exp2f(F.sink[h] * LOG2E - m);
    asm volatile("s_waitcnt lgkmcnt(0)" ::: "memory");
    float rli[16];
#pragma unroll
    for (int r = 0; r < 16; ++r) rli[r] = __builtin_amdgcn_rcpf(ol[r] + li_l[crow(r, hi)]);
    __syncthreads();
    AT_LAS float* XD = (AT_LAS float*)lds + wid * 32 * XROWW;
#pragma unroll
    for (int r = 0; r < 16; ++r)
#pragma unroll
        for (int d0 = 0; d0 < 2; ++d0) XD[crow(r, hi) * XROWW + d0 * 32 + r32] = o[d0][r] * rli[r];
    asm volatile("s_waitcnt lgkmcnt(0)" ::: "memory");
    const int row = lane >> 1, half = lane & 1;
    bf16* yp = F.Y + (size_t)(row0 + row) * DM + 512 + h * 64 + half * 32;
#pragma unroll
    for (int c8 = 0; c8 < 4; ++c8) { const f32x4 x0 = *(const AT_LAS f32x4*)(XD + row * XROWW + half * 32 + 8 * c8), x1 = *(const AT_LAS f32x4*)(XD + row * XROWW + half * 32 + 8 * c8 + 4);
        v4u w; w.x = cvtpk(x0.x, x0.y); w.y = cvtpk(x0.z, x0.w); w.z = cvtpk(x1.x, x1.y); w.w = cvtpk(x1.z, x1.w); *(v4u*)(yp + 8 * c8) = w; }
    __syncthreads();
}
__device__ __forceinline__ void p3_attention(Frame& F) {
    const float lam = lam_value(F);
#ifndef NO_DIFF
#pragma unroll 1
    for (int U = F.vcu * 2; U < BATCH * 4 * (SEQ / 128) * RP(F, 3); U += 2 * F.G)
#pragma unroll 1
        for (int i = 0; i < 2; ++i) { const int u = (U + i) % 512; diff_unit(F, u >> 8, (u >> 6) & 3, u & 63, lam); }
#endif
#ifndef NO_WIN
#pragma unroll 1
    for (int W = F.vcu * 2; W < BATCH * (SEQ / 32) * RP(F, 3); W += 2 * F.G)
#pragma unroll 1
        for (int i = 0; i < 2; ++i) { const int w = (W + i) % 512; win_unit(F, w >> 8, w & 255); }
#endif
}

__device__ __forceinline__ unsigned long long wave_max64(unsigned long long k) {
#pragma unroll
    for (int o = 1; o < 64; o <<= 1) { const unsigned lo = __shfl_xor((unsigned)k, o), hi = __shfl_xor((unsigned)(k >> 32), o); const unsigned long long t = ((unsigned long long)hi << 32) | lo; k = t > k ? t : k; }
    return k;
}
__device__ __forceinline__ void p5a_route(Frame& F) {
    const int npass = RP(F, 5);
    LAS float* WRT = (LAS float*)(F.lds + RING_OFF);
    LAS int* lcnt = (LAS int*)(F.lds + XTRA_OFF); LAS int* lbase = lcnt + 32; LAS int* le = lcnt + 64; LAS int* lrk = le + 256;
    for (int idx = F.tid; idx < 32768; idx += 512) { const int k = idx >> 5, e = idx & 31; WRT[e * 1024 + (k ^ ((e & 15) << 2))] = F.w_router[idx]; }
    gu32* gcnt = F.ctl + CW_CNT;
    typedef unsigned u32x2 __attribute__((ext_vector_type(2)));
    for (int cc = blockIdx.x; cc < (NTOK / 64) * npass; cc += F.G) { const int chunk = cc % (NTOK / 64); const bool dry = cc < (NTOK / 64) * (npass - 1);
        if (F.tid < 32) lcnt[F.tid] = 0;
        __syncthreads();
        const int b = (chunk * 64) >> 13; const float* mv = F.modv + b * 6144;
#pragma unroll 1
        for (int grp = 0; grp < 2; ++grp) {
            const int row0 = chunk * 64 + F.wave * 8 + grp * 4;
            f32x4 xv[4][4]; float ss[4];
#pragma unroll
            for (int r = 0; r < 4; ++r) { float s = 0.f;
#pragma unroll
                for (int j = 0; j < 4; ++j) { { const u32x2 t_ = *(const u32x2*)((const bf16*)F.X1 + (size_t)(row0 + r) * DM + 4 * F.lane + 256 * j); xv[r][j] = (f32x4){bflo(t_.x), bfhi(t_.x), bflo(t_.y), bfhi(t_.y)}; } s += (xv[r][j].x * xv[r][j].x + xv[r][j].y * xv[r][j].y) + (xv[r][j].z * xv[r][j].z + xv[r][j].w * xv[r][j].w); }
                ss[r] = 1.0f / sqrtf(wave_sum(s) * (1.f / DM) + NORM_EPS); }
#pragma unroll
            for (int j = 0; j < 4; ++j) { const int col = 4 * F.lane + 256 * j; const f32x4 g = *(const f32x4*)(F.norm2_g + col), sh = *(const f32x4*)(mv + 3072 + col), sc = *(const f32x4*)(mv + 4096 + col);
                const f32x4 ga = g * (sc + 1.0f);
#pragma unroll
                for (int r = 0; r < 4; ++r) { xv[r][j] = (xv[r][j] * ss[r]) * ga + sh;
                    *(unsigned*)((unsigned char*)F.XN + (size_t)(row0 + r) * DM + col) = pk4_fp8(xv[r][j].x, xv[r][j].y, xv[r][j].z, xv[r][j].w); } }
            float logit[4] = {0.f, 0.f, 0.f, 0.f};
            const bool up = (F.lane & 32) != 0, up2 = (F.lane & 16) != 0; const int myg = (F.lane >> 1) & 7;
#pragma unroll 1
            for (int g = 0; g < 8; ++g) {
                float a[4][4];
#pragma unroll
                for (int r = 0; r < 4; ++r)
#pragma unroll
                    for (int ee = 0; ee < 4; ++ee) a[r][ee] = 0.f;
                const LAS float* wg_ = WRT + g * 4096;
#pragma unroll
                for (int ee = 0; ee < 4; ++ee) { const LAS float* wb = wg_ + ee * 1024 + ((4 * F.lane) ^ (((g * 4 + ee) & 15) << 2));
#pragma unroll
                    for (int j = 0; j < 4; ++j) { const f32x4 w = *(const LAS f32x4*)(wb + 256 * j);
#pragma unroll
                        for (int r = 0; r < 4; ++r) a[r][ee] += (xv[r][j].x * w.x + xv[r][j].y * w.y) + (xv[r][j].z * w.z + xv[r][j].w * w.w); } }
#pragma unroll
                for (int r = 0; r < 4; ++r) {
                    const float v0 = (up ? a[r][2] : a[r][0]) + __shfl_xor(up ? a[r][0] : a[r][2], 32);
                    const float v1 = (up ? a[r][3] : a[r][1]) + __shfl_xor(up ? a[r][1] : a[r][3], 32);
                    float v = (up2 ? v1 : v0) + __shfl_xor(up2 ? v0 : v1, 16);
                    v += __shfl_xor(v, 1); v += __shfl_xor(v, 2); v += __shfl_xor(v, 4); v += __shfl_xor(v, 8);
                    if (myg == g) logit[r] = v;
                }
            }
            const int e = 4 * myg + (up ? 2 : 0) + (up2 ? 1 : 0);
            const float br = F.b_router[e];
#pragma unroll
            for (int r = 0; r < 4; ++r) {
                unsigned u = __float_as_uint(logit[r] + br); u = (u & 0x80000000u) ? ~u : (u | 0x80000000u);
                unsigned long long key = ((unsigned long long)u << 32) | (unsigned)(31 - e);
                int ek[4]; float vk[4];
#pragma unroll
                for (int k = 0; k < 4; ++k) { const unsigned long long mx = wave_max64(key); ek[k] = 31 - (int)(mx & 31u); unsigned uu = (unsigned)(mx >> 32); uu = (uu & 0x80000000u) ? (uu & 0x7fffffffu) : ~uu; vk[k] = __uint_as_float(uu);
                    if (e == ek[k]) key = 0ull; }
                const float p1 = __expf(vk[1] - vk[0]), p2 = __expf(vk[2] - vk[0]), p3 = __expf(vk[3] - vk[0]); const float inv = 1.0f / (1.0f + p1 + p2 + p3);
                if (F.lane < 4 && !dry) { const int k = F.lane; const int ee = k == 0 ? ek[0] : (k == 1 ? ek[1] : (k == 2 ? ek[2] : ek[3])); const float gg = (k == 0 ? 1.0f : (k == 1 ? p1 : (k == 2 ? p2 : p3))) * inv;
                    const int rl = F.wave * 8 + grp * 4 + r; const int rank = __hip_atomic_fetch_add(lcnt + ee, 1, __ATOMIC_RELAXED, __HIP_MEMORY_SCOPE_WORKGROUP);
                    le[rl * 4 + k] = ee; lrk[rl * 4 + k] = rank; F.rgate[(size_t)(row0 + r) * 4 + k] = gg; }
            }
        }
        __syncthreads();
        if (F.tid < 32 && !dry) lbase[F.tid] = (int)__hip_atomic_fetch_add(gcnt + F.tid, (unsigned)lcnt[F.tid], __ATOMIC_RELAXED, __HIP_MEMORY_SCOPE_AGENT);
        __syncthreads();
        if (F.tid < 256 && !dry) { const int row = chunk * 64 + (F.tid >> 2), k = F.tid & 3; const int ee = le[F.tid]; const int slot = lbase[ee] + lrk[F.tid]; F.re[(size_t)row * 4 + k] = ee; F.rslot[(size_t)row * 4 + k] = slot; F.elist[ee * NTOK + slot] = row; }
        __syncthreads();
    }
}
__device__ __forceinline__ int expert_tables(Frame& F, LAS int* pst, LAS int* pexp) {
    LAS int* npan = pst + 40; LAS int* cntT = pexp + 320;
    if (F.tid < 64) {
        const int e = F.lane & 31; const int cnt = (int)__hip_atomic_load(F.ctl + CW_CNT + e, __ATOMIC_RELAXED, __HIP_MEMORY_SCOPE_AGENT);
        const int np = (cnt + 255) >> 8; int incl = np;
#pragma unroll
        for (int o = 1; o < 32; o <<= 1) { const int t = __shfl_up(incl, o, 32); if (e >= o) incl += t; }
        if (F.lane < 32) { const int st = incl - np; cntT[e] = cnt; pst[e] = st * 256; for (int i = 0; i < np; ++i) pexp[st + i] = e; if (e == 31) { pst[32] = incl * 256; npan[0] = incl; } } }
    __syncthreads();
    return npan[0];
}
__device__ __forceinline__ void p5b_scatter(Frame& F) {
    LAS int* pst = (LAS int*)(F.lds + XTRA_OFF); LAS int* pexp = pst + 64;
    (void)expert_tables(F, pst, pexp);
    const int gw = F.vcu * NWAVES + F.wave, NGW = F.G * NWAVES;
    for (int rr = gw; rr < NTOK * RP(F, 6); rr += NGW) { const int row = rr % NTOK;
        const v4u a = *(const v4u*)(F.XN + (size_t)row * DM + 8 * F.lane), b = *(const v4u*)(F.XN + (size_t)row * DM + 512 + 8 * F.lane);
#pragma unroll
        for (int k = 0; k < 4; ++k) { const int e = F.re[(size_t)row * 4 + k]; const int pos = pst[e] + F.rslot[(size_t)row * 4 + k];
            if (F.lane == 0) F.rpos[(size_t)row * 4 + k] = pos;
            *(v4u*)(F.XG + (size_t)pos * DM + 8 * F.lane) = a; *(v4u*)(F.XG + (size_t)pos * DM + 512 + 8 * F.lane) = b; }
    }
}
__device__ __forceinline__ void p8_final(Frame& F) {
    LAS int* pst = (LAS int*)(F.lds + XTRA_OFF); LAS int* pexp = pst + 64;
    (void)expert_tables(F, pst, pexp);
    const int gw = F.vcu * NWAVES + F.wave, NGW = F.G * NWAVES;
    typedef unsigned u32x2 __attribute__((ext_vector_type(2)));
    for (int pp = gw; pp < (NTOK / 2) * RP(F, 9); pp += NGW) { const int row0 = (pp % (NTOK / 2)) * 2;
        const float* g2 = F.modv + (row0 >> 13) * 6144 + 5120;
        int pos[2][4]; float gt[2][4];
#pragma unroll
        for (int q = 0; q < 2; ++q)
#pragma unroll
            for (int k = 0; k < 4; ++k) { const size_t ix = (size_t)(row0 + q) * 4 + k; pos[q][k] = pst[F.re[ix]] + F.rslot[ix]; gt[q][k] = F.rgate[ix]; }
        f32x4 xv[2][4]; unsigned yv[2][4][4];
#pragma unroll
        for (int q = 0; q < 2; ++q)
#pragma unroll
            for (int j = 0; j < 4; ++j) { const int col = 4 * F.lane + 256 * j; { const u32x2 t_ = *(const u32x2*)((const bf16*)F.X1 + (size_t)(row0 + q) * DM + col); xv[q][j] = (f32x4){bflo(t_.x), bfhi(t_.x), bflo(t_.y), bfhi(t_.y)}; }
#pragma unroll
                for (int k = 0; k < 4; ++k) yv[q][j][k] = *(const unsigned*)((const unsigned char*)F.Y2 + (size_t)pos[q][k] * DM + col); }
#pragma unroll
        for (int q = 0; q < 2; ++q) { float s = 0.f;
#pragma unroll
            for (int j = 0; j < 4; ++j) { const int col = 4 * F.lane + 256 * j; f32x4 a = {0.f, 0.f, 0.f, 0.f};
#pragma unroll
                for (int k = 0; k < 4; ++k) { const unsigned y = yv[q][j][k]; const auto lo2 = __builtin_amdgcn_cvt_pk_f32_fp8((int)y, false), hi2 = __builtin_amdgcn_cvt_pk_f32_fp8((int)y, true); a += (f32x4){lo2[0], lo2[1], hi2[0], hi2[1]} * gt[q][k]; }
                xv[q][j] = xv[q][j] + *(const f32x4*)(g2 + col) * a;
                s += (xv[q][j].x * xv[q][j].x + xv[q][j].y * xv[q][j].y) + (xv[q][j].z * xv[q][j].z + xv[q][j].w * xv[q][j].w); }
            const float rstd = 1.0f / sqrtf(wave_sum(s) * (1.f / DM) + NORM_EPS);
#pragma unroll
            for (int j = 0; j < 4; ++j) { const int col = 4 * F.lane + 256 * j; __builtin_nontemporal_store(xv[q][j] * rstd * *(const f32x4*)(F.final_g + col), (f32x4*)(F.out + (size_t)(row0 + q) * DM + col)); } }
    }
}

#ifndef FAST_GEMM
#define FAST_GEMM 1
#endif
#ifndef FAST_ATTN
#define FAST_ATTN 1
#endif
constexpr int N_PHASES = 10;
struct Args { const float* in[23]; float* out; unsigned char* ws; int ph_lo, ph_hi, use_bar, pad; };
__global__ void __launch_bounds__(NWAVES * 64, 2) mk_fwd(Args args) {
    extern __shared__ __attribute__((aligned(16))) unsigned char lds[];
    Frame F;
    F.lds = (LAS unsigned char*)lds; F.MISC = (volatile LAS unsigned*)(F.lds + MISC_OFF);
    F.tid = threadIdx.x; F.lane = F.tid & 63; F.wave = __builtin_amdgcn_readfirstlane(F.tid >> 6);
    F.probe = args.pad; F.G = gridDim.x; { const int bx = blockIdx.x; F.vcu = (F.G % 8 == 0) ? (bx % 8) * (F.G / 8) + bx / 8 : bx; }
    unsigned char* ws = args.ws;
    F.ctl = (gu32*)(ws + WS_CTL);
    F.x = args.in[0]; F.c = args.in[1]; F.ctx = args.in[2]; F.c_ctx = args.in[3]; F.w_mod = args.in[4]; F.b_mod = args.in[5]; F.norm1_g = args.in[6]; F.w_in = args.in[7];
    F.lq1 = args.in[8]; F.lk1 = args.in[9]; F.lq2 = args.in[10]; F.lk2 = args.in[11]; F.subln_g = args.in[12]; F.sink = args.in[13]; F.w_out = args.in[14]; F.norm2_g = args.in[15];
    F.w_router = args.in[16]; F.b_router = args.in[17]; F.w_gu = args.in[18]; F.b_gu = args.in[19]; F.w_dn = args.in[20]; F.b_dn = args.in[21]; F.final_g = args.in[22];
    F.out = args.out;
    F.modp = (float*)(ws + WS_MODP); F.modv = (float*)(ws + WS_MODV); F.rope = (float*)(ws + WS_ROPE); F.X1 = (float*)(ws + WS_X1);
    F.elist = (int*)(ws + WS_ELIST); F.re = (int*)(ws + WS_ROUTE); F.rslot = F.re + NTOK * 4; F.rgate = (float*)(F.rslot + NTOK * 4); F.rpos = (int*)(F.rgate + NTOK * 4);
    F.Win_t = (bf16*)(ws + WS_WIN); F.Wout_t = (bf16*)(ws + WS_WOUT); F.Wgu_t = (bf16*)(ws + WS_WGU); F.Wdn_t = (bf16*)(ws + WS_WDN);
    F.XN = (bf16*)(ws + WS_XN); F.QA = (bf16*)(ws + WS_QA); F.KA = (bf16*)(ws + WS_KA); F.VA = (bf16*)(ws + WS_VA); F.QB = (bf16*)(ws + WS_QB); F.KB = (bf16*)(ws + WS_KB); F.VB = (bf16*)(ws + WS_VB);
    F.Y = (bf16*)(ws + WS_Y); F.XG = (bf16*)(ws + WS_XG); F.H = (bf16*)(ws + WS_H); F.Y2 = (bf16*)(ws + WS_Y2);
    for (int u = F.tid; u < (LDS_BYTES - LDSCTL_OFF) / 4; u += NWAVES * 64) ((LAS unsigned*)(F.lds + LDSCTL_OFF))[u] = 0u;
    __syncthreads();
#ifdef SPIN_SEAM
#define STAMP(k) do { if ((k) == SPIN_SEAM && blockIdx.x == 0 && F.tid == 0) *(volatile LAS unsigned long long*)(F.lds + XTRA_OFF + 15008) = wall_clock64(); } while (0)
    if (blockIdx.x == 0 && F.tid == 0) { const unsigned long long t_ = wall_clock64(); *(volatile LAS unsigned long long*)(F.lds + XTRA_OFF + 15000) = t_; *(volatile LAS unsigned long long*)(F.lds + XTRA_OFF + 15008) = t_; }
#else
#define STAMP(k) do {} while (0)
#endif
    XcdBarrier bar; bar.bar = (unsigned*)(F.ctl + CW_BAR); bar.x = 0; bar.st = nullptr;
    if (args.use_bar) bar = xcd_barrier_post((unsigned*)(F.ctl + CW_BAR), F.MISC + 8);
    const int lo = args.ph_lo, hi = args.ph_hi;
#ifndef PH_MASK
#define PH_MASK 0x3ff
#endif
#define IN(k) (((PH_MASK >> (k)) & 1) && lo <= (k) && (k) < hi)
#ifndef REP_MASK
#define REP_MASK 0
#endif
#define SEAM(k) do { if (IN(k) && IN((k) + 1)) { if (args.use_bar) { xcd_barrier(bar); if (args.pad & 0x10000) { xcd_barrier(bar); xcd_barrier(bar); } } } else { __syncthreads(); } } while (0)

    if (IN(0)) { p0_prologue(F); } SEAM(0); STAMP(0);
    if (IN(1)) { p1_norm(F); } SEAM(1); STAMP(1);
    if (IN(2)) {
        EpiQKV E{F.QA, F.KA, F.VA, F.QB, F.KB, F.VB, F.rope};
#if FAST_GEMM
        if (F.G == 256 && (int)blockIdx.x >= P2_GEMM_WGS) p0_tail(F);
        else {
        pg8::Gemm g{F.XN, F.Win_t, NROW, INC, DM}; RepOrder S; S.init(NROW, INC, F.G == 256 ? P2_GEMM_WGS : F.G, (int)blockIdx.x); S.rep = RP(F, 2);
        EpiQKVFast EA{F.QA, F.KA, F.VA, F.QB, F.KB, F.VB, F.rope};
        pg8::gemm_phase<EpiQKVFast, RepOrder, true, true>(F.lds + RING_OFF, g, S, EA);
        }
#else
        naive_gemm(F, F.XN, NROW / 128, INC, DM, DenseSel{F.Win_t}, E);
#endif
    } SEAM(2); STAMP(2);
#if FAST_ATTN == 1
    if (IN(3)) { p3_vt_pass(F); if (args.use_bar) xcd_barrier(bar); else __syncthreads(); STAMP(10); p3_attention(F); } SEAM(3); STAMP(3);
#else
    if (IN(3)) { naive_diff_attn(F); __syncthreads(); naive_win_attn(F); } SEAM(3); STAMP(3);
#endif
    if (IN(4)) {
        EpiOut E{F.x, F.modv, F.X1};
#if FAST_GEMM
        pg8::Gemm g{F.Y, F.Wout_t, NTOK, DM, DM}; RepOrder S; S.init(NTOK, DM, F.G, (int)blockIdx.x); S.rep = RP(F, 4);
        EpiAdapt<EpiOut, 0> EA{E};
        pg8::gemm_phase<EpiAdapt<EpiOut, 0>, RepOrder, true, true>(F.lds + RING_OFF, g, S, EA);
#else
        naive_gemm(F, F.Y, NTOK / 128, DM, DM, DenseSel{F.Wout_t}, E);
#endif
    } SEAM(4); STAMP(4);
    if (IN(5)) { p5a_route(F); } SEAM(5); STAMP(5);
    if (IN(7)) {
        LAS int* pst = (LAS int*)(F.lds + XTRA_OFF); LAS int* pexp = pst + 64; LAS int* cntT = pexp + 320; LAS int* tokT = (LAS int*)(F.lds + XTRA_OFF + 2048);
        const int NP = expert_tables(F, pst, pexp);
        EpiGU E{(unsigned char*)F.H, F.b_gu};
        GroupedOrder S{GUW / 256, NP, F.G, (int)blockIdx.x, pexp, RP(F, 7), tokT};
        { const int R = S.rounds();
          GroupedOrder S1 = S; S1.rep = 1; const int r = F.tid & 255; int tv[5];
#pragma unroll
          for (int q = 0; q < 5; ++q) { const int i = 2 * q + (F.tid >> 8); pg8::Unit u; tv[q] = -1;
              if (i < R && S1.next(i, u)) { const int e = pexp[u.pm], sl = u.pm * 256 - pst[e] + r; tv[q] = sl < cntT[e] ? F.elist[e * NTOK + sl] : 0; } }
#pragma unroll
          for (int q = 0; q < 5; ++q) { const int i = 2 * q + (F.tid >> 8); if (tv[q] >= 0) tokT[i * 256 + r] = tv[q]; }
          __syncthreads(); }
#if FAST_GEMM
        pg8::Gemm g{F.XN, F.Wgu_t, NP * 256, GUW, DM / 2};
        EpiAdapt<EpiGU, GUW / 256> EA{E};
        pg8::gemm_phase<EpiAdapt<EpiGU, GUW / 256>, GroupedOrder, true, true, true, true>(F.lds + RING_OFF, g, S, EA);
#else
#error "the naive GEMM path has no gather"
#endif
    } SEAM(7); STAMP(7);
    if (IN(8)) {
        LAS int* pst = (LAS int*)(F.lds + XTRA_OFF); LAS int* pexp = pst + 64;
        const int NP = expert_tables(F, pst, pexp);
        EpiDN E{F.Y2, F.b_dn};
#if FAST_GEMM
        pg8::Gemm g{F.H, F.Wdn_t, NP * 256, DM, DM / 2}; GroupedOrder S{DM / 256, NP, F.G, (int)blockIdx.x, pexp, RP(F, 8), nullptr};
        EpiAdaptP<EpiDN, DM / 256> EA{E};
        pg8::gemm_phase<EpiAdaptP<EpiDN, DM / 256>, GroupedOrder, true, true, false, true>(F.lds + RING_OFF, g, S, EA);
#else
        naive_gemm(F, F.H, NP * 2, DM, DM, GroupSel{F.Wdn_t, pexp, DM, DM}, E);
#endif
    } SEAM(8); STAMP(8);
    if (IN(9)) { p8_final(F); }
#ifdef SPIN_SEAM
    if (blockIdx.x == 0 && F.tid == 0) { const unsigned long long t0_ = *(volatile LAS unsigned long long*)(F.lds + XTRA_OFF + 15000), tk_ = *(volatile LAS unsigned long long*)(F.lds + XTRA_OFF + 15008);
        const unsigned long long te_ = wall_clock64(); while (wall_clock64() - te_ < tk_ - t0_) __builtin_amdgcn_s_sleep(8); }
#endif
#undef STAMP
#undef IN
#undef SEAM
}

#ifndef N_LAUNCH_MODE
#define N_LAUNCH_MODE 0
#endif
extern "C" void kernel_launch(void* const* d_in, const int* in_sizes, int n_in, void* d_out, int out_size, void* d_ws, size_t ws_size, hipStream_t stream) {
    static int grid = 0;
    if (grid == 0) {
        if (n_in != 23 || in_sizes[0] != NTOK * DM || out_size != NTOK * DM || ws_size < WS_END) { fprintf(stderr, "kernel_launch: unexpected shapes (n_in %d, in0 %d, out %d, ws %zu); nothing launched\n", n_in, n_in > 0 ? in_sizes[0] : -1, out_size, ws_size); grid = -1; return; }
        int dev = 0, cus = 0, per_cu = 0;
        if (hipGetDevice(&dev) != hipSuccess || hipDeviceGetAttribute(&cus, hipDeviceAttributeMultiprocessorCount, dev) != hipSuccess) { grid = -1; return; }
        if (hipFuncSetAttribute((const void*)mk_fwd, hipFuncAttributeMaxDynamicSharedMemorySize, LDS_BYTES) != hipSuccess) { fprintf(stderr, "kernel_launch: hipFuncSetAttribute failed\n"); grid = -1; return; }
        if (hipOccupancyMaxActiveBlocksPerMultiprocessor(&per_cu, (const void*)mk_fwd, NWAVES * 64, LDS_BYTES) != hipSuccess || per_cu < 1) fprintf(stderr, "kernel_launch: note: occupancy query reports %d\n", per_cu);
        (void)hipGetLastError();
        grid = cus;
    }
    if (grid < 0) return;
    if (hipMemsetAsync((char*)d_ws + WS_CTL, 0, CTL_ZERO_BYTES, stream) != hipSuccess) { fprintf(stderr, "kernel_launch: memset failed\n"); return; }
    Args a{};
    for (int i = 0; i < 23; ++i) a.in[i] = (const float*)d_in[i];
    a.out = (float*)d_out; a.ws = (unsigned char*)d_ws; a.pad = REP_MASK;
#if N_LAUNCH_MODE == 0
    a.ph_lo = 0; a.ph_hi = N_PHASES; a.use_bar = 1;
    hipLaunchKernelGGL(mk_fwd, dim3(grid), dim3(NWAVES * 64), LDS_BYTES, stream, a);
#else
    for (int p = 0; p < N_PHASES; ++p) { a.ph_lo = p; a.ph_hi = p + 1; a.use_bar = 0; hipLaunchKernelGGL(mk_fwd, dim3(grid), dim3(NWAVES * 64), LDS_BYTES, stream, a); }
#endif
}
```

```cpp
#include <hip/hip_runtime.h>
#include <cstdio>
#include <cstdint>
namespace pg8 {
#define PG8_LAS __attribute__((address_space(3)))
typedef unsigned short bf16_t;
typedef short bf16x8 __attribute__((ext_vector_type(8)));
typedef float f32x4 __attribute__((ext_vector_type(4)));
typedef unsigned u32x4 __attribute__((ext_vector_type(4)));
constexpr int BM = 256, BK = 64, HALF = 128, HTB = HALF * BK * 2  , STAGE_BYTES = 8 * HTB, NXCD = 8, WGM = 8;

__host__ __device__ __forceinline__ int lds_byte(int r, int c) { const int st = (r >> 4) * 2 + (c >> 5), rr = r & 15, cc = c & 31, ob = rr * 64 + cc * 2; return st * 1024 + (ob ^ (((ob >> 9) & 1) << 5)); }
__host__ __device__ __forceinline__ void stage_rc(int b, int& R, int& C) { const int st = b / 1024, sb = b % 1024, swz = sb ^ (((sb >> 9) & 1) << 5); R = (st >> 1) * 16 + swz / 64; C = (st & 1) * 32 + (swz % 64) / 2; }
__host__ __device__ __forceinline__ int perm32(int rho) { const int n = rho >> 4, i = rho & 15; return 8 * (i >> 2) + 4 * n + (i & 3); }

struct Unit { int pm, pn; };
struct Gemm { const bf16_t* A; const bf16_t* Bt; int M, N, K; };

struct StaticOrder {
    int nM, nN, nwg, G, c;
    __host__ __device__ void init(int M, int N, int G_, int c_) { nM = M / BM; nN = N / BM; nwg = nM * nN; G = G_; c = c_; }
    __host__ __device__ bool next(int i, Unit& u) const {
        const long L = (long)i * G + c; if (L >= nwg) return false;
        int wgid = (int)L; { const int q = nwg / NXCD, r = nwg % NXCD, xcd = wgid % NXCD, off = wgid / NXCD; wgid = (xcd < r ? xcd * (q + 1) : r * (q + 1) + (xcd - r) * q) + off; }
        const int nig = WGM * nN, gid = wgid / nig, fm = gid * WGM, gsz = (nM - fm) < WGM ? (nM - fm) : WGM;
        u.pm = fm + ((wgid % nig) % gsz); u.pn = (wgid % nig) / gsz; return true;
    }
    __device__ __forceinline__ void a_ready(const Unit&) const {}
    __device__ __forceinline__ void done(const Unit&) const {}
};

__device__ __forceinline__ unsigned cvt_pk_bf16(float lo, float hi) { unsigned r; asm volatile("v_cvt_pk_bf16_f32 %0, %1, %2" : "=v"(r) : "v"(lo), "v"(hi)); return r; }
typedef float f32x2 __attribute__((ext_vector_type(2)));
typedef int i32x4 __attribute__((ext_vector_type(4))); typedef int i32x8 __attribute__((ext_vector_type(8)));
__device__ __forceinline__ i32x8 cat8(bf16x8 a, bf16x8 b) { const i32x4 x = __builtin_bit_cast(i32x4, a), y = __builtin_bit_cast(i32x4, b); return __builtin_shufflevector(x, y, 0, 1, 2, 3, 4, 5, 6, 7); }
template <class Epi, class Sched, bool ALIGN_EPI = false, bool SP2 = false, bool GATHER = false, bool FP8 = false>
__device__ __forceinline__ void gemm_phase(PG8_LAS unsigned char* lds, const Gemm g, const Sched& S, const Epi& E) {
    const int tid = threadIdx.x, wid = __builtin_amdgcn_readfirstlane(tid >> 6), lane = tid & 63, wr = wid >> 2, wc = wid & 3, fr = lane & 15, fq = lane >> 4;
    const int K = g.K, nt = K / BK;
    unsigned voffA[2], voffB[2]; int RA[2]; unsigned CA2[2];
#pragma unroll
    for (int i = 0; i < 2; ++i) { int R, C; stage_rc(tid * 16 + i * 8192, R, C); const int Rb = Epi::PERM ? ((R & ~31) + perm32(R & 31)) : R;
        voffA[i] = (unsigned)(R * K + C) * 2u; voffB[i] = (unsigned)(Rb * K + C) * 2u; RA[i] = R; CA2[i] = (unsigned)C * 2u; }
    static_assert(!GATHER || SP2, "GATHER is wired into the SP2 loop only");
    unsigned gA[2][2], gN[2][2];
    const size_t kstep = (size_t)(BK * 2);
    const size_t hstep = (size_t)HALF * K * 2;
    const size_t tstep = 2 * hstep;
    const unsigned ldsw = (unsigned)wid * 1024u;
    const int aoff = lds_byte(wr * 64 + fr, fq * 8), boff = lds_byte(wc * 32 + fr, fq * 8);
#define PG8_SA(b, h) (((b) * 2 + (h)) * HTB)
#define PG8_SB(b, h) ((4 + (b) * 2 + (h)) * HTB)
#define PG8_STAGE(bufoff, gbase, voff) do { _Pragma("unroll") for (int _i = 0; _i < 2; ++_i) \
        __builtin_amdgcn_global_load_lds((const unsigned*)((const char*)(gbase) + (voff)[_i]), (PG8_LAS unsigned*)(lds + (bufoff) + ldsw + _i * 8192), 16, 0, 0); } while (0)
#define PG8_STAGEG(bufoff, kbytes, v0, v1) do { \
        __builtin_amdgcn_global_load_lds((const unsigned*)((const char*)g.A + (kbytes) + (v0)), (PG8_LAS unsigned*)(lds + (bufoff) + ldsw), 16, 0, 0); \
        __builtin_amdgcn_global_load_lds((const unsigned*)((const char*)g.A + (kbytes) + (v1)), (PG8_LAS unsigned*)(lds + (bufoff) + ldsw + 8192), 16, 0, 0); } while (0)
#define PG8_GOFF(dst, ui_) do { _Pragma("unroll") for (int h_ = 0; h_ < 2; ++h_) _Pragma("unroll") for (int i_ = 0; i_ < 2; ++i_) dst[h_][i_] = (unsigned)S.tok((ui_), h_ * HALF + RA[i_]) * (unsigned)(K * 2) + CA2[i_]; } while (0)
#define PG8_LDA(dst, b, h) do { _Pragma("unroll") for (int m = 0; m < 4; ++m) _Pragma("unroll") for (int k = 0; k < 2; ++k) dst[m][k] = *(const PG8_LAS bf16x8*)(lds + PG8_SA(b, h) + aoff + m * 2048 + k * 1024); } while (0)
#define PG8_LDB(dst, b, h) do { _Pragma("unroll") for (int n = 0; n < 2; ++n) _Pragma("unroll") for (int k = 0; k < 2; ++k) dst[n][k] = *(const PG8_LAS bf16x8*)(lds + PG8_SB(b, h) + boff + n * 2048 + k * 1024); } while (0)
#define PG8_MMA(ai, bj, At, Bt) do { __builtin_amdgcn_s_setprio(1); _Pragma("unroll") for (int m = 0; m < 4; ++m) _Pragma("unroll") for (int n = 0; n < 2; ++n) { \
        if constexpr (FP8) { const i32x8 a8_ = cat8(Bt[n][0], Bt[n][1]), b8_ = cat8(At[m][0], At[m][1]); \
            asm volatile("v_mfma_scale_f32_16x16x128_f8f6f4 %0, %1, %2, %0, %3, %4 op_sel_hi:[0,0,0]" : "+v"(acc[ai][bj][m][n]) : "v"(a8_), "v"(b8_), "v"(sc_w8), "v"(sc_a8)); } \
        else { _Pragma("unroll") for (int k = 0; k < 2; ++k) acc[ai][bj][m][n] = __builtin_amdgcn_mfma_f32_16x16x32_bf16(Bt[n][k], At[m][k], acc[ai][bj][m][n], 0, 0, 0); } } \
        __builtin_amdgcn_s_setprio(0); } while (0)
#define PG8_WAIT_V(n) asm volatile("s_waitcnt vmcnt(" #n ")" ::: "memory")
#define PG8_WAIT_L(n) asm volatile("s_waitcnt lgkmcnt(" #n ")" ::: "memory")
#define PG8_BAR __builtin_amdgcn_s_barrier()
#define PG8_SCHED __builtin_amdgcn_sched_barrier(0)
    int sc_w8 = 0x7A7A7A7A, sc_a8 = 0x7F7F7F7F;
    asm volatile("" : "+v"(sc_w8), "+v"(sc_a8));
    Unit cur, nxt; int ui = 0;
    if (!S.next(0, cur)) return;
    f32x4 acc[2][2][4][2];
#pragma unroll
    for (int a = 0; a < 2; ++a)
#pragma unroll
        for (int b = 0; b < 2; ++b)
#pragma unroll
            for (int m = 0; m < 4; ++m)
#pragma unroll
                for (int n = 0; n < 2; ++n) acc[a][b][m][n] = (f32x4){0.f, 0.f, 0.f, 0.f};
    bf16x8 At[4][2], B0[2][2], B1[2][2];
    const char* cA = (const char*)g.A + (size_t)cur.pm * tstep; const char* cB = (const char*)g.Bt + (size_t)cur.pn * tstep;
    S.a_ready(cur);
    if constexpr (SP2) {
        if constexpr (GATHER) { PG8_GOFF(gA, 0); }
        PG8_STAGE(PG8_SB(0, 0), cB, voffB); PG8_STAGE(PG8_SB(0, 1), cB + hstep, voffB);
        if constexpr (GATHER) { PG8_STAGEG(PG8_SA(0, 0), 0, gA[0][0], gA[0][1]); PG8_STAGEG(PG8_SA(0, 1), 0, gA[1][0], gA[1][1]); } else { PG8_STAGE(PG8_SA(0, 0), cA, voffA); PG8_STAGE(PG8_SA(0, 1), cA + hstep, voffA); }
        if (wr == 1) PG8_BAR;
        PG8_WAIT_V(2); PG8_BAR;
        PG8_STAGE(PG8_SB(1, 0), cB + kstep, voffB); if constexpr (GATHER) { PG8_STAGEG(PG8_SA(1, 0), kstep, gA[0][0], gA[0][1]); } else { PG8_STAGE(PG8_SA(1, 0), cA + kstep, voffA); } PG8_STAGE(PG8_SB(1, 1), cB + hstep + kstep, voffB);
        PG8_WAIT_V(6); PG8_BAR;
    } else {
        PG8_STAGE(PG8_SB(0, 0), cB, voffB); PG8_STAGE(PG8_SA(0, 0), cA, voffA); PG8_STAGE(PG8_SB(0, 1), cB + hstep, voffB); PG8_STAGE(PG8_SA(0, 1), cA + hstep, voffA);
        if (wr == 1) PG8_BAR;
        PG8_WAIT_V(4); PG8_BAR;
        PG8_STAGE(PG8_SB(1, 0), cB + kstep, voffB); PG8_STAGE(PG8_SA(1, 0), cA + kstep, voffA); PG8_STAGE(PG8_SB(1, 1), cB + hstep + kstep, voffB);
        PG8_WAIT_V(6); PG8_BAR;
    }
    for (;;) {
        const bool has_next = S.next(ui + 1, nxt);
        const char* nA = has_next ? (const char*)g.A + (size_t)nxt.pm * tstep : cA; const char* nB = has_next ? (const char*)g.Bt + (size_t)nxt.pn * tstep : cB;
        if constexpr (GATHER) { if (has_next) { PG8_GOFF(gN, ui + 1); } else { _Pragma("unroll") for (int h_ = 0; h_ < 2; ++h_) _Pragma("unroll") for (int i_ = 0; i_ < 2; ++i_) gN[h_][i_] = gA[h_][i_]; } }
#pragma unroll 1
        for (int t = 0; t < nt; t += 2) {
            const bool last = (t == nt - 2);
            const char* a1 = cA + (size_t)(t + 1) * kstep;
            const char* a2 = last ? nA : cA + (size_t)(t + 2) * kstep; const char* b2 = last ? nB : cB + (size_t)(t + 2) * kstep;
            const char* a3 = a2 + kstep; const char* b3 = b2 + kstep;
            if (last && has_next) S.a_ready(nxt);
            if constexpr (SP2) {
            const size_t k1_ = (size_t)(t + 1) * kstep, k2_ = last ? (size_t)0 : (size_t)(t + 2) * kstep;
            const unsigned s00_ = last ? gN[0][0] : gA[0][0], s01_ = last ? gN[0][1] : gA[0][1], s10_ = last ? gN[1][0] : gA[1][0], s11_ = last ? gN[1][1] : gA[1][1];
            PG8_LDB(B0, 0, 0); PG8_LDB(B1, 0, 1); PG8_SCHED; PG8_LDA(At, 0, 0); if constexpr (GATHER) { PG8_STAGEG(PG8_SA(1, 1), k1_, gA[1][0], gA[1][1]); } else { PG8_STAGE(PG8_SA(1, 1), a1 + hstep, voffA); }
            PG8_WAIT_V(8); PG8_WAIT_L(0); PG8_BAR; PG8_MMA(0, 0, At, B0); PG8_MMA(0, 1, At, B1); PG8_BAR; PG8_SCHED;
            PG8_LDA(At, 0, 1); PG8_STAGE(PG8_SB(0, 0), b2, voffB); PG8_STAGE(PG8_SB(0, 1), b2 + hstep, voffB); if constexpr (GATHER) { PG8_STAGEG(PG8_SA(0, 0), k2_, s00_, s01_); } else { PG8_STAGE(PG8_SA(0, 0), a2, voffA); }
            PG8_WAIT_V(8); PG8_WAIT_L(0); PG8_BAR; PG8_MMA(1, 0, At, B0); PG8_MMA(1, 1, At, B1); PG8_BAR; PG8_SCHED;
            PG8_LDB(B0, 1, 0); PG8_LDB(B1, 1, 1); PG8_SCHED; PG8_LDA(At, 1, 0); if constexpr (GATHER) { PG8_STAGEG(PG8_SA(0, 1), k2_, s10_, s11_); } else { PG8_STAGE(PG8_SA(0, 1), a2 + hstep, voffA); }
            PG8_WAIT_V(8); PG8_WAIT_L(0); PG8_BAR; PG8_MMA(0, 0, At, B0); PG8_MMA(0, 1, At, B1); PG8_BAR; PG8_SCHED;
            PG8_LDA(At, 1, 1); PG8_STAGE(PG8_SB(1, 0), b3, voffB); PG8_STAGE(PG8_SB(1, 1), b3 + hstep, voffB); if constexpr (GATHER) { PG8_STAGEG(PG8_SA(1, 0), k2_ + kstep, s00_, s01_); } else { PG8_STAGE(PG8_SA(1, 0), a3, voffA); }
            PG8_WAIT_V(8); PG8_WAIT_L(0); PG8_BAR; PG8_MMA(1, 0, At, B0); PG8_MMA(1, 1, At, B1); PG8_BAR; PG8_SCHED;
            } else {
            PG8_LDB(B0, 0, 0); PG8_SCHED; PG8_LDA(At, 0, 0); PG8_STAGE(PG8_SA(1, 1), a1 + hstep, voffA);
            PG8_WAIT_L(8); PG8_BAR; PG8_WAIT_L(0); PG8_MMA(0, 0, At, B0); PG8_BAR; PG8_SCHED;
            PG8_LDB(B1, 0, 1); PG8_STAGE(PG8_SB(0, 0), b2, voffB);
            PG8_BAR; PG8_WAIT_L(0); PG8_MMA(0, 1, At, B1); PG8_BAR;
            PG8_LDA(At, 0, 1); PG8_STAGE(PG8_SA(0, 0), a2, voffA);
            PG8_BAR; PG8_WAIT_L(0); PG8_MMA(1, 0, At, B0); PG8_BAR; PG8_SCHED;
            PG8_STAGE(PG8_SB(0, 1), b2 + hstep, voffB);
            PG8_WAIT_V(6); PG8_BAR; PG8_MMA(1, 1, At, B1); PG8_BAR;
            PG8_LDB(B0, 1, 0); PG8_SCHED; PG8_LDA(At, 1, 0); PG8_STAGE(PG8_SA(0, 1), a2 + hstep, voffA);
            PG8_WAIT_L(8); PG8_BAR; PG8_WAIT_L(0); PG8_MMA(0, 0, At, B0); PG8_BAR; PG8_SCHED;
            PG8_LDB(B1, 1, 1); PG8_STAGE(PG8_SB(1, 0), b3, voffB);
            PG8_BAR; PG8_WAIT_L(0); PG8_MMA(0, 1, At, B1); PG8_BAR;
            PG8_LDA(At, 1, 1); PG8_STAGE(PG8_SA(1, 0), a3, voffA);
            PG8_BAR; PG8_WAIT_L(0); PG8_MMA(1, 0, At, B0); PG8_BAR; PG8_SCHED;
            PG8_STAGE(PG8_SB(1, 1), b3 + hstep, voffB);
            PG8_WAIT_V(6); PG8_BAR; PG8_MMA(1, 1, At, B1); PG8_BAR;
            }
        }
        if constexpr (FP8) { asm volatile("s_nop 15\n\ts_nop 15" ::: "memory"); }
        if constexpr (ALIGN_EPI) { if (wr == 0) PG8_BAR; }
        if constexpr (!Epi::AFTER_DRAIN) { E(acc, cur, wr, wc, fr, fq); S.done(cur); }
        if (!has_next) break;
#pragma unroll
        for (int a = 0; a < 2; ++a)
#pragma unroll
            for (int b = 0; b < 2; ++b)
#pragma unroll
                for (int m = 0; m < 4; ++m)
#pragma unroll
                    for (int n = 0; n < 2; ++n) acc[a][b][m][n] = (f32x4){0.f, 0.f, 0.f, 0.f};
        cur = nxt; cA = nA; cB = nB; ++ui;
        if constexpr (GATHER) { _Pragma("unroll") for (int h_ = 0; h_ < 2; ++h_) _Pragma("unroll") for (int i_ = 0; i_ < 2; ++i_) gA[h_][i_] = gN[h_][i_]; }
        if constexpr (ALIGN_EPI) { if (wr == 1) PG8_BAR; }
    }
    PG8_WAIT_V(0);
    if constexpr (!ALIGN_EPI) { if (wr == 0) PG8_BAR; }
    PG8_BAR;
    if constexpr (Epi::AFTER_DRAIN) { E.fused(acc, cur, wr, wc, fr, fq, lds, wid, lane); S.done(cur); }
#undef PG8_SA
#undef PG8_SB
#undef PG8_STAGE
#undef PG8_STAGEG
#undef PG8_GOFF
#undef PG8_LDA
#undef PG8_LDB
#undef PG8_MMA
#undef PG8_WAIT_V
#undef PG8_WAIT_L
#undef PG8_BAR
#undef PG8_SCHED
}
}
#define GAS __attribute__((address_space(1)))
#define LAS __attribute__((address_space(3)))
typedef unsigned short bf16;
typedef unsigned v4u __attribute__((ext_vector_type(4)));
typedef float f32x4 __attribute__((ext_vector_type(4)));
typedef short bf16x8 __attribute__((ext_vector_type(8)));
typedef GAS unsigned gu32;
typedef GAS unsigned long long gu64;
#define RLX_AGENT __ATOMIC_RELAXED, __HIP_MEMORY_SCOPE_AGENT
#define LDS_WAIT() asm volatile("s_waitcnt lgkmcnt(0)" ::: "memory")
#define VM_WAIT() asm volatile("s_waitcnt vmcnt(0)" ::: "memory")
__device__ __forceinline__ unsigned long long rt() { return __builtin_amdgcn_s_memrealtime(); }
__device__ __forceinline__ unsigned f2bf(float f) { unsigned u = __builtin_bit_cast(unsigned, f); return (u + 0x7fffu + ((u >> 16) & 1u)) >> 16; }
__device__ __forceinline__ unsigned pk2(float lo, float hi) { return f2bf(lo) | (f2bf(hi) << 16); }
#define XB_TMO      128
#define XB_XCNT(j)  (256  + 64 * (j))
#define XB_XSUB(j)  (1280 + 64 * (j))
#define XB_XGEN(j)  (2304 + 64 * (j))
#define XB_TOP      3328
#define XB_TOPGEN   3392
#define XCD_BAR_WORDS 3456
#define XB_SPIN_CAP (1u << 22)

__device__ __forceinline__ unsigned xb_ld(unsigned* p)              { return __hip_atomic_load(p, __ATOMIC_RELAXED, __HIP_MEMORY_SCOPE_AGENT); }
__device__ __forceinline__ unsigned xb_add(unsigned* p, unsigned v) { return __hip_atomic_fetch_add(p, v, __ATOMIC_RELAXED, __HIP_MEMORY_SCOPE_AGENT); }
__device__ __forceinline__ unsigned xb_xcc_id() { return (unsigned)__builtin_amdgcn_s_getreg((3 << 11) | 20) & 0xFu; }
#define XB_SPIN(cond, bar) do { unsigned _sp = 0; while (cond) { __builtin_amdgcn_s_sleep(1); \
    if ((++_sp & 255u) == 0u) { if (xb_ld(&(bar)[XB_TMO])) break; if (_sp > XB_SPIN_CAP) { atomicAdd(&(bar)[XB_TMO], 1u); break; } } } } while (0)

struct XcdBarrier {
    unsigned* bar; unsigned x;
    volatile LAS unsigned* st;
};

__device__ __forceinline__ XcdBarrier xcd_barrier_post(unsigned* bar, volatile LAS unsigned* st) {
    XcdBarrier b; b.bar = bar; b.x = xb_xcc_id(); b.st = st;
    if (threadIdx.x == 0) (void)xb_add(&bar[XB_XCNT(b.x)], 1u);
    return b;
}
__device__ __forceinline__ void xcd_barrier_complete(unsigned* bar, unsigned x, unsigned& nloc, unsigned& nx) {
    const unsigned G = gridDim.x * gridDim.y * gridDim.z;
    unsigned sum, cnt, mine, sp = 0u;
    for (;;) {
        sum = 0u; cnt = 0u; mine = 0u;
#pragma unroll
        for (unsigned j = 0; j < 16; ++j) { const unsigned c = xb_ld(&bar[XB_XCNT(j)]); sum += c; cnt += (c > 0u) ? 1u : 0u; mine = (j == x) ? c : mine; }
        if (sum == G) break;
        __builtin_amdgcn_s_sleep(1);
        if ((++sp & 255u) == 0u) { if (xb_ld(&bar[XB_TMO])) break; if (sp > XB_SPIN_CAP) { atomicAdd(&bar[XB_TMO], 1u); break; } }
    }
    nloc = mine > 0u ? mine : 1u; nx = cnt > 0u ? cnt : 1u;
}

__device__ __forceinline__ void xcd_barrier(const XcdBarrier& b) {
    asm volatile("s_waitcnt vmcnt(0)" ::: "memory");
    __syncthreads();
    if (threadIdx.x == 0) {
        unsigned* bar = b.bar;
        __builtin_amdgcn_s_waitcnt(0);
        unsigned nloc = b.st[0], nx = b.st[1];
        if (nloc == 0u) { xcd_barrier_complete(bar, b.x, nloc, nx); b.st[0] = nloc; b.st[1] = nx; }
        const unsigned old = xb_add(&bar[XB_XSUB(b.x)], 1u);
        const unsigned gen = old / nloc;
        if (old + 1u == (gen + 1u) * nloc) {
            __builtin_amdgcn_fence(__ATOMIC_RELEASE, "agent");
            asm volatile("s_waitcnt vmcnt(0)" ::: "memory");
            const unsigned og = xb_add(&bar[XB_TOP], 1u);
            const unsigned tg = og / nx;
            if (og + 1u == (tg + 1u) * nx) xb_add(&bar[XB_TOPGEN], 1u);
            else XB_SPIN(xb_ld(&bar[XB_TOPGEN]) == tg, bar);
            __builtin_amdgcn_fence(__ATOMIC_ACQUIRE, "agent");
            xb_add(&bar[XB_XGEN(b.x)], 1u);
            asm volatile("s_waitcnt vmcnt(0)" ::: "memory");
        } else {
            XB_SPIN(xb_ld(&bar[XB_XGEN(b.x)]) == gen, bar);
            __builtin_amdgcn_fence(__ATOMIC_ACQUIRE, "agent");
            asm volatile("s_waitcnt vmcnt(0)" ::: "memory");
        }
    }
    __syncthreads();
}

constexpr int BATCH = 2, SEQ = 8192, DM = 1024, CTXL = 256;
constexpr int NTOK = BATCH * SEQ, NCTXR = BATCH * CTXL, NROW = NTOK + NCTXR, KVLEN = SEQ + CTXL;
constexpr int INC = 2304, NEXP = 32, TOPK = 4, GUW = 2048;
constexpr int NPAD_MAX = NTOK * TOPK + NEXP * 256;
constexpr float NORM_EPS = 1e-6f, LOG2E = 1.4426950408889634f, QSCALE = 0.125f * 1.4426950408889634f;
constexpr int NWAVES = 8;


namespace at2 {
typedef short bf16x8 __attribute__((ext_vector_type(8)));
typedef short s16x4 __attribute__((ext_vector_type(4)));
typedef float f32x16 __attribute__((ext_vector_type(16)));
typedef unsigned u32x4 __attribute__((ext_vector_type(4)));
constexpr int SHM_V = 16384, SHM_K = 16384, AT_WS_OFF = 73728, AT_WS3_OFF = 98304, XROW = 132, XROWW = 68;
constexpr int SDEPTH = 1;
constexpr float THRL = 8.0f;
#define AT_LAS __attribute__((address_space(3)))
#define KSWZ(row, colB) ((row) * 256 + ((colB) ^ (((row) & 7) << 4)))
#define SBAR() __builtin_amdgcn_sched_barrier(0)
__device__ __forceinline__ int crow(int r, int hi) { return (r & 3) + 8 * (r >> 2) + 4 * hi; }
typedef float f32x2_t __attribute__((ext_vector_type(2))); typedef __bf16 bf16x2_t __attribute__((ext_vector_type(2)));
__device__ __forceinline__ unsigned cvtpk2(float lo, float hi) { f32x2_t v = {lo, hi}; bf16x2_t b = __builtin_convertvector(v, bf16x2_t); return __builtin_bit_cast(unsigned, b); }
__device__ __forceinline__ void partialSM(f32x16& p0, f32x16& p1, float& m_reg, float& alpha) {
  float pmax = p0[0];
#pragma unroll
  for (int r = 1; r < 16; ++r) pmax = fmaxf(pmax, p0[r]);
#pragma unroll
  for (int r = 0; r < 16; ++r) pmax = fmaxf(pmax, p1[r]);
  { auto rr = __builtin_amdgcn_permlane32_swap(__float_as_uint(pmax), __float_as_uint(pmax), false, false); pmax = fmaxf(__uint_as_float(rr[0]), __uint_as_float(rr[1])); }
  float mn;
  if (__builtin_expect(__all(pmax - m_reg <= THRL), 1)) { mn = m_reg; alpha = 1.f; }
  else { mn = fmaxf(m_reg, pmax); alpha = __builtin_amdgcn_exp2f(m_reg - mn); m_reg = mn; }
#pragma unroll
  for (int r = 0; r < 16; ++r) p0[r] = p0[r] - mn;
#pragma unroll
  for (int r = 0; r < 16; ++r) p1[r] = p1[r] - mn;
#pragma unroll
  for (int r = 0; r < 16; ++r) p0[r] = __builtin_amdgcn_exp2f(p0[r]);
}
__device__ __forceinline__ void finishSM(f32x16& p0, f32x16& p1, float alpha, float& l_reg, bf16x8& pa0, bf16x8& pa1, bf16x8& pa2, bf16x8& pa3) {
#pragma unroll
  for (int r = 0; r < 16; ++r) p1[r] = __builtin_amdgcn_exp2f(p1[r]);
  float ps = 0;
#pragma unroll
  for (int r = 0; r < 16; ++r) ps += p0[r];
#pragma unroll
  for (int r = 0; r < 16; ++r) ps += p1[r];
  { auto rr = __builtin_amdgcn_permlane32_swap(__float_as_uint(ps), __float_as_uint(ps), false, false); ps = __uint_as_float(rr[0]) + __uint_as_float(rr[1]); }
  l_reg = l_reg * alpha + ps;
#define PK4(P, BASE, OUT) do { unsigned a0 = cvtpk2(P[BASE + 0], P[BASE + 1]), a1 = cvtpk2(P[BASE + 2], P[BASE + 3]);   \
    unsigned b0 = cvtpk2(P[BASE + 4], P[BASE + 5]), b1 = cvtpk2(P[BASE + 6], P[BASE + 7]);                              \
    auto r0 = __builtin_amdgcn_permlane32_swap(a0, b0, false, false); auto r1 = __builtin_amdgcn_permlane32_swap(a1, b1, false, false); \
    u32x4 w = {r0[0], r1[0], r0[1], r1[1]}; OUT = __builtin_bit_cast(bf16x8, w); } while (0)
  PK4(p0, 0, pa0); PK4(p0, 8, pa1); PK4(p1, 0, pa2); PK4(p1, 8, pa3);
#undef PK4
}
__device__ __forceinline__ void qkt(f32x16& p0, f32x16& p1, const AT_LAS char* Ks, const bf16x8* qr, int r32, int hi) {
  p0 = f32x16{}; p1 = f32x16{};
#pragma unroll
  for (int d0 = 0; d0 < 4; ++d0) { const int cb = (d0 * 16 + hi * 8) * 2;
    const bf16x8 b0 = *(const AT_LAS bf16x8*)(Ks + KSWZ(r32, cb));
    const bf16x8 b1 = *(const AT_LAS bf16x8*)(Ks + KSWZ(32 + r32, cb));
    p0 = __builtin_amdgcn_mfma_f32_32x32x16_bf16(b0, qr[d0], p0, 0, 0, 0);
    p1 = __builtin_amdgcn_mfma_f32_32x32x16_bf16(b1, qr[d0], p1, 0, 0, 0); }
}
__device__ __forceinline__ int v_st(int k, int c) { const int kk = (k & ~0xC) | ((k & 4) << 1) | ((k & 8) >> 1); return ((kk >> 3) * 4 + (c >> 5)) * 512 + ((kk & 7) * 32 + (c & 31)) * 2; }
__device__ __forceinline__ int v_rd_base(int lane) { return ((lane & 3) << 3) | (((lane >> 2) & 3) << 6) | (((lane >> 4) & 1) << 5) | (((lane >> 5) & 1) << 8); }
constexpr int v_rd_off(int d0, int ks, int half) { return d0 * 512 + ks * 4096 + half * 2048; }
template <int OFF> __device__ __forceinline__ s16x4 tr_read(int vb) { s16x4 r; asm volatile("ds_read_b64_tr_b16 %0, %1 offset:%2" : "=&v"(r) : "v"(vb), "i"(OFF) : "memory"); return r; }
template <int D0> __device__ __forceinline__ void pv_one(f32x16& od, int vb, bf16x8 pa0, bf16x8 pa1, bf16x8 pa2, bf16x8 pa3) {
  const s16x4 l0 = tr_read<v_rd_off(D0, 0, 0)>(vb), h0 = tr_read<v_rd_off(D0, 0, 1)>(vb), l1 = tr_read<v_rd_off(D0, 1, 0)>(vb), h1 = tr_read<v_rd_off(D0, 1, 1)>(vb);
  const s16x4 l2 = tr_read<v_rd_off(D0, 2, 0)>(vb), h2 = tr_read<v_rd_off(D0, 2, 1)>(vb), l3 = tr_read<v_rd_off(D0, 3, 0)>(vb), h3 = tr_read<v_rd_off(D0, 3, 1)>(vb);
  asm volatile("s_waitcnt lgkmcnt(0)" ::: "memory"); SBAR();
#define PK(L, H) (bf16x8){L[0], L[1], L[2], L[3], H[0], H[1], H[2], H[3]}
  od = __builtin_amdgcn_mfma_f32_32x32x16_bf16(pa0, PK(l0, h0), od, 0, 0, 0);
  od = __builtin_amdgcn_mfma_f32_32x32x16_bf16(pa1, PK(l1, h1), od, 0, 0, 0);
  od = __builtin_amdgcn_mfma_f32_32x32x16_bf16(pa2, PK(l2, h2), od, 0, 0, 0);
  od = __builtin_amdgcn_mfma_f32_32x32x16_bf16(pa3, PK(l3, h3), od, 0, 0, 0);
#undef PK
}
typedef short v4i16_t __attribute__((ext_vector_type(4)));
__device__ __forceinline__ s16x4 vtr(int vb, int off) { return __builtin_bit_cast(s16x4, __builtin_amdgcn_ds_read_tr16_b64_v4i16((AT_LAS v4i16_t*)(unsigned)(vb + off))); }
template <int D0> __device__ __forceinline__ void pv_one_b(f32x16& od, int vb, bf16x8 pa0, bf16x8 pa1, bf16x8 pa2, bf16x8 pa3) {
  const s16x4 l0 = vtr(vb, v_rd_off(D0, 0, 0)), h0 = vtr(vb, v_rd_off(D0, 0, 1)), l1 = vtr(vb, v_rd_off(D0, 1, 0)), h1 = vtr(vb, v_rd_off(D0, 1, 1));
  const s16x4 l2 = vtr(vb, v_rd_off(D0, 2, 0)), h2 = vtr(vb, v_rd_off(D0, 2, 1)), l3 = vtr(vb, v_rd_off(D0, 3, 0)), h3 = vtr(vb, v_rd_off(D0, 3, 1));
#define PK(L, H) (bf16x8){L[0], L[1], L[2], L[3], H[0], H[1], H[2], H[3]}
  od = __builtin_amdgcn_mfma_f32_32x32x16_bf16(pa0, PK(l0, h0), od, 0, 0, 0);
  od = __builtin_amdgcn_mfma_f32_32x32x16_bf16(pa1, PK(l1, h1), od, 0, 0, 0);
  od = __builtin_amdgcn_mfma_f32_32x32x16_bf16(pa2, PK(l2, h2), od, 0, 0, 0);
  od = __builtin_amdgcn_mfma_f32_32x32x16_bf16(pa3, PK(l3, h3), od, 0, 0, 0);
#undef PK
}
template <int NDB> __device__ __forceinline__ void pv_all_b(f32x16* o, int vb, bf16x8 pa0, bf16x8 pa1, bf16x8 pa2, bf16x8 pa3) {
  pv_one_b<0>(o[0], vb, pa0, pa1, pa2, pa3); pv_one_b<1>(o[1], vb, pa0, pa1, pa2, pa3);
  if constexpr (NDB == 4) { pv_one_b<2>(o[2], vb, pa0, pa1, pa2, pa3); pv_one_b<3>(o[3], vb, pa0, pa1, pa2, pa3); }
}
template <int NDB> __device__ __forceinline__ void pv_all(f32x16* o, int vb, bf16x8 pa0, bf16x8 pa1, bf16x8 pa2, bf16x8 pa3) {
  pv_one<0>(o[0], vb, pa0, pa1, pa2, pa3); pv_one<1>(o[1], vb, pa0, pa1, pa2, pa3);
  if constexpr (NDB == 4) { pv_one<2>(o[2], vb, pa0, pa1, pa2, pa3); pv_one<3>(o[3], vb, pa0, pa1, pa2, pa3); }
}
__device__ __forceinline__ void wmask(f32x16& p0, f32x16& p1, int k0, int q, int hi) {
#pragma unroll
  for (int r = 0; r < 16; ++r) { const int d = k0 + crow(r, hi) - q; if (d > 128 || d < -128) p0[r] = -1e30f; if (d + 32 > 128 || d + 32 < -128) p1[r] = -1e30f; }
}

struct UnitArgs {
  const bf16* Q; int ldq;
  const bf16* K; const bf16* V; int ldk;
  int kcolB;
  int vcolB;
  int q0;
  int ks;
};
template <bool DIFF> __device__ __forceinline__ int tile_k0(const UnitArgs& a, int j) { if constexpr (DIFF) return 64 * j; else return j < 4 ? SEQ + 64 * j : a.ks + 64 * (j - 4); }

#define RD128(dst, addr, OFF) asm volatile("ds_read_b128 %0, %1 offset:%2" : "=v"(dst) : "v"(addr), "i"(OFF) : "memory")
#define RDTR(dst, addr, OFF) asm volatile("ds_read_b64_tr_b16 %0, %1 offset:%2" : "=v"(dst) : "v"(addr), "i"(OFF) : "memory")
#define WAITL8_4(n, a, b, c, d) asm volatile("s_waitcnt lgkmcnt(" #n ")" : "+v"(a), "+v"(b), "+v"(c), "+v"(d) :: "memory")
#define WAITL8_8(n, a, b, c, d, e, f, g, h) asm volatile("s_waitcnt lgkmcnt(" #n ")" : "+v"(a), "+v"(b), "+v"(c), "+v"(d), "+v"(e), "+v"(f), "+v"(g), "+v"(h) :: "memory")
__device__ __forceinline__ float max3f(float a, float b, float c) { return __builtin_fmaxf(__builtin_fmaxf(a, b), c); }
__device__ __forceinline__ void softmax_seg2(f32x16& p0, f32x16& p1, float& m_reg, float& alpha, bf16x8& pa0, bf16x8& pa1, bf16x8& pa2, bf16x8& pa3) {
  float x = max3f(p0[0], p0[1], p0[2]), y = max3f(p1[0], p1[1], p1[2]);
  x = max3f(x, p0[3], p0[4]); y = max3f(y, p1[3], p1[4]); x = max3f(x, p0[5], p0[6]); y = max3f(y, p1[5], p1[6]); x = max3f(x, p0[7], p0[8]); y = max3f(y, p1[7], p1[8]);
  x = max3f(x, p0[9], p0[10]); y = max3f(y, p1[9], p1[10]); x = max3f(x, p0[11], p0[12]); y = max3f(y, p1[11], p1[12]); x = max3f(x, p0[13], p0[14]); y = max3f(y, p1[13], p1[14]);
  float pmax = max3f(x, y, p0[15]); pmax = fmaxf(pmax, p1[15]);
  { auto rr = __builtin_amdgcn_permlane32_swap(__float_as_uint(pmax), __float_as_uint(pmax), false, false); pmax = fmaxf(__uint_as_float(rr[0]), __uint_as_float(rr[1])); }
  float mn;
  if (__builtin_expect(__all(pmax - m_reg <= THRL), 1)) { mn = m_reg; alpha = 1.f; }
  else { mn = fmaxf(m_reg, pmax); alpha = __builtin_amdgcn_exp2f(m_reg - mn); m_reg = mn; }
#pragma unroll
  for (int r = 0; r < 16; ++r) { p0[r] = __builtin_amdgcn_exp2f(p0[r] - mn); p1[r] = __builtin_amdgcn_exp2f(p1[r] - mn); }
  { u32x4 w = {cvtpk2(p0[0], p0[1]), cvtpk2(p0[2], p0[3]), cvtpk2(p0[4], p0[5]), cvtpk2(p0[6], p0[7])}; pa0 = __builtin_bit_cast(bf16x8, w); }
  { u32x4 w = {cvtpk2(p0[8], p0[9]), cvtpk2(p0[10], p0[11]), cvtpk2(p0[12], p0[13]), cvtpk2(p0[14], p0[15])}; pa1 = __builtin_bit_cast(bf16x8, w); }
  { u32x4 w = {cvtpk2(p1[0], p1[1]), cvtpk2(p1[2], p1[3]), cvtpk2(p1[4], p1[5]), cvtpk2(p1[6], p1[7])}; pa2 = __builtin_bit_cast(bf16x8, w); }
  { u32x4 w = {cvtpk2(p1[8], p1[9]), cvtpk2(p1[10], p1[11]), cvtpk2(p1[12], p1[13]), cvtpk2(p1[14], p1[15])}; pa3 = __builtin_bit_cast(bf16x8, w); }
}
template <bool DIFF>
__device__ __forceinline__ void attn_tiles_pp3(const UnitArgs& a, AT_LAS char* lds, int tid, int wid, int lane, f32x16* o, f32x16& ol, float& m_out) {
  constexpr int NDB = DIFF ? 4 : 2; constexpr int NT = DIFF ? KVLEN / 64 : 10;
  const int r32 = lane & 31, hi = lane >> 5;
  AT_LAS char* V_lds = lds; AT_LAS char* K_lds = lds + 3 * SHM_V;
  AT_LAS float* al_l = (AT_LAS float*)(lds + AT_WS3_OFF) + wid * 64 + 32;
  float m_reg = -1e30f, alpha = 1.f; bf16x8 qr[4];
  const short one_ = (short)0x3F80; const bf16x8 ones = {one_, one_, one_, one_, one_, one_, one_, one_};
  const bf16* Qw = a.Q + (long)r32 * a.ldq + hi * 8;
#pragma unroll
  for (int d0 = 0; d0 < 4; ++d0) qr[d0] = *(const bf16x8*)(Qw + d0 * 16);
  int koff[2], voff[2];
#pragma unroll
  for (int i = 0; i < 2; ++i) { const int pc = 2 * wid + i;
    { const int row = 4 * pc + (lane >> 4), p = lane & 15; koff[i] = row * a.ldk + ((p ^ (row & 7)) << 3); }
    { const int s = 2 * pc + (lane >> 5), kk = (s >> 2) * 8 + ((lane & 31) >> 2); const int key = kk; voff[i] = key * a.ldk + (s & 3) * 32 + 8 * (lane & 3); } }
  const int vb0 = (int)(unsigned)(uintptr_t)V_lds + v_rd_base(lane) + a.vcolB;
  const int kb0 = (int)(unsigned)(uintptr_t)K_lds + a.kcolB + r32 * 256;
  int kad[4];
#pragma unroll
  for (int d0 = 0; d0 < 4; ++d0) kad[d0] = kb0 + (((d0 * 2 + hi) ^ (r32 & 7)) << 4);
#define DMA_K(t, slot) do { const bf16* kb_ = a.K + (long)tile_k0<DIFF>(a, (t)) * a.ldk; _Pragma("unroll") for (int i_ = 0; i_ < 2; ++i_) \
    __builtin_amdgcn_global_load_lds((const unsigned*)(kb_ + koff[i_]), (AT_LAS unsigned*)(K_lds + (slot) * SHM_K + (2 * wid + i_) * 1024), 16, 0, 0); } while (0)
#define DMA_V(t, slot) do { const bf16* vb_ = a.V + (long)tile_k0<DIFF>(a, (t)) * a.ldk; _Pragma("unroll") for (int i_ = 0; i_ < 2; ++i_) \
    __builtin_amdgcn_global_load_lds((const unsigned*)(vb_ + voff[i_]), (AT_LAS unsigned*)(V_lds + (slot) * SHM_V + (2 * wid + i_) * 1024), 16, 0, 0); } while (0)
#define BAR_MID() do { SBAR(); asm volatile("s_barrier" ::: "memory"); SBAR(); } while (0)
#define BAR_END(n) do { SBAR(); asm volatile("s_waitcnt vmcnt(" #n ")\n\ts_barrier" ::: "memory"); SBAR(); } while (0)
#define RESC2() do { if (__any(alpha < 1.f)) { if (hi == 0) al_l[r32] = alpha; asm volatile("s_waitcnt lgkmcnt(0)" ::: "memory"); \
    _Pragma("unroll") for (int r = 0; r < 16; ++r) { const float f_ = al_l[crow(r, hi)]; ol[r] *= f_; _Pragma("unroll") for (int d = 0; d < NDB; ++d) o[d][r] *= f_; } } } while (0)
#define WMASK2(t) do { if constexpr (!DIFF) { if ((t) >= 4) wmask(p0, p1, tile_k0<DIFF>(a, (t)), a.q0 + r32, hi); } } while (0)
#define VSEG(t) do { WMASK2(t); softmax_seg2(p0, p1, m_reg, alpha, pa0, pa1, pa2, pa3); RESC2(); } while (0)
#define PKV(L, H) (bf16x8){L[0], L[1], L[2], L[3], H[0], H[1], H[2], H[3]}
#define VRD8(X, D0, va) do { RDTR(X##0, va, v_rd_off(D0, 0, 0)); RDTR(X##1, va, v_rd_off(D0, 0, 1)); RDTR(X##2, va, v_rd_off(D0, 1, 0)); RDTR(X##3, va, v_rd_off(D0, 1, 1)); \
    RDTR(X##4, va, v_rd_off(D0, 2, 0)); RDTR(X##5, va, v_rd_off(D0, 2, 1)); RDTR(X##6, va, v_rd_off(D0, 3, 0)); RDTR(X##7, va, v_rd_off(D0, 3, 1)); } while (0)
#define PV4(od, X) do { od = __builtin_amdgcn_mfma_f32_32x32x16_bf16(pa0, PKV(X##0, X##1), od, 0, 0, 0); od = __builtin_amdgcn_mfma_f32_32x32x16_bf16(pa1, PKV(X##2, X##3), od, 0, 0, 0); \
    od = __builtin_amdgcn_mfma_f32_32x32x16_bf16(pa2, PKV(X##4, X##5), od, 0, 0, 0); od = __builtin_amdgcn_mfma_f32_32x32x16_bf16(pa3, PKV(X##6, X##7), od, 0, 0, 0); } while (0)
#define MSEG(DOQK, DOPV, ksl, vsl) do { \
    bf16x8 k0_, k1_, k2_, k3_; s16x4 A0, A1, A2, A3, A4, A5, A6, A7, B0, B1, B2, B3, B4, B5, B6, B7; \
    const int ko_ = (ksl) * SHM_K; const int va_ = vb0 + (vsl) * SHM_V; \
    if (DOQK) { RD128(k0_, kad[0] + ko_, 0); RD128(k1_, kad[0] + ko_, 8192); RD128(k2_, kad[1] + ko_, 0); RD128(k3_, kad[1] + ko_, 8192); \
      bf16x8 k4_, k5_, k6_, k7_; RD128(k4_, kad[2] + ko_, 0); RD128(k5_, kad[2] + ko_, 8192); RD128(k6_, kad[3] + ko_, 0); RD128(k7_, kad[3] + ko_, 8192); \
      WAITL8_4(4, k0_, k1_, k2_, k3_); SBAR(); \
      p0 = __builtin_amdgcn_mfma_f32_32x32x16_bf16(k0_, qr[0], (f32x16){}, 0, 0, 0); p1 = __builtin_amdgcn_mfma_f32_32x32x16_bf16(k1_, qr[0], (f32x16){}, 0, 0, 0); \
      p0 = __builtin_amdgcn_mfma_f32_32x32x16_bf16(k2_, qr[1], p0, 0, 0, 0); p1 = __builtin_amdgcn_mfma_f32_32x32x16_bf16(k3_, qr[1], p1, 0, 0, 0); SBAR(); \
      if (DOPV) { VRD8(A, 0, va_); WAITL8_4(8, k4_, k5_, k6_, k7_); } else { WAITL8_4(0, k4_, k5_, k6_, k7_); } SBAR(); \
      p0 = __builtin_amdgcn_mfma_f32_32x32x16_bf16(k4_, qr[2], p0, 0, 0, 0); p1 = __builtin_amdgcn_mfma_f32_32x32x16_bf16(k5_, qr[2], p1, 0, 0, 0); \
      p0 = __builtin_amdgcn_mfma_f32_32x32x16_bf16(k6_, qr[3], p0, 0, 0, 0); p1 = __builtin_amdgcn_mfma_f32_32x32x16_bf16(k7_, qr[3], p1, 0, 0, 0); SBAR(); } \
    else if (DOPV) { VRD8(A, 0, va_); } \
    if (DOPV) { VRD8(B, 1, va_); WAITL8_8(8, A0, A1, A2, A3, A4, A5, A6, A7); SBAR(); PV4(o[0], A); SBAR(); \
      if constexpr (NDB == 4) { VRD8(A, 2, va_); WAITL8_8(8, B0, B1, B2, B3, B4, B5, B6, B7); SBAR(); PV4(o[1], B); SBAR(); \
        VRD8(B, 3, va_); WAITL8_8(8, A0, A1, A2, A3, A4, A5, A6, A7); SBAR(); PV4(o[2], A); SBAR(); \
        WAITL8_8(0, B0, B1, B2, B3, B4, B5, B6, B7); SBAR(); PV4(o[3], B); SBAR(); } \
      else { WAITL8_8(0, B0, B1, B2, B3, B4, B5, B6, B7); SBAR(); PV4(o[1], B); SBAR(); } \
      ol = __builtin_amdgcn_mfma_f32_32x32x16_bf16(pa0, ones, ol, 0, 0, 0); ol = __builtin_amdgcn_mfma_f32_32x32x16_bf16(pa1, ones, ol, 0, 0, 0); \
      ol = __builtin_amdgcn_mfma_f32_32x32x16_bf16(pa2, ones, ol, 0, 0, 0); ol = __builtin_amdgcn_mfma_f32_32x32x16_bf16(pa3, ones, ol, 0, 0, 0); SBAR(); } \
  } while (0)
#define ROT3(s) ((s) == 2 ? 0 : (s) + 1)
  f32x16 p0, p1; bf16x8 pa0, pa1, pa2, pa3;
  DMA_K(0, 0); DMA_K(1, 1); DMA_V(0, 0); BAR_END(0);
  int sk = 0;
  if (wid < 4) {
    DMA_K(2, 2); DMA_V(1, 1); MSEG(true, false, 0, 0); BAR_MID(); VSEG(0); BAR_END(4);
    sk = 1;
    for (int t = 1; t <= NT - 3; ++t) { const int s1 = ROT3(sk), s2 = ROT3(s1);
      DMA_K(t + 2, s2); DMA_V(t + 1, s1); MSEG(true, true, sk, s2); BAR_MID(); VSEG(t); BAR_END(4); sk = s1; }
    { const int s1 = ROT3(sk), s2 = ROT3(s1); DMA_V(NT - 1, s1); MSEG(true, true, sk, s2); BAR_MID(); VSEG(NT - 2); BAR_END(2); sk = s1; }
    { const int s1 = ROT3(sk), s2 = ROT3(s1); MSEG(true, true, sk, s2); BAR_MID(); VSEG(NT - 1); BAR_END(0); sk = s1; }
    { const int s2 = ROT3(ROT3(sk)); MSEG(false, true, 0, s2); BAR_MID(); BAR_END(0); }
  } else {
    DMA_K(2, 2); DMA_V(1, 1); BAR_MID(); MSEG(true, false, 0, 0); BAR_END(4);
    sk = 1;
    for (int t = 1; t <= NT - 3; ++t) { const int s1 = ROT3(sk), s2 = ROT3(s1);
      DMA_K(t + 2, s2); DMA_V(t + 1, s1); VSEG(t - 1); BAR_MID(); MSEG(true, true, sk, s2); BAR_END(4); sk = s1; }
    { const int s1 = ROT3(sk), s2 = ROT3(s1); DMA_V(NT - 1, s1); VSEG(NT - 3); BAR_MID(); MSEG(true, true, sk, s2); BAR_END(2); sk = s1; }
    { const int s1 = ROT3(sk), s2 = ROT3(s1); VSEG(NT - 2); BAR_MID(); MSEG(true, true, sk, s2); BAR_END(0); sk = s1; }
    { const int s2 = ROT3(ROT3(sk)); VSEG(NT - 1); BAR_MID(); MSEG(false, true, 0, s2); BAR_END(0); }
  }
  m_out = m_reg;
#undef DMA_K
#undef DMA_V
#undef BAR_MID
#undef BAR_END
#undef RESC2
#undef WMASK2
#undef VSEG
#undef PKV
#undef VRD8
#undef PV4
#undef MSEG
#undef ROT3
}

typedef int i32x8v __attribute__((ext_vector_type(8)));
constexpr int F8_SLOT = 8192, F8_K_OFF = 0, F8_V_OFF = 3 * F8_SLOT;
#define MF8_ACC(acc, a8, b8) asm volatile("v_mfma_scale_f32_32x32x64_f8f6f4 %0, %1, %2, %0, %3, %3 op_sel_hi:[0,0,0]" : "+v"(acc) : "v"(a8), "v"(b8), "v"(sc1))
#define MF8_NEW(acc, a8, b8) asm volatile("v_mfma_scale_f32_32x32x64_f8f6f4 %0, %1, %2, 0, %3, %3 op_sel_hi:[0,0,0]" : "=&v"(acc) : "v"(a8), "v"(b8), "v"(sc1))
__device__ __forceinline__ unsigned pk4f8(float a, float b, float c, float d) { int w = 0; w = __builtin_amdgcn_cvt_pk_fp8_f32(a, b, w, false); w = __builtin_amdgcn_cvt_pk_fp8_f32(c, d, w, true); return (unsigned)w; }
struct UnitArgs8 { const unsigned char* Q; const unsigned char* K; const unsigned char* VT; int comp, ldk, vdoff, q0, ks; };
template <bool DIFF> __device__ __forceinline__ int tile8_k0(const UnitArgs8& a, int j) { if constexpr (DIFF) return 64 * j; else return j < 4 ? SEQ + 64 * j : a.ks + 64 * (j - 4); }
template <bool DIFF>
__device__ __forceinline__ void attn_tiles_f8(const UnitArgs8& a, AT_LAS char* lds, int tid, int wid, int lane, f32x16* o, f32x16& ol, float& m_out) {
  constexpr int NDB = DIFF ? 4 : 2, NT = DIFF ? KVLEN / 64 : 10;
  const int r32 = lane & 31, hi = lane >> 5;
  AT_LAS char* K_lds = lds + F8_K_OFF; AT_LAS char* V_lds = lds + F8_V_OFF;
  AT_LAS float* al_l = (AT_LAS float*)(lds + AT_WS3_OFF) + wid * 64 + 32;
  float m_reg = -1e30f, alpha = 1.f;
  int sc1 = 0x7F7F7F7F; asm volatile("" : "+v"(sc1));
  i32x8v ones8; { int o4 = 0x38383838; asm volatile("" : "+v"(o4)); ones8 = (i32x8v){o4, o4, o4, o4, o4, o4, o4, o4}; }
  i32x8v q8; { const u32x4 qa_ = *(const u32x4*)(a.Q + (long)r32 * 512 + hi * 32), qb_ = *(const u32x4*)(a.Q + (long)r32 * 512 + hi * 32 + 16);
    q8 = (i32x8v){(int)qa_.x, (int)qa_.y, (int)qa_.z, (int)qa_.w, (int)qb_.x, (int)qb_.y, (int)qb_.z, (int)qb_.w}; }
  const int kkey = 8 * wid + (lane >> 3), koff = kkey * a.ldk + (((lane & 7) ^ ((kkey >> 1) & 7)) << 4);
  const int vd = 16 * wid + (lane >> 2); const long voff = (long)vd * KVLEN + (((lane & 3) ^ ((vd >> 2) & 3)) << 4);
  const int ksw = (r32 >> 1) & 7, vsw = (r32 >> 2) & 3;
  const int kb = (int)(unsigned)(uintptr_t)K_lds + r32 * 128, ka0 = kb + (((a.comp * 4 + 2 * hi) ^ ksw) << 4), ka1 = kb + (((a.comp * 4 + 2 * hi + 1) ^ ksw) << 4);
  const int vbb = (int)(unsigned)(uintptr_t)V_lds + a.vdoff + r32 * 64, va0 = vbb + (((2 * hi) ^ vsw) << 4), va1 = vbb + (((2 * hi + 1) ^ vsw) << 4);
#define DMA_K(t, slot) __builtin_amdgcn_global_load_lds((const unsigned*)(a.K + (long)tile8_k0<DIFF>(a, (t)) * a.ldk + koff), (AT_LAS unsigned*)(K_lds + (slot) * F8_SLOT + wid * 1024), 16, 0, 0)
#define DMA_V(t, slot) __builtin_amdgcn_global_load_lds((const unsigned*)(a.VT + (long)tile8_k0<DIFF>(a, (t)) + voff), (AT_LAS unsigned*)(V_lds + (slot) * F8_SLOT + wid * 1024), 16, 0, 0)
#define BAR_MID() do { SBAR(); asm volatile("s_barrier" ::: "memory"); SBAR(); } while (0)
#define BAR_END(n) do { SBAR(); asm volatile("s_waitcnt vmcnt(" #n ")\n\ts_barrier" ::: "memory"); SBAR(); } while (0)
#define RESC2() do { if (__any(alpha < 1.f)) { if (hi == 0) al_l[r32] = alpha; asm volatile("s_waitcnt lgkmcnt(0)" ::: "memory"); \
    _Pragma("unroll") for (int r = 0; r < 16; ++r) { const float f_ = al_l[crow(r, hi)]; ol[r] *= f_; _Pragma("unroll") for (int d = 0; d < NDB; ++d) o[d][r] *= f_; } } } while (0)
#define VSEG(t) do { if constexpr (!DIFF) { if ((t) >= 4) wmask(p0, p1, tile8_k0<DIFF>(a, (t)), a.q0 + r32, hi); } bf16x8 t0_, t1_, t2_, t3_; softmax_seg2(p0, p1, m_reg, alpha, t0_, t1_, t2_, t3_); (void)t0_; (void)t1_; (void)t2_; (void)t3_; \
    pa8 = (i32x8v){(int)pk4f8(p0[0], p0[1], p0[2], p0[3]), (int)pk4f8(p0[4], p0[5], p0[6], p0[7]), (int)pk4f8(p0[8], p0[9], p0[10], p0[11]), (int)pk4f8(p0[12], p0[13], p0[14], p0[15]), \
                   (int)pk4f8(p1[0], p1[1], p1[2], p1[3]), (int)pk4f8(p1[4], p1[5], p1[6], p1[7]), (int)pk4f8(p1[8], p1[9], p1[10], p1[11]), (int)pk4f8(p1[12], p1[13], p1[14], p1[15])}; RESC2(); } while (0)
#define RD16(dst, addr, OFF) asm volatile("ds_read_b128 %0, %1 offset:%2" : "=v"(dst) : "v"(addr), "i"(OFF) : "memory")
#define CAT8(x, y) (i32x8v){(int)x[0], (int)x[1], (int)x[2], (int)x[3], (int)y[0], (int)y[1], (int)y[2], (int)y[3]}
#define MSEG(DOQK, DOPV, ksl, vsl) do { \
    u32x4 ka_, kb_, kc_, kd_, v0a, v0b, v1a, v1b, v2a, v2b, v3a, v3b; const int ko_ = (ksl) * F8_SLOT, vo_ = (vsl) * F8_SLOT; \
    if (DOQK) { RD16(ka_, ka0 + ko_, 0); RD16(kb_, ka1 + ko_, 0); RD16(kc_, ka0 + ko_, 4096); RD16(kd_, ka1 + ko_, 4096); } \
    if (DOPV) { RD16(v0a, va0 + vo_, 0); RD16(v0b, va1 + vo_, 0); RD16(v1a, va0 + vo_, 2048); RD16(v1b, va1 + vo_, 2048); \
                if constexpr (NDB == 4) { RD16(v2a, va0 + vo_, 4096); RD16(v2b, va1 + vo_, 4096); RD16(v3a, va0 + vo_, 6144); RD16(v3b, va1 + vo_, 6144); } } \
    if (DOQK) { if (DOPV) { if constexpr (NDB == 4) asm volatile("s_waitcnt lgkmcnt(8)" : "+v"(ka_), "+v"(kb_), "+v"(kc_), "+v"(kd_) :: "memory"); else asm volatile("s_waitcnt lgkmcnt(4)" : "+v"(ka_), "+v"(kb_), "+v"(kc_), "+v"(kd_) :: "memory"); } else { asm volatile("s_waitcnt lgkmcnt(0)" : "+v"(ka_), "+v"(kb_), "+v"(kc_), "+v"(kd_) :: "memory"); } SBAR(); \
      { const i32x8v k0_ = CAT8(ka_, kb_), k1_ = CAT8(kc_, kd_); MF8_NEW(p0, k0_, q8); MF8_NEW(p1, k1_, q8); } SBAR(); } \
    if (DOPV) { if constexpr (NDB == 4) { asm volatile("s_waitcnt lgkmcnt(0)" : "+v"(v0a), "+v"(v0b), "+v"(v1a), "+v"(v1b), "+v"(v2a), "+v"(v2b), "+v"(v3a), "+v"(v3b) :: "memory"); SBAR(); \
        const i32x8v w0_ = CAT8(v0a, v0b), w1_ = CAT8(v1a, v1b), w2_ = CAT8(v2a, v2b), w3_ = CAT8(v3a, v3b); \
        MF8_ACC(o[0], pa8, w0_); MF8_ACC(o[1], pa8, w1_); MF8_ACC(o[2], pa8, w2_); MF8_ACC(o[3], pa8, w3_); MF8_ACC(ol, pa8, ones8); } \
      else { asm volatile("s_waitcnt lgkmcnt(0)" : "+v"(v0a), "+v"(v0b), "+v"(v1a), "+v"(v1b) :: "memory"); SBAR(); \
        const i32x8v w0_ = CAT8(v0a, v0b), w1_ = CAT8(v1a, v1b); MF8_ACC(o[0], pa8, w0_); MF8_ACC(o[1], pa8, w1_); MF8_ACC(ol, pa8, ones8); } SBAR(); } \
    asm volatile("s_nop 15\n\ts_nop 15" ::: "memory");     \
  } while (0)
#define ROT3(s) ((s) == 2 ? 0 : (s) + 1)
  f32x16 p0, p1; i32x8v pa8;
  DMA_K(0, 0); DMA_K(1, 1); DMA_V(0, 0); BAR_END(0);
  int sk = 0;
  if (wid < 4) {
    DMA_K(2, 2); DMA_V(1, 1); MSEG(true, false, 0, 0); BAR_MID(); VSEG(0); BAR_END(2);
    sk = 1;
    for (int t = 1; t <= NT - 3; ++t) { const int s1 = ROT3(sk), s2 = ROT3(s1);
      DMA_K(t + 2, s2); DMA_V(t + 1, s1); MSEG(true, true, sk, s2); BAR_MID(); VSEG(t); BAR_END(2); sk = s1; }
    { const int s1 = ROT3(sk), s2 = ROT3(s1); DMA_V(NT - 1, s1); MSEG(true, true, sk, s2); BAR_MID(); VSEG(NT - 2); BAR_END(1); sk = s1; }
    { const int s1 = ROT3(sk), s2 = ROT3(s1); MSEG(true, true, sk, s2); BAR_MID(); VSEG(NT - 1); BAR_END(0); sk = s1; }
    { const int s2 = ROT3(ROT3(sk)); MSEG(false, true, 0, s2); BAR_MID(); BAR_END(0); }
  } else {
    DMA_K(2, 2); DMA_V(1, 1); BAR_MID(); MSEG(true, false, 0, 0); BAR_END(2);
    sk = 1;
    for (int t = 1; t <= NT - 3; ++t) { const int s1 = ROT3(sk), s2 = ROT3(s1);
      DMA_K(t + 2, s2); DMA_V(t + 1, s1); VSEG(t - 1); BAR_MID(); MSEG(true, true, sk, s2); BAR_END(2); sk = s1; }
    { const int s1 = ROT3(sk), s2 = ROT3(s1); DMA_V(NT - 1, s1); VSEG(NT - 3); BAR_MID(); MSEG(true, true, sk, s2); BAR_END(1); sk = s1; }
    { const int s1 = ROT3(sk), s2 = ROT3(s1); VSEG(NT - 2); BAR_MID(); MSEG(true, true, sk, s2); BAR_END(0); sk = s1; }
    { const int s2 = ROT3(ROT3(sk)); VSEG(NT - 1); BAR_MID(); MSEG(false, true, 0, s2); BAR_END(0); }
  }
  m_out = m_reg;
#undef DMA_K
#undef DMA_V
#undef BAR_MID
#undef BAR_END
#undef RESC2
#undef VSEG
#undef RD16
#undef CAT8
#undef MSEG
#undef ROT3
}
#undef KSWZ
#undef SBAR
}

constexpr size_t MiB = 1u << 20;
constexpr size_t WS_CTL = 0, CTL_ZERO_BYTES = 1 * MiB;
constexpr size_t WS_MODP = 1 * MiB;
constexpr size_t WS_MODV = 2 * MiB;
constexpr size_t WS_ROPE = 2 * MiB + 128 * 1024;
constexpr size_t WS_ROUTE = 3 * MiB;
constexpr size_t WS_WIN = 4 * MiB, WS_WOUT = 9 * MiB, WS_WGU = 12 * MiB, WS_WDN = 140 * MiB;
constexpr size_t WS_ELIST = 238 * MiB;
constexpr size_t WS_XN = 204 * MiB;
constexpr size_t WS_QA = 240 * MiB, WS_KA = 256 * MiB, WS_VA = 274 * MiB, WS_QB = 292 * MiB, WS_KB = 308 * MiB, WS_VB = 314 * MiB;
constexpr size_t WS_Y = 320 * MiB, WS_X1 = 352 * MiB, WS_XG = 416 * MiB, WS_H = 560 * MiB, WS_Y2 = 704 * MiB, WS_END = 848 * MiB;
constexpr int CW_TMO = 0, CW_CODE = 1, CW_BAR = 4096, CW_CNT = 8192;
constexpr int MODP_KC = 8;

constexpr int RING_OFF = 0, RING_BYTES = 131072;
constexpr int LDSCTL_OFF = RING_BYTES, MISC_OFF = LDSCTL_OFF + 320, XTRA_OFF = LDSCTL_OFF + 1024;
constexpr int LDS_BYTES = 147456;

__device__ const double ROPE_CS[32] = {
    0.54030230586813977, 0.8414709848078965, 0.84600911028170789, 0.53316843991402285, 0.95041528025518285, 0.31098359290718575, 0.98423023447009461, 0.17689218624615005,
    0.99500416527802582, 0.099833416646828155, 0.99841927779266448, 0.056204499214692491, 0.99950004166527784, 0.031617506402433708, 0.99984189028361437, 0.01778185687966613,
    0.99995000041666526, 0.0099998333341666645, 0.9999841886533658, 0.0056233836139601857, 0.99999500000416663, 0.0031622723897082477, 0.99999841886158658, 0.0017782784728035289,
    0.99999950000004167, 0.00099999983333334168, 0.99999984188612112, 0.00056234129555235944, 0.99999995000000041, 0.00031622776074637522, 0.99999998418861169, 0.00017782794006665674};

__device__ __forceinline__ unsigned cvtpk(float lo, float hi) { return at2::cvtpk2(lo, hi); }
__device__ __forceinline__ unsigned pk4_fp8(float a, float b, float c, float d) { int w = 0; w = __builtin_amdgcn_cvt_pk_fp8_f32(a, b, w, false); w = __builtin_amdgcn_cvt_pk_fp8_f32(c, d, w, true); return (unsigned)w; }
__device__ __forceinline__ float bflo(unsigned w) { return __uint_as_float(w << 16); }
__device__ __forceinline__ float bfhi(unsigned w) { return __uint_as_float(w & 0xffff0000u); }
__device__ __forceinline__ bf16 f2bf1(float f) { return (bf16)(cvtpk(f, 0.f) & 0xffffu); }
__device__ __forceinline__ void unpack8(const v4u v, float* f) { f[0] = bflo(v.x); f[1] = bfhi(v.x); f[2] = bflo(v.y); f[3] = bfhi(v.y); f[4] = bflo(v.z); f[5] = bfhi(v.z); f[6] = bflo(v.w); f[7] = bfhi(v.w); }
__device__ __forceinline__ float wave_sum(float v) {
#pragma unroll
    for (int o = 1; o < 64; o <<= 1) v += __shfl_xor(v, o);
    return v;
}

struct Frame {
    LAS unsigned char* lds;
    volatile LAS unsigned* MISC;
    gu32* ctl;
    int tid, lane, wave, vcu, G, probe;
    const float *x, *c, *ctx, *c_ctx, *w_mod, *b_mod, *norm1_g, *w_in, *lq1, *lk1, *lq2, *lk2, *subln_g, *sink, *w_out, *norm2_g, *w_router, *b_router, *w_gu, *b_gu, *w_dn, *b_dn, *final_g;
    float* out;
    float *modp, *modv, *rope, *X1, *rgate;
    int *re, *rslot, *rpos, *elist;
    bf16 *Win_t, *Wout_t, *Wgu_t, *Wdn_t, *XN, *QA, *KA, *VA, *QB, *KB, *VB, *Y, *XG, *H, *Y2;
};

#ifdef PROBE_BUILD
#define RP(F, k) (1 + (((F).probe >> (k)) & 1))
#else
#define RP(F, k) 1
#endif
struct EpiQKV {
    bf16 *QA, *KA, *VA, *QB, *KB, *VB; const float* rope;
    struct Ctx { bf16* p; bool skip, rp, isq; const float* cs; };
    __device__ __forceinline__ Ctx prep(int row, int cg) const {
        Ctx c; const bool lat = row < NTOK; const int b = lat ? (row >> 13) : ((row - NTOK) >> 8);
        const int kvrow = lat ? (b * KVLEN + (row & (SEQ - 1))) : (b * KVLEN + SEQ + ((row - NTOK) & (CTXL - 1)));
        c.skip = false; c.rp = lat; c.isq = false;
        if (cg < 512)       { c.p = QA + (size_t)row * 512 + cg; c.isq = true; c.skip = !lat; }
        else if (cg < 1024) { c.p = KA + (size_t)kvrow * 512 + (cg - 512); }
        else if (cg < 1536) { c.p = VA + (size_t)kvrow * 512 + (cg - 1024); c.rp = false; }
        else if (cg < 2048) { c.p = QB + (size_t)row * 512 + (cg - 1536); c.isq = true; c.skip = !lat; }
        else if (cg < 2176) { c.p = KB + (size_t)kvrow * 128 + (cg - 2048); }
        else                { c.p = VB + (size_t)kvrow * 128 + (cg - 2176); c.rp = false; }
        const int t = row & (SEQ - 1); const int pos = ((cg >> 5) & 1) ? (t & 63) : (t >> 6);
        c.cs = rope + pos * 32;
        return c;
    }
    __device__ __forceinline__ void math(const Ctx& c, int i, float lo, float hi, float& olo, float& ohi) const {
        if (c.rp) { const float cs = c.cs[2 * i], sn = c.cs[2 * i + 1]; olo = lo * cs - hi * sn; ohi = hi * cs + lo * sn; } else { olo = lo; ohi = hi; }
        if (c.isq) { olo *= QSCALE; ohi *= QSCALE; }
    }
    __device__ __forceinline__ void one(int row, int cg, int i, float lo, float hi, int) const {
        const Ctx c = prep(row, cg); if (c.skip) return; float a, b; math(c, i, lo, hi, a, b); c.p[i] = f2bf1(a); c.p[16 + i] = f2bf1(b);
    }
    __device__ __forceinline__ void four(int row, int cg, int i0, const f32x4 lo, const f32x4 hi, int) const {
        const Ctx c = prep(row, cg); if (c.skip) return; float a[4], b[4];
#pragma unroll
        for (int i = 0; i < 4; ++i) math(c, i0 + i, lo[i], hi[i], a[i], b[i]);
        typedef unsigned u32x2 __attribute__((ext_vector_type(2)));
        *(u32x2*)(c.p + i0) = (u32x2){cvtpk(a[0], a[1]), cvtpk(a[2], a[3])}; *(u32x2*)(c.p + 16 + i0) = (u32x2){cvtpk(b[0], b[1]), cvtpk(b[2], b[3])};
    }
};
struct EpiOut {
    const float* x; const float* modv; float* X1;
    __device__ __forceinline__ void one(int row, int cg, int i, float lo, float hi, int) const {
        const float* g1 = modv + (row >> 13) * 6144 + 2048; const size_t o = (size_t)row * DM + cg + i;
        X1[o] = x[o] + g1[cg + i] * lo; X1[o + 16] = x[o + 16] + g1[cg + 16 + i] * hi;
    }
    __device__ __forceinline__ void four(int row, int cg, int i0, const f32x4 lo, const f32x4 hi, int) const {
        const float* g1 = modv + (row >> 13) * 6144 + 2048 + cg + i0; const size_t o = (size_t)row * DM + cg + i0;
        typedef unsigned u32x2 __attribute__((ext_vector_type(2)));
        const f32x4 a = *(const f32x4*)(g1) * lo, b = *(const f32x4*)(g1 + 16) * hi;
        *(u32x2*)((bf16*)X1 + o) = (u32x2){cvtpk(a[0], a[1]), cvtpk(a[2], a[3])}; *(u32x2*)((bf16*)X1 + o + 16) = (u32x2){cvtpk(b[0], b[1]), cvtpk(b[2], b[3])};
    }
};
__device__ __forceinline__ float swiglu(float g, float lin) {
    g = fminf(g, 7.0f); lin = fminf(fmaxf(lin, -7.0f), 7.0f);
    return g * __builtin_amdgcn_rcpf(1.0f + __builtin_amdgcn_exp2f(-1.702f * LOG2E * g)) * (lin + 1.0f);
}
struct EpiGU {
    unsigned char* H; const float* b_gu;
    __device__ __forceinline__ void one(int row, int cg, int i, float lo, float hi, int e) const { (void)row; (void)cg; (void)i; (void)lo; (void)hi; (void)e; }
    __device__ __forceinline__ void four(int row, int cg, int i0, const f32x4 lo, const f32x4 hi, int e) const {
        const int f = (cg >> 1) + i0; const float* bb = b_gu + e * GUW + 2 * f; const f32x4 b0 = *(const f32x4*)bb, b1 = *(const f32x4*)(bb + 4);
        const float a0 = swiglu(lo[0] + b0[0], hi[0] + b0[1]), a1 = swiglu(lo[1] + b0[2], hi[1] + b0[3]), a2 = swiglu(lo[2] + b1[0], hi[2] + b1[1]), a3 = swiglu(lo[3] + b1[2], hi[3] + b1[3]);
        *(unsigned*)(H + (size_t)row * DM + f) = pk4_fp8(a0, a1, a2, a3);
    }
};
struct EpiDN {
    bf16* Y2; const float* b_dn;
    __device__ __forceinline__ void eight(int row, int c0, const f32x4 v0, const f32x4 v1, int e) const {
        const float* bb = b_dn + e * DM + c0; const f32x4 b0 = *(const f32x4*)bb, b1 = *(const f32x4*)(bb + 4);
        typedef unsigned u32x2 __attribute__((ext_vector_type(2)));
        *(u32x2*)((unsigned char*)Y2 + (size_t)row * DM + c0) = (u32x2){pk4_fp8(v0[0] + b0[0], v0[1] + b0[1], v0[2] + b0[2], v0[3] + b0[3]), pk4_fp8(v1[0] + b1[0], v1[1] + b1[1], v1[2] + b1[2], v1[3] + b1[3])};
    }
    __device__ __forceinline__ void one(int row, int cg, int i, float lo, float hi, int e) const {
        const float* bb = b_dn + e * DM + cg + i; bf16* p = Y2 + (size_t)row * DM + cg + i; p[0] = f2bf1(lo + bb[0]); p[16] = f2bf1(hi + bb[16]);
    }
    __device__ __forceinline__ void four(int row, int cg, int i0, const f32x4 lo, const f32x4 hi, int e) const {
        const float* bb = b_dn + e * DM + cg + i0; const f32x4 b0 = *(const f32x4*)bb, b1 = *(const f32x4*)(bb + 16); bf16* p = Y2 + (size_t)row * DM + cg + i0;
        typedef unsigned u32x2 __attribute__((ext_vector_type(2)));
        *(u32x2*)p = (u32x2){cvtpk(lo[0] + b0[0], lo[1] + b0[1]), cvtpk(lo[2] + b0[2], lo[3] + b0[3])}; *(u32x2*)(p + 16) = (u32x2){cvtpk(hi[0] + b1[0], hi[1] + b1[1]), cvtpk(hi[2] + b1[2], hi[3] + b1[3])};
    }
};
template <class E, int NN> struct EpiAdapt {
    static constexpr bool PERM = false, AFTER_DRAIN = false;
    E e;
    __device__ __forceinline__ void operator()(const pg8::f32x4 (&acc)[2][2][4][2], const pg8::Unit& u, int wr, int wc, int fr, int fq) const {
        int ex = 0, pn = u.pn; if (NN) { ex = pn / NN; pn = pn - ex * NN; }
#pragma unroll
        for (int ai = 0; ai < 2; ++ai)
#pragma unroll
            for (int m = 0; m < 4; ++m) { const int row = u.pm * 256 + ai * 128 + wr * 64 + m * 16 + fr;
#pragma unroll
                for (int bj = 0; bj < 2; ++bj) e.four(row, pn * 256 + bj * 128 + wc * 32, 4 * fq, acc[ai][bj][m][0], acc[ai][bj][m][1], ex); }
    }
};
struct RepOrder : pg8::StaticOrder { int rep;
    __device__ __forceinline__ bool next(int i, pg8::Unit& u) const { if (rep > 1) { const int R = (nwg + G - 1) / G; if (i >= R * rep) return false; i %= R; } return pg8::StaticOrder::next(i, u); } };
struct EpiQKVFast {
    static constexpr bool PERM = false, AFTER_DRAIN = false;
    bf16 *QA, *KA, *VA, *QB, *KB, *VB; const float* rope;
    __device__ __forceinline__ void operator()(const pg8::f32x4 (&acc)[2][2][4][2], const pg8::Unit& u, int wr, int wc, int fr, int fq) const {
        typedef unsigned u32x2 __attribute__((ext_vector_type(2)));
        bf16* base[2]; int ld[2]; bool isq[2], rp[2], kvr[2], f8[2];
#pragma unroll
        for (int bj = 0; bj < 2; ++bj) { const int cg = u.pn * 256 + bj * 128 + wc * 32; isq[bj] = false; rp[bj] = true; kvr[bj] = true; f8[bj] = true;
            if (cg < 512)       { base[bj] = (bf16*)((unsigned char*)QA + cg); ld[bj] = 512; isq[bj] = true; kvr[bj] = false; }
            else if (cg < 1024) { base[bj] = (bf16*)((unsigned char*)KA + (cg - 512)); ld[bj] = 512; }
            else if (cg < 1536) { base[bj] = (bf16*)((unsigned char*)VA + (cg - 1024)); ld[bj] = 512; rp[bj] = false; }
            else if (cg < 2048) { base[bj] = (bf16*)((unsigned char*)QB + (cg - 1536)); ld[bj] = 512; isq[bj] = true; kvr[bj] = false; }
            else if (cg < 2176) { base[bj] = (bf16*)((unsigned char*)KB + (cg - 2048)); ld[bj] = 128; }
            else                { base[bj] = (bf16*)((unsigned char*)VB + (cg - 2176)); ld[bj] = 128; rp[bj] = false; } }
        const bool colhalf = (wc & 1) != 0;
#pragma unroll
        for (int ai = 0; ai < 2; ++ai)
#pragma unroll
            for (int m = 0; m < 4; ++m) {
                const int row = u.pm * 256 + ai * 128 + wr * 64 + m * 16 + fr; const bool lat = row < NTOK;
                const int b = lat ? (row >> 13) : ((row - NTOK) >> 8);
                const int kvrow = lat ? (b * KVLEN + (row & (SEQ - 1))) : (b * KVLEN + SEQ + ((row - NTOK) & (CTXL - 1)));
                const int t = row & (SEQ - 1), pos = colhalf ? (t & 63) : (t >> 6);
                const f32x4 c0 = *(const f32x4*)(rope + pos * 32 + 8 * fq), c1 = *(const f32x4*)(rope + pos * 32 + 8 * fq + 4);
#pragma unroll
                for (int bj = 0; bj < 2; ++bj) {
                    if (isq[bj] && !lat) continue;
                    f32x4 lo = acc[ai][bj][m][0], hi = acc[ai][bj][m][1];
                    if (rp[bj] && lat) { const f32x4 cs = {c0[0], c0[2], c1[0], c1[2]}, sn = {c0[1], c0[3], c1[1], c1[3]}; const f32x4 nl = lo * cs - hi * sn, nh = hi * cs + lo * sn; lo = nl; hi = nh; }
                    if (isq[bj]) { lo = lo * QSCALE; hi = hi * QSCALE; }
                    const size_t rr = (size_t)(kvr[bj] ? kvrow : row) * ld[bj];
                    if (f8[bj]) { unsigned char* p = (unsigned char*)base[bj] + rr + 4 * fq; *(unsigned*)p = pk4_fp8(lo[0], lo[1], lo[2], lo[3]); *(unsigned*)(p + 16) = pk4_fp8(hi[0], hi[1], hi[2], hi[3]); }
                    else { bf16* p = base[bj] + rr + 4 * fq; *(u32x2*)p = (u32x2){cvtpk(lo[0], lo[1]), cvtpk(lo[2], lo[3])}; *(u32x2*)(p + 16) = (u32x2){cvtpk(hi[0], hi[1]), cvtpk(hi[2], hi[3])}; }
                }
            }
    }
};
template <class E, int NN> struct EpiAdaptP {
    static constexpr bool PERM = true, AFTER_DRAIN = false;
    E e;
    __device__ __forceinline__ void operator()(const pg8::f32x4 (&acc)[2][2][4][2], const pg8::Unit& u, int wr, int wc, int fr, int fq) const {
        int ex = 0, pn = u.pn; if (NN) { ex = pn / NN; pn = pn - ex * NN; }
#pragma unroll
        for (int ai = 0; ai < 2; ++ai)
#pragma unroll
            for (int m = 0; m < 4; ++m) { const int row = u.pm * 256 + ai * 128 + wr * 64 + m * 16 + fr;
#pragma unroll
                for (int bj = 0; bj < 2; ++bj) e.eight(row, pn * 256 + bj * 128 + wc * 32 + 8 * fq, acc[ai][bj][m][0], acc[ai][bj][m][1], ex); }
    }
};
struct GroupedOrder {
    int nN, NP, G, c; const LAS int* pexp; int rep; const LAS int* tokT;
    __device__ __forceinline__ int rounds() const { const int upr = G / nN; return (NP + upr - 1) / upr; }
    __device__ __forceinline__ int tok(int ui, int r) const { if (rep > 1) ui %= rounds(); return tokT[ui * 256 + r]; }
    __device__ __forceinline__ bool next(int i, pg8::Unit& u) const {
        int p, j;
        if (rep > 1) { const int R = rounds(); if (i >= R * rep) return false; i %= R; }
        if (G == 256) { const int x = c & 7, r = c >> 3, ppx = 32 / nN; p = i * (8 * ppx) + x * ppx + r / nN; j = r % nN; }
        else { const long L = (long)i * G + c; p = (int)(L / nN); j = (int)(L % nN); }
        if (p >= NP) return false;
        u.pm = p; u.pn = pexp[p] * nN + j; return true;
    }
    __device__ __forceinline__ void a_ready(const pg8::Unit&) const {}
    __device__ __forceinline__ void done(const pg8::Unit&) const {}
};

struct DenseSel { const bf16* Bt; __device__ __forceinline__ const bf16* operator()(int, int& e) const { e = 0; return Bt; } };
struct GroupSel { const bf16* Bt; const LAS int* pexp; int N, K; __device__ __forceinline__ const bf16* operator()(int mt, int& e) const { e = pexp[mt >> 1]; return Bt + (size_t)e * N * K; } };
template <class Epi, class BSel>
__device__ __forceinline__ void naive_gemm(Frame& F, const bf16* A, int Mtiles, int N, int K, const BSel& bs, const Epi& E) {
    LAS float* As = (LAS float*)(F.lds + RING_OFF); LAS float* Bs = As + 128 * 33;
    const int nNt = N / 64, tx = F.tid & 15, ty = F.tid >> 4;
    for (int t = blockIdx.x; t < Mtiles * nNt; t += F.G) {
        const int mt = t / nNt, nt = t % nNt; int e; const bf16* Bt = bs(mt, e);
        float acc[4][4];
#pragma unroll
        for (int r = 0; r < 4; ++r)
#pragma unroll
            for (int j = 0; j < 4; ++j) acc[r][j] = 0.f;
        for (int k0 = 0; k0 < K; k0 += 32) {
            { const int r = F.tid >> 2, kc = (F.tid & 3) * 8; float f[8]; unpack8(*(const v4u*)(A + (size_t)(mt * 128 + r) * K + k0 + kc), f);
#pragma unroll
              for (int i = 0; i < 8; ++i) As[r * 33 + kc + i] = f[i]; }
            if (F.tid < 256) { const int r = F.tid >> 2, kc = (F.tid & 3) * 8; float f[8]; unpack8(*(const v4u*)(Bt + (size_t)(nt * 64 + r) * K + k0 + kc), f);
#pragma unroll
              for (int i = 0; i < 8; ++i) Bs[r * 33 + kc + i] = f[i]; }
            __syncthreads();
#pragma unroll 8
            for (int kk = 0; kk < 32; ++kk) { float a[4], b[4];
#pragma unroll
                for (int r = 0; r < 4; ++r) a[r] = As[(ty * 4 + r) * 33 + kk];
#pragma unroll
                for (int j = 0; j < 4; ++j) b[j] = Bs[(tx + 16 * j) * 33 + kk];
#pragma unroll
                for (int r = 0; r < 4; ++r)
#pragma unroll
                    for (int j = 0; j < 4; ++j) acc[r][j] += a[r] * b[j]; }
            __syncthreads();
        }
#pragma unroll
        for (int r = 0; r < 4; ++r) { const int row = mt * 128 + ty * 4 + r; E.one(row, nt * 64, tx, acc[r][0], acc[r][1], e); E.one(row, nt * 64 + 32, tx, acc[r][2], acc[r][3], e); }
    }
}

template <bool GUPERM>
__device__ __forceinline__ void p0_transpose_item(const float* W, int K, int N, bf16* WT, LAS float* scr, int item, int lane) {
    const int nblk = N / 32, kb = item / nblk, nb = item % nblk, k0 = 64 * kb, n0 = 32 * nb;
    { f32x4 v[8]; const float* wp = W + (size_t)(k0 + (lane >> 3)) * N + n0 + 4 * (lane & 7);
#pragma unroll
      for (int i = 0; i < 8; ++i) v[i] = __builtin_nontemporal_load((const f32x4*)(wp + (size_t)(8 * i) * N));
#pragma unroll
      for (int i = 0; i < 8; ++i) { LAS float* d = scr + (8 * i + (lane >> 3)) * 33 + 4 * (lane & 7); d[0] = v[i].x; d[1] = v[i].y; d[2] = v[i].z; d[3] = v[i].w; } }
    LDS_WAIT(); asm volatile("" ::: "memory");
    const int c = lane & 7;
#pragma unroll
    for (int j = 0; j < 4; ++j) { const int n = (lane >> 3) + 8 * j; const LAS float* s = scr + (8 * c) * 33 + n;
        v4u o; o.x = cvtpk(s[0 * 33], s[1 * 33]); o.y = cvtpk(s[2 * 33], s[3 * 33]); o.z = cvtpk(s[4 * 33], s[5 * 33]); o.w = cvtpk(s[6 * 33], s[7 * 33]);
        const int nd = GUPERM ? ((n & 1) * 16 + (n >> 1)) : n;
        *(GAS v4u*)(WT + (size_t)(n0 + nd) * K + k0 + 8 * c) = o; }
    LDS_WAIT(); asm volatile("" ::: "memory");
}
template <bool GUPERM>
__device__ __forceinline__ void p0_transpose_item_fp8(const float* W, int K, int N, unsigned char* WT, LAS float* scr, int item, int lane) {
    const int nblk = N / 32, kb = item / nblk, nb = item % nblk, k0 = 64 * kb, n0 = 32 * nb;
    { f32x4 v[8]; const float* wp = W + (size_t)(k0 + (lane >> 3)) * N + n0 + 4 * (lane & 7);
#pragma unroll
      for (int i = 0; i < 8; ++i) v[i] = __builtin_nontemporal_load((const f32x4*)(wp + (size_t)(8 * i) * N));
#pragma unroll
      for (int i = 0; i < 8; ++i) { LAS float* d = scr + (8 * i + (lane >> 3)) * 33 + 4 * (lane & 7); d[0] = v[i].x; d[1] = v[i].y; d[2] = v[i].z; d[3] = v[i].w; } }
    LDS_WAIT(); asm volatile("" ::: "memory");
    const int c = lane & 7;
    typedef unsigned u32x2 __attribute__((ext_vector_type(2)));
#pragma unroll
    for (int j = 0; j < 4; ++j) { const int n = (lane >> 3) + 8 * j; const LAS float* s = scr + (8 * c) * 33 + n;
        u32x2 o; o.x = pk4_fp8(s[0 * 33] * 32.f, s[1 * 33] * 32.f, s[2 * 33] * 32.f, s[3 * 33] * 32.f); o.y = pk4_fp8(s[4 * 33] * 32.f, s[5 * 33] * 32.f, s[6 * 33] * 32.f, s[7 * 33] * 32.f);
        const int nd = GUPERM ? ((n & 1) * 16 + (n >> 1)) : n;
        *(GAS u32x2*)(WT + (size_t)(n0 + nd) * K + k0 + 8 * c) = o; }
    LDS_WAIT(); asm volatile("" ::: "memory");
}
struct F8Item { const float* wp; unsigned char* wt; int K; int guperm; };
__device__ __forceinline__ F8Item f8_decode(const Frame& F, int r, int lane) {
    constexpr int I_GU1 = (DM / 64) * (GUW / 32), I_DN1 = (DM / 64) * (DM / 32);
    F8Item I; const float* W; int N, item; unsigned char* WT;
    if (r < NEXP * I_GU1) { const int e = r / I_GU1; item = r % I_GU1; W = F.w_gu + (size_t)e * DM * GUW; N = GUW; WT = (unsigned char*)F.Wgu_t + (size_t)e * GUW * DM; I.guperm = 1; }
    else { r -= NEXP * I_GU1; const int e = r / I_DN1; item = r % I_DN1; W = F.w_dn + (size_t)e * DM * DM; N = DM; WT = (unsigned char*)F.Wdn_t + (size_t)e * DM * DM; I.guperm = 0; }
    const int nblk = N / 32, kb = item / nblk, nb = item % nblk, k0 = 64 * kb, n0 = 32 * nb;
    I.wp = W + (size_t)(k0 + (lane >> 3)) * N + n0 + 4 * (lane & 7); I.K = N;
    I.wt = WT + (size_t)n0 * DM + k0 + 8 * (lane & 7);
    return I;
}
__device__ __forceinline__ void f8_issue(const F8Item& I, f32x4 (&v)[8]) {
#pragma unroll
    for (int i = 0; i < 8; ++i) v[i] = __builtin_nontemporal_load((const f32x4*)(I.wp + (size_t)(8 * i) * I.K));
}
__device__ __forceinline__ void f8_finish(const F8Item& I, f32x4 (&v)[8], LAS float* scr, int lane) {
#pragma unroll
    for (int i = 0; i < 8; ++i) { LAS float* d = scr + (8 * i + (lane >> 3)) * 33 + 4 * (lane & 7); d[0] = v[i].x; d[1] = v[i].y; d[2] = v[i].z; d[3] = v[i].w; }
    LDS_WAIT(); asm volatile("" ::: "memory");
    const int c = lane & 7;
    typedef unsigned u32x2 __attribute__((ext_vector_type(2)));
#pragma unroll
    for (int j = 0; j < 4; ++j) { const int n = (lane >> 3) + 8 * j; const LAS float* s = scr + (8 * c) * 33 + n;
        u32x2 o; o.x = pk4_fp8(s[0 * 33] * 32.f, s[1 * 33] * 32.f, s[2 * 33] * 32.f, s[3 * 33] * 32.f); o.y = pk4_fp8(s[4 * 33] * 32.f, s[5 * 33] * 32.f, s[6 * 33] * 32.f, s[7 * 33] * 32.f);
        const int nd = I.guperm ? ((n & 1) * 16 + (n >> 1)) : n;
        *(GAS u32x2*)(I.wt + (size_t)nd * DM) = o; }
    LDS_WAIT(); asm volatile("" ::: "memory");
}
__device__ __forceinline__ void f8_stream(const Frame& F, LAS float* scr, int r, int rend, int stride) {
    f32x4 va[8], vb[8]; F8Item Ia, Ib;
    if (r >= rend) return;
    Ia = f8_decode(F, r, F.lane); f8_issue(Ia, va);
    while (true) {
        int nx = r + stride;
        if (nx < rend) { Ib = f8_decode(F, nx, F.lane); f8_issue(Ib, vb); }
        f8_finish(Ia, va, scr, F.lane);
        r = nx; if (r >= rend) break;
        nx = r + stride;
        if (nx < rend) { Ia = f8_decode(F, nx, F.lane); f8_issue(Ia, va); }
        f8_finish(Ib, vb, scr, F.lane);
        r = nx; if (r >= rend) break;
    }
}
__device__ __forceinline__ void p0_item(Frame& F, LAS float* sil, LAS float* scr, int it) {
    constexpr int I_IN = (DM / 64) * (INC / 32), I_OUT = (DM / 64) * (DM / 32), I_GU1 = (DM / 64) * (GUW / 32), I_DN1 = (DM / 64) * (DM / 32);

        int r = it;
        if (r < I_IN) { p0_transpose_item<false>(F.w_in, DM, INC, F.Win_t, scr, r, F.lane); return; } r -= I_IN;
        if (r < I_OUT) { p0_transpose_item<false>(F.w_out, DM, DM, F.Wout_t, scr, r, F.lane); return; } r -= I_OUT;
        if (r < NEXP * I_GU1) { const int e = r / I_GU1; p0_transpose_item_fp8<true>(F.w_gu + (size_t)e * DM * GUW, DM, GUW, (unsigned char*)F.Wgu_t + (size_t)e * GUW * DM, scr, r % I_GU1, F.lane); return; } r -= NEXP * I_GU1;
        { const int e = r / I_DN1; p0_transpose_item_fp8<false>(F.w_dn + (size_t)e * DM * DM, DM, DM, (unsigned char*)F.Wdn_t + (size_t)e * DM * DM, scr, r % I_DN1, F.lane); }
}
constexpr int P0_NITEMS = (DM / 64) * (INC / 32) + (DM / 64) * (DM / 32) + NEXP * (DM / 64) * (GUW / 32) + NEXP * (DM / 64) * (DM / 32);
#ifndef P2_TAIL_ITEMS
#define P2_TAIL_ITEMS 46000
#endif
#ifndef P2_GEMM_WGS_N
#define P2_GEMM_WGS_N 152
#endif
constexpr int P2_GEMM_WGS = P2_GEMM_WGS_N;
constexpr int P0_SPLIT = P0_NITEMS - P2_TAIL_ITEMS;
__device__ __forceinline__ void p0_tail(Frame& F) {
    LAS float* scr = (LAS float*)(F.lds + RING_OFF + F.wave * 16384);
    const int w = ((int)blockIdx.x - P2_GEMM_WGS) * NWAVES + F.wave, NW = (F.G - P2_GEMM_WGS) * NWAVES;
    constexpr int NPRE = (DM / 64) * (INC / 32) + (DM / 64) * (DM / 32);
    f8_stream(F, scr, P0_SPLIT - NPRE + w, P0_NITEMS - NPRE, NW);
}
__device__ __forceinline__ void p0_prologue(Frame& F) {
    LAS float* sil = (LAS float*)(F.lds + XTRA_OFF);
    for (int i = F.tid; i < 3072; i += 512) { const int v = i >> 10, k = i & 1023; const float cv = (v < 2) ? F.c[v * 1024 + k] : F.c_ctx[k]; sil[i] = cv / (1.f + __expf(-cv)); }
    __syncthreads();
    const int gw = F.vcu * NWAVES + F.wave, NGW = F.G * NWAVES;
    if (blockIdx.x == 0) for (int i = F.tid; i < 2048; i += 512) { const int pos = i >> 4, j = i & 15; double cr = 1.0, sr = 0.0, cb = ROPE_CS[2 * j], sb = ROPE_CS[2 * j + 1];
        for (int bit = 0; bit < 7; ++bit) { if ((pos >> bit) & 1) { const double t = cr * cb - sr * sb; sr = cr * sb + sr * cb; cr = t; } const double t2 = cb * cb - sb * sb; sb = 2.0 * cb * sb; cb = t2; }
        F.rope[2 * i] = (float)cr; F.rope[2 * i + 1] = (float)sr; }
    for (int r = F.vcu; r < 24 * MODP_KC; r += F.G) {
        const int nb = r % 24, kc = r / 24, n = nb * 256 + F.lane * 4, kbase = kc * 128 + F.wave * 16;
        f32x4 a0 = {0.f, 0.f, 0.f, 0.f}, a1 = a0, a2 = a0;
        const float* wp = F.w_mod + (size_t)kbase * 6144 + n;
#pragma unroll
        for (int kk = 0; kk < 16; ++kk) { const f32x4 w = __builtin_nontemporal_load((const f32x4*)(wp + (size_t)kk * 6144)); const int k = kbase + kk; a0 += w * sil[k]; a1 += w * sil[1024 + k]; a2 += w * sil[2048 + k]; }
        LAS float* red = (LAS float*)(F.lds + RING_OFF);
        *(LAS f32x4*)(red + (F.wave * 3 + 0) * 256 + 4 * F.lane) = a0; *(LAS f32x4*)(red + (F.wave * 3 + 1) * 256 + 4 * F.lane) = a1; *(LAS f32x4*)(red + (F.wave * 3 + 2) * 256 + 4 * F.lane) = a2;
        __syncthreads();
        for (int i = F.tid; i < 768; i += 512) { float t = 0.f;
#pragma unroll
            for (int w = 0; w < NWAVES; ++w) t += red[w * 768 + i];
            F.modp[(size_t)(kc * 3 + i / 256) * 6144 + nb * 256 + (i % 256)] = t; }
        __syncthreads();
    }
    LAS float* scr = (LAS float*)(F.lds + RING_OFF + F.wave * 16384);
    constexpr int I_IN = (DM / 64) * (INC / 32), I_OUT = (DM / 64) * (DM / 32), I_GU1 = (DM / 64) * (GUW / 32), I_DN1 = (DM / 64) * (DM / 32);
    constexpr int NITEMS = I_IN + I_OUT + NEXP * I_GU1 + NEXP * I_DN1;
    const int nsplit = (F.G == 256) ? P0_SPLIT : NITEMS;
    constexpr int NPRE = I_IN + I_OUT;
    int it0 = gw;
    if (NPRE > NGW) { for (; it0 < NPRE; it0 += NGW) p0_item(F, sil, scr, it0); } else if (it0 < NPRE) { p0_item(F, sil, scr, it0); it0 += NGW; }
    f8_stream(F, scr, it0 - NPRE, nsplit - NPRE, NGW);
}
__device__ __forceinline__ void p1_norm(Frame& F) {
    LAS float* ml = (LAS float*)(F.lds + RING_OFF);
    for (int i0 = F.tid; i0 < 6144; i0 += 2048) { float pv[4][MODP_KC], bv[4];
#pragma unroll
        for (int q = 0; q < 4; ++q) { const int i = i0 + 512 * q, v = i / 2048, j = i % 2048; bv[q] = F.b_mod[j];
#pragma unroll
            for (int kc = 0; kc < MODP_KC; ++kc) pv[q][kc] = F.modp[(size_t)(kc * 3 + v) * 6144 + j]; }
#pragma unroll
        for (int q = 0; q < 4; ++q) { float t = bv[q];
#pragma unroll
            for (int kc = 0; kc < MODP_KC; ++kc) t += pv[q][kc];
            ml[i0 + 512 * q] = t; } }
    for (int gi = blockIdx.x * 512 + F.tid; gi < 3 * 6144; gi += F.G * 512) { const int v = gi / 6144, j = gi % 6144; float s = F.b_mod[j];
        for (int kc = 0; kc < MODP_KC; ++kc) s += F.modp[(size_t)(kc * 3 + v) * 6144 + j]; F.modv[gi] = s; }
    __syncthreads();
    const int gw = F.vcu * NWAVES + F.wave, NGW = F.G * NWAVES;
    typedef unsigned u32x2 __attribute__((ext_vector_type(2)));
    for (int pp = gw; pp < (NROW / 2) * RP(F, 1); pp += NGW) { const int m0 = (pp % (NROW / 2)) * 2;
        f32x4 xv[2][4]; float s[2] = {0.f, 0.f}; int v[2];
#pragma unroll
        for (int q = 0; q < 2; ++q) { const int m = m0 + q; v[q] = m < SEQ ? 0 : (m < NTOK ? 1 : 2);
            const float* src = m < NTOK ? F.x + (size_t)m * DM : F.ctx + (size_t)(m - NTOK) * DM;
#pragma unroll
            for (int j = 0; j < 4; ++j) xv[q][j] = __builtin_nontemporal_load((const f32x4*)(src + 4 * F.lane + 256 * j)); }
#pragma unroll
        for (int q = 0; q < 2; ++q)
#pragma unroll
            for (int j = 0; j < 4; ++j) s[q] += (xv[q][j].x * xv[q][j].x + xv[q][j].y * xv[q][j].y) + (xv[q][j].z * xv[q][j].z + xv[q][j].w * xv[q][j].w);
#pragma unroll
        for (int q = 0; q < 2; ++q) { const int m = m0 + q; const float rstd = 1.0f / sqrtf(wave_sum(s[q]) * (1.f / DM) + NORM_EPS);
#pragma unroll
            for (int j = 0; j < 4; ++j) { const int col = 4 * F.lane + 256 * j; const f32x4 g = *(const f32x4*)(F.norm1_g + col);
                const f32x4 sh = *(const LAS f32x4*)(ml + v[q] * 2048 + col), sc = *(const LAS f32x4*)(ml + v[q] * 2048 + 1024 + col);
                const f32x4 y = (xv[q][j] * rstd * g) * (sc + 1.0f) + sh;
                *(u32x2*)(F.XN + (size_t)m * DM + col) = (u32x2){cvtpk(y.x, y.y), cvtpk(y.z, y.w)}; } }
    }
}

__device__ __forceinline__ float lam_value(Frame& F) {
    const float a = wave_sum(F.lq1[F.lane] * F.lk1[F.lane]), b = wave_sum(F.lq2[F.lane] * F.lk2[F.lane]);
    return __expf(a) - __expf(b) + 0.2f;
}
__device__ __forceinline__ void naive_diff_attn(Frame& F) {
    const float lam = lam_value(F);
    LAS float* X = (LAS float*)(F.lds + RING_OFF);
    LAS float* SS = X + 128 * 128;
    const int q = F.tid & 127, comp = (F.tid >> 7) & 1, vh = F.tid >> 8;
    for (int it = blockIdx.x; it < BATCH * 4 * (SEQ / 128); it += F.G) {
        const int b = it >> 8, h = (it >> 6) & 3, qb = it & 63; const int row = b * SEQ + qb * 128 + q;
        float qv[64], o[64];
#pragma unroll
        for (int c8 = 0; c8 < 8; ++c8) unpack8(*(const v4u*)(F.QA + (size_t)row * 512 + h * 128 + comp * 64 + c8 * 8), qv + 8 * c8);
#pragma unroll
        for (int e = 0; e < 64; ++e) o[e] = 0.f;
        float m = -1e30f, l = 0.f;
        const bf16* kp = F.KA + (size_t)(b * KVLEN) * 512 + h * 128 + comp * 64; const bf16* vp = F.VA + (size_t)(b * KVLEN) * 512 + h * 128 + vh * 64;
        for (int key = 0; key < KVLEN; ++key) {
            float s = 0.f;
#pragma unroll
            for (int c8 = 0; c8 < 8; ++c8) { float kf[8]; unpack8(*(const v4u*)(kp + (size_t)key * 512 + c8 * 8), kf);
#pragma unroll
                for (int i = 0; i < 8; ++i) s += qv[8 * c8 + i] * kf[i]; }
            if (s > m) { const float a = exp2f(m - s); l *= a;
#pragma unroll
                for (int e = 0; e < 64; ++e) o[e] *= a;
                m = s; }
            const float p = exp2f(s - m); l += p;
#pragma unroll
            for (int c8 = 0; c8 < 8; ++c8) { float vf[8]; unpack8(*(const v4u*)(vp + (size_t)key * 512 + c8 * 8), vf);
#pragma unroll
                for (int i = 0; i < 8; ++i) o[8 * c8 + i] += p * vf[i]; }
        }
        const float inv = 1.0f / l;
        __syncthreads();
        if (comp == 1) {
#pragma unroll
            for (int e = 0; e < 64; ++e) X[(vh * 64 + e) * 128 + q] = lam * o[e] * inv; }
        __syncthreads();
        if (comp == 0) { float ss = 0.f;
#pragma unroll
            for (int e = 0; e < 64; ++e) { o[e] = o[e] * inv - X[(vh * 64 + e) * 128 + q]; ss += o[e] * o[e]; }
            SS[vh * 128 + q] = ss; }
        __syncthreads();
        if (comp == 0) { const float r = 0.8f / sqrtf((SS[q] + SS[128 + q]) * (1.f / 128.f) + NORM_EPS);
            bf16* yp = F.Y + (size_t)row * DM + h * 128 + vh * 64; const float* sg = F.subln_g + vh * 64;
#pragma unroll
            for (int c8 = 0; c8 < 8; ++c8) { v4u w; w.x = cvtpk(o[8 * c8] * r * sg[8 * c8], o[8 * c8 + 1] * r * sg[8 * c8 + 1]); w.y = cvtpk(o[8 * c8 + 2] * r * sg[8 * c8 + 2], o[8 * c8 + 3] * r * sg[8 * c8 + 3]);
                w.z = cvtpk(o[8 * c8 + 4] * r * sg[8 * c8 + 4], o[8 * c8 + 5] * r * sg[8 * c8 + 5]); w.w = cvtpk(o[8 * c8 + 6] * r * sg[8 * c8 + 6], o[8 * c8 + 7] * r * sg[8 * c8 + 7]);
                *(v4u*)(yp + 8 * c8) = w; } }
    }
}
__device__ __forceinline__ void naive_win_attn(Frame& F) {
    for (int it = blockIdx.x; it < BATCH * 8 * (SEQ / 512); it += F.G) {
        const int b = it >> 7, h = (it >> 4) & 7, t = (it & 15) * 512 + F.tid, kv = h >> 2; const int row = b * SEQ + t;
        float qv[64], o[64];
#pragma unroll
        for (int c8 = 0; c8 < 8; ++c8) unpack8(*(const v4u*)(F.QB + (size_t)row * 512 + h * 64 + c8 * 8), qv + 8 * c8);
#pragma unroll
        for (int e = 0; e < 64; ++e) o[e] = 0.f;
        float m = F.sink[h] * LOG2E, l = 1.0f;
        const bf16* kp = F.KB + (size_t)(b * KVLEN) * 128 + kv * 64; const bf16* vp = F.VB + (size_t)(b * KVLEN) * 128 + kv * 64;
        for (int jj = 0; jj < 257 + CTXL; ++jj) {
            const int key = jj < 257 ? t - 128 + jj : SEQ + (jj - 257);
            if (jj < 257 && (key < 0 || key >= SEQ)) continue;
            float s = 0.f;
#pragma unroll
            for (int c8 = 0; c8 < 8; ++c8) { float kf[8]; unpack8(*(const v4u*)(kp + (size_t)key * 128 + c8 * 8), kf);
#pragma unroll
                for (int i = 0; i < 8; ++i) s += qv[8 * c8 + i] * kf[i]; }
            if (s > m) { const float a = exp2f(m - s); l *= a;
#pragma unroll
                for (int e = 0; e < 64; ++e) o[e] *= a;
                m = s; }
            const float p = exp2f(s - m); l += p;
#pragma unroll
            for (int c8 = 0; c8 < 8; ++c8) { float vf[8]; unpack8(*(const v4u*)(vp + (size_t)key * 128 + c8 * 8), vf);
#pragma unroll
                for (int i = 0; i < 8; ++i) o[8 * c8 + i] += p * vf[i]; }
        }
        const float inv = 1.0f / l; bf16* yp = F.Y + (size_t)row * DM + 512 + h * 64;
#pragma unroll
        for (int c8 = 0; c8 < 8; ++c8) { v4u w; w.x = cvtpk(o[8 * c8] * inv, o[8 * c8 + 1] * inv); w.y = cvtpk(o[8 * c8 + 2] * inv, o[8 * c8 + 3] * inv); w.z = cvtpk(o[8 * c8 + 4] * inv, o[8 * c8 + 5] * inv); w.w = cvtpk(o[8 * c8 + 6] * inv, o[8 * c8 + 7] * inv);
            *(v4u*)(yp + 8 * c8) = w; }
    }
}

#ifndef ATT_PP
#define ATT_PP 3
#endif
constexpr size_t WIN_VT_OFF = 16u << 20;
__device__ __forceinline__ void vt_item(const unsigned char* src, int rstride, unsigned char* drow0, int tile, int dg, int half) {
        unsigned outw[4][8];
#pragma unroll
        for (int i8 = 0; i8 < 8; ++i8) { const int kg = 8 * half + i8;
            const unsigned w0 = *(const unsigned*)(src + (size_t)(4 * kg + 0) * rstride), w1 = *(const unsigned*)(src + (size_t)(4 * kg + 1) * rstride), w2 = *(const unsigned*)(src + (size_t)(4 * kg + 2) * rstride), w3 = *(const unsigned*)(src + (size_t)(4 * kg + 3) * rstride);
            const unsigned a01 = __builtin_amdgcn_perm(w1, w0, 0x05010400u), c01 = __builtin_amdgcn_perm(w1, w0, 0x07030602u);
            const unsigned a23 = __builtin_amdgcn_perm(w3, w2, 0x05010400u), c23 = __builtin_amdgcn_perm(w3, w2, 0x07030602u);
            const int slot = ((i8 >> 1) & 3) + 4 * (i8 & 1);
            outw[0][slot] = __builtin_amdgcn_perm(a23, a01, 0x05040100u); outw[1][slot] = __builtin_amdgcn_perm(a23, a01, 0x07060302u);
            outw[2][slot] = __builtin_amdgcn_perm(c23, c01, 0x05040100u); outw[3][slot] = __builtin_amdgcn_perm(c23, c01, 0x07060302u); }
#pragma unroll
        for (int i = 0; i < 4; ++i) { unsigned char* dst = drow0 + (size_t)i * KVLEN + tile * 64 + 16 * half;
            *(v4u*)dst = (v4u){outw[i][0], outw[i][1], outw[i][2], outw[i][3]}; *(v4u*)(dst + 32) = (v4u){outw[i][4], outw[i][5], outw[i][6], outw[i][7]}; }
}
__device__ __forceinline__ void p3_vt_pass(Frame& F) {
    const unsigned char* V8 = (const unsigned char*)F.VA; unsigned char* VT8 = (unsigned char*)F.XG;
    const unsigned char* VB8 = (const unsigned char*)F.VB; unsigned char* VBT8 = (unsigned char*)F.XG + WIN_VT_OFF;
    const int gw = F.vcu * NWAVES + F.wave, NGW = F.G * NWAVES, dg = F.lane & 31, half = F.lane >> 5;
    constexpr int NTL = KVLEN / 64;
    for (int it = gw; it < 10 * NTL; it += NGW) {
        if (it < 8 * NTL) { const int bh = it / NTL, tile = it % NTL, b = bh >> 2, h = bh & 3;
            vt_item(V8 + ((size_t)(b * KVLEN + tile * 64)) * 512 + h * 128 + 4 * dg, 512, VT8 + ((size_t)(bh * 128 + 4 * dg)) * KVLEN, tile, dg, half); }
        else { const int b = (it - 8 * NTL) / NTL, tile = it % NTL;
            vt_item(VB8 + ((size_t)(b * KVLEN + tile * 64)) * 128 + 4 * dg, 128, VBT8 + ((size_t)(b * 128 + 4 * dg)) * KVLEN, tile, dg, half); }
    }
}
__device__ __forceinline__ void diff_unit(Frame& F, int b, int h, int qb, float lam) {
    using namespace at2;
    const int wid = F.wave, lane = F.lane, r32 = lane & 31, hi = lane >> 5, qblk = wid >> 1, comp = wid & 1;
    const int row0 = b * SEQ + qb * 128 + qblk * 32;
    UnitArgs8 a; a.Q = (const unsigned char*)F.QA + (size_t)row0 * 512 + h * 128 + comp * 64;
    a.K = (const unsigned char*)F.KA + (size_t)(b * KVLEN) * 512 + h * 128; a.VT = (const unsigned char*)F.XG + (size_t)((b * 4 + h) * 128) * KVLEN; a.comp = comp; a.ldk = 512; a.vdoff = 0; a.q0 = 0; a.ks = 0;
    f32x16 o[4]; o[0] = f32x16{}; o[1] = f32x16{}; o[2] = f32x16{}; o[3] = f32x16{};
    float m; f32x16 ol = f32x16{};
    AT_LAS char* lds = (AT_LAS char*)F.lds;
    attn_tiles_f8<true>(a, lds, F.tid, wid, lane, o, ol, m);
    float rli[16];
#pragma unroll
    for (int r = 0; r < 16; ++r) rli[r] = __builtin_amdgcn_rcpf(ol[r]);
    __syncthreads();
    AT_LAS float* XD = (AT_LAS float*)lds + qblk * 32 * XROW;
    if (comp == 1) {
#pragma unroll
        for (int r = 0; r < 16; ++r)
#pragma unroll
            for (int d0 = 0; d0 < 4; ++d0) XD[crow(r, hi) * XROW + d0 * 32 + r32] = lam * (o[d0][r] * rli[r]); }
    __syncthreads();
    if (comp == 0) {
#pragma unroll
        for (int r = 0; r < 16; ++r)
#pragma unroll
            for (int d0 = 0; d0 < 4; ++d0) { const int idx = crow(r, hi) * XROW + d0 * 32 + r32; XD[idx] = o[d0][r] * rli[r] - XD[idx]; }
        asm volatile("s_waitcnt lgkmcnt(0)" ::: "memory");
        const int row = lane >> 1, half = lane & 1;
        f32x4 v[16]; float ss = 0.f;
#pragma unroll
        for (int i = 0; i < 16; ++i) { v[i] = *(const AT_LAS f32x4*)(XD + row * XROW + half * 64 + 4 * i); ss += (v[i].x * v[i].x + v[i].y * v[i].y) + (v[i].z * v[i].z + v[i].w * v[i].w); }
        ss += __shfl_xor(ss, 1);
        const float rs = 0.8f / sqrtf(ss * (1.f / 128.f) + NORM_EPS);
        bf16* yp = F.Y + (size_t)(row0 + row) * DM + h * 128 + half * 64; const float* sg = F.subln_g + half * 64;
#pragma unroll
        for (int c8 = 0; c8 < 8; ++c8) { const f32x4 g0 = *(const f32x4*)(sg + 8 * c8), g1 = *(const f32x4*)(sg + 8 * c8 + 4); const f32x4 x0 = v[2 * c8] * rs * g0, x1 = v[2 * c8 + 1] * rs * g1;
            v4u w; w.x = cvtpk(x0.x, x0.y); w.y = cvtpk(x0.z, x0.w); w.z = cvtpk(x1.x, x1.y); w.w = cvtpk(x1.z, x1.w); *(v4u*)(yp + 8 * c8) = w; }
    }
    __syncthreads();
}
__device__ __forceinline__ void win_unit(Frame& F, int b, int j32) {
    using namespace at2;
    const int wid = F.wave, lane = F.lane, r32 = lane & 31, hi = lane >> 5, h = wid, kv = h >> 2;
    const int t0 = 32 * j32, row0 = b * SEQ + t0;
    UnitArgs8 a; a.Q = (const unsigned char*)F.QB + (size_t)row0 * 512 + h * 64;
    a.K = (const unsigned char*)F.KB + (size_t)(b * KVLEN) * 128; a.VT = (const unsigned char*)F.XG + WIN_VT_OFF + (size_t)(b * 128) * KVLEN; a.comp = kv; a.ldk = 128; a.vdoff = kv * 4096; a.q0 = t0;
    { const int st = t0 - 128; int ks = st < 0 ? 0 : (st & ~63); if (ks > SEQ - 384) ks = SEQ - 384; a.ks = ks; }
    f32x16 o[2]; o[0] = f32x16{}; o[1] = f32x16{};
    float m; f32x16 ol = f32x16{};
    AT_LAS char* lds = (AT_LAS char*)F.lds;
    attn_tiles_f8<false>(a, lds, F.tid, wid, lane, o, ol, m);
    AT_LAS float* li_l = (AT_LAS float*)(lds + AT_WS3_OFF) + wid * 64;
    if (hi == 0) li_l[r32] = __builtin_amdgcn_exp2f(F.sink[h] * LOG2E - m);
    asm volatile("s_waitcnt lgkmcnt(0)" ::: "memory");
    float rli[16];
#pragma unroll
    for (int r = 0; r < 16; ++r) rli[r] = __builtin_amdgcn_rcpf(ol[r] + li_l[crow(r, hi)]);
    __syncthreads();
    AT_LAS float* XD = (AT_LAS float*)lds + wid * 32 * XROWW;
#pragma unroll
    for (int r = 0; r < 16; ++r)
#pragma unroll
        for (int d0 = 0; d0 < 2; ++d0) XD[crow(r, hi) * XROWW + d0 * 32 + r32] = o[d0][r] * rli[r];
    asm volatile("s_waitcnt lgkmcnt(0)" ::: "memory");
    const int row = lane >> 1, half = lane & 1;
    bf16* yp = F.Y + (size_t)(row0 + row) * DM + 512 + h * 64 + half * 32;
#pragma unroll
    for (int c8 = 0; c8 < 4; ++c8) { const f32x4 x0 = *(const AT_LAS f32x4*)(XD + row * XROWW + half * 32 + 8 * c8), x1 = *(const AT_LAS f32x4*)(XD + row * XROWW + half * 32 + 8 * c8 + 4);
        v4u w; w.x = cvtpk(x0.x, x0.y); w.y = cvtpk(x0.z, x0.w); w.z = cvtpk(x1.x, x1.y); w.w = cvtpk(x1.z, x1.w); *(v4u*)(yp + 8 * c8) = w; }
    __syncthreads();
}
__device__ __forceinline__ void p3_attention(Frame& F) {
    const float lam = lam_value(F);
#ifndef NO_DIFF
#pragma unroll 1
    for (int U = F.vcu * 2; U < BATCH * 4 * (SEQ / 128) * RP(F, 3); U += 2 * F.G)
#pragma unroll 1
        for (int i = 0; i < 2; ++i) { const int u = (U + i) % 512; diff_unit(F, u >> 8, (u >> 6) & 3, u & 63, lam); }
#endif
#ifndef NO_WIN
#pragma unroll 1
    for (int W = F.vcu * 2; W < BATCH * (SEQ / 32) * RP(F, 3); W += 2 * F.G)
#pragma unroll 1
        for (int i = 0; i < 2; ++i) { const int w = (W + i) % 512; win_unit(F, w >> 8, w & 255); }
#endif
}

__device__ __forceinline__ unsigned long long wave_max64(unsigned long long k) {
#pragma unroll
    for (int o = 1; o < 64; o <<= 1) { const unsigned lo = __shfl_xor((unsigned)k, o), hi = __shfl_xor((unsigned)(k >> 32), o); const unsigned long long t = ((unsigned long long)hi << 32) | lo; k = t > k ? t : k; }
    return k;
}
__device__ __forceinline__ void p5a_route(Frame& F) {
    const int npass = RP(F, 5);
    LAS float* WRT = (LAS float*)(F.lds + RING_OFF);
    LAS int* lcnt = (LAS int*)(F.lds + XTRA_OFF); LAS int* lbase = lcnt + 32; LAS int* le = lcnt + 64; LAS int* lrk = le + 256;
    for (int idx = F.tid; idx < 32768; idx += 512) { const int k = idx >> 5, e = idx & 31; WRT[e * 1024 + (k ^ ((e & 15) << 2))] = F.w_router[idx]; }
    gu32* gcnt = F.ctl + CW_CNT;
    typedef unsigned u32x2 __attribute__((ext_vector_type(2)));
    for (int cc = blockIdx.x; cc < (NTOK / 64) * npass; cc += F.G) { const int chunk = cc % (NTOK / 64); const bool dry = cc < (NTOK / 64) * (npass - 1);
        if (F.tid < 32) lcnt[F.tid] = 0;
        __syncthreads();
        const int b = (chunk * 64) >> 13; const float* mv = F.modv + b * 6144;
#pragma unroll 1
        for (int grp = 0; grp < 2; ++grp) {
            const int row0 = chunk * 64 + F.wave * 8 + grp * 4;
            f32x4 xv[4][4]; float ss[4];
#pragma unroll
            for (int r = 0; r < 4; ++r) { float s = 0.f;
#pragma unroll
                for (int j = 0; j < 4; ++j) { { const size_t o_ = (size_t)(row0 + r) * DM + 4 * F.lane + 256 * j; const u32x2 t_ = *(const u32x2*)((const bf16*)((const unsigned char*)F.XG + 32 * MiB) + o_);
                        xv[r][j] = __builtin_nontemporal_load((const f32x4*)(F.x + o_)) + (f32x4){bflo(t_.x), bfhi(t_.x), bflo(t_.y), bfhi(t_.y)};
                        if (!dry) *(u32x2*)((bf16*)F.X1 + o_) = (u32x2){cvtpk(xv[r][j].x, xv[r][j].y), cvtpk(xv[r][j].z, xv[r][j].w)}; } s += (xv[r][j].x * xv[r][j].x + xv[r][j].y * xv[r][j].y) + (xv[r][j].z * xv[r][j].z + xv[r][j].w * xv[r][j].w); }
                ss[r] = 1.0f / sqrtf(wave_sum(s) * (1.f / DM) + NORM_EPS); }
#pragma unroll
            for (int j = 0; j < 4; ++j) { const int col = 4 * F.lane + 256 * j; const f32x4 g = *(const f32x4*)(F.norm2_g + col), sh = *(const f32x4*)(mv + 3072 + col), sc = *(const f32x4*)(mv + 4096 + col);
                const f32x4 ga = g * (sc + 1.0f);
#pragma unroll
                for (int r = 0; r < 4; ++r) { xv[r][j] = (xv[r][j] * ss[r]) * ga + sh;
                    *(unsigned*)((unsigned char*)F.XN + (size_t)(row0 + r) * DM + col) = pk4_fp8(xv[r][j].x, xv[r][j].y, xv[r][j].z, xv[r][j].w); } }
            float logit[4] = {0.f, 0.f, 0.f, 0.f};
            const bool up = (F.lane & 32) != 0, up2 = (F.lane & 16) != 0; const int myg = (F.lane >> 1) & 7;
#pragma unroll 1
            for (int g = 0; g < 8; ++g) {
                float a[4][4];
#pragma unroll
                for (int r = 0; r < 4; ++r)
#pragma unroll
                    for (int ee = 0; ee < 4; ++ee) a[r][ee] = 0.f;
                const LAS float* wg_ = WRT + g * 4096;
#pragma unroll
                for (int ee = 0; ee < 4; ++ee) { const LAS float* wb = wg_ + ee * 1024 + ((4 * F.lane) ^ (((g * 4 + ee) & 15) << 2));
#pragma unroll
                    for (int j = 0; j < 4; ++j) { const f32x4 w = *(const LAS f32x4*)(wb + 256 * j);
#pragma unroll
                        for (int r = 0; r < 4; ++r) a[r][ee] += (xv[r][j].x * w.x + xv[r][j].y * w.y) + (xv[r][j].z * w.z + xv[r][j].w * w.w); } }
#pragma unroll
                for (int r = 0; r < 4; ++r) {
                    const float v0 = (up ? a[r][2] : a[r][0]) + __shfl_xor(up ? a[r][0] : a[r][2], 32);
                    const float v1 = (up ? a[r][3] : a[r][1]) + __shfl_xor(up ? a[r][1] : a[r][3], 32);
                    float v = (up2 ? v1 : v0) + __shfl_xor(up2 ? v0 : v1, 16);
                    v += __shfl_xor(v, 1); v += __shfl_xor(v, 2); v += __shfl_xor(v, 4); v += __shfl_xor(v, 8);
                    if (myg == g) logit[r] = v;
                }
            }
            const int e = 4 * myg + (up ? 2 : 0) + (up2 ? 1 : 0);
            const float br = F.b_router[e];
#pragma unroll
            for (int r = 0; r < 4; ++r) {
                unsigned u = __float_as_uint(logit[r] + br); u = (u & 0x80000000u) ? ~u : (u | 0x80000000u);
                unsigned long long key = ((unsigned long long)u << 32) | (unsigned)(31 - e);
                int ek[4]; float vk[4];
#pragma unroll
                for (int k = 0; k < 4; ++k) { const unsigned long long mx = wave_max64(key); ek[k] = 31 - (int)(mx & 31u); unsigned uu = (unsigned)(mx >> 32); uu = (uu & 0x80000000u) ? (uu & 0x7fffffffu) : ~uu; vk[k] = __uint_as_float(uu);
                    if (e == ek[k]) key = 0ull; }
                const float p1 = __expf(vk[1] - vk[0]), p2 = __expf(vk[2] - vk[0]), p3 = __expf(vk[3] - vk[0]); const float inv = 1.0f / (1.0f + p1 + p2 + p3);
                if (F.lane < 4 && !dry) { const int k = F.lane; const int ee = k == 0 ? ek[0] : (k == 1 ? ek[1] : (k == 2 ? ek[2] : ek[3])); const float gg = (k == 0 ? 1.0f : (k == 1 ? p1 : (k == 2 ? p2 : p3))) * inv;
                    const int rl = F.wave * 8 + grp * 4 + r; const int rank = __hip_atomic_fetch_add(lcnt + ee, 1, __ATOMIC_RELAXED, __HIP_MEMORY_SCOPE_WORKGROUP);
                    le[rl * 4 + k] = ee; lrk[rl * 4 + k] = rank; F.rgate[(size_t)(row0 + r) * 4 + k] = gg; }
            }
        }
        __syncthreads();
        if (F.tid < 32 && !dry) lbase[F.tid] = (int)__hip_atomic_fetch_add(gcnt + F.tid, (unsigned)lcnt[F.tid], __ATOMIC_RELAXED, __HIP_MEMORY_SCOPE_AGENT);
        __syncthreads();
        if (F.tid < 256 && !dry) { const int row = chunk * 64 + (F.tid >> 2), k = F.tid & 3; const int ee = le[F.tid]; const int slot = lbase[ee] + lrk[F.tid]; F.re[(size_t)row * 4 + k] = ee; F.rslot[(size_t)row * 4 + k] = slot; F.elist[ee * NTOK + slot] = row; }
        __syncthreads();
    }
}
__device__ __forceinline__ int expert_tables(Frame& F, LAS int* pst, LAS int* pexp) {
    LAS int* npan = pst + 40; LAS int* cntT = pexp + 320;
    if (F.tid < 64) {
        const int e = F.lane & 31; const int cnt = (int)__hip_atomic_load(F.ctl + CW_CNT + e, __ATOMIC_RELAXED, __HIP_MEMORY_SCOPE_AGENT);
        const int np = (cnt + 255) >> 8; int incl = np;
#pragma unroll
        for (int o = 1; o < 32; o <<= 1) { const int t = __shfl_up(incl, o, 32); if (e >= o) incl += t; }
        if (F.lane < 32) { const int st = incl - np; cntT[e] = cnt; pst[e] = st * 256; for (int i = 0; i < np; ++i) pexp[st + i] = e; if (e == 31) { pst[32] = incl * 256; npan[0] = incl; } } }
    __syncthreads();
    return npan[0];
}
__device__ __forceinline__ void p5b_scatter(Frame& F) {
    LAS int* pst = (LAS int*)(F.lds + XTRA_OFF); LAS int* pexp = pst + 64;
    (void)expert_tables(F, pst, pexp);
    const int gw = F.vcu * NWAVES + F.wave, NGW = F.G * NWAVES;
    for (int rr = gw; rr < NTOK * RP(F, 6); rr += NGW) { const int row = rr % NTOK;
        const v4u a = *(const v4u*)(F.XN + (size_t)row * DM + 8 * F.lane), b = *(const v4u*)(F.XN + (size_t)row * DM + 512 + 8 * F.lane);
#pragma unroll
        for (int k = 0; k < 4; ++k) { const int e = F.re[(size_t)row * 4 + k]; const int pos = pst[e] + F.rslot[(size_t)row * 4 + k];
            if (F.lane == 0) F.rpos[(size_t)row * 4 + k] = pos;
            *(v4u*)(F.XG + (size_t)pos * DM + 8 * F.lane) = a; *(v4u*)(F.XG + (size_t)pos * DM + 512 + 8 * F.lane) = b; }
    }
}
__device__ __forceinline__ void p8_final(Frame& F) {
    LAS int* pst = (LAS int*)(F.lds + XTRA_OFF); LAS int* pexp = pst + 64;
    (void)expert_tables(F, pst, pexp);
    const int gw = F.vcu * NWAVES + F.wave, NGW = F.G * NWAVES;
    typedef unsigned u32x2 __attribute__((ext_vector_type(2)));
    for (int pp = gw; pp < (NTOK / 2) * RP(F, 9); pp += NGW) { const int row0 = (pp % (NTOK / 2)) * 2;
        const float* g2 = F.modv + (row0 >> 13) * 6144 + 5120;
        int pos[2][4]; float gt[2][4];
#pragma unroll
        for (int q = 0; q < 2; ++q)
#pragma unroll
            for (int k = 0; k < 4; ++k) { const size_t ix = (size_t)(row0 + q) * 4 + k; pos[q][k] = pst[F.re[ix]] + F.rslot[ix]; gt[q][k] = F.rgate[ix]; }
        f32x4 xv[2][4]; unsigned yv[2][4][4];
#pragma unroll
        for (int q = 0; q < 2; ++q)
#pragma unroll
            for (int j = 0; j < 4; ++j) { const int col = 4 * F.lane + 256 * j; { const u32x2 t_ = *(const u32x2*)((const bf16*)F.X1 + (size_t)(row0 + q) * DM + col); xv[q][j] = (f32x4){bflo(t_.x), bfhi(t_.x), bflo(t_.y), bfhi(t_.y)}; }
#pragma unroll
                for (int k = 0; k < 4; ++k) yv[q][j][k] = *(const unsigned*)((const unsigned char*)F.Y2 + (size_t)pos[q][k] * DM + col); }
#pragma unroll
        for (int q = 0; q < 2; ++q) { float s = 0.f;
#pragma unroll
            for (int j = 0; j < 4; ++j) { const int col = 4 * F.lane + 256 * j; f32x4 a = {0.f, 0.f, 0.f, 0.f};
#pragma unroll
                for (int k = 0; k < 4; ++k) { const unsigned y = yv[q][j][k]; const auto lo2 = __builtin_amdgcn_cvt_pk_f32_fp8((int)y, false), hi2 = __builtin_amdgcn_cvt_pk_f32_fp8((int)y, true); a += (f32x4){lo2[0], lo2[1], hi2[0], hi2[1]} * gt[q][k]; }
                xv[q][j] = xv[q][j] + *(const f32x4*)(g2 + col) * a;
                s += (xv[q][j].x * xv[q][j].x + xv[q][j].y * xv[q][j].y) + (xv[q][j].z * xv[q][j].z + xv[q][j].w * xv[q][j].w); }
            const float rstd = 1.0f / sqrtf(wave_sum(s) * (1.f / DM) + NORM_EPS);
#pragma unroll
            for (int j = 0; j < 4; ++j) { const int col = 4 * F.lane + 256 * j; __builtin_nontemporal_store(xv[q][j] * rstd * *(const f32x4*)(F.final_g + col), (f32x4*)(F.out + (size_t)(row0 + q) * DM + col)); } }
    }
}

#ifndef FAST_GEMM
#define FAST_GEMM 1
#endif
#ifndef FAST_ATTN
#define FAST_ATTN 1
#endif
constexpr int N_PHASES = 10;
struct Args { const float* in[23]; float* out; unsigned char* ws; int ph_lo, ph_hi, use_bar, pad; };
__global__ void __launch_bounds__(NWAVES * 64, 2) mk_fwd(Args args) {
    extern __shared__ __attribute__((aligned(16))) unsigned char lds[];
    Frame F;
    F.lds = (LAS unsigned char*)lds; F.MISC = (volatile LAS unsigned*)(F.lds + MISC_OFF);
    F.tid = threadIdx.x; F.lane = F.tid & 63; F.wave = __builtin_amdgcn_readfirstlane(F.tid >> 6);
    F.probe = args.pad; F.G = gridDim.x; { const int bx = blockIdx.x; F.vcu = (F.G % 8 == 0) ? (bx % 8) * (F.G / 8) + bx / 8 : bx; }
    unsigned char* ws = args.ws;
    F.ctl = (gu32*)(ws + WS_CTL);
    F.x = args.in[0]; F.c = args.in[1]; F.ctx = args.in[2]; F.c_ctx = args.in[3]; F.w_mod = args.in[4]; F.b_mod = args.in[5]; F.norm1_g = args.in[6]; F.w_in = args.in[7];
    F.lq1 = args.in[8]; F.lk1 = args.in[9]; F.lq2 = args.in[10]; F.lk2 = args.in[11]; F.subln_g = args.in[12]; F.sink = args.in[13]; F.w_out = args.in[14]; F.norm2_g = args.in[15];
    F.w_router = args.in[16]; F.b_router = args.in[17]; F.w_gu = args.in[18]; F.b_gu = args.in[19]; F.w_dn = args.in[20]; F.b_dn = args.in[21]; F.final_g = args.in[22];
    F.out = args.out;
    F.modp = (float*)(ws + WS_MODP); F.modv = (float*)(ws + WS_MODV); F.rope = (float*)(ws + WS_ROPE); F.X1 = (float*)(ws + WS_X1);
    F.elist = (int*)(ws + WS_ELIST); F.re = (int*)(ws + WS_ROUTE); F.rslot = F.re + NTOK * 4; F.rgate = (float*)(F.rslot + NTOK * 4); F.rpos = (int*)(F.rgate + NTOK * 4);
    F.Win_t = (bf16*)(ws + WS_WIN); F.Wout_t = (bf16*)(ws + WS_WOUT); F.Wgu_t = (bf16*)(ws + WS_WGU); F.Wdn_t = (bf16*)(ws + WS_WDN);
    F.XN = (bf16*)(ws + WS_XN); F.QA = (bf16*)(ws + WS_QA); F.KA = (bf16*)(ws + WS_KA); F.VA = (bf16*)(ws + WS_VA); F.QB = (bf16*)(ws + WS_QB); F.KB = (bf16*)(ws + WS_KB); F.VB = (bf16*)(ws + WS_VB);
    F.Y = (bf16*)(ws + WS_Y); F.XG = (bf16*)(ws + WS_XG); F.H = (bf16*)(ws + WS_H); F.Y2 = (bf16*)(ws + WS_Y2);
    for (int u = F.tid; u < (LDS_BYTES - LDSCTL_OFF) / 4; u += NWAVES * 64) ((LAS unsigned*)(F.lds + LDSCTL_OFF))[u] = 0u;
    __syncthreads();
#ifdef SPIN_SEAM
#define STAMP(k) do { if ((k) == SPIN_SEAM && blockIdx.x == 0 && F.tid == 0) *(volatile LAS unsigned long long*)(F.lds + XTRA_OFF + 15008) = wall_clock64(); } while (0)
    if (blockIdx.x == 0 && F.tid == 0) { const unsigned long long t_ = wall_clock64(); *(volatile LAS unsigned long long*)(F.lds + XTRA_OFF + 15000) = t_; *(volatile LAS unsigned long long*)(F.lds + XTRA_OFF + 15008) = t_; }
#else
#define STAMP(k) do {} while (0)
#endif
    XcdBarrier bar; bar.bar = (unsigned*)(F.ctl + CW_BAR); bar.x = 0; bar.st = nullptr;
    if (args.use_bar) bar = xcd_barrier_post((unsigned*)(F.ctl + CW_BAR), F.MISC + 8);
    const int lo = args.ph_lo, hi = args.ph_hi;
#ifndef PH_MASK
#define PH_MASK 0x3ff
#endif
#define IN(k) (((PH_MASK >> (k)) & 1) && lo <= (k) && (k) < hi)
#ifndef REP_MASK
#define REP_MASK 0
#endif
#define SEAM(k) do { if (IN(k) && IN((k) + 1)) { if (args.use_bar) { xcd_barrier(bar); if (args.pad & 0x10000) { xcd_barrier(bar); xcd_barrier(bar); } } } else { __syncthreads(); } } while (0)

    if (IN(0)) { p0_prologue(F); } SEAM(0); STAMP(0);
    if (IN(1)) { p1_norm(F); } SEAM(1); STAMP(1);
    if (IN(2)) {
        EpiQKV E{F.QA, F.KA, F.VA, F.QB, F.KB, F.VB, F.rope};
#if FAST_GEMM
        if (F.G == 256 && (int)blockIdx.x >= P2_GEMM_WGS) p0_tail(F);
        else {
        pg8::Gemm g{F.XN, F.Win_t, NROW, INC, DM}; RepOrder S; S.init(NROW, INC, F.G == 256 ? P2_GEMM_WGS : F.G, (int)blockIdx.x); S.rep = RP(F, 2);
        EpiQKVFast EA{F.QA, F.KA, F.VA, F.QB, F.KB, F.VB, F.rope};
        pg8::gemm_phase<EpiQKVFast, RepOrder, true, true>(F.lds + RING_OFF, g, S, EA);
        }
#else
        naive_gemm(F, F.XN, NROW / 128, INC, DM, DenseSel{F.Win_t}, E);
#endif
    } SEAM(2); STAMP(2);
#if FAST_ATTN == 1
    if (IN(3)) { p3_vt_pass(F); if (args.use_bar) xcd_barrier(bar); else __syncthreads(); STAMP(10); p3_attention(F); } SEAM(3); STAMP(3);
#else
    if (IN(3)) { naive_diff_attn(F); __syncthreads(); naive_win_attn(F); } SEAM(3); STAMP(3);
#endif
    if (IN(4)) {
        EpiOut E{F.x, F.modv, (float*)((unsigned char*)F.XG + 32 * MiB)};
#if FAST_GEMM
        pg8::Gemm g{F.Y, F.Wout_t, NTOK, DM, DM}; RepOrder S; S.init(NTOK, DM, F.G, (int)blockIdx.x); S.rep = RP(F, 4);
        EpiAdapt<EpiOut, 0> EA{E};
        pg8::gemm_phase<EpiAdapt<EpiOut, 0>, RepOrder, true, true>(F.lds + RING_OFF, g, S, EA);
#else
        naive_gemm(F, F.Y, NTOK / 128, DM, DM, DenseSel{F.Wout_t}, E);
#endif
    } SEAM(4); STAMP(4);
    if (IN(5)) { p5a_route(F); } SEAM(5); STAMP(5);
    if (IN(7)) {
        LAS int* pst = (LAS int*)(F.lds + XTRA_OFF); LAS int* pexp = pst + 64; LAS int* cntT = pexp + 320; LAS int* tokT = (LAS int*)(F.lds + XTRA_OFF + 2048);
        const int NP = expert_tables(F, pst, pexp);
        EpiGU E{(unsigned char*)F.H, F.b_gu};
        GroupedOrder S{GUW / 256, NP, F.G, (int)blockIdx.x, pexp, RP(F, 7), tokT};
        { const int R = S.rounds();
          GroupedOrder S1 = S; S1.rep = 1; const int r = F.tid & 255; int tv[5];
#pragma unroll
          for (int q = 0; q < 5; ++q) { const int i = 2 * q + (F.tid >> 8); pg8::Unit u; tv[q] = -1;
              if (i < R && S1.next(i, u)) { const int e = pexp[u.pm], sl = u.pm * 256 - pst[e] + r; tv[q] = sl < cntT[e] ? F.elist[e * NTOK + sl] : 0; } }
#pragma unroll
          for (int q = 0; q < 5; ++q) { const int i = 2 * q + (F.tid >> 8); if (tv[q] >= 0) tokT[i * 256 + r] = tv[q]; }
          __syncthreads(); }
#if FAST_GEMM
        pg8::Gemm g{F.XN, F.Wgu_t, NP * 256, GUW, DM / 2};
        EpiAdapt<EpiGU, GUW / 256> EA{E};
        pg8::gemm_phase<EpiAdapt<EpiGU, GUW / 256>, GroupedOrder, true, true, true, true>(F.lds + RING_OFF, g, S, EA);
#else
#error "the naive GEMM path has no gather"
#endif
    } SEAM(7); STAMP(7);
    if (IN(8)) {
        LAS int* pst = (LAS int*)(F.lds + XTRA_OFF); LAS int* pexp = pst + 64;
        const int NP = expert_tables(F, pst, pexp);
        EpiDN E{F.Y2, F.b_dn};
#if FAST_GEMM
        pg8::Gemm g{F.H, F.Wdn_t, NP * 256, DM, DM / 2}; GroupedOrder S{DM / 256, NP, F.G, (int)blockIdx.x, pexp, RP(F, 8), nullptr};
        EpiAdaptP<EpiDN, DM / 256> EA{E};
        pg8::gemm_phase<EpiAdaptP<EpiDN, DM / 256>, GroupedOrder, true, true, false, true>(F.lds + RING_OFF, g, S, EA);
#else
        naive_gemm(F, F.H, NP * 2, DM, DM, GroupSel{F.Wdn_t, pexp, DM, DM}, E);
#endif
    } SEAM(8); STAMP(8);
    if (IN(9)) { p8_final(F); }
#ifdef SPIN_SEAM
    if (blockIdx.x == 0 && F.tid == 0) { const unsigned long long t0_ = *(volatile LAS unsigned long long*)(F.lds + XTRA_OFF + 15000), tk_ = *(volatile LAS unsigned long long*)(F.lds + XTRA_OFF + 15008);
        const unsigned long long te_ = wall_clock64(); while (wall_clock64() - te_ < tk_ - t0_) __builtin_amdgcn_s_sleep(8); }
#endif
#undef STAMP
#undef IN
#undef SEAM
}

#ifndef N_LAUNCH_MODE
#define N_LAUNCH_MODE 0
#endif
extern "C" void kernel_launch(void* const* d_in, const int* in_sizes, int n_in, void* d_out, int out_size, void* d_ws, size_t ws_size, hipStream_t stream) {
    static int grid = 0;
    if (grid == 0) {
        if (n_in != 23 || in_sizes[0] != NTOK * DM || out_size != NTOK * DM || ws_size < WS_END) { fprintf(stderr, "kernel_launch: unexpected shapes (n_in %d, in0 %d, out %d, ws %zu); nothing launched\n", n_in, n_in > 0 ? in_sizes[0] : -1, out_size, ws_size); grid = -1; return; }
        int dev = 0, cus = 0, per_cu = 0;
        if (hipGetDevice(&dev) != hipSuccess || hipDeviceGetAttribute(&cus, hipDeviceAttributeMultiprocessorCount, dev) != hipSuccess) { grid = -1; return; }
        if (hipFuncSetAttribute((const void*)mk_fwd, hipFuncAttributeMaxDynamicSharedMemorySize, LDS_BYTES) != hipSuccess) { fprintf(stderr, "kernel_launch: hipFuncSetAttribute failed\n"); grid = -1; return; }
        if (hipOccupancyMaxActiveBlocksPerMultiprocessor(&per_cu, (const void*)mk_fwd, NWAVES * 64, LDS_BYTES) != hipSuccess || per_cu < 1) fprintf(stderr, "kernel_launch: note: occupancy query reports %d\n", per_cu);
        (void)hipGetLastError();
        grid = cus;
    }
    if (grid < 0) return;
    if (hipMemsetAsync((char*)d_ws + WS_CTL, 0, CTL_ZERO_BYTES, stream) != hipSuccess) { fprintf(stderr, "kernel_launch: memset failed\n"); return; }
    Args a{};
    for (int i = 0; i < 23; ++i) a.in[i] = (const float*)d_in[i];
    a.out = (float*)d_out; a.ws = (unsigned char*)d_ws; a.pad = REP_MASK;
#if N_LAUNCH_MODE == 0
    a.ph_lo = 0; a.ph_hi = N_PHASES; a.use_bar = 1;
    hipLaunchKernelGGL(mk_fwd, dim3(grid), dim3(NWAVES * 64), LDS_BYTES, stream, a);
#else
    for (int p = 0; p < N_PHASES; ++p) { a.ph_lo = p; a.ph_hi = p + 1; a.use_bar = 0; hipLaunchKernelGGL(mk_fwd, dim3(grid), dim3(NWAVES * 64), LDS_BYTES, stream, a); }
#endif
}
```

```cpp
#include <hip/hip_runtime.h>
#include <cstdio>
#include <cstdint>
namespace pg8 {
#define PG8_LAS __attribute__((address_space(3)))
typedef unsigned short bf16_t;
typedef short bf16x8 __attribute__((ext_vector_type(8)));
typedef float f32x4 __attribute__((ext_vector_type(4)));
typedef unsigned u32x4 __attribute__((ext_vector_type(4)));
constexpr int BM = 256, BK = 64, HALF = 128, HTB = HALF * BK * 2  , STAGE_BYTES = 8 * HTB, NXCD = 8, WGM = 8;

__host__ __device__ __forceinline__ int lds_byte(int r, int c) { const int st = (r >> 4) * 2 + (c >> 5), rr = r & 15, cc = c & 31, ob = rr * 64 + cc * 2; return st * 1024 + (ob ^ (((ob >> 9) & 1) << 5)); }
__host__ __device__ __forceinline__ void stage_rc(int b, int& R, int& C) { const int st = b / 1024, sb = b % 1024, swz = sb ^ (((sb >> 9) & 1) << 5); R = (st >> 1) * 16 + swz / 64; C = (st & 1) * 32 + (swz % 64) / 2; }
__host__ __device__ __forceinline__ int perm32(int rho) { const int n = rho >> 4, i = rho & 15; return 8 * (i >> 2) + 4 * n + (i & 3); }

struct Unit { int pm, pn; };
struct Gemm { const bf16_t* A; const bf16_t* Bt; int M, N, K; };

struct StaticOrder {
    int nM, nN, nwg, G, c;
    __host__ __device__ void init(int M, int N, int G_, int c_) { nM = M / BM; nN = N / BM; nwg = nM * nN; G = G_; c = c_; }
    __host__ __device__ bool next(int i, Unit& u) const {
        const long L = (long)i * G + c; if (L >= nwg) return false;
        int wgid = (int)L; { const int q = nwg / NXCD, r = nwg % NXCD, xcd = wgid % NXCD, off = wgid / NXCD; wgid = (xcd < r ? xcd * (q + 1) : r * (q + 1) + (xcd - r) * q) + off; }
        const int nig = WGM * nN, gid = wgid / nig, fm = gid * WGM, gsz = (nM - fm) < WGM ? (nM - fm) : WGM;
        u.pm = fm + ((wgid % nig) % gsz); u.pn = (wgid % nig) / gsz; return true;
    }
    __device__ __forceinline__ void a_ready(const Unit&) const {}
    __device__ __forceinline__ void done(const Unit&) const {}
};

__device__ __forceinline__ unsigned cvt_pk_bf16(float lo, float hi) { unsigned r; asm volatile("v_cvt_pk_bf16_f32 %0, %1, %2" : "=v"(r) : "v"(lo), "v"(hi)); return r; }
typedef float f32x2 __attribute__((ext_vector_type(2)));
typedef int i32x4 __attribute__((ext_vector_type(4))); typedef int i32x8 __attribute__((ext_vector_type(8)));
__device__ __forceinline__ i32x8 cat8(bf16x8 a, bf16x8 b) { const i32x4 x = __builtin_bit_cast(i32x4, a), y = __builtin_bit_cast(i32x4, b); return __builtin_shufflevector(x, y, 0, 1, 2, 3, 4, 5, 6, 7); }
template <class Epi, class Sched, bool ALIGN_EPI = false, bool SP2 = false, bool GATHER = false, bool FP8 = false>
__device__ __forceinline__ void gemm_phase(PG8_LAS unsigned char* lds, const Gemm g, const Sched& S, const Epi& E) {
    const int tid = threadIdx.x, wid = __builtin_amdgcn_readfirstlane(tid >> 6), lane = tid & 63, wr = wid >> 2, wc = wid & 3, fr = lane & 15, fq = lane >> 4;
    const int K = g.K, nt = K / BK;
    unsigned voffA[2], voffB[2]; int RA[2]; unsigned CA2[2];
#pragma unroll
    for (int i = 0; i < 2; ++i) { int R, C; stage_rc(tid * 16 + i * 8192, R, C); const int Rb = Epi::PERM ? ((R & ~31) + perm32(R & 31)) : R;
        voffA[i] = (unsigned)(R * K + C) * 2u; voffB[i] = (unsigned)(Rb * K + C) * 2u; RA[i] = R; CA2[i] = (unsigned)C * 2u; }
    static_assert(!GATHER || SP2, "GATHER is wired into the SP2 loop only");
    unsigned gA[2][2], gN[2][2];
    const size_t kstep = (size_t)(BK * 2);
    const size_t hstep = (size_t)HALF * K * 2;
    const size_t tstep = 2 * hstep;
    const unsigned ldsw = (unsigned)wid * 1024u;
    const int aoff = lds_byte(wr * 64 + fr, fq * 8), boff = lds_byte(wc * 32 + fr, fq * 8);
#define PG8_SA(b, h) (((b) * 2 + (h)) * HTB)
#define PG8_SB(b, h) ((4 + (b) * 2 + (h)) * HTB)
#define PG8_STAGE(bufoff, gbase, voff) do { _Pragma("unroll") for (int _i = 0; _i < 2; ++_i) \
        __builtin_amdgcn_global_load_lds((const unsigned*)((const char*)(gbase) + (voff)[_i]), (PG8_LAS unsigned*)(lds + (bufoff) + ldsw + _i * 8192), 16, 0, 0); } while (0)
#define PG8_STAGEG(bufoff, kbytes, v0, v1) do { \
        __builtin_amdgcn_global_load_lds((const unsigned*)((const char*)g.A + (kbytes) + (v0)), (PG8_LAS unsigned*)(lds + (bufoff) + ldsw), 16, 0, 0); \
        __builtin_amdgcn_global_load_lds((const unsigned*)((const char*)g.A + (kbytes) + (v1)), (PG8_LAS unsigned*)(lds + (bufoff) + ldsw + 8192), 16, 0, 0); } while (0)
#define PG8_GOFF(dst, ui_) do { _Pragma("unroll") for (int h_ = 0; h_ < 2; ++h_) _Pragma("unroll") for (int i_ = 0; i_ < 2; ++i_) dst[h_][i_] = (unsigned)S.tok((ui_), h_ * HALF + RA[i_]) * (unsigned)(K * 2) + CA2[i_]; } while (0)
#define PG8_LDA(dst, b, h) do { _Pragma("unroll") for (int m = 0; m < 4; ++m) _Pragma("unroll") for (int k = 0; k < 2; ++k) dst[m][k] = *(const PG8_LAS bf16x8*)(lds + PG8_SA(b, h) + aoff + m * 2048 + k * 1024); } while (0)
#define PG8_LDB(dst, b, h) do { _Pragma("unroll") for (int n = 0; n < 2; ++n) _Pragma("unroll") for (int k = 0; k < 2; ++k) dst[n][k] = *(const PG8_LAS bf16x8*)(lds + PG8_SB(b, h) + boff + n * 2048 + k * 1024); } while (0)
#define PG8_MMA(ai, bj, At, Bt) do { __builtin_amdgcn_s_setprio(1); _Pragma("unroll") for (int m = 0; m < 4; ++m) _Pragma("unroll") for (int n = 0; n < 2; ++n) { \
        if constexpr (FP8) { const i32x8 a8_ = cat8(Bt[n][0], Bt[n][1]), b8_ = cat8(At[m][0], At[m][1]); \
            asm volatile("v_mfma_scale_f32_16x16x128_f8f6f4 %0, %1, %2, %0, %3, %4 op_sel_hi:[0,0,0]" : "+v"(acc[ai][bj][m][n]) : "v"(a8_), "v"(b8_), "v"(sc_w8), "v"(sc_a8)); } \
        else { _Pragma("unroll") for (int k = 0; k < 2; ++k) acc[ai][bj][m][n] = __builtin_amdgcn_mfma_f32_16x16x32_bf16(Bt[n][k], At[m][k], acc[ai][bj][m][n], 0, 0, 0); } } \
        __builtin_amdgcn_s_setprio(0); } while (0)
#define PG8_WAIT_V(n) asm volatile("s_waitcnt vmcnt(" #n ")" ::: "memory")
#define PG8_WAIT_L(n) asm volatile("s_waitcnt lgkmcnt(" #n ")" ::: "memory")
#define PG8_BAR __builtin_amdgcn_s_barrier()
#define PG8_SCHED __builtin_amdgcn_sched_barrier(0)
    int sc_w8 = 0x7A7A7A7A, sc_a8 = 0x7F7F7F7F;
    asm volatile("" : "+v"(sc_w8), "+v"(sc_a8));
    Unit cur, nxt; int ui = 0;
    if (!S.next(0, cur)) return;
    f32x4 acc[2][2][4][2];
#pragma unroll
    for (int a = 0; a < 2; ++a)
#pragma unroll
        for (int b = 0; b < 2; ++b)
#pragma unroll
            for (int m = 0; m < 4; ++m)
#pragma unroll
                for (int n = 0; n < 2; ++n) acc[a][b][m][n] = (f32x4){0.f, 0.f, 0.f, 0.f};
    bf16x8 At[4][2], B0[2][2], B1[2][2];
    const char* cA = (const char*)g.A + (size_t)cur.pm * tstep; const char* cB = (const char*)g.Bt + (size_t)cur.pn * tstep;
    S.a_ready(cur);
    if constexpr (SP2) {
        if constexpr (GATHER) { PG8_GOFF(gA, 0); }
        PG8_STAGE(PG8_SB(0, 0), cB, voffB); PG8_STAGE(PG8_SB(0, 1), cB + hstep, voffB);
        if constexpr (GATHER) { PG8_STAGEG(PG8_SA(0, 0), 0, gA[0][0], gA[0][1]); PG8_STAGEG(PG8_SA(0, 1), 0, gA[1][0], gA[1][1]); } else { PG8_STAGE(PG8_SA(0, 0), cA, voffA); PG8_STAGE(PG8_SA(0, 1), cA + hstep, voffA); }
        if (wr == 1) PG8_BAR;
        PG8_WAIT_V(2); PG8_BAR;
        PG8_STAGE(PG8_SB(1, 0), cB + kstep, voffB); if constexpr (GATHER) { PG8_STAGEG(PG8_SA(1, 0), kstep, gA[0][0], gA[0][1]); } else { PG8_STAGE(PG8_SA(1, 0), cA + kstep, voffA); } PG8_STAGE(PG8_SB(1, 1), cB + hstep + kstep, voffB);
        PG8_WAIT_V(6); PG8_BAR;
    } else {
        PG8_STAGE(PG8_SB(0, 0), cB, voffB); PG8_STAGE(PG8_SA(0, 0), cA, voffA); PG8_STAGE(PG8_SB(0, 1), cB + hstep, voffB); PG8_STAGE(PG8_SA(0, 1), cA + hstep, voffA);
        if (wr == 1) PG8_BAR;
        PG8_WAIT_V(4); PG8_BAR;
        PG8_STAGE(PG8_SB(1, 0), cB + kstep, voffB); PG8_STAGE(PG8_SA(1, 0), cA + kstep, voffA); PG8_STAGE(PG8_SB(1, 1), cB + hstep + kstep, voffB);
        PG8_WAIT_V(6); PG8_BAR;
    }
    for (;;) {
        const bool has_next = S.next(ui + 1, nxt);
        const char* nA = has_next ? (const char*)g.A + (size_t)nxt.pm * tstep : cA; const char* nB = has_next ? (const char*)g.Bt + (size_t)nxt.pn * tstep : cB;
        if constexpr (GATHER) { if (has_next) { PG8_GOFF(gN, ui + 1); } else { _Pragma("unroll") for (int h_ = 0; h_ < 2; ++h_) _Pragma("unroll") for (int i_ = 0; i_ < 2; ++i_) gN[h_][i_] = gA[h_][i_]; } }
#pragma unroll 1
        for (int t = 0; t < nt; t += 2) {
            const bool last = (t == nt - 2);
            const char* a1 = cA + (size_t)(t + 1) * kstep;
            const char* a2 = last ? nA : cA + (size_t)(t + 2) * kstep; const char* b2 = last ? nB : cB + (size_t)(t + 2) * kstep;
            const char* a3 = a2 + kstep; const char* b3 = b2 + kstep;
            if (last && has_next) S.a_ready(nxt);
            if constexpr (SP2) {
            const size_t k1_ = (size_t)(t + 1) * kstep, k2_ = last ? (size_t)0 : (size_t)(t + 2) * kstep;
            const unsigned s00_ = last ? gN[0][0] : gA[0][0], s01_ = last ? gN[0][1] : gA[0][1], s10_ = last ? gN[1][0] : gA[1][0], s11_ = last ? gN[1][1] : gA[1][1];
            PG8_LDB(B0, 0, 0); PG8_LDB(B1, 0, 1); PG8_SCHED; PG8_LDA(At, 0, 0); if constexpr (GATHER) { PG8_STAGEG(PG8_SA(1, 1), k1_, gA[1][0], gA[1][1]); } else { PG8_STAGE(PG8_SA(1, 1), a1 + hstep, voffA); }
            PG8_WAIT_V(8); PG8_WAIT_L(0); PG8_BAR; PG8_MMA(0, 0, At, B0); PG8_MMA(0, 1, At, B1); PG8_BAR; PG8_SCHED;
            PG8_LDA(At, 0, 1); PG8_STAGE(PG8_SB(0, 0), b2, voffB); PG8_STAGE(PG8_SB(0, 1), b2 + hstep, voffB); if constexpr (GATHER) { PG8_STAGEG(PG8_SA(0, 0), k2_, s00_, s01_); } else { PG8_STAGE(PG8_SA(0, 0), a2, voffA); }
            PG8_WAIT_V(8); PG8_WAIT_L(0); PG8_BAR; PG8_MMA(1, 0, At, B0); PG8_MMA(1, 1, At, B1); PG8_BAR; PG8_SCHED;
            PG8_LDB(B0, 1, 0); PG8_LDB(B1, 1, 1); PG8_SCHED; PG8_LDA(At, 1, 0); if constexpr (GATHER) { PG8_STAGEG(PG8_SA(0, 1), k2_, s10_, s11_); } else { PG8_STAGE(PG8_SA(0, 1), a2 + hstep, voffA); }
            PG8_WAIT_V(8); PG8_WAIT_L(0); PG8_BAR; PG8_MMA(0, 0, At, B0); PG8_MMA(0, 1, At, B1); PG8_BAR; PG8_SCHED;
            PG8_LDA(At, 1, 1); PG8_STAGE(PG8_SB(1, 0), b3, voffB); PG8_STAGE(PG8_SB(1, 1), b3 + hstep, voffB); if constexpr (GATHER) { PG8_STAGEG(PG8_SA(1, 0), k2_ + kstep, s00_, s01_); } else { PG8_STAGE(PG8_SA(1, 0), a3, voffA); }
            PG8_WAIT_V(8); PG8_WAIT_L(0); PG8_BAR; PG8_MMA(1, 0, At, B0); PG8_MMA(1, 1, At, B1); PG8_BAR; PG8_SCHED;
            } else {
            PG8_LDB(B0, 0, 0); PG8_SCHED; PG8_LDA(At, 0, 0); PG8_STAGE(PG8_SA(1, 1), a1 + hstep, voffA);
            PG8_WAIT_L(8); PG8_BAR; PG8_WAIT_L(0); PG8_MMA(0, 0, At, B0); PG8_BAR; PG8_SCHED;
            PG8_LDB(B1, 0, 1); PG8_STAGE(PG8_SB(0, 0), b2, voffB);
            PG8_BAR; PG8_WAIT_L(0); PG8_MMA(0, 1, At, B1); PG8_BAR;
            PG8_LDA(At, 0, 1); PG8_STAGE(PG8_SA(0, 0), a2, voffA);
            PG8_BAR; PG8_WAIT_L(0); PG8_MMA(1, 0, At, B0); PG8_BAR; PG8_SCHED;
            PG8_STAGE(PG8_SB(0, 1), b2 + hstep, voffB);
            PG8_WAIT_V(6); PG8_BAR; PG8_MMA(1, 1, At, B1); PG8_BAR;
            PG8_LDB(B0, 1, 0); PG8_SCHED; PG8_LDA(At, 1, 0); PG8_STAGE(PG8_SA(0, 1), a2 + hstep, voffA);
            PG8_WAIT_L(8); PG8_BAR; PG8_WAIT_L(0); PG8_MMA(0, 0, At, B0); PG8_BAR; PG8_SCHED;
            PG8_LDB(B1, 1, 1); PG8_STAGE(PG8_SB(1, 0), b3, voffB);
            PG8_BAR; PG8_WAIT_L(0); PG8_MMA(0, 1, At, B1); PG8_BAR;
            PG8_LDA(At, 1, 1); PG8_STAGE(PG8_SA(1, 0), a3, voffA);
            PG8_BAR; PG8_WAIT_L(0); PG8_MMA(1, 0, At, B0); PG8_BAR; PG8_SCHED;
            PG8_STAGE(PG8_SB(1, 1), b3 + hstep, voffB);
            PG8_WAIT_V(6); PG8_BAR; PG8_MMA(1, 1, At, B1); PG8_BAR;
            }
        }
        if constexpr (FP8) { asm volatile("s_nop 15\n\ts_nop 15" ::: "memory"); }
        if constexpr (ALIGN_EPI) { if (wr == 0) PG8_BAR; }
        if constexpr (!Epi::AFTER_DRAIN) { E(acc, cur, wr, wc, fr, fq); S.done(cur); }
        if (!has_next) break;
#pragma unroll
        for (int a = 0; a < 2; ++a)
#pragma unroll
            for (int b = 0; b < 2; ++b)
#pragma unroll
                for (int m = 0; m < 4; ++m)
#pragma unroll
                    for (int n = 0; n < 2; ++n) acc[a][b][m][n] = (f32x4){0.f, 0.f, 0.f, 0.f};
        cur = nxt; cA = nA; cB = nB; ++ui;
        if constexpr (GATHER) { _Pragma("unroll") for (int h_ = 0; h_ < 2; ++h_) _Pragma("unroll") for (int i_ = 0; i_ < 2; ++i_) gA[h_][i_] = gN[h_][i_]; }
        if constexpr (ALIGN_EPI) { if (wr == 1) PG8_BAR; }
    }
    PG8_WAIT_V(0);
    if constexpr (!ALIGN_EPI) { if (wr == 0) PG8_BAR; }
    PG8_BAR;
    if constexpr (Epi::AFTER_DRAIN) { E.fused(acc, cur, wr, wc, fr, fq, lds, wid, lane); S.done(cur); }
#undef PG8_SA
#undef PG8_SB
#undef PG8_STAGE
#undef PG8_STAGEG
#undef PG8_GOFF
#undef PG8_LDA
#undef PG8_LDB
#undef PG8_MMA
#undef PG8_WAIT_V
#undef PG8_WAIT_L
#undef PG8_BAR
#undef PG8_SCHED
}
}
#define GAS __attribute__((address_space(1)))
#define LAS __attribute__((address_space(3)))
typedef unsigned short bf16;
typedef unsigned v4u __attribute__((ext_vector_type(4)));
typedef float f32x4 __attribute__((ext_vector_type(4)));
typedef short bf16x8 __attribute__((ext_vector_type(8)));
typedef GAS unsigned gu32;
typedef GAS unsigned long long gu64;
#define RLX_AGENT __ATOMIC_RELAXED, __HIP_MEMORY_SCOPE_AGENT
#define LDS_WAIT() asm volatile("s_waitcnt lgkmcnt(0)" ::: "memory")
#define VM_WAIT() asm volatile("s_waitcnt vmcnt(0)" ::: "memory")
__device__ __forceinline__ unsigned long long rt() { return __builtin_amdgcn_s_memrealtime(); }
__device__ __forceinline__ unsigned f2bf(float f) { unsigned u = __builtin_bit_cast(unsigned, f); return (u + 0x7fffu + ((u >> 16) & 1u)) >> 16; }
__device__ __forceinline__ unsigned pk2(float lo, float hi) { return f2bf(lo) | (f2bf(hi) << 16); }
#define XB_TMO      128
#define XB_XCNT(j)  (256  + 64 * (j))
#define XB_XSUB(j)  (1280 + 64 * (j))
#define XB_XGEN(j)  (2304 + 64 * (j))
#define XB_TOP      3328
#define XB_TOPGEN   3392
#define XCD_BAR_WORDS 3456
#define XB_SPIN_CAP (1u << 22)

__device__ __forceinline__ unsigned xb_ld(unsigned* p)              { return __hip_atomic_load(p, __ATOMIC_RELAXED, __HIP_MEMORY_SCOPE_AGENT); }
__device__ __forceinline__ unsigned xb_add(unsigned* p, unsigned v) { return __hip_atomic_fetch_add(p, v, __ATOMIC_RELAXED, __HIP_MEMORY_SCOPE_AGENT); }
__device__ __forceinline__ unsigned xb_xcc_id() { return (unsigned)__builtin_amdgcn_s_getreg((3 << 11) | 20) & 0xFu; }
#define XB_SPIN(cond, bar) do { unsigned _sp = 0; while (cond) { __builtin_amdgcn_s_sleep(1); \
    if ((++_sp & 255u) == 0u) { if (xb_ld(&(bar)[XB_TMO])) break; if (_sp > XB_SPIN_CAP) { atomicAdd(&(bar)[XB_TMO], 1u); break; } } } } while (0)

struct XcdBarrier {
    unsigned* bar; unsigned x;
    volatile LAS unsigned* st;
};

__device__ __forceinline__ XcdBarrier xcd_barrier_post(unsigned* bar, volatile LAS unsigned* st) {
    XcdBarrier b; b.bar = bar; b.x = xb_xcc_id(); b.st = st;
    if (threadIdx.x == 0) (void)xb_add(&bar[XB_XCNT(b.x)], 1u);
    return b;
}
__device__ __forceinline__ void xcd_barrier_complete(unsigned* bar, unsigned x, unsigned& nloc, unsigned& nx) {
    const unsigned G = gridDim.x * gridDim.y * gridDim.z;
    unsigned sum, cnt, mine, sp = 0u;
    for (;;) {
        sum = 0u; cnt = 0u; mine = 0u;
#pragma unroll
        for (unsigned j = 0; j < 16; ++j) { const unsigned c = xb_ld(&bar[XB_XCNT(j)]); sum += c; cnt += (c > 0u) ? 1u : 0u; mine = (j == x) ? c : mine; }
        if (sum == G) break;
        __builtin_amdgcn_s_sleep(1);
        if ((++sp & 255u) == 0u) { if (xb_ld(&bar[XB_TMO])) break; if (sp > XB_SPIN_CAP) { atomicAdd(&bar[XB_TMO], 1u); break; } }
    }
    nloc = mine > 0u ? mine : 1u; nx = cnt > 0u ? cnt : 1u;
}

__device__ __forceinline__ void xcd_barrier(const XcdBarrier& b) {
    asm volatile("s_waitcnt vmcnt(0)" ::: "memory");
    __syncthreads();
    if (threadIdx.x == 0) {
        unsigned* bar = b.bar;
        __builtin_amdgcn_s_waitcnt(0);
        unsigned nloc = b.st[0], nx = b.st[1];
        if (nloc == 0u) { xcd_barrier_complete(bar, b.x, nloc, nx); b.st[0] = nloc; b.st[1] = nx; }
        const unsigned old = xb_add(&bar[XB_XSUB(b.x)], 1u);
        const unsigned gen = old / nloc;
        if (old + 1u == (gen + 1u) * nloc) {
            __builtin_amdgcn_fence(__ATOMIC_RELEASE, "agent");
            asm volatile("s_waitcnt vmcnt(0)" ::: "memory");
            const unsigned og = xb_add(&bar[XB_TOP], 1u);
            const unsigned tg = og / nx;
            if (og + 1u == (tg + 1u) * nx) xb_add(&bar[XB_TOPGEN], 1u);
            else XB_SPIN(xb_ld(&bar[XB_TOPGEN]) == tg, bar);
            __builtin_amdgcn_fence(__ATOMIC_ACQUIRE, "agent");
            xb_add(&bar[XB_XGEN(b.x)], 1u);
            asm volatile("s_waitcnt vmcnt(0)" ::: "memory");
        } else {
            XB_SPIN(xb_ld(&bar[XB_XGEN(b.x)]) == gen, bar);
            __builtin_amdgcn_fence(__ATOMIC_ACQUIRE, "agent");
            asm volatile("s_waitcnt vmcnt(0)" ::: "memory");
        }
    }
    __syncthreads();
}

constexpr int BATCH = 2, SEQ = 8192, DM = 1024, CTXL = 256;
constexpr int NTOK = BATCH * SEQ, NCTXR = BATCH * CTXL, NROW = NTOK + NCTXR, KVLEN = SEQ + CTXL;
constexpr int INC = 2304, NEXP = 32, TOPK = 4, GUW = 2048;
constexpr int NPAD_MAX = NTOK * TOPK + NEXP * 256;
constexpr float NORM_EPS = 1e-6f, LOG2E = 1.4426950408889634f, QSCALE = 0.125f * 1.4426950408889634f;
constexpr int NWAVES = 8;


namespace at2 {
typedef short bf16x8 __attribute__((ext_vector_type(8)));
typedef short s16x4 __attribute__((ext_vector_type(4)));
typedef float f32x16 __attribute__((ext_vector_type(16)));
typedef unsigned u32x4 __attribute__((ext_vector_type(4)));
constexpr int SHM_V = 16384, SHM_K = 16384, AT_WS_OFF = 73728, AT_WS3_OFF = 98304, XROW = 132, XROWW = 68;
constexpr int SDEPTH = 1;
constexpr float THRL = 8.0f;
#define AT_LAS __attribute__((address_space(3)))
#define KSWZ(row, colB) ((row) * 256 + ((colB) ^ (((row) & 7) << 4)))
#define SBAR() __builtin_amdgcn_sched_barrier(0)
__device__ __forceinline__ int crow(int r, int hi) { return (r & 3) + 8 * (r >> 2) + 4 * hi; }
typedef float f32x2_t __attribute__((ext_vector_type(2))); typedef __bf16 bf16x2_t __attribute__((ext_vector_type(2)));
__device__ __forceinline__ unsigned cvtpk2(float lo, float hi) { f32x2_t v = {lo, hi}; bf16x2_t b = __builtin_convertvector(v, bf16x2_t); return __builtin_bit_cast(unsigned, b); }
__device__ __forceinline__ void partialSM(f32x16& p0, f32x16& p1, float& m_reg, float& alpha) {
  float pmax = p0[0];
#pragma unroll
  for (int r = 1; r < 16; ++r) pmax = fmaxf(pmax, p0[r]);
#pragma unroll
  for (int r = 0; r < 16; ++r) pmax = fmaxf(pmax, p1[r]);
  { auto rr = __builtin_amdgcn_permlane32_swap(__float_as_uint(pmax), __float_as_uint(pmax), false, false); pmax = fmaxf(__uint_as_float(rr[0]), __uint_as_float(rr[1])); }
  float mn;
  if (__builtin_expect(__all(pmax - m_reg <= THRL), 1)) { mn = m_reg; alpha = 1.f; }
  else { mn = fmaxf(m_reg, pmax); alpha = __builtin_amdgcn_exp2f(m_reg - mn); m_reg = mn; }
#pragma unroll
  for (int r = 0; r < 16; ++r) p0[r] = p0[r] - mn;
#pragma unroll
  for (int r = 0; r < 16; ++r) p1[r] = p1[r] - mn;
#pragma unroll
  for (int r = 0; r < 16; ++r) p0[r] = __builtin_amdgcn_exp2f(p0[r]);
}
__device__ __forceinline__ void finishSM(f32x16& p0, f32x16& p1, float alpha, float& l_reg, bf16x8& pa0, bf16x8& pa1, bf16x8& pa2, bf16x8& pa3) {
#pragma unroll
  for (int r = 0; r < 16; ++r) p1[r] = __builtin_amdgcn_exp2f(p1[r]);
  float ps = 0;
#pragma unroll
  for (int r = 0; r < 16; ++r) ps += p0[r];
#pragma unroll
  for (int r = 0; r < 16; ++r) ps += p1[r];
  { auto rr = __builtin_amdgcn_permlane32_swap(__float_as_uint(ps), __float_as_uint(ps), false, false); ps = __uint_as_float(rr[0]) + __uint_as_float(rr[1]); }
  l_reg = l_reg * alpha + ps;
#define PK4(P, BASE, OUT) do { unsigned a0 = cvtpk2(P[BASE + 0], P[BASE + 1]), a1 = cvtpk2(P[BASE + 2], P[BASE + 3]);   \
    unsigned b0 = cvtpk2(P[BASE + 4], P[BASE + 5]), b1 = cvtpk2(P[BASE + 6], P[BASE + 7]);                              \
    auto r0 = __builtin_amdgcn_permlane32_swap(a0, b0, false, false); auto r1 = __builtin_amdgcn_permlane32_swap(a1, b1, false, false); \
    u32x4 w = {r0[0], r1[0], r0[1], r1[1]}; OUT = __builtin_bit_cast(bf16x8, w); } while (0)
  PK4(p0, 0, pa0); PK4(p0, 8, pa1); PK4(p1, 0, pa2); PK4(p1, 8, pa3);
#undef PK4
}
__device__ __forceinline__ void qkt(f32x16& p0, f32x16& p1, const AT_LAS char* Ks, const bf16x8* qr, int r32, int hi) {
  p0 = f32x16{}; p1 = f32x16{};
#pragma unroll
  for (int d0 = 0; d0 < 4; ++d0) { const int cb = (d0 * 16 + hi * 8) * 2;
    const bf16x8 b0 = *(const AT_LAS bf16x8*)(Ks + KSWZ(r32, cb));
    const bf16x8 b1 = *(const AT_LAS bf16x8*)(Ks + KSWZ(32 + r32, cb));
    p0 = __builtin_amdgcn_mfma_f32_32x32x16_bf16(b0, qr[d0], p0, 0, 0, 0);
    p1 = __builtin_amdgcn_mfma_f32_32x32x16_bf16(b1, qr[d0], p1, 0, 0, 0); }
}
__device__ __forceinline__ int v_st(int k, int c) { const int kk = (k & ~0xC) | ((k & 4) << 1) | ((k & 8) >> 1); return ((kk >> 3) * 4 + (c >> 5)) * 512 + ((kk & 7) * 32 + (c & 31)) * 2; }
__device__ __forceinline__ int v_rd_base(int lane) { return ((lane & 3) << 3) | (((lane >> 2) & 3) << 6) | (((lane >> 4) & 1) << 5) | (((lane >> 5) & 1) << 8); }
constexpr int v_rd_off(int d0, int ks, int half) { return d0 * 512 + ks * 4096 + half * 2048; }
template <int OFF> __device__ __forceinline__ s16x4 tr_read(int vb) { s16x4 r; asm volatile("ds_read_b64_tr_b16 %0, %1 offset:%2" : "=&v"(r) : "v"(vb), "i"(OFF) : "memory"); return r; }
template <int D0> __device__ __forceinline__ void pv_one(f32x16& od, int vb, bf16x8 pa0, bf16x8 pa1, bf16x8 pa2, bf16x8 pa3) {
  const s16x4 l0 = tr_read<v_rd_off(D0, 0, 0)>(vb), h0 = tr_read<v_rd_off(D0, 0, 1)>(vb), l1 = tr_read<v_rd_off(D0, 1, 0)>(vb), h1 = tr_read<v_rd_off(D0, 1, 1)>(vb);
  const s16x4 l2 = tr_read<v_rd_off(D0, 2, 0)>(vb), h2 = tr_read<v_rd_off(D0, 2, 1)>(vb), l3 = tr_read<v_rd_off(D0, 3, 0)>(vb), h3 = tr_read<v_rd_off(D0, 3, 1)>(vb);
  asm volatile("s_waitcnt lgkmcnt(0)" ::: "memory"); SBAR();
#define PK(L, H) (bf16x8){L[0], L[1], L[2], L[3], H[0], H[1], H[2], H[3]}
  od = __builtin_amdgcn_mfma_f32_32x32x16_bf16(pa0, PK(l0, h0), od, 0, 0, 0);
  od = __builtin_amdgcn_mfma_f32_32x32x16_bf16(pa1, PK(l1, h1), od, 0, 0, 0);
  od = __builtin_amdgcn_mfma_f32_32x32x16_bf16(pa2, PK(l2, h2), od, 0, 0, 0);
  od = __builtin_amdgcn_mfma_f32_32x32x16_bf16(pa3, PK(l3, h3), od, 0, 0, 0);
#undef PK
}
typedef short v4i16_t __attribute__((ext_vector_type(4)));
__device__ __forceinline__ s16x4 vtr(int vb, int off) { return __builtin_bit_cast(s16x4, __builtin_amdgcn_ds_read_tr16_b64_v4i16((AT_LAS v4i16_t*)(unsigned)(vb + off))); }
template <int D0> __device__ __forceinline__ void pv_one_b(f32x16& od, int vb, bf16x8 pa0, bf16x8 pa1, bf16x8 pa2, bf16x8 pa3) {
  const s16x4 l0 = vtr(vb, v_rd_off(D0, 0, 0)), h0 = vtr(vb, v_rd_off(D0, 0, 1)), l1 = vtr(vb, v_rd_off(D0, 1, 0)), h1 = vtr(vb, v_rd_off(D0, 1, 1));
  const s16x4 l2 = vtr(vb, v_rd_off(D0, 2, 0)), h2 = vtr(vb, v_rd_off(D0, 2, 1)), l3 = vtr(vb, v_rd_off(D0, 3, 0)), h3 = vtr(vb, v_rd_off(D0, 3, 1));
#define PK(L, H) (bf16x8){L[0], L[1], L[2], L[3], H[0], H[1], H[2], H[3]}
  od = __builtin_amdgcn_mfma_f32_32x32x16_bf16(pa0, PK(l0, h0), od, 0, 0, 0);
  od = __builtin_amdgcn_mfma_f32_32x32x16_bf16(pa1, PK(l1, h1), od, 0, 0, 0);
  od = __builtin_amdgcn_mfma_f32_32x32x16_bf16(pa2, PK(l2, h2), od, 0, 0, 0);
  od = __builtin_amdgcn_mfma_f32_32x32x16_bf16(pa3, PK(l3, h3), od, 0, 0, 0);
#undef PK
}
template <int NDB> __device__ __forceinline__ void pv_all_b(f32x16* o, int vb, bf16x8 pa0, bf16x8 pa1, bf16x8 pa2, bf16x8 pa3) {
  pv_one_b<0>(o[0], vb, pa0, pa1, pa2, pa3); pv_one_b<1>(o[1], vb, pa0, pa1, pa2, pa3);
  if constexpr (NDB == 4) { pv_one_b<2>(o[2], vb, pa0, pa1, pa2, pa3); pv_one_b<3>(o[3], vb, pa0, pa1, pa2, pa3); }
}
template <int NDB> __device__ __forceinline__ void pv_all(f32x16* o, int vb, bf16x8 pa0, bf16x8 pa1, bf16x8 pa2, bf16x8 pa3) {
  pv_one<0>(o[0], vb, pa0, pa1, pa2, pa3); pv_one<1>(o[1], vb, pa0, pa1, pa2, pa3);
  if constexpr (NDB == 4) { pv_one<2>(o[2], vb, pa0, pa1, pa2, pa3); pv_one<3>(o[3], vb, pa0, pa1, pa2, pa3); }
}
__device__ __forceinline__ void wmask(f32x16& p0, f32x16& p1, int k0, int q, int hi) {
#pragma unroll
  for (int r = 0; r < 16; ++r) { const int d = k0 + crow(r, hi) - q; if (d > 128 || d < -128) p0[r] = -1e30f; if (d + 32 > 128 || d + 32 < -128) p1[r] = -1e30f; }
}

struct UnitArgs {
  const bf16* Q; int ldq;
  const bf16* K; const bf16* V; int ldk;
  int kcolB;
  int vcolB;
  int q0;
  int ks;
};
template <bool DIFF> __device__ __forceinline__ int tile_k0(const UnitArgs& a, int j) { if constexpr (DIFF) return 64 * j; else return j < 4 ? SEQ + 64 * j : a.ks + 64 * (j - 4); }

#define RD128(dst, addr, OFF) asm volatile("ds_read_b128 %0, %1 offset:%2" : "=v"(dst) : "v"(addr), "i"(OFF) : "memory")
#define RDTR(dst, addr, OFF) asm volatile("ds_read_b64_tr_b16 %0, %1 offset:%2" : "=v"(dst) : "v"(addr), "i"(OFF) : "memory")
#define WAITL8_4(n, a, b, c, d) asm volatile("s_waitcnt lgkmcnt(" #n ")" : "+v"(a), "+v"(b), "+v"(c), "+v"(d) :: "memory")
#define WAITL8_8(n, a, b, c, d, e, f, g, h) asm volatile("s_waitcnt lgkmcnt(" #n ")" : "+v"(a), "+v"(b), "+v"(c), "+v"(d), "+v"(e), "+v"(f), "+v"(g), "+v"(h) :: "memory")
__device__ __forceinline__ float max3f(float a, float b, float c) { return __builtin_fmaxf(__builtin_fmaxf(a, b), c); }
__device__ __forceinline__ void softmax_seg2(f32x16& p0, f32x16& p1, float& m_reg, float& alpha, bf16x8& pa0, bf16x8& pa1, bf16x8& pa2, bf16x8& pa3) {
  float x = max3f(p0[0], p0[1], p0[2]), y = max3f(p1[0], p1[1], p1[2]);
  x = max3f(x, p0[3], p0[4]); y = max3f(y, p1[3], p1[4]); x = max3f(x, p0[5], p0[6]); y = max3f(y, p1[5], p1[6]); x = max3f(x, p0[7], p0[8]); y = max3f(y, p1[7], p1[8]);
  x = max3f(x, p0[9], p0[10]); y = max3f(y, p1[9], p1[10]); x = max3f(x, p0[11], p0[12]); y = max3f(y, p1[11], p1[12]); x = max3f(x, p0[13], p0[14]); y = max3f(y, p1[13], p1[14]);
  float pmax = max3f(x, y, p0[15]); pmax = fmaxf(pmax, p1[15]);
  { auto rr = __builtin_amdgcn_permlane32_swap(__float_as_uint(pmax), __float_as_uint(pmax), false, false); pmax = fmaxf(__uint_as_float(rr[0]), __uint_as_float(rr[1])); }
  float mn;
  if (__builtin_expect(__all(pmax - m_reg <= THRL), 1)) { mn = m_reg; alpha = 1.f; }
  else { mn = fmaxf(m_reg, pmax); alpha = __builtin_amdgcn_exp2f(m_reg - mn); m_reg = mn; }
#pragma unroll
  for (int r = 0; r < 16; ++r) { p0[r] = __builtin_amdgcn_exp2f(p0[r] - mn); p1[r] = __builtin_amdgcn_exp2f(p1[r] - mn); }
  { u32x4 w = {cvtpk2(p0[0], p0[1]), cvtpk2(p0[2], p0[3]), cvtpk2(p0[4], p0[5]), cvtpk2(p0[6], p0[7])}; pa0 = __builtin_bit_cast(bf16x8, w); }
  { u32x4 w = {cvtpk2(p0[8], p0[9]), cvtpk2(p0[10], p0[11]), cvtpk2(p0[12], p0[13]), cvtpk2(p0[14], p0[15])}; pa1 = __builtin_bit_cast(bf16x8, w); }
  { u32x4 w = {cvtpk2(p1[0], p1[1]), cvtpk2(p1[2], p1[3]), cvtpk2(p1[4], p1[5]), cvtpk2(p1[6], p1[7])}; pa2 = __builtin_bit_cast(bf16x8, w); }
  { u32x4 w = {cvtpk2(p1[8], p1[9]), cvtpk2(p1[10], p1[11]), cvtpk2(p1[12], p1[13]), cvtpk2(p1[14], p1[15])}; pa3 = __builtin_bit_cast(bf16x8, w); }
}
template <bool DIFF>
__device__ __forceinline__ void attn_tiles_pp3(const UnitArgs& a, AT_LAS char* lds, int tid, int wid, int lane, f32x16* o, f32x16& ol, float& m_out) {
  constexpr int NDB = DIFF ? 4 : 2; constexpr int NT = DIFF ? KVLEN / 64 : 10;
  const int r32 = lane & 31, hi = lane >> 5;
  AT_LAS char* V_lds = lds; AT_LAS char* K_lds = lds + 3 * SHM_V;
  AT_LAS float* al_l = (AT_LAS float*)(lds + AT_WS3_OFF) + wid * 64 + 32;
  float m_reg = -1e30f, alpha = 1.f; bf16x8 qr[4];
  const short one_ = (short)0x3F80; const bf16x8 ones = {one_, one_, one_, one_, one_, one_, one_, one_};
  const bf16* Qw = a.Q + (long)r32 * a.ldq + hi * 8;
#pragma unroll
  for (int d0 = 0; d0 < 4; ++d0) qr[d0] = *(const bf16x8*)(Qw + d0 * 16);
  int koff[2], voff[2];
#pragma unroll
  for (int i = 0; i < 2; ++i) { const int pc = 2 * wid + i;
    { const int row = 4 * pc + (lane >> 4), p = lane & 15; koff[i] = row * a.ldk + ((p ^ (row & 7)) << 3); }
    { const int s = 2 * pc + (lane >> 5), kk = (s >> 2) * 8 + ((lane & 31) >> 2); const int key = kk; voff[i] = key * a.ldk + (s & 3) * 32 + 8 * (lane & 3); } }
  const int vb0 = (int)(unsigned)(uintptr_t)V_lds + v_rd_base(lane) + a.vcolB;
  const int kb0 = (int)(unsigned)(uintptr_t)K_lds + a.kcolB + r32 * 256;
  int kad[4];
#pragma unroll
  for (int d0 = 0; d0 < 4; ++d0) kad[d0] = kb0 + (((d0 * 2 + hi) ^ (r32 & 7)) << 4);
#define DMA_K(t, slot) do { const bf16* kb_ = a.K + (long)tile_k0<DIFF>(a, (t)) * a.ldk; _Pragma("unroll") for (int i_ = 0; i_ < 2; ++i_) \
    __builtin_amdgcn_global_load_lds((const unsigned*)(kb_ + koff[i_]), (AT_LAS unsigned*)(K_lds + (slot) * SHM_K + (2 * wid + i_) * 1024), 16, 0, 0); } while (0)
#define DMA_V(t, slot) do { const bf16* vb_ = a.V + (long)tile_k0<DIFF>(a, (t)) * a.ldk; _Pragma("unroll") for (int i_ = 0; i_ < 2; ++i_) \
    __builtin_amdgcn_global_load_lds((const unsigned*)(vb_ + voff[i_]), (AT_LAS unsigned*)(V_lds + (slot) * SHM_V + (2 * wid + i_) * 1024), 16, 0, 0); } while (0)
#define BAR_MID() do { SBAR(); asm volatile("s_barrier" ::: "memory"); SBAR(); } while (0)
#define BAR_END(n) do { SBAR(); asm volatile("s_waitcnt vmcnt(" #n ")\n\ts_barrier" ::: "memory"); SBAR(); } while (0)
#define RESC2() do { if (__any(alpha < 1.f)) { if (hi == 0) al_l[r32] = alpha; asm volatile("s_waitcnt lgkmcnt(0)" ::: "memory"); \
    _Pragma("unroll") for (int r = 0; r < 16; ++r) { const float f_ = al_l[crow(r, hi)]; ol[r] *= f_; _Pragma("unroll") for (int d = 0; d < NDB; ++d) o[d][r] *= f_; } } } while (0)
#define WMASK2(t) do { if constexpr (!DIFF) { if ((t) >= 4) wmask(p0, p1, tile_k0<DIFF>(a, (t)), a.q0 + r32, hi); } } while (0)
#define VSEG(t) do { WMASK2(t); softmax_seg2(p0, p1, m_reg, alpha, pa0, pa1, pa2, pa3); RESC2(); } while (0)
#define PKV(L, H) (bf16x8){L[0], L[1], L[2], L[3], H[0], H[1], H[2], H[3]}
#define VRD8(X, D0, va) do { RDTR(X##0, va, v_rd_off(D0, 0, 0)); RDTR(X##1, va, v_rd_off(D0, 0, 1)); RDTR(X##2, va, v_rd_off(D0, 1, 0)); RDTR(X##3, va, v_rd_off(D0, 1, 1)); \
    RDTR(X##4, va, v_rd_off(D0, 2, 0)); RDTR(X##5, va, v_rd_off(D0, 2, 1)); RDTR(X##6, va, v_rd_off(D0, 3, 0)); RDTR(X##7, va, v_rd_off(D0, 3, 1)); } while (0)
#define PV4(od, X) do { od = __builtin_amdgcn_mfma_f32_32x32x16_bf16(pa0, PKV(X##0, X##1), od, 0, 0, 0); od = __builtin_amdgcn_mfma_f32_32x32x16_bf16(pa1, PKV(X##2, X##3), od, 0, 0, 0); \
    od = __builtin_amdgcn_mfma_f32_32x32x16_bf16(pa2, PKV(X##4, X##5), od, 0, 0, 0); od = __builtin_amdgcn_mfma_f32_32x32x16_bf16(pa3, PKV(X##6, X##7), od, 0, 0, 0); } while (0)
#define MSEG(DOQK, DOPV, ksl, vsl) do { \
    bf16x8 k0_, k1_, k2_, k3_; s16x4 A0, A1, A2, A3, A4, A5, A6, A7, B0, B1, B2, B3, B4, B5, B6, B7; \
    const int ko_ = (ksl) * SHM_K; const int va_ = vb0 + (vsl) * SHM_V; \
    if (DOQK) { RD128(k0_, kad[0] + ko_, 0); RD128(k1_, kad[0] + ko_, 8192); RD128(k2_, kad[1] + ko_, 0); RD128(k3_, kad[1] + ko_, 8192); \
      bf16x8 k4_, k5_, k6_, k7_; RD128(k4_, kad[2] + ko_, 0); RD128(k5_, kad[2] + ko_, 8192); RD128(k6_, kad[3] + ko_, 0); RD128(k7_, kad[3] + ko_, 8192); \
      WAITL8_4(4, k0_, k1_, k2_, k3_); SBAR(); \
      p0 = __builtin_amdgcn_mfma_f32_32x32x16_bf16(k0_, qr[0], (f32x16){}, 0, 0, 0); p1 = __builtin_amdgcn_mfma_f32_32x32x16_bf16(k1_, qr[0], (f32x16){}, 0, 0, 0); \
      p0 = __builtin_amdgcn_mfma_f32_32x32x16_bf16(k2_, qr[1], p0, 0, 0, 0); p1 = __builtin_amdgcn_mfma_f32_32x32x16_bf16(k3_, qr[1], p1, 0, 0, 0); SBAR(); \
      if (DOPV) { VRD8(A, 0, va_); WAITL8_4(8, k4_, k5_, k6_, k7_); } else { WAITL8_4(0, k4_, k5_, k6_, k7_); } SBAR(); \
      p0 = __builtin_amdgcn_mfma_f32_32x32x16_bf16(k4_, qr[2], p0, 0, 0, 0); p1 = __builtin_amdgcn_mfma_f32_32x32x16_bf16(k5_, qr[2], p1, 0, 0, 0); \
      p0 = __builtin_amdgcn_mfma_f32_32x32x16_bf16(k6_, qr[3], p0, 0, 0, 0); p1 = __builtin_amdgcn_mfma_f32_32x32x16_bf16(k7_, qr[3], p1, 0, 0, 0); SBAR(); } \
    else if (DOPV) { VRD8(A, 0, va_); } \
    if (DOPV) { VRD8(B, 1, va_); WAITL8_8(8, A0, A1, A2, A3, A4, A5, A6, A7); SBAR(); PV4(o[0], A); SBAR(); \
      if constexpr (NDB == 4) { VRD8(A, 2, va_); WAITL8_8(8, B0, B1, B2, B3, B4, B5, B6, B7); SBAR(); PV4(o[1], B); SBAR(); \
        VRD8(B, 3, va_); WAITL8_8(8, A0, A1, A2, A3, A4, A5, A6, A7); SBAR(); PV4(o[2], A); SBAR(); \
        WAITL8_8(0, B0, B1, B2, B3, B4, B5, B6, B7); SBAR(); PV4(o[3], B); SBAR(); } \
      else { WAITL8_8(0, B0, B1, B2, B3, B4, B5, B6, B7); SBAR(); PV4(o[1], B); SBAR(); } \
      ol = __builtin_amdgcn_mfma_f32_32x32x16_bf16(pa0, ones, ol, 0, 0, 0); ol = __builtin_amdgcn_mfma_f32_32x32x16_bf16(pa1, ones, ol, 0, 0, 0); \
      ol = __builtin_amdgcn_mfma_f32_32x32x16_bf16(pa2, ones, ol, 0, 0, 0); ol = __builtin_amdgcn_mfma_f32_32x32x16_bf16(pa3, ones, ol, 0, 0, 0); SBAR(); } \
  } while (0)
#define ROT3(s) ((s) == 2 ? 0 : (s) + 1)
  f32x16 p0, p1; bf16x8 pa0, pa1, pa2, pa3;
  DMA_K(0, 0); DMA_K(1, 1); DMA_V(0, 0); BAR_END(0);
  int sk = 0;
  if (wid < 4) {
    DMA_K(2, 2); DMA_V(1, 1); MSEG(true, false, 0, 0); BAR_MID(); VSEG(0); BAR_END(4);
    sk = 1;
    for (int t = 1; t <= NT - 3; ++t) { const int s1 = ROT3(sk), s2 = ROT3(s1);
      DMA_K(t + 2, s2); DMA_V(t + 1, s1); MSEG(true, true, sk, s2); BAR_MID(); VSEG(t); BAR_END(4); sk = s1; }
    { const int s1 = ROT3(sk), s2 = ROT3(s1); DMA_V(NT - 1, s1); MSEG(true, true, sk, s2); BAR_MID(); VSEG(NT - 2); BAR_END(2); sk = s1; }
    { const int s1 = ROT3(sk), s2 = ROT3(s1); MSEG(true, true, sk, s2); BAR_MID(); VSEG(NT - 1); BAR_END(0); sk = s1; }
    { const int s2 = ROT3(ROT3(sk)); MSEG(false, true, 0, s2); BAR_MID(); BAR_END(0); }
  } else {
    DMA_K(2, 2); DMA_V(1, 1); BAR_MID(); MSEG(true, false, 0, 0); BAR_END(4);
    sk = 1;
    for (int t = 1; t <= NT - 3; ++t) { const int s1 = ROT3(sk), s2 = ROT3(s1);
      DMA_K(t + 2, s2); DMA_V(t + 1, s1); VSEG(t - 1); BAR_MID(); MSEG(true, true, sk, s2); BAR_END(4); sk = s1; }
    { const int s1 = ROT3(sk), s2 = ROT3(s1); DMA_V(NT - 1, s1); VSEG(NT - 3); BAR_MID(); MSEG(true, true, sk, s2); BAR_END(2); sk = s1; }
    { const int s1 = ROT3(sk), s2 = ROT3(s1); VSEG(NT - 2); BAR_MID(); MSEG(true, true, sk, s2); BAR_END(0); sk = s1; }
    { const int s2 = ROT3(ROT3(sk)); VSEG(NT - 1); BAR_MID(); MSEG(false, true, 0, s2); BAR_END(0); }
  }
  m_out = m_reg;
#undef DMA_K
#undef DMA_V
#undef BAR_MID
#undef BAR_END
#undef RESC2
#undef WMASK2
#undef VSEG
#undef PKV
#undef VRD8
#undef PV4
#undef MSEG
#undef ROT3
}

typedef int i32x8v __attribute__((ext_vector_type(8)));
constexpr int F8_SLOT = 8192, F8_K_OFF = 0, F8_V_OFF = 3 * F8_SLOT;
#define MF8_ACC(acc, a8, b8) asm volatile("v_mfma_scale_f32_32x32x64_f8f6f4 %0, %1, %2, %0, %3, %3 op_sel_hi:[0,0,0]" : "+v"(acc) : "v"(a8), "v"(b8), "v"(sc1))
#define MF8_NEW(acc, a8, b8) asm volatile("v_mfma_scale_f32_32x32x64_f8f6f4 %0, %1, %2, 0, %3, %3 op_sel_hi:[0,0,0]" : "=&v"(acc) : "v"(a8), "v"(b8), "v"(sc1))
__device__ __forceinline__ unsigned pk4f8(float a, float b, float c, float d) { int w = 0; w = __builtin_amdgcn_cvt_pk_fp8_f32(a, b, w, false); w = __builtin_amdgcn_cvt_pk_fp8_f32(c, d, w, true); return (unsigned)w; }
struct UnitArgs8 { const unsigned char* Q; const unsigned char* K; const unsigned char* VT; int comp, ldk, vdoff, q0, ks; };
template <bool DIFF> __device__ __forceinline__ int tile8_k0(const UnitArgs8& a, int j) { if constexpr (DIFF) return 64 * j; else return j < 4 ? SEQ + 64 * j : a.ks + 64 * (j - 4); }
template <bool DIFF>
__device__ __forceinline__ void attn_tiles_f8(const UnitArgs8& a, AT_LAS char* lds, int tid, int wid, int lane, f32x16* o, f32x16& ol, float& m_out) {
  constexpr int NDB = DIFF ? 4 : 2, NT = DIFF ? KVLEN / 64 : 10;
  const int r32 = lane & 31, hi = lane >> 5;
  AT_LAS char* K_lds = lds + F8_K_OFF; AT_LAS char* V_lds = lds + F8_V_OFF;
  AT_LAS float* al_l = (AT_LAS float*)(lds + AT_WS3_OFF) + wid * 64 + 32;
  float m_reg = -1e30f, alpha = 1.f;
  int sc1 = 0x7F7F7F7F; asm volatile("" : "+v"(sc1));
  i32x8v ones8; { int o4 = 0x38383838; asm volatile("" : "+v"(o4)); ones8 = (i32x8v){o4, o4, o4, o4, o4, o4, o4, o4}; }
  i32x8v q8; { const u32x4 qa_ = *(const u32x4*)(a.Q + (long)r32 * 512 + hi * 32), qb_ = *(const u32x4*)(a.Q + (long)r32 * 512 + hi * 32 + 16);
    q8 = (i32x8v){(int)qa_.x, (int)qa_.y, (int)qa_.z, (int)qa_.w, (int)qb_.x, (int)qb_.y, (int)qb_.z, (int)qb_.w}; }
  const int kkey = 8 * wid + (lane >> 3), koff = kkey * a.ldk + (((lane & 7) ^ ((kkey >> 1) & 7)) << 4);
  const int vd = 16 * wid + (lane >> 2); const long voff = (long)vd * KVLEN + (((lane & 3) ^ ((vd >> 2) & 3)) << 4);
  const int ksw = (r32 >> 1) & 7, vsw = (r32 >> 2) & 3;
  const int kb = (int)(unsigned)(uintptr_t)K_lds + r32 * 128, ka0 = kb + (((a.comp * 4 + 2 * hi) ^ ksw) << 4), ka1 = kb + (((a.comp * 4 + 2 * hi + 1) ^ ksw) << 4);
  const int vbb = (int)(unsigned)(uintptr_t)V_lds + a.vdoff + r32 * 64, va0 = vbb + (((2 * hi) ^ vsw) << 4), va1 = vbb + (((2 * hi + 1) ^ vsw) << 4);
#define DMA_K(t, slot) __builtin_amdgcn_global_load_lds((const unsigned*)(a.K + (long)tile8_k0<DIFF>(a, (t)) * a.ldk + koff), (AT_LAS unsigned*)(K_lds + (slot) * F8_SLOT + wid * 1024), 16, 0, 0)
#define DMA_V(t, slot) __builtin_amdgcn_global_load_lds((const unsigned*)(a.VT + (long)tile8_k0<DIFF>(a, (t)) + voff), (AT_LAS unsigned*)(V_lds + (slot) * F8_SLOT + wid * 1024), 16, 0, 0)
#define BAR_MID() do { SBAR(); asm volatile("s_barrier" ::: "memory"); SBAR(); } while (0)
#define BAR_END(n) do { SBAR(); asm volatile("s_waitcnt vmcnt(" #n ")\n\ts_barrier" ::: "memory"); SBAR(); } while (0)
#define RESC2() do { if (__any(alpha < 1.f)) { if (hi == 0) al_l[r32] = alpha; asm volatile("s_waitcnt lgkmcnt(0)" ::: "memory"); \
    _Pragma("unroll") for (int r = 0; r < 16; ++r) { const float f_ = al_l[crow(r, hi)]; ol[r] *= f_; _Pragma("unroll") for (int d = 0; d < NDB; ++d) o[d][r] *= f_; } } } while (0)
#define VSEG(t) do { if constexpr (!DIFF) { if ((t) >= 4) wmask(p0, p1, tile8_k0<DIFF>(a, (t)), a.q0 + r32, hi); } bf16x8 t0_, t1_, t2_, t3_; softmax_seg2(p0, p1, m_reg, alpha, t0_, t1_, t2_, t3_); (void)t0_; (void)t1_; (void)t2_; (void)t3_; \
    pa8 = (i32x8v){(int)pk4f8(p0[0], p0[1], p0[2], p0[3]), (int)pk4f8(p0[4], p0[5], p0[6], p0[7]), (int)pk4f8(p0[8], p0[9], p0[10], p0[11]), (int)pk4f8(p0[12], p0[13], p0[14], p0[15]), \
                   (int)pk4f8(p1[0], p1[1], p1[2], p1[3]), (int)pk4f8(p1[4], p1[5], p1[6], p1[7]), (int)pk4f8(p1[8], p1[9], p1[10], p1[11]), (int)pk4f8(p1[12], p1[13], p1[14], p1[15])}; RESC2(); } while (0)
#define RD16(dst, addr, OFF) asm volatile("ds_read_b128 %0, %1 offset:%2" : "=v"(dst) : "v"(addr), "i"(OFF) : "memory")
#define CAT8(x, y) (i32x8v){(int)x[0], (int)x[1], (int)x[2], (int)x[3], (int)y[0], (int)y[1], (int)y[2], (int)y[3]}
#define MSEG(DOQK, DOPV, ksl, vsl) do { \
    u32x4 ka_, kb_, kc_, kd_, v0a, v0b, v1a, v1b, v2a, v2b, v3a, v3b; const int ko_ = (ksl) * F8_SLOT, vo_ = (vsl) * F8_SLOT; \
    if (DOQK) { RD16(ka_, ka0 + ko_, 0); RD16(kb_, ka1 + ko_, 0); RD16(kc_, ka0 + ko_, 4096); RD16(kd_, ka1 + ko_, 4096); } \
    if (DOPV) { RD16(v0a, va0 + vo_, 0); RD16(v0b, va1 + vo_, 0); RD16(v1a, va0 + vo_, 2048); RD16(v1b, va1 + vo_, 2048); \
                if constexpr (NDB == 4) { RD16(v2a, va0 + vo_, 4096); RD16(v2b, va1 + vo_, 4096); RD16(v3a, va0 + vo_, 6144); RD16(v3b, va1 + vo_, 6144); } } \
    if (DOQK) { if (DOPV) { if constexpr (NDB == 4) asm volatile("s_waitcnt lgkmcnt(8)" : "+v"(ka_), "+v"(kb_), "+v"(kc_), "+v"(kd_) :: "memory"); else asm volatile("s_waitcnt lgkmcnt(4)" : "+v"(ka_), "+v"(kb_), "+v"(kc_), "+v"(kd_) :: "memory"); } else { asm volatile("s_waitcnt lgkmcnt(0)" : "+v"(ka_), "+v"(kb_), "+v"(kc_), "+v"(kd_) :: "memory"); } SBAR(); \
      { const i32x8v k0_ = CAT8(ka_, kb_), k1_ = CAT8(kc_, kd_); MF8_NEW(p0, k0_, q8); MF8_NEW(p1, k1_, q8); } SBAR(); } \
    if (DOPV) { if constexpr (NDB == 4) { asm volatile("s_waitcnt lgkmcnt(0)" : "+v"(v0a), "+v"(v0b), "+v"(v1a), "+v"(v1b), "+v"(v2a), "+v"(v2b), "+v"(v3a), "+v"(v3b) :: "memory"); SBAR(); \
        const i32x8v w0_ = CAT8(v0a, v0b), w1_ = CAT8(v1a, v1b), w2_ = CAT8(v2a, v2b), w3_ = CAT8(v3a, v3b); \
        MF8_ACC(o[0], pa8, w0_); MF8_ACC(o[1], pa8, w1_); MF8_ACC(o[2], pa8, w2_); MF8_ACC(o[3], pa8, w3_); MF8_ACC(ol, pa8, ones8); } \
      else { asm volatile("s_waitcnt lgkmcnt(0)" : "+v"(v0a), "+v"(v0b), "+v"(v1a), "+v"(v1b) :: "memory"); SBAR(); \
        const i32x8v w0_ = CAT8(v0a, v0b), w1_ = CAT8(v1a, v1b); MF8_ACC(o[0], pa8, w0_); MF8_ACC(o[1], pa8, w1_); MF8_ACC(ol, pa8, ones8); } SBAR(); } \
    asm volatile("s_nop 15\n\ts_nop 15" ::: "memory");     \
  } while (0)
#define ROT3(s) ((s) == 2 ? 0 : (s) + 1)
  f32x16 p0, p1; i32x8v pa8;
  DMA_K(0, 0); DMA_K(1, 1); DMA_V(0, 0); BAR_END(0);
  int sk = 0;
  if (wid < 4) {
    DMA_K(2, 2); DMA_V(1, 1); MSEG(true, false, 0, 0); BAR_MID(); VSEG(0); BAR_END(2);
    sk = 1;
    for (int t = 1; t <= NT - 3; ++t) { const int s1 = ROT3(sk), s2 = ROT3(s1);
      DMA_K(t + 2, s2); DMA_V(t + 1, s1); MSEG(true, true, sk, s2); BAR_MID(); VSEG(t); BAR_END(2); sk = s1; }
    { const int s1 = ROT3(sk), s2 = ROT3(s1); DMA_V(NT - 1, s1); MSEG(true, true, sk, s2); BAR_MID(); VSEG(NT - 2); BAR_END(1); sk = s1; }
    { const int s1 = ROT3(sk), s2 = ROT3(s1); MSEG(true, true, sk, s2); BAR_MID(); VSEG(NT - 1); BAR_END(0); sk = s1; }
    { const int s2 = ROT3(ROT3(sk)); MSEG(false, true, 0, s2); BAR_MID(); BAR_END(0); }
  } else {
    DMA_K(2, 2); DMA_V(1, 1); BAR_MID(); MSEG(true, false, 0, 0); BAR_END(2);
    sk = 1;
    for (int t = 1; t <= NT - 3; ++t) { const int s1 = ROT3(sk), s2 = ROT3(s1);
      DMA_K(t + 2, s2); DMA_V(t + 1, s1); VSEG(t - 1); BAR_MID(); MSEG(true, true, sk, s2); BAR_END(2); sk = s1; }
    { const int s1 = ROT3(sk), s2 = ROT3(s1); DMA_V(NT - 1, s1); VSEG(NT - 3); BAR_MID(); MSEG(true, true, sk, s2); BAR_END(1); sk = s1; }
    { const int s1 = ROT3(sk), s2 = ROT3(s1); VSEG(NT - 2); BAR_MID(); MSEG(true, true, sk, s2); BAR_END(0); sk = s1; }
    { const int s2 = ROT3(ROT3(sk)); VSEG(NT - 1); BAR_MID(); MSEG(false, true, 0, s2); BAR_END(0); }
  }
  m_out = m_reg;
#undef DMA_K
#undef DMA_V
#undef BAR_MID
#undef BAR_END
#undef RESC2
#undef VSEG
#undef RD16
#undef CAT8
#undef MSEG
#undef ROT3
}
#undef KSWZ
#undef SBAR
}

constexpr size_t MiB = 1u << 20;
constexpr size_t WS_CTL = 0, CTL_ZERO_BYTES = 1 * MiB;
constexpr size_t WS_MODP = 1 * MiB;
constexpr size_t WS_MODV = 2 * MiB;
constexpr size_t WS_ROPE = 2 * MiB + 128 * 1024;
constexpr size_t WS_ROUTE = 3 * MiB;
constexpr size_t WS_WIN = 4 * MiB, WS_WOUT = 9 * MiB, WS_WGU = 12 * MiB, WS_WDN = 140 * MiB;
constexpr size_t WS_ELIST = 238 * MiB;
constexpr size_t WS_XN = 204 * MiB;
constexpr size_t WS_QA = 240 * MiB, WS_KA = 256 * MiB, WS_VA = 274 * MiB, WS_QB = 292 * MiB, WS_KB = 308 * MiB, WS_VB = 314 * MiB;
constexpr size_t WS_Y = 320 * MiB, WS_X1 = 352 * MiB, WS_XG = 416 * MiB, WS_H = 560 * MiB, WS_Y2 = 704 * MiB, WS_END = 848 * MiB;
constexpr int CW_TMO = 0, CW_CODE = 1, CW_BAR = 4096, CW_CNT = 8192;
constexpr int MODP_KC = 8;

constexpr int RING_OFF = 0, RING_BYTES = 131072;
constexpr int LDSCTL_OFF = RING_BYTES, MISC_OFF = LDSCTL_OFF + 320, XTRA_OFF = LDSCTL_OFF + 1024;
constexpr int LDS_BYTES = 147456;

__device__ const double ROPE_CS[32] = {
    0.54030230586813977, 0.8414709848078965, 0.84600911028170789, 0.53316843991402285, 0.95041528025518285, 0.31098359290718575, 0.98423023447009461, 0.17689218624615005,
    0.99500416527802582, 0.099833416646828155, 0.99841927779266448, 0.056204499214692491, 0.99950004166527784, 0.031617506402433708, 0.99984189028361437, 0.01778185687966613,
    0.99995000041666526, 0.0099998333341666645, 0.9999841886533658, 0.0056233836139601857, 0.99999500000416663, 0.0031622723897082477, 0.99999841886158658, 0.0017782784728035289,
    0.99999950000004167, 0.00099999983333334168, 0.99999984188612112, 0.00056234129555235944, 0.99999995000000041, 0.00031622776074637522, 0.99999998418861169, 0.00017782794006665674};

__device__ __forceinline__ unsigned cvtpk(float lo, float hi) { return at2::cvtpk2(lo, hi); }
__device__ __forceinline__ unsigned pk4_fp8(float a, float b, float c, float d) { int w = 0; w = __builtin_amdgcn_cvt_pk_fp8_f32(a, b, w, false); w = __builtin_amdgcn_cvt_pk_fp8_f32(c, d, w, true); return (unsigned)w; }
__device__ __forceinline__ float bflo(unsigned w) { return __uint_as_float(w << 16); }
__device__ __forceinline__ float bfhi(unsigned w) { return __uint_as_float(w & 0xffff0000u); }
__device__ __forceinline__ bf16 f2bf1(float f) { return (bf16)(cvtpk(f, 0.f) & 0xffffu); }
__device__ __forceinline__ void unpack8(const v4u v, float* f) { f[0] = bflo(v.x); f[1] = bfhi(v.x); f[2] = bflo(v.y); f[3] = bfhi(v.y); f[4] = bflo(v.z); f[5] = bfhi(v.z); f[6] = bflo(v.w); f[7] = bfhi(v.w); }
__device__ __forceinline__ float wave_sum(float v) {
#pragma unroll
    for (int o = 1; o < 64; o <<= 1) v += __shfl_xor(v, o);
    return v;
}

struct Frame {
    LAS unsigned char* lds;
    volatile LAS unsigned* MISC;
    gu32* ctl;
    int tid, lane, wave, vcu, G, probe;
    const float *x, *c, *ctx, *c_ctx, *w_mod, *b_mod, *norm1_g, *w_in, *lq1, *lk1, *lq2, *lk2, *subln_g, *sink, *w_out, *norm2_g, *w_router, *b_router, *w_gu, *b_gu, *w_dn, *b_dn, *final_g;
    float* out;
    float *modp, *modv, *rope, *X1, *rgate;
    int *re, *rslot, *rpos, *elist;
    bf16 *Win_t, *Wout_t, *Wgu_t, *Wdn_t, *XN, *QA, *KA, *VA, *QB, *KB, *VB, *Y, *XG, *H, *Y2;
};

#ifdef PROBE_BUILD
#define RP(F, k) (1 + (((F).probe >> (k)) & 1))
#else
#define RP(F, k) 1
#endif
struct EpiQKV {
    bf16 *QA, *KA, *VA, *QB, *KB, *VB; const float* rope;
    struct Ctx { bf16* p; bool skip, rp, isq; const float* cs; };
    __device__ __forceinline__ Ctx prep(int row, int cg) const {
        Ctx c; const bool lat = row < NTOK; const int b = lat ? (row >> 13) : ((row - NTOK) >> 8);
        const int kvrow = lat ? (b * KVLEN + (row & (SEQ - 1))) : (b * KVLEN + SEQ + ((row - NTOK) & (CTXL - 1)));
        c.skip = false; c.rp = lat; c.isq = false;
        if (cg < 512)       { c.p = QA + (size_t)row * 512 + cg; c.isq = true; c.skip = !lat; }
        else if (cg < 1024) { c.p = KA + (size_t)kvrow * 512 + (cg - 512); }
        else if (cg < 1536) { c.p = VA + (size_t)kvrow * 512 + (cg - 1024); c.rp = false; }
        else if (cg < 2048) { c.p = QB + (size_t)row * 512 + (cg - 1536); c.isq = true; c.skip = !lat; }
        else if (cg < 2176) { c.p = KB + (size_t)kvrow * 128 + (cg - 2048); }
        else                { c.p = VB + (size_t)kvrow * 128 + (cg - 2176); c.rp = false; }
        const int t = row & (SEQ - 1); const int pos = ((cg >> 5) & 1) ? (t & 63) : (t >> 6);
        c.cs = rope + pos * 32;
        return c;
    }
    __device__ __forceinline__ void math(const Ctx& c, int i, float lo, float hi, float& olo, float& ohi) const {
        if (c.rp) { const float cs = c.cs[2 * i], sn = c.cs[2 * i + 1]; olo = lo * cs - hi * sn; ohi = hi * cs + lo * sn; } else { olo = lo; ohi = hi; }
        if (c.isq) { olo *= QSCALE; ohi *= QSCALE; }
    }
    __device__ __forceinline__ void one(int row, int cg, int i, float lo, float hi, int) const {
        const Ctx c = prep(row, cg); if (c.skip) return; float a, b; math(c, i, lo, hi, a, b); c.p[i] = f2bf1(a); c.p[16 + i] = f2bf1(b);
    }
    __device__ __forceinline__ void four(int row, int cg, int i0, const f32x4 lo, const f32x4 hi, int) const {
        const Ctx c = prep(row, cg); if (c.skip) return; float a[4], b[4];
#pragma unroll
        for (int i = 0; i < 4; ++i) math(c, i0 + i, lo[i], hi[i], a[i], b[i]);
        typedef unsigned u32x2 __attribute__((ext_vector_type(2)));
        *(u32x2*)(c.p + i0) = (u32x2){cvtpk(a[0], a[1]), cvtpk(a[2], a[3])}; *(u32x2*)(c.p + 16 + i0) = (u32x2){cvtpk(b[0], b[1]), cvtpk(b[2], b[3])};
    }
};
struct EpiOut {
    const float* x; const float* modv; float* X1;
    __device__ __forceinline__ void one(int row, int cg, int i, float lo, float hi, int) const {
        const float* g1 = modv + (row >> 13) * 6144 + 2048; const size_t o = (size_t)row * DM + cg + i;
        X1[o] = x[o] + g1[cg + i] * lo; X1[o + 16] = x[o + 16] + g1[cg + 16 + i] * hi;
    }
    __device__ __forceinline__ void four(int row, int cg, int i0, const f32x4 lo, const f32x4 hi, int) const {
        const float* g1 = modv + (row >> 13) * 6144 + 2048 + cg + i0; const size_t o = (size_t)row * DM + cg + i0;
        typedef unsigned u32x2 __attribute__((ext_vector_type(2)));
        const f32x4 a = *(const f32x4*)(g1) * lo, b = *(const f32x4*)(g1 + 16) * hi;
        *(u32x2*)((bf16*)X1 + o) = (u32x2){cvtpk(a[0], a[1]), cvtpk(a[2], a[3])}; *(u32x2*)((bf16*)X1 + o + 16) = (u32x2){cvtpk(b[0], b[1]), cvtpk(b[2], b[3])};
    }
};
__device__ __forceinline__ float swiglu(float g, float lin) {
    g = fminf(g, 7.0f); lin = fminf(fmaxf(lin, -7.0f), 7.0f);
    return g * __builtin_amdgcn_rcpf(1.0f + __builtin_amdgcn_exp2f(-1.702f * LOG2E * g)) * (lin + 1.0f);
}
struct EpiGU {
    unsigned char* H; const float* b_gu;
    __device__ __forceinline__ void one(int row, int cg, int i, float lo, float hi, int e) const { (void)row; (void)cg; (void)i; (void)lo; (void)hi; (void)e; }
    __device__ __forceinline__ void four(int row, int cg, int i0, const f32x4 lo, const f32x4 hi, int e) const {
        const int f = (cg >> 1) + i0; const float* bb = b_gu + e * GUW + 2 * f; const f32x4 b0 = *(const f32x4*)bb, b1 = *(const f32x4*)(bb + 4);
        const float a0 = swiglu(lo[0] + b0[0], hi[0] + b0[1]), a1 = swiglu(lo[1] + b0[2], hi[1] + b0[3]), a2 = swiglu(lo[2] + b1[0], hi[2] + b1[1]), a3 = swiglu(lo[3] + b1[2], hi[3] + b1[3]);
        *(unsigned*)(H + (size_t)row * DM + f) = pk4_fp8(a0, a1, a2, a3);
    }
};
struct EpiDN {
    bf16* Y2; const float* b_dn;
    __device__ __forceinline__ void eight(int row, int c0, const f32x4 v0, const f32x4 v1, int e) const {
        const float* bb = b_dn + e * DM + c0; const f32x4 b0 = *(const f32x4*)bb, b1 = *(const f32x4*)(bb + 4);
        typedef unsigned u32x2 __attribute__((ext_vector_type(2)));
        *(u32x2*)((unsigned char*)Y2 + (size_t)row * DM + c0) = (u32x2){pk4_fp8(v0[0] + b0[0], v0[1] + b0[1], v0[2] + b0[2], v0[3] + b0[3]), pk4_fp8(v1[0] + b1[0], v1[1] + b1[1], v1[2] + b1[2], v1[3] + b1[3])};
    }
    __device__ __forceinline__ void one(int row, int cg, int i, float lo, float hi, int e) const {
        const float* bb = b_dn + e * DM + cg + i; bf16* p = Y2 + (size_t)row * DM + cg + i; p[0] = f2bf1(lo + bb[0]); p[16] = f2bf1(hi + bb[16]);
    }
    __device__ __forceinline__ void four(int row, int cg, int i0, const f32x4 lo, const f32x4 hi, int e) const {
        const float* bb = b_dn + e * DM + cg + i0; const f32x4 b0 = *(const f32x4*)bb, b1 = *(const f32x4*)(bb + 16); bf16* p = Y2 + (size_t)row * DM + cg + i0;
        typedef unsigned u32x2 __attribute__((ext_vector_type(2)));
        *(u32x2*)p = (u32x2){cvtpk(lo[0] + b0[0], lo[1] + b0[1]), cvtpk(lo[2] + b0[2], lo[3] + b0[3])}; *(u32x2*)(p + 16) = (u32x2){cvtpk(hi[0] + b1[0], hi[1] + b1[1]), cvtpk(hi[2] + b1[2], hi[3] + b1[3])};
    }
};
template <class E, int NN> struct EpiAdapt {
    static constexpr bool PERM = false, AFTER_DRAIN = false;
    E e;
    __device__ __forceinline__ void operator()(const pg8::f32x4 (&acc)[2][2][4][2], const pg8::Unit& u, int wr, int wc, int fr, int fq) const {
        int ex = 0, pn = u.pn; if (NN) { ex = pn / NN; pn = pn - ex * NN; }
#pragma unroll
        for (int ai = 0; ai < 2; ++ai)
#pragma unroll
            for (int m = 0; m < 4; ++m) { const int row = u.pm * 256 + ai * 128 + wr * 64 + m * 16 + fr;
#pragma unroll
                for (int bj = 0; bj < 2; ++bj) e.four(row, pn * 256 + bj * 128 + wc * 32, 4 * fq, acc[ai][bj][m][0], acc[ai][bj][m][1], ex); }
    }
};
struct RepOrder : pg8::StaticOrder { int rep;
    __device__ __forceinline__ bool next(int i, pg8::Unit& u) const { if (rep > 1) { const int R = (nwg + G - 1) / G; if (i >= R * rep) return false; i %= R; } return pg8::StaticOrder::next(i, u); } };
struct EpiQKVFast {
    static constexpr bool PERM = false, AFTER_DRAIN = false;
    bf16 *QA, *KA, *VA, *QB, *KB, *VB; const float* rope;
    __device__ __forceinline__ void operator()(const pg8::f32x4 (&acc)[2][2][4][2], const pg8::Unit& u, int wr, int wc, int fr, int fq) const {
        typedef unsigned u32x2 __attribute__((ext_vector_type(2)));
        bf16* base[2]; int ld[2]; bool isq[2], rp[2], kvr[2], f8[2];
#pragma unroll
        for (int bj = 0; bj < 2; ++bj) { const int cg = u.pn * 256 + bj * 128 + wc * 32; isq[bj] = false; rp[bj] = true; kvr[bj] = true; f8[bj] = true;
            if (cg < 512)       { base[bj] = (bf16*)((unsigned char*)QA + cg); ld[bj] = 512; isq[bj] = true; kvr[bj] = false; }
            else if (cg < 1024) { base[bj] = (bf16*)((unsigned char*)KA + (cg - 512)); ld[bj] = 512; }
            else if (cg < 1536) { base[bj] = (bf16*)((unsigned char*)VA + (cg - 1024)); ld[bj] = 512; rp[bj] = false; }
            else if (cg < 2048) { base[bj] = (bf16*)((unsigned char*)QB + (cg - 1536)); ld[bj] = 512; isq[bj] = true; kvr[bj] = false; }
            else if (cg < 2176) { base[bj] = (bf16*)((unsigned char*)KB + (cg - 2048)); ld[bj] = 128; }
            else                { base[bj] = (bf16*)((unsigned char*)VB + (cg - 2176)); ld[bj] = 128; rp[bj] = false; } }
        const bool colhalf = (wc & 1) != 0;
#pragma unroll
        for (int ai = 0; ai < 2; ++ai)
#pragma unroll
            for (int m = 0; m < 4; ++m) {
                const int row = u.pm * 256 + ai * 128 + wr * 64 + m * 16 + fr; const bool lat = row < NTOK;
                const int b = lat ? (row >> 13) : ((row - NTOK) >> 8);
                const int kvrow = lat ? (b * KVLEN + (row & (SEQ - 1))) : (b * KVLEN + SEQ + ((row - NTOK) & (CTXL - 1)));
                const int t = row & (SEQ - 1), pos = colhalf ? (t & 63) : (t >> 6);
                const f32x4 c0 = *(const f32x4*)(rope + pos * 32 + 8 * fq), c1 = *(const f32x4*)(rope + pos * 32 + 8 * fq + 4);
#pragma unroll
                for (int bj = 0; bj < 2; ++bj) {
                    if (isq[bj] && !lat) continue;
                    f32x4 lo = acc[ai][bj][m][0], hi = acc[ai][bj][m][1];
                    if (rp[bj] && lat) { const f32x4 cs = {c0[0], c0[2], c1[0], c1[2]}, sn = {c0[1], c0[3], c1[1], c1[3]}; const f32x4 nl = lo * cs - hi * sn, nh = hi * cs + lo * sn; lo = nl; hi = nh; }
                    if (isq[bj]) { lo = lo * QSCALE; hi = hi * QSCALE; }
                    const size_t rr = (size_t)(kvr[bj] ? kvrow : row) * ld[bj];
                    if (f8[bj]) { unsigned char* p = (unsigned char*)base[bj] + rr + 4 * fq; *(unsigned*)p = pk4_fp8(lo[0], lo[1], lo[2], lo[3]); *(unsigned*)(p + 16) = pk4_fp8(hi[0], hi[1], hi[2], hi[3]); }
                    else { bf16* p = base[bj] + rr + 4 * fq; *(u32x2*)p = (u32x2){cvtpk(lo[0], lo[1]), cvtpk(lo[2], lo[3])}; *(u32x2*)(p + 16) = (u32x2){cvtpk(hi[0], hi[1]), cvtpk(hi[2], hi[3])}; }
                }
            }
    }
};
template <class E, int NN> struct EpiAdaptP {
    static constexpr bool PERM = true, AFTER_DRAIN = false;
    E e;
    __device__ __forceinline__ void operator()(const pg8::f32x4 (&acc)[2][2][4][2], const pg8::Unit& u, int wr, int wc, int fr, int fq) const {
        int ex = 0, pn = u.pn; if (NN) { ex = pn / NN; pn = pn - ex * NN; }
#pragma unroll
        for (int ai = 0; ai < 2; ++ai)
#pragma unroll
            for (int m = 0; m < 4; ++m) { const int row = u.pm * 256 + ai * 128 + wr * 64 + m * 16 + fr;
#pragma unroll
                for (int bj = 0; bj < 2; ++bj) e.eight(row, pn * 256 + bj * 128 + wc * 32 + 8 * fq, acc[ai][bj][m][0], acc[ai][bj][m][1], ex); }
    }
};
struct GroupedOrder {
    int nN, NP, G, c; const LAS int* pexp; int rep; const LAS int* tokT;
    __device__ __forceinline__ int rounds() const { const int upr = G / nN; return (NP + upr - 1) / upr; }
    __device__ __forceinline__ int tok(int ui, int r) const { if (rep > 1) ui %= rounds(); return tokT[ui * 256 + r]; }
    __device__ __forceinline__ bool next(int i, pg8::Unit& u) const {
        int p, j;
        if (rep > 1) { const int R = rounds(); if (i >= R * rep) return false; i %= R; }
        if (G == 256) { const int x = c & 7, r = c >> 3, ppx = 32 / nN; p = i * (8 * ppx) + x * ppx + r / nN; j = r % nN; }
        else { const long L = (long)i * G + c; p = (int)(L / nN); j = (int)(L % nN); }
        if (p >= NP) return false;
        u.pm = p; u.pn = pexp[p] * nN + j; return true;
    }
    __device__ __forceinline__ void a_ready(const pg8::Unit&) const {}
    __device__ __forceinline__ void done(const pg8::Unit&) const {}
};

struct DenseSel { const bf16* Bt; __device__ __forceinline__ const bf16* operator()(int, int& e) const { e = 0; return Bt; } };
struct GroupSel { const bf16* Bt; const LAS int* pexp; int N, K; __device__ __forceinline__ const bf16* operator()(int mt, int& e) const { e = pexp[mt >> 1]; return Bt + (size_t)e * N * K; } };
template <class Epi, class BSel>
__device__ __forceinline__ void naive_gemm(Frame& F, const bf16* A, int Mtiles, int N, int K, const BSel& bs, const Epi& E) {
    LAS float* As = (LAS float*)(F.lds + RING_OFF); LAS float* Bs = As + 128 * 33;
    const int nNt = N / 64, tx = F.tid & 15, ty = F.tid >> 4;
    for (int t = blockIdx.x; t < Mtiles * nNt; t += F.G) {
        const int mt = t / nNt, nt = t % nNt; int e; const bf16* Bt = bs(mt, e);
        float acc[4][4];
#pragma unroll
        for (int r = 0; r < 4; ++r)
#pragma unroll
            for (int j = 0; j < 4; ++j) acc[r][j] = 0.f;
        for (int k0 = 0; k0 < K; k0 += 32) {
            { const int r = F.tid >> 2, kc = (F.tid & 3) * 8; float f[8]; unpack8(*(const v4u*)(A + (size_t)(mt * 128 + r) * K + k0 + kc), f);
#pragma unroll
              for (int i = 0; i < 8; ++i) As[r * 33 + kc + i] = f[i]; }
            if (F.tid < 256) { const int r = F.tid >> 2, kc = (F.tid & 3) * 8; float f[8]; unpack8(*(const v4u*)(Bt + (size_t)(nt * 64 + r) * K + k0 + kc), f);
#pragma unroll
              for (int i = 0; i < 8; ++i) Bs[r * 33 + kc + i] = f[i]; }
            __syncthreads();
#pragma unroll 8
            for (int kk = 0; kk < 32; ++kk) { float a[4], b[4];
#pragma unroll
                for (int r = 0; r < 4; ++r) a[r] = As[(ty * 4 + r) * 33 + kk];
#pragma unroll
                for (int j = 0; j < 4; ++j) b[j] = Bs[(tx + 16 * j) * 33 + kk];
#pragma unroll
                for (int r = 0; r < 4; ++r)
#pragma unroll
                    for (int j = 0; j < 4; ++j) acc[r][j] += a[r] * b[j]; }
            __syncthreads();
        }
#pragma unroll
        for (int r = 0; r < 4; ++r) { const int row = mt * 128 + ty * 4 + r; E.one(row, nt * 64, tx, acc[r][0], acc[r][1], e); E.one(row, nt * 64 + 32, tx, acc[r][2], acc[r][3], e); }
    }
}

template <bool GUPERM>
__device__ __forceinline__ void p0_transpose_item(const float* W, int K, int N, bf16* WT, LAS float* scr, int item, int lane) {
    const int nblk = N / 32, kb = item / nblk, nb = item % nblk, k0 = 64 * kb, n0 = 32 * nb;
    { f32x4 v[8]; const float* wp = W + (size_t)(k0 + (lane >> 3)) * N + n0 + 4 * (lane & 7);
#pragma unroll
      for (int i = 0; i < 8; ++i) v[i] = __builtin_nontemporal_load((const f32x4*)(wp + (size_t)(8 * i) * N));
#pragma unroll
      for (int i = 0; i < 8; ++i) { LAS float* d = scr + (8 * i + (lane >> 3)) * 33 + 4 * (lane & 7); d[0] = v[i].x; d[1] = v[i].y; d[2] = v[i].z; d[3] = v[i].w; } }
    LDS_WAIT(); asm volatile("" ::: "memory");
    const int c = lane & 7;
#pragma unroll
    for (int j = 0; j < 4; ++j) { const int n = (lane >> 3) + 8 * j; const LAS float* s = scr + (8 * c) * 33 + n;
        v4u o; o.x = cvtpk(s[0 * 33], s[1 * 33]); o.y = cvtpk(s[2 * 33], s[3 * 33]); o.z = cvtpk(s[4 * 33], s[5 * 33]); o.w = cvtpk(s[6 * 33], s[7 * 33]);
        const int nd = GUPERM ? ((n & 1) * 16 + (n >> 1)) : n;
        *(GAS v4u*)(WT + (size_t)(n0 + nd) * K + k0 + 8 * c) = o; }
    LDS_WAIT(); asm volatile("" ::: "memory");
}
template <bool GUPERM>
__device__ __forceinline__ void p0_transpose_item_fp8(const float* W, int K, int N, unsigned char* WT, LAS float* scr, int item, int lane) {
    const int nblk = N / 32, kb = item / nblk, nb = item % nblk, k0 = 64 * kb, n0 = 32 * nb;
    { f32x4 v[8]; const float* wp = W + (size_t)(k0 + (lane >> 3)) * N + n0 + 4 * (lane & 7);
#pragma unroll
      for (int i = 0; i < 8; ++i) v[i] = __builtin_nontemporal_load((const f32x4*)(wp + (size_t)(8 * i) * N));
#pragma unroll
      for (int i = 0; i < 8; ++i) { LAS float* d = scr + (8 * i + (lane >> 3)) * 33 + 4 * (lane & 7); d[0] = v[i].x; d[1] = v[i].y; d[2] = v[i].z; d[3] = v[i].w; } }
    LDS_WAIT(); asm volatile("" ::: "memory");
    const int c = lane & 7;
    typedef unsigned u32x2 __attribute__((ext_vector_type(2)));
#pragma unroll
    for (int j = 0; j < 4; ++j) { const int n = (lane >> 3) + 8 * j; const LAS float* s = scr + (8 * c) * 33 + n;
        u32x2 o; o.x = pk4_fp8(s[0 * 33] * 32.f, s[1 * 33] * 32.f, s[2 * 33] * 32.f, s[3 * 33] * 32.f); o.y = pk4_fp8(s[4 * 33] * 32.f, s[5 * 33] * 32.f, s[6 * 33] * 32.f, s[7 * 33] * 32.f);
        const int nd = GUPERM ? ((n & 1) * 16 + (n >> 1)) : n;
        *(GAS u32x2*)(WT + (size_t)(n0 + nd) * K + k0 + 8 * c) = o; }
    LDS_WAIT(); asm volatile("" ::: "memory");
}
struct F8Item { const float* wp; unsigned char* wt; int K; int guperm; };
__device__ __forceinline__ F8Item f8_decode(const Frame& F, int r, int lane) {
    constexpr int I_GU1 = (DM / 64) * (GUW / 32), I_DN1 = (DM / 64) * (DM / 32);
    F8Item I; const float* W; int N, item; unsigned char* WT;
    if (r < NEXP * I_GU1) { const int e = r / I_GU1; item = r % I_GU1; W = F.w_gu + (size_t)e * DM * GUW; N = GUW; WT = (unsigned char*)F.Wgu_t + (size_t)e * GUW * DM; I.guperm = 1; }
    else { r -= NEXP * I_GU1; const int e = r / I_DN1; item = r % I_DN1; W = F.w_dn + (size_t)e * DM * DM; N = DM; WT = (unsigned char*)F.Wdn_t + (size_t)e * DM * DM; I.guperm = 0; }
    const int nblk = N / 32, kb = item / nblk, nb = item % nblk, k0 = 64 * kb, n0 = 32 * nb;
    I.wp = W + (size_t)(k0 + (lane >> 3)) * N + n0 + 4 * (lane & 7); I.K = N;
    I.wt = WT + (size_t)n0 * DM + k0 + 8 * (lane & 7);
    return I;
}
__device__ __forceinline__ void f8_issue(const F8Item& I, f32x4 (&v)[8]) {
#pragma unroll
    for (int i = 0; i < 8; ++i) v[i] = __builtin_nontemporal_load((const f32x4*)(I.wp + (size_t)(8 * i) * I.K));
}
__device__ __forceinline__ void f8_finish(const F8Item& I, f32x4 (&v)[8], LAS float* scr, int lane) {
#pragma unroll
    for (int i = 0; i < 8; ++i) { LAS float* d = scr + (8 * i + (lane >> 3)) * 33 + 4 * (lane & 7); d[0] = v[i].x; d[1] = v[i].y; d[2] = v[i].z; d[3] = v[i].w; }
    LDS_WAIT(); asm volatile("" ::: "memory");
    const int c = lane & 7;
    typedef unsigned u32x2 __attribute__((ext_vector_type(2)));
#pragma unroll
    for (int j = 0; j < 4; ++j) { const int n = (lane >> 3) + 8 * j; const LAS float* s = scr + (8 * c) * 33 + n;
        u32x2 o; o.x = pk4_fp8(s[0 * 33] * 32.f, s[1 * 33] * 32.f, s[2 * 33] * 32.f, s[3 * 33] * 32.f); o.y = pk4_fp8(s[4 * 33] * 32.f, s[5 * 33] * 32.f, s[6 * 33] * 32.f, s[7 * 33] * 32.f);
        const int nd = I.guperm ? ((n & 1) * 16 + (n >> 1)) : n;
        *(GAS u32x2*)(I.wt + (size_t)nd * DM) = o; }
    LDS_WAIT(); asm volatile("" ::: "memory");
}
__device__ __forceinline__ void f8_stream(const Frame& F, LAS float* scr, int r, int rend, int stride) {
    f32x4 va[8], vb[8]; F8Item Ia, Ib;
    if (r >= rend) return;
    Ia = f8_decode(F, r, F.lane); f8_issue(Ia, va);
    while (true) {
        int nx = r + stride;
        if (nx < rend) { Ib = f8_decode(F, nx, F.lane); f8_issue(Ib, vb); }
        f8_finish(Ia, va, scr, F.lane);
        r = nx; if (r >= rend) break;
        nx = r + stride;
        if (nx < rend) { Ia = f8_decode(F, nx, F.lane); f8_issue(Ia, va); }
        f8_finish(Ib, vb, scr, F.lane);
        r = nx; if (r >= rend) break;
    }
}
__device__ __forceinline__ void p0_item(Frame& F, LAS float* sil, LAS float* scr, int it) {
    constexpr int I_IN = (DM / 64) * (INC / 32), I_OUT = (DM / 64) * (DM / 32), I_GU1 = (DM / 64) * (GUW / 32), I_DN1 = (DM / 64) * (DM / 32);

        int r = it;
        if (r < I_IN) { p0_transpose_item<false>(F.w_in, DM, INC, F.Win_t, scr, r, F.lane); return; } r -= I_IN;
        if (r < I_OUT) { p0_transpose_item<false>(F.w_out, DM, DM, F.Wout_t, scr, r, F.lane); return; } r -= I_OUT;
        if (r < NEXP * I_GU1) { const int e = r / I_GU1; p0_transpose_item_fp8<true>(F.w_gu + (size_t)e * DM * GUW, DM, GUW, (unsigned char*)F.Wgu_t + (size_t)e * GUW * DM, scr, r % I_GU1, F.lane); return; } r -= NEXP * I_GU1;
        { const int e = r / I_DN1; p0_transpose_item_fp8<false>(F.w_dn + (size_t)e * DM * DM, DM, DM, (unsigned char*)F.Wdn_t + (size_t)e * DM * DM, scr, r % I_DN1, F.lane); }
}
constexpr int P0_NITEMS = (DM / 64) * (INC / 32) + (DM / 64) * (DM / 32) + NEXP * (DM / 64) * (GUW / 32) + NEXP * (DM / 64) * (DM / 32);
#ifndef P2_TAIL_ITEMS
#define P2_TAIL_ITEMS 46000
#endif
#ifndef P2_GEMM_WGS_N
#define P2_GEMM_WGS_N 152
#endif
constexpr int P2_GEMM_WGS = P2_GEMM_WGS_N;
constexpr int P0_SPLIT = P0_NITEMS - P2_TAIL_ITEMS;
__device__ __forceinline__ void p0_tail(Frame& F) {
    LAS float* scr = (LAS float*)(F.lds + RING_OFF + F.wave * 16384);
    const int w = ((int)blockIdx.x - P2_GEMM_WGS) * NWAVES + F.wave, NW = (F.G - P2_GEMM_WGS) * NWAVES;
    constexpr int NPRE = (DM / 64) * (INC / 32) + (DM / 64) * (DM / 32);
    f8_stream(F, scr, P0_SPLIT - NPRE + w, P0_NITEMS - NPRE, NW);
}
__device__ __forceinline__ void p0_prologue(Frame& F) {
    LAS float* sil = (LAS float*)(F.lds + XTRA_OFF);
    for (int i = F.tid; i < 3072; i += 512) { const int v = i >> 10, k = i & 1023; const float cv = (v < 2) ? F.c[v * 1024 + k] : F.c_ctx[k]; sil[i] = cv / (1.f + __expf(-cv)); }
    __syncthreads();
    const int gw = F.vcu * NWAVES + F.wave, NGW = F.G * NWAVES;
    if (blockIdx.x == 0) for (int i = F.tid; i < 2048; i += 512) { const int pos = i >> 4, j = i & 15; double cr = 1.0, sr = 0.0, cb = ROPE_CS[2 * j], sb = ROPE_CS[2 * j + 1];
        for (int bit = 0; bit < 7; ++bit) { if ((pos >> bit) & 1) { const double t = cr * cb - sr * sb; sr = cr * sb + sr * cb; cr = t; } const double t2 = cb * cb - sb * sb; sb = 2.0 * cb * sb; cb = t2; }
        F.rope[2 * i] = (float)cr; F.rope[2 * i + 1] = (float)sr; }
    for (int r = F.vcu; r < 24 * MODP_KC; r += F.G) {
        const int nb = r % 24, kc = r / 24, n = nb * 256 + F.lane * 4, kbase = kc * 128 + F.wave * 16;
        f32x4 a0 = {0.f, 0.f, 0.f, 0.f}, a1 = a0, a2 = a0;
        const float* wp = F.w_mod + (size_t)kbase * 6144 + n;
#pragma unroll
        for (int kk = 0; kk < 16; ++kk) { const f32x4 w = __builtin_nontemporal_load((const f32x4*)(wp + (size_t)kk * 6144)); const int k = kbase + kk; a0 += w * sil[k]; a1 += w * sil[1024 + k]; a2 += w * sil[2048 + k]; }
        LAS float* red = (LAS float*)(F.lds + RING_OFF);
        *(LAS f32x4*)(red + (F.wave * 3 + 0) * 256 + 4 * F.lane) = a0; *(LAS f32x4*)(red + (F.wave * 3 + 1) * 256 + 4 * F.lane) = a1; *(LAS f32x4*)(red + (F.wave * 3 + 2) * 256 + 4 * F.lane) = a2;
        __syncthreads();
        for (int i = F.tid; i < 768; i += 512) { float t = 0.f;
#pragma unroll
            for (int w = 0; w < NWAVES; ++w) t += red[w * 768 + i];
            F.modp[(size_t)(kc * 3 + i / 256) * 6144 + nb * 256 + (i % 256)] = t; }
        __syncthreads();
    }
    LAS float* scr = (LAS float*)(F.lds + RING_OFF + F.wave * 16384);
    constexpr int I_IN = (DM / 64) * (INC / 32), I_OUT = (DM / 64) * (DM / 32), I_GU1 = (DM / 64) * (GUW / 32), I_DN1 = (DM / 64) * (DM / 32);
    constexpr int NITEMS = I_IN + I_OUT + NEXP * I_GU1 + NEXP * I_DN1;
    const int nsplit = (F.G == 256) ? P0_SPLIT : NITEMS;
    constexpr int NPRE = I_IN + I_OUT;
    int it0 = gw;
    if (NPRE > NGW) { for (; it0 < NPRE; it0 += NGW) p0_item(F, sil, scr, it0); } else if (it0 < NPRE) { p0_item(F, sil, scr, it0); it0 += NGW; }
    f8_stream(F, scr, it0 - NPRE, nsplit - NPRE, NGW);
}
__device__ __forceinline__ void p1_norm(Frame& F) {
    LAS float* ml = (LAS float*)(F.lds + RING_OFF);
    for (int i0 = F.tid; i0 < 6144; i0 += 2048) { float pv[4][MODP_KC], bv[4];
#pragma unroll
        for (int q = 0; q < 4; ++q) { const int i = i0 + 512 * q, v = i / 2048, j = i % 2048; bv[q] = F.b_mod[j];
#pragma unroll
            for (int kc = 0; kc < MODP_KC; ++kc) pv[q][kc] = F.modp[(size_t)(kc * 3 + v) * 6144 + j]; }
#pragma unroll
        for (int q = 0; q < 4; ++q) { float t = bv[q];
#pragma unroll
            for (int kc = 0; kc < MODP_KC; ++kc) t += pv[q][kc];
            ml[i0 + 512 * q] = t; } }
    for (int gi = blockIdx.x * 512 + F.tid; gi < 3 * 6144; gi += F.G * 512) { const int v = gi / 6144, j = gi % 6144; float s = F.b_mod[j];
        for (int kc = 0; kc < MODP_KC; ++kc) s += F.modp[(size_t)(kc * 3 + v) * 6144 + j]; F.modv[gi] = s; }
    __syncthreads();
    const int gw = F.vcu * NWAVES + F.wave, NGW = F.G * NWAVES;
    typedef unsigned u32x2 __attribute__((ext_vector_type(2)));
    for (int pp = gw; pp < (NROW / 2) * RP(F, 1); pp += NGW) { const int m0 = (pp % (NROW / 2)) * 2;
        f32x4 xv[2][4]; float s[2] = {0.f, 0.f}; int v[2];
#pragma unroll
        for (int q = 0; q < 2; ++q) { const int m = m0 + q; v[q] = m < SEQ ? 0 : (m < NTOK ? 1 : 2);
            const float* src = m < NTOK ? F.x + (size_t)m * DM : F.ctx + (size_t)(m - NTOK) * DM;
#pragma unroll
            for (int j = 0; j < 4; ++j) xv[q][j] = __builtin_nontemporal_load((const f32x4*)(src + 4 * F.lane + 256 * j)); }
#pragma unroll
        for (int q = 0; q < 2; ++q)
#pragma unroll
            for (int j = 0; j < 4; ++j) s[q] += (xv[q][j].x * xv[q][j].x + xv[q][j].y * xv[q][j].y) + (xv[q][j].z * xv[q][j].z + xv[q][j].w * xv[q][j].w);
#pragma unroll
        for (int q = 0; q < 2; ++q) { const int m = m0 + q; const float rstd = 1.0f / sqrtf(wave_sum(s[q]) * (1.f / DM) + NORM_EPS);
#pragma unroll
            for (int j = 0; j < 4; ++j) { const int col = 4 * F.lane + 256 * j; const f32x4 g = *(const f32x4*)(F.norm1_g + col);
                const f32x4 sh = *(const LAS f32x4*)(ml + v[q] * 2048 + col), sc = *(const LAS f32x4*)(ml + v[q] * 2048 + 1024 + col);
                const f32x4 y = (xv[q][j] * rstd * g) * (sc + 1.0f) + sh;
                *(u32x2*)(F.XN + (size_t)m * DM + col) = (u32x2){cvtpk(y.x, y.y), cvtpk(y.z, y.w)}; } }
    }
}

__device__ __forceinline__ float lam_value(Frame& F) {
    const float a = wave_sum(F.lq1[F.lane] * F.lk1[F.lane]), b = wave_sum(F.lq2[F.lane] * F.lk2[F.lane]);
    return __expf(a) - __expf(b) + 0.2f;
}
__device__ __forceinline__ void naive_diff_attn(Frame& F) {
    const float lam = lam_value(F);
    LAS float* X = (LAS float*)(F.lds + RING_OFF);
    LAS float* SS = X + 128 * 128;
    const int q = F.tid & 127, comp = (F.tid >> 7) & 1, vh = F.tid >> 8;
    for (int it = blockIdx.x; it < BATCH * 4 * (SEQ / 128); it += F.G) {
        const int b = it >> 8, h = (it >> 6) & 3, qb = it & 63; const int row = b * SEQ + qb * 128 + q;
        float qv[64], o[64];
#pragma unroll
        for (int c8 = 0; c8 < 8; ++c8) unpack8(*(const v4u*)(F.QA + (size_t)row * 512 + h * 128 + comp * 64 + c8 * 8), qv + 8 * c8);
#pragma unroll
        for (int e = 0; e < 64; ++e) o[e] = 0.f;
        float m = -1e30f, l = 0.f;
        const bf16* kp = F.KA + (size_t)(b * KVLEN) * 512 + h * 128 + comp * 64; const bf16* vp = F.VA + (size_t)(b * KVLEN) * 512 + h * 128 + vh * 64;
        for (int key = 0; key < KVLEN; ++key) {
            float s = 0.f;
#pragma unroll
            for (int c8 = 0; c8 < 8; ++c8) { float kf[8]; unpack8(*(const v4u*)(kp + (size_t)key * 512 + c8 * 8), kf);
#pragma unroll
                for (int i = 0; i < 8; ++i) s += qv[8 * c8 + i] * kf[i]; }
            if (s > m) { const float a = exp2f(m - s); l *= a;
#pragma unroll
                for (int e = 0; e < 64; ++e) o[e] *= a;
                m = s; }
            const float p = exp2f(s - m); l += p;
#pragma unroll
            for (int c8 = 0; c8 < 8; ++c8) { float vf[8]; unpack8(*(const v4u*)(vp + (size_t)key * 512 + c8 * 8), vf);
#pragma unroll
                for (int i = 0; i < 8; ++i) o[8 * c8 + i] += p * vf[i]; }
        }
        const float inv = 1.0f / l;
        __syncthreads();
        if (comp == 1) {
#pragma unroll
            for (int e = 0; e < 64; ++e) X[(vh * 64 + e) * 128 + q] = lam * o[e] * inv; }
        __syncthreads();
        if (comp == 0) { float ss = 0.f;
#pragma unroll
            for (int e = 0; e < 64; ++e) { o[e] = o[e] * inv - X[(vh * 64 + e) * 128 + q]; ss += o[e] * o[e]; }
            SS[vh * 128 + q] = ss; }
        __syncthreads();
        if (comp == 0) { const float r = 0.8f / sqrtf((SS[q] + SS[128 + q]) * (1.f / 128.f) + NORM_EPS);
            bf16* yp = F.Y + (size_t)row * DM + h * 128 + vh * 64; const float* sg = F.subln_g + vh * 64;
#pragma unroll
            for (int c8 = 0; c8 < 8; ++c8) { v4u w; w.x = cvtpk(o[8 * c8] * r * sg[8 * c8], o[8 * c8 + 1] * r * sg[8 * c8 + 1]); w.y = cvtpk(o[8 * c8 + 2] * r * sg[8 * c8 + 2], o[8 * c8 + 3] * r * sg[8 * c8 + 3]);
                w.z = cvtpk(o[8 * c8 + 4] * r * sg[8 * c8 + 4], o[8 * c8 + 5] * r * sg[8 * c8 + 5]); w.w = cvtpk(o[8 * c8 + 6] * r * sg[8 * c8 + 6], o[8 * c8 + 7] * r * sg[8 * c8 + 7]);
                *(v4u*)(yp + 8 * c8) = w; } }
    }
}
__device__ __forceinline__ void naive_win_attn(Frame& F) {
    for (int it = blockIdx.x; it < BATCH * 8 * (SEQ / 512); it += F.G) {
        const int b = it >> 7, h = (it >> 4) & 7, t = (it & 15) * 512 + F.tid, kv = h >> 2; const int row = b * SEQ + t;
        float qv[64], o[64];
#pragma unroll
        for (int c8 = 0; c8 < 8; ++c8) unpack8(*(const v4u*)(F.QB + (size_t)row * 512 + h * 64 + c8 * 8), qv + 8 * c8);
#pragma unroll
        for (int e = 0; e < 64; ++e) o[e] = 0.f;
        float m = F.sink[h] * LOG2E, l = 1.0f;
        const bf16* kp = F.KB + (size_t)(b * KVLEN) * 128 + kv * 64; const bf16* vp = F.VB + (size_t)(b * KVLEN) * 128 + kv * 64;
        for (int jj = 0; jj < 257 + CTXL; ++jj) {
            const int key = jj < 257 ? t - 128 + jj : SEQ + (jj - 257);
            if (jj < 257 && (key < 0 || key >= SEQ)) continue;
            float s = 0.f;
#pragma unroll
            for (int c8 = 0; c8 < 8; ++c8) { float kf[8]; unpack8(*(const v4u*)(kp + (size_t)key * 128 + c8 * 8), kf);
#pragma unroll
                for (int i = 0; i < 8; ++i) s += qv[8 * c8 + i] * kf[i]; }
            if (s > m) { const float a = exp2f(m - s); l *= a;
#pragma unroll
                for (int e = 0; e < 64; ++e) o[e] *= a;
                m = s; }
            const float p = exp2f(s - m); l += p;
#pragma unroll
            for (int c8 = 0; c8 < 8; ++c8) { float vf[8]; unpack8(*(const v4u*)(vp + (size_t)key * 128 + c8 * 8), vf);
#pragma unroll
                for (int i = 0; i < 8; ++i) o[8 * c8 + i] += p * vf[i]; }
        }
        const float inv = 1.0f / l; bf16* yp = F.Y + (size_t)row * DM + 512 + h * 64;
#pragma unroll
        for (int c8 = 0; c8 < 8; ++c8) { v4u w; w.x = cvtpk(o[8 * c8] * inv, o[8 * c8 + 1] * inv); w.y = cvtpk(o[8 * c8 + 2] * inv, o[8 * c8 + 3] * inv); w.z = cvtpk(o[8 * c8 + 4] * inv, o[8 * c8 + 5] * inv); w.w = cvtpk(o[8 * c8 + 6] * inv, o[8 * c8 + 7] * inv);
            *(v4u*)(yp + 8 * c8) = w; }
    }
}

#ifndef ATT_PP
#define ATT_PP 3
#endif
constexpr size_t WIN_VT_OFF = 16u << 20;
__device__ __forceinline__ void vt_item(const unsigned char* src, int rstride, unsigned char* drow0, int tile, int dg, int half) {
        unsigned outw[4][8];
#pragma unroll
        for (int i8 = 0; i8 < 8; ++i8) { const int kg = 8 * half + i8;
            const unsigned w0 = *(const unsigned*)(src + (size_t)(4 * kg + 0) * rstride), w1 = *(const unsigned*)(src + (size_t)(4 * kg + 1) * rstride), w2 = *(const unsigned*)(src + (size_t)(4 * kg + 2) * rstride), w3 = *(const unsigned*)(src + (size_t)(4 * kg + 3) * rstride);
            const unsigned a01 = __builtin_amdgcn_perm(w1, w0, 0x05010400u), c01 = __builtin_amdgcn_perm(w1, w0, 0x07030602u);
            const unsigned a23 = __builtin_amdgcn_perm(w3, w2, 0x05010400u), c23 = __builtin_amdgcn_perm(w3, w2, 0x07030602u);
            const int slot = ((i8 >> 1) & 3) + 4 * (i8 & 1);
            outw[0][slot] = __builtin_amdgcn_perm(a23, a01, 0x05040100u); outw[1][slot] = __builtin_amdgcn_perm(a23, a01, 0x07060302u);
            outw[2][slot] = __builtin_amdgcn_perm(c23, c01, 0x05040100u); outw[3][slot] = __builtin_amdgcn_perm(c23, c01, 0x07060302u); }
#pragma unroll
        for (int i = 0; i < 4; ++i) { unsigned char* dst = drow0 + (size_t)i * KVLEN + tile * 64 + 16 * half;
            *(v4u*)dst = (v4u){outw[i][0], outw[i][1], outw[i][2], outw[i][3]}; *(v4u*)(dst + 32) = (v4u){outw[i][4], outw[i][5], outw[i][6], outw[i][7]}; }
}
__device__ __forceinline__ void p3_vt_pass(Frame& F) {
    const unsigned char* V8 = (const unsigned char*)F.VA; unsigned char* VT8 = (unsigned char*)F.XG;
    const unsigned char* VB8 = (const unsigned char*)F.VB; unsigned char* VBT8 = (unsigned char*)F.XG + WIN_VT_OFF;
    const int gw = F.vcu * NWAVES + F.wave, NGW = F.G * NWAVES, dg = F.lane & 31, half = F.lane >> 5;
    constexpr int NTL = KVLEN / 64;
    for (int it = gw; it < 10 * NTL; it += NGW) {
        if (it < 8 * NTL) { const int bh = it / NTL, tile = it % NTL, b = bh >> 2, h = bh & 3;
            vt_item(V8 + ((size_t)(b * KVLEN + tile * 64)) * 512 + h * 128 + 4 * dg, 512, VT8 + ((size_t)(bh * 128 + 4 * dg)) * KVLEN, tile, dg, half); }
        else { const int b = (it - 8 * NTL) / NTL, tile = it % NTL;
            vt_item(VB8 + ((size_t)(b * KVLEN + tile * 64)) * 128 + 4 * dg, 128, VBT8 + ((size_t)(b * 128 + 4 * dg)) * KVLEN, tile, dg, half); }
    }
}
__device__ __forceinline__ void diff_unit(Frame& F, int b, int h, int qb, float lam) {
    using namespace at2;
    const int wid = F.wave, lane = F.lane, r32 = lane & 31, hi = lane >> 5, qblk = wid >> 1, comp = wid & 1;
    const int row0 = b * SEQ + qb * 128 + qblk * 32;
    UnitArgs8 a; a.Q = (const unsigned char*)F.QA + (size_t)row0 * 512 + h * 128 + comp * 64;
    a.K = (const unsigned char*)F.KA + (size_t)(b * KVLEN) * 512 + h * 128; a.VT = (const unsigned char*)F.XG + (size_t)((b * 4 + h) * 128) * KVLEN; a.comp = comp; a.ldk = 512; a.vdoff = 0; a.q0 = 0; a.ks = 0;
    f32x16 o[4]; o[0] = f32x16{}; o[1] = f32x16{}; o[2] = f32x16{}; o[3] = f32x16{};
    float m; f32x16 ol = f32x16{};
    AT_LAS char* lds = (AT_LAS char*)F.lds;
    attn_tiles_f8<true>(a, lds, F.tid, wid, lane, o, ol, m);
    float rli[16];
#pragma unroll
    for (int r = 0; r < 16; ++r) rli[r] = __builtin_amdgcn_rcpf(ol[r]);
    __syncthreads();
    AT_LAS float* XD = (AT_LAS float*)lds + qblk * 32 * XROW;
    if (comp == 1) {
#pragma unroll
        for (int r = 0; r < 16; ++r)
#pragma unroll
            for (int d0 = 0; d0 < 4; ++d0) XD[crow(r, hi) * XROW + d0 * 32 + r32] = lam * (o[d0][r] * rli[r]); }
    __syncthreads();
    if (comp == 0) {
#pragma unroll
        for (int r = 0; r < 16; ++r)
#pragma unroll
            for (int d0 = 0; d0 < 4; ++d0) { const int idx = crow(r, hi) * XROW + d0 * 32 + r32; XD[idx] = o[d0][r] * rli[r] - XD[idx]; }
        asm volatile("s_waitcnt lgkmcnt(0)" ::: "memory");
        const int row = lane >> 1, half = lane & 1;
        f32x4 v[16]; float ss = 0.f;
#pragma unroll
        for (int i = 0; i < 16; ++i) { v[i] = *(const AT_LAS f32x4*)(XD + row * XROW + half * 64 + 4 * i); ss += (v[i].x * v[i].x + v[i].y * v[i].y) + (v[i].z * v[i].z + v[i].w * v[i].w); }
        ss += __shfl_xor(ss, 1);
        const float rs = 0.8f / sqrtf(ss * (1.f / 128.f) + NORM_EPS);
        bf16* yp = F.Y + (size_t)(row0 + row) * DM + h * 128 + half * 64; const float* sg = F.subln_g + half * 64;
#pragma unroll
        for (int c8 = 0; c8 < 8; ++c8) { const f32x4 g0 = *(const f32x4*)(sg + 8 * c8), g1 = *(const f32x4*)(sg + 8 * c8 + 4); const f32x4 x0 = v[2 * c8] * rs * g0, x1 = v[2 * c8 + 1] * rs * g1;
            v4u w; w.x = cvtpk(x0.x, x0.y); w.y = cvtpk(x0.z, x0.w); w.z = cvtpk(x1.x, x1.y); w.w = cvtpk(x1.z, x1.w); *(v4u*)(yp + 8 * c8) = w; }
    }
    __syncthreads();
}
__device__ __forceinline__ void win_unit(Frame& F, int b, int j32) {
    using namespace at2;
    const int wid = F.wave, lane = F.lane, r32 = lane & 31, hi = lane >> 5, h = wid, kv = h >> 2;
    const int t0 = 32 * j32, row0 = b * SEQ + t0;
    UnitArgs8 a; a.Q = (const unsigned char*)F.QB + (size_t)row0 * 512 + h * 64;
    a.K = (const unsigned char*)F.KB + (size_t)(b * KVLEN) * 128; a.VT = (const unsigned char*)F.XG + WIN_VT_OFF + (size_t)(b * 128) * KVLEN; a.comp = kv; a.ldk = 128; a.vdoff = kv * 4096; a.q0 = t0;
    { const int st = t0 - 128; int ks = st < 0 ? 0 : (st & ~63); if (ks > SEQ - 384) ks = SEQ - 384; a.ks = ks; }
    f32x16 o[2]; o[0] = f32x16{}; o[1] = f32x16{};
    float m; f32x16 ol = f32x16{};
    AT_LAS char* lds = (AT_LAS char*)F.lds;
    attn_tiles_f8<false>(a, lds, F.tid, wid, lane, o, ol, m);
    AT_LAS float* li_l = (AT_LAS float*)(lds + AT_WS3_OFF) + wid * 64;
    if (hi == 0) li_l[r32] = __builtin_amdgcn_exp2f(F.sink[h] * LOG2E - m);
    asm volatile("s_waitcnt lgkmcnt(0)" ::: "memory");
    float rli[16];
#pragma unroll
    for (int r = 0; r < 16; ++r) rli[r] = __builtin_amdgcn_rcpf(ol[r] + li_l[crow(r, hi)]);
    __syncthreads();
    AT_LAS float* XD = (AT_LAS float*)lds + wid * 32 * XROWW;
#pragma unroll
    for (int r = 0; r < 16; ++r)
#pragma unroll
        for (int d0 = 0; d0 < 2; ++d0) XD[crow(r, hi) * XROWW + d0 * 32 + r32] = o[d0][r] * rli[r];
    asm volatile("s_waitcnt lgkmcnt(0)" ::: "memory");
    const int row = lane >> 1, half = lane & 1;
    bf16* yp = F.Y + (size_t)(row0 + row) * DM + 512 + h * 64 + half * 32;
#pragma unroll
    for (int c8 = 0; c8 < 4; ++c8) { const f32x4 x0 = *(const AT_LAS f32x4*)(XD + row * XROWW + half * 32 + 8 * c8), x1 = *(const AT_LAS f32x4*)(XD + row * XROWW + half * 32 + 8 * c8 + 4);
        v4u w; w.x = cvtpk(x0.x, x0.y); w.y = cvtpk(x0.z, x0.w); w.z = cvtpk(x1.x, x1.y); w.w = cvtpk(x1.z, x1.w); *(v4u*)(yp + 8 * c8) = w; }
    __syncthreads();
}
__device__ __forceinline__ void p3_attention(Frame& F) {
    const float lam = lam_value(F);
#ifndef NO_DIFF
#pragma unroll 1
    for (int U = F.vcu * 2; U < BATCH * 4 * (SEQ / 128) * RP(F, 3); U += 2 * F.G)
#pragma unroll 1
        for (int i = 0; i < 2; ++i) { const int u = (U + i) % 512; diff_unit(F, u >> 8, (u >> 6) & 3, u & 63, lam); }
#endif
#ifndef NO_WIN
#pragma unroll 1
    for (int W = F.vcu * 2; W < BATCH * (SEQ / 32) * RP(F, 3); W += 2 * F.G)
#pragma unroll 1
        for (int i = 0; i < 2; ++i) { const int w = (W + i) % 512; win_unit(F, w >> 8, w & 255); }
#endif
}

__device__ __forceinline__ unsigned long long wave_max64(unsigned long long k) {
#pragma unroll
    for (int o = 1; o < 64; o <<= 1) { const unsigned lo = __shfl_xor((unsigned)k, o), hi = __shfl_xor((unsigned)(k >> 32), o); const unsigned long long t = ((unsigned long long)hi << 32) | lo; k = t > k ? t : k; }
    return k;
}
__device__ __forceinline__ void p5a_route(Frame& F) {
    const int npass = RP(F, 5);
    LAS unsigned char* WH = F.lds + RING_OFF; LAS unsigned char* WL = WH + 65536;
    LAS int* lcnt = (LAS int*)(F.lds + XTRA_OFF); LAS int* lbase = lcnt + 32; LAS int* le = lcnt + 64; LAS int* lrk = le + 256;
    LAS float* cpart = (LAS float*)(F.lds + XTRA_OFF + 2560);
    LAS float* cvec = cpart + 512;
    LAS float* ssqx = cvec + 32;
    LAS float* pl = (LAS float*)(F.lds + RING_OFF);
    LAS float* gash = (LAS float*)(F.lds + RING_OFF + 16384);
    gu32* gcnt = F.ctl + CW_CNT;
    typedef unsigned u32x2 __attribute__((ext_vector_type(2))); typedef unsigned u32x4 __attribute__((ext_vector_type(4))); typedef short bf16x8 __attribute__((ext_vector_type(8)));
    const bf16* YG = (const bf16*)((const unsigned char*)F.XG + 32 * MiB);
    const int m = F.lane & 15, kg = F.lane >> 4, rb = F.wave & 3, kh = F.wave >> 2;
    for (int cc = blockIdx.x; cc < (NTOK / 64) * npass; cc += F.G) { const int chunk = cc % (NTOK / 64); const bool dry = cc < (NTOK / 64) * (npass - 1);
        const int b = (chunk * 64) >> 13; const float* mv = F.modv + b * 6144;
        __syncthreads();
        if (F.tid < 32) lcnt[F.tid] = 0;
        {
            const int e = F.tid & 31, q = F.tid >> 5; float csum = 0.f;
#pragma unroll 2
            for (int i = 0; i < 8; ++i) { const int kgrp = q + 16 * i, k0 = 8 * kgrp; float w[8];
#pragma unroll
                for (int j = 0; j < 8; ++j) w[j] = F.w_router[(k0 + j) * 32 + e];
                const f32x4 g0 = *(const f32x4*)(F.norm2_g + k0), g1 = *(const f32x4*)(F.norm2_g + k0 + 4), s0 = *(const f32x4*)(mv + 4096 + k0), s1 = *(const f32x4*)(mv + 4096 + k0 + 4);
                const f32x4 h0 = *(const f32x4*)(mv + 3072 + k0), h1 = *(const f32x4*)(mv + 3072 + k0 + 4);
                const f32x4 ga0 = g0 * (s0 + 1.0f), ga1 = g1 * (s1 + 1.0f);
                const float ga[8] = {ga0.x, ga0.y, ga0.z, ga0.w, ga1.x, ga1.y, ga1.z, ga1.w}, sh[8] = {h0.x, h0.y, h0.z, h0.w, h1.x, h1.y, h1.z, h1.w};
                unsigned hp[4], lp[4];
#pragma unroll
                for (int j = 0; j < 4; ++j) { const float a0 = w[2 * j] * ga[2 * j], a1 = w[2 * j + 1] * ga[2 * j + 1]; hp[j] = cvtpk(a0, a1); lp[j] = cvtpk(a0 - bflo(hp[j]), a1 - bfhi(hp[j])); }
#pragma unroll
                for (int j = 0; j < 8; ++j) csum += sh[j] * w[j];
                const int off = e * 2048 + ((kgrp ^ (e & 15)) << 4);
                *(LAS u32x4*)(WH + off) = (u32x4){hp[0], hp[1], hp[2], hp[3]}; *(LAS u32x4*)(WL + off) = (u32x4){lp[0], lp[1], lp[2], lp[3]}; }
            cpart[q * 32 + e] = csum; }
        __syncthreads();
        if (F.tid < 32) { float c = F.b_router[F.tid];
#pragma unroll
            for (int q = 0; q < 16; ++q) c += cpart[q * 32 + F.tid];
            cvec[F.tid] = c; }
        const int r = chunk * 64 + rb * 16 + m; const size_t rowoff = (size_t)r * DM;
        f32x4 acc0 = {0.f, 0.f, 0.f, 0.f}, acc1 = acc0; float ssq = 0.f;
        const int wrow0 = m * 2048, wrow1 = (m + 16) * 2048;
#pragma unroll 4
        for (int s_ = 0; s_ < 16; ++s_) { const int ks = 16 * kh + s_, k0 = 32 * ks + 8 * kg;
            const f32x4 xa = __builtin_nontemporal_load((const f32x4*)(F.x + rowoff + k0)), xb = __builtin_nontemporal_load((const f32x4*)(F.x + rowoff + k0 + 4)); const u32x4 yy = *(const u32x4*)(YG + rowoff + k0);
            const float x1[8] = {xa.x + bflo(yy.x), xa.y + bfhi(yy.x), xa.z + bflo(yy.y), xa.w + bfhi(yy.y), xb.x + bflo(yy.z), xb.y + bfhi(yy.z), xb.z + bflo(yy.w), xb.w + bfhi(yy.w)};
            unsigned hp[4], lp[4];
#pragma unroll
            for (int j = 0; j < 4; ++j) { hp[j] = cvtpk(x1[2 * j], x1[2 * j + 1]); lp[j] = cvtpk(x1[2 * j] - bflo(hp[j]), x1[2 * j + 1] - bfhi(hp[j])); ssq += x1[2 * j] * x1[2 * j] + x1[2 * j + 1] * x1[2 * j + 1]; }
            const u32x4 hv = {hp[0], hp[1], hp[2], hp[3]}, lv = {lp[0], lp[1], lp[2], lp[3]};
            *(u32x4*)((bf16*)F.X1 + rowoff + k0) = hv;
            const int sw = ((4 * ks + kg) ^ m) << 4;
            const bf16x8 bh0 = *(const LAS bf16x8*)(WH + wrow0 + sw), bh1 = *(const LAS bf16x8*)(WH + wrow1 + sw), bl0 = *(const LAS bf16x8*)(WL + wrow0 + sw), bl1 = *(const LAS bf16x8*)(WL + wrow1 + sw);
            const bf16x8 ah = __builtin_bit_cast(bf16x8, hv), al = __builtin_bit_cast(bf16x8, lv);
            acc0 = __builtin_amdgcn_mfma_f32_16x16x32_bf16(ah, bh0, acc0, 0, 0, 0); acc1 = __builtin_amdgcn_mfma_f32_16x16x32_bf16(ah, bh1, acc1, 0, 0, 0);
            acc0 = __builtin_amdgcn_mfma_f32_16x16x32_bf16(ah, bl0, acc0, 0, 0, 0); acc1 = __builtin_amdgcn_mfma_f32_16x16x32_bf16(ah, bl1, acc1, 0, 0, 0);
            acc0 = __builtin_amdgcn_mfma_f32_16x16x32_bf16(al, bh0, acc0, 0, 0, 0); acc1 = __builtin_amdgcn_mfma_f32_16x16x32_bf16(al, bh1, acc1, 0, 0, 0); }
        ssq += __shfl_xor(ssq, 16); ssq += __shfl_xor(ssq, 32);
        __syncthreads();
#pragma unroll
        for (int i = 0; i < 4; ++i) { const int row = rb * 16 + 4 * kg + i; pl[(kh * 64 + row) * 32 + m] = acc0[i]; pl[(kh * 64 + row) * 32 + 16 + m] = acc1[i]; }
        if (kg == 0) ssqx[kh * 64 + rb * 16 + m] = ssq;
        { const int k = 2 * F.tid; const float ga0 = F.norm2_g[k] * (mv[4096 + k] + 1.0f), ga1 = F.norm2_g[k + 1] * (mv[4096 + k + 1] + 1.0f); gash[k] = ga0; gash[k + 1] = ga1; gash[1024 + k] = mv[3072 + k]; gash[1024 + k + 1] = mv[3072 + k + 1]; }
        __syncthreads();
        { const float rstd = 1.0f / sqrtf((ssqx[rb * 16 + m] + ssqx[64 + rb * 16 + m]) * (1.f / DM) + NORM_EPS);
#pragma unroll 4
          for (int s_ = 0; s_ < 16; ++s_) { const int k0 = 32 * (16 * kh + s_) + 8 * kg; const u32x4 hv = *(const u32x4*)((const bf16*)F.X1 + rowoff + k0);
              const f32x4 ga0 = *(const LAS f32x4*)(gash + k0), ga1 = *(const LAS f32x4*)(gash + k0 + 4), sh0 = *(const LAS f32x4*)(gash + 1024 + k0), sh1 = *(const LAS f32x4*)(gash + 1024 + k0 + 4);
              const unsigned o0 = pk4_fp8((bflo(hv.x) * rstd) * ga0.x + sh0.x, (bfhi(hv.x) * rstd) * ga0.y + sh0.y, (bflo(hv.y) * rstd) * ga0.z + sh0.z, (bfhi(hv.y) * rstd) * ga0.w + sh0.w);
              const unsigned o1 = pk4_fp8((bflo(hv.z) * rstd) * ga1.x + sh1.x, (bfhi(hv.z) * rstd) * ga1.y + sh1.y, (bflo(hv.w) * rstd) * ga1.z + sh1.z, (bfhi(hv.w) * rstd) * ga1.w + sh1.w);
              *(u32x2*)((unsigned char*)F.XN + rowoff + k0) = (u32x2){o0, o1}; } }
#pragma unroll
        for (int ii = 0; ii < 2; ++ii) { const int rl = rb * 16 + 4 * kg + 2 * kh + ii;
            const float rs = 1.0f / sqrtf((ssqx[rl] + ssqx[64 + rl]) * (1.f / DM) + NORM_EPS);
            const float v0 = (pl[rl * 32 + m] + pl[(64 + rl) * 32 + m]) * rs + cvec[m], v1 = (pl[rl * 32 + 16 + m] + pl[(64 + rl) * 32 + 16 + m]) * rs + cvec[16 + m];
            unsigned u0 = __float_as_uint(v0), u1 = __float_as_uint(v1); u0 = (u0 & 0x80000000u) ? ~u0 : (u0 | 0x80000000u); u1 = (u1 & 0x80000000u) ? ~u1 : (u1 | 0x80000000u);
            unsigned long long key0 = ((unsigned long long)u0 << 32) | (unsigned)(31 - m), key1 = ((unsigned long long)u1 << 32) | (unsigned)(15 - m);
            int ek[4]; float vk[4];
#pragma unroll
            for (int k = 0; k < 4; ++k) { unsigned long long mx = key0 > key1 ? key0 : key1;
#pragma unroll
                for (int o = 1; o < 16; o <<= 1) { const unsigned lo = __shfl_xor((unsigned)mx, o), hi = __shfl_xor((unsigned)(mx >> 32), o); const unsigned long long t = ((unsigned long long)hi << 32) | lo; mx = t > mx ? t : mx; }
                ek[k] = 31 - (int)(mx & 31u); unsigned uu = (unsigned)(mx >> 32); uu = (uu & 0x80000000u) ? (uu & 0x7fffffffu) : ~uu; vk[k] = __uint_as_float(uu);
                if (ek[k] == m) key0 = 0ull; if (ek[k] == 16 + m) key1 = 0ull; }
            const float p1 = __expf(vk[1] - vk[0]), p2 = __expf(vk[2] - vk[0]), p3 = __expf(vk[3] - vk[0]); const float inv = 1.0f / (1.0f + p1 + p2 + p3);
            if (m < 4 && !dry) { const int k = m; const int ee = k == 0 ? ek[0] : (k == 1 ? ek[1] : (k == 2 ? ek[2] : ek[3])); const float gg = (k == 0 ? 1.0f : (k == 1 ? p1 : (k == 2 ? p2 : p3))) * inv;
                const int rank = __hip_atomic_fetch_add(lcnt + ee, 1, __ATOMIC_RELAXED, __HIP_MEMORY_SCOPE_WORKGROUP);
                le[rl * 4 + k] = ee; lrk[rl * 4 + k] = rank; F.rgate[(size_t)(chunk * 64 + rl) * 4 + k] = gg; }
        }
        __syncthreads();
        if (F.tid < 32 && !dry) lbase[F.tid] = (int)__hip_atomic_fetch_add(gcnt + F.tid, (unsigned)lcnt[F.tid], __ATOMIC_RELAXED, __HIP_MEMORY_SCOPE_AGENT);
        __syncthreads();
        if (F.tid < 256 && !dry) { const int row = chunk * 64 + (F.tid >> 2), k = F.tid & 3; const int ee = le[F.tid]; const int slot = lbase[ee] + lrk[F.tid]; F.re[(size_t)row * 4 + k] = ee; F.rslot[(size_t)row * 4 + k] = slot; F.elist[ee * NTOK + slot] = row; }
        __syncthreads();
    }
}
__device__ __forceinline__ int expert_tables(Frame& F, LAS int* pst, LAS int* pexp) {
    LAS int* npan = pst + 40; LAS int* cntT = pexp + 320;
    if (F.tid < 64) {
        const int e = F.lane & 31; const int cnt = (int)__hip_atomic_load(F.ctl + CW_CNT + e, __ATOMIC_RELAXED, __HIP_MEMORY_SCOPE_AGENT);
        const int np = (cnt + 255) >> 8; int incl = np;
#pragma unroll
        for (int o = 1; o < 32; o <<= 1) { const int t = __shfl_up(incl, o, 32); if (e >= o) incl += t; }
        if (F.lane < 32) { const int st = incl - np; cntT[e] = cnt; pst[e] = st * 256; for (int i = 0; i < np; ++i) pexp[st + i] = e; if (e == 31) { pst[32] = incl * 256; npan[0] = incl; } } }
    __syncthreads();
    return npan[0];
}
__device__ __forceinline__ void p5b_scatter(Frame& F) {
    LAS int* pst = (LAS int*)(F.lds + XTRA_OFF); LAS int* pexp = pst + 64;
    (void)expert_tables(F, pst, pexp);
    const int gw = F.vcu * NWAVES + F.wave, NGW = F.G * NWAVES;
    for (int rr = gw; rr < NTOK * RP(F, 6); rr += NGW) { const int row = rr % NTOK;
        const v4u a = *(const v4u*)(F.XN + (size_t)row * DM + 8 * F.lane), b = *(const v4u*)(F.XN + (size_t)row * DM + 512 + 8 * F.lane);
#pragma unroll
        for (int k = 0; k < 4; ++k) { const int e = F.re[(size_t)row * 4 + k]; const int pos = pst[e] + F.rslot[(size_t)row * 4 + k];
            if (F.lane == 0) F.rpos[(size_t)row * 4 + k] = pos;
            *(v4u*)(F.XG + (size_t)pos * DM + 8 * F.lane) = a; *(v4u*)(F.XG + (size_t)pos * DM + 512 + 8 * F.lane) = b; }
    }
}
__device__ __forceinline__ void p8_final(Frame& F) {
    LAS int* pst = (LAS int*)(F.lds + XTRA_OFF); LAS int* pexp = pst + 64;
    (void)expert_tables(F, pst, pexp);
    const int gw = F.vcu * NWAVES + F.wave, NGW = F.G * NWAVES;
    typedef unsigned u32x2 __attribute__((ext_vector_type(2)));
    for (int pp = gw; pp < (NTOK / 2) * RP(F, 9); pp += NGW) { const int row0 = (pp % (NTOK / 2)) * 2;
        const float* g2 = F.modv + (row0 >> 13) * 6144 + 5120;
        int pos[2][4]; float gt[2][4];
#pragma unroll
        for (int q = 0; q < 2; ++q)
#pragma unroll
            for (int k = 0; k < 4; ++k) { const size_t ix = (size_t)(row0 + q) * 4 + k; pos[q][k] = pst[F.re[ix]] + F.rslot[ix]; gt[q][k] = F.rgate[ix]; }
        f32x4 xv[2][4]; unsigned yv[2][4][4];
#pragma unroll
        for (int q = 0; q < 2; ++q)
#pragma unroll
            for (int j = 0; j < 4; ++j) { const int col = 4 * F.lane + 256 * j; { const u32x2 t_ = *(const u32x2*)((const bf16*)F.X1 + (size_t)(row0 + q) * DM + col); xv[q][j] = (f32x4){bflo(t_.x), bfhi(t_.x), bflo(t_.y), bfhi(t_.y)}; }
#pragma unroll
                for (int k = 0; k < 4; ++k) yv[q][j][k] = *(const unsigned*)((const unsigned char*)F.Y2 + (size_t)pos[q][k] * DM + col); }
#pragma unroll
        for (int q = 0; q < 2; ++q) { float s = 0.f;
#pragma unroll
            for (int j = 0; j < 4; ++j) { const int col = 4 * F.lane + 256 * j; f32x4 a = {0.f, 0.f, 0.f, 0.f};
#pragma unroll
                for (int k = 0; k < 4; ++k) { const unsigned y = yv[q][j][k]; const auto lo2 = __builtin_amdgcn_cvt_pk_f32_fp8((int)y, false), hi2 = __builtin_amdgcn_cvt_pk_f32_fp8((int)y, true); a += (f32x4){lo2[0], lo2[1], hi2[0], hi2[1]} * gt[q][k]; }
                xv[q][j] = xv[q][j] + *(const f32x4*)(g2 + col) * a;
                s += (xv[q][j].x * xv[q][j].x + xv[q][j].y * xv[q][j].y) + (xv[q][j].z * xv[q][j].z + xv[q][j].w * xv[q][j].w); }
            const float rstd = 1.0f / sqrtf(wave_sum(s) * (1.f / DM) + NORM_EPS);
#pragma unroll
            for (int j = 0; j < 4; ++j) { const int col = 4 * F.lane + 256 * j; __builtin_nontemporal_store(xv[q][j] * rstd * *(const f32x4*)(F.final_g + col), (f32x4*)(F.out + (size_t)(row0 + q) * DM + col)); } }
    }
}

#ifndef FAST_GEMM
#define FAST_GEMM 1
#endif
#ifndef FAST_ATTN
#define FAST_ATTN 1
#endif
constexpr int N_PHASES = 10;
struct Args { const float* in[23]; float* out; unsigned char* ws; int ph_lo, ph_hi, use_bar, pad; };
__global__ void __launch_bounds__(NWAVES * 64, 2) mk_fwd(Args args) {
    extern __shared__ __attribute__((aligned(16))) unsigned char lds[];
    Frame F;
    F.lds = (LAS unsigned char*)lds; F.MISC = (volatile LAS unsigned*)(F.lds + MISC_OFF);
    F.tid = threadIdx.x; F.lane = F.tid & 63; F.wave = __builtin_amdgcn_readfirstlane(F.tid >> 6);
    F.probe = args.pad; F.G = gridDim.x; { const int bx = blockIdx.x; F.vcu = (F.G % 8 == 0) ? (bx % 8) * (F.G / 8) + bx / 8 : bx; }
    unsigned char* ws = args.ws;
    F.ctl = (gu32*)(ws + WS_CTL);
    F.x = args.in[0]; F.c = args.in[1]; F.ctx = args.in[2]; F.c_ctx = args.in[3]; F.w_mod = args.in[4]; F.b_mod = args.in[5]; F.norm1_g = args.in[6]; F.w_in = args.in[7];
    F.lq1 = args.in[8]; F.lk1 = args.in[9]; F.lq2 = args.in[10]; F.lk2 = args.in[11]; F.subln_g = args.in[12]; F.sink = args.in[13]; F.w_out = args.in[14]; F.norm2_g = args.in[15];
    F.w_router = args.in[16]; F.b_router = args.in[17]; F.w_gu = args.in[18]; F.b_gu = args.in[19]; F.w_dn = args.in[20]; F.b_dn = args.in[21]; F.final_g = args.in[22];
    F.out = args.out;
    F.modp = (float*)(ws + WS_MODP); F.modv = (float*)(ws + WS_MODV); F.rope = (float*)(ws + WS_ROPE); F.X1 = (float*)(ws + WS_X1);
    F.elist = (int*)(ws + WS_ELIST); F.re = (int*)(ws + WS_ROUTE); F.rslot = F.re + NTOK * 4; F.rgate = (float*)(F.rslot + NTOK * 4); F.rpos = (int*)(F.rgate + NTOK * 4);
    F.Win_t = (bf16*)(ws + WS_WIN); F.Wout_t = (bf16*)(ws + WS_WOUT); F.Wgu_t = (bf16*)(ws + WS_WGU); F.Wdn_t = (bf16*)(ws + WS_WDN);
    F.XN = (bf16*)(ws + WS_XN); F.QA = (bf16*)(ws + WS_QA); F.KA = (bf16*)(ws + WS_KA); F.VA = (bf16*)(ws + WS_VA); F.QB = (bf16*)(ws + WS_QB); F.KB = (bf16*)(ws + WS_KB); F.VB = (bf16*)(ws + WS_VB);
    F.Y = (bf16*)(ws + WS_Y); F.XG = (bf16*)(ws + WS_XG); F.H = (bf16*)(ws + WS_H); F.Y2 = (bf16*)(ws + WS_Y2);
    for (int u = F.tid; u < (LDS_BYTES - LDSCTL_OFF) / 4; u += NWAVES * 64) ((LAS unsigned*)(F.lds + LDSCTL_OFF))[u] = 0u;
    __syncthreads();
#ifdef SPIN_SEAM
#define STAMP(k) do { if ((k) == SPIN_SEAM && blockIdx.x == 0 && F.tid == 0) *(volatile LAS unsigned long long*)(F.lds + XTRA_OFF + 15008) = wall_clock64(); } while (0)
    if (blockIdx.x == 0 && F.tid == 0) { const unsigned long long t_ = wall_clock64(); *(volatile LAS unsigned long long*)(F.lds + XTRA_OFF + 15000) = t_; *(volatile LAS unsigned long long*)(F.lds + XTRA_OFF + 15008) = t_; }
#else
#define STAMP(k) do {} while (0)
#endif
    XcdBarrier bar; bar.bar = (unsigned*)(F.ctl + CW_BAR); bar.x = 0; bar.st = nullptr;
    if (args.use_bar) bar = xcd_barrier_post((unsigned*)(F.ctl + CW_BAR), F.MISC + 8);
    const int lo = args.ph_lo, hi = args.ph_hi;
#ifndef PH_MASK
#define PH_MASK 0x3ff
#endif
#define IN(k) (((PH_MASK >> (k)) & 1) && lo <= (k) && (k) < hi)
#ifndef REP_MASK
#define REP_MASK 0
#endif
#define SEAM(k) do { if (IN(k) && IN((k) + 1)) { if (args.use_bar) { xcd_barrier(bar); if (args.pad & 0x10000) { xcd_barrier(bar); xcd_barrier(bar); } } } else { __syncthreads(); } } while (0)

    if (IN(0)) { p0_prologue(F); } SEAM(0); STAMP(0);
    if (IN(1)) { p1_norm(F); } SEAM(1); STAMP(1);
    if (IN(2)) {
        EpiQKV E{F.QA, F.KA, F.VA, F.QB, F.KB, F.VB, F.rope};
#if FAST_GEMM
        if (F.G == 256 && (int)blockIdx.x >= P2_GEMM_WGS) p0_tail(F);
        else {
        pg8::Gemm g{F.XN, F.Win_t, NROW, INC, DM}; RepOrder S; S.init(NROW, INC, F.G == 256 ? P2_GEMM_WGS : F.G, (int)blockIdx.x); S.rep = RP(F, 2);
        EpiQKVFast EA{F.QA, F.KA, F.VA, F.QB, F.KB, F.VB, F.rope};
        pg8::gemm_phase<EpiQKVFast, RepOrder, true, true>(F.lds + RING_OFF, g, S, EA);
        }
#else
        naive_gemm(F, F.XN, NROW / 128, INC, DM, DenseSel{F.Win_t}, E);
#endif
    } SEAM(2); STAMP(2);
#if FAST_ATTN == 1
    if (IN(3)) { p3_vt_pass(F); if (args.use_bar) xcd_barrier(bar); else __syncthreads(); STAMP(10); p3_attention(F); } SEAM(3); STAMP(3);
#else
    if (IN(3)) { naive_diff_attn(F); __syncthreads(); naive_win_attn(F); } SEAM(3); STAMP(3);
#endif
    if (IN(4)) {
        EpiOut E{F.x, F.modv, (float*)((unsigned char*)F.XG + 32 * MiB)};
#if FAST_GEMM
        pg8::Gemm g{F.Y, F.Wout_t, NTOK, DM, DM}; RepOrder S; S.init(NTOK, DM, F.G, (int)blockIdx.x); S.rep = RP(F, 4);
        EpiAdapt<EpiOut, 0> EA{E};
        pg8::gemm_phase<EpiAdapt<EpiOut, 0>, RepOrder, true, true>(F.lds + RING_OFF, g, S, EA);
#else
        naive_gemm(F, F.Y, NTOK / 128, DM, DM, DenseSel{F.Wout_t}, E);
#endif
    } SEAM(4); STAMP(4);
    if (IN(5)) { p5a_route(F); } SEAM(5); STAMP(5);
    if (IN(7)) {
        LAS int* pst = (LAS int*)(F.lds + XTRA_OFF); LAS int* pexp = pst + 64; LAS int* cntT = pexp + 320; LAS int* tokT = (LAS int*)(F.lds + XTRA_OFF + 2048);
        const int NP = expert_tables(F, pst, pexp);
        EpiGU E{(unsigned char*)F.H, F.b_gu};
        GroupedOrder S{GUW / 256, NP, F.G, (int)blockIdx.x, pexp, RP(F, 7), tokT};
        { const int R = S.rounds();
          GroupedOrder S1 = S; S1.rep = 1; const int r = F.tid & 255; int tv[5];
#pragma unroll
          for (int q = 0; q < 5; ++q) { const int i = 2 * q + (F.tid >> 8); pg8::Unit u; tv[q] = -1;
              if (i < R && S1.next(i, u)) { const int e = pexp[u.pm], sl = u.pm * 256 - pst[e] + r; tv[q] = sl < cntT[e] ? F.elist[e * NTOK + sl] : 0; } }
#pragma unroll
          for (int q = 0; q < 5; ++q) { const int i = 2 * q + (F.tid >> 8); if (tv[q] >= 0) tokT[i * 256 + r] = tv[q]; }
          __syncthreads(); }
#if FAST_GEMM
        pg8::Gemm g{F.XN, F.Wgu_t, NP * 256, GUW, DM / 2};
        EpiAdapt<EpiGU, GUW / 256> EA{E};
        pg8::gemm_phase<EpiAdapt<EpiGU, GUW / 256>, GroupedOrder, true, true, true, true>(F.lds + RING_OFF, g, S, EA);
#else
#error "the naive GEMM path has no gather"
#endif
    } SEAM(7); STAMP(7);
    if (IN(8)) {
        LAS int* pst = (LAS int*)(F.lds + XTRA_OFF); LAS int* pexp = pst + 64;
        const int NP = expert_tables(F, pst, pexp);
        EpiDN E{F.Y2, F.b_dn};
#if FAST_GEMM
        pg8::Gemm g{F.H, F.Wdn_t, NP * 256, DM, DM / 2}; GroupedOrder S{DM / 256, NP, F.G, (int)blockIdx.x, pexp, RP(F, 8), nullptr};
        EpiAdaptP<EpiDN, DM / 256> EA{E};
        pg8::gemm_phase<EpiAdaptP<EpiDN, DM / 256>, GroupedOrder, true, true, false, true>(F.lds + RING_OFF, g, S, EA);
#else
        naive_gemm(F, F.H, NP * 2, DM, DM, GroupSel{F.Wdn_t, pexp, DM, DM}, E);
#endif
    } SEAM(8); STAMP(8);
    if (IN(9)) { p8_final(F); }
#ifdef SPIN_SEAM
    if (blockIdx.x == 0 && F.tid == 0) { const unsigned long long t0_ = *(volatile LAS unsigned long long*)(F.lds + XTRA_OFF + 15000), tk_ = *(volatile LAS unsigned long long*)(F.lds + XTRA_OFF + 15008);
        const unsigned long long te_ = wall_clock64(); while (wall_clock64() - te_ < tk_ - t0_) __builtin_amdgcn_s_sleep(8); }
#endif
#undef STAMP
#undef IN
#undef SEAM
}

#ifndef N_LAUNCH_MODE
#define N_LAUNCH_MODE 0
#endif
extern "C" void kernel_launch(void* const* d_in, const int* in_sizes, int n_in, void* d_out, int out_size, void* d_ws, size_t ws_size, hipStream_t stream) {
    static int grid = 0;
    if (grid == 0) {
        if (n_in != 23 || in_sizes[0] != NTOK * DM || out_size != NTOK * DM || ws_size < WS_END) { fprintf(stderr, "kernel_launch: unexpected shapes (n_in %d, in0 %d, out %d, ws %zu); nothing launched\n", n_in, n_in > 0 ? in_sizes[0] : -1, out_size, ws_size); grid = -1; return; }
        int dev = 0, cus = 0, per_cu = 0;
        if (hipGetDevice(&dev) != hipSuccess || hipDeviceGetAttribute(&cus, hipDeviceAttributeMultiprocessorCount, dev) != hipSuccess) { grid = -1; return; }
        if (hipFuncSetAttribute((const void*)mk_fwd, hipFuncAttributeMaxDynamicSharedMemorySize, LDS_BYTES) != hipSuccess) { fprintf(stderr, "kernel_launch: hipFuncSetAttribute failed\n"); grid = -1; return; }
        if (hipOccupancyMaxActiveBlocksPerMultiprocessor(&per_cu, (const void*)mk_fwd, NWAVES * 64, LDS_BYTES) != hipSuccess || per_cu < 1) fprintf(stderr, "kernel_launch: note: occupancy query reports %d\n", per_cu);
        (void)hipGetLastError();
        grid = cus;
    }
    if (grid < 0) return;
    if (hipMemsetAsync((char*)d_ws + WS_CTL, 0, CTL_ZERO_BYTES, stream) != hipSuccess) { fprintf(stderr, "kernel_launch: memset failed\n"); return; }
    Args a{};
    for (int i = 0; i < 23; ++i) a.in[i] = (const float*)d_in[i];
    a.out = (float*)d_out; a.ws = (unsigned char*)d_ws; a.pad = REP_MASK;
#if N_LAUNCH_MODE == 0
    a.ph_lo = 0; a.ph_hi = N_PHASES; a.use_bar = 1;
    hipLaunchKernelGGL(mk_fwd, dim3(grid), dim3(NWAVES * 64), LDS_BYTES, stream, a);
#else
    for (int p = 0; p < N_PHASES; ++p) { a.ph_lo = p; a.ph_hi = p + 1; a.use_bar = 0; hipLaunchKernelGGL(mk_fwd, dim3(grid), dim3(NWAVES * 64), LDS_BYTES, stream, a); }
#endif
}
```

```cpp
#include <hip/hip_runtime.h>
#include <cstdio>
#include <cstdint>
namespace pg8 {
#define PG8_LAS __attribute__((address_space(3)))
typedef unsigned short bf16_t;
typedef short bf16x8 __attribute__((ext_vector_type(8)));
typedef float f32x4 __attribute__((ext_vector_type(4)));
typedef unsigned u32x4 __attribute__((ext_vector_type(4)));
constexpr int BM = 256, BK = 64, HALF = 128, HTB = HALF * BK * 2  , STAGE_BYTES = 8 * HTB, NXCD = 8, WGM = 8;

__host__ __device__ __forceinline__ int lds_byte(int r, int c) { const int st = (r >> 4) * 2 + (c >> 5), rr = r & 15, cc = c & 31, ob = rr * 64 + cc * 2; return st * 1024 + (ob ^ (((ob >> 9) & 1) << 5)); }
__host__ __device__ __forceinline__ void stage_rc(int b, int& R, int& C) { const int st = b / 1024, sb = b % 1024, swz = sb ^ (((sb >> 9) & 1) << 5); R = (st >> 1) * 16 + swz / 64; C = (st & 1) * 32 + (swz % 64) / 2; }
__host__ __device__ __forceinline__ int perm32(int rho) { const int n = rho >> 4, i = rho & 15; return 8 * (i >> 2) + 4 * n + (i & 3); }

struct Unit { int pm, pn; };
struct Gemm { const bf16_t* A; const bf16_t* Bt; int M, N, K; };

struct StaticOrder {
    int nM, nN, nwg, G, c;
    __host__ __device__ void init(int M, int N, int G_, int c_) { nM = M / BM; nN = N / BM; nwg = nM * nN; G = G_; c = c_; }
    __host__ __device__ bool next(int i, Unit& u) const {
        const long L = (long)i * G + c; if (L >= nwg) return false;
        int wgid = (int)L; { const int q = nwg / NXCD, r = nwg % NXCD, xcd = wgid % NXCD, off = wgid / NXCD; wgid = (xcd < r ? xcd * (q + 1) : r * (q + 1) + (xcd - r) * q) + off; }
        const int nig = WGM * nN, gid = wgid / nig, fm = gid * WGM, gsz = (nM - fm) < WGM ? (nM - fm) : WGM;
        u.pm = fm + ((wgid % nig) % gsz); u.pn = (wgid % nig) / gsz; return true;
    }
    __device__ __forceinline__ void a_ready(const Unit&) const {}
    __device__ __forceinline__ void done(const Unit&) const {}
};

__device__ __forceinline__ unsigned cvt_pk_bf16(float lo, float hi) { unsigned r; asm volatile("v_cvt_pk_bf16_f32 %0, %1, %2" : "=v"(r) : "v"(lo), "v"(hi)); return r; }
typedef float f32x2 __attribute__((ext_vector_type(2)));
typedef int i32x4 __attribute__((ext_vector_type(4))); typedef int i32x8 __attribute__((ext_vector_type(8)));
__device__ __forceinline__ i32x8 cat8(bf16x8 a, bf16x8 b) { const i32x4 x = __builtin_bit_cast(i32x4, a), y = __builtin_bit_cast(i32x4, b); return __builtin_shufflevector(x, y, 0, 1, 2, 3, 4, 5, 6, 7); }
template <class Epi, class Sched, bool ALIGN_EPI = false, bool SP2 = false, bool GATHER = false, bool FP8 = false>
__device__ __forceinline__ void gemm_phase(PG8_LAS unsigned char* lds, const Gemm g, const Sched& S, const Epi& E) {
    const int tid = threadIdx.x, wid = __builtin_amdgcn_readfirstlane(tid >> 6), lane = tid & 63, wr = wid >> 2, wc = wid & 3, fr = lane & 15, fq = lane >> 4;
    const int K = g.K, nt = K / BK;
    unsigned voffA[2], voffB[2]; int RA[2]; unsigned CA2[2];
#pragma unroll
    for (int i = 0; i < 2; ++i) { int R, C; stage_rc(tid * 16 + i * 8192, R, C); const int Rb = Epi::PERM ? ((R & ~31) + perm32(R & 31)) : R;
        voffA[i] = (unsigned)(R * K + C) * 2u; voffB[i] = (unsigned)(Rb * K + C) * 2u; RA[i] = R; CA2[i] = (unsigned)C * 2u; }
    static_assert(!GATHER || SP2, "GATHER is wired into the SP2 loop only");
    unsigned gA[2][2], gN[2][2];
    const size_t kstep = (size_t)(BK * 2);
    const size_t hstep = (size_t)HALF * K * 2;
    const size_t tstep = 2 * hstep;
    const unsigned ldsw = (unsigned)wid * 1024u;
    const int aoff = lds_byte(wr * 64 + fr, fq * 8), boff = lds_byte(wc * 32 + fr, fq * 8);
#define PG8_SA(b, h) (((b) * 2 + (h)) * HTB)
#define PG8_SB(b, h) ((4 + (b) * 2 + (h)) * HTB)
#define PG8_STAGE(bufoff, gbase, voff) do { _Pragma("unroll") for (int _i = 0; _i < 2; ++_i) \
        __builtin_amdgcn_global_load_lds((const unsigned*)((const char*)(gbase) + (voff)[_i]), (PG8_LAS unsigned*)(lds + (bufoff) + ldsw + _i * 8192), 16, 0, 0); } while (0)
#define PG8_STAGEG(bufoff, kbytes, v0, v1) do { \
        __builtin_amdgcn_global_load_lds((const unsigned*)((const char*)g.A + (kbytes) + (v0)), (PG8_LAS unsigned*)(lds + (bufoff) + ldsw), 16, 0, 0); \
        __builtin_amdgcn_global_load_lds((const unsigned*)((const char*)g.A + (kbytes) + (v1)), (PG8_LAS unsigned*)(lds + (bufoff) + ldsw + 8192), 16, 0, 0); } while (0)
#define PG8_GOFF(dst, ui_) do { _Pragma("unroll") for (int h_ = 0; h_ < 2; ++h_) _Pragma("unroll") for (int i_ = 0; i_ < 2; ++i_) dst[h_][i_] = (unsigned)S.tok((ui_), h_ * HALF + RA[i_]) * (unsigned)(K * 2) + CA2[i_]; } while (0)
#define PG8_LDA(dst, b, h) do { _Pragma("unroll") for (int m = 0; m < 4; ++m) _Pragma("unroll") for (int k = 0; k < 2; ++k) dst[m][k] = *(const PG8_LAS bf16x8*)(lds + PG8_SA(b, h) + aoff + m * 2048 + k * 1024); } while (0)
#define PG8_LDB(dst, b, h) do { _Pragma("unroll") for (int n = 0; n < 2; ++n) _Pragma("unroll") for (int k = 0; k < 2; ++k) dst[n][k] = *(const PG8_LAS bf16x8*)(lds + PG8_SB(b, h) + boff + n * 2048 + k * 1024); } while (0)
#define PG8_MMA(ai, bj, At, Bt) do { __builtin_amdgcn_s_setprio(1); _Pragma("unroll") for (int m = 0; m < 4; ++m) _Pragma("unroll") for (int n = 0; n < 2; ++n) { \
        if constexpr (FP8) { const i32x8 a8_ = cat8(Bt[n][0], Bt[n][1]), b8_ = cat8(At[m][0], At[m][1]); \
            asm volatile("v_mfma_scale_f32_16x16x128_f8f6f4 %0, %1, %2, %0, %3, %4 op_sel_hi:[0,0,0]" : "+v"(acc[ai][bj][m][n]) : "v"(a8_), "v"(b8_), "v"(sc_w8), "v"(sc_a8)); } \
        else { _Pragma("unroll") for (int k = 0; k < 2; ++k) acc[ai][bj][m][n] = __builtin_amdgcn_mfma_f32_16x16x32_bf16(Bt[n][k], At[m][k], acc[ai][bj][m][n], 0, 0, 0); } } \
        __builtin_amdgcn_s_setprio(0); } while (0)
#define PG8_WAIT_V(n) asm volatile("s_waitcnt vmcnt(" #n ")" ::: "memory")
#define PG8_WAIT_L(n) asm volatile("s_waitcnt lgkmcnt(" #n ")" ::: "memory")
#define PG8_BAR __builtin_amdgcn_s_barrier()
#define PG8_SCHED __builtin_amdgcn_sched_barrier(0)
    int sc_w8 = 0x7A7A7A7A, sc_a8 = 0x7F7F7F7F;
    asm volatile("" : "+v"(sc_w8), "+v"(sc_a8));
    Unit cur, nxt; int ui = 0;
    if (!S.next(0, cur)) return;
    f32x4 acc[2][2][4][2];
#pragma unroll
    for (int a = 0; a < 2; ++a)
#pragma unroll
        for (int b = 0; b < 2; ++b)
#pragma unroll
            for (int m = 0; m < 4; ++m)
#pragma unroll
                for (int n = 0; n < 2; ++n) acc[a][b][m][n] = (f32x4){0.f, 0.f, 0.f, 0.f};
    bf16x8 At[4][2], B0[2][2], B1[2][2];
    const char* cA = (const char*)g.A + (size_t)cur.pm * tstep; const char* cB = (const char*)g.Bt + (size_t)cur.pn * tstep;
    S.a_ready(cur);
    if constexpr (SP2) {
        if constexpr (GATHER) { PG8_GOFF(gA, 0); }
        PG8_STAGE(PG8_SB(0, 0), cB, voffB); PG8_STAGE(PG8_SB(0, 1), cB + hstep, voffB);
        if constexpr (GATHER) { PG8_STAGEG(PG8_SA(0, 0), 0, gA[0][0], gA[0][1]); PG8_STAGEG(PG8_SA(0, 1), 0, gA[1][0], gA[1][1]); } else { PG8_STAGE(PG8_SA(0, 0), cA, voffA); PG8_STAGE(PG8_SA(0, 1), cA + hstep, voffA); }
        if (wr == 1) PG8_BAR;
        PG8_WAIT_V(2); PG8_BAR;
        PG8_STAGE(PG8_SB(1, 0), cB + kstep, voffB); if constexpr (GATHER) { PG8_STAGEG(PG8_SA(1, 0), kstep, gA[0][0], gA[0][1]); } else { PG8_STAGE(PG8_SA(1, 0), cA + kstep, voffA); } PG8_STAGE(PG8_SB(1, 1), cB + hstep + kstep, voffB);
        PG8_WAIT_V(6); PG8_BAR;
    } else {
        PG8_STAGE(PG8_SB(0, 0), cB, voffB); PG8_STAGE(PG8_SA(0, 0), cA, voffA); PG8_STAGE(PG8_SB(0, 1), cB + hstep, voffB); PG8_STAGE(PG8_SA(0, 1), cA + hstep, voffA);
        if (wr == 1) PG8_BAR;
        PG8_WAIT_V(4); PG8_BAR;
        PG8_STAGE(PG8_SB(1, 0), cB + kstep, voffB); PG8_STAGE(PG8_SA(1, 0), cA + kstep, voffA); PG8_STAGE(PG8_SB(1, 1), cB + hstep + kstep, voffB);
        PG8_WAIT_V(6); PG8_BAR;
    }
    for (;;) {
        const bool has_next = S.next(ui + 1, nxt);
        const char* nA = has_next ? (const char*)g.A + (size_t)nxt.pm * tstep : cA; const char* nB = has_next ? (const char*)g.Bt + (size_t)nxt.pn * tstep : cB;
        if constexpr (GATHER) { if (has_next) { PG8_GOFF(gN, ui + 1); } else { _Pragma("unroll") for (int h_ = 0; h_ < 2; ++h_) _Pragma("unroll") for (int i_ = 0; i_ < 2; ++i_) gN[h_][i_] = gA[h_][i_]; } }
#pragma unroll 1
        for (int t = 0; t < nt; t += 2) {
            const bool last = (t == nt - 2);
            const char* a1 = cA + (size_t)(t + 1) * kstep;
            const char* a2 = last ? nA : cA + (size_t)(t + 2) * kstep; const char* b2 = last ? nB : cB + (size_t)(t + 2) * kstep;
            const char* a3 = a2 + kstep; const char* b3 = b2 + kstep;
            if (last && has_next) S.a_ready(nxt);
            if constexpr (SP2) {
            const size_t k1_ = (size_t)(t + 1) * kstep, k2_ = last ? (size_t)0 : (size_t)(t + 2) * kstep;
            const unsigned s00_ = last ? gN[0][0] : gA[0][0], s01_ = last ? gN[0][1] : gA[0][1], s10_ = last ? gN[1][0] : gA[1][0], s11_ = last ? gN[1][1] : gA[1][1];
            PG8_LDB(B0, 0, 0); PG8_LDB(B1, 0, 1); PG8_SCHED; PG8_LDA(At, 0, 0); if constexpr (GATHER) { PG8_STAGEG(PG8_SA(1, 1), k1_, gA[1][0], gA[1][1]); } else { PG8_STAGE(PG8_SA(1, 1), a1 + hstep, voffA); }
            PG8_WAIT_V(8); PG8_WAIT_L(0); PG8_BAR; PG8_MMA(0, 0, At, B0); PG8_MMA(0, 1, At, B1); PG8_BAR; PG8_SCHED;
            PG8_LDA(At, 0, 1); PG8_STAGE(PG8_SB(0, 0), b2, voffB); PG8_STAGE(PG8_SB(0, 1), b2 + hstep, voffB); if constexpr (GATHER) { PG8_STAGEG(PG8_SA(0, 0), k2_, s00_, s01_); } else { PG8_STAGE(PG8_SA(0, 0), a2, voffA); }
            PG8_WAIT_V(8); PG8_WAIT_L(0); PG8_BAR; PG8_MMA(1, 0, At, B0); PG8_MMA(1, 1, At, B1); PG8_BAR; PG8_SCHED;
            PG8_LDB(B0, 1, 0); PG8_LDB(B1, 1, 1); PG8_SCHED; PG8_LDA(At, 1, 0); if constexpr (GATHER) { PG8_STAGEG(PG8_SA(0, 1), k2_, s10_, s11_); } else { PG8_STAGE(PG8_SA(0, 1), a2 + hstep, voffA); }
            PG8_WAIT_V(8); PG8_WAIT_L(0); PG8_BAR; PG8_MMA(0, 0, At, B0); PG8_MMA(0, 1, At, B1); PG8_BAR; PG8_SCHED;
            PG8_LDA(At, 1, 1); PG8_STAGE(PG8_SB(1, 0), b3, voffB); PG8_STAGE(PG8_SB(1, 1), b3 + hstep, voffB); if constexpr (GATHER) { PG8_STAGEG(PG8_SA(1, 0), k2_ + kstep, s00_, s01_); } else { PG8_STAGE(PG8_SA(1, 0), a3, voffA); }
            PG8_WAIT_V(8); PG8_WAIT_L(0); PG8_BAR; PG8_MMA(1, 0, At, B0); PG8_MMA(1, 1, At, B1); PG8_BAR; PG8_SCHED;
            } else {
            PG8_LDB(B0, 0, 0); PG8_SCHED; PG8_LDA(At, 0, 0); PG8_STAGE(PG8_SA(1, 1), a1 + hstep, voffA);
            PG8_WAIT_L(8); PG8_BAR; PG8_WAIT_L(0); PG8_MMA(0, 0, At, B0); PG8_BAR; PG8_SCHED;
            PG8_LDB(B1, 0, 1); PG8_STAGE(PG8_SB(0, 0), b2, voffB);
            PG8_BAR; PG8_WAIT_L(0); PG8_MMA(0, 1, At, B1); PG8_BAR;
            PG8_LDA(At, 0, 1); PG8_STAGE(PG8_SA(0, 0), a2, voffA);
            PG8_BAR; PG8_WAIT_L(0); PG8_MMA(1, 0, At, B0); PG8_BAR; PG8_SCHED;
            PG8_STAGE(PG8_SB(0, 1), b2 + hstep, voffB);
            PG8_WAIT_V(6); PG8_BAR; PG8_MMA(1, 1, At, B1); PG8_BAR;
            PG8_LDB(B0, 1, 0); PG8_SCHED; PG8_LDA(At, 1, 0); PG8_STAGE(PG8_SA(0, 1), a2 + hstep, voffA);
            PG8_WAIT_L(8); PG8_BAR; PG8_WAIT_L(0); PG8_MMA(0, 0, At, B0); PG8_BAR; PG8_SCHED;
            PG8_LDB(B1, 1, 1); PG8_STAGE(PG8_SB(1, 0), b3, voffB);
            PG8_BAR; PG8_WAIT_L(0); PG8_MMA(0, 1, At, B1); PG8_BAR;
            PG8_LDA(At, 1, 1); PG8_STAGE(PG8_SA(1, 0), a3, voffA);
            PG8_BAR; PG8_WAIT_L(0); PG8_MMA(1, 0, At, B0); PG8_BAR; PG8_SCHED;
            PG8_STAGE(PG8_SB(1, 1), b3 + hstep, voffB);
            PG8_WAIT_V(6); PG8_BAR; PG8_MMA(1, 1, At, B1); PG8_BAR;
            }
        }
        if constexpr (FP8) { asm volatile("s_nop 15\n\ts_nop 15" ::: "memory"); }
        if constexpr (ALIGN_EPI) { if (wr == 0) PG8_BAR; }
        if constexpr (!Epi::AFTER_DRAIN) { E(acc, cur, wr, wc, fr, fq); S.done(cur); }
        if (!has_next) break;
#pragma unroll
        for (int a = 0; a < 2; ++a)
#pragma unroll
            for (int b = 0; b < 2; ++b)
#pragma unroll
                for (int m = 0; m < 4; ++m)
#pragma unroll
                    for (int n = 0; n < 2; ++n) acc[a][b][m][n] = (f32x4){0.f, 0.f, 0.f, 0.f};
        cur = nxt; cA = nA; cB = nB; ++ui;
        if constexpr (GATHER) { _Pragma("unroll") for (int h_ = 0; h_ < 2; ++h_) _Pragma("unroll") for (int i_ = 0; i_ < 2; ++i_) gA[h_][i_] = gN[h_][i_]; }
        if constexpr (ALIGN_EPI) { if (wr == 1) PG8_BAR; }
    }
    PG8_WAIT_V(0);
    if constexpr (!ALIGN_EPI) { if (wr == 0) PG8_BAR; }
    PG8_BAR;
    if constexpr (Epi::AFTER_DRAIN) { E.fused(acc, cur, wr, wc, fr, fq, lds, wid, lane); S.done(cur); }
#undef PG8_SA
#undef PG8_SB
#undef PG8_STAGE
#undef PG8_STAGEG
#undef PG8_GOFF
#undef PG8_LDA
#undef PG8_LDB
#undef PG8_MMA
#undef PG8_WAIT_V
#undef PG8_WAIT_L
#undef PG8_BAR
#undef PG8_SCHED
}
}
#define GAS __attribute__((address_space(1)))
#define LAS __attribute__((address_space(3)))
typedef unsigned short bf16;
typedef unsigned v4u __attribute__((ext_vector_type(4)));
typedef float f32x4 __attribute__((ext_vector_type(4)));
typedef short bf16x8 __attribute__((ext_vector_type(8)));
typedef GAS unsigned gu32;
typedef GAS unsigned long long gu64;
#define RLX_AGENT __ATOMIC_RELAXED, __HIP_MEMORY_SCOPE_AGENT
#define LDS_WAIT() asm volatile("s_waitcnt lgkmcnt(0)" ::: "memory")
#define VM_WAIT() asm volatile("s_waitcnt vmcnt(0)" ::: "memory")
__device__ __forceinline__ unsigned long long rt() { return __builtin_amdgcn_s_memrealtime(); }
__device__ __forceinline__ unsigned f2bf(float f) { unsigned u = __builtin_bit_cast(unsigned, f); return (u + 0x7fffu + ((u >> 16) & 1u)) >> 16; }
__device__ __forceinline__ unsigned pk2(float lo, float hi) { return f2bf(lo) | (f2bf(hi) << 16); }
#define XB_TMO      128
#define XB_XCNT(j)  (256  + 64 * (j))
#define XB_XSUB(j)  (1280 + 64 * (j))
#define XB_XGEN(j)  (2304 + 64 * (j))
#define XB_TOP      3328
#define XB_TOPGEN   3392
#define XCD_BAR_WORDS 3456
#define XB_SPIN_CAP (1u << 22)

__device__ __forceinline__ unsigned xb_ld(unsigned* p)              { return __hip_atomic_load(p, __ATOMIC_RELAXED, __HIP_MEMORY_SCOPE_AGENT); }
__device__ __forceinline__ unsigned xb_add(unsigned* p, unsigned v) { return __hip_atomic_fetch_add(p, v, __ATOMIC_RELAXED, __HIP_MEMORY_SCOPE_AGENT); }
__device__ __forceinline__ unsigned xb_xcc_id() { return (unsigned)__builtin_amdgcn_s_getreg((3 << 11) | 20) & 0xFu; }
#define XB_SPIN(cond, bar) do { unsigned _sp = 0; while (cond) { __builtin_amdgcn_s_sleep(1); \
    if ((++_sp & 255u) == 0u) { if (xb_ld(&(bar)[XB_TMO])) break; if (_sp > XB_SPIN_CAP) { atomicAdd(&(bar)[XB_TMO], 1u); break; } } } } while (0)

struct XcdBarrier {
    unsigned* bar; unsigned x;
    volatile LAS unsigned* st;
};

__device__ __forceinline__ XcdBarrier xcd_barrier_post(unsigned* bar, volatile LAS unsigned* st) {
    XcdBarrier b; b.bar = bar; b.x = xb_xcc_id(); b.st = st;
    if (threadIdx.x == 0) (void)xb_add(&bar[XB_XCNT(b.x)], 1u);
    return b;
}
__device__ __forceinline__ void xcd_barrier_complete(unsigned* bar, unsigned x, unsigned& nloc, unsigned& nx) {
    const unsigned G = gridDim.x * gridDim.y * gridDim.z;
    unsigned sum, cnt, mine, sp = 0u;
    for (;;) {
        sum = 0u; cnt = 0u; mine = 0u;
#pragma unroll
        for (unsigned j = 0; j < 16; ++j) { const unsigned c = xb_ld(&bar[XB_XCNT(j)]); sum += c; cnt += (c > 0u) ? 1u : 0u; mine = (j == x) ? c : mine; }
        if (sum == G) break;
        __builtin_amdgcn_s_sleep(1);
        if ((++sp & 255u) == 0u) { if (xb_ld(&bar[XB_TMO])) break; if (sp > XB_SPIN_CAP) { atomicAdd(&bar[XB_TMO], 1u); break; } }
    }
    nloc = mine > 0u ? mine : 1u; nx = cnt > 0u ? cnt : 1u;
}

__device__ __forceinline__ void xcd_barrier(const XcdBarrier& b) {
    asm volatile("s_waitcnt vmcnt(0)" ::: "memory");
    __syncthreads();
    if (threadIdx.x == 0) {
        unsigned* bar = b.bar;
        __builtin_amdgcn_s_waitcnt(0);
        unsigned nloc = b.st[0], nx = b.st[1];
        if (nloc == 0u) { xcd_barrier_complete(bar, b.x, nloc, nx); b.st[0] = nloc; b.st[1] = nx; }
        const unsigned old = xb_add(&bar[XB_XSUB(b.x)], 1u);
        const unsigned gen = old / nloc;
        if (old + 1u == (gen + 1u) * nloc) {
            __builtin_amdgcn_fence(__ATOMIC_RELEASE, "agent");
            asm volatile("s_waitcnt vmcnt(0)" ::: "memory");
            const unsigned og = xb_add(&bar[XB_TOP], 1u);
            const unsigned tg = og / nx;
            if (og + 1u == (tg + 1u) * nx) xb_add(&bar[XB_TOPGEN], 1u);
            else XB_SPIN(xb_ld(&bar[XB_TOPGEN]) == tg, bar);
            __builtin_amdgcn_fence(__ATOMIC_ACQUIRE, "agent");
            xb_add(&bar[XB_XGEN(b.x)], 1u);
            asm volatile("s_waitcnt vmcnt(0)" ::: "memory");
        } else {
            XB_SPIN(xb_ld(&bar[XB_XGEN(b.x)]) == gen, bar);
            __builtin_amdgcn_fence(__ATOMIC_ACQUIRE, "agent");
            asm volatile("s_waitcnt vmcnt(0)" ::: "memory");
        }
    }
    __syncthreads();
}

constexpr int BATCH = 2, SEQ = 8192, DM = 1024, CTXL = 256;
constexpr int NTOK = BATCH * SEQ, NCTXR = BATCH * CTXL, NROW = NTOK + NCTXR, KVLEN = SEQ + CTXL;
constexpr int INC = 2304, NEXP = 32, TOPK = 4, GUW = 2048;
constexpr int NPAD_MAX = NTOK * TOPK + NEXP * 256;
constexpr float NORM_EPS = 1e-6f, LOG2E = 1.4426950408889634f, QSCALE = 0.125f * 1.4426950408889634f;
constexpr int NWAVES = 8;


namespace at2 {
typedef short bf16x8 __attribute__((ext_vector_type(8)));
typedef short s16x4 __attribute__((ext_vector_type(4)));
typedef float f32x16 __attribute__((ext_vector_type(16)));
typedef unsigned u32x4 __attribute__((ext_vector_type(4)));
constexpr int SHM_V = 16384, SHM_K = 16384, AT_WS_OFF = 73728, AT_WS3_OFF = 98304, XROW = 132, XROWW = 68;
constexpr int SDEPTH = 1;
constexpr float THRL = 8.0f;
#define AT_LAS __attribute__((address_space(3)))
#define KSWZ(row, colB) ((row) * 256 + ((colB) ^ (((row) & 7) << 4)))
#define SBAR() __builtin_amdgcn_sched_barrier(0)
__device__ __forceinline__ int crow(int r, int hi) { return (r & 3) + 8 * (r >> 2) + 4 * hi; }
typedef float f32x2_t __attribute__((ext_vector_type(2))); typedef __bf16 bf16x2_t __attribute__((ext_vector_type(2)));
__device__ __forceinline__ unsigned cvtpk2(float lo, float hi) { f32x2_t v = {lo, hi}; bf16x2_t b = __builtin_convertvector(v, bf16x2_t); return __builtin_bit_cast(unsigned, b); }
__device__ __forceinline__ void partialSM(f32x16& p0, f32x16& p1, float& m_reg, float& alpha) {
  float pmax = p0[0];
#pragma unroll
  for (int r = 1; r < 16; ++r) pmax = fmaxf(pmax, p0[r]);
#pragma unroll
  for (int r = 0; r < 16; ++r) pmax = fmaxf(pmax, p1[r]);
  { auto rr = __builtin_amdgcn_permlane32_swap(__float_as_uint(pmax), __float_as_uint(pmax), false, false); pmax = fmaxf(__uint_as_float(rr[0]), __uint_as_float(rr[1])); }
  float mn;
  if (__builtin_expect(__all(pmax - m_reg <= THRL), 1)) { mn = m_reg; alpha = 1.f; }
  else { mn = fmaxf(m_reg, pmax); alpha = __builtin_amdgcn_exp2f(m_reg - mn); m_reg = mn; }
#pragma unroll
  for (int r = 0; r < 16; ++r) p0[r] = p0[r] - mn;
#pragma unroll
  for (int r = 0; r < 16; ++r) p1[r] = p1[r] - mn;
#pragma unroll
  for (int r = 0; r < 16; ++r) p0[r] = __builtin_amdgcn_exp2f(p0[r]);
}
__device__ __forceinline__ void finishSM(f32x16& p0, f32x16& p1, float alpha, float& l_reg, bf16x8& pa0, bf16x8& pa1, bf16x8& pa2, bf16x8& pa3) {
#pragma unroll
  for (int r = 0; r < 16; ++r) p1[r] = __builtin_amdgcn_exp2f(p1[r]);
  float ps = 0;
#pragma unroll
  for (int r = 0; r < 16; ++r) ps += p0[r];
#pragma unroll
  for (int r = 0; r < 16; ++r) ps += p1[r];
  { auto rr = __builtin_amdgcn_permlane32_swap(__float_as_uint(ps), __float_as_uint(ps), false, false); ps = __uint_as_float(rr[0]) + __uint_as_float(rr[1]); }
  l_reg = l_reg * alpha + ps;
#define PK4(P, BASE, OUT) do { unsigned a0 = cvtpk2(P[BASE + 0], P[BASE + 1]), a1 = cvtpk2(P[BASE + 2], P[BASE + 3]);   \
    unsigned b0 = cvtpk2(P[BASE + 4], P[BASE + 5]), b1 = cvtpk2(P[BASE + 6], P[BASE + 7]);                              \
    auto r0 = __builtin_amdgcn_permlane32_swap(a0, b0, false, false); auto r1 = __builtin_amdgcn_permlane32_swap(a1, b1, false, false); \
    u32x4 w = {r0[0], r1[0], r0[1], r1[1]}; OUT = __builtin_bit_cast(bf16x8, w); } while (0)
  PK4(p0, 0, pa0); PK4(p0, 8, pa1); PK4(p1, 0, pa2); PK4(p1, 8, pa3);
#undef PK4
}
__device__ __forceinline__ void qkt(f32x16& p0, f32x16& p1, const AT_LAS char* Ks, const bf16x8* qr, int r32, int hi) {
  p0 = f32x16{}; p1 = f32x16{};
#pragma unroll
  for (int d0 = 0; d0 < 4; ++d0) { const int cb = (d0 * 16 + hi * 8) * 2;
    const bf16x8 b0 = *(const AT_LAS bf16x8*)(Ks + KSWZ(r32, cb));
    const bf16x8 b1 = *(const AT_LAS bf16x8*)(Ks + KSWZ(32 + r32, cb));
    p0 = __builtin_amdgcn_mfma_f32_32x32x16_bf16(b0, qr[d0], p0, 0, 0, 0);
    p1 = __builtin_amdgcn_mfma_f32_32x32x16_bf16(b1, qr[d0], p1, 0, 0, 0); }
}
__device__ __forceinline__ int v_st(int k, int c) { const int kk = (k & ~0xC) | ((k & 4) << 1) | ((k & 8) >> 1); return ((kk >> 3) * 4 + (c >> 5)) * 512 + ((kk & 7) * 32 + (c & 31)) * 2; }
__device__ __forceinline__ int v_rd_base(int lane) { return ((lane & 3) << 3) | (((lane >> 2) & 3) << 6) | (((lane >> 4) & 1) << 5) | (((lane >> 5) & 1) << 8); }
constexpr int v_rd_off(int d0, int ks, int half) { return d0 * 512 + ks * 4096 + half * 2048; }
template <int OFF> __device__ __forceinline__ s16x4 tr_read(int vb) { s16x4 r; asm volatile("ds_read_b64_tr_b16 %0, %1 offset:%2" : "=&v"(r) : "v"(vb), "i"(OFF) : "memory"); return r; }
template <int D0> __device__ __forceinline__ void pv_one(f32x16& od, int vb, bf16x8 pa0, bf16x8 pa1, bf16x8 pa2, bf16x8 pa3) {
  const s16x4 l0 = tr_read<v_rd_off(D0, 0, 0)>(vb), h0 = tr_read<v_rd_off(D0, 0, 1)>(vb), l1 = tr_read<v_rd_off(D0, 1, 0)>(vb), h1 = tr_read<v_rd_off(D0, 1, 1)>(vb);
  const s16x4 l2 = tr_read<v_rd_off(D0, 2, 0)>(vb), h2 = tr_read<v_rd_off(D0, 2, 1)>(vb), l3 = tr_read<v_rd_off(D0, 3, 0)>(vb), h3 = tr_read<v_rd_off(D0, 3, 1)>(vb);
  asm volatile("s_waitcnt lgkmcnt(0)" ::: "memory"); SBAR();
#define PK(L, H) (bf16x8){L[0], L[1], L[2], L[3], H[0], H[1], H[2], H[3]}
  od = __builtin_amdgcn_mfma_f32_32x32x16_bf16(pa0, PK(l0, h0), od, 0, 0, 0);
  od = __builtin_amdgcn_mfma_f32_32x32x16_bf16(pa1, PK(l1, h1), od, 0, 0, 0);
  od = __builtin_amdgcn_mfma_f32_32x32x16_bf16(pa2, PK(l2, h2), od, 0, 0, 0);
  od = __builtin_amdgcn_mfma_f32_32x32x16_bf16(pa3, PK(l3, h3), od, 0, 0, 0);
#undef PK
}
typedef short v4i16_t __attribute__((ext_vector_type(4)));
__device__ __forceinline__ s16x4 vtr(int vb, int off) { return __builtin_bit_cast(s16x4, __builtin_amdgcn_ds_read_tr16_b64_v4i16((AT_LAS v4i16_t*)(unsigned)(vb + off))); }
template <int D0> __device__ __forceinline__ void pv_one_b(f32x16& od, int vb, bf16x8 pa0, bf16x8 pa1, bf16x8 pa2, bf16x8 pa3) {
  const s16x4 l0 = vtr(vb, v_rd_off(D0, 0, 0)), h0 = vtr(vb, v_rd_off(D0, 0, 1)), l1 = vtr(vb, v_rd_off(D0, 1, 0)), h1 = vtr(vb, v_rd_off(D0, 1, 1));
  const s16x4 l2 = vtr(vb, v_rd_off(D0, 2, 0)), h2 = vtr(vb, v_rd_off(D0, 2, 1)), l3 = vtr(vb, v_rd_off(D0, 3, 0)), h3 = vtr(vb, v_rd_off(D0, 3, 1));
#define PK(L, H) (bf16x8){L[0], L[1], L[2], L[3], H[0], H[1], H[2], H[3]}
  od = __builtin_amdgcn_mfma_f32_32x32x16_bf16(pa0, PK(l0, h0), od, 0, 0, 0);
  od = __builtin_amdgcn_mfma_f32_32x32x16_bf16(pa1, PK(l1, h1), od, 0, 0, 0);
  od = __builtin_amdgcn_mfma_f32_32x32x16_bf16(pa2, PK(l2, h2), od, 0, 0, 0);
  od = __builtin_amdgcn_mfma_f32_32x32x16_bf16(pa3, PK(l3, h3), od, 0, 0, 0);
#undef PK
}
template <int NDB> __device__ __forceinline__ void pv_all_b(f32x16* o, int vb, bf16x8 pa0, bf16x8 pa1, bf16x8 pa2, bf16x8 pa3) {
  pv_one_b<0>(o[0], vb, pa0, pa1, pa2, pa3); pv_one_b<1>(o[1], vb, pa0, pa1, pa2, pa3);
  if constexpr (NDB == 4) { pv_one_b<2>(o[2], vb, pa0, pa1, pa2, pa3); pv_one_b<3>(o[3], vb, pa0, pa1, pa2, pa3); }
}
template <int NDB> __device__ __forceinline__ void pv_all(f32x16* o, int vb, bf16x8 pa0, bf16x8 pa1, bf16x8 pa2, bf16x8 pa3) {
  pv_one<0>(o[0], vb, pa0, pa1, pa2, pa3); pv_one<1>(o[1], vb, pa0, pa1, pa2, pa3);
  if constexpr (NDB == 4) { pv_one<2>(o[2], vb, pa0, pa1, pa2, pa3); pv_one<3>(o[3], vb, pa0, pa1, pa2, pa3); }
}
__device__ __forceinline__ void wmask(f32x16& p0, f32x16& p1, int k0, int q, int hi) {
#pragma unroll
  for (int r = 0; r < 16; ++r) { const int d = k0 + crow(r, hi) - q; if (d > 128 || d < -128) p0[r] = -1e30f; if (d + 32 > 128 || d + 32 < -128) p1[r] = -1e30f; }
}

struct UnitArgs {
  const bf16* Q; int ldq;
  const bf16* K; const bf16* V; int ldk;
  int kcolB;
  int vcolB;
  int q0;
  int ks;
};
template <bool DIFF> __device__ __forceinline__ int tile_k0(const UnitArgs& a, int j) { if constexpr (DIFF) return 64 * j; else return j < 4 ? SEQ + 64 * j : a.ks + 64 * (j - 4); }

#define RD128(dst, addr, OFF) asm volatile("ds_read_b128 %0, %1 offset:%2" : "=v"(dst) : "v"(addr), "i"(OFF) : "memory")
#define RDTR(dst, addr, OFF) asm volatile("ds_read_b64_tr_b16 %0, %1 offset:%2" : "=v"(dst) : "v"(addr), "i"(OFF) : "memory")
#define WAITL8_4(n, a, b, c, d) asm volatile("s_waitcnt lgkmcnt(" #n ")" : "+v"(a), "+v"(b), "+v"(c), "+v"(d) :: "memory")
#define WAITL8_8(n, a, b, c, d, e, f, g, h) asm volatile("s_waitcnt lgkmcnt(" #n ")" : "+v"(a), "+v"(b), "+v"(c), "+v"(d), "+v"(e), "+v"(f), "+v"(g), "+v"(h) :: "memory")
__device__ __forceinline__ float max3f(float a, float b, float c) { return __builtin_fmaxf(__builtin_fmaxf(a, b), c); }
__device__ __forceinline__ void softmax_seg2(f32x16& p0, f32x16& p1, float& m_reg, float& alpha, bf16x8& pa0, bf16x8& pa1, bf16x8& pa2, bf16x8& pa3) {
  float x = max3f(p0[0], p0[1], p0[2]), y = max3f(p1[0], p1[1], p1[2]);
  x = max3f(x, p0[3], p0[4]); y = max3f(y, p1[3], p1[4]); x = max3f(x, p0[5], p0[6]); y = max3f(y, p1[5], p1[6]); x = max3f(x, p0[7], p0[8]); y = max3f(y, p1[7], p1[8]);
  x = max3f(x, p0[9], p0[10]); y = max3f(y, p1[9], p1[10]); x = max3f(x, p0[11], p0[12]); y = max3f(y, p1[11], p1[12]); x = max3f(x, p0[13], p0[14]); y = max3f(y, p1[13], p1[14]);
  float pmax = max3f(x, y, p0[15]); pmax = fmaxf(pmax, p1[15]);
  { auto rr = __builtin_amdgcn_permlane32_swap(__float_as_uint(pmax), __float_as_uint(pmax), false, false); pmax = fmaxf(__uint_as_float(rr[0]), __uint_as_float(rr[1])); }
  float mn;
  if (__builtin_expect(__all(pmax - m_reg <= THRL), 1)) { mn = m_reg; alpha = 1.f; }
  else { mn = fmaxf(m_reg, pmax); alpha = __builtin_amdgcn_exp2f(m_reg - mn); m_reg = mn; }
#pragma unroll
  for (int r = 0; r < 16; ++r) { p0[r] = __builtin_amdgcn_exp2f(p0[r] - mn); p1[r] = __builtin_amdgcn_exp2f(p1[r] - mn); }
  { u32x4 w = {cvtpk2(p0[0], p0[1]), cvtpk2(p0[2], p0[3]), cvtpk2(p0[4], p0[5]), cvtpk2(p0[6], p0[7])}; pa0 = __builtin_bit_cast(bf16x8, w); }
  { u32x4 w = {cvtpk2(p0[8], p0[9]), cvtpk2(p0[10], p0[11]), cvtpk2(p0[12], p0[13]), cvtpk2(p0[14], p0[15])}; pa1 = __builtin_bit_cast(bf16x8, w); }
  { u32x4 w = {cvtpk2(p1[0], p1[1]), cvtpk2(p1[2], p1[3]), cvtpk2(p1[4], p1[5]), cvtpk2(p1[6], p1[7])}; pa2 = __builtin_bit_cast(bf16x8, w); }
  { u32x4 w = {cvtpk2(p1[8], p1[9]), cvtpk2(p1[10], p1[11]), cvtpk2(p1[12], p1[13]), cvtpk2(p1[14], p1[15])}; pa3 = __builtin_bit_cast(bf16x8, w); }
}
template <bool DIFF>
__device__ __forceinline__ void attn_tiles_pp3(const UnitArgs& a, AT_LAS char* lds, int tid, int wid, int lane, f32x16* o, f32x16& ol, float& m_out) {
  constexpr int NDB = DIFF ? 4 : 2; constexpr int NT = DIFF ? KVLEN / 64 : 10;
  const int r32 = lane & 31, hi = lane >> 5;
  AT_LAS char* V_lds = lds; AT_LAS char* K_lds = lds + 3 * SHM_V;
  AT_LAS float* al_l = (AT_LAS float*)(lds + AT_WS3_OFF) + wid * 64 + 32;
  float m_reg = -1e30f, alpha = 1.f; bf16x8 qr[4];
  const short one_ = (short)0x3F80; const bf16x8 ones = {one_, one_, one_, one_, one_, one_, one_, one_};
  const bf16* Qw = a.Q + (long)r32 * a.ldq + hi * 8;
#pragma unroll
  for (int d0 = 0; d0 < 4; ++d0) qr[d0] = *(const bf16x8*)(Qw + d0 * 16);
  int koff[2], voff[2];
#pragma unroll
  for (int i = 0; i < 2; ++i) { const int pc = 2 * wid + i;
    { const int row = 4 * pc + (lane >> 4), p = lane & 15; koff[i] = row * a.ldk + ((p ^ (row & 7)) << 3); }
    { const int s = 2 * pc + (lane >> 5), kk = (s >> 2) * 8 + ((lane & 31) >> 2); const int key = kk; voff[i] = key * a.ldk + (s & 3) * 32 + 8 * (lane & 3); } }
  const int vb0 = (int)(unsigned)(uintptr_t)V_lds + v_rd_base(lane) + a.vcolB;
  const int kb0 = (int)(unsigned)(uintptr_t)K_lds + a.kcolB + r32 * 256;
  int kad[4];
#pragma unroll
  for (int d0 = 0; d0 < 4; ++d0) kad[d0] = kb0 + (((d0 * 2 + hi) ^ (r32 & 7)) << 4);
#define DMA_K(t, slot) do { const bf16* kb_ = a.K + (long)tile_k0<DIFF>(a, (t)) * a.ldk; _Pragma("unroll") for (int i_ = 0; i_ < 2; ++i_) \
    __builtin_amdgcn_global_load_lds((const unsigned*)(kb_ + koff[i_]), (AT_LAS unsigned*)(K_lds + (slot) * SHM_K + (2 * wid + i_) * 1024), 16, 0, 0); } while (0)
#define DMA_V(t, slot) do { const bf16* vb_ = a.V + (long)tile_k0<DIFF>(a, (t)) * a.ldk; _Pragma("unroll") for (int i_ = 0; i_ < 2; ++i_) \
    __builtin_amdgcn_global_load_lds((const unsigned*)(vb_ + voff[i_]), (AT_LAS unsigned*)(V_lds + (slot) * SHM_V + (2 * wid + i_) * 1024), 16, 0, 0); } while (0)
#define BAR_MID() do { SBAR(); asm volatile("s_barrier" ::: "memory"); SBAR(); } while (0)
#define BAR_END(n) do { SBAR(); asm volatile("s_waitcnt vmcnt(" #n ")\n\ts_barrier" ::: "memory"); SBAR(); } while (0)
#define RESC2() do { if (__any(alpha < 1.f)) { if (hi == 0) al_l[r32] = alpha; asm volatile("s_waitcnt lgkmcnt(0)" ::: "memory"); \
    _Pragma("unroll") for (int r = 0; r < 16; ++r) { const float f_ = al_l[crow(r, hi)]; ol[r] *= f_; _Pragma("unroll") for (int d = 0; d < NDB; ++d) o[d][r] *= f_; } } } while (0)
#define WMASK2(t) do { if constexpr (!DIFF) { if ((t) >= 4) wmask(p0, p1, tile_k0<DIFF>(a, (t)), a.q0 + r32, hi); } } while (0)
#define VSEG(t) do { WMASK2(t); softmax_seg2(p0, p1, m_reg, alpha, pa0, pa1, pa2, pa3); RESC2(); } while (0)
#define PKV(L, H) (bf16x8){L[0], L[1], L[2], L[3], H[0], H[1], H[2], H[3]}
#define VRD8(X, D0, va) do { RDTR(X##0, va, v_rd_off(D0, 0, 0)); RDTR(X##1, va, v_rd_off(D0, 0, 1)); RDTR(X##2, va, v_rd_off(D0, 1, 0)); RDTR(X##3, va, v_rd_off(D0, 1, 1)); \
    RDTR(X##4, va, v_rd_off(D0, 2, 0)); RDTR(X##5, va, v_rd_off(D0, 2, 1)); RDTR(X##6, va, v_rd_off(D0, 3, 0)); RDTR(X##7, va, v_rd_off(D0, 3, 1)); } while (0)
#define PV4(od, X) do { od = __builtin_amdgcn_mfma_f32_32x32x16_bf16(pa0, PKV(X##0, X##1), od, 0, 0, 0); od = __builtin_amdgcn_mfma_f32_32x32x16_bf16(pa1, PKV(X##2, X##3), od, 0, 0, 0); \
    od = __builtin_amdgcn_mfma_f32_32x32x16_bf16(pa2, PKV(X##4, X##5), od, 0, 0, 0); od = __builtin_amdgcn_mfma_f32_32x32x16_bf16(pa3, PKV(X##6, X##7), od, 0, 0, 0); } while (0)
#define MSEG(DOQK, DOPV, ksl, vsl) do { \
    bf16x8 k0_, k1_, k2_, k3_; s16x4 A0, A1, A2, A3, A4, A5, A6, A7, B0, B1, B2, B3, B4, B5, B6, B7; \
    const int ko_ = (ksl) * SHM_K; const int va_ = vb0 + (vsl) * SHM_V; \
    if (DOQK) { RD128(k0_, kad[0] + ko_, 0); RD128(k1_, kad[0] + ko_, 8192); RD128(k2_, kad[1] + ko_, 0); RD128(k3_, kad[1] + ko_, 8192); \
      bf16x8 k4_, k5_, k6_, k7_; RD128(k4_, kad[2] + ko_, 0); RD128(k5_, kad[2] + ko_, 8192); RD128(k6_, kad[3] + ko_, 0); RD128(k7_, kad[3] + ko_, 8192); \
      WAITL8_4(4, k0_, k1_, k2_, k3_); SBAR(); \
      p0 = __builtin_amdgcn_mfma_f32_32x32x16_bf16(k0_, qr[0], (f32x16){}, 0, 0, 0); p1 = __builtin_amdgcn_mfma_f32_32x32x16_bf16(k1_, qr[0], (f32x16){}, 0, 0, 0); \
      p0 = __builtin_amdgcn_mfma_f32_32x32x16_bf16(k2_, qr[1], p0, 0, 0, 0); p1 = __builtin_amdgcn_mfma_f32_32x32x16_bf16(k3_, qr[1], p1, 0, 0, 0); SBAR(); \
      if (DOPV) { VRD8(A, 0, va_); WAITL8_4(8, k4_, k5_, k6_, k7_); } else { WAITL8_4(0, k4_, k5_, k6_, k7_); } SBAR(); \
      p0 = __builtin_amdgcn_mfma_f32_32x32x16_bf16(k4_, qr[2], p0, 0, 0, 0); p1 = __builtin_amdgcn_mfma_f32_32x32x16_bf16(k5_, qr[2], p1, 0, 0, 0); \
      p0 = __builtin_amdgcn_mfma_f32_32x32x16_bf16(k6_, qr[3], p0, 0, 0, 0); p1 = __builtin_amdgcn_mfma_f32_32x32x16_bf16(k7_, qr[3], p1, 0, 0, 0); SBAR(); } \
    else if (DOPV) { VRD8(A, 0, va_); } \
    if (DOPV) { VRD8(B, 1, va_); WAITL8_8(8, A0, A1, A2, A3, A4, A5, A6, A7); SBAR(); PV4(o[0], A); SBAR(); \
      if constexpr (NDB == 4) { VRD8(A, 2, va_); WAITL8_8(8, B0, B1, B2, B3, B4, B5, B6, B7); SBAR(); PV4(o[1], B); SBAR(); \
        VRD8(B, 3, va_); WAITL8_8(8, A0, A1, A2, A3, A4, A5, A6, A7); SBAR(); PV4(o[2], A); SBAR(); \
        WAITL8_8(0, B0, B1, B2, B3, B4, B5, B6, B7); SBAR(); PV4(o[3], B); SBAR(); } \
      else { WAITL8_8(0, B0, B1, B2, B3, B4, B5, B6, B7); SBAR(); PV4(o[1], B); SBAR(); } \
      ol = __builtin_amdgcn_mfma_f32_32x32x16_bf16(pa0, ones, ol, 0, 0, 0); ol = __builtin_amdgcn_mfma_f32_32x32x16_bf16(pa1, ones, ol, 0, 0, 0); \
      ol = __builtin_amdgcn_mfma_f32_32x32x16_bf16(pa2, ones, ol, 0, 0, 0); ol = __builtin_amdgcn_mfma_f32_32x32x16_bf16(pa3, ones, ol, 0, 0, 0); SBAR(); } \
  } while (0)
#define ROT3(s) ((s) == 2 ? 0 : (s) + 1)
  f32x16 p0, p1; bf16x8 pa0, pa1, pa2, pa3;
  DMA_K(0, 0); DMA_K(1, 1); DMA_V(0, 0); BAR_END(0);
  int sk = 0;
  if (wid < 4) {
    DMA_K(2, 2); DMA_V(1, 1); MSEG(true, false, 0, 0); BAR_MID(); VSEG(0); BAR_END(4);
    sk = 1;
    for (int t = 1; t <= NT - 3; ++t) { const int s1 = ROT3(sk), s2 = ROT3(s1);
      DMA_K(t + 2, s2); DMA_V(t + 1, s1); MSEG(true, true, sk, s2); BAR_MID(); VSEG(t); BAR_END(4); sk = s1; }
    { const int s1 = ROT3(sk), s2 = ROT3(s1); DMA_V(NT - 1, s1); MSEG(true, true, sk, s2); BAR_MID(); VSEG(NT - 2); BAR_END(2); sk = s1; }
    { const int s1 = ROT3(sk), s2 = ROT3(s1); MSEG(true, true, sk, s2); BAR_MID(); VSEG(NT - 1); BAR_END(0); sk = s1; }
    { const int s2 = ROT3(ROT3(sk)); MSEG(false, true, 0, s2); BAR_MID(); BAR_END(0); }
  } else {
    DMA_K(2, 2); DMA_V(1, 1); BAR_MID(); MSEG(true, false, 0, 0); BAR_END(4);
    sk = 1;
    for (int t = 1; t <= NT - 3; ++t) { const int s1 = ROT3(sk), s2 = ROT3(s1);
      DMA_K(t + 2, s2); DMA_V(t + 1, s1); VSEG(t - 1); BAR_MID(); MSEG(true, true, sk, s2); BAR_END(4); sk = s1; }
    { const int s1 = ROT3(sk), s2 = ROT3(s1); DMA_V(NT - 1, s1); VSEG(NT - 3); BAR_MID(); MSEG(true, true, sk, s2); BAR_END(2); sk = s1; }
    { const int s1 = ROT3(sk), s2 = ROT3(s1); VSEG(NT - 2); BAR_MID(); MSEG(true, true, sk, s2); BAR_END(0); sk = s1; }
    { const int s2 = ROT3(ROT3(sk)); VSEG(NT - 1); BAR_MID(); MSEG(false, true, 0, s2); BAR_END(0); }
  }
  m_out = m_reg;
#undef DMA_K
#undef DMA_V
#undef BAR_MID
#undef BAR_END
#undef RESC2
#undef WMASK2
#undef VSEG
#undef PKV
#undef VRD8
#undef PV4
#undef MSEG
#undef ROT3
}

typedef int i32x8v __attribute__((ext_vector_type(8)));
constexpr int F8_SLOT = 8192, F8_K_OFF = 0, F8_V_OFF = 3 * F8_SLOT;
#define MF8_ACC(acc, a8, b8) asm volatile("v_mfma_scale_f32_32x32x64_f8f6f4 %0, %1, %2, %0, %3, %3 op_sel_hi:[0,0,0]" : "+v"(acc) : "v"(a8), "v"(b8), "v"(sc1))
#define MF8_NEW(acc, a8, b8) asm volatile("v_mfma_scale_f32_32x32x64_f8f6f4 %0, %1, %2, 0, %3, %3 op_sel_hi:[0,0,0]" : "=&v"(acc) : "v"(a8), "v"(b8), "v"(sc1))
__device__ __forceinline__ unsigned pk4f8(float a, float b, float c, float d) { int w = 0; w = __builtin_amdgcn_cvt_pk_fp8_f32(a, b, w, false); w = __builtin_amdgcn_cvt_pk_fp8_f32(c, d, w, true); return (unsigned)w; }
struct UnitArgs8 { const unsigned char* Q; const unsigned char* K; const unsigned char* VT; int comp, ldk, vdoff, q0, ks; };
template <bool DIFF> __device__ __forceinline__ int tile8_k0(const UnitArgs8& a, int j) { if constexpr (DIFF) return 64 * j; else return j < 4 ? SEQ + 64 * j : a.ks + 64 * (j - 4); }
template <bool DIFF>
__device__ __forceinline__ void attn_tiles_f8(const UnitArgs8& a, AT_LAS char* lds, int tid, int wid, int lane, f32x16* o, f32x16& ol, float& m_out) {
  constexpr int NDB = DIFF ? 4 : 2, NT = DIFF ? KVLEN / 64 : 10;
  const int r32 = lane & 31, hi = lane >> 5;
  AT_LAS char* K_lds = lds + F8_K_OFF; AT_LAS char* V_lds = lds + F8_V_OFF;
  AT_LAS float* al_l = (AT_LAS float*)(lds + AT_WS3_OFF) + wid * 64 + 32;
  float m_reg = -1e30f, alpha = 1.f;
  int sc1 = 0x7F7F7F7F; asm volatile("" : "+v"(sc1));
  i32x8v ones8; { int o4 = 0x38383838; asm volatile("" : "+v"(o4)); ones8 = (i32x8v){o4, o4, o4, o4, o4, o4, o4, o4}; }
  i32x8v q8; { const u32x4 qa_ = *(const u32x4*)(a.Q + (long)r32 * 512 + hi * 32), qb_ = *(const u32x4*)(a.Q + (long)r32 * 512 + hi * 32 + 16);
    q8 = (i32x8v){(int)qa_.x, (int)qa_.y, (int)qa_.z, (int)qa_.w, (int)qb_.x, (int)qb_.y, (int)qb_.z, (int)qb_.w}; }
  const int kkey = 8 * wid + (lane >> 3), koff = kkey * a.ldk + (((lane & 7) ^ ((kkey >> 1) & 7)) << 4);
  const int vd = 16 * wid + (lane >> 2); const long voff = (long)vd * KVLEN + (((lane & 3) ^ ((vd >> 2) & 3)) << 4);
  const int ksw = (r32 >> 1) & 7, vsw = (r32 >> 2) & 3;
  const int kb = (int)(unsigned)(uintptr_t)K_lds + r32 * 128, ka0 = kb + (((a.comp * 4 + 2 * hi) ^ ksw) << 4), ka1 = kb + (((a.comp * 4 + 2 * hi + 1) ^ ksw) << 4);
  const int vbb = (int)(unsigned)(uintptr_t)V_lds + a.vdoff + r32 * 64, va0 = vbb + (((2 * hi) ^ vsw) << 4), va1 = vbb + (((2 * hi + 1) ^ vsw) << 4);
#define DMA_K(t, slot) __builtin_amdgcn_global_load_lds((const unsigned*)(a.K + (long)tile8_k0<DIFF>(a, (t)) * a.ldk + koff), (AT_LAS unsigned*)(K_lds + (slot) * F8_SLOT + wid * 1024), 16, 0, 0)
#define DMA_V(t, slot) __builtin_amdgcn_global_load_lds((const unsigned*)(a.VT + (long)tile8_k0<DIFF>(a, (t)) + voff), (AT_LAS unsigned*)(V_lds + (slot) * F8_SLOT + wid * 1024), 16, 0, 0)
#define BAR_MID() do { SBAR(); asm volatile("s_barrier" ::: "memory"); SBAR(); } while (0)
#define BAR_END(n) do { SBAR(); asm volatile("s_waitcnt vmcnt(" #n ")\n\ts_barrier" ::: "memory"); SBAR(); } while (0)
#define RESC2() do { if (__any(alpha < 1.f)) { if (hi == 0) al_l[r32] = alpha; asm volatile("s_waitcnt lgkmcnt(0)" ::: "memory"); \
    _Pragma("unroll") for (int r = 0; r < 16; ++r) { const float f_ = al_l[crow(r, hi)]; ol[r] *= f_; _Pragma("unroll") for (int d = 0; d < NDB; ++d) o[d][r] *= f_; } } } while (0)
#define VSEG(t) do { if constexpr (!DIFF) { if ((t) >= 4) wmask(p0, p1, tile8_k0<DIFF>(a, (t)), a.q0 + r32, hi); } bf16x8 t0_, t1_, t2_, t3_; softmax_seg2(p0, p1, m_reg, alpha, t0_, t1_, t2_, t3_); (void)t0_; (void)t1_; (void)t2_; (void)t3_; \
    pa8 = (i32x8v){(int)pk4f8(p0[0], p0[1], p0[2], p0[3]), (int)pk4f8(p0[4], p0[5], p0[6], p0[7]), (int)pk4f8(p0[8], p0[9], p0[10], p0[11]), (int)pk4f8(p0[12], p0[13], p0[14], p0[15]), \
                   (int)pk4f8(p1[0], p1[1], p1[2], p1[3]), (int)pk4f8(p1[4], p1[5], p1[6], p1[7]), (int)pk4f8(p1[8], p1[9], p1[10], p1[11]), (int)pk4f8(p1[12], p1[13], p1[14], p1[15])}; RESC2(); } while (0)
#define RD16(dst, addr, OFF) asm volatile("ds_read_b128 %0, %1 offset:%2" : "=v"(dst) : "v"(addr), "i"(OFF) : "memory")
#define CAT8(x, y) (i32x8v){(int)x[0], (int)x[1], (int)x[2], (int)x[3], (int)y[0], (int)y[1], (int)y[2], (int)y[3]}
#define MSEG(DOQK, DOPV, ksl, vsl) do { \
    u32x4 ka_, kb_, kc_, kd_, v0a, v0b, v1a, v1b, v2a, v2b, v3a, v3b; const int ko_ = (ksl) * F8_SLOT, vo_ = (vsl) * F8_SLOT; \
    if (DOQK) { RD16(ka_, ka0 + ko_, 0); RD16(kb_, ka1 + ko_, 0); RD16(kc_, ka0 + ko_, 4096); RD16(kd_, ka1 + ko_, 4096); } \
    if (DOPV) { RD16(v0a, va0 + vo_, 0); RD16(v0b, va1 + vo_, 0); RD16(v1a, va0 + vo_, 2048); RD16(v1b, va1 + vo_, 2048); \
                if constexpr (NDB == 4) { RD16(v2a, va0 + vo_, 4096); RD16(v2b, va1 + vo_, 4096); RD16(v3a, va0 + vo_, 6144); RD16(v3b, va1 + vo_, 6144); } } \
    if (DOQK) { if (DOPV) { if constexpr (NDB == 4) asm volatile("s_waitcnt lgkmcnt(8)" : "+v"(ka_), "+v"(kb_), "+v"(kc_), "+v"(kd_) :: "memory"); else asm volatile("s_waitcnt lgkmcnt(4)" : "+v"(ka_), "+v"(kb_), "+v"(kc_), "+v"(kd_) :: "memory"); } else { asm volatile("s_waitcnt lgkmcnt(0)" : "+v"(ka_), "+v"(kb_), "+v"(kc_), "+v"(kd_) :: "memory"); } SBAR(); \
      { const i32x8v k0_ = CAT8(ka_, kb_), k1_ = CAT8(kc_, kd_); MF8_NEW(p0, k0_, q8); MF8_NEW(p1, k1_, q8); } SBAR(); } \
    if (DOPV) { if constexpr (NDB == 4) { asm volatile("s_waitcnt lgkmcnt(0)" : "+v"(v0a), "+v"(v0b), "+v"(v1a), "+v"(v1b), "+v"(v2a), "+v"(v2b), "+v"(v3a), "+v"(v3b) :: "memory"); SBAR(); \
        const i32x8v w0_ = CAT8(v0a, v0b), w1_ = CAT8(v1a, v1b), w2_ = CAT8(v2a, v2b), w3_ = CAT8(v3a, v3b); \
        MF8_ACC(o[0], pa8, w0_); MF8_ACC(o[1], pa8, w1_); MF8_ACC(o[2], pa8, w2_); MF8_ACC(o[3], pa8, w3_); MF8_ACC(ol, pa8, ones8); } \
      else { asm volatile("s_waitcnt lgkmcnt(0)" : "+v"(v0a), "+v"(v0b), "+v"(v1a), "+v"(v1b) :: "memory"); SBAR(); \
        const i32x8v w0_ = CAT8(v0a, v0b), w1_ = CAT8(v1a, v1b); MF8_ACC(o[0], pa8, w0_); MF8_ACC(o[1], pa8, w1_); MF8_ACC(ol, pa8, ones8); } SBAR(); } \
    asm volatile("s_nop 15\n\ts_nop 15" ::: "memory");     \
  } while (0)
#define ROT3(s) ((s) == 2 ? 0 : (s) + 1)
  f32x16 p0, p1; i32x8v pa8;
  DMA_K(0, 0); DMA_K(1, 1); DMA_V(0, 0); BAR_END(0);
  int sk = 0;
  if (wid < 4) {
    DMA_K(2, 2); DMA_V(1, 1); MSEG(true, false, 0, 0); BAR_MID(); VSEG(0); BAR_END(2);
    sk = 1;
    for (int t = 1; t <= NT - 3; ++t) { const int s1 = ROT3(sk), s2 = ROT3(s1);
      DMA_K(t + 2, s2); DMA_V(t + 1, s1); MSEG(true, true, sk, s2); BAR_MID(); VSEG(t); BAR_END(2); sk = s1; }
    { const int s1 = ROT3(sk), s2 = ROT3(s1); DMA_V(NT - 1, s1); MSEG(true, true, sk, s2); BAR_MID(); VSEG(NT - 2); BAR_END(1); sk = s1; }
    { const int s1 = ROT3(sk), s2 = ROT3(s1); MSEG(true, true, sk, s2); BAR_MID(); VSEG(NT - 1); BAR_END(0); sk = s1; }
    { const int s2 = ROT3(ROT3(sk)); MSEG(false, true, 0, s2); BAR_MID(); BAR_END(0); }
  } else {
    DMA_K(2, 2); DMA_V(1, 1); BAR_MID(); MSEG(true, false, 0, 0); BAR_END(2);
    sk = 1;
    for (int t = 1; t <= NT - 3; ++t) { const int s1 = ROT3(sk), s2 = ROT3(s1);
      DMA_K(t + 2, s2); DMA_V(t + 1, s1); VSEG(t - 1); BAR_MID(); MSEG(true, true, sk, s2); BAR_END(2); sk = s1; }
    { const int s1 = ROT3(sk), s2 = ROT3(s1); DMA_V(NT - 1, s1); VSEG(NT - 3); BAR_MID(); MSEG(true, true, sk, s2); BAR_END(1); sk = s1; }
    { const int s1 = ROT3(sk), s2 = ROT3(s1); VSEG(NT - 2); BAR_MID(); MSEG(true, true, sk, s2); BAR_END(0); sk = s1; }
    { const int s2 = ROT3(ROT3(sk)); VSEG(NT - 1); BAR_MID(); MSEG(false, true, 0, s2); BAR_END(0); }
  }
  m_out = m_reg;
#undef DMA_K
#undef DMA_V
#undef BAR_MID
#undef BAR_END
#undef RESC2
#undef VSEG
#undef RD16
#undef CAT8
#undef MSEG
#undef ROT3
}
#undef KSWZ
#undef SBAR
}

#ifndef QKV_FP8
#define QKV_FP8 1
#endif
constexpr size_t MiB = 1u << 20;
constexpr size_t WS_CTL = 0, CTL_ZERO_BYTES = 1 * MiB;
constexpr size_t WS_MODP = 1 * MiB;
constexpr size_t WS_MODV = 2 * MiB;
constexpr size_t WS_ROPE = 2 * MiB + 128 * 1024;
constexpr size_t WS_ROUTE = 3 * MiB;
constexpr size_t WS_WIN = 4 * MiB, WS_WOUT = 9 * MiB, WS_WGU = 12 * MiB, WS_WDN = 140 * MiB;
constexpr size_t WS_ELIST = 238 * MiB;
constexpr size_t WS_XN = 204 * MiB;
constexpr size_t WS_QA = 240 * MiB, WS_KA = 256 * MiB, WS_VA = 274 * MiB, WS_QB = 292 * MiB, WS_KB = 308 * MiB, WS_VB = 314 * MiB;
constexpr size_t WS_Y = 320 * MiB, WS_X1 = 352 * MiB, WS_XG = 416 * MiB, WS_H = 560 * MiB, WS_Y2 = 704 * MiB, WS_END = 848 * MiB;
constexpr int CW_TMO = 0, CW_CODE = 1, CW_BAR = 4096, CW_CNT = 8192;
constexpr int MODP_KC = 8;

constexpr int RING_OFF = 0, RING_BYTES = 131072;
constexpr int LDSCTL_OFF = RING_BYTES, MISC_OFF = LDSCTL_OFF + 320, XTRA_OFF = LDSCTL_OFF + 1024;
constexpr int LDS_BYTES = 147456;

__device__ const double ROPE_CS[32] = {
    0.54030230586813977, 0.8414709848078965, 0.84600911028170789, 0.53316843991402285, 0.95041528025518285, 0.31098359290718575, 0.98423023447009461, 0.17689218624615005,
    0.99500416527802582, 0.099833416646828155, 0.99841927779266448, 0.056204499214692491, 0.99950004166527784, 0.031617506402433708, 0.99984189028361437, 0.01778185687966613,
    0.99995000041666526, 0.0099998333341666645, 0.9999841886533658, 0.0056233836139601857, 0.99999500000416663, 0.0031622723897082477, 0.99999841886158658, 0.0017782784728035289,
    0.99999950000004167, 0.00099999983333334168, 0.99999984188612112, 0.00056234129555235944, 0.99999995000000041, 0.00031622776074637522, 0.99999998418861169, 0.00017782794006665674};

__device__ __forceinline__ unsigned cvtpk(float lo, float hi) { return at2::cvtpk2(lo, hi); }
__device__ __forceinline__ unsigned pk4_fp8(float a, float b, float c, float d) { int w = 0; w = __builtin_amdgcn_cvt_pk_fp8_f32(a, b, w, false); w = __builtin_amdgcn_cvt_pk_fp8_f32(c, d, w, true); return (unsigned)w; }
__device__ __forceinline__ float bflo(unsigned w) { return __uint_as_float(w << 16); }
__device__ __forceinline__ float bfhi(unsigned w) { return __uint_as_float(w & 0xffff0000u); }
__device__ __forceinline__ bf16 f2bf1(float f) { return (bf16)(cvtpk(f, 0.f) & 0xffffu); }
__device__ __forceinline__ void unpack8(const v4u v, float* f) { f[0] = bflo(v.x); f[1] = bfhi(v.x); f[2] = bflo(v.y); f[3] = bfhi(v.y); f[4] = bflo(v.z); f[5] = bfhi(v.z); f[6] = bflo(v.w); f[7] = bfhi(v.w); }
__device__ __forceinline__ float wave_sum(float v) {
#pragma unroll
    for (int o = 1; o < 64; o <<= 1) v += __shfl_xor(v, o);
    return v;
}

struct Frame {
    LAS unsigned char* lds;
    volatile LAS unsigned* MISC;
    gu32* ctl;
    int tid, lane, wave, vcu, G, probe;
    const float *x, *c, *ctx, *c_ctx, *w_mod, *b_mod, *norm1_g, *w_in, *lq1, *lk1, *lq2, *lk2, *subln_g, *sink, *w_out, *norm2_g, *w_router, *b_router, *w_gu, *b_gu, *w_dn, *b_dn, *final_g;
    float* out;
    float *modp, *modv, *rope, *X1, *rgate;
    int *re, *rslot, *rpos, *elist;
    bf16 *Win_t, *Wout_t, *Wgu_t, *Wdn_t, *XN, *QA, *KA, *VA, *QB, *KB, *VB, *Y, *XG, *H, *Y2;
};

#ifdef PROBE_BUILD
#define RP(F, k) (1 + (((F).probe >> (k)) & 1))
#else
#define RP(F, k) 1
#endif
struct EpiQKV {
    bf16 *QA, *KA, *VA, *QB, *KB, *VB; const float* rope;
    struct Ctx { bf16* p; bool skip, rp, isq; const float* cs; };
    __device__ __forceinline__ Ctx prep(int row, int cg) const {
        Ctx c; const bool lat = row < NTOK; const int b = lat ? (row >> 13) : ((row - NTOK) >> 8);
        const int kvrow = lat ? (b * KVLEN + (row & (SEQ - 1))) : (b * KVLEN + SEQ + ((row - NTOK) & (CTXL - 1)));
        c.skip = false; c.rp = lat; c.isq = false;
        if (cg < 512)       { c.p = QA + (size_t)row * 512 + cg; c.isq = true; c.skip = !lat; }
        else if (cg < 1024) { c.p = KA + (size_t)kvrow * 512 + (cg - 512); }
        else if (cg < 1536) { c.p = VA + (size_t)kvrow * 512 + (cg - 1024); c.rp = false; }
        else if (cg < 2048) { c.p = QB + (size_t)row * 512 + (cg - 1536); c.isq = true; c.skip = !lat; }
        else if (cg < 2176) { c.p = KB + (size_t)kvrow * 128 + (cg - 2048); }
        else                { c.p = VB + (size_t)kvrow * 128 + (cg - 2176); c.rp = false; }
        const int t = row & (SEQ - 1); const int pos = ((cg >> 5) & 1) ? (t & 63) : (t >> 6);
        c.cs = rope + pos * 32;
        return c;
    }
    __device__ __forceinline__ void math(const Ctx& c, int i, float lo, float hi, float& olo, float& ohi) const {
        if (c.rp) { const float cs = c.cs[2 * i], sn = c.cs[2 * i + 1]; olo = lo * cs - hi * sn; ohi = hi * cs + lo * sn; } else { olo = lo; ohi = hi; }
        if (c.isq) { olo *= QSCALE; ohi *= QSCALE; }
    }
    __device__ __forceinline__ void one(int row, int cg, int i, float lo, float hi, int) const {
        const Ctx c = prep(row, cg); if (c.skip) return; float a, b; math(c, i, lo, hi, a, b); c.p[i] = f2bf1(a); c.p[16 + i] = f2bf1(b);
    }
    __device__ __forceinline__ void four(int row, int cg, int i0, const f32x4 lo, const f32x4 hi, int) const {
        const Ctx c = prep(row, cg); if (c.skip) return; float a[4], b[4];
#pragma unroll
        for (int i = 0; i < 4; ++i) math(c, i0 + i, lo[i], hi[i], a[i], b[i]);
        typedef unsigned u32x2 __attribute__((ext_vector_type(2)));
        *(u32x2*)(c.p + i0) = (u32x2){cvtpk(a[0], a[1]), cvtpk(a[2], a[3])}; *(u32x2*)(c.p + 16 + i0) = (u32x2){cvtpk(b[0], b[1]), cvtpk(b[2], b[3])};
    }
};
struct EpiOut {
    const float* x; const float* modv; float* X1;
    __device__ __forceinline__ void one(int row, int cg, int i, float lo, float hi, int) const {
        const float* g1 = modv + (row >> 13) * 6144 + 2048; const size_t o = (size_t)row * DM + cg + i;
        X1[o] = x[o] + g1[cg + i] * lo; X1[o + 16] = x[o + 16] + g1[cg + 16 + i] * hi;
    }
    __device__ __forceinline__ void four(int row, int cg, int i0, const f32x4 lo, const f32x4 hi, int) const {
        const float* g1 = modv + (row >> 13) * 6144 + 2048 + cg + i0; const size_t o = (size_t)row * DM + cg + i0;
        typedef unsigned u32x2 __attribute__((ext_vector_type(2)));
        const f32x4 a = *(const f32x4*)(g1) * lo, b = *(const f32x4*)(g1 + 16) * hi;
        *(u32x2*)((bf16*)X1 + o) = (u32x2){cvtpk(a[0], a[1]), cvtpk(a[2], a[3])}; *(u32x2*)((bf16*)X1 + o + 16) = (u32x2){cvtpk(b[0], b[1]), cvtpk(b[2], b[3])};
    }
};
__device__ __forceinline__ float swiglu(float g, float lin) {
    g = fminf(g, 7.0f); lin = fminf(fmaxf(lin, -7.0f), 7.0f);
    return g * __builtin_amdgcn_rcpf(1.0f + __builtin_amdgcn_exp2f(-1.702f * LOG2E * g)) * (lin + 1.0f);
}
struct EpiGU {
    unsigned char* H; const float* b_gu;
    __device__ __forceinline__ void one(int row, int cg, int i, float lo, float hi, int e) const { (void)row; (void)cg; (void)i; (void)lo; (void)hi; (void)e; }
    __device__ __forceinline__ void four(int row, int cg, int i0, const f32x4 lo, const f32x4 hi, int e) const {
        const int f = (cg >> 1) + i0; const float* bb = b_gu + e * GUW + 2 * f; const f32x4 b0 = *(const f32x4*)bb, b1 = *(const f32x4*)(bb + 4);
        const float a0 = swiglu(lo[0] + b0[0], hi[0] + b0[1]), a1 = swiglu(lo[1] + b0[2], hi[1] + b0[3]), a2 = swiglu(lo[2] + b1[0], hi[2] + b1[1]), a3 = swiglu(lo[3] + b1[2], hi[3] + b1[3]);
        *(unsigned*)(H + (size_t)row * DM + f) = pk4_fp8(a0, a1, a2, a3);
    }
};
struct EpiDN {
    bf16* Y2; const float* b_dn;
    __device__ __forceinline__ void eight(int row, int c0, const f32x4 v0, const f32x4 v1, int e) const {
        const float* bb = b_dn + e * DM + c0; const f32x4 b0 = *(const f32x4*)bb, b1 = *(const f32x4*)(bb + 4);
        typedef unsigned u32x2 __attribute__((ext_vector_type(2)));
        *(u32x2*)((unsigned char*)Y2 + (size_t)row * DM + c0) = (u32x2){pk4_fp8(v0[0] + b0[0], v0[1] + b0[1], v0[2] + b0[2], v0[3] + b0[3]), pk4_fp8(v1[0] + b1[0], v1[1] + b1[1], v1[2] + b1[2], v1[3] + b1[3])};
    }
    __device__ __forceinline__ void one(int row, int cg, int i, float lo, float hi, int e) const {
        const float* bb = b_dn + e * DM + cg + i; bf16* p = Y2 + (size_t)row * DM + cg + i; p[0] = f2bf1(lo + bb[0]); p[16] = f2bf1(hi + bb[16]);
    }
    __device__ __forceinline__ void four(int row, int cg, int i0, const f32x4 lo, const f32x4 hi, int e) const {
        const float* bb = b_dn + e * DM + cg + i0; const f32x4 b0 = *(const f32x4*)bb, b1 = *(const f32x4*)(bb + 16); bf16* p = Y2 + (size_t)row * DM + cg + i0;
        typedef unsigned u32x2 __attribute__((ext_vector_type(2)));
        *(u32x2*)p = (u32x2){cvtpk(lo[0] + b0[0], lo[1] + b0[1]), cvtpk(lo[2] + b0[2], lo[3] + b0[3])}; *(u32x2*)(p + 16) = (u32x2){cvtpk(hi[0] + b1[0], hi[1] + b1[1]), cvtpk(hi[2] + b1[2], hi[3] + b1[3])};
    }
};
template <class E, int NN> struct EpiAdapt {
    static constexpr bool PERM = false, AFTER_DRAIN = false;
    E e;
    __device__ __forceinline__ void operator()(const pg8::f32x4 (&acc)[2][2][4][2], const pg8::Unit& u, int wr, int wc, int fr, int fq) const {
        int ex = 0, pn = u.pn; if (NN) { ex = pn / NN; pn = pn - ex * NN; }
#pragma unroll
        for (int ai = 0; ai < 2; ++ai)
#pragma unroll
            for (int m = 0; m < 4; ++m) { const int row = u.pm * 256 + ai * 128 + wr * 64 + m * 16 + fr;
#pragma unroll
                for (int bj = 0; bj < 2; ++bj) e.four(row, pn * 256 + bj * 128 + wc * 32, 4 * fq, acc[ai][bj][m][0], acc[ai][bj][m][1], ex); }
    }
};
struct RepOrder : pg8::StaticOrder { int rep;
    __device__ __forceinline__ bool next(int i, pg8::Unit& u) const { if (rep > 1) { const int R = (nwg + G - 1) / G; if (i >= R * rep) return false; i %= R; } return pg8::StaticOrder::next(i, u); } };
struct EpiQKVFast {
    static constexpr bool PERM = false, AFTER_DRAIN = false;
    bf16 *QA, *KA, *VA, *QB, *KB, *VB; const float* rope;
    __device__ __forceinline__ void operator()(const pg8::f32x4 (&acc)[2][2][4][2], const pg8::Unit& u, int wr, int wc, int fr, int fq) const {
        typedef unsigned u32x2 __attribute__((ext_vector_type(2)));
        bf16* base[2]; int ld[2]; bool isq[2], rp[2], kvr[2], f8[2];
#pragma unroll
        for (int bj = 0; bj < 2; ++bj) { const int cg = u.pn * 256 + bj * 128 + wc * 32; isq[bj] = false; rp[bj] = true; kvr[bj] = true; f8[bj] = true;
            if (cg < 512)       { base[bj] = (bf16*)((unsigned char*)QA + cg); ld[bj] = 512; isq[bj] = true; kvr[bj] = false; }
            else if (cg < 1024) { base[bj] = (bf16*)((unsigned char*)KA + (cg - 512)); ld[bj] = 512; }
            else if (cg < 1536) { base[bj] = (bf16*)((unsigned char*)VA + (cg - 1024)); ld[bj] = 512; rp[bj] = false; }
            else if (cg < 2048) { base[bj] = (bf16*)((unsigned char*)QB + (cg - 1536)); ld[bj] = 512; isq[bj] = true; kvr[bj] = false; }
            else if (cg < 2176) { base[bj] = (bf16*)((unsigned char*)KB + (cg - 2048)); ld[bj] = 128; }
            else                { base[bj] = (bf16*)((unsigned char*)VB + (cg - 2176)); ld[bj] = 128; rp[bj] = false; } }
        const bool colhalf = (wc & 1) != 0;
#pragma unroll
        for (int ai = 0; ai < 2; ++ai)
#pragma unroll
            for (int m = 0; m < 4; ++m) {
                const int row = u.pm * 256 + ai * 128 + wr * 64 + m * 16 + fr; const bool lat = row < NTOK;
                const int b = lat ? (row >> 13) : ((row - NTOK) >> 8);
                const int kvrow = lat ? (b * KVLEN + (row & (SEQ - 1))) : (b * KVLEN + SEQ + ((row - NTOK) & (CTXL - 1)));
                const int t = row & (SEQ - 1), pos = colhalf ? (t & 63) : (t >> 6);
                const f32x4 c0 = *(const f32x4*)(rope + pos * 32 + 8 * fq), c1 = *(const f32x4*)(rope + pos * 32 + 8 * fq + 4);
#pragma unroll
                for (int bj = 0; bj < 2; ++bj) {
                    if (isq[bj] && !lat) continue;
                    f32x4 lo = acc[ai][bj][m][0], hi = acc[ai][bj][m][1];
                    if (rp[bj] && lat) { const f32x4 cs = {c0[0], c0[2], c1[0], c1[2]}, sn = {c0[1], c0[3], c1[1], c1[3]}; const f32x4 nl = lo * cs - hi * sn, nh = hi * cs + lo * sn; lo = nl; hi = nh; }
                    if (isq[bj]) { lo = lo * QSCALE; hi = hi * QSCALE; }
                    const size_t rr = (size_t)(kvr[bj] ? kvrow : row) * ld[bj];
                    if (f8[bj]) { unsigned char* p = (unsigned char*)base[bj] + rr + 4 * fq; *(unsigned*)p = pk4_fp8(lo[0], lo[1], lo[2], lo[3]); *(unsigned*)(p + 16) = pk4_fp8(hi[0], hi[1], hi[2], hi[3]); }
                    else { bf16* p = base[bj] + rr + 4 * fq; *(u32x2*)p = (u32x2){cvtpk(lo[0], lo[1]), cvtpk(lo[2], lo[3])}; *(u32x2*)(p + 16) = (u32x2){cvtpk(hi[0], hi[1]), cvtpk(hi[2], hi[3])}; }
                }
            }
    }
};
template <class E, int NN> struct EpiAdaptP {
    static constexpr bool PERM = true, AFTER_DRAIN = false;
    E e;
    __device__ __forceinline__ void operator()(const pg8::f32x4 (&acc)[2][2][4][2], const pg8::Unit& u, int wr, int wc, int fr, int fq) const {
        int ex = 0, pn = u.pn; if (NN) { ex = pn / NN; pn = pn - ex * NN; }
#pragma unroll
        for (int ai = 0; ai < 2; ++ai)
#pragma unroll
            for (int m = 0; m < 4; ++m) { const int row = u.pm * 256 + ai * 128 + wr * 64 + m * 16 + fr;
#pragma unroll
                for (int bj = 0; bj < 2; ++bj) e.eight(row, pn * 256 + bj * 128 + wc * 32 + 8 * fq, acc[ai][bj][m][0], acc[ai][bj][m][1], ex); }
    }
};
struct GroupedOrder {
    int nN, NP, G, c; const LAS int* pexp; int rep; const LAS int* tokT;
    __device__ __forceinline__ int rounds() const { const int upr = G / nN; return (NP + upr - 1) / upr; }
    __device__ __forceinline__ int tok(int ui, int r) const { if (rep > 1) ui %= rounds(); return tokT[ui * 256 + r]; }
    __device__ __forceinline__ bool next(int i, pg8::Unit& u) const {
        int p, j;
        if (rep > 1) { const int R = rounds(); if (i >= R * rep) return false; i %= R; }
        if (G == 256) { const int x = c & 7, r = c >> 3, ppx = 32 / nN; p = i * (8 * ppx) + x * ppx + r / nN; j = r % nN; }
        else { const long L = (long)i * G + c; p = (int)(L / nN); j = (int)(L % nN); }
        if (p >= NP) return false;
        u.pm = p; u.pn = pexp[p] * nN + j; return true;
    }
    __device__ __forceinline__ void a_ready(const pg8::Unit&) const {}
    __device__ __forceinline__ void done(const pg8::Unit&) const {}
};

struct DenseSel { const bf16* Bt; __device__ __forceinline__ const bf16* operator()(int, int& e) const { e = 0; return Bt; } };
struct GroupSel { const bf16* Bt; const LAS int* pexp; int N, K; __device__ __forceinline__ const bf16* operator()(int mt, int& e) const { e = pexp[mt >> 1]; return Bt + (size_t)e * N * K; } };
template <class Epi, class BSel>
__device__ __forceinline__ void naive_gemm(Frame& F, const bf16* A, int Mtiles, int N, int K, const BSel& bs, const Epi& E) {
    LAS float* As = (LAS float*)(F.lds + RING_OFF); LAS float* Bs = As + 128 * 33;
    const int nNt = N / 64, tx = F.tid & 15, ty = F.tid >> 4;
    for (int t = blockIdx.x; t < Mtiles * nNt; t += F.G) {
        const int mt = t / nNt, nt = t % nNt; int e; const bf16* Bt = bs(mt, e);
        float acc[4][4];
#pragma unroll
        for (int r = 0; r < 4; ++r)
#pragma unroll
            for (int j = 0; j < 4; ++j) acc[r][j] = 0.f;
        for (int k0 = 0; k0 < K; k0 += 32) {
            { const int r = F.tid >> 2, kc = (F.tid & 3) * 8; float f[8]; unpack8(*(const v4u*)(A + (size_t)(mt * 128 + r) * K + k0 + kc), f);
#pragma unroll
              for (int i = 0; i < 8; ++i) As[r * 33 + kc + i] = f[i]; }
            if (F.tid < 256) { const int r = F.tid >> 2, kc = (F.tid & 3) * 8; float f[8]; unpack8(*(const v4u*)(Bt + (size_t)(nt * 64 + r) * K + k0 + kc), f);
#pragma unroll
              for (int i = 0; i < 8; ++i) Bs[r * 33 + kc + i] = f[i]; }
            __syncthreads();
#pragma unroll 8
            for (int kk = 0; kk < 32; ++kk) { float a[4], b[4];
#pragma unroll
                for (int r = 0; r < 4; ++r) a[r] = As[(ty * 4 + r) * 33 + kk];
#pragma unroll
                for (int j = 0; j < 4; ++j) b[j] = Bs[(tx + 16 * j) * 33 + kk];
#pragma unroll
                for (int r = 0; r < 4; ++r)
#pragma unroll
                    for (int j = 0; j < 4; ++j) acc[r][j] += a[r] * b[j]; }
            __syncthreads();
        }
#pragma unroll
        for (int r = 0; r < 4; ++r) { const int row = mt * 128 + ty * 4 + r; E.one(row, nt * 64, tx, acc[r][0], acc[r][1], e); E.one(row, nt * 64 + 32, tx, acc[r][2], acc[r][3], e); }
    }
}

template <bool GUPERM>
__device__ __forceinline__ void p0_transpose_item(const float* W, int K, int N, bf16* WT, LAS float* scr, int item, int lane) {
    const int nblk = N / 32, kb = item / nblk, nb = item % nblk, k0 = 64 * kb, n0 = 32 * nb;
    { f32x4 v[8]; const float* wp = W + (size_t)(k0 + (lane >> 3)) * N + n0 + 4 * (lane & 7);
#pragma unroll
      for (int i = 0; i < 8; ++i) v[i] = __builtin_nontemporal_load((const f32x4*)(wp + (size_t)(8 * i) * N));
#pragma unroll
      for (int i = 0; i < 8; ++i) { LAS float* d = scr + (8 * i + (lane >> 3)) * 33 + 4 * (lane & 7); d[0] = v[i].x; d[1] = v[i].y; d[2] = v[i].z; d[3] = v[i].w; } }
    LDS_WAIT(); asm volatile("" ::: "memory");
    const int c = lane & 7;
#pragma unroll
    for (int j = 0; j < 4; ++j) { const int n = (lane >> 3) + 8 * j; const LAS float* s = scr + (8 * c) * 33 + n;
        v4u o; o.x = cvtpk(s[0 * 33], s[1 * 33]); o.y = cvtpk(s[2 * 33], s[3 * 33]); o.z = cvtpk(s[4 * 33], s[5 * 33]); o.w = cvtpk(s[6 * 33], s[7 * 33]);
        const int nd = GUPERM ? ((n & 1) * 16 + (n >> 1)) : n;
        *(GAS v4u*)(WT + (size_t)(n0 + nd) * K + k0 + 8 * c) = o; }
    LDS_WAIT(); asm volatile("" ::: "memory");
}
template <bool GUPERM>
__device__ __forceinline__ void p0_transpose_item_fp8(const float* W, int K, int N, unsigned char* WT, LAS float* scr, int item, int lane) {
    const int nblk = N / 32, kb = item / nblk, nb = item % nblk, k0 = 64 * kb, n0 = 32 * nb;
    { f32x4 v[8]; const float* wp = W + (size_t)(k0 + (lane >> 3)) * N + n0 + 4 * (lane & 7);
#pragma unroll
      for (int i = 0; i < 8; ++i) v[i] = __builtin_nontemporal_load((const f32x4*)(wp + (size_t)(8 * i) * N));
#pragma unroll
      for (int i = 0; i < 8; ++i) { LAS float* d = scr + (8 * i + (lane >> 3)) * 33 + 4 * (lane & 7); d[0] = v[i].x; d[1] = v[i].y; d[2] = v[i].z; d[3] = v[i].w; } }
    LDS_WAIT(); asm volatile("" ::: "memory");
    const int c = lane & 7;
    typedef unsigned u32x2 __attribute__((ext_vector_type(2)));
#pragma unroll
    for (int j = 0; j < 4; ++j) { const int n = (lane >> 3) + 8 * j; const LAS float* s = scr + (8 * c) * 33 + n;
        u32x2 o; o.x = pk4_fp8(s[0 * 33] * 32.f, s[1 * 33] * 32.f, s[2 * 33] * 32.f, s[3 * 33] * 32.f); o.y = pk4_fp8(s[4 * 33] * 32.f, s[5 * 33] * 32.f, s[6 * 33] * 32.f, s[7 * 33] * 32.f);
        const int nd = GUPERM ? ((n & 1) * 16 + (n >> 1)) : n;
        *(GAS u32x2*)(WT + (size_t)(n0 + nd) * K + k0 + 8 * c) = o; }
    LDS_WAIT(); asm volatile("" ::: "memory");
}
struct F8Item { const float* wp; unsigned char* wt; int K; int guperm; };
__device__ __forceinline__ F8Item f8_decode(const Frame& F, int r, int lane) {
    constexpr int I_GU1 = (DM / 64) * (GUW / 32), I_DN1 = (DM / 64) * (DM / 32);
    F8Item I; const float* W; int N, item; unsigned char* WT;
    if (r < NEXP * I_GU1) { const int e = r / I_GU1; item = r % I_GU1; W = F.w_gu + (size_t)e * DM * GUW; N = GUW; WT = (unsigned char*)F.Wgu_t + (size_t)e * GUW * DM; I.guperm = 1; }
    else { r -= NEXP * I_GU1; const int e = r / I_DN1; item = r % I_DN1; W = F.w_dn + (size_t)e * DM * DM; N = DM; WT = (unsigned char*)F.Wdn_t + (size_t)e * DM * DM; I.guperm = 0; }
    const int nblk = N / 32, kb = item / nblk, nb = item % nblk, k0 = 64 * kb, n0 = 32 * nb;
    I.wp = W + (size_t)(k0 + (lane >> 3)) * N + n0 + 4 * (lane & 7); I.K = N;
    I.wt = WT + (size_t)n0 * DM + k0 + 8 * (lane & 7);
    return I;
}
__device__ __forceinline__ void f8_issue(const F8Item& I, f32x4 (&v)[8]) {
#pragma unroll
    for (int i = 0; i < 8; ++i) v[i] = __builtin_nontemporal_load((const f32x4*)(I.wp + (size_t)(8 * i) * I.K));
}
__device__ __forceinline__ void f8_finish(const F8Item& I, f32x4 (&v)[8], LAS float* scr, int lane) {
#pragma unroll
    for (int i = 0; i < 8; ++i) { LAS float* d = scr + (8 * i + (lane >> 3)) * 33 + 4 * (lane & 7); d[0] = v[i].x; d[1] = v[i].y; d[2] = v[i].z; d[3] = v[i].w; }
    LDS_WAIT(); asm volatile("" ::: "memory");
    const int c = lane & 7;
    typedef unsigned u32x2 __attribute__((ext_vector_type(2)));
#pragma unroll
    for (int j = 0; j < 4; ++j) { const int n = (lane >> 3) + 8 * j; const LAS float* s = scr + (8 * c) * 33 + n;
        u32x2 o; o.x = pk4_fp8(s[0 * 33] * 32.f, s[1 * 33] * 32.f, s[2 * 33] * 32.f, s[3 * 33] * 32.f); o.y = pk4_fp8(s[4 * 33] * 32.f, s[5 * 33] * 32.f, s[6 * 33] * 32.f, s[7 * 33] * 32.f);
        const int nd = I.guperm ? ((n & 1) * 16 + (n >> 1)) : n;
        *(GAS u32x2*)(I.wt + (size_t)nd * DM) = o; }
    LDS_WAIT(); asm volatile("" ::: "memory");
}
__device__ __forceinline__ void f8_stream(const Frame& F, LAS float* scr, int r, int rend, int stride) {
    f32x4 va[8], vb[8]; F8Item Ia, Ib;
    if (r >= rend) return;
    Ia = f8_decode(F, r, F.lane); f8_issue(Ia, va);
    while (true) {
        int nx = r + stride;
        if (nx < rend) { Ib = f8_decode(F, nx, F.lane); f8_issue(Ib, vb); }
        f8_finish(Ia, va, scr, F.lane);
        r = nx; if (r >= rend) break;
        nx = r + stride;
        if (nx < rend) { Ia = f8_decode(F, nx, F.lane); f8_issue(Ia, va); }
        f8_finish(Ib, vb, scr, F.lane);
        r = nx; if (r >= rend) break;
    }
}
__device__ __forceinline__ void p0_item(Frame& F, LAS float* sil, LAS float* scr, int it) {
    constexpr int I_IN = (DM / 64) * (INC / 32), I_OUT = (DM / 64) * (DM / 32), I_GU1 = (DM / 64) * (GUW / 32), I_DN1 = (DM / 64) * (DM / 32);

        int r = it;
#if QKV_FP8
        if (r < I_IN) { p0_transpose_item_fp8<false>(F.w_in, DM, INC, (unsigned char*)F.Win_t, scr, r, F.lane); return; } r -= I_IN;
#else
        if (r < I_IN) { p0_transpose_item<false>(F.w_in, DM, INC, F.Win_t, scr, r, F.lane); return; } r -= I_IN;
#endif
        if (r < I_OUT) { p0_transpose_item<false>(F.w_out, DM, DM, F.Wout_t, scr, r, F.lane); return; } r -= I_OUT;
        if (r < NEXP * I_GU1) { const int e = r / I_GU1; p0_transpose_item_fp8<true>(F.w_gu + (size_t)e * DM * GUW, DM, GUW, (unsigned char*)F.Wgu_t + (size_t)e * GUW * DM, scr, r % I_GU1, F.lane); return; } r -= NEXP * I_GU1;
        { const int e = r / I_DN1; p0_transpose_item_fp8<false>(F.w_dn + (size_t)e * DM * DM, DM, DM, (unsigned char*)F.Wdn_t + (size_t)e * DM * DM, scr, r % I_DN1, F.lane); }
}
constexpr int P0_NITEMS = (DM / 64) * (INC / 32) + (DM / 64) * (DM / 32) + NEXP * (DM / 64) * (GUW / 32) + NEXP * (DM / 64) * (DM / 32);
#ifndef P2_TAIL_ITEMS
#define P2_TAIL_ITEMS 44000
#endif
#ifndef P2_GEMM_WGS_N
#define P2_GEMM_WGS_N 120
#endif
constexpr int P2_GEMM_WGS = P2_GEMM_WGS_N;
constexpr int P0_SPLIT = P0_NITEMS - P2_TAIL_ITEMS;
__device__ __forceinline__ void p0_tail(Frame& F) {
    LAS float* scr = (LAS float*)(F.lds + RING_OFF + F.wave * 16384);
    const int w = ((int)blockIdx.x - P2_GEMM_WGS) * NWAVES + F.wave, NW = (F.G - P2_GEMM_WGS) * NWAVES;
    constexpr int NPRE = (DM / 64) * (INC / 32) + (DM / 64) * (DM / 32);
    f8_stream(F, scr, P0_SPLIT - NPRE + w, P0_NITEMS - NPRE, NW);
}
__device__ __forceinline__ void p0_prologue(Frame& F) {
    LAS float* sil = (LAS float*)(F.lds + XTRA_OFF);
    for (int i = F.tid; i < 3072; i += 512) { const int v = i >> 10, k = i & 1023; const float cv = (v < 2) ? F.c[v * 1024 + k] : F.c_ctx[k]; sil[i] = cv / (1.f + __expf(-cv)); }
    __syncthreads();
    const int gw = F.vcu * NWAVES + F.wave, NGW = F.G * NWAVES;
    if (blockIdx.x == 0) for (int i = F.tid; i < 2048; i += 512) { const int pos = i >> 4, j = i & 15; double cr = 1.0, sr = 0.0, cb = ROPE_CS[2 * j], sb = ROPE_CS[2 * j + 1];
        for (int bit = 0; bit < 7; ++bit) { if ((pos >> bit) & 1) { const double t = cr * cb - sr * sb; sr = cr * sb + sr * cb; cr = t; } const double t2 = cb * cb - sb * sb; sb = 2.0 * cb * sb; cb = t2; }
        F.rope[2 * i] = (float)cr; F.rope[2 * i + 1] = (float)sr; }
    for (int r = F.vcu; r < 24 * MODP_KC; r += F.G) {
        const int nb = r % 24, kc = r / 24, n = nb * 256 + F.lane * 4, kbase = kc * 128 + F.wave * 16;
        f32x4 a0 = {0.f, 0.f, 0.f, 0.f}, a1 = a0, a2 = a0;
        const float* wp = F.w_mod + (size_t)kbase * 6144 + n;
#pragma unroll
        for (int kk = 0; kk < 16; ++kk) { const f32x4 w = __builtin_nontemporal_load((const f32x4*)(wp + (size_t)kk * 6144)); const int k = kbase + kk; a0 += w * sil[k]; a1 += w * sil[1024 + k]; a2 += w * sil[2048 + k]; }
        LAS float* red = (LAS float*)(F.lds + RING_OFF);
        *(LAS f32x4*)(red + (F.wave * 3 + 0) * 256 + 4 * F.lane) = a0; *(LAS f32x4*)(red + (F.wave * 3 + 1) * 256 + 4 * F.lane) = a1; *(LAS f32x4*)(red + (F.wave * 3 + 2) * 256 + 4 * F.lane) = a2;
        __syncthreads();
        for (int i = F.tid; i < 768; i += 512) { float t = 0.f;
#pragma unroll
            for (int w = 0; w < NWAVES; ++w) t += red[w * 768 + i];
            F.modp[(size_t)(kc * 3 + i / 256) * 6144 + nb * 256 + (i % 256)] = t; }
        __syncthreads();
    }
    LAS float* scr = (LAS float*)(F.lds + RING_OFF + F.wave * 16384);
    constexpr int I_IN = (DM / 64) * (INC / 32), I_OUT = (DM / 64) * (DM / 32), I_GU1 = (DM / 64) * (GUW / 32), I_DN1 = (DM / 64) * (DM / 32);
    constexpr int NITEMS = I_IN + I_OUT + NEXP * I_GU1 + NEXP * I_DN1;
    const int nsplit = (F.G == 256) ? P0_SPLIT : NITEMS;
    constexpr int NPRE = I_IN + I_OUT;
    int it0 = gw;
    if (NPRE > NGW) { for (; it0 < NPRE; it0 += NGW) p0_item(F, sil, scr, it0); } else if (it0 < NPRE) { p0_item(F, sil, scr, it0); it0 += NGW; }
    f8_stream(F, scr, it0 - NPRE, nsplit - NPRE, NGW);
}
__device__ __forceinline__ void p1_norm(Frame& F) {
    LAS float* ml = (LAS float*)(F.lds + RING_OFF);
    for (int i0 = F.tid; i0 < 6144; i0 += 2048) { float pv[4][MODP_KC], bv[4];
#pragma unroll
        for (int q = 0; q < 4; ++q) { const int i = i0 + 512 * q, v = i / 2048, j = i % 2048; bv[q] = F.b_mod[j];
#pragma unroll
            for (int kc = 0; kc < MODP_KC; ++kc) pv[q][kc] = F.modp[(size_t)(kc * 3 + v) * 6144 + j]; }
#pragma unroll
        for (int q = 0; q < 4; ++q) { float t = bv[q];
#pragma unroll
            for (int kc = 0; kc < MODP_KC; ++kc) t += pv[q][kc];
            ml[i0 + 512 * q] = t; } }
    for (int gi = blockIdx.x * 512 + F.tid; gi < 3 * 6144; gi += F.G * 512) { const int v = gi / 6144, j = gi % 6144; float s = F.b_mod[j];
        for (int kc = 0; kc < MODP_KC; ++kc) s += F.modp[(size_t)(kc * 3 + v) * 6144 + j]; F.modv[gi] = s; }
    __syncthreads();
    const int gw = F.vcu * NWAVES + F.wave, NGW = F.G * NWAVES;
    typedef unsigned u32x2 __attribute__((ext_vector_type(2)));
    for (int pp = gw; pp < (NROW / 2) * RP(F, 1); pp += NGW) { const int m0 = (pp % (NROW / 2)) * 2;
        f32x4 xv[2][4]; float s[2] = {0.f, 0.f}; int v[2];
#pragma unroll
        for (int q = 0; q < 2; ++q) { const int m = m0 + q; v[q] = m < SEQ ? 0 : (m < NTOK ? 1 : 2);
            const float* src = m < NTOK ? F.x + (size_t)m * DM : F.ctx + (size_t)(m - NTOK) * DM;
#pragma unroll
            for (int j = 0; j < 4; ++j) xv[q][j] = __builtin_nontemporal_load((const f32x4*)(src + 4 * F.lane + 256 * j)); }
#pragma unroll
        for (int q = 0; q < 2; ++q)
#pragma unroll
            for (int j = 0; j < 4; ++j) s[q] += (xv[q][j].x * xv[q][j].x + xv[q][j].y * xv[q][j].y) + (xv[q][j].z * xv[q][j].z + xv[q][j].w * xv[q][j].w);
#pragma unroll
        for (int q = 0; q < 2; ++q) { const int m = m0 + q; const float rstd = 1.0f / sqrtf(wave_sum(s[q]) * (1.f / DM) + NORM_EPS);
#pragma unroll
            for (int j = 0; j < 4; ++j) { const int col = 4 * F.lane + 256 * j; const f32x4 g = *(const f32x4*)(F.norm1_g + col);
                const f32x4 sh = *(const LAS f32x4*)(ml + v[q] * 2048 + col), sc = *(const LAS f32x4*)(ml + v[q] * 2048 + 1024 + col);
                const f32x4 y = (xv[q][j] * rstd * g) * (sc + 1.0f) + sh;
#if QKV_FP8
                *(unsigned*)((unsigned char*)F.XN + (size_t)m * DM + col) = pk4_fp8(y.x, y.y, y.z, y.w); } }
#else
                *(u32x2*)(F.XN + (size_t)m * DM + col) = (u32x2){cvtpk(y.x, y.y), cvtpk(y.z, y.w)}; } }
#endif
    }
}

__device__ __forceinline__ float lam_value(Frame& F) {
    const float a = wave_sum(F.lq1[F.lane] * F.lk1[F.lane]), b = wave_sum(F.lq2[F.lane] * F.lk2[F.lane]);
    return __expf(a) - __expf(b) + 0.2f;
}
__device__ __forceinline__ void naive_diff_attn(Frame& F) {
    const float lam = lam_value(F);
    LAS float* X = (LAS float*)(F.lds + RING_OFF);
    LAS float* SS = X + 128 * 128;
    const int q = F.tid & 127, comp = (F.tid >> 7) & 1, vh = F.tid >> 8;
    for (int it = blockIdx.x; it < BATCH * 4 * (SEQ / 128); it += F.G) {
        const int b = it >> 8, h = (it >> 6) & 3, qb = it & 63; const int row = b * SEQ + qb * 128 + q;
        float qv[64], o[64];
#pragma unroll
        for (int c8 = 0; c8 < 8; ++c8) unpack8(*(const v4u*)(F.QA + (size_t)row * 512 + h * 128 + comp * 64 + c8 * 8), qv + 8 * c8);
#pragma unroll
        for (int e = 0; e < 64; ++e) o[e] = 0.f;
        float m = -1e30f, l = 0.f;
        const bf16* kp = F.KA + (size_t)(b * KVLEN) * 512 + h * 128 + comp * 64; const bf16* vp = F.VA + (size_t)(b * KVLEN) * 512 + h * 128 + vh * 64;
        for (int key = 0; key < KVLEN; ++key) {
            float s = 0.f;
#pragma unroll
            for (int c8 = 0; c8 < 8; ++c8) { float kf[8]; unpack8(*(const v4u*)(kp + (size_t)key * 512 + c8 * 8), kf);
#pragma unroll
                for (int i = 0; i < 8; ++i) s += qv[8 * c8 + i] * kf[i]; }
            if (s > m) { const float a = exp2f(m - s); l *= a;
#pragma unroll
                for (int e = 0; e < 64; ++e) o[e] *= a;
                m = s; }
            const float p = exp2f(s - m); l += p;
#pragma unroll
            for (int c8 = 0; c8 < 8; ++c8) { float vf[8]; unpack8(*(const v4u*)(vp + (size_t)key * 512 + c8 * 8), vf);
#pragma unroll
                for (int i = 0; i < 8; ++i) o[8 * c8 + i] += p * vf[i]; }
        }
        const float inv = 1.0f / l;
        __syncthreads();
        if (comp == 1) {
#pragma unroll
            for (int e = 0; e < 64; ++e) X[(vh * 64 + e) * 128 + q] = lam * o[e] * inv; }
        __syncthreads();
        if (comp == 0) { float ss = 0.f;
#pragma unroll
            for (int e = 0; e < 64; ++e) { o[e] = o[e] * inv - X[(vh * 64 + e) * 128 + q]; ss += o[e] * o[e]; }
            SS[vh * 128 + q] = ss; }
        __syncthreads();
        if (comp == 0) { const float r = 0.8f / sqrtf((SS[q] + SS[128 + q]) * (1.f / 128.f) + NORM_EPS);
            bf16* yp = F.Y + (size_t)row * DM + h * 128 + vh * 64; const float* sg = F.subln_g + vh * 64;
#pragma unroll
            for (int c8 = 0; c8 < 8; ++c8) { v4u w; w.x = cvtpk(o[8 * c8] * r * sg[8 * c8], o[8 * c8 + 1] * r * sg[8 * c8 + 1]); w.y = cvtpk(o[8 * c8 + 2] * r * sg[8 * c8 + 2], o[8 * c8 + 3] * r * sg[8 * c8 + 3]);
                w.z = cvtpk(o[8 * c8 + 4] * r * sg[8 * c8 + 4], o[8 * c8 + 5] * r * sg[8 * c8 + 5]); w.w = cvtpk(o[8 * c8 + 6] * r * sg[8 * c8 + 6], o[8 * c8 + 7] * r * sg[8 * c8 + 7]);
                *(v4u*)(yp + 8 * c8) = w; } }
    }
}
__device__ __forceinline__ void naive_win_attn(Frame& F) {
    for (int it = blockIdx.x; it < BATCH * 8 * (SEQ / 512); it += F.G) {
        const int b = it >> 7, h = (it >> 4) & 7, t = (it & 15) * 512 + F.tid, kv = h >> 2; const int row = b * SEQ + t;
        float qv[64], o[64];
#pragma unroll
        for (int c8 = 0; c8 < 8; ++c8) unpack8(*(const v4u*)(F.QB + (size_t)row * 512 + h * 64 + c8 * 8), qv + 8 * c8);
#pragma unroll
        for (int e = 0; e < 64; ++e) o[e] = 0.f;
        float m = F.sink[h] * LOG2E, l = 1.0f;
        const bf16* kp = F.KB + (size_t)(b * KVLEN) * 128 + kv * 64; const bf16* vp = F.VB + (size_t)(b * KVLEN) * 128 + kv * 64;
        for (int jj = 0; jj < 257 + CTXL; ++jj) {
            const int key = jj < 257 ? t - 128 + jj : SEQ + (jj - 257);
            if (jj < 257 && (key < 0 || key >= SEQ)) continue;
            float s = 0.f;
#pragma unroll
            for (int c8 = 0; c8 < 8; ++c8) { float kf[8]; unpack8(*(const v4u*)(kp + (size_t)key * 128 + c8 * 8), kf);
#pragma unroll
                for (int i = 0; i < 8; ++i) s += qv[8 * c8 + i] * kf[i]; }
            if (s > m) { const float a = exp2f(m - s); l *= a;
#pragma unroll
                for (int e = 0; e < 64; ++e) o[e] *= a;
                m = s; }
            const float p = exp2f(s - m); l += p;
#pragma unroll
            for (int c8 = 0; c8 < 8; ++c8) { float vf[8]; unpack8(*(const v4u*)(vp + (size_t)key * 128 + c8 * 8), vf);
#pragma unroll
                for (int i = 0; i < 8; ++i) o[8 * c8 + i] += p * vf[i]; }
        }
        const float inv = 1.0f / l; bf16* yp = F.Y + (size_t)row * DM + 512 + h * 64;
#pragma unroll
        for (int c8 = 0; c8 < 8; ++c8) { v4u w; w.x = cvtpk(o[8 * c8] * inv, o[8 * c8 + 1] * inv); w.y = cvtpk(o[8 * c8 + 2] * inv, o[8 * c8 + 3] * inv); w.z = cvtpk(o[8 * c8 + 4] * inv, o[8 * c8 + 5] * inv); w.w = cvtpk(o[8 * c8 + 6] * inv, o[8 * c8 + 7] * inv);
            *(v4u*)(yp + 8 * c8) = w; }
    }
}

#ifndef ATT_PP
#define ATT_PP 3
#endif
constexpr size_t WIN_VT_OFF = 16u << 20;
__device__ __forceinline__ void vt_item(const unsigned char* src, int rstride, unsigned char* drow0, int tile, int dg, int half) {
        unsigned outw[4][8];
#pragma unroll
        for (int i8 = 0; i8 < 8; ++i8) { const int kg = 8 * half + i8;
            const unsigned w0 = *(const unsigned*)(src + (size_t)(4 * kg + 0) * rstride), w1 = *(const unsigned*)(src + (size_t)(4 * kg + 1) * rstride), w2 = *(const unsigned*)(src + (size_t)(4 * kg + 2) * rstride), w3 = *(const unsigned*)(src + (size_t)(4 * kg + 3) * rstride);
            const unsigned a01 = __builtin_amdgcn_perm(w1, w0, 0x05010400u), c01 = __builtin_amdgcn_perm(w1, w0, 0x07030602u);
            const unsigned a23 = __builtin_amdgcn_perm(w3, w2, 0x05010400u), c23 = __builtin_amdgcn_perm(w3, w2, 0x07030602u);
            const int slot = ((i8 >> 1) & 3) + 4 * (i8 & 1);
            outw[0][slot] = __builtin_amdgcn_perm(a23, a01, 0x05040100u); outw[1][slot] = __builtin_amdgcn_perm(a23, a01, 0x07060302u);
            outw[2][slot] = __builtin_amdgcn_perm(c23, c01, 0x05040100u); outw[3][slot] = __builtin_amdgcn_perm(c23, c01, 0x07060302u); }
#pragma unroll
        for (int i = 0; i < 4; ++i) { unsigned char* dst = drow0 + (size_t)i * KVLEN + tile * 64 + 16 * half;
            *(v4u*)dst = (v4u){outw[i][0], outw[i][1], outw[i][2], outw[i][3]}; *(v4u*)(dst + 32) = (v4u){outw[i][4], outw[i][5], outw[i][6], outw[i][7]}; }
}
__device__ __forceinline__ void p3_vt_pass(Frame& F) {
    const unsigned char* V8 = (const unsigned char*)F.VA; unsigned char* VT8 = (unsigned char*)F.XG;
    const unsigned char* VB8 = (const unsigned char*)F.VB; unsigned char* VBT8 = (unsigned char*)F.XG + WIN_VT_OFF;
    const int gw = F.vcu * NWAVES + F.wave, NGW = F.G * NWAVES, dg = F.lane & 31, half = F.lane >> 5;
    constexpr int NTL = KVLEN / 64;
    for (int it = gw; it < 10 * NTL; it += NGW) {
        if (it < 8 * NTL) { const int bh = it / NTL, tile = it % NTL, b = bh >> 2, h = bh & 3;
            vt_item(V8 + ((size_t)(b * KVLEN + tile * 64)) * 512 + h * 128 + 4 * dg, 512, VT8 + ((size_t)(bh * 128 + 4 * dg)) * KVLEN, tile, dg, half); }
        else { const int b = (it - 8 * NTL) / NTL, tile = it % NTL;
            vt_item(VB8 + ((size_t)(b * KVLEN + tile * 64)) * 128 + 4 * dg, 128, VBT8 + ((size_t)(b * 128 + 4 * dg)) * KVLEN, tile, dg, half); }
    }
}
__device__ __forceinline__ void diff_unit(Frame& F, int b, int h, int qb, float lam) {
    using namespace at2;
    const int wid = F.wave, lane = F.lane, r32 = lane & 31, hi = lane >> 5, qblk = wid >> 1, comp = wid & 1;
    const int row0 = b * SEQ + qb * 128 + qblk * 32;
    UnitArgs8 a; a.Q = (const unsigned char*)F.QA + (size_t)row0 * 512 + h * 128 + comp * 64;
    a.K = (const unsigned char*)F.KA + (size_t)(b * KVLEN) * 512 + h * 128; a.VT = (const unsigned char*)F.XG + (size_t)((b * 4 + h) * 128) * KVLEN; a.comp = comp; a.ldk = 512; a.vdoff = 0; a.q0 = 0; a.ks = 0;
    f32x16 o[4]; o[0] = f32x16{}; o[1] = f32x16{}; o[2] = f32x16{}; o[3] = f32x16{};
    float m; f32x16 ol = f32x16{};
    AT_LAS char* lds = (AT_LAS char*)F.lds;
    attn_tiles_f8<true>(a, lds, F.tid, wid, lane, o, ol, m);
    float rli[16];
#pragma unroll
    for (int r = 0; r < 16; ++r) rli[r] = __builtin_amdgcn_rcpf(ol[r]);
    __syncthreads();
    AT_LAS float* XD = (AT_LAS float*)lds + qblk * 32 * XROW;
    if (comp == 1) {
#pragma unroll
        for (int r = 0; r < 16; ++r)
#pragma unroll
            for (int d0 = 0; d0 < 4; ++d0) XD[crow(r, hi) * XROW + d0 * 32 + r32] = lam * (o[d0][r] * rli[r]); }
    __syncthreads();
    if (comp == 0) {
#pragma unroll
        for (int r = 0; r < 16; ++r)
#pragma unroll
            for (int d0 = 0; d0 < 4; ++d0) { const int idx = crow(r, hi) * XROW + d0 * 32 + r32; XD[idx] = o[d0][r] * rli[r] - XD[idx]; }
        asm volatile("s_waitcnt lgkmcnt(0)" ::: "memory");
        const int row = lane >> 1, half = lane & 1;
        f32x4 v[16]; float ss = 0.f;
#pragma unroll
        for (int i = 0; i < 16; ++i) { v[i] = *(const AT_LAS f32x4*)(XD + row * XROW + half * 64 + 4 * i); ss += (v[i].x * v[i].x + v[i].y * v[i].y) + (v[i].z * v[i].z + v[i].w * v[i].w); }
        ss += __shfl_xor(ss, 1);
        const float rs = 0.8f / sqrtf(ss * (1.f / 128.f) + NORM_EPS);
        bf16* yp = F.Y + (size_t)(row0 + row) * DM + h * 128 + half * 64; const float* sg = F.subln_g + half * 64;
#pragma unroll
        for (int c8 = 0; c8 < 8; ++c8) { const f32x4 g0 = *(const f32x4*)(sg + 8 * c8), g1 = *(const f32x4*)(sg + 8 * c8 + 4); const f32x4 x0 = v[2 * c8] * rs * g0, x1 = v[2 * c8 + 1] * rs * g1;
            v4u w; w.x = cvtpk(x0.x, x0.y); w.y = cvtpk(x0.z, x0.w); w.z = cvtpk(x1.x, x1.y); w.w = cvtpk(x1.z, x1.w); *(v4u*)(yp + 8 * c8) = w; }
    }
    __syncthreads();
}
__device__ __forceinline__ void win_unit(Frame& F, int b, int j32) {
    using namespace at2;
    const int wid = F.wave, lane = F.lane, r32 = lane & 31, hi = lane >> 5, h = wid, kv = h >> 2;
    const int t0 = 32 * j32, row0 = b * SEQ + t0;
    UnitArgs8 a; a.Q = (const unsigned char*)F.QB + (size_t)row0 * 512 + h * 64;
    a.K = (const unsigned char*)F.KB + (size_t)(b * KVLEN) * 128; a.VT = (const unsigned char*)F.XG + WIN_VT_OFF + (size_t)(b * 128) * KVLEN; a.comp = kv; a.ldk = 128; a.vdoff = kv * 4096; a.q0 = t0;
    { const int st = t0 - 128; int ks = st < 0 ? 0 : (st & ~63); if (ks > SEQ - 384) ks = SEQ - 384; a.ks = ks; }
    f32x16 o[2]; o[0] = f32x16{}; o[1] = f32x16{};
    float m; f32x16 ol = f32x16{};
    AT_LAS char* lds = (AT_LAS char*)F.lds;
    attn_tiles_f8<false>(a, lds, F.tid, wid, lane, o, ol, m);
    AT_LAS float* li_l = (AT_LAS float*)(lds + AT_WS3_OFF) + wid * 64;
    if (hi == 0) li_l[r32] = __builtin_amdgcn_exp2f(F.sink[h] * LOG2E - m);
    asm volatile("s_waitcnt lgkmcnt(0)" ::: "memory");
    float rli[16];
#pragma unroll
    for (int r = 0; r < 16; ++r) rli[r] = __builtin_amdgcn_rcpf(ol[r] + li_l[crow(r, hi)]);
    __syncthreads();
    AT_LAS float* XD = (AT_LAS float*)lds + wid * 32 * XROWW;
#pragma unroll
    for (int r = 0; r < 16; ++r)
#pragma unroll
        for (int d0 = 0; d0 < 2; ++d0) XD[crow(r, hi) * XROWW + d0 * 32 + r32] = o[d0][r] * rli[r];
    asm volatile("s_waitcnt lgkmcnt(0)" ::: "memory");
    const int row = lane >> 1, half = lane & 1;
    bf16* yp = F.Y + (size_t)(row0 + row) * DM + 512 + h * 64 + half * 32;
#pragma unroll
    for (int c8 = 0; c8 < 4; ++c8) { const f32x4 x0 = *(const AT_LAS f32x4*)(XD + row * XROWW + half * 32 + 8 * c8), x1 = *(const AT_LAS f32x4*)(XD + row * XROWW + half * 32 + 8 * c8 + 4);
        v4u w; w.x = cvtpk(x0.x, x0.y); w.y = cvtpk(x0.z, x0.w); w.z = cvtpk(x1.x, x1.y); w.w = cvtpk(x1.z, x1.w); *(v4u*)(yp + 8 * c8) = w; }
    __syncthreads();
}
__device__ __forceinline__ void p3_attention(Frame& F) {
    const float lam = lam_value(F);
#ifndef NO_DIFF
#pragma unroll 1
    for (int U = F.vcu * 2; U < BATCH * 4 * (SEQ / 128) * RP(F, 3); U += 2 * F.G)
#pragma unroll 1
        for (int i = 0; i < 2; ++i) { const int u = (U + i) % 512; diff_unit(F, u >> 8, (u >> 6) & 3, u & 63, lam); }
#endif
#ifndef NO_WIN
#pragma unroll 1
    for (int W = F.vcu * 2; W < BATCH * (SEQ / 32) * RP(F, 3); W += 2 * F.G)
#pragma unroll 1
        for (int i = 0; i < 2; ++i) { const int w = (W + i) % 512; win_unit(F, w >> 8, w & 255); }
#endif
}

__device__ __forceinline__ unsigned long long wave_max64(unsigned long long k) {
#pragma unroll
    for (int o = 1; o < 64; o <<= 1) { const unsigned lo = __shfl_xor((unsigned)k, o), hi = __shfl_xor((unsigned)(k >> 32), o); const unsigned long long t = ((unsigned long long)hi << 32) | lo; k = t > k ? t : k; }
    return k;
}
__device__ __forceinline__ void p5a_route(Frame& F) {
    const int npass = RP(F, 5);
    LAS unsigned char* WH = F.lds + RING_OFF; LAS unsigned char* WL = WH + 65536;
    LAS int* lcnt = (LAS int*)(F.lds + XTRA_OFF); LAS int* lbase = lcnt + 32; LAS int* le = lcnt + 64; LAS int* lrk = le + 256;
    LAS float* cpart = (LAS float*)(F.lds + XTRA_OFF + 2560);
    LAS float* cvec = cpart + 512;
    LAS float* ssqx = cvec + 32;
    LAS float* pl = (LAS float*)(F.lds + RING_OFF);
    LAS float* gash = (LAS float*)(F.lds + RING_OFF + 16384);
    gu32* gcnt = F.ctl + CW_CNT;
    typedef unsigned u32x2 __attribute__((ext_vector_type(2))); typedef unsigned u32x4 __attribute__((ext_vector_type(4))); typedef short bf16x8 __attribute__((ext_vector_type(8)));
    const bf16* YG = (const bf16*)((const unsigned char*)F.XG + 32 * MiB);
    const int m = F.lane & 15, kg = F.lane >> 4, rb = F.wave & 3, kh = F.wave >> 2;
    for (int cc = blockIdx.x; cc < (NTOK / 64) * npass; cc += F.G) { const int chunk = cc % (NTOK / 64); const bool dry = cc < (NTOK / 64) * (npass - 1);
        const int b = (chunk * 64) >> 13; const float* mv = F.modv + b * 6144;
        __syncthreads();
        if (F.tid < 32) lcnt[F.tid] = 0;
        {
            const int e = F.tid & 31, q = F.tid >> 5; float csum = 0.f;
#pragma unroll 2
            for (int i = 0; i < 8; ++i) { const int kgrp = q + 16 * i, k0 = 8 * kgrp; float w[8];
#pragma unroll
                for (int j = 0; j < 8; ++j) w[j] = F.w_router[(k0 + j) * 32 + e];
                const f32x4 g0 = *(const f32x4*)(F.norm2_g + k0), g1 = *(const f32x4*)(F.norm2_g + k0 + 4), s0 = *(const f32x4*)(mv + 4096 + k0), s1 = *(const f32x4*)(mv + 4096 + k0 + 4);
                const f32x4 h0 = *(const f32x4*)(mv + 3072 + k0), h1 = *(const f32x4*)(mv + 3072 + k0 + 4);
                const f32x4 ga0 = g0 * (s0 + 1.0f), ga1 = g1 * (s1 + 1.0f);
                const float ga[8] = {ga0.x, ga0.y, ga0.z, ga0.w, ga1.x, ga1.y, ga1.z, ga1.w}, sh[8] = {h0.x, h0.y, h0.z, h0.w, h1.x, h1.y, h1.z, h1.w};
                unsigned hp[4], lp[4];
#pragma unroll
                for (int j = 0; j < 4; ++j) { const float a0 = w[2 * j] * ga[2 * j], a1 = w[2 * j + 1] * ga[2 * j + 1]; hp[j] = cvtpk(a0, a1); lp[j] = cvtpk(a0 - bflo(hp[j]), a1 - bfhi(hp[j])); }
#pragma unroll
                for (int j = 0; j < 8; ++j) csum += sh[j] * w[j];
                const int off = e * 2048 + ((kgrp ^ (e & 15)) << 4);
                *(LAS u32x4*)(WH + off) = (u32x4){hp[0], hp[1], hp[2], hp[3]}; *(LAS u32x4*)(WL + off) = (u32x4){lp[0], lp[1], lp[2], lp[3]}; }
            cpart[q * 32 + e] = csum; }
        __syncthreads();
        if (F.tid < 32) { float c = F.b_router[F.tid];
#pragma unroll
            for (int q = 0; q < 16; ++q) c += cpart[q * 32 + F.tid];
            cvec[F.tid] = c; }
        const int r = chunk * 64 + rb * 16 + m; const size_t rowoff = (size_t)r * DM;
        f32x4 acc0 = {0.f, 0.f, 0.f, 0.f}, acc1 = acc0; float ssq = 0.f;
        const int wrow0 = m * 2048, wrow1 = (m + 16) * 2048;
#pragma unroll 4
        for (int s_ = 0; s_ < 16; ++s_) { const int ks = 16 * kh + s_, k0 = 32 * ks + 8 * kg;
            const f32x4 xa = __builtin_nontemporal_load((const f32x4*)(F.x + rowoff + k0)), xb = __builtin_nontemporal_load((const f32x4*)(F.x + rowoff + k0 + 4)); const u32x4 yy = *(const u32x4*)(YG + rowoff + k0);
            const float x1[8] = {xa.x + bflo(yy.x), xa.y + bfhi(yy.x), xa.z + bflo(yy.y), xa.w + bfhi(yy.y), xb.x + bflo(yy.z), xb.y + bfhi(yy.z), xb.z + bflo(yy.w), xb.w + bfhi(yy.w)};
            unsigned hp[4], lp[4];
#pragma unroll
            for (int j = 0; j < 4; ++j) { hp[j] = cvtpk(x1[2 * j], x1[2 * j + 1]); lp[j] = cvtpk(x1[2 * j] - bflo(hp[j]), x1[2 * j + 1] - bfhi(hp[j])); ssq += x1[2 * j] * x1[2 * j] + x1[2 * j + 1] * x1[2 * j + 1]; }
            const u32x4 hv = {hp[0], hp[1], hp[2], hp[3]}, lv = {lp[0], lp[1], lp[2], lp[3]};
            *(u32x4*)((bf16*)F.X1 + rowoff + k0) = hv;
            const int sw = ((4 * ks + kg) ^ m) << 4;
            const bf16x8 bh0 = *(const LAS bf16x8*)(WH + wrow0 + sw), bh1 = *(const LAS bf16x8*)(WH + wrow1 + sw), bl0 = *(const LAS bf16x8*)(WL + wrow0 + sw), bl1 = *(const LAS bf16x8*)(WL + wrow1 + sw);
            const bf16x8 ah = __builtin_bit_cast(bf16x8, hv), al = __builtin_bit_cast(bf16x8, lv);
            acc0 = __builtin_amdgcn_mfma_f32_16x16x32_bf16(ah, bh0, acc0, 0, 0, 0); acc1 = __builtin_amdgcn_mfma_f32_16x16x32_bf16(ah, bh1, acc1, 0, 0, 0);
            acc0 = __builtin_amdgcn_mfma_f32_16x16x32_bf16(ah, bl0, acc0, 0, 0, 0); acc1 = __builtin_amdgcn_mfma_f32_16x16x32_bf16(ah, bl1, acc1, 0, 0, 0);
            acc0 = __builtin_amdgcn_mfma_f32_16x16x32_bf16(al, bh0, acc0, 0, 0, 0); acc1 = __builtin_amdgcn_mfma_f32_16x16x32_bf16(al, bh1, acc1, 0, 0, 0); }
        ssq += __shfl_xor(ssq, 16); ssq += __shfl_xor(ssq, 32);
        __syncthreads();
#pragma unroll
        for (int i = 0; i < 4; ++i) { const int row = rb * 16 + 4 * kg + i; pl[(kh * 64 + row) * 32 + m] = acc0[i]; pl[(kh * 64 + row) * 32 + 16 + m] = acc1[i]; }
        if (kg == 0) ssqx[kh * 64 + rb * 16 + m] = ssq;
        { const int k = 2 * F.tid; const float ga0 = F.norm2_g[k] * (mv[4096 + k] + 1.0f), ga1 = F.norm2_g[k + 1] * (mv[4096 + k + 1] + 1.0f); gash[k] = ga0; gash[k + 1] = ga1; gash[1024 + k] = mv[3072 + k]; gash[1024 + k + 1] = mv[3072 + k + 1]; }
        __syncthreads();
        { const float rstd = 1.0f / sqrtf((ssqx[rb * 16 + m] + ssqx[64 + rb * 16 + m]) * (1.f / DM) + NORM_EPS);
#pragma unroll 4
          for (int s_ = 0; s_ < 16; ++s_) { const int k0 = 32 * (16 * kh + s_) + 8 * kg; const u32x4 hv = *(const u32x4*)((const bf16*)F.X1 + rowoff + k0);
              const f32x4 ga0 = *(const LAS f32x4*)(gash + k0), ga1 = *(const LAS f32x4*)(gash + k0 + 4), sh0 = *(const LAS f32x4*)(gash + 1024 + k0), sh1 = *(const LAS f32x4*)(gash + 1024 + k0 + 4);
              const unsigned o0 = pk4_fp8((bflo(hv.x) * rstd) * ga0.x + sh0.x, (bfhi(hv.x) * rstd) * ga0.y + sh0.y, (bflo(hv.y) * rstd) * ga0.z + sh0.z, (bfhi(hv.y) * rstd) * ga0.w + sh0.w);
              const unsigned o1 = pk4_fp8((bflo(hv.z) * rstd) * ga1.x + sh1.x, (bfhi(hv.z) * rstd) * ga1.y + sh1.y, (bflo(hv.w) * rstd) * ga1.z + sh1.z, (bfhi(hv.w) * rstd) * ga1.w + sh1.w);
              *(u32x2*)((unsigned char*)F.XN + rowoff + k0) = (u32x2){o0, o1}; } }
#pragma unroll
        for (int ii = 0; ii < 2; ++ii) { const int rl = rb * 16 + 4 * kg + 2 * kh + ii;
            const float rs = 1.0f / sqrtf((ssqx[rl] + ssqx[64 + rl]) * (1.f / DM) + NORM_EPS);
            const float v0 = (pl[rl * 32 + m] + pl[(64 + rl) * 32 + m]) * rs + cvec[m], v1 = (pl[rl * 32 + 16 + m] + pl[(64 + rl) * 32 + 16 + m]) * rs + cvec[16 + m];
            unsigned u0 = __float_as_uint(v0), u1 = __float_as_uint(v1); u0 = (u0 & 0x80000000u) ? ~u0 : (u0 | 0x80000000u); u1 = (u1 & 0x80000000u) ? ~u1 : (u1 | 0x80000000u);
            unsigned long long key0 = ((unsigned long long)u0 << 32) | (unsigned)(31 - m), key1 = ((unsigned long long)u1 << 32) | (unsigned)(15 - m);
            int ek[4]; float vk[4];
#pragma unroll
            for (int k = 0; k < 4; ++k) { unsigned long long mx = key0 > key1 ? key0 : key1;
#pragma unroll
                for (int o = 1; o < 16; o <<= 1) { const unsigned lo = __shfl_xor((unsigned)mx, o), hi = __shfl_xor((unsigned)(mx >> 32), o); const unsigned long long t = ((unsigned long long)hi << 32) | lo; mx = t > mx ? t : mx; }
                ek[k] = 31 - (int)(mx & 31u); unsigned uu = (unsigned)(mx >> 32); uu = (uu & 0x80000000u) ? (uu & 0x7fffffffu) : ~uu; vk[k] = __uint_as_float(uu);
                if (ek[k] == m) key0 = 0ull; if (ek[k] == 16 + m) key1 = 0ull; }
            const float p1 = __expf(vk[1] - vk[0]), p2 = __expf(vk[2] - vk[0]), p3 = __expf(vk[3] - vk[0]); const float inv = 1.0f / (1.0f + p1 + p2 + p3);
            if (m < 4 && !dry) { const int k = m; const int ee = k == 0 ? ek[0] : (k == 1 ? ek[1] : (k == 2 ? ek[2] : ek[3])); const float gg = (k == 0 ? 1.0f : (k == 1 ? p1 : (k == 2 ? p2 : p3))) * inv;
                const int rank = __hip_atomic_fetch_add(lcnt + ee, 1, __ATOMIC_RELAXED, __HIP_MEMORY_SCOPE_WORKGROUP);
                le[rl * 4 + k] = ee; lrk[rl * 4 + k] = rank; F.rgate[(size_t)(chunk * 64 + rl) * 4 + k] = gg; }
        }
        __syncthreads();
        if (F.tid < 32 && !dry) lbase[F.tid] = (int)__hip_atomic_fetch_add(gcnt + F.tid, (unsigned)lcnt[F.tid], __ATOMIC_RELAXED, __HIP_MEMORY_SCOPE_AGENT);
        __syncthreads();
        if (F.tid < 256 && !dry) { const int row = chunk * 64 + (F.tid >> 2), k = F.tid & 3; const int ee = le[F.tid]; const int slot = lbase[ee] + lrk[F.tid]; F.re[(size_t)row * 4 + k] = ee; F.rslot[(size_t)row * 4 + k] = slot; F.elist[ee * NTOK + slot] = row; }
        __syncthreads();
    }
}
__device__ __forceinline__ int expert_tables(Frame& F, LAS int* pst, LAS int* pexp) {
    LAS int* npan = pst + 40; LAS int* cntT = pexp + 320;
    if (F.tid < 64) {
        const int e = F.lane & 31; const int cnt = (int)__hip_atomic_load(F.ctl + CW_CNT + e, __ATOMIC_RELAXED, __HIP_MEMORY_SCOPE_AGENT);
        const int np = (cnt + 255) >> 8; int incl = np;
#pragma unroll
        for (int o = 1; o < 32; o <<= 1) { const int t = __shfl_up(incl, o, 32); if (e >= o) incl += t; }
        if (F.lane < 32) { const int st = incl - np; cntT[e] = cnt; pst[e] = st * 256; for (int i = 0; i < np; ++i) pexp[st + i] = e; if (e == 31) { pst[32] = incl * 256; npan[0] = incl; } } }
    __syncthreads();
    return npan[0];
}
__device__ __forceinline__ void p5b_scatter(Frame& F) {
    LAS int* pst = (LAS int*)(F.lds + XTRA_OFF); LAS int* pexp = pst + 64;
    (void)expert_tables(F, pst, pexp);
    const int gw = F.vcu * NWAVES + F.wave, NGW = F.G * NWAVES;
    for (int rr = gw; rr < NTOK * RP(F, 6); rr += NGW) { const int row = rr % NTOK;
        const v4u a = *(const v4u*)(F.XN + (size_t)row * DM + 8 * F.lane), b = *(const v4u*)(F.XN + (size_t)row * DM + 512 + 8 * F.lane);
#pragma unroll
        for (int k = 0; k < 4; ++k) { const int e = F.re[(size_t)row * 4 + k]; const int pos = pst[e] + F.rslot[(size_t)row * 4 + k];
            if (F.lane == 0) F.rpos[(size_t)row * 4 + k] = pos;
            *(v4u*)(F.XG + (size_t)pos * DM + 8 * F.lane) = a; *(v4u*)(F.XG + (size_t)pos * DM + 512 + 8 * F.lane) = b; }
    }
}
__device__ __forceinline__ void p8_final(Frame& F) {
    LAS int* pst = (LAS int*)(F.lds + XTRA_OFF); LAS int* pexp = pst + 64;
    (void)expert_tables(F, pst, pexp);
    const int gw = F.vcu * NWAVES + F.wave, NGW = F.G * NWAVES;
    typedef unsigned u32x2 __attribute__((ext_vector_type(2)));
    for (int pp = gw; pp < (NTOK / 2) * RP(F, 9); pp += NGW) { const int row0 = (pp % (NTOK / 2)) * 2;
        const float* g2 = F.modv + (row0 >> 13) * 6144 + 5120;
        int pos[2][4]; float gt[2][4];
#pragma unroll
        for (int q = 0; q < 2; ++q)
#pragma unroll
            for (int k = 0; k < 4; ++k) { const size_t ix = (size_t)(row0 + q) * 4 + k; pos[q][k] = pst[F.re[ix]] + F.rslot[ix]; gt[q][k] = F.rgate[ix]; }
        f32x4 xv[2][4]; unsigned yv[2][4][4];
#pragma unroll
        for (int q = 0; q < 2; ++q)
#pragma unroll
            for (int j = 0; j < 4; ++j) { const int col = 4 * F.lane + 256 * j; { const u32x2 t_ = *(const u32x2*)((const bf16*)F.X1 + (size_t)(row0 + q) * DM + col); xv[q][j] = (f32x4){bflo(t_.x), bfhi(t_.x), bflo(t_.y), bfhi(t_.y)}; }
#pragma unroll
                for (int k = 0; k < 4; ++k) yv[q][j][k] = *(const unsigned*)((const unsigned char*)F.Y2 + (size_t)pos[q][k] * DM + col); }
#pragma unroll
        for (int q = 0; q < 2; ++q) { float s = 0.f;
#pragma unroll
            for (int j = 0; j < 4; ++j) { const int col = 4 * F.lane + 256 * j; f32x4 a = {0.f, 0.f, 0.f, 0.f};
#pragma unroll
                for (int k = 0; k < 4; ++k) { const unsigned y = yv[q][j][k]; const auto lo2 = __builtin_amdgcn_cvt_pk_f32_fp8((int)y, false), hi2 = __builtin_amdgcn_cvt_pk_f32_fp8((int)y, true); a += (f32x4){lo2[0], lo2[1], hi2[0], hi2[1]} * gt[q][k]; }
                xv[q][j] = xv[q][j] + *(const f32x4*)(g2 + col) * a;
                s += (xv[q][j].x * xv[q][j].x + xv[q][j].y * xv[q][j].y) + (xv[q][j].z * xv[q][j].z + xv[q][j].w * xv[q][j].w); }
            const float rstd = 1.0f / sqrtf(wave_sum(s) * (1.f / DM) + NORM_EPS);
#pragma unroll
            for (int j = 0; j < 4; ++j) { const int col = 4 * F.lane + 256 * j; __builtin_nontemporal_store(xv[q][j] * rstd * *(const f32x4*)(F.final_g + col), (f32x4*)(F.out + (size_t)(row0 + q) * DM + col)); } }
    }
}

#ifndef FAST_GEMM
#define FAST_GEMM 1
#endif
#ifndef FAST_ATTN
#define FAST_ATTN 1
#endif
constexpr int N_PHASES = 10;
struct Args { const float* in[23]; float* out; unsigned char* ws; int ph_lo, ph_hi, use_bar, pad; };
__global__ void __launch_bounds__(NWAVES * 64, 2) mk_fwd(Args args) {
    extern __shared__ __attribute__((aligned(16))) unsigned char lds[];
    Frame F;
    F.lds = (LAS unsigned char*)lds; F.MISC = (volatile LAS unsigned*)(F.lds + MISC_OFF);
    F.tid = threadIdx.x; F.lane = F.tid & 63; F.wave = __builtin_amdgcn_readfirstlane(F.tid >> 6);
    F.probe = args.pad; F.G = gridDim.x; { const int bx = blockIdx.x; F.vcu = (F.G % 8 == 0) ? (bx % 8) * (F.G / 8) + bx / 8 : bx; }
    unsigned char* ws = args.ws;
    F.ctl = (gu32*)(ws + WS_CTL);
    F.x = args.in[0]; F.c = args.in[1]; F.ctx = args.in[2]; F.c_ctx = args.in[3]; F.w_mod = args.in[4]; F.b_mod = args.in[5]; F.norm1_g = args.in[6]; F.w_in = args.in[7];
    F.lq1 = args.in[8]; F.lk1 = args.in[9]; F.lq2 = args.in[10]; F.lk2 = args.in[11]; F.subln_g = args.in[12]; F.sink = args.in[13]; F.w_out = args.in[14]; F.norm2_g = args.in[15];
    F.w_router = args.in[16]; F.b_router = args.in[17]; F.w_gu = args.in[18]; F.b_gu = args.in[19]; F.w_dn = args.in[20]; F.b_dn = args.in[21]; F.final_g = args.in[22];
    F.out = args.out;
    F.modp = (float*)(ws + WS_MODP); F.modv = (float*)(ws + WS_MODV); F.rope = (float*)(ws + WS_ROPE); F.X1 = (float*)(ws + WS_X1);
    F.elist = (int*)(ws + WS_ELIST); F.re = (int*)(ws + WS_ROUTE); F.rslot = F.re + NTOK * 4; F.rgate = (float*)(F.rslot + NTOK * 4); F.rpos = (int*)(F.rgate + NTOK * 4);
    F.Win_t = (bf16*)(ws + WS_WIN); F.Wout_t = (bf16*)(ws + WS_WOUT); F.Wgu_t = (bf16*)(ws + WS_WGU); F.Wdn_t = (bf16*)(ws + WS_WDN);
    F.XN = (bf16*)(ws + WS_XN); F.QA = (bf16*)(ws + WS_QA); F.KA = (bf16*)(ws + WS_KA); F.VA = (bf16*)(ws + WS_VA); F.QB = (bf16*)(ws + WS_QB); F.KB = (bf16*)(ws + WS_KB); F.VB = (bf16*)(ws + WS_VB);
    F.Y = (bf16*)(ws + WS_Y); F.XG = (bf16*)(ws + WS_XG); F.H = (bf16*)(ws + WS_H); F.Y2 = (bf16*)(ws + WS_Y2);
    for (int u = F.tid; u < (LDS_BYTES - LDSCTL_OFF) / 4; u += NWAVES * 64) ((LAS unsigned*)(F.lds + LDSCTL_OFF))[u] = 0u;
    __syncthreads();
#ifdef SPIN_SEAM
#define STAMP(k) do { if ((k) == SPIN_SEAM && blockIdx.x == 0 && F.tid == 0) *(volatile LAS unsigned long long*)(F.lds + XTRA_OFF + 15008) = wall_clock64(); } while (0)
    if (blockIdx.x == 0 && F.tid == 0) { const unsigned long long t_ = wall_clock64(); *(volatile LAS unsigned long long*)(F.lds + XTRA_OFF + 15000) = t_; *(volatile LAS unsigned long long*)(F.lds + XTRA_OFF + 15008) = t_; }
#else
#define STAMP(k) do {} while (0)
#endif
    XcdBarrier bar; bar.bar = (unsigned*)(F.ctl + CW_BAR); bar.x = 0; bar.st = nullptr;
    if (args.use_bar) bar = xcd_barrier_post((unsigned*)(F.ctl + CW_BAR), F.MISC + 8);
    const int lo = args.ph_lo, hi = args.ph_hi;
#ifndef PH_MASK
#define PH_MASK 0x3ff
#endif
#define IN(k) (((PH_MASK >> (k)) & 1) && lo <= (k) && (k) < hi)
#ifndef REP_MASK
#define REP_MASK 0
#endif
#define SEAM(k) do { if (IN(k) && IN((k) + 1)) { if (args.use_bar) { xcd_barrier(bar); if (args.pad & 0x10000) { xcd_barrier(bar); xcd_barrier(bar); } } } else { __syncthreads(); } } while (0)

    if (IN(0)) { p0_prologue(F); } SEAM(0); STAMP(0);
    if (IN(1)) { p1_norm(F); } SEAM(1); STAMP(1);
    if (IN(2)) {
        EpiQKV E{F.QA, F.KA, F.VA, F.QB, F.KB, F.VB, F.rope};
#if FAST_GEMM
        if (F.G == 256 && (int)blockIdx.x >= P2_GEMM_WGS) p0_tail(F);
        else {
        RepOrder S; S.init(NROW, INC, F.G == 256 ? P2_GEMM_WGS : F.G, (int)blockIdx.x); S.rep = RP(F, 2);
        EpiQKVFast EA{F.QA, F.KA, F.VA, F.QB, F.KB, F.VB, F.rope};
#if QKV_FP8
        pg8::Gemm g{F.XN, F.Win_t, NROW, INC, DM / 2};
        pg8::gemm_phase<EpiQKVFast, RepOrder, true, true, false, true>(F.lds + RING_OFF, g, S, EA);
#else
        pg8::Gemm g{F.XN, F.Win_t, NROW, INC, DM};
        pg8::gemm_phase<EpiQKVFast, RepOrder, true, true>(F.lds + RING_OFF, g, S, EA);
#endif
        }
#else
        naive_gemm(F, F.XN, NROW / 128, INC, DM, DenseSel{F.Win_t}, E);
#endif
    } SEAM(2); STAMP(2);
#if FAST_ATTN == 1
    if (IN(3)) { p3_vt_pass(F); if (args.use_bar) xcd_barrier(bar); else __syncthreads(); STAMP(10); p3_attention(F); } SEAM(3); STAMP(3);
#else
    if (IN(3)) { naive_diff_attn(F); __syncthreads(); naive_win_attn(F); } SEAM(3); STAMP(3);
#endif
    if (IN(4)) {
        EpiOut E{F.x, F.modv, (float*)((unsigned char*)F.XG + 32 * MiB)};
#if FAST_GEMM
        pg8::Gemm g{F.Y, F.Wout_t, NTOK, DM, DM}; RepOrder S; S.init(NTOK, DM, F.G, (int)blockIdx.x); S.rep = RP(F, 4);
        EpiAdapt<EpiOut, 0> EA{E};
        pg8::gemm_phase<EpiAdapt<EpiOut, 0>, RepOrder, true, true>(F.lds + RING_OFF, g, S, EA);
#else
        naive_gemm(F, F.Y, NTOK / 128, DM, DM, DenseSel{F.Wout_t}, E);
#endif
    } SEAM(4); STAMP(4);
    if (IN(5)) { p5a_route(F); } SEAM(5); STAMP(5);
    if (IN(7)) {
        LAS int* pst = (LAS int*)(F.lds + XTRA_OFF); LAS int* pexp = pst + 64; LAS int* cntT = pexp + 320; LAS int* tokT = (LAS int*)(F.lds + XTRA_OFF + 2048);
        const int NP = expert_tables(F, pst, pexp);
        EpiGU E{(unsigned char*)F.H, F.b_gu};
        GroupedOrder S{GUW / 256, NP, F.G, (int)blockIdx.x, pexp, RP(F, 7), tokT};
        { const int R = S.rounds();
          GroupedOrder S1 = S; S1.rep = 1; const int r = F.tid & 255; int tv[5];
#pragma unroll
          for (int q = 0; q < 5; ++q) { const int i = 2 * q + (F.tid >> 8); pg8::Unit u; tv[q] = -1;
              if (i < R && S1.next(i, u)) { const int e = pexp[u.pm], sl = u.pm * 256 - pst[e] + r; tv[q] = sl < cntT[e] ? F.elist[e * NTOK + sl] : 0; } }
#pragma unroll
          for (int q = 0; q < 5; ++q) { const int i = 2 * q + (F.tid >> 8); if (tv[q] >= 0) tokT[i * 256 + r] = tv[q]; }
          __syncthreads(); }
#if FAST_GEMM
        pg8::Gemm g{F.XN, F.Wgu_t, NP * 256, GUW, DM / 2};
        EpiAdapt<EpiGU, GUW / 256> EA{E};
        pg8::gemm_phase<EpiAdapt<EpiGU, GUW / 256>, GroupedOrder, true, true, true, true>(F.lds + RING_OFF, g, S, EA);
#else
#error "the naive GEMM path has no gather"
#endif
    } SEAM(7); STAMP(7);
    if (IN(8)) {
        LAS int* pst = (LAS int*)(F.lds + XTRA_OFF); LAS int* pexp = pst + 64;
        const int NP = expert_tables(F, pst, pexp);
        EpiDN E{F.Y2, F.b_dn};
#if FAST_GEMM
        pg8::Gemm g{F.H, F.Wdn_t, NP * 256, DM, DM / 2}; GroupedOrder S{DM / 256, NP, F.G, (int)blockIdx.x, pexp, RP(F, 8), nullptr};
        EpiAdaptP<EpiDN, DM / 256> EA{E};
        pg8::gemm_phase<EpiAdaptP<EpiDN, DM / 256>, GroupedOrder, true, true, false, true>(F.lds + RING_OFF, g, S, EA);
#else
        naive_gemm(F, F.H, NP * 2, DM, DM, GroupSel{F.Wdn_t, pexp, DM, DM}, E);
#endif
    } SEAM(8); STAMP(8);
    if (IN(9)) { p8_final(F); }
#ifdef SPIN_SEAM
    if (blockIdx.x == 0 && F.tid == 0) { const unsigned long long t0_ = *(volatile LAS unsigned long long*)(F.lds + XTRA_OFF + 15000), tk_ = *(volatile LAS unsigned long long*)(F.lds + XTRA_OFF + 15008);
        const unsigned long long te_ = wall_clock64(); while (wall_clock64() - te_ < tk_ - t0_) __builtin_amdgcn_s_sleep(8); }
#endif
#undef STAMP
#undef IN
#undef SEAM
}

#ifndef N_LAUNCH_MODE
#define N_LAUNCH_MODE 0
#endif
extern "C" void kernel_launch(void* const* d_in, const int* in_sizes, int n_in, void* d_out, int out_size, void* d_ws, size_t ws_size, hipStream_t stream) {
    static int grid = 0;
    if (grid == 0) {
        if (n_in != 23 || in_sizes[0] != NTOK * DM || out_size != NTOK * DM || ws_size < WS_END) { fprintf(stderr, "kernel_launch: unexpected shapes (n_in %d, in0 %d, out %d, ws %zu); nothing launched\n", n_in, n_in > 0 ? in_sizes[0] : -1, out_size, ws_size); grid = -1; return; }
        int dev = 0, cus = 0, per_cu = 0;
        if (hipGetDevice(&dev) != hipSuccess || hipDeviceGetAttribute(&cus, hipDeviceAttributeMultiprocessorCount, dev) != hipSuccess) { grid = -1; return; }
        if (hipFuncSetAttribute((const void*)mk_fwd, hipFuncAttributeMaxDynamicSharedMemorySize, LDS_BYTES) != hipSuccess) { fprintf(stderr, "kernel_launch: hipFuncSetAttribute failed\n"); grid = -1; return; }
        if (hipOccupancyMaxActiveBlocksPerMultiprocessor(&per_cu, (const void*)mk_fwd, NWAVES * 64, LDS_BYTES) != hipSuccess || per_cu < 1) fprintf(stderr, "kernel_launch: note: occupancy query reports %d\n", per_cu);
        (void)hipGetLastError();
        grid = cus;
    }
    if (grid < 0) return;
    if (hipMemsetAsync((char*)d_ws + WS_CTL, 0, CTL_ZERO_BYTES, stream) != hipSuccess) { fprintf(stderr, "kernel_launch: memset failed\n"); return; }
    Args a{};
    for (int i = 0; i < 23; ++i) a.in[i] = (const float*)d_in[i];
    a.out = (float*)d_out; a.ws = (unsigned char*)d_ws; a.pad = REP_MASK;
#if N_LAUNCH_MODE == 0
    a.ph_lo = 0; a.ph_hi = N_PHASES; a.use_bar = 1;
    hipLaunchKernelGGL(mk_fwd, dim3(grid), dim3(NWAVES * 64), LDS_BYTES, stream, a);
#else
    for (int p = 0; p < N_PHASES; ++p) { a.ph_lo = p; a.ph_hi = p + 1; a.use_bar = 0; hipLaunchKernelGGL(mk_fwd, dim3(grid), dim3(NWAVES * 64), LDS_BYTES, stream, a); }
#endif
}
```

```cpp
#include <hip/hip_runtime.h>
#include <cstdio>
#include <cstdint>
namespace pg8 {
#define PG8_LAS __attribute__((address_space(3)))
typedef unsigned short bf16_t;
typedef short bf16x8 __attribute__((ext_vector_type(8)));
typedef float f32x4 __attribute__((ext_vector_type(4)));
typedef unsigned u32x4 __attribute__((ext_vector_type(4)));
constexpr int BM = 256, BK = 64, HALF = 128, HTB = HALF * BK * 2  , STAGE_BYTES = 8 * HTB, NXCD = 8, WGM = 8;

__host__ __device__ __forceinline__ int lds_byte(int r, int c) { const int st = (r >> 4) * 2 + (c >> 5), rr = r & 15, cc = c & 31, ob = rr * 64 + cc * 2; return st * 1024 + (ob ^ (((ob >> 9) & 1) << 5)); }
__host__ __device__ __forceinline__ void stage_rc(int b, int& R, int& C) { const int st = b / 1024, sb = b % 1024, swz = sb ^ (((sb >> 9) & 1) << 5); R = (st >> 1) * 16 + swz / 64; C = (st & 1) * 32 + (swz % 64) / 2; }
__host__ __device__ __forceinline__ int perm32(int rho) { const int n = rho >> 4, i = rho & 15; return 8 * (i >> 2) + 4 * n + (i & 3); }

struct Unit { int pm, pn; };
struct Gemm { const bf16_t* A; const bf16_t* Bt; int M, N, K; };

struct StaticOrder {
    int nM, nN, nwg, G, c;
    __host__ __device__ void init(int M, int N, int G_, int c_) { nM = M / BM; nN = N / BM; nwg = nM * nN; G = G_; c = c_; }
    __host__ __device__ bool next(int i, Unit& u) const {
        const long L = (long)i * G + c; if (L >= nwg) return false;
        int wgid = (int)L; { const int q = nwg / NXCD, r = nwg % NXCD, xcd = wgid % NXCD, off = wgid / NXCD; wgid = (xcd < r ? xcd * (q + 1) : r * (q + 1) + (xcd - r) * q) + off; }
        const int nig = WGM * nN, gid = wgid / nig, fm = gid * WGM, gsz = (nM - fm) < WGM ? (nM - fm) : WGM;
        u.pm = fm + ((wgid % nig) % gsz); u.pn = (wgid % nig) / gsz; return true;
    }
    __device__ __forceinline__ void a_ready(const Unit&) const {}
    __device__ __forceinline__ void done(const Unit&) const {}
};

__device__ __forceinline__ unsigned cvt_pk_bf16(float lo, float hi) { unsigned r; asm volatile("v_cvt_pk_bf16_f32 %0, %1, %2" : "=v"(r) : "v"(lo), "v"(hi)); return r; }
typedef float f32x2 __attribute__((ext_vector_type(2)));
typedef int i32x4 __attribute__((ext_vector_type(4))); typedef int i32x8 __attribute__((ext_vector_type(8)));
__device__ __forceinline__ i32x8 cat8(bf16x8 a, bf16x8 b) { const i32x4 x = __builtin_bit_cast(i32x4, a), y = __builtin_bit_cast(i32x4, b); return __builtin_shufflevector(x, y, 0, 1, 2, 3, 4, 5, 6, 7); }
template <class Epi, class Sched, bool ALIGN_EPI = false, bool SP2 = false, bool GATHER = false, bool FP8 = false>
__device__ __forceinline__ void gemm_phase(PG8_LAS unsigned char* lds, const Gemm g, const Sched& S, const Epi& E) {
    const int tid = threadIdx.x, wid = __builtin_amdgcn_readfirstlane(tid >> 6), lane = tid & 63, wr = wid >> 2, wc = wid & 3, fr = lane & 15, fq = lane >> 4;
    const int K = g.K, nt = K / BK;
    unsigned voffA[2], voffB[2]; int RA[2]; unsigned CA2[2];
#pragma unroll
    for (int i = 0; i < 2; ++i) { int R, C; stage_rc(tid * 16 + i * 8192, R, C); const int Rb = Epi::PERM ? ((R & ~31) + perm32(R & 31)) : R;
        voffA[i] = (unsigned)(R * K + C) * 2u; voffB[i] = (unsigned)(Rb * K + C) * 2u; RA[i] = R; CA2[i] = (unsigned)C * 2u; }
    static_assert(!GATHER || SP2, "GATHER is wired into the SP2 loop only");
    unsigned gA[2][2], gN[2][2];
    const size_t kstep = (size_t)(BK * 2);
    const size_t hstep = (size_t)HALF * K * 2;
    const size_t tstep = 2 * hstep;
    const unsigned ldsw = (unsigned)wid * 1024u;
    const int aoff = lds_byte(wr * 64 + fr, fq * 8), boff = lds_byte(wc * 32 + fr, fq * 8);
#define PG8_SA(b, h) (((b) * 2 + (h)) * HTB)
#define PG8_SB(b, h) ((4 + (b) * 2 + (h)) * HTB)
#define PG8_STAGE(bufoff, gbase, voff) do { _Pragma("unroll") for (int _i = 0; _i < 2; ++_i) \
        __builtin_amdgcn_global_load_lds((const unsigned*)((const char*)(gbase) + (voff)[_i]), (PG8_LAS unsigned*)(lds + (bufoff) + ldsw + _i * 8192), 16, 0, 0); } while (0)
#define PG8_STAGEG(bufoff, kbytes, v0, v1) do { \
        __builtin_amdgcn_global_load_lds((const unsigned*)((const char*)g.A + (kbytes) + (v0)), (PG8_LAS unsigned*)(lds + (bufoff) + ldsw), 16, 0, 0); \
        __builtin_amdgcn_global_load_lds((const unsigned*)((const char*)g.A + (kbytes) + (v1)), (PG8_LAS unsigned*)(lds + (bufoff) + ldsw + 8192), 16, 0, 0); } while (0)
#define PG8_GOFF(dst, ui_) do { _Pragma("unroll") for (int h_ = 0; h_ < 2; ++h_) _Pragma("unroll") for (int i_ = 0; i_ < 2; ++i_) dst[h_][i_] = (unsigned)S.tok((ui_), h_ * HALF + RA[i_]) * (unsigned)(K * 2) + CA2[i_]; } while (0)
#define PG8_LDA(dst, b, h) do { _Pragma("unroll") for (int m = 0; m < 4; ++m) _Pragma("unroll") for (int k = 0; k < 2; ++k) dst[m][k] = *(const PG8_LAS bf16x8*)(lds + PG8_SA(b, h) + aoff + m * 2048 + k * 1024); } while (0)
#define PG8_LDB(dst, b, h) do { _Pragma("unroll") for (int n = 0; n < 2; ++n) _Pragma("unroll") for (int k = 0; k < 2; ++k) dst[n][k] = *(const PG8_LAS bf16x8*)(lds + PG8_SB(b, h) + boff + n * 2048 + k * 1024); } while (0)
#define PG8_MMA(ai, bj, At, Bt) do { __builtin_amdgcn_s_setprio(1); _Pragma("unroll") for (int m = 0; m < 4; ++m) _Pragma("unroll") for (int n = 0; n < 2; ++n) { \
        if constexpr (FP8) { const i32x8 a8_ = cat8(Bt[n][0], Bt[n][1]), b8_ = cat8(At[m][0], At[m][1]); \
            asm volatile("v_mfma_scale_f32_16x16x128_f8f6f4 %0, %1, %2, %0, %3, %4 op_sel_hi:[0,0,0]" : "+v"(acc[ai][bj][m][n]) : "v"(a8_), "v"(b8_), "v"(sc_w8), "v"(sc_a8)); } \
        else { _Pragma("unroll") for (int k = 0; k < 2; ++k) acc[ai][bj][m][n] = __builtin_amdgcn_mfma_f32_16x16x32_bf16(Bt[n][k], At[m][k], acc[ai][bj][m][n], 0, 0, 0); } } \
        __builtin_amdgcn_s_setprio(0); } while (0)
#define PG8_WAIT_V(n) asm volatile("s_waitcnt vmcnt(" #n ")" ::: "memory")
#define PG8_WAIT_L(n) asm volatile("s_waitcnt lgkmcnt(" #n ")" ::: "memory")
#define PG8_BAR __builtin_amdgcn_s_barrier()
#define PG8_SCHED __builtin_amdgcn_sched_barrier(0)
    int sc_w8 = 0x7A7A7A7A, sc_a8 = 0x7F7F7F7F;
    asm volatile("" : "+v"(sc_w8), "+v"(sc_a8));
    Unit cur, nxt; int ui = 0;
    if (!S.next(0, cur)) return;
    f32x4 acc[2][2][4][2];
#pragma unroll
    for (int a = 0; a < 2; ++a)
#pragma unroll
        for (int b = 0; b < 2; ++b)
#pragma unroll
            for (int m = 0; m < 4; ++m)
#pragma unroll
                for (int n = 0; n < 2; ++n) acc[a][b][m][n] = (f32x4){0.f, 0.f, 0.f, 0.f};
    bf16x8 At[4][2], B0[2][2], B1[2][2];
    const char* cA = (const char*)g.A + (size_t)cur.pm * tstep; const char* cB = (const char*)g.Bt + (size_t)cur.pn * tstep;
    S.a_ready(cur);
    if constexpr (SP2) {
        if constexpr (GATHER) { PG8_GOFF(gA, 0); }
        PG8_STAGE(PG8_SB(0, 0), cB, voffB); PG8_STAGE(PG8_SB(0, 1), cB + hstep, voffB);
        if constexpr (GATHER) { PG8_STAGEG(PG8_SA(0, 0), 0, gA[0][0], gA[0][1]); PG8_STAGEG(PG8_SA(0, 1), 0, gA[1][0], gA[1][1]); } else { PG8_STAGE(PG8_SA(0, 0), cA, voffA); PG8_STAGE(PG8_SA(0, 1), cA + hstep, voffA); }
        if (wr == 1) PG8_BAR;
        PG8_WAIT_V(2); PG8_BAR;
        PG8_STAGE(PG8_SB(1, 0), cB + kstep, voffB); if constexpr (GATHER) { PG8_STAGEG(PG8_SA(1, 0), kstep, gA[0][0], gA[0][1]); } else { PG8_STAGE(PG8_SA(1, 0), cA + kstep, voffA); } PG8_STAGE(PG8_SB(1, 1), cB + hstep + kstep, voffB);
        PG8_WAIT_V(6); PG8_BAR;
    } else {
        PG8_STAGE(PG8_SB(0, 0), cB, voffB); PG8_STAGE(PG8_SA(0, 0), cA, voffA); PG8_STAGE(PG8_SB(0, 1), cB + hstep, voffB); PG8_STAGE(PG8_SA(0, 1), cA + hstep, voffA);
        if (wr == 1) PG8_BAR;
        PG8_WAIT_V(4); PG8_BAR;
        PG8_STAGE(PG8_SB(1, 0), cB + kstep, voffB); PG8_STAGE(PG8_SA(1, 0), cA + kstep, voffA); PG8_STAGE(PG8_SB(1, 1), cB + hstep + kstep, voffB);
        PG8_WAIT_V(6); PG8_BAR;
    }
    for (;;) {
        const bool has_next = S.next(ui + 1, nxt);
        const char* nA = has_next ? (const char*)g.A + (size_t)nxt.pm * tstep : cA; const char* nB = has_next ? (const char*)g.Bt + (size_t)nxt.pn * tstep : cB;
        if constexpr (GATHER) { if (has_next) { PG8_GOFF(gN, ui + 1); } else { _Pragma("unroll") for (int h_ = 0; h_ < 2; ++h_) _Pragma("unroll") for (int i_ = 0; i_ < 2; ++i_) gN[h_][i_] = gA[h_][i_]; } }
#pragma unroll 1
        for (int t = 0; t < nt; t += 2) {
            const bool last = (t == nt - 2);
            const char* a1 = cA + (size_t)(t + 1) * kstep;
            const char* a2 = last ? nA : cA + (size_t)(t + 2) * kstep; const char* b2 = last ? nB : cB + (size_t)(t + 2) * kstep;
            const char* a3 = a2 + kstep; const char* b3 = b2 + kstep;
            if (last && has_next) S.a_ready(nxt);
            if constexpr (SP2) {
            const size_t k1_ = (size_t)(t + 1) * kstep, k2_ = last ? (size_t)0 : (size_t)(t + 2) * kstep;
            const unsigned s00_ = last ? gN[0][0] : gA[0][0], s01_ = last ? gN[0][1] : gA[0][1], s10_ = last ? gN[1][0] : gA[1][0], s11_ = last ? gN[1][1] : gA[1][1];
            PG8_LDB(B0, 0, 0); PG8_LDB(B1, 0, 1); PG8_SCHED; PG8_LDA(At, 0, 0); if constexpr (GATHER) { PG8_STAGEG(PG8_SA(1, 1), k1_, gA[1][0], gA[1][1]); } else { PG8_STAGE(PG8_SA(1, 1), a1 + hstep, voffA); }
            PG8_WAIT_V(8); PG8_WAIT_L(0); PG8_BAR; PG8_MMA(0, 0, At, B0); PG8_MMA(0, 1, At, B1); PG8_BAR; PG8_SCHED;
            PG8_LDA(At, 0, 1); PG8_STAGE(PG8_SB(0, 0), b2, voffB); PG8_STAGE(PG8_SB(0, 1), b2 + hstep, voffB); if constexpr (GATHER) { PG8_STAGEG(PG8_SA(0, 0), k2_, s00_, s01_); } else { PG8_STAGE(PG8_SA(0, 0), a2, voffA); }
            PG8_WAIT_V(8); PG8_WAIT_L(0); PG8_BAR; PG8_MMA(1, 0, At, B0); PG8_MMA(1, 1, At, B1); PG8_BAR; PG8_SCHED;
            PG8_LDB(B0, 1, 0); PG8_LDB(B1, 1, 1); PG8_SCHED; PG8_LDA(At, 1, 0); if constexpr (GATHER) { PG8_STAGEG(PG8_SA(0, 1), k2_, s10_, s11_); } else { PG8_STAGE(PG8_SA(0, 1), a2 + hstep, voffA); }
            PG8_WAIT_V(8); PG8_WAIT_L(0); PG8_BAR; PG8_MMA(0, 0, At, B0); PG8_MMA(0, 1, At, B1); PG8_BAR; PG8_SCHED;
            PG8_LDA(At, 1, 1); PG8_STAGE(PG8_SB(1, 0), b3, voffB); PG8_STAGE(PG8_SB(1, 1), b3 + hstep, voffB); if constexpr (GATHER) { PG8_STAGEG(PG8_SA(1, 0), k2_ + kstep, s00_, s01_); } else { PG8_STAGE(PG8_SA(1, 0), a3, voffA); }
            PG8_WAIT_V(8); PG8_WAIT_L(0); PG8_BAR; PG8_MMA(1, 0, At, B0); PG8_MMA(1, 1, At, B1); PG8_BAR; PG8_SCHED;
            } else {
            PG8_LDB(B0, 0, 0); PG8_SCHED; PG8_LDA(At, 0, 0); PG8_STAGE(PG8_SA(1, 1), a1 + hstep, voffA);
            PG8_WAIT_L(8); PG8_BAR; PG8_WAIT_L(0); PG8_MMA(0, 0, At, B0); PG8_BAR; PG8_SCHED;
            PG8_LDB(B1, 0, 1); PG8_STAGE(PG8_SB(0, 0), b2, voffB);
            PG8_BAR; PG8_WAIT_L(0); PG8_MMA(0, 1, At, B1); PG8_BAR;
            PG8_LDA(At, 0, 1); PG8_STAGE(PG8_SA(0, 0), a2, voffA);
            PG8_BAR; PG8_WAIT_L(0); PG8_MMA(1, 0, At, B0); PG8_BAR; PG8_SCHED;
            PG8_STAGE(PG8_SB(0, 1), b2 + hstep, voffB);
            PG8_WAIT_V(6); PG8_BAR; PG8_MMA(1, 1, At, B1); PG8_BAR;
            PG8_LDB(B0, 1, 0); PG8_SCHED; PG8_LDA(At, 1, 0); PG8_STAGE(PG8_SA(0, 1), a2 + hstep, voffA);
            PG8_WAIT_L(8); PG8_BAR; PG8_WAIT_L(0); PG8_MMA(0, 0, At, B0); PG8_BAR; PG8_SCHED;
            PG8_LDB(B1, 1, 1); PG8_STAGE(PG8_SB(1, 0), b3, voffB);
            PG8_BAR; PG8_WAIT_L(0); PG8_MMA(0, 1, At, B1); PG8_BAR;
            PG8_LDA(At, 1, 1); PG8_STAGE(PG8_SA(1, 0), a3, voffA);
            PG8_BAR; PG8_WAIT_L(0); PG8_MMA(1, 0, At, B0); PG8_BAR; PG8_SCHED;
            PG8_STAGE(PG8_SB(1, 1), b3 + hstep, voffB);
            PG8_WAIT_V(6); PG8_BAR; PG8_MMA(1, 1, At, B1); PG8_BAR;
            }
        }
        if constexpr (FP8) { asm volatile("s_nop 15\n\ts_nop 15" ::: "memory"); }
        if constexpr (ALIGN_EPI) { if (wr == 0) PG8_BAR; }
        if constexpr (!Epi::AFTER_DRAIN) { E(acc, cur, wr, wc, fr, fq); S.done(cur); }
        if (!has_next) break;
#pragma unroll
        for (int a = 0; a < 2; ++a)
#pragma unroll
            for (int b = 0; b < 2; ++b)
#pragma unroll
                for (int m = 0; m < 4; ++m)
#pragma unroll
                    for (int n = 0; n < 2; ++n) acc[a][b][m][n] = (f32x4){0.f, 0.f, 0.f, 0.f};
        cur = nxt; cA = nA; cB = nB; ++ui;
        if constexpr (GATHER) { _Pragma("unroll") for (int h_ = 0; h_ < 2; ++h_) _Pragma("unroll") for (int i_ = 0; i_ < 2; ++i_) gA[h_][i_] = gN[h_][i_]; }
        if constexpr (ALIGN_EPI) { if (wr == 1) PG8_BAR; }
    }
    PG8_WAIT_V(0);
    if constexpr (!ALIGN_EPI) { if (wr == 0) PG8_BAR; }
    PG8_BAR;
    if constexpr (Epi::AFTER_DRAIN) { E.fused(acc, cur, wr, wc, fr, fq, lds, wid, lane); S.done(cur); }
#undef PG8_SA
#undef PG8_SB
#undef PG8_STAGE
#undef PG8_STAGEG
#undef PG8_GOFF
#undef PG8_LDA
#undef PG8_LDB
#undef PG8_MMA
#undef PG8_WAIT_V
#undef PG8_WAIT_L
#undef PG8_BAR
#undef PG8_SCHED
}
}
#define GAS __attribute__((address_space(1)))
#define LAS __attribute__((address_space(3)))
typedef unsigned short bf16;
typedef unsigned v4u __attribute__((ext_vector_type(4)));
typedef float f32x4 __attribute__((ext_vector_type(4)));
typedef short bf16x8 __attribute__((ext_vector_type(8)));
typedef GAS unsigned gu32;
typedef GAS unsigned long long gu64;
#define RLX_AGENT __ATOMIC_RELAXED, __HIP_MEMORY_SCOPE_AGENT
#define LDS_WAIT() asm volatile("s_waitcnt lgkmcnt(0)" ::: "memory")
#define VM_WAIT() asm volatile("s_waitcnt vmcnt(0)" ::: "memory")
__device__ __forceinline__ unsigned long long rt() { return __builtin_amdgcn_s_memrealtime(); }
__device__ __forceinline__ unsigned f2bf(float f) { unsigned u = __builtin_bit_cast(unsigned, f); return (u + 0x7fffu + ((u >> 16) & 1u)) >> 16; }
__device__ __forceinline__ unsigned pk2(float lo, float hi) { return f2bf(lo) | (f2bf(hi) << 16); }
#define XB_TMO      128
#define XB_XCNT(j)  (256  + 64 * (j))
#define XB_XSUB(j)  (1280 + 64 * (j))
#define XB_XGEN(j)  (2304 + 64 * (j))
#define XB_TOP      3328
#define XB_TOPGEN   3392
#define XCD_BAR_WORDS 3456
#define XB_SPIN_CAP (1u << 22)

__device__ __forceinline__ unsigned xb_ld(unsigned* p)              { return __hip_atomic_load(p, __ATOMIC_RELAXED, __HIP_MEMORY_SCOPE_AGENT); }
__device__ __forceinline__ unsigned xb_add(unsigned* p, unsigned v) { return __hip_atomic_fetch_add(p, v, __ATOMIC_RELAXED, __HIP_MEMORY_SCOPE_AGENT); }
__device__ __forceinline__ unsigned xb_xcc_id() { return (unsigned)__builtin_amdgcn_s_getreg((3 << 11) | 20) & 0xFu; }
#define XB_SPIN(cond, bar) do { unsigned _sp = 0; while (cond) { __builtin_amdgcn_s_sleep(1); \
    if ((++_sp & 255u) == 0u) { if (xb_ld(&(bar)[XB_TMO])) break; if (_sp > XB_SPIN_CAP) { atomicAdd(&(bar)[XB_TMO], 1u); break; } } } } while (0)

struct XcdBarrier {
    unsigned* bar; unsigned x;
    volatile LAS unsigned* st;
};

__device__ __forceinline__ XcdBarrier xcd_barrier_post(unsigned* bar, volatile LAS unsigned* st) {
    XcdBarrier b; b.bar = bar; b.x = xb_xcc_id(); b.st = st;
    if (threadIdx.x == 0) (void)xb_add(&bar[XB_XCNT(b.x)], 1u);
    return b;
}
__device__ __forceinline__ void xcd_barrier_complete(unsigned* bar, unsigned x, unsigned& nloc, unsigned& nx) {
    const unsigned G = gridDim.x * gridDim.y * gridDim.z;
    unsigned sum, cnt, mine, sp = 0u;
    for (;;) {
        sum = 0u; cnt = 0u; mine = 0u;
#pragma unroll
        for (unsigned j = 0; j < 16; ++j) { const unsigned c = xb_ld(&bar[XB_XCNT(j)]); sum += c; cnt += (c > 0u) ? 1u : 0u; mine = (j == x) ? c : mine; }
        if (sum == G) break;
        __builtin_amdgcn_s_sleep(1);
        if ((++sp & 255u) == 0u) { if (xb_ld(&bar[XB_TMO])) break; if (sp > XB_SPIN_CAP) { atomicAdd(&bar[XB_TMO], 1u); break; } }
    }
    nloc = mine > 0u ? mine : 1u; nx = cnt > 0u ? cnt : 1u;
}

__device__ __forceinline__ void xcd_barrier(const XcdBarrier& b) {
    asm volatile("s_waitcnt vmcnt(0)" ::: "memory");
    __syncthreads();
    if (threadIdx.x == 0) {
        unsigned* bar = b.bar;
        __builtin_amdgcn_s_waitcnt(0);
        unsigned nloc = b.st[0], nx = b.st[1];
        if (nloc == 0u) { xcd_barrier_complete(bar, b.x, nloc, nx); b.st[0] = nloc; b.st[1] = nx; }
        const unsigned old = xb_add(&bar[XB_XSUB(b.x)], 1u);
        const unsigned gen = old / nloc;
        if (old + 1u == (gen + 1u) * nloc) {
            __builtin_amdgcn_fence(__ATOMIC_RELEASE, "agent");
            asm volatile("s_waitcnt vmcnt(0)" ::: "memory");
            const unsigned og = xb_add(&bar[XB_TOP], 1u);
            const unsigned tg = og / nx;
            if (og + 1u == (tg + 1u) * nx) xb_add(&bar[XB_TOPGEN], 1u);
            else XB_SPIN(xb_ld(&bar[XB_TOPGEN]) == tg, bar);
            __builtin_amdgcn_fence(__ATOMIC_ACQUIRE, "agent");
            xb_add(&bar[XB_XGEN(b.x)], 1u);
            asm volatile("s_waitcnt vmcnt(0)" ::: "memory");
        } else {
            XB_SPIN(xb_ld(&bar[XB_XGEN(b.x)]) == gen, bar);
            __builtin_amdgcn_fence(__ATOMIC_ACQUIRE, "agent");
            asm volatile("s_waitcnt vmcnt(0)" ::: "memory");
        }
    }
    __syncthreads();
}

constexpr int BATCH = 2, SEQ = 8192, DM = 1024, CTXL = 256;
constexpr int NTOK = BATCH * SEQ, NCTXR = BATCH * CTXL, NROW = NTOK + NCTXR, KVLEN = SEQ + CTXL;
constexpr int INC = 2304, NEXP = 32, TOPK = 4, GUW = 2048;
constexpr int NPAD_MAX = NTOK * TOPK + NEXP * 256;
constexpr float NORM_EPS = 1e-6f, LOG2E = 1.4426950408889634f, QSCALE = 0.125f * 1.4426950408889634f;
constexpr int NWAVES = 8;


namespace at2 {
typedef short bf16x8 __attribute__((ext_vector_type(8)));
typedef short s16x4 __attribute__((ext_vector_type(4)));
typedef float f32x16 __attribute__((ext_vector_type(16)));
typedef unsigned u32x4 __attribute__((ext_vector_type(4)));
constexpr int SHM_V = 16384, SHM_K = 16384, AT_WS_OFF = 73728, AT_WS3_OFF = 98304, XROW = 132, XROWW = 68;
constexpr int SDEPTH = 1;
constexpr float THRL = 8.0f;
#define AT_LAS __attribute__((address_space(3)))
#define KSWZ(row, colB) ((row) * 256 + ((colB) ^ (((row) & 7) << 4)))
#define SBAR() __builtin_amdgcn_sched_barrier(0)
__device__ __forceinline__ int crow(int r, int hi) { return (r & 3) + 8 * (r >> 2) + 4 * hi; }
typedef float f32x2_t __attribute__((ext_vector_type(2))); typedef __bf16 bf16x2_t __attribute__((ext_vector_type(2)));
__device__ __forceinline__ unsigned cvtpk2(float lo, float hi) { f32x2_t v = {lo, hi}; bf16x2_t b = __builtin_convertvector(v, bf16x2_t); return __builtin_bit_cast(unsigned, b); }
__device__ __forceinline__ void partialSM(f32x16& p0, f32x16& p1, float& m_reg, float& alpha) {
  float pmax = p0[0];
#pragma unroll
  for (int r = 1; r < 16; ++r) pmax = fmaxf(pmax, p0[r]);
#pragma unroll
  for (int r = 0; r < 16; ++r) pmax = fmaxf(pmax, p1[r]);
  { auto rr = __builtin_amdgcn_permlane32_swap(__float_as_uint(pmax), __float_as_uint(pmax), false, false); pmax = fmaxf(__uint_as_float(rr[0]), __uint_as_float(rr[1])); }
  float mn;
  if (__builtin_expect(__all(pmax - m_reg <= THRL), 1)) { mn = m_reg; alpha = 1.f; }
  else { mn = fmaxf(m_reg, pmax); alpha = __builtin_amdgcn_exp2f(m_reg - mn); m_reg = mn; }
#pragma unroll
  for (int r = 0; r < 16; ++r) p0[r] = p0[r] - mn;
#pragma unroll
  for (int r = 0; r < 16; ++r) p1[r] = p1[r] - mn;
#pragma unroll
  for (int r = 0; r < 16; ++r) p0[r] = __builtin_amdgcn_exp2f(p0[r]);
}
__device__ __forceinline__ void finishSM(f32x16& p0, f32x16& p1, float alpha, float& l_reg, bf16x8& pa0, bf16x8& pa1, bf16x8& pa2, bf16x8& pa3) {
#pragma unroll
  for (int r = 0; r < 16; ++r) p1[r] = __builtin_amdgcn_exp2f(p1[r]);
  float ps = 0;
#pragma unroll
  for (int r = 0; r < 16; ++r) ps += p0[r];
#pragma unroll
  for (int r = 0; r < 16; ++r) ps += p1[r];
  { auto rr = __builtin_amdgcn_permlane32_swap(__float_as_uint(ps), __float_as_uint(ps), false, false); ps = __uint_as_float(rr[0]) + __uint_as_float(rr[1]); }
  l_reg = l_reg * alpha + ps;
#define PK4(P, BASE, OUT) do { unsigned a0 = cvtpk2(P[BASE + 0], P[BASE + 1]), a1 = cvtpk2(P[BASE + 2], P[BASE + 3]);   \
    unsigned b0 = cvtpk2(P[BASE + 4], P[BASE + 5]), b1 = cvtpk2(P[BASE + 6], P[BASE + 7]);                              \
    auto r0 = __builtin_amdgcn_permlane32_swap(a0, b0, false, false); auto r1 = __builtin_amdgcn_permlane32_swap(a1, b1, false, false); \
    u32x4 w = {r0[0], r1[0], r0[1], r1[1]}; OUT = __builtin_bit_cast(bf16x8, w); } while (0)
  PK4(p0, 0, pa0); PK4(p0, 8, pa1); PK4(p1, 0, pa2); PK4(p1, 8, pa3);
#undef PK4
}
__device__ __forceinline__ void qkt(f32x16& p0, f32x16& p1, const AT_LAS char* Ks, const bf16x8* qr, int r32, int hi) {
  p0 = f32x16{}; p1 = f32x16{};
#pragma unroll
  for (int d0 = 0; d0 < 4; ++d0) { const int cb = (d0 * 16 + hi * 8) * 2;
    const bf16x8 b0 = *(const AT_LAS bf16x8*)(Ks + KSWZ(r32, cb));
    const bf16x8 b1 = *(const AT_LAS bf16x8*)(Ks + KSWZ(32 + r32, cb));
    p0 = __builtin_amdgcn_mfma_f32_32x32x16_bf16(b0, qr[d0], p0, 0, 0, 0);
    p1 = __builtin_amdgcn_mfma_f32_32x32x16_bf16(b1, qr[d0], p1, 0, 0, 0); }
}
__device__ __forceinline__ int v_st(int k, int c) { const int kk = (k & ~0xC) | ((k & 4) << 1) | ((k & 8) >> 1); return ((kk >> 3) * 4 + (c >> 5)) * 512 + ((kk & 7) * 32 + (c & 31)) * 2; }
__device__ __forceinline__ int v_rd_base(int lane) { return ((lane & 3) << 3) | (((lane >> 2) & 3) << 6) | (((lane >> 4) & 1) << 5) | (((lane >> 5) & 1) << 8); }
constexpr int v_rd_off(int d0, int ks, int half) { return d0 * 512 + ks * 4096 + half * 2048; }
template <int OFF> __device__ __forceinline__ s16x4 tr_read(int vb) { s16x4 r; asm volatile("ds_read_b64_tr_b16 %0, %1 offset:%2" : "=&v"(r) : "v"(vb), "i"(OFF) : "memory"); return r; }
template <int D0> __device__ __forceinline__ void pv_one(f32x16& od, int vb, bf16x8 pa0, bf16x8 pa1, bf16x8 pa2, bf16x8 pa3) {
  const s16x4 l0 = tr_read<v_rd_off(D0, 0, 0)>(vb), h0 = tr_read<v_rd_off(D0, 0, 1)>(vb), l1 = tr_read<v_rd_off(D0, 1, 0)>(vb), h1 = tr_read<v_rd_off(D0, 1, 1)>(vb);
  const s16x4 l2 = tr_read<v_rd_off(D0, 2, 0)>(vb), h2 = tr_read<v_rd_off(D0, 2, 1)>(vb), l3 = tr_read<v_rd_off(D0, 3, 0)>(vb), h3 = tr_read<v_rd_off(D0, 3, 1)>(vb);
  asm volatile("s_waitcnt lgkmcnt(0)" ::: "memory"); SBAR();
#define PK(L, H) (bf16x8){L[0], L[1], L[2], L[3], H[0], H[1], H[2], H[3]}
  od = __builtin_amdgcn_mfma_f32_32x32x16_bf16(pa0, PK(l0, h0), od, 0, 0, 0);
  od = __builtin_amdgcn_mfma_f32_32x32x16_bf16(pa1, PK(l1, h1), od, 0, 0, 0);
  od = __builtin_amdgcn_mfma_f32_32x32x16_bf16(pa2, PK(l2, h2), od, 0, 0, 0);
  od = __builtin_amdgcn_mfma_f32_32x32x16_bf16(pa3, PK(l3, h3), od, 0, 0, 0);
#undef PK
}
typedef short v4i16_t __attribute__((ext_vector_type(4)));
__device__ __forceinline__ s16x4 vtr(int vb, int off) { return __builtin_bit_cast(s16x4, __builtin_amdgcn_ds_read_tr16_b64_v4i16((AT_LAS v4i16_t*)(unsigned)(vb + off))); }
template <int D0> __device__ __forceinline__ void pv_one_b(f32x16& od, int vb, bf16x8 pa0, bf16x8 pa1, bf16x8 pa2, bf16x8 pa3) {
  const s16x4 l0 = vtr(vb, v_rd_off(D0, 0, 0)), h0 = vtr(vb, v_rd_off(D0, 0, 1)), l1 = vtr(vb, v_rd_off(D0, 1, 0)), h1 = vtr(vb, v_rd_off(D0, 1, 1));
  const s16x4 l2 = vtr(vb, v_rd_off(D0, 2, 0)), h2 = vtr(vb, v_rd_off(D0, 2, 1)), l3 = vtr(vb, v_rd_off(D0, 3, 0)), h3 = vtr(vb, v_rd_off(D0, 3, 1));
#define PK(L, H) (bf16x8){L[0], L[1], L[2], L[3], H[0], H[1], H[2], H[3]}
  od = __builtin_amdgcn_mfma_f32_32x32x16_bf16(pa0, PK(l0, h0), od, 0, 0, 0);
  od = __builtin_amdgcn_mfma_f32_32x32x16_bf16(pa1, PK(l1, h1), od, 0, 0, 0);
  od = __builtin_amdgcn_mfma_f32_32x32x16_bf16(pa2, PK(l2, h2), od, 0, 0, 0);
  od = __builtin_amdgcn_mfma_f32_32x32x16_bf16(pa3, PK(l3, h3), od, 0, 0, 0);
#undef PK
}
template <int NDB> __device__ __forceinline__ void pv_all_b(f32x16* o, int vb, bf16x8 pa0, bf16x8 pa1, bf16x8 pa2, bf16x8 pa3) {
  pv_one_b<0>(o[0], vb, pa0, pa1, pa2, pa3); pv_one_b<1>(o[1], vb, pa0, pa1, pa2, pa3);
  if constexpr (NDB == 4) { pv_one_b<2>(o[2], vb, pa0, pa1, pa2, pa3); pv_one_b<3>(o[3], vb, pa0, pa1, pa2, pa3); }
}
template <int NDB> __device__ __forceinline__ void pv_all(f32x16* o, int vb, bf16x8 pa0, bf16x8 pa1, bf16x8 pa2, bf16x8 pa3) {
  pv_one<0>(o[0], vb, pa0, pa1, pa2, pa3); pv_one<1>(o[1], vb, pa0, pa1, pa2, pa3);
  if constexpr (NDB == 4) { pv_one<2>(o[2], vb, pa0, pa1, pa2, pa3); pv_one<3>(o[3], vb, pa0, pa1, pa2, pa3); }
}
__device__ __forceinline__ void wmask(f32x16& p0, f32x16& p1, int k0, int q, int hi) {
#pragma unroll
  for (int r = 0; r < 16; ++r) { const int d = k0 + crow(r, hi) - q; if (d > 128 || d < -128) p0[r] = -1e30f; if (d + 32 > 128 || d + 32 < -128) p1[r] = -1e30f; }
}

struct UnitArgs {
  const bf16* Q; int ldq;
  const bf16* K; const bf16* V; int ldk;
  int kcolB;
  int vcolB;
  int q0;
  int ks;
};
template <bool DIFF> __device__ __forceinline__ int tile_k0(const UnitArgs& a, int j) { if constexpr (DIFF) return 64 * j; else return j < 4 ? SEQ + 64 * j : a.ks + 64 * (j - 4); }

#define RD128(dst, addr, OFF) asm volatile("ds_read_b128 %0, %1 offset:%2" : "=v"(dst) : "v"(addr), "i"(OFF) : "memory")
#define RDTR(dst, addr, OFF) asm volatile("ds_read_b64_tr_b16 %0, %1 offset:%2" : "=v"(dst) : "v"(addr), "i"(OFF) : "memory")
#define WAITL8_4(n, a, b, c, d) asm volatile("s_waitcnt lgkmcnt(" #n ")" : "+v"(a), "+v"(b), "+v"(c), "+v"(d) :: "memory")
#define WAITL8_8(n, a, b, c, d, e, f, g, h) asm volatile("s_waitcnt lgkmcnt(" #n ")" : "+v"(a), "+v"(b), "+v"(c), "+v"(d), "+v"(e), "+v"(f), "+v"(g), "+v"(h) :: "memory")
__device__ __forceinline__ float max3f(float a, float b, float c) { return __builtin_fmaxf(__builtin_fmaxf(a, b), c); }
__device__ __forceinline__ void softmax_seg2(f32x16& p0, f32x16& p1, float& m_reg, float& alpha, bf16x8& pa0, bf16x8& pa1, bf16x8& pa2, bf16x8& pa3) {
  float x = max3f(p0[0], p0[1], p0[2]), y = max3f(p1[0], p1[1], p1[2]);
  x = max3f(x, p0[3], p0[4]); y = max3f(y, p1[3], p1[4]); x = max3f(x, p0[5], p0[6]); y = max3f(y, p1[5], p1[6]); x = max3f(x, p0[7], p0[8]); y = max3f(y, p1[7], p1[8]);
  x = max3f(x, p0[9], p0[10]); y = max3f(y, p1[9], p1[10]); x = max3f(x, p0[11], p0[12]); y = max3f(y, p1[11], p1[12]); x = max3f(x, p0[13], p0[14]); y = max3f(y, p1[13], p1[14]);
  float pmax = max3f(x, y, p0[15]); pmax = fmaxf(pmax, p1[15]);
  { auto rr = __builtin_amdgcn_permlane32_swap(__float_as_uint(pmax), __float_as_uint(pmax), false, false); pmax = fmaxf(__uint_as_float(rr[0]), __uint_as_float(rr[1])); }
  float mn;
  if (__builtin_expect(__all(pmax - m_reg <= THRL), 1)) { mn = m_reg; alpha = 1.f; }
  else { mn = fmaxf(m_reg, pmax); alpha = __builtin_amdgcn_exp2f(m_reg - mn); m_reg = mn; }
#pragma unroll
  for (int r = 0; r < 16; ++r) { p0[r] = __builtin_amdgcn_exp2f(p0[r] - mn); p1[r] = __builtin_amdgcn_exp2f(p1[r] - mn); }
  { u32x4 w = {cvtpk2(p0[0], p0[1]), cvtpk2(p0[2], p0[3]), cvtpk2(p0[4], p0[5]), cvtpk2(p0[6], p0[7])}; pa0 = __builtin_bit_cast(bf16x8, w); }
  { u32x4 w = {cvtpk2(p0[8], p0[9]), cvtpk2(p0[10], p0[11]), cvtpk2(p0[12], p0[13]), cvtpk2(p0[14], p0[15])}; pa1 = __builtin_bit_cast(bf16x8, w); }
  { u32x4 w = {cvtpk2(p1[0], p1[1]), cvtpk2(p1[2], p1[3]), cvtpk2(p1[4], p1[5]), cvtpk2(p1[6], p1[7])}; pa2 = __builtin_bit_cast(bf16x8, w); }
  { u32x4 w = {cvtpk2(p1[8], p1[9]), cvtpk2(p1[10], p1[11]), cvtpk2(p1[12], p1[13]), cvtpk2(p1[14], p1[15])}; pa3 = __builtin_bit_cast(bf16x8, w); }
}
template <bool DIFF>
__device__ __forceinline__ void attn_tiles_pp3(const UnitArgs& a, AT_LAS char* lds, int tid, int wid, int lane, f32x16* o, f32x16& ol, float& m_out) {
  constexpr int NDB = DIFF ? 4 : 2; constexpr int NT = DIFF ? KVLEN / 64 : 10;
  const int r32 = lane & 31, hi = lane >> 5;
  AT_LAS char* V_lds = lds; AT_LAS char* K_lds = lds + 3 * SHM_V;
  AT_LAS float* al_l = (AT_LAS float*)(lds + AT_WS3_OFF) + wid * 64 + 32;
  float m_reg = -1e30f, alpha = 1.f; bf16x8 qr[4];
  const short one_ = (short)0x3F80; const bf16x8 ones = {one_, one_, one_, one_, one_, one_, one_, one_};
  const bf16* Qw = a.Q + (long)r32 * a.ldq + hi * 8;
#pragma unroll
  for (int d0 = 0; d0 < 4; ++d0) qr[d0] = *(const bf16x8*)(Qw + d0 * 16);
  int koff[2], voff[2];
#pragma unroll
  for (int i = 0; i < 2; ++i) { const int pc = 2 * wid + i;
    { const int row = 4 * pc + (lane >> 4), p = lane & 15; koff[i] = row * a.ldk + ((p ^ (row & 7)) << 3); }
    { const int s = 2 * pc + (lane >> 5), kk = (s >> 2) * 8 + ((lane & 31) >> 2); const int key = kk; voff[i] = key * a.ldk + (s & 3) * 32 + 8 * (lane & 3); } }
  const int vb0 = (int)(unsigned)(uintptr_t)V_lds + v_rd_base(lane) + a.vcolB;
  const int kb0 = (int)(unsigned)(uintptr_t)K_lds + a.kcolB + r32 * 256;
  int kad[4];
#pragma unroll
  for (int d0 = 0; d0 < 4; ++d0) kad[d0] = kb0 + (((d0 * 2 + hi) ^ (r32 & 7)) << 4);
#define DMA_K(t, slot) do { const bf16* kb_ = a.K + (long)tile_k0<DIFF>(a, (t)) * a.ldk; _Pragma("unroll") for (int i_ = 0; i_ < 2; ++i_) \
    __builtin_amdgcn_global_load_lds((const unsigned*)(kb_ + koff[i_]), (AT_LAS unsigned*)(K_lds + (slot) * SHM_K + (2 * wid + i_) * 1024), 16, 0, 0); } while (0)
#define DMA_V(t, slot) do { const bf16* vb_ = a.V + (long)tile_k0<DIFF>(a, (t)) * a.ldk; _Pragma("unroll") for (int i_ = 0; i_ < 2; ++i_) \
    __builtin_amdgcn_global_load_lds((const unsigned*)(vb_ + voff[i_]), (AT_LAS unsigned*)(V_lds + (slot) * SHM_V + (2 * wid + i_) * 1024), 16, 0, 0); } while (0)
#define BAR_MID() do { SBAR(); asm volatile("s_barrier" ::: "memory"); SBAR(); } while (0)
#define BAR_END(n) do { SBAR(); asm volatile("s_waitcnt vmcnt(" #n ")\n\ts_barrier" ::: "memory"); SBAR(); } while (0)
#define RESC2() do { if (__any(alpha < 1.f)) { if (hi == 0) al_l[r32] = alpha; asm volatile("s_waitcnt lgkmcnt(0)" ::: "memory"); \
    _Pragma("unroll") for (int r = 0; r < 16; ++r) { const float f_ = al_l[crow(r, hi)]; ol[r] *= f_; _Pragma("unroll") for (int d = 0; d < NDB; ++d) o[d][r] *= f_; } } } while (0)
#define WMASK2(t) do { if constexpr (!DIFF) { if ((t) >= 4) wmask(p0, p1, tile_k0<DIFF>(a, (t)), a.q0 + r32, hi); } } while (0)
#define VSEG(t) do { WMASK2(t); softmax_seg2(p0, p1, m_reg, alpha, pa0, pa1, pa2, pa3); RESC2(); } while (0)
#define PKV(L, H) (bf16x8){L[0], L[1], L[2], L[3], H[0], H[1], H[2], H[3]}
#define VRD8(X, D0, va) do { RDTR(X##0, va, v_rd_off(D0, 0, 0)); RDTR(X##1, va, v_rd_off(D0, 0, 1)); RDTR(X##2, va, v_rd_off(D0, 1, 0)); RDTR(X##3, va, v_rd_off(D0, 1, 1)); \
    RDTR(X##4, va, v_rd_off(D0, 2, 0)); RDTR(X##5, va, v_rd_off(D0, 2, 1)); RDTR(X##6, va, v_rd_off(D0, 3, 0)); RDTR(X##7, va, v_rd_off(D0, 3, 1)); } while (0)
#define PV4(od, X) do { od = __builtin_amdgcn_mfma_f32_32x32x16_bf16(pa0, PKV(X##0, X##1), od, 0, 0, 0); od = __builtin_amdgcn_mfma_f32_32x32x16_bf16(pa1, PKV(X##2, X##3), od, 0, 0, 0); \
    od = __builtin_amdgcn_mfma_f32_32x32x16_bf16(pa2, PKV(X##4, X##5), od, 0, 0, 0); od = __builtin_amdgcn_mfma_f32_32x32x16_bf16(pa3, PKV(X##6, X##7), od, 0, 0, 0); } while (0)
#define MSEG(DOQK, DOPV, ksl, vsl) do { \
    bf16x8 k0_, k1_, k2_, k3_; s16x4 A0, A1, A2, A3, A4, A5, A6, A7, B0, B1, B2, B3, B4, B5, B6, B7; \
    const int ko_ = (ksl) * SHM_K; const int va_ = vb0 + (vsl) * SHM_V; \
    if (DOQK) { RD128(k0_, kad[0] + ko_, 0); RD128(k1_, kad[0] + ko_, 8192); RD128(k2_, kad[1] + ko_, 0); RD128(k3_, kad[1] + ko_, 8192); \
      bf16x8 k4_, k5_, k6_, k7_; RD128(k4_, kad[2] + ko_, 0); RD128(k5_, kad[2] + ko_, 8192); RD128(k6_, kad[3] + ko_, 0); RD128(k7_, kad[3] + ko_, 8192); \
      WAITL8_4(4, k0_, k1_, k2_, k3_); SBAR(); \
      p0 = __builtin_amdgcn_mfma_f32_32x32x16_bf16(k0_, qr[0], (f32x16){}, 0, 0, 0); p1 = __builtin_amdgcn_mfma_f32_32x32x16_bf16(k1_, qr[0], (f32x16){}, 0, 0, 0); \
      p0 = __builtin_amdgcn_mfma_f32_32x32x16_bf16(k2_, qr[1], p0, 0, 0, 0); p1 = __builtin_amdgcn_mfma_f32_32x32x16_bf16(k3_, qr[1], p1, 0, 0, 0); SBAR(); \
      if (DOPV) { VRD8(A, 0, va_); WAITL8_4(8, k4_, k5_, k6_, k7_); } else { WAITL8_4(0, k4_, k5_, k6_, k7_); } SBAR(); \
      p0 = __builtin_amdgcn_mfma_f32_32x32x16_bf16(k4_, qr[2], p0, 0, 0, 0); p1 = __builtin_amdgcn_mfma_f32_32x32x16_bf16(k5_, qr[2], p1, 0, 0, 0); \
      p0 = __builtin_amdgcn_mfma_f32_32x32x16_bf16(k6_, qr[3], p0, 0, 0, 0); p1 = __builtin_amdgcn_mfma_f32_32x32x16_bf16(k7_, qr[3], p1, 0, 0, 0); SBAR(); } \
    else if (DOPV) { VRD8(A, 0, va_); } \
    if (DOPV) { VRD8(B, 1, va_); WAITL8_8(8, A0, A1, A2, A3, A4, A5, A6, A7); SBAR(); PV4(o[0], A); SBAR(); \
      if constexpr (NDB == 4) { VRD8(A, 2, va_); WAITL8_8(8, B0, B1, B2, B3, B4, B5, B6, B7); SBAR(); PV4(o[1], B); SBAR(); \
        VRD8(B, 3, va_); WAITL8_8(8, A0, A1, A2, A3, A4, A5, A6, A7); SBAR(); PV4(o[2], A); SBAR(); \
        WAITL8_8(0, B0, B1, B2, B3, B4, B5, B6, B7); SBAR(); PV4(o[3], B); SBAR(); } \
      else { WAITL8_8(0, B0, B1, B2, B3, B4, B5, B6, B7); SBAR(); PV4(o[1], B); SBAR(); } \
      ol = __builtin_amdgcn_mfma_f32_32x32x16_bf16(pa0, ones, ol, 0, 0, 0); ol = __builtin_amdgcn_mfma_f32_32x32x16_bf16(pa1, ones, ol, 0, 0, 0); \
      ol = __builtin_amdgcn_mfma_f32_32x32x16_bf16(pa2, ones, ol, 0, 0, 0); ol = __builtin_amdgcn_mfma_f32_32x32x16_bf16(pa3, ones, ol, 0, 0, 0); SBAR(); } \
  } while (0)
#define ROT3(s) ((s) == 2 ? 0 : (s) + 1)
  f32x16 p0, p1; bf16x8 pa0, pa1, pa2, pa3;
  DMA_K(0, 0); DMA_K(1, 1); DMA_V(0, 0); BAR_END(0);
  int sk = 0;
  if (wid < 4) {
    DMA_K(2, 2); DMA_V(1, 1); MSEG(true, false, 0, 0); BAR_MID(); VSEG(0); BAR_END(4);
    sk = 1;
    for (int t = 1; t <= NT - 3; ++t) { const int s1 = ROT3(sk), s2 = ROT3(s1);
      DMA_K(t + 2, s2); DMA_V(t + 1, s1); MSEG(true, true, sk, s2); BAR_MID(); VSEG(t); BAR_END(4); sk = s1; }
    { const int s1 = ROT3(sk), s2 = ROT3(s1); DMA_V(NT - 1, s1); MSEG(true, true, sk, s2); BAR_MID(); VSEG(NT - 2); BAR_END(2); sk = s1; }
    { const int s1 = ROT3(sk), s2 = ROT3(s1); MSEG(true, true, sk, s2); BAR_MID(); VSEG(NT - 1); BAR_END(0); sk = s1; }
    { const int s2 = ROT3(ROT3(sk)); MSEG(false, true, 0, s2); BAR_MID(); BAR_END(0); }
  } else {
    DMA_K(2, 2); DMA_V(1, 1); BAR_MID(); MSEG(true, false, 0, 0); BAR_END(4);
    sk = 1;
    for (int t = 1; t <= NT - 3; ++t) { const int s1 = ROT3(sk), s2 = ROT3(s1);
      DMA_K(t + 2, s2); DMA_V(t + 1, s1); VSEG(t - 1); BAR_MID(); MSEG(true, true, sk, s2); BAR_END(4); sk = s1; }
    { const int s1 = ROT3(sk), s2 = ROT3(s1); DMA_V(NT - 1, s1); VSEG(NT - 3); BAR_MID(); MSEG(true, true, sk, s2); BAR_END(2); sk = s1; }
    { const int s1 = ROT3(sk), s2 = ROT3(s1); VSEG(NT - 2); BAR_MID(); MSEG(true, true, sk, s2); BAR_END(0); sk = s1; }
    { const int s2 = ROT3(ROT3(sk)); VSEG(NT - 1); BAR_MID(); MSEG(false, true, 0, s2); BAR_END(0); }
  }
  m_out = m_reg;
#undef DMA_K
#undef DMA_V
#undef BAR_MID
#undef BAR_END
#undef RESC2
#undef WMASK2
#undef VSEG
#undef PKV
#undef VRD8
#undef PV4
#undef MSEG
#undef ROT3
}

typedef int i32x8v __attribute__((ext_vector_type(8)));
constexpr int F8_SLOT = 8192, F8_K_OFF = 0, F8_V_OFF = 3 * F8_SLOT;
#define MF8_ACC(acc, a8, b8) asm volatile("v_mfma_scale_f32_32x32x64_f8f6f4 %0, %1, %2, %0, %3, %3 op_sel_hi:[0,0,0]" : "+v"(acc) : "v"(a8), "v"(b8), "v"(sc1))
#define MF8_NEW(acc, a8, b8) asm volatile("v_mfma_scale_f32_32x32x64_f8f6f4 %0, %1, %2, 0, %3, %3 op_sel_hi:[0,0,0]" : "=&v"(acc) : "v"(a8), "v"(b8), "v"(sc1))
__device__ __forceinline__ unsigned pk4f8(float a, float b, float c, float d) { int w = 0; w = __builtin_amdgcn_cvt_pk_fp8_f32(a, b, w, false); w = __builtin_amdgcn_cvt_pk_fp8_f32(c, d, w, true); return (unsigned)w; }
struct UnitArgs8 { const unsigned char* Q; const unsigned char* K; const unsigned char* VT; int comp, ldk, vdoff, q0, ks; };
template <bool DIFF> __device__ __forceinline__ int tile8_k0(const UnitArgs8& a, int j) { if constexpr (DIFF) return 64 * j; else return j < 4 ? SEQ + 64 * j : a.ks + 64 * (j - 4); }
template <bool DIFF>
__device__ __forceinline__ void attn_tiles_f8(const UnitArgs8& a, AT_LAS char* lds, int tid, int wid, int lane, f32x16* o, f32x16& ol, float& m_out) {
  constexpr int NDB = DIFF ? 4 : 2, NT = DIFF ? KVLEN / 64 : 10;
  const int r32 = lane & 31, hi = lane >> 5;
  AT_LAS char* K_lds = lds + F8_K_OFF; AT_LAS char* V_lds = lds + F8_V_OFF;
  AT_LAS float* al_l = (AT_LAS float*)(lds + AT_WS3_OFF) + wid * 64 + 32;
  float m_reg = -1e30f, alpha = 1.f;
  int sc1 = 0x7F7F7F7F; asm volatile("" : "+v"(sc1));
  i32x8v ones8; { int o4 = 0x38383838; asm volatile("" : "+v"(o4)); ones8 = (i32x8v){o4, o4, o4, o4, o4, o4, o4, o4}; }
  i32x8v q8; { const u32x4 qa_ = *(const u32x4*)(a.Q + (long)r32 * 512 + hi * 32), qb_ = *(const u32x4*)(a.Q + (long)r32 * 512 + hi * 32 + 16);
    q8 = (i32x8v){(int)qa_.x, (int)qa_.y, (int)qa_.z, (int)qa_.w, (int)qb_.x, (int)qb_.y, (int)qb_.z, (int)qb_.w}; }
  const int kkey = 8 * wid + (lane >> 3), koff = kkey * a.ldk + (((lane & 7) ^ ((kkey >> 1) & 7)) << 4);
  const int vd = 16 * wid + (lane >> 2); const long voff = (long)vd * KVLEN + (((lane & 3) ^ ((vd >> 2) & 3)) << 4);
  const int ksw = (r32 >> 1) & 7, vsw = (r32 >> 2) & 3;
  const int kb = (int)(unsigned)(uintptr_t)K_lds + r32 * 128, ka0 = kb + (((a.comp * 4 + 2 * hi) ^ ksw) << 4), ka1 = kb + (((a.comp * 4 + 2 * hi + 1) ^ ksw) << 4);
  const int vbb = (int)(unsigned)(uintptr_t)V_lds + a.vdoff + r32 * 64, va0 = vbb + (((2 * hi) ^ vsw) << 4), va1 = vbb + (((2 * hi + 1) ^ vsw) << 4);
#define DMA_K(t, slot) __builtin_amdgcn_global_load_lds((const unsigned*)(a.K + (long)tile8_k0<DIFF>(a, (t)) * a.ldk + koff), (AT_LAS unsigned*)(K_lds + (slot) * F8_SLOT + wid * 1024), 16, 0, 0)
#define DMA_V(t, slot) __builtin_amdgcn_global_load_lds((const unsigned*)(a.VT + (long)tile8_k0<DIFF>(a, (t)) + voff), (AT_LAS unsigned*)(V_lds + (slot) * F8_SLOT + wid * 1024), 16, 0, 0)
#define BAR_MID() do { SBAR(); asm volatile("s_barrier" ::: "memory"); SBAR(); } while (0)
#define BAR_END(n) do { SBAR(); asm volatile("s_waitcnt vmcnt(" #n ")\n\ts_barrier" ::: "memory"); SBAR(); } while (0)
#define RESC2() do { if (__any(alpha < 1.f)) { if (hi == 0) al_l[r32] = alpha; asm volatile("s_waitcnt lgkmcnt(0)" ::: "memory"); \
    _Pragma("unroll") for (int r = 0; r < 16; ++r) { const float f_ = al_l[crow(r, hi)]; ol[r] *= f_; _Pragma("unroll") for (int d = 0; d < NDB; ++d) o[d][r] *= f_; } } } while (0)
#define VSEG(t) do { if constexpr (!DIFF) { if ((t) >= 4) wmask(p0, p1, tile8_k0<DIFF>(a, (t)), a.q0 + r32, hi); } bf16x8 t0_, t1_, t2_, t3_; softmax_seg2(p0, p1, m_reg, alpha, t0_, t1_, t2_, t3_); (void)t0_; (void)t1_; (void)t2_; (void)t3_; \
    pa8 = (i32x8v){(int)pk4f8(p0[0], p0[1], p0[2], p0[3]), (int)pk4f8(p0[4], p0[5], p0[6], p0[7]), (int)pk4f8(p0[8], p0[9], p0[10], p0[11]), (int)pk4f8(p0[12], p0[13], p0[14], p0[15]), \
                   (int)pk4f8(p1[0], p1[1], p1[2], p1[3]), (int)pk4f8(p1[4], p1[5], p1[6], p1[7]), (int)pk4f8(p1[8], p1[9], p1[10], p1[11]), (int)pk4f8(p1[12], p1[13], p1[14], p1[15])}; RESC2(); } while (0)
#define RD16(dst, addr, OFF) asm volatile("ds_read_b128 %0, %1 offset:%2" : "=v"(dst) : "v"(addr), "i"(OFF) : "memory")
#define CAT8(x, y) (i32x8v){(int)x[0], (int)x[1], (int)x[2], (int)x[3], (int)y[0], (int)y[1], (int)y[2], (int)y[3]}
#define MSEG(DOQK, DOPV, ksl, vsl) do { \
    u32x4 ka_, kb_, kc_, kd_, v0a, v0b, v1a, v1b, v2a, v2b, v3a, v3b; const int ko_ = (ksl) * F8_SLOT, vo_ = (vsl) * F8_SLOT; \
    if (DOQK) { RD16(ka_, ka0 + ko_, 0); RD16(kb_, ka1 + ko_, 0); RD16(kc_, ka0 + ko_, 4096); RD16(kd_, ka1 + ko_, 4096); } \
    if (DOPV) { RD16(v0a, va0 + vo_, 0); RD16(v0b, va1 + vo_, 0); RD16(v1a, va0 + vo_, 2048); RD16(v1b, va1 + vo_, 2048); \
                if constexpr (NDB == 4) { RD16(v2a, va0 + vo_, 4096); RD16(v2b, va1 + vo_, 4096); RD16(v3a, va0 + vo_, 6144); RD16(v3b, va1 + vo_, 6144); } } \
    if (DOQK) { if (DOPV) { if constexpr (NDB == 4) asm volatile("s_waitcnt lgkmcnt(8)" : "+v"(ka_), "+v"(kb_), "+v"(kc_), "+v"(kd_) :: "memory"); else asm volatile("s_waitcnt lgkmcnt(4)" : "+v"(ka_), "+v"(kb_), "+v"(kc_), "+v"(kd_) :: "memory"); } else { asm volatile("s_waitcnt lgkmcnt(0)" : "+v"(ka_), "+v"(kb_), "+v"(kc_), "+v"(kd_) :: "memory"); } SBAR(); \
      { const i32x8v k0_ = CAT8(ka_, kb_), k1_ = CAT8(kc_, kd_); MF8_NEW(p0, k0_, q8); MF8_NEW(p1, k1_, q8); } SBAR(); } \
    if (DOPV) { if constexpr (NDB == 4) { asm volatile("s_waitcnt lgkmcnt(0)" : "+v"(v0a), "+v"(v0b), "+v"(v1a), "+v"(v1b), "+v"(v2a), "+v"(v2b), "+v"(v3a), "+v"(v3b) :: "memory"); SBAR(); \
        const i32x8v w0_ = CAT8(v0a, v0b), w1_ = CAT8(v1a, v1b), w2_ = CAT8(v2a, v2b), w3_ = CAT8(v3a, v3b); \
        MF8_ACC(o[0], pa8, w0_); MF8_ACC(o[1], pa8, w1_); MF8_ACC(o[2], pa8, w2_); MF8_ACC(o[3], pa8, w3_); MF8_ACC(ol, pa8, ones8); } \
      else { asm volatile("s_waitcnt lgkmcnt(0)" : "+v"(v0a), "+v"(v0b), "+v"(v1a), "+v"(v1b) :: "memory"); SBAR(); \
        const i32x8v w0_ = CAT8(v0a, v0b), w1_ = CAT8(v1a, v1b); MF8_ACC(o[0], pa8, w0_); MF8_ACC(o[1], pa8, w1_); MF8_ACC(ol, pa8, ones8); } SBAR(); } \
    asm volatile("s_nop 15\n\ts_nop 15" ::: "memory");     \
  } while (0)
#define ROT3(s) ((s) == 2 ? 0 : (s) + 1)
  f32x16 p0, p1; i32x8v pa8;
  DMA_K(0, 0); DMA_K(1, 1); DMA_V(0, 0); BAR_END(0);
  int sk = 0;
  if (wid < 4) {
    DMA_K(2, 2); DMA_V(1, 1); MSEG(true, false, 0, 0); BAR_MID(); VSEG(0); BAR_END(2);
    sk = 1;
    for (int t = 1; t <= NT - 3; ++t) { const int s1 = ROT3(sk), s2 = ROT3(s1);
      DMA_K(t + 2, s2); DMA_V(t + 1, s1); MSEG(true, true, sk, s2); BAR_MID(); VSEG(t); BAR_END(2); sk = s1; }
    { const int s1 = ROT3(sk), s2 = ROT3(s1); DMA_V(NT - 1, s1); MSEG(true, true, sk, s2); BAR_MID(); VSEG(NT - 2); BAR_END(1); sk = s1; }
    { const int s1 = ROT3(sk), s2 = ROT3(s1); MSEG(true, true, sk, s2); BAR_MID(); VSEG(NT - 1); BAR_END(0); sk = s1; }
    { const int s2 = ROT3(ROT3(sk)); MSEG(false, true, 0, s2); BAR_MID(); BAR_END(0); }
  } else {
    DMA_K(2, 2); DMA_V(1, 1); BAR_MID(); MSEG(true, false, 0, 0); BAR_END(2);
    sk = 1;
    for (int t = 1; t <= NT - 3; ++t) { const int s1 = ROT3(sk), s2 = ROT3(s1);
      DMA_K(t + 2, s2); DMA_V(t + 1, s1); VSEG(t - 1); BAR_MID(); MSEG(true, true, sk, s2); BAR_END(2); sk = s1; }
    { const int s1 = ROT3(sk), s2 = ROT3(s1); DMA_V(NT - 1, s1); VSEG(NT - 3); BAR_MID(); MSEG(true, true, sk, s2); BAR_END(1); sk = s1; }
    { const int s1 = ROT3(sk), s2 = ROT3(s1); VSEG(NT - 2); BAR_MID(); MSEG(true, true, sk, s2); BAR_END(0); sk = s1; }
    { const int s2 = ROT3(ROT3(sk)); VSEG(NT - 1); BAR_MID(); MSEG(false, true, 0, s2); BAR_END(0); }
  }
  m_out = m_reg;
#undef DMA_K
#undef DMA_V
#undef BAR_MID
#undef BAR_END
#undef RESC2
#undef VSEG
#undef RD16
#undef CAT8
#undef MSEG
#undef ROT3
}
#undef KSWZ
#undef SBAR
}

#ifndef QKV_FP8
#define QKV_FP8 1
#endif
constexpr size_t MiB = 1u << 20;
constexpr size_t WS_CTL = 0, CTL_ZERO_BYTES = 1 * MiB;
constexpr size_t WS_MODP = 1 * MiB;
constexpr size_t WS_MODV = 2 * MiB;
constexpr size_t WS_ROPE = 2 * MiB + 128 * 1024;
constexpr size_t WS_ROUTE = 3 * MiB;
constexpr size_t WS_WIN = 4 * MiB, WS_WOUT = 9 * MiB, WS_WGU = 12 * MiB, WS_WDN = 140 * MiB;
constexpr size_t WS_ELIST = 238 * MiB;
constexpr size_t WS_XN = 204 * MiB;
constexpr size_t WS_QA = 240 * MiB, WS_KA = 256 * MiB, WS_VA = 274 * MiB, WS_QB = 292 * MiB, WS_KB = 308 * MiB, WS_VB = 314 * MiB;
constexpr size_t WS_Y = 320 * MiB, WS_X1 = 352 * MiB, WS_XG = 416 * MiB, WS_H = 560 * MiB, WS_Y2 = 704 * MiB, WS_END = 848 * MiB;
constexpr int CW_TMO = 0, CW_CODE = 1, CW_BAR = 4096, CW_CNT = 8192;
constexpr int MODP_KC = 8;

constexpr int RING_OFF = 0, RING_BYTES = 131072;
constexpr int LDSCTL_OFF = RING_BYTES, MISC_OFF = LDSCTL_OFF + 320, XTRA_OFF = LDSCTL_OFF + 1024;
constexpr int LDS_BYTES = 147456;

__device__ const double ROPE_CS[32] = {
    0.54030230586813977, 0.8414709848078965, 0.84600911028170789, 0.53316843991402285, 0.95041528025518285, 0.31098359290718575, 0.98423023447009461, 0.17689218624615005,
    0.99500416527802582, 0.099833416646828155, 0.99841927779266448, 0.056204499214692491, 0.99950004166527784, 0.031617506402433708, 0.99984189028361437, 0.01778185687966613,
    0.99995000041666526, 0.0099998333341666645, 0.9999841886533658, 0.0056233836139601857, 0.99999500000416663, 0.0031622723897082477, 0.99999841886158658, 0.0017782784728035289,
    0.99999950000004167, 0.00099999983333334168, 0.99999984188612112, 0.00056234129555235944, 0.99999995000000041, 0.00031622776074637522, 0.99999998418861169, 0.00017782794006665674};

__device__ __forceinline__ unsigned cvtpk(float lo, float hi) { return at2::cvtpk2(lo, hi); }
__device__ __forceinline__ unsigned pk4_fp8(float a, float b, float c, float d) { int w = 0; w = __builtin_amdgcn_cvt_pk_fp8_f32(a, b, w, false); w = __builtin_amdgcn_cvt_pk_fp8_f32(c, d, w, true); return (unsigned)w; }
__device__ __forceinline__ float bflo(unsigned w) { return __uint_as_float(w << 16); }
__device__ __forceinline__ float bfhi(unsigned w) { return __uint_as_float(w & 0xffff0000u); }
__device__ __forceinline__ bf16 f2bf1(float f) { return (bf16)(cvtpk(f, 0.f) & 0xffffu); }
__device__ __forceinline__ void unpack8(const v4u v, float* f) { f[0] = bflo(v.x); f[1] = bfhi(v.x); f[2] = bflo(v.y); f[3] = bfhi(v.y); f[4] = bflo(v.z); f[5] = bfhi(v.z); f[6] = bflo(v.w); f[7] = bfhi(v.w); }
__device__ __forceinline__ float wave_sum(float v) {
#pragma unroll
    for (int o = 1; o < 64; o <<= 1) v += __shfl_xor(v, o);
    return v;
}

struct Frame {
    LAS unsigned char* lds;
    volatile LAS unsigned* MISC;
    gu32* ctl;
    int tid, lane, wave, vcu, G, probe;
    const float *x, *c, *ctx, *c_ctx, *w_mod, *b_mod, *norm1_g, *w_in, *lq1, *lk1, *lq2, *lk2, *subln_g, *sink, *w_out, *norm2_g, *w_router, *b_router, *w_gu, *b_gu, *w_dn, *b_dn, *final_g;
    float* out;
    float *modp, *modv, *rope, *X1, *rgate;
    int *re, *rslot, *rpos, *elist;
    bf16 *Win_t, *Wout_t, *Wgu_t, *Wdn_t, *XN, *QA, *KA, *VA, *QB, *KB, *VB, *Y, *XG, *H, *Y2;
};

#ifdef PROBE_BUILD
#define RP(F, k) (1 + (((F).probe >> (k)) & 1))
#else
#define RP(F, k) 1
#endif
struct EpiQKV {
    bf16 *QA, *KA, *VA, *QB, *KB, *VB; const float* rope;
    struct Ctx { bf16* p; bool skip, rp, isq; const float* cs; };
    __device__ __forceinline__ Ctx prep(int row, int cg) const {
        Ctx c; const bool lat = row < NTOK; const int b = lat ? (row >> 13) : ((row - NTOK) >> 8);
        const int kvrow = lat ? (b * KVLEN + (row & (SEQ - 1))) : (b * KVLEN + SEQ + ((row - NTOK) & (CTXL - 1)));
        c.skip = false; c.rp = lat; c.isq = false;
        if (cg < 512)       { c.p = QA + (size_t)row * 512 + cg; c.isq = true; c.skip = !lat; }
        else if (cg < 1024) { c.p = KA + (size_t)kvrow * 512 + (cg - 512); }
        else if (cg < 1536) { c.p = VA + (size_t)kvrow * 512 + (cg - 1024); c.rp = false; }
        else if (cg < 2048) { c.p = QB + (size_t)row * 512 + (cg - 1536); c.isq = true; c.skip = !lat; }
        else if (cg < 2176) { c.p = KB + (size_t)kvrow * 128 + (cg - 2048); }
        else                { c.p = VB + (size_t)kvrow * 128 + (cg - 2176); c.rp = false; }
        const int t = row & (SEQ - 1); const int pos = ((cg >> 5) & 1) ? (t & 63) : (t >> 6);
        c.cs = rope + pos * 32;
        return c;
    }
    __device__ __forceinline__ void math(const Ctx& c, int i, float lo, float hi, float& olo, float& ohi) const {
        if (c.rp) { const float cs = c.cs[2 * i], sn = c.cs[2 * i + 1]; olo = lo * cs - hi * sn; ohi = hi * cs + lo * sn; } else { olo = lo; ohi = hi; }
        if (c.isq) { olo *= QSCALE; ohi *= QSCALE; }
    }
    __device__ __forceinline__ void one(int row, int cg, int i, float lo, float hi, int) const {
        const Ctx c = prep(row, cg); if (c.skip) return; float a, b; math(c, i, lo, hi, a, b); c.p[i] = f2bf1(a); c.p[16 + i] = f2bf1(b);
    }
    __device__ __forceinline__ void four(int row, int cg, int i0, const f32x4 lo, const f32x4 hi, int) const {
        const Ctx c = prep(row, cg); if (c.skip) return; float a[4], b[4];
#pragma unroll
        for (int i = 0; i < 4; ++i) math(c, i0 + i, lo[i], hi[i], a[i], b[i]);
        typedef unsigned u32x2 __attribute__((ext_vector_type(2)));
        *(u32x2*)(c.p + i0) = (u32x2){cvtpk(a[0], a[1]), cvtpk(a[2], a[3])}; *(u32x2*)(c.p + 16 + i0) = (u32x2){cvtpk(b[0], b[1]), cvtpk(b[2], b[3])};
    }
};
struct EpiOut {
    const float* x; const float* modv; float* X1;
    __device__ __forceinline__ void one(int row, int cg, int i, float lo, float hi, int) const {
        const float* g1 = modv + (row >> 13) * 6144 + 2048; const size_t o = (size_t)row * DM + cg + i;
        X1[o] = x[o] + g1[cg + i] * lo; X1[o + 16] = x[o + 16] + g1[cg + 16 + i] * hi;
    }
    struct Pre { f32x4 a, b; };
    __device__ __forceinline__ Pre pre(int row0, int cg, int i0, int) const { const float* g1 = modv + (row0 >> 13) * 6144 + 2048 + cg + i0; return Pre{*(const f32x4*)(g1), *(const f32x4*)(g1 + 16)}; }
    __device__ __forceinline__ void four(int row, int cg, int i0, const f32x4 lo, const f32x4 hi, int, const Pre& pr) const {
        const size_t o = (size_t)row * DM + cg + i0;
        typedef unsigned u32x2 __attribute__((ext_vector_type(2)));
        const f32x4 a = pr.a * lo, b = pr.b * hi;
        *(u32x2*)((bf16*)X1 + o) = (u32x2){cvtpk(a[0], a[1]), cvtpk(a[2], a[3])}; *(u32x2*)((bf16*)X1 + o + 16) = (u32x2){cvtpk(b[0], b[1]), cvtpk(b[2], b[3])};
    }
};
__device__ __forceinline__ float swiglu(float g, float lin) {
    g = fminf(g, 7.0f); lin = fminf(fmaxf(lin, -7.0f), 7.0f);
    return g * __builtin_amdgcn_rcpf(1.0f + __builtin_amdgcn_exp2f(-1.702f * LOG2E * g)) * (lin + 1.0f);
}
struct EpiGU {
    unsigned char* H; const float* b_gu;
    __device__ __forceinline__ void one(int row, int cg, int i, float lo, float hi, int e) const { (void)row; (void)cg; (void)i; (void)lo; (void)hi; (void)e; }
    struct Pre { f32x4 a, b; };
    __device__ __forceinline__ Pre pre(int, int cg, int i0, int e) const { const int f = (cg >> 1) + i0; const float* bb = b_gu + e * GUW + 2 * f; return Pre{*(const f32x4*)bb, *(const f32x4*)(bb + 4)}; }
    __device__ __forceinline__ void four(int row, int cg, int i0, const f32x4 lo, const f32x4 hi, int e, const Pre& pr) const {
        const int f = (cg >> 1) + i0; const f32x4 b0 = pr.a, b1 = pr.b; (void)e;
        const float a0 = swiglu(lo[0] + b0[0], hi[0] + b0[1]), a1 = swiglu(lo[1] + b0[2], hi[1] + b0[3]), a2 = swiglu(lo[2] + b1[0], hi[2] + b1[1]), a3 = swiglu(lo[3] + b1[2], hi[3] + b1[3]);
        *(unsigned*)(H + (size_t)row * DM + f) = pk4_fp8(a0, a1, a2, a3);
    }
};
struct EpiDN {
    bf16* Y2; const float* b_dn;
    struct Pre { f32x4 a, b; };
    __device__ __forceinline__ Pre pre(int, int c0, int, int e) const { const float* bb = b_dn + e * DM + c0; return Pre{*(const f32x4*)bb, *(const f32x4*)(bb + 4)}; }
    __device__ __forceinline__ void eight(int row, int c0, const f32x4 v0, const f32x4 v1, int e, const Pre& pr) const {
        const f32x4 b0 = pr.a, b1 = pr.b; (void)e;
        typedef unsigned u32x2 __attribute__((ext_vector_type(2)));
        *(u32x2*)((unsigned char*)Y2 + (size_t)row * DM + c0) = (u32x2){pk4_fp8(v0[0] + b0[0], v0[1] + b0[1], v0[2] + b0[2], v0[3] + b0[3]), pk4_fp8(v1[0] + b1[0], v1[1] + b1[1], v1[2] + b1[2], v1[3] + b1[3])};
    }
    __device__ __forceinline__ void one(int row, int cg, int i, float lo, float hi, int e) const {
        const float* bb = b_dn + e * DM + cg + i; bf16* p = Y2 + (size_t)row * DM + cg + i; p[0] = f2bf1(lo + bb[0]); p[16] = f2bf1(hi + bb[16]);
    }
    __device__ __forceinline__ void four(int row, int cg, int i0, const f32x4 lo, const f32x4 hi, int e) const {
        const float* bb = b_dn + e * DM + cg + i0; const f32x4 b0 = *(const f32x4*)bb, b1 = *(const f32x4*)(bb + 16); bf16* p = Y2 + (size_t)row * DM + cg + i0;
        typedef unsigned u32x2 __attribute__((ext_vector_type(2)));
        *(u32x2*)p = (u32x2){cvtpk(lo[0] + b0[0], lo[1] + b0[1]), cvtpk(lo[2] + b0[2], lo[3] + b0[3])}; *(u32x2*)(p + 16) = (u32x2){cvtpk(hi[0] + b1[0], hi[1] + b1[1]), cvtpk(hi[2] + b1[2], hi[3] + b1[3])};
    }
};
template <class E, int NN> struct EpiAdapt {
    static constexpr bool PERM = false, AFTER_DRAIN = false;
    E e;
    __device__ __forceinline__ void operator()(const pg8::f32x4 (&acc)[2][2][4][2], const pg8::Unit& u, int wr, int wc, int fr, int fq) const {
        int ex = 0, pn = u.pn; if (NN) { ex = pn / NN; pn = pn - ex * NN; }
        const typename E::Pre pr0 = e.pre(u.pm * 256, pn * 256 + wc * 32, 4 * fq, ex), pr1 = e.pre(u.pm * 256, pn * 256 + 128 + wc * 32, 4 * fq, ex);
#pragma unroll
        for (int ai = 0; ai < 2; ++ai)
#pragma unroll
            for (int m = 0; m < 4; ++m) { const int row = u.pm * 256 + ai * 128 + wr * 64 + m * 16 + fr;
                e.four(row, pn * 256 + wc * 32, 4 * fq, acc[ai][0][m][0], acc[ai][0][m][1], ex, pr0); e.four(row, pn * 256 + 128 + wc * 32, 4 * fq, acc[ai][1][m][0], acc[ai][1][m][1], ex, pr1); }
    }
};
struct RepOrder : pg8::StaticOrder { int rep;
    __device__ __forceinline__ bool next(int i, pg8::Unit& u) const { if (rep > 1) { const int R = (nwg + G - 1) / G; if (i >= R * rep) return false; i %= R; } return pg8::StaticOrder::next(i, u); } };
struct EpiQKVFast {
    static constexpr bool PERM = false, AFTER_DRAIN = false;
    bf16 *QA, *KA, *VA, *QB, *KB, *VB; const float* rope;
    __device__ __forceinline__ void operator()(const pg8::f32x4 (&acc)[2][2][4][2], const pg8::Unit& u, int wr, int wc, int fr, int fq) const {
        typedef unsigned u32x2 __attribute__((ext_vector_type(2)));
        bf16* base[2]; int ld[2]; bool isq[2], rp[2], kvr[2], f8[2];
#pragma unroll
        for (int bj = 0; bj < 2; ++bj) { const int cg = u.pn * 256 + bj * 128 + wc * 32; isq[bj] = false; rp[bj] = true; kvr[bj] = true; f8[bj] = true;
            if (cg < 512)       { base[bj] = (bf16*)((unsigned char*)QA + cg); ld[bj] = 512; isq[bj] = true; kvr[bj] = false; }
            else if (cg < 1024) { base[bj] = (bf16*)((unsigned char*)KA + (cg - 512)); ld[bj] = 512; }
            else if (cg < 1536) { base[bj] = (bf16*)((unsigned char*)VA + (cg - 1024)); ld[bj] = 512; rp[bj] = false; }
            else if (cg < 2048) { base[bj] = (bf16*)((unsigned char*)QB + (cg - 1536)); ld[bj] = 512; isq[bj] = true; kvr[bj] = false; }
            else if (cg < 2176) { base[bj] = (bf16*)((unsigned char*)KB + (cg - 2048)); ld[bj] = 128; }
            else                { base[bj] = (bf16*)((unsigned char*)VB + (cg - 2176)); ld[bj] = 128; rp[bj] = false; } }
        const bool colhalf = (wc & 1) != 0;
#pragma unroll
        for (int ai = 0; ai < 2; ++ai)
#pragma unroll
            for (int m = 0; m < 4; ++m) {
                const int row = u.pm * 256 + ai * 128 + wr * 64 + m * 16 + fr; const bool lat = row < NTOK;
                const int b = lat ? (row >> 13) : ((row - NTOK) >> 8);
                const int kvrow = lat ? (b * KVLEN + (row & (SEQ - 1))) : (b * KVLEN + SEQ + ((row - NTOK) & (CTXL - 1)));
                const int t = row & (SEQ - 1), pos = colhalf ? (t & 63) : (t >> 6);
                const f32x4 c0 = *(const f32x4*)(rope + pos * 32 + 8 * fq), c1 = *(const f32x4*)(rope + pos * 32 + 8 * fq + 4);
#pragma unroll
                for (int bj = 0; bj < 2; ++bj) {
                    if (isq[bj] && !lat) continue;
                    f32x4 lo = acc[ai][bj][m][0], hi = acc[ai][bj][m][1];
                    if (rp[bj] && lat) { const f32x4 cs = {c0[0], c0[2], c1[0], c1[2]}, sn = {c0[1], c0[3], c1[1], c1[3]}; const f32x4 nl = lo * cs - hi * sn, nh = hi * cs + lo * sn; lo = nl; hi = nh; }
                    if (isq[bj]) { lo = lo * QSCALE; hi = hi * QSCALE; }
                    const size_t rr = (size_t)(kvr[bj] ? kvrow : row) * ld[bj];
                    if (f8[bj]) { unsigned char* p = (unsigned char*)base[bj] + rr + 4 * fq; *(unsigned*)p = pk4_fp8(lo[0], lo[1], lo[2], lo[3]); *(unsigned*)(p + 16) = pk4_fp8(hi[0], hi[1], hi[2], hi[3]); }
                    else { bf16* p = base[bj] + rr + 4 * fq; *(u32x2*)p = (u32x2){cvtpk(lo[0], lo[1]), cvtpk(lo[2], lo[3])}; *(u32x2*)(p + 16) = (u32x2){cvtpk(hi[0], hi[1]), cvtpk(hi[2], hi[3])}; }
                }
            }
    }
};
template <class E, int NN> struct EpiAdaptP {
    static constexpr bool PERM = true, AFTER_DRAIN = false;
    E e;
    __device__ __forceinline__ void operator()(const pg8::f32x4 (&acc)[2][2][4][2], const pg8::Unit& u, int wr, int wc, int fr, int fq) const {
        int ex = 0, pn = u.pn; if (NN) { ex = pn / NN; pn = pn - ex * NN; }
        const typename E::Pre pr0 = e.pre(u.pm * 256, pn * 256 + wc * 32 + 8 * fq, 0, ex), pr1 = e.pre(u.pm * 256, pn * 256 + 128 + wc * 32 + 8 * fq, 0, ex);
#pragma unroll
        for (int ai = 0; ai < 2; ++ai)
#pragma unroll
            for (int m = 0; m < 4; ++m) { const int row = u.pm * 256 + ai * 128 + wr * 64 + m * 16 + fr;
                e.eight(row, pn * 256 + wc * 32 + 8 * fq, acc[ai][0][m][0], acc[ai][0][m][1], ex, pr0); e.eight(row, pn * 256 + 128 + wc * 32 + 8 * fq, acc[ai][1][m][0], acc[ai][1][m][1], ex, pr1); }
    }
};
struct GroupedOrder {
    int nN, NP, G, c; const LAS int* pexp; int rep; const LAS int* tokT;
    __device__ __forceinline__ int rounds() const { const int upr = G / nN; return (NP + upr - 1) / upr; }
    __device__ __forceinline__ int tok(int ui, int r) const { if (rep > 1) ui %= rounds(); return tokT[ui * 256 + r]; }
    __device__ __forceinline__ bool next(int i, pg8::Unit& u) const {
        int p, j;
        if (rep > 1) { const int R = rounds(); if (i >= R * rep) return false; i %= R; }
        if (G == 256) { const int x = c & 7, r = c >> 3, ppx = 32 / nN; p = i * (8 * ppx) + x * ppx + r / nN; j = r % nN; }
        else { const long L = (long)i * G + c; p = (int)(L / nN); j = (int)(L % nN); }
        if (p >= NP) return false;
        u.pm = p; u.pn = pexp[p] * nN + j; return true;
    }
    __device__ __forceinline__ void a_ready(const pg8::Unit&) const {}
    __device__ __forceinline__ void done(const pg8::Unit&) const {}
};

struct DenseSel { const bf16* Bt; __device__ __forceinline__ const bf16* operator()(int, int& e) const { e = 0; return Bt; } };
struct GroupSel { const bf16* Bt; const LAS int* pexp; int N, K; __device__ __forceinline__ const bf16* operator()(int mt, int& e) const { e = pexp[mt >> 1]; return Bt + (size_t)e * N * K; } };
template <class Epi, class BSel>
__device__ __forceinline__ void naive_gemm(Frame& F, const bf16* A, int Mtiles, int N, int K, const BSel& bs, const Epi& E) {
    LAS float* As = (LAS float*)(F.lds + RING_OFF); LAS float* Bs = As + 128 * 33;
    const int nNt = N / 64, tx = F.tid & 15, ty = F.tid >> 4;
    for (int t = blockIdx.x; t < Mtiles * nNt; t += F.G) {
        const int mt = t / nNt, nt = t % nNt; int e; const bf16* Bt = bs(mt, e);
        float acc[4][4];
#pragma unroll
        for (int r = 0; r < 4; ++r)
#pragma unroll
            for (int j = 0; j < 4; ++j) acc[r][j] = 0.f;
        for (int k0 = 0; k0 < K; k0 += 32) {
            { const int r = F.tid >> 2, kc = (F.tid & 3) * 8; float f[8]; unpack8(*(const v4u*)(A + (size_t)(mt * 128 + r) * K + k0 + kc), f);
#pragma unroll
              for (int i = 0; i < 8; ++i) As[r * 33 + kc + i] = f[i]; }
            if (F.tid < 256) { const int r = F.tid >> 2, kc = (F.tid & 3) * 8; float f[8]; unpack8(*(const v4u*)(Bt + (size_t)(nt * 64 + r) * K + k0 + kc), f);
#pragma unroll
              for (int i = 0; i < 8; ++i) Bs[r * 33 + kc + i] = f[i]; }
            __syncthreads();
#pragma unroll 8
            for (int kk = 0; kk < 32; ++kk) { float a[4], b[4];
#pragma unroll
                for (int r = 0; r < 4; ++r) a[r] = As[(ty * 4 + r) * 33 + kk];
#pragma unroll
                for (int j = 0; j < 4; ++j) b[j] = Bs[(tx + 16 * j) * 33 + kk];
#pragma unroll
                for (int r = 0; r < 4; ++r)
#pragma unroll
                    for (int j = 0; j < 4; ++j) acc[r][j] += a[r] * b[j]; }
            __syncthreads();
        }
#pragma unroll
        for (int r = 0; r < 4; ++r) { const int row = mt * 128 + ty * 4 + r; E.one(row, nt * 64, tx, acc[r][0], acc[r][1], e); E.one(row, nt * 64 + 32, tx, acc[r][2], acc[r][3], e); }
    }
}

template <bool GUPERM>
__device__ __forceinline__ void p0_transpose_item(const float* W, int K, int N, bf16* WT, LAS float* scr, int item, int lane) {
    const int nblk = N / 32, kb = item / nblk, nb = item % nblk, k0 = 64 * kb, n0 = 32 * nb;
    { f32x4 v[8]; const float* wp = W + (size_t)(k0 + (lane >> 3)) * N + n0 + 4 * (lane & 7);
#pragma unroll
      for (int i = 0; i < 8; ++i) v[i] = __builtin_nontemporal_load((const f32x4*)(wp + (size_t)(8 * i) * N));
#pragma unroll
      for (int i = 0; i < 8; ++i) { LAS float* d = scr + (8 * i + (lane >> 3)) * 33 + 4 * (lane & 7); d[0] = v[i].x; d[1] = v[i].y; d[2] = v[i].z; d[3] = v[i].w; } }
    LDS_WAIT(); asm volatile("" ::: "memory");
    const int c = lane & 7;
#pragma unroll
    for (int j = 0; j < 4; ++j) { const int n = (lane >> 3) + 8 * j; const LAS float* s = scr + (8 * c) * 33 + n;
        v4u o; o.x = cvtpk(s[0 * 33], s[1 * 33]); o.y = cvtpk(s[2 * 33], s[3 * 33]); o.z = cvtpk(s[4 * 33], s[5 * 33]); o.w = cvtpk(s[6 * 33], s[7 * 33]);
        const int nd = GUPERM ? ((n & 1) * 16 + (n >> 1)) : n;
        *(GAS v4u*)(WT + (size_t)(n0 + nd) * K + k0 + 8 * c) = o; }
    LDS_WAIT(); asm volatile("" ::: "memory");
}
template <bool GUPERM>
__device__ __forceinline__ void p0_transpose_item_fp8(const float* W, int K, int N, unsigned char* WT, LAS float* scr, int item, int lane) {
    const int nblk = N / 32, kb = item / nblk, nb = item % nblk, k0 = 64 * kb, n0 = 32 * nb;
    { f32x4 v[8]; const float* wp = W + (size_t)(k0 + (lane >> 3)) * N + n0 + 4 * (lane & 7);
#pragma unroll
      for (int i = 0; i < 8; ++i) v[i] = __builtin_nontemporal_load((const f32x4*)(wp + (size_t)(8 * i) * N));
#pragma unroll
      for (int i = 0; i < 8; ++i) { LAS float* d = scr + (8 * i + (lane >> 3)) * 33 + 4 * (lane & 7); d[0] = v[i].x; d[1] = v[i].y; d[2] = v[i].z; d[3] = v[i].w; } }
    LDS_WAIT(); asm volatile("" ::: "memory");
    const int c = lane & 7;
    typedef unsigned u32x2 __attribute__((ext_vector_type(2)));
#pragma unroll
    for (int j = 0; j < 4; ++j) { const int n = (lane >> 3) + 8 * j; const LAS float* s = scr + (8 * c) * 33 + n;
        u32x2 o; o.x = pk4_fp8(s[0 * 33] * 32.f, s[1 * 33] * 32.f, s[2 * 33] * 32.f, s[3 * 33] * 32.f); o.y = pk4_fp8(s[4 * 33] * 32.f, s[5 * 33] * 32.f, s[6 * 33] * 32.f, s[7 * 33] * 32.f);
        const int nd = GUPERM ? ((n & 1) * 16 + (n >> 1)) : n;
        *(GAS u32x2*)(WT + (size_t)(n0 + nd) * K + k0 + 8 * c) = o; }
    LDS_WAIT(); asm volatile("" ::: "memory");
}
struct F8Item { const float* wp; unsigned char* wt; int K; int guperm; };
__device__ __forceinline__ F8Item f8_decode(const Frame& F, int r, int lane) {
    constexpr int I_GU1 = (DM / 64) * (GUW / 32), I_DN1 = (DM / 64) * (DM / 32);
    F8Item I; const float* W; int N, item; unsigned char* WT;
    if (r < NEXP * I_GU1) { const int e = r / I_GU1; item = r % I_GU1; W = F.w_gu + (size_t)e * DM * GUW; N = GUW; WT = (unsigned char*)F.Wgu_t + (size_t)e * GUW * DM; I.guperm = 1; }
    else { r -= NEXP * I_GU1; const int e = r / I_DN1; item = r % I_DN1; W = F.w_dn + (size_t)e * DM * DM; N = DM; WT = (unsigned char*)F.Wdn_t + (size_t)e * DM * DM; I.guperm = 0; }
    const int nblk = N / 32, kb = item / nblk, nb = item % nblk, k0 = 64 * kb, n0 = 32 * nb;
    I.wp = W + (size_t)(k0 + (lane >> 3)) * N + n0 + 4 * (lane & 7); I.K = N;
    I.wt = WT + (size_t)n0 * DM + k0 + 8 * (lane & 7);
    return I;
}
__device__ __forceinline__ void f8_issue(const F8Item& I, f32x4 (&v)[8]) {
#pragma unroll
    for (int i = 0; i < 8; ++i) v[i] = __builtin_nontemporal_load((const f32x4*)(I.wp + (size_t)(8 * i) * I.K));
}
__device__ __forceinline__ void f8_finish(const F8Item& I, f32x4 (&v)[8], LAS float* scr, int lane) {
#pragma unroll
    for (int i = 0; i < 8; ++i) { LAS float* d = scr + (8 * i + (lane >> 3)) * 33 + 4 * (lane & 7); d[0] = v[i].x; d[1] = v[i].y; d[2] = v[i].z; d[3] = v[i].w; }
    LDS_WAIT(); asm volatile("" ::: "memory");
    const int c = lane & 7;
    typedef unsigned u32x2 __attribute__((ext_vector_type(2)));
#pragma unroll
    for (int j = 0; j < 4; ++j) { const int n = (lane >> 3) + 8 * j; const LAS float* s = scr + (8 * c) * 33 + n;
        u32x2 o; o.x = pk4_fp8(s[0 * 33] * 32.f, s[1 * 33] * 32.f, s[2 * 33] * 32.f, s[3 * 33] * 32.f); o.y = pk4_fp8(s[4 * 33] * 32.f, s[5 * 33] * 32.f, s[6 * 33] * 32.f, s[7 * 33] * 32.f);
        const int nd = I.guperm ? ((n & 1) * 16 + (n >> 1)) : n;
        *(GAS u32x2*)(I.wt + (size_t)nd * DM) = o; }
    LDS_WAIT(); asm volatile("" ::: "memory");
}
__device__ __forceinline__ void f8_stream(const Frame& F, LAS float* scr, int r, int rend, int stride) {
    f32x4 va[8], vb[8], vc[8], vd[8]; F8Item Ia, Ib, Ic, Id;
    if (r >= rend) return;
    Ia = f8_decode(F, r, F.lane); f8_issue(Ia, va);
    if (r + stride < rend) { Ib = f8_decode(F, r + stride, F.lane); f8_issue(Ib, vb); }
    if (r + 2 * stride < rend) { Ic = f8_decode(F, r + 2 * stride, F.lane); f8_issue(Ic, vc); }
#define F8_STEP(CI, CV, NI, NV) { const int nx3 = r + 3 * stride; if (nx3 < rend) { NI = f8_decode(F, nx3, F.lane); f8_issue(NI, NV); } f8_finish(CI, CV, scr, F.lane); r += stride; if (r >= rend) break; }
    while (true) { F8_STEP(Ia, va, Id, vd) F8_STEP(Ib, vb, Ia, va) F8_STEP(Ic, vc, Ib, vb) F8_STEP(Id, vd, Ic, vc) }
#undef F8_STEP
}
__device__ __forceinline__ void p0_item(Frame& F, LAS float* sil, LAS float* scr, int it) {
    constexpr int I_IN = (DM / 64) * (INC / 32), I_OUT = (DM / 64) * (DM / 32), I_GU1 = (DM / 64) * (GUW / 32), I_DN1 = (DM / 64) * (DM / 32);

        int r = it;
#if QKV_FP8
        if (r < I_IN) { p0_transpose_item_fp8<false>(F.w_in, DM, INC, (unsigned char*)F.Win_t, scr, r, F.lane); return; } r -= I_IN;
#else
        if (r < I_IN) { p0_transpose_item<false>(F.w_in, DM, INC, F.Win_t, scr, r, F.lane); return; } r -= I_IN;
#endif
        if (r < I_OUT) { p0_transpose_item<false>(F.w_out, DM, DM, F.Wout_t, scr, r, F.lane); return; } r -= I_OUT;
        if (r < NEXP * I_GU1) { const int e = r / I_GU1; p0_transpose_item_fp8<true>(F.w_gu + (size_t)e * DM * GUW, DM, GUW, (unsigned char*)F.Wgu_t + (size_t)e * GUW * DM, scr, r % I_GU1, F.lane); return; } r -= NEXP * I_GU1;
        { const int e = r / I_DN1; p0_transpose_item_fp8<false>(F.w_dn + (size_t)e * DM * DM, DM, DM, (unsigned char*)F.Wdn_t + (size_t)e * DM * DM, scr, r % I_DN1, F.lane); }
}
constexpr int P0_NITEMS = (DM / 64) * (INC / 32) + (DM / 64) * (DM / 32) + NEXP * (DM / 64) * (GUW / 32) + NEXP * (DM / 64) * (DM / 32);
#ifndef P2_TAIL_ITEMS
#define P2_TAIL_ITEMS 44000
#endif
#ifndef P2_GEMM_WGS_N
#define P2_GEMM_WGS_N 120
#endif
constexpr int P2_GEMM_WGS = P2_GEMM_WGS_N;
constexpr int P0_SPLIT = P0_NITEMS - P2_TAIL_ITEMS;
__device__ __forceinline__ void p0_tail(Frame& F) {
    LAS float* scr = (LAS float*)(F.lds + RING_OFF + F.wave * 16384);
    const int w = ((int)blockIdx.x - P2_GEMM_WGS) * NWAVES + F.wave, NW = (F.G - P2_GEMM_WGS) * NWAVES;
    constexpr int NPRE = (DM / 64) * (INC / 32) + (DM / 64) * (DM / 32);
    f8_stream(F, scr, P0_SPLIT - NPRE + w, P0_NITEMS - NPRE, NW);
}
__device__ __forceinline__ void p0_prologue(Frame& F) {
    LAS float* sil = (LAS float*)(F.lds + XTRA_OFF);
    for (int i = F.tid; i < 3072; i += 512) { const int v = i >> 10, k = i & 1023; const float cv = (v < 2) ? F.c[v * 1024 + k] : F.c_ctx[k]; sil[i] = cv / (1.f + __expf(-cv)); }
    __syncthreads();
    const int gw = F.vcu * NWAVES + F.wave, NGW = F.G * NWAVES;
    if (blockIdx.x == 0) for (int i = F.tid; i < 2048; i += 512) { const int pos = i >> 4, j = i & 15; double cr = 1.0, sr = 0.0, cb = ROPE_CS[2 * j], sb = ROPE_CS[2 * j + 1];
        for (int bit = 0; bit < 7; ++bit) { if ((pos >> bit) & 1) { const double t = cr * cb - sr * sb; sr = cr * sb + sr * cb; cr = t; } const double t2 = cb * cb - sb * sb; sb = 2.0 * cb * sb; cb = t2; }
        F.rope[2 * i] = (float)cr; F.rope[2 * i + 1] = (float)sr; }
    for (int r = F.vcu; r < 24 * MODP_KC; r += F.G) {
        const int nb = r % 24, kc = r / 24, n = nb * 256 + F.lane * 4, kbase = kc * 128 + F.wave * 16;
        f32x4 a0 = {0.f, 0.f, 0.f, 0.f}, a1 = a0, a2 = a0;
        const float* wp = F.w_mod + (size_t)kbase * 6144 + n;
#pragma unroll
        for (int kk = 0; kk < 16; ++kk) { const f32x4 w = __builtin_nontemporal_load((const f32x4*)(wp + (size_t)kk * 6144)); const int k = kbase + kk; a0 += w * sil[k]; a1 += w * sil[1024 + k]; a2 += w * sil[2048 + k]; }
        LAS float* red = (LAS float*)(F.lds + RING_OFF);
        *(LAS f32x4*)(red + (F.wave * 3 + 0) * 256 + 4 * F.lane) = a0; *(LAS f32x4*)(red + (F.wave * 3 + 1) * 256 + 4 * F.lane) = a1; *(LAS f32x4*)(red + (F.wave * 3 + 2) * 256 + 4 * F.lane) = a2;
        __syncthreads();
        for (int i = F.tid; i < 768; i += 512) { float t = 0.f;
#pragma unroll
            for (int w = 0; w < NWAVES; ++w) t += red[w * 768 + i];
            F.modp[(size_t)(kc * 3 + i / 256) * 6144 + nb * 256 + (i % 256)] = t; }
        __syncthreads();
    }
    LAS float* scr = (LAS float*)(F.lds + RING_OFF + F.wave * 16384);
    constexpr int I_IN = (DM / 64) * (INC / 32), I_OUT = (DM / 64) * (DM / 32), I_GU1 = (DM / 64) * (GUW / 32), I_DN1 = (DM / 64) * (DM / 32);
    constexpr int NITEMS = I_IN + I_OUT + NEXP * I_GU1 + NEXP * I_DN1;
    const int nsplit = (F.G == 256) ? P0_SPLIT : NITEMS;
    constexpr int NPRE = I_IN + I_OUT;
    int it0 = gw;
    if (NPRE > NGW) { for (; it0 < NPRE; it0 += NGW) p0_item(F, sil, scr, it0); } else if (it0 < NPRE) { p0_item(F, sil, scr, it0); it0 += NGW; }
    f8_stream(F, scr, it0 - NPRE, nsplit - NPRE, NGW);
}
__device__ __forceinline__ void p1_norm(Frame& F) {
    LAS float* ml = (LAS float*)(F.lds + RING_OFF);
    for (int i0 = F.tid; i0 < 6144; i0 += 2048) { float pv[4][MODP_KC], bv[4];
#pragma unroll
        for (int q = 0; q < 4; ++q) { const int i = i0 + 512 * q, v = i / 2048, j = i % 2048; bv[q] = F.b_mod[j];
#pragma unroll
            for (int kc = 0; kc < MODP_KC; ++kc) pv[q][kc] = F.modp[(size_t)(kc * 3 + v) * 6144 + j]; }
#pragma unroll
        for (int q = 0; q < 4; ++q) { float t = bv[q];
#pragma unroll
            for (int kc = 0; kc < MODP_KC; ++kc) t += pv[q][kc];
            ml[i0 + 512 * q] = t; } }
    for (int gi = blockIdx.x * 512 + F.tid; gi < 3 * 6144; gi += F.G * 512) { const int v = gi / 6144, j = gi % 6144; float s = F.b_mod[j];
        for (int kc = 0; kc < MODP_KC; ++kc) s += F.modp[(size_t)(kc * 3 + v) * 6144 + j]; F.modv[gi] = s; }
    __syncthreads();
    const int gw = F.vcu * NWAVES + F.wave, NGW = F.G * NWAVES;
    typedef unsigned u32x2 __attribute__((ext_vector_type(2)));
    for (int pp = gw; pp < (NROW / 2) * RP(F, 1); pp += NGW) { const int m0 = (pp % (NROW / 2)) * 2;
        f32x4 xv[2][4]; float s[2] = {0.f, 0.f}; int v[2];
#pragma unroll
        for (int q = 0; q < 2; ++q) { const int m = m0 + q; v[q] = m < SEQ ? 0 : (m < NTOK ? 1 : 2);
            const float* src = m < NTOK ? F.x + (size_t)m * DM : F.ctx + (size_t)(m - NTOK) * DM;
#pragma unroll
            for (int j = 0; j < 4; ++j) xv[q][j] = __builtin_nontemporal_load((const f32x4*)(src + 4 * F.lane + 256 * j)); }
#pragma unroll
        for (int q = 0; q < 2; ++q)
#pragma unroll
            for (int j = 0; j < 4; ++j) s[q] += (xv[q][j].x * xv[q][j].x + xv[q][j].y * xv[q][j].y) + (xv[q][j].z * xv[q][j].z + xv[q][j].w * xv[q][j].w);
#pragma unroll
        for (int q = 0; q < 2; ++q) { const int m = m0 + q; const float rstd = 1.0f / sqrtf(wave_sum(s[q]) * (1.f / DM) + NORM_EPS);
#pragma unroll
            for (int j = 0; j < 4; ++j) { const int col = 4 * F.lane + 256 * j; const f32x4 g = *(const f32x4*)(F.norm1_g + col);
                const f32x4 sh = *(const LAS f32x4*)(ml + v[q] * 2048 + col), sc = *(const LAS f32x4*)(ml + v[q] * 2048 + 1024 + col);
                const f32x4 y = (xv[q][j] * rstd * g) * (sc + 1.0f) + sh;
#if QKV_FP8
                *(unsigned*)((unsigned char*)F.XN + (size_t)m * DM + col) = pk4_fp8(y.x, y.y, y.z, y.w); } }
#else
                *(u32x2*)(F.XN + (size_t)m * DM + col) = (u32x2){cvtpk(y.x, y.y), cvtpk(y.z, y.w)}; } }
#endif
    }
}

__device__ __forceinline__ float lam_value(Frame& F) {
    const float a = wave_sum(F.lq1[F.lane] * F.lk1[F.lane]), b = wave_sum(F.lq2[F.lane] * F.lk2[F.lane]);
    return __expf(a) - __expf(b) + 0.2f;
}
__device__ __forceinline__ void naive_diff_attn(Frame& F) {
    const float lam = lam_value(F);
    LAS float* X = (LAS float*)(F.lds + RING_OFF);
    LAS float* SS = X + 128 * 128;
    const int q = F.tid & 127, comp = (F.tid >> 7) & 1, vh = F.tid >> 8;
    for (int it = blockIdx.x; it < BATCH * 4 * (SEQ / 128); it += F.G) {
        const int b = it >> 8, h = (it >> 6) & 3, qb = it & 63; const int row = b * SEQ + qb * 128 + q;
        float qv[64], o[64];
#pragma unroll
        for (int c8 = 0; c8 < 8; ++c8) unpack8(*(const v4u*)(F.QA + (size_t)row * 512 + h * 128 + comp * 64 + c8 * 8), qv + 8 * c8);
#pragma unroll
        for (int e = 0; e < 64; ++e) o[e] = 0.f;
        float m = -1e30f, l = 0.f;
        const bf16* kp = F.KA + (size_t)(b * KVLEN) * 512 + h * 128 + comp * 64; const bf16* vp = F.VA + (size_t)(b * KVLEN) * 512 + h * 128 + vh * 64;
        for (int key = 0; key < KVLEN; ++key) {
            float s = 0.f;
#pragma unroll
            for (int c8 = 0; c8 < 8; ++c8) { float kf[8]; unpack8(*(const v4u*)(kp + (size_t)key * 512 + c8 * 8), kf);
#pragma unroll
                for (int i = 0; i < 8; ++i) s += qv[8 * c8 + i] * kf[i]; }
            if (s > m) { const float a = exp2f(m - s); l *= a;
#pragma unroll
                for (int e = 0; e < 64; ++e) o[e] *= a;
                m = s; }
            const float p = exp2f(s - m); l += p;
#pragma unroll
            for (int c8 = 0; c8 < 8; ++c8) { float vf[8]; unpack8(*(const v4u*)(vp + (size_t)key * 512 + c8 * 8), vf);
#pragma unroll
                for (int i = 0; i < 8; ++i) o[8 * c8 + i] += p * vf[i]; }
        }
        const float inv = 1.0f / l;
        __syncthreads();
        if (comp == 1) {
#pragma unroll
            for (int e = 0; e < 64; ++e) X[(vh * 64 + e) * 128 + q] = lam * o[e] * inv; }
        __syncthreads();
        if (comp == 0) { float ss = 0.f;
#pragma unroll
            for (int e = 0; e < 64; ++e) { o[e] = o[e] * inv - X[(vh * 64 + e) * 128 + q]; ss += o[e] * o[e]; }
            SS[vh * 128 + q] = ss; }
        __syncthreads();
        if (comp == 0) { const float r = 0.8f / sqrtf((SS[q] + SS[128 + q]) * (1.f / 128.f) + NORM_EPS);
            bf16* yp = F.Y + (size_t)row * DM + h * 128 + vh * 64; const float* sg = F.subln_g + vh * 64;
#pragma unroll
            for (int c8 = 0; c8 < 8; ++c8) { v4u w; w.x = cvtpk(o[8 * c8] * r * sg[8 * c8], o[8 * c8 + 1] * r * sg[8 * c8 + 1]); w.y = cvtpk(o[8 * c8 + 2] * r * sg[8 * c8 + 2], o[8 * c8 + 3] * r * sg[8 * c8 + 3]);
                w.z = cvtpk(o[8 * c8 + 4] * r * sg[8 * c8 + 4], o[8 * c8 + 5] * r * sg[8 * c8 + 5]); w.w = cvtpk(o[8 * c8 + 6] * r * sg[8 * c8 + 6], o[8 * c8 + 7] * r * sg[8 * c8 + 7]);
                *(v4u*)(yp + 8 * c8) = w; } }
    }
}
__device__ __forceinline__ void naive_win_attn(Frame& F) {
    for (int it = blockIdx.x; it < BATCH * 8 * (SEQ / 512); it += F.G) {
        const int b = it >> 7, h = (it >> 4) & 7, t = (it & 15) * 512 + F.tid, kv = h >> 2; const int row = b * SEQ + t;
        float qv[64], o[64];
#pragma unroll
        for (int c8 = 0; c8 < 8; ++c8) unpack8(*(const v4u*)(F.QB + (size_t)row * 512 + h * 64 + c8 * 8), qv + 8 * c8);
#pragma unroll
        for (int e = 0; e < 64; ++e) o[e] = 0.f;
        float m = F.sink[h] * LOG2E, l = 1.0f;
        const bf16* kp = F.KB + (size_t)(b * KVLEN) * 128 + kv * 64; const bf16* vp = F.VB + (size_t)(b * KVLEN) * 128 + kv * 64;
        for (int jj = 0; jj < 257 + CTXL; ++jj) {
            const int key = jj < 257 ? t - 128 + jj : SEQ + (jj - 257);
            if (jj < 257 && (key < 0 || key >= SEQ)) continue;
            float s = 0.f;
#pragma unroll
            for (int c8 = 0; c8 < 8; ++c8) { float kf[8]; unpack8(*(const v4u*)(kp + (size_t)key * 128 + c8 * 8), kf);
#pragma unroll
                for (int i = 0; i < 8; ++i) s += qv[8 * c8 + i] * kf[i]; }
            if (s > m) { const float a = exp2f(m - s); l *= a;
#pragma unroll
                for (int e = 0; e < 64; ++e) o[e] *= a;
                m = s; }
            const float p = exp2f(s - m); l += p;
#pragma unroll
            for (int c8 = 0; c8 < 8; ++c8) { float vf[8]; unpack8(*(const v4u*)(vp + (size_t)key * 128 + c8 * 8), vf);
#pragma unroll
                for (int i = 0; i < 8; ++i) o[8 * c8 + i] += p * vf[i]; }
        }
        const float inv = 1.0f / l; bf16* yp = F.Y + (size_t)row * DM + 512 + h * 64;
#pragma unroll
        for (int c8 = 0; c8 < 8; ++c8) { v4u w; w.x = cvtpk(o[8 * c8] * inv, o[8 * c8 + 1] * inv); w.y = cvtpk(o[8 * c8 + 2] * inv, o[8 * c8 + 3] * inv); w.z = cvtpk(o[8 * c8 + 4] * inv, o[8 * c8 + 5] * inv); w.w = cvtpk(o[8 * c8 + 6] * inv, o[8 * c8 + 7] * inv);
            *(v4u*)(yp + 8 * c8) = w; }
    }
}

#ifndef ATT_PP
#define ATT_PP 3
#endif
constexpr size_t WIN_VT_OFF = 16u << 20;
__device__ __forceinline__ void vt_item(const unsigned char* src, int rstride, unsigned char* drow0, int tile, int dg, int half) {
        unsigned outw[4][8];
#pragma unroll
        for (int i8 = 0; i8 < 8; ++i8) { const int kg = 8 * half + i8;
            const unsigned w0 = *(const unsigned*)(src + (size_t)(4 * kg + 0) * rstride), w1 = *(const unsigned*)(src + (size_t)(4 * kg + 1) * rstride), w2 = *(const unsigned*)(src + (size_t)(4 * kg + 2) * rstride), w3 = *(const unsigned*)(src + (size_t)(4 * kg + 3) * rstride);
            const unsigned a01 = __builtin_amdgcn_perm(w1, w0, 0x05010400u), c01 = __builtin_amdgcn_perm(w1, w0, 0x07030602u);
            const unsigned a23 = __builtin_amdgcn_perm(w3, w2, 0x05010400u), c23 = __builtin_amdgcn_perm(w3, w2, 0x07030602u);
            const int slot = ((i8 >> 1) & 3) + 4 * (i8 & 1);
            outw[0][slot] = __builtin_amdgcn_perm(a23, a01, 0x05040100u); outw[1][slot] = __builtin_amdgcn_perm(a23, a01, 0x07060302u);
            outw[2][slot] = __builtin_amdgcn_perm(c23, c01, 0x05040100u); outw[3][slot] = __builtin_amdgcn_perm(c23, c01, 0x07060302u); }
#pragma unroll
        for (int i = 0; i < 4; ++i) { unsigned char* dst = drow0 + (size_t)i * KVLEN + tile * 64 + 16 * half;
            *(v4u*)dst = (v4u){outw[i][0], outw[i][1], outw[i][2], outw[i][3]}; *(v4u*)(dst + 32) = (v4u){outw[i][4], outw[i][5], outw[i][6], outw[i][7]}; }
}
__device__ __forceinline__ void p3_vt_pass(Frame& F) {
    const unsigned char* V8 = (const unsigned char*)F.VA; unsigned char* VT8 = (unsigned char*)F.XG;
    const unsigned char* VB8 = (const unsigned char*)F.VB; unsigned char* VBT8 = (unsigned char*)F.XG + WIN_VT_OFF;
    const int gw = F.vcu * NWAVES + F.wave, NGW = F.G * NWAVES, dg = F.lane & 31, half = F.lane >> 5;
    constexpr int NTL = KVLEN / 64;
    for (int it = gw; it < 10 * NTL; it += NGW) {
        if (it < 8 * NTL) { const int bh = it / NTL, tile = it % NTL, b = bh >> 2, h = bh & 3;
            vt_item(V8 + ((size_t)(b * KVLEN + tile * 64)) * 512 + h * 128 + 4 * dg, 512, VT8 + ((size_t)(bh * 128 + 4 * dg)) * KVLEN, tile, dg, half); }
        else { const int b = (it - 8 * NTL) / NTL, tile = it % NTL;
            vt_item(VB8 + ((size_t)(b * KVLEN + tile * 64)) * 128 + 4 * dg, 128, VBT8 + ((size_t)(b * 128 + 4 * dg)) * KVLEN, tile, dg, half); }
    }
}
__device__ __forceinline__ void diff_unit(Frame& F, int b, int h, int qb, float lam) {
    using namespace at2;
    const int wid = F.wave, lane = F.lane, r32 = lane & 31, hi = lane >> 5, qblk = wid >> 1, comp = wid & 1;
    const int row0 = b * SEQ + qb * 128 + qblk * 32;
    UnitArgs8 a; a.Q = (const unsigned char*)F.QA + (size_t)row0 * 512 + h * 128 + comp * 64;
    a.K = (const unsigned char*)F.KA + (size_t)(b * KVLEN) * 512 + h * 128; a.VT = (const unsigned char*)F.XG + (size_t)((b * 4 + h) * 128) * KVLEN; a.comp = comp; a.ldk = 512; a.vdoff = 0; a.q0 = 0; a.ks = 0;
    f32x16 o[4]; o[0] = f32x16{}; o[1] = f32x16{}; o[2] = f32x16{}; o[3] = f32x16{};
    float m; f32x16 ol = f32x16{};
    AT_LAS char* lds = (AT_LAS char*)F.lds;
    attn_tiles_f8<true>(a, lds, F.tid, wid, lane, o, ol, m);
    float rli[16];
#pragma unroll
    for (int r = 0; r < 16; ++r) rli[r] = __builtin_amdgcn_rcpf(ol[r]);
    __syncthreads();
    AT_LAS float* XD = (AT_LAS float*)lds + qblk * 32 * XROW;
    if (comp == 1) {
#pragma unroll
        for (int r = 0; r < 16; ++r)
#pragma unroll
            for (int d0 = 0; d0 < 4; ++d0) XD[crow(r, hi) * XROW + d0 * 32 + r32] = lam * (o[d0][r] * rli[r]); }
    __syncthreads();
    if (comp == 0) {
#pragma unroll
        for (int r = 0; r < 16; ++r)
#pragma unroll
            for (int d0 = 0; d0 < 4; ++d0) { const int idx = crow(r, hi) * XROW + d0 * 32 + r32; XD[idx] = o[d0][r] * rli[r] - XD[idx]; }
        asm volatile("s_waitcnt lgkmcnt(0)" ::: "memory");
        const int row = lane >> 1, half = lane & 1;
        f32x4 v[16]; float ss = 0.f;
#pragma unroll
        for (int i = 0; i < 16; ++i) { v[i] = *(const AT_LAS f32x4*)(XD + row * XROW + half * 64 + 4 * i); ss += (v[i].x * v[i].x + v[i].y * v[i].y) + (v[i].z * v[i].z + v[i].w * v[i].w); }
        ss += __shfl_xor(ss, 1);
        const float rs = 0.8f / sqrtf(ss * (1.f / 128.f) + NORM_EPS);
        bf16* yp = F.Y + (size_t)(row0 + row) * DM + h * 128 + half * 64; const float* sg = F.subln_g + half * 64;
#pragma unroll
        for (int c8 = 0; c8 < 8; ++c8) { const f32x4 g0 = *(const f32x4*)(sg + 8 * c8), g1 = *(const f32x4*)(sg + 8 * c8 + 4); const f32x4 x0 = v[2 * c8] * rs * g0, x1 = v[2 * c8 + 1] * rs * g1;
            v4u w; w.x = cvtpk(x0.x, x0.y); w.y = cvtpk(x0.z, x0.w); w.z = cvtpk(x1.x, x1.y); w.w = cvtpk(x1.z, x1.w); *(v4u*)(yp + 8 * c8) = w; }
    }
    __syncthreads();
}
__device__ __forceinline__ void win_unit(Frame& F, int b, int j32) {
    using namespace at2;
    const int wid = F.wave, lane = F.lane, r32 = lane & 31, hi = lane >> 5, h = wid, kv = h >> 2;
    const int t0 = 32 * j32, row0 = b * SEQ + t0;
    UnitArgs8 a; a.Q = (const unsigned char*)F.QB + (size_t)row0 * 512 + h * 64;
    a.K = (const unsigned char*)F.KB + (size_t)(b * KVLEN) * 128; a.VT = (const unsigned char*)F.XG + WIN_VT_OFF + (size_t)(b * 128) * KVLEN; a.comp = kv; a.ldk = 128; a.vdoff = kv * 4096; a.q0 = t0;
    { const int st = t0 - 128; int ks = st < 0 ? 0 : (st & ~63); if (ks > SEQ - 384) ks = SEQ - 384; a.ks = ks; }
    f32x16 o[2]; o[0] = f32x16{}; o[1] = f32x16{};
    float m; f32x16 ol = f32x16{};
    AT_LAS char* lds = (AT_LAS char*)F.lds;
    attn_tiles_f8<false>(a, lds, F.tid, wid, lane, o, ol, m);
    AT_LAS float* li_l = (AT_LAS float*)(lds + AT_WS3_OFF) + wid * 64;
    if (hi == 0) li_l[r32] = __builtin_amdgcn_exp2f(F.sink[h] * LOG2E - m);
    asm volatile("s_waitcnt lgkmcnt(0)" ::: "memory");
    float rli[16];
#pragma unroll
    for (int r = 0; r < 16; ++r) rli[r] = __builtin_amdgcn_rcpf(ol[r] + li_l[crow(r, hi)]);
    __syncthreads();
    AT_LAS float* XD = (AT_LAS float*)lds + wid * 32 * XROWW;
#pragma unroll
    for (int r = 0; r < 16; ++r)
#pragma unroll
        for (int d0 = 0; d0 < 2; ++d0) XD[crow(r, hi) * XROWW + d0 * 32 + r32] = o[d0][r] * rli[r];
    asm volatile("s_waitcnt lgkmcnt(0)" ::: "memory");
    const int row = lane >> 1, half = lane & 1;
    bf16* yp = F.Y + (size_t)(row0 + row) * DM + 512 + h * 64 + half * 32;
#pragma unroll
    for (int c8 = 0; c8 < 4; ++c8) { const f32x4 x0 = *(const AT_LAS f32x4*)(XD + row * XROWW + half * 32 + 8 * c8), x1 = *(const AT_LAS f32x4*)(XD + row * XROWW + half * 32 + 8 * c8 + 4);
        v4u w; w.x = cvtpk(x0.x, x0.y); w.y = cvtpk(x0.z, x0.w); w.z = cvtpk(x1.x, x1.y); w.w = cvtpk(x1.z, x1.w); *(v4u*)(yp + 8 * c8) = w; }
    __syncthreads();
}
__device__ __forceinline__ void p3_attention(Frame& F) {
    const float lam = lam_value(F);
#ifndef NO_DIFF
#pragma unroll 1
    for (int U = F.vcu * 2; U < BATCH * 4 * (SEQ / 128) * RP(F, 3); U += 2 * F.G)
#pragma unroll 1
        for (int i = 0; i < 2; ++i) { const int u = (U + i) % 512; diff_unit(F, u >> 8, (u >> 6) & 3, u & 63, lam); }
#endif
#ifndef NO_WIN
#pragma unroll 1
    for (int W = F.vcu * 2; W < BATCH * (SEQ / 32) * RP(F, 3); W += 2 * F.G)
#pragma unroll 1
        for (int i = 0; i < 2; ++i) { const int w = (W + i) % 512; win_unit(F, w >> 8, w & 255); }
#endif
}

__device__ __forceinline__ unsigned long long wave_max64(unsigned long long k) {
#pragma unroll
    for (int o = 1; o < 64; o <<= 1) { const unsigned lo = __shfl_xor((unsigned)k, o), hi = __shfl_xor((unsigned)(k >> 32), o); const unsigned long long t = ((unsigned long long)hi << 32) | lo; k = t > k ? t : k; }
    return k;
}
__device__ __forceinline__ void p5a_route(Frame& F) {
    const int npass = RP(F, 5);
    LAS unsigned char* WH = F.lds + RING_OFF; LAS unsigned char* WL = WH + 65536;
    LAS int* lcnt = (LAS int*)(F.lds + XTRA_OFF); LAS int* lbase = lcnt + 32; LAS int* le = lcnt + 64; LAS int* lrk = le + 256;
    LAS float* cpart = (LAS float*)(F.lds + XTRA_OFF + 2560);
    LAS float* cvec = cpart + 512;
    LAS float* ssqx = cvec + 32;
    LAS float* pl = (LAS float*)(F.lds + RING_OFF);
    LAS float* gash = (LAS float*)(F.lds + RING_OFF + 16384);
    gu32* gcnt = F.ctl + CW_CNT;
    typedef unsigned u32x2 __attribute__((ext_vector_type(2))); typedef unsigned u32x4 __attribute__((ext_vector_type(4))); typedef short bf16x8 __attribute__((ext_vector_type(8)));
    const bf16* YG = (const bf16*)((const unsigned char*)F.XG + 32 * MiB);
    const int m = F.lane & 15, kg = F.lane >> 4, rb = F.wave & 3, kh = F.wave >> 2;
    for (int cc = blockIdx.x; cc < (NTOK / 64) * npass; cc += F.G) { const int chunk = cc % (NTOK / 64); const bool dry = cc < (NTOK / 64) * (npass - 1);
        const int b = (chunk * 64) >> 13; const float* mv = F.modv + b * 6144;
        __syncthreads();
        if (F.tid < 32) lcnt[F.tid] = 0;
        {
            const int e = F.tid & 31, q = F.tid >> 5; float csum = 0.f;
#pragma unroll 2
            for (int i = 0; i < 8; ++i) { const int kgrp = q + 16 * i, k0 = 8 * kgrp; float w[8];
#pragma unroll
                for (int j = 0; j < 8; ++j) w[j] = F.w_router[(k0 + j) * 32 + e];
                const f32x4 g0 = *(const f32x4*)(F.norm2_g + k0), g1 = *(const f32x4*)(F.norm2_g + k0 + 4), s0 = *(const f32x4*)(mv + 4096 + k0), s1 = *(const f32x4*)(mv + 4096 + k0 + 4);
                const f32x4 h0 = *(const f32x4*)(mv + 3072 + k0), h1 = *(const f32x4*)(mv + 3072 + k0 + 4);
                const f32x4 ga0 = g0 * (s0 + 1.0f), ga1 = g1 * (s1 + 1.0f);
                const float ga[8] = {ga0.x, ga0.y, ga0.z, ga0.w, ga1.x, ga1.y, ga1.z, ga1.w}, sh[8] = {h0.x, h0.y, h0.z, h0.w, h1.x, h1.y, h1.z, h1.w};
                unsigned hp[4], lp[4];
#pragma unroll
                for (int j = 0; j < 4; ++j) { const float a0 = w[2 * j] * ga[2 * j], a1 = w[2 * j + 1] * ga[2 * j + 1]; hp[j] = cvtpk(a0, a1); lp[j] = cvtpk(a0 - bflo(hp[j]), a1 - bfhi(hp[j])); }
#pragma unroll
                for (int j = 0; j < 8; ++j) csum += sh[j] * w[j];
                const int off = e * 2048 + ((kgrp ^ (e & 15)) << 4);
                *(LAS u32x4*)(WH + off) = (u32x4){hp[0], hp[1], hp[2], hp[3]}; *(LAS u32x4*)(WL + off) = (u32x4){lp[0], lp[1], lp[2], lp[3]}; }
            cpart[q * 32 + e] = csum; }
        __syncthreads();
        if (F.tid < 32) { float c = F.b_router[F.tid];
#pragma unroll
            for (int q = 0; q < 16; ++q) c += cpart[q * 32 + F.tid];
            cvec[F.tid] = c; }
        const int r = chunk * 64 + rb * 16 + m; const size_t rowoff = (size_t)r * DM;
        f32x4 acc0 = {0.f, 0.f, 0.f, 0.f}, acc1 = acc0; float ssq = 0.f;
        const int wrow0 = m * 2048, wrow1 = (m + 16) * 2048;
#pragma unroll 4
        for (int s_ = 0; s_ < 16; ++s_) { const int ks = 16 * kh + s_, k0 = 32 * ks + 8 * kg;
            const f32x4 xa = __builtin_nontemporal_load((const f32x4*)(F.x + rowoff + k0)), xb = __builtin_nontemporal_load((const f32x4*)(F.x + rowoff + k0 + 4)); const u32x4 yy = *(const u32x4*)(YG + rowoff + k0);
            const float x1[8] = {xa.x + bflo(yy.x), xa.y + bfhi(yy.x), xa.z + bflo(yy.y), xa.w + bfhi(yy.y), xb.x + bflo(yy.z), xb.y + bfhi(yy.z), xb.z + bflo(yy.w), xb.w + bfhi(yy.w)};
            unsigned hp[4], lp[4];
#pragma unroll
            for (int j = 0; j < 4; ++j) { hp[j] = cvtpk(x1[2 * j], x1[2 * j + 1]); lp[j] = cvtpk(x1[2 * j] - bflo(hp[j]), x1[2 * j + 1] - bfhi(hp[j])); ssq += x1[2 * j] * x1[2 * j] + x1[2 * j + 1] * x1[2 * j + 1]; }
            const u32x4 hv = {hp[0], hp[1], hp[2], hp[3]}, lv = {lp[0], lp[1], lp[2], lp[3]};
            *(u32x4*)((bf16*)F.X1 + rowoff + k0) = hv;
            const int sw = ((4 * ks + kg) ^ m) << 4;
            const bf16x8 bh0 = *(const LAS bf16x8*)(WH + wrow0 + sw), bh1 = *(const LAS bf16x8*)(WH + wrow1 + sw), bl0 = *(const LAS bf16x8*)(WL + wrow0 + sw), bl1 = *(const LAS bf16x8*)(WL + wrow1 + sw);
            const bf16x8 ah = __builtin_bit_cast(bf16x8, hv), al = __builtin_bit_cast(bf16x8, lv);
            acc0 = __builtin_amdgcn_mfma_f32_16x16x32_bf16(ah, bh0, acc0, 0, 0, 0); acc1 = __builtin_amdgcn_mfma_f32_16x16x32_bf16(ah, bh1, acc1, 0, 0, 0);
            acc0 = __builtin_amdgcn_mfma_f32_16x16x32_bf16(ah, bl0, acc0, 0, 0, 0); acc1 = __builtin_amdgcn_mfma_f32_16x16x32_bf16(ah, bl1, acc1, 0, 0, 0);
            acc0 = __builtin_amdgcn_mfma_f32_16x16x32_bf16(al, bh0, acc0, 0, 0, 0); acc1 = __builtin_amdgcn_mfma_f32_16x16x32_bf16(al, bh1, acc1, 0, 0, 0); }
        ssq += __shfl_xor(ssq, 16); ssq += __shfl_xor(ssq, 32);
        __syncthreads();
#pragma unroll
        for (int i = 0; i < 4; ++i) { const int row = rb * 16 + 4 * kg + i; pl[(kh * 64 + row) * 32 + m] = acc0[i]; pl[(kh * 64 + row) * 32 + 16 + m] = acc1[i]; }
        if (kg == 0) ssqx[kh * 64 + rb * 16 + m] = ssq;
        { const int k = 2 * F.tid; const float ga0 = F.norm2_g[k] * (mv[4096 + k] + 1.0f), ga1 = F.norm2_g[k + 1] * (mv[4096 + k + 1] + 1.0f); gash[k] = ga0; gash[k + 1] = ga1; gash[1024 + k] = mv[3072 + k]; gash[1024 + k + 1] = mv[3072 + k + 1]; }
        __syncthreads();
        { const float rstd = 1.0f / sqrtf((ssqx[rb * 16 + m] + ssqx[64 + rb * 16 + m]) * (1.f / DM) + NORM_EPS);
#pragma unroll 4
          for (int s_ = 0; s_ < 16; ++s_) { const int k0 = 32 * (16 * kh + s_) + 8 * kg; const u32x4 hv = *(const u32x4*)((const bf16*)F.X1 + rowoff + k0);
              const f32x4 ga0 = *(const LAS f32x4*)(gash + k0), ga1 = *(const LAS f32x4*)(gash + k0 + 4), sh0 = *(const LAS f32x4*)(gash + 1024 + k0), sh1 = *(const LAS f32x4*)(gash + 1024 + k0 + 4);
              const unsigned o0 = pk4_fp8((bflo(hv.x) * rstd) * ga0.x + sh0.x, (bfhi(hv.x) * rstd) * ga0.y + sh0.y, (bflo(hv.y) * rstd) * ga0.z + sh0.z, (bfhi(hv.y) * rstd) * ga0.w + sh0.w);
              const unsigned o1 = pk4_fp8((bflo(hv.z) * rstd) * ga1.x + sh1.x, (bfhi(hv.z) * rstd) * ga1.y + sh1.y, (bflo(hv.w) * rstd) * ga1.z + sh1.z, (bfhi(hv.w) * rstd) * ga1.w + sh1.w);
              *(u32x2*)((unsigned char*)F.XN + rowoff + k0) = (u32x2){o0, o1}; } }
#pragma unroll
        for (int ii = 0; ii < 2; ++ii) { const int rl = rb * 16 + 4 * kg + 2 * kh + ii;
            const float rs = 1.0f / sqrtf((ssqx[rl] + ssqx[64 + rl]) * (1.f / DM) + NORM_EPS);
            const float v0 = (pl[rl * 32 + m] + pl[(64 + rl) * 32 + m]) * rs + cvec[m], v1 = (pl[rl * 32 + 16 + m] + pl[(64 + rl) * 32 + 16 + m]) * rs + cvec[16 + m];
            unsigned u0 = __float_as_uint(v0), u1 = __float_as_uint(v1); u0 = (u0 & 0x80000000u) ? ~u0 : (u0 | 0x80000000u); u1 = (u1 & 0x80000000u) ? ~u1 : (u1 | 0x80000000u);
            unsigned long long key0 = ((unsigned long long)u0 << 32) | (unsigned)(31 - m), key1 = ((unsigned long long)u1 << 32) | (unsigned)(15 - m);
            int ek[4]; float vk[4];
#pragma unroll
            for (int k = 0; k < 4; ++k) { unsigned long long mx = key0 > key1 ? key0 : key1;
#pragma unroll
                for (int o = 1; o < 16; o <<= 1) { const unsigned lo = __shfl_xor((unsigned)mx, o), hi = __shfl_xor((unsigned)(mx >> 32), o); const unsigned long long t = ((unsigned long long)hi << 32) | lo; mx = t > mx ? t : mx; }
                ek[k] = 31 - (int)(mx & 31u); unsigned uu = (unsigned)(mx >> 32); uu = (uu & 0x80000000u) ? (uu & 0x7fffffffu) : ~uu; vk[k] = __uint_as_float(uu);
                if (ek[k] == m) key0 = 0ull; if (ek[k] == 16 + m) key1 = 0ull; }
            const float p1 = __expf(vk[1] - vk[0]), p2 = __expf(vk[2] - vk[0]), p3 = __expf(vk[3] - vk[0]); const float inv = 1.0f / (1.0f + p1 + p2 + p3);
            if (m < 4 && !dry) { const int k = m; const int ee = k == 0 ? ek[0] : (k == 1 ? ek[1] : (k == 2 ? ek[2] : ek[3])); const float gg = (k == 0 ? 1.0f : (k == 1 ? p1 : (k == 2 ? p2 : p3))) * inv;
                const int rank = __hip_atomic_fetch_add(lcnt + ee, 1, __ATOMIC_RELAXED, __HIP_MEMORY_SCOPE_WORKGROUP);
                le[rl * 4 + k] = ee; lrk[rl * 4 + k] = rank; F.rgate[(size_t)(chunk * 64 + rl) * 4 + k] = gg; }
        }
        __syncthreads();
        if (F.tid < 32 && !dry) lbase[F.tid] = (int)__hip_atomic_fetch_add(gcnt + F.tid, (unsigned)lcnt[F.tid], __ATOMIC_RELAXED, __HIP_MEMORY_SCOPE_AGENT);
        __syncthreads();
        if (F.tid < 256 && !dry) { const int row = chunk * 64 + (F.tid >> 2), k = F.tid & 3; const int ee = le[F.tid]; const int slot = lbase[ee] + lrk[F.tid]; F.re[(size_t)row * 4 + k] = ee; F.rslot[(size_t)row * 4 + k] = slot; F.elist[ee * NTOK + slot] = row; }
        __syncthreads();
    }
}
__device__ __forceinline__ int expert_tables(Frame& F, LAS int* pst, LAS int* pexp) {
    LAS int* npan = pst + 40; LAS int* cntT = pexp + 320;
    if (F.tid < 64) {
        const int e = F.lane & 31; const int cnt = (int)__hip_atomic_load(F.ctl + CW_CNT + e, __ATOMIC_RELAXED, __HIP_MEMORY_SCOPE_AGENT);
        const int np = (cnt + 255) >> 8; int incl = np;
#pragma unroll
        for (int o = 1; o < 32; o <<= 1) { const int t = __shfl_up(incl, o, 32); if (e >= o) incl += t; }
        if (F.lane < 32) { const int st = incl - np; cntT[e] = cnt; pst[e] = st * 256; for (int i = 0; i < np; ++i) pexp[st + i] = e; if (e == 31) { pst[32] = incl * 256; npan[0] = incl; } } }
    __syncthreads();
    return npan[0];
}
__device__ __forceinline__ void p5b_scatter(Frame& F) {
    LAS int* pst = (LAS int*)(F.lds + XTRA_OFF); LAS int* pexp = pst + 64;
    (void)expert_tables(F, pst, pexp);
    const int gw = F.vcu * NWAVES + F.wave, NGW = F.G * NWAVES;
    for (int rr = gw; rr < NTOK * RP(F, 6); rr += NGW) { const int row = rr % NTOK;
        const v4u a = *(const v4u*)(F.XN + (size_t)row * DM + 8 * F.lane), b = *(const v4u*)(F.XN + (size_t)row * DM + 512 + 8 * F.lane);
#pragma unroll
        for (int k = 0; k < 4; ++k) { const int e = F.re[(size_t)row * 4 + k]; const int pos = pst[e] + F.rslot[(size_t)row * 4 + k];
            if (F.lane == 0) F.rpos[(size_t)row * 4 + k] = pos;
            *(v4u*)(F.XG + (size_t)pos * DM + 8 * F.lane) = a; *(v4u*)(F.XG + (size_t)pos * DM + 512 + 8 * F.lane) = b; }
    }
}
__device__ __forceinline__ void p8_final(Frame& F) {
    LAS int* pst = (LAS int*)(F.lds + XTRA_OFF); LAS int* pexp = pst + 64;
    (void)expert_tables(F, pst, pexp);
    const int gw = F.vcu * NWAVES + F.wave, NGW = F.G * NWAVES;
    typedef unsigned u32x2 __attribute__((ext_vector_type(2)));
    for (int pp = gw; pp < (NTOK / 2) * RP(F, 9); pp += NGW) { const int row0 = (pp % (NTOK / 2)) * 2;
        const float* g2 = F.modv + (row0 >> 13) * 6144 + 5120;
        int pos[2][4]; float gt[2][4];
#pragma unroll
        for (int q = 0; q < 2; ++q)
#pragma unroll
            for (int k = 0; k < 4; ++k) { const size_t ix = (size_t)(row0 + q) * 4 + k; pos[q][k] = pst[F.re[ix]] + F.rslot[ix]; gt[q][k] = F.rgate[ix]; }
        f32x4 xv[2][4]; unsigned yv[2][4][4];
#pragma unroll
        for (int q = 0; q < 2; ++q)
#pragma unroll
            for (int j = 0; j < 4; ++j) { const int col = 4 * F.lane + 256 * j; { const u32x2 t_ = *(const u32x2*)((const bf16*)F.X1 + (size_t)(row0 + q) * DM + col); xv[q][j] = (f32x4){bflo(t_.x), bfhi(t_.x), bflo(t_.y), bfhi(t_.y)}; }
#pragma unroll
                for (int k = 0; k < 4; ++k) yv[q][j][k] = *(const unsigned*)((const unsigned char*)F.Y2 + (size_t)pos[q][k] * DM + col); }
#pragma unroll
        for (int q = 0; q < 2; ++q) { float s = 0.f;
#pragma unroll
            for (int j = 0; j < 4; ++j) { const int col = 4 * F.lane + 256 * j; f32x4 a = {0.f, 0.f, 0.f, 0.f};
#pragma unroll
                for (int k = 0; k < 4; ++k) { const unsigned y = yv[q][j][k]; const auto lo2 = __builtin_amdgcn_cvt_pk_f32_fp8((int)y, false), hi2 = __builtin_amdgcn_cvt_pk_f32_fp8((int)y, true); a += (f32x4){lo2[0], lo2[1], hi2[0], hi2[1]} * gt[q][k]; }
                xv[q][j] = xv[q][j] + *(const f32x4*)(g2 + col) * a;
                s += (xv[q][j].x * xv[q][j].x + xv[q][j].y * xv[q][j].y) + (xv[q][j].z * xv[q][j].z + xv[q][j].w * xv[q][j].w); }
            const float rstd = 1.0f / sqrtf(wave_sum(s) * (1.f / DM) + NORM_EPS);
#pragma unroll
            for (int j = 0; j < 4; ++j) { const int col = 4 * F.lane + 256 * j; __builtin_nontemporal_store(xv[q][j] * rstd * *(const f32x4*)(F.final_g + col), (f32x4*)(F.out + (size_t)(row0 + q) * DM + col)); } }
    }
}

#ifndef FAST_GEMM
#define FAST_GEMM 1
#endif
#ifndef FAST_ATTN
#define FAST_ATTN 1
#endif
constexpr int N_PHASES = 10;
struct Args { const float* in[23]; float* out; unsigned char* ws; int ph_lo, ph_hi, use_bar, pad; };
__global__ void __launch_bounds__(NWAVES * 64, 2) mk_fwd(Args args) {
    extern __shared__ __attribute__((aligned(16))) unsigned char lds[];
    Frame F;
    F.lds = (LAS unsigned char*)lds; F.MISC = (volatile LAS unsigned*)(F.lds + MISC_OFF);
    F.tid = threadIdx.x; F.lane = F.tid & 63; F.wave = __builtin_amdgcn_readfirstlane(F.tid >> 6);
    F.probe = args.pad; F.G = gridDim.x; { const int bx = blockIdx.x; F.vcu = (F.G % 8 == 0) ? (bx % 8) * (F.G / 8) + bx / 8 : bx; }
    unsigned char* ws = args.ws;
    F.ctl = (gu32*)(ws + WS_CTL);
    F.x = args.in[0]; F.c = args.in[1]; F.ctx = args.in[2]; F.c_ctx = args.in[3]; F.w_mod = args.in[4]; F.b_mod = args.in[5]; F.norm1_g = args.in[6]; F.w_in = args.in[7];
    F.lq1 = args.in[8]; F.lk1 = args.in[9]; F.lq2 = args.in[10]; F.lk2 = args.in[11]; F.subln_g = args.in[12]; F.sink = args.in[13]; F.w_out = args.in[14]; F.norm2_g = args.in[15];
    F.w_router = args.in[16]; F.b_router = args.in[17]; F.w_gu = args.in[18]; F.b_gu = args.in[19]; F.w_dn = args.in[20]; F.b_dn = args.in[21]; F.final_g = args.in[22];
    F.out = args.out;
    F.modp = (float*)(ws + WS_MODP); F.modv = (float*)(ws + WS_MODV); F.rope = (float*)(ws + WS_ROPE); F.X1 = (float*)(ws + WS_X1);
    F.elist = (int*)(ws + WS_ELIST); F.re = (int*)(ws + WS_ROUTE); F.rslot = F.re + NTOK * 4; F.rgate = (float*)(F.rslot + NTOK * 4); F.rpos = (int*)(F.rgate + NTOK * 4);
    F.Win_t = (bf16*)(ws + WS_WIN); F.Wout_t = (bf16*)(ws + WS_WOUT); F.Wgu_t = (bf16*)(ws + WS_WGU); F.Wdn_t = (bf16*)(ws + WS_WDN);
    F.XN = (bf16*)(ws + WS_XN); F.QA = (bf16*)(ws + WS_QA); F.KA = (bf16*)(ws + WS_KA); F.VA = (bf16*)(ws + WS_VA); F.QB = (bf16*)(ws + WS_QB); F.KB = (bf16*)(ws + WS_KB); F.VB = (bf16*)(ws + WS_VB);
    F.Y = (bf16*)(ws + WS_Y); F.XG = (bf16*)(ws + WS_XG); F.H = (bf16*)(ws + WS_H); F.Y2 = (bf16*)(ws + WS_Y2);
    for (int u = F.tid; u < (LDS_BYTES - LDSCTL_OFF) / 4; u += NWAVES * 64) ((LAS unsigned*)(F.lds + LDSCTL_OFF))[u] = 0u;
    __syncthreads();
#ifdef SPIN_SEAM
#define STAMP(k) do { if ((k) == SPIN_SEAM && blockIdx.x == 0 && F.tid == 0) *(volatile LAS unsigned long long*)(F.lds + XTRA_OFF + 15008) = wall_clock64(); } while (0)
    if (blockIdx.x == 0 && F.tid == 0) { const unsigned long long t_ = wall_clock64(); *(volatile LAS unsigned long long*)(F.lds + XTRA_OFF + 15000) = t_; *(volatile LAS unsigned long long*)(F.lds + XTRA_OFF + 15008) = t_; }
#else
#define STAMP(k) do {} while (0)
#endif
    XcdBarrier bar; bar.bar = (unsigned*)(F.ctl + CW_BAR); bar.x = 0; bar.st = nullptr;
    if (args.use_bar) bar = xcd_barrier_post((unsigned*)(F.ctl + CW_BAR), F.MISC + 8);
    const int lo = args.ph_lo, hi = args.ph_hi;
#ifndef PH_MASK
#define PH_MASK 0x3ff
#endif
#define IN(k) (((PH_MASK >> (k)) & 1) && lo <= (k) && (k) < hi)
#ifndef REP_MASK
#define REP_MASK 0
#endif
#define SEAM(k) do { if (IN(k) && IN((k) + 1)) { if (args.use_bar) { xcd_barrier(bar); if (args.pad & 0x10000) { xcd_barrier(bar); xcd_barrier(bar); } } } else { __syncthreads(); } } while (0)

    if (IN(0)) { p0_prologue(F); } SEAM(0); STAMP(0);
    if (IN(1)) { p1_norm(F); } SEAM(1); STAMP(1);
    if (IN(2)) {
        EpiQKV E{F.QA, F.KA, F.VA, F.QB, F.KB, F.VB, F.rope};
#if FAST_GEMM
        if (F.G == 256 && (int)blockIdx.x >= P2_GEMM_WGS) p0_tail(F);
        else {
        RepOrder S; S.init(NROW, INC, F.G == 256 ? P2_GEMM_WGS : F.G, (int)blockIdx.x); S.rep = RP(F, 2);
        EpiQKVFast EA{F.QA, F.KA, F.VA, F.QB, F.KB, F.VB, F.rope};
#if QKV_FP8
        pg8::Gemm g{F.XN, F.Win_t, NROW, INC, DM / 2};
        pg8::gemm_phase<EpiQKVFast, RepOrder, true, true, false, true>(F.lds + RING_OFF, g, S, EA);
#else
        pg8::Gemm g{F.XN, F.Win_t, NROW, INC, DM};
        pg8::gemm_phase<EpiQKVFast, RepOrder, true, true>(F.lds + RING_OFF, g, S, EA);
#endif
        }
#else
        naive_gemm(F, F.XN, NROW / 128, INC, DM, DenseSel{F.Win_t}, E);
#endif
    } SEAM(2); STAMP(2);
#if FAST_ATTN == 1
    if (IN(3)) { p3_vt_pass(F); if (args.use_bar) xcd_barrier(bar); else __syncthreads(); STAMP(10); p3_attention(F); } SEAM(3); STAMP(3);
#else
    if (IN(3)) { naive_diff_attn(F); __syncthreads(); naive_win_attn(F); } SEAM(3); STAMP(3);
#endif
    if (IN(4)) {
        EpiOut E{F.x, F.modv, (float*)((unsigned char*)F.XG + 32 * MiB)};
#if FAST_GEMM
        pg8::Gemm g{F.Y, F.Wout_t, NTOK, DM, DM}; RepOrder S; S.init(NTOK, DM, F.G, (int)blockIdx.x); S.rep = RP(F, 4);
        EpiAdapt<EpiOut, 0> EA{E};
        pg8::gemm_phase<EpiAdapt<EpiOut, 0>, RepOrder, true, true>(F.lds + RING_OFF, g, S, EA);
#else
        naive_gemm(F, F.Y, NTOK / 128, DM, DM, DenseSel{F.Wout_t}, E);
#endif
    } SEAM(4); STAMP(4);
    if (IN(5)) { p5a_route(F); } SEAM(5); STAMP(5);
    if (IN(7)) {
        LAS int* pst = (LAS int*)(F.lds + XTRA_OFF); LAS int* pexp = pst + 64; LAS int* cntT = pexp + 320; LAS int* tokT = (LAS int*)(F.lds + XTRA_OFF + 2048);
        const int NP = expert_tables(F, pst, pexp);
        EpiGU E{(unsigned char*)F.H, F.b_gu};
        GroupedOrder S{GUW / 256, NP, F.G, (int)blockIdx.x, pexp, RP(F, 7), tokT};
        { const int R = S.rounds();
          GroupedOrder S1 = S; S1.rep = 1; const int r = F.tid & 255; int tv[5];
#pragma unroll
          for (int q = 0; q < 5; ++q) { const int i = 2 * q + (F.tid >> 8); pg8::Unit u; tv[q] = -1;
              if (i < R && S1.next(i, u)) { const int e = pexp[u.pm], sl = u.pm * 256 - pst[e] + r; tv[q] = sl < cntT[e] ? F.elist[e * NTOK + sl] : 0; } }
#pragma unroll
          for (int q = 0; q < 5; ++q) { const int i = 2 * q + (F.tid >> 8); if (tv[q] >= 0) tokT[i * 256 + r] = tv[q]; }
          __syncthreads(); }
#if FAST_GEMM
        pg8::Gemm g{F.XN, F.Wgu_t, NP * 256, GUW, DM / 2};
        EpiAdapt<EpiGU, GUW / 256> EA{E};
        pg8::gemm_phase<EpiAdapt<EpiGU, GUW / 256>, GroupedOrder, true, true, true, true>(F.lds + RING_OFF, g, S, EA);
#else
#error "the naive GEMM path has no gather"
#endif
    } SEAM(7); STAMP(7);
    if (IN(8)) {
        LAS int* pst = (LAS int*)(F.lds + XTRA_OFF); LAS int* pexp = pst + 64;
        const int NP = expert_tables(F, pst, pexp);
        EpiDN E{F.Y2, F.b_dn};
#if FAST_GEMM
        pg8::Gemm g{F.H, F.Wdn_t, NP * 256, DM, DM / 2}; GroupedOrder S{DM / 256, NP, F.G, (int)blockIdx.x, pexp, RP(F, 8), nullptr};
        EpiAdaptP<EpiDN, DM / 256> EA{E};
        pg8::gemm_phase<EpiAdaptP<EpiDN, DM / 256>, GroupedOrder, true, true, false, true>(F.lds + RING_OFF, g, S, EA);
#else
        naive_gemm(F, F.H, NP * 2, DM, DM, GroupSel{F.Wdn_t, pexp, DM, DM}, E);
#endif
    } SEAM(8); STAMP(8);
    if (IN(9)) { p8_final(F); }
#ifdef SPIN_SEAM
    if (blockIdx.x == 0 && F.tid == 0) { const unsigned long long t0_ = *(volatile LAS unsigned long long*)(F.lds + XTRA_OFF + 15000), tk_ = *(volatile LAS unsigned long long*)(F.lds + XTRA_OFF + 15008);
        const unsigned long long te_ = wall_clock64(); while (wall_clock64() - te_ < tk_ - t0_) __builtin_amdgcn_s_sleep(8); }
#endif
#undef STAMP
#undef IN
#undef SEAM
}

#ifndef N_LAUNCH_MODE
#define N_LAUNCH_MODE 0
#endif
extern "C" void kernel_launch(void* const* d_in, const int* in_sizes, int n_in, void* d_out, int out_size, void* d_ws, size_t ws_size, hipStream_t stream) {
    static int grid = 0;
    if (grid == 0) {
        if (n_in != 23 || in_sizes[0] != NTOK * DM || out_size != NTOK * DM || ws_size < WS_END) { fprintf(stderr, "kernel_launch: unexpected shapes (n_in %d, in0 %d, out %d, ws %zu); nothing launched\n", n_in, n_in > 0 ? in_sizes[0] : -1, out_size, ws_size); grid = -1; return; }
        int dev = 0, cus = 0, per_cu = 0;
        if (hipGetDevice(&dev) != hipSuccess || hipDeviceGetAttribute(&cus, hipDeviceAttributeMultiprocessorCount, dev) != hipSuccess) { grid = -1; return; }
        if (hipFuncSetAttribute((const void*)mk_fwd, hipFuncAttributeMaxDynamicSharedMemorySize, LDS_BYTES) != hipSuccess) { fprintf(stderr, "kernel_launch: hipFuncSetAttribute failed\n"); grid = -1; return; }
        if (hipOccupancyMaxActiveBlocksPerMultiprocessor(&per_cu, (const void*)mk_fwd, NWAVES * 64, LDS_BYTES) != hipSuccess || per_cu < 1) fprintf(stderr, "kernel_launch: note: occupancy query reports %d\n", per_cu);
        (void)hipGetLastError();
        grid = cus;
    }
    if (grid < 0) return;
    if (hipMemsetAsync((char*)d_ws + WS_CTL, 0, CTL_ZERO_BYTES, stream) != hipSuccess) { fprintf(stderr, "kernel_launch: memset failed\n"); return; }
    Args a{};
    for (int i = 0; i < 23; ++i) a.in[i] = (const float*)d_in[i];
    a.out = (float*)d_out; a.ws = (unsigned char*)d_ws; a.pad = REP_MASK;
#if N_LAUNCH_MODE == 0
    a.ph_lo = 0; a.ph_hi = N_PHASES; a.use_bar = 1;
    hipLaunchKernelGGL(mk_fwd, dim3(grid), dim3(NWAVES * 64), LDS_BYTES, stream, a);
#else
    for (int p = 0; p < N_PHASES; ++p) { a.ph_lo = p; a.ph_hi = p + 1; a.use_bar = 0; hipLaunchKernelGGL(mk_fwd, dim3(grid), dim3(NWAVES * 64), LDS_BYTES, stream, a); }
#endif
}
```
